# Optimizing an MI355X kernel written in HIP

```python
import math
import jax, jax.numpy as jnp
from jax import lax
import numpy as np

D_MODEL = 1024
BATCH = 8
SEQ = 2048
DEPTH = 1
DEC_BATCH = 128
DEC_SEQ = 1
PAST_LEN = 16384
PAGE_SIZE = 128

D_MIX = D_MODEL
C_CONV = D_MIX // 2
CONV_WIDTH = 31
DN_HEADS = 4
DN_DK = (D_MIX - C_CONV) // DN_HEADS
DN_DV = DN_DK
DN_QK = DN_HEADS * DN_DK
DN_V = DN_HEADS * DN_DV
QKV_COLS = 2 * DN_QK + DN_V
SHORT_CONV = 4
DN_CHUNK = 64
N_MEM = 256
MEM_HEADS = 4
MEM_HD = D_MODEL // MEM_HEADS
D_FF = -(-8 * D_MODEL // (3 * 256)) * 256

O_GLU_A = 0
O_GLU_B = C_CONV
O_QKV = 2 * C_CONV
O_Z = O_QKV + QKV_COLS
O_BETA = O_Z + DN_V
O_DECAY = O_BETA + DN_HEADS
IN_COLS = O_DECAY + DN_HEADS

kernel_name = 'hymba_conformer_gdn_memxattn_step'


def rms_norm(x, g, eps=1e-6):
    xf = x.astype(jnp.float32)
    y = xf * lax.rsqrt(jnp.mean(xf * xf, axis=-1, keepdims=True) + eps)
    return (y * g.astype(jnp.float32)).astype(x.dtype)


def layer_norm(x, g, b, eps=1e-5):
    xf = x.astype(jnp.float32)
    mu = jnp.mean(xf, axis=-1, keepdims=True)
    xc = xf - mu
    y = xc * lax.rsqrt(jnp.mean(xc * xc, axis=-1, keepdims=True) + eps)
    return (y * g.astype(jnp.float32) + b.astype(jnp.float32)).astype(x.dtype)


def l2_norm(x, eps=1e-6):
    return x * lax.rsqrt(jnp.sum(x * x, axis=-1, keepdims=True) + eps)


def causal_depthwise_conv(x, buf, w):
    xp = jnp.concatenate([buf.astype(x.dtype), x], axis=1)
    y = lax.conv_general_dilated(xp, w[:, None, :].astype(x.dtype), window_strides=(1,), padding='VALID',
                                 dimension_numbers=('NWC', 'WIO', 'NWC'), feature_group_count=x.shape[-1])
    return y, xp[:, xp.shape[1] - (w.shape[0] - 1):]


def gated_delta_chunked(q, k, v, g, beta, s0):
    bsz, seq = q.shape[0], q.shape[1]
    c = min(DN_CHUNK, seq)
    n = -(-seq // c)
    pad = n * c - seq
    if pad:
        padw = lambda t: jnp.pad(t, [(0, 0), (0, pad)] + [(0, 0)] * (t.ndim - 2))
        q, k, v, g, beta = padw(q), padw(k), padw(v), padw(g), padw(beta)

    def chunks(t):
        t = t.reshape((bsz, n, c) + t.shape[2:])
        return jnp.swapaxes(jnp.swapaxes(t, 0, 1), 2, 3)

    q, k, v, g, beta = chunks(q), chunks(k), chunks(v), chunks(g), chunks(beta)
    gc = jnp.cumsum(g, axis=-1)
    incl = jnp.tril(jnp.ones((c, c), dtype=bool))
    strict = jnp.tril(jnp.ones((c, c), dtype=bool), k=-1)
    decay = jnp.exp(jnp.where(incl, gc[..., :, None] - gc[..., None, :], -jnp.inf))
    kb = k * beta[..., None]
    lower = jnp.where(strict, jnp.einsum('nbhid,nbhjd->nbhij', kb, k) * decay, 0.0)
    a_mat = lower + jnp.eye(c, dtype=lower.dtype)
    u = lax.linalg.triangular_solve(a_mat, v * beta[..., None], left_side=True, lower=True, unit_diagonal=True)
    w = lax.linalg.triangular_solve(a_mat, kb * jnp.exp(gc)[..., None], left_side=True, lower=True,
                                    unit_diagonal=True)
    qk = jnp.where(incl, jnp.einsum('nbhid,nbhjd->nbhij', q, k) * decay, 0.0)

    def step(s, xs):
        q_i, k_i, u_i, w_i, g_i, qk_i = xs
        v_new = u_i - jnp.einsum('bhcd,bhde->bhce', w_i, s)
        o_i = (jnp.einsum('bhcd,bhde->bhce', q_i * jnp.exp(g_i)[..., None], s)
               + jnp.einsum('bhij,bhje->bhie', qk_i, v_new))
        g_last = g_i[..., -1]
        k_dec = k_i * jnp.exp(g_last[..., None] - g_i)[..., None]
        s = s * jnp.exp(g_last)[..., None, None] + jnp.einsum('bhcd,bhce->bhde', k_dec, v_new)
        return s, o_i

    s_fin, o = lax.scan(step, s0, (q, k, u, w, gc, qk))
    o = jnp.swapaxes(jnp.swapaxes(o, 2, 3), 0, 1).reshape(bsz, n * c, o.shape[2], o.shape[-1])[:, :seq]
    return o, s_fin


def parallel_mixer(h, conv_buf, sc_buf, s0, w_in, conv_w, conv_b, conv_ln_g, conv_ln_b, sc_w, a_log, dt_bias,
                   dn_norm, w_out):
    bsz, seq, _ = h.shape
    p = h @ w_in
    u = p[..., O_GLU_A:O_GLU_B] * jax.nn.sigmoid(p[..., O_GLU_B:O_QKV])
    c, new_conv_buf = causal_depthwise_conv(u, conv_buf, conv_w)
    c = jax.nn.silu(layer_norm(c + conv_b, conv_ln_g, conv_ln_b))
    qkv, new_sc_buf = causal_depthwise_conv(p[..., O_QKV:O_Z], sc_buf, sc_w)
    qkv = jax.nn.silu(qkv).astype(jnp.float32)
    q = l2_norm(qkv[..., :DN_QK].reshape(bsz, seq, DN_HEADS, DN_DK)) * (DN_DK ** -0.5)
    k = l2_norm(qkv[..., DN_QK:2 * DN_QK].reshape(bsz, seq, DN_HEADS, DN_DK))
    v = qkv[..., 2 * DN_QK:].reshape(bsz, seq, DN_HEADS, DN_DV)
    beta = jax.nn.sigmoid(p[..., O_BETA:O_DECAY].astype(jnp.float32))
    g = -jnp.exp(a_log.astype(jnp.float32)) * jax.nn.softplus(
        p[..., O_DECAY:IN_COLS].astype(jnp.float32) + dt_bias.astype(jnp.float32))
    o, s_new = gated_delta_chunked(q, k, v, g, beta, s0.astype(jnp.float32))
    z = p[..., O_Z:O_BETA].reshape(bsz, seq, DN_HEADS, DN_DV).astype(jnp.float32)
    o = rms_norm(o, dn_norm) * jax.nn.silu(z)
    d = o.reshape(bsz, seq, DN_V).astype(h.dtype)
    y = jnp.concatenate([c, d], axis=-1) @ w_out
    return y, new_conv_buf, new_sc_buf, s_new.astype(h.dtype)


def memory_kv(mem, norm_mem_kv, w_mk, w_mv):
    bsz, n_mem, _ = mem.shape
    m = rms_norm(mem, norm_mem_kv)
    k = (m @ w_mk).reshape(bsz, n_mem, MEM_HEADS, MEM_HD)
    v = (m @ w_mv).reshape(bsz, n_mem, MEM_HEADS, MEM_HD)
    return k, v


def memory_attend(h, mem_k, mem_v, w_mq, w_mo):
    bsz, seq, _ = h.shape
    q = (h @ w_mq).reshape(bsz, seq, MEM_HEADS, MEM_HD)
    s = jnp.einsum('blhd,bmhd->bhlm', q.astype(jnp.float32), mem_k.astype(jnp.float32)) * (MEM_HD ** -0.5)
    pr = jax.nn.softmax(s, axis=-1)
    o = jnp.einsum('bhlm,bmhd->blhd', pr, mem_v.astype(jnp.float32)).astype(h.dtype)
    return o.reshape(bsz, seq, MEM_HEADS * MEM_HD) @ w_mo


def swiglu(h, w_gate, w_up, w_down):
    return (jax.nn.silu(h @ w_gate) * (h @ w_up)) @ w_down


def decoder_layer(x, conv_buf, sc_buf, s0, mem_k, mem_v, norm_mix, w_in, conv_w, conv_b, conv_ln_g, conv_ln_b,
                  sc_w, a_log, dt_bias, dn_norm, w_out, norm_mem_q, w_mq, w_mo, norm_ffn, w_gate, w_up, w_down):
    y, conv_buf, sc_buf, s = parallel_mixer(rms_norm(x, norm_mix), conv_buf, sc_buf, s0, w_in, conv_w, conv_b,
                                            conv_ln_g, conv_ln_b, sc_w, a_log, dt_bias, dn_norm, w_out)
    x = x + y
    x = x + memory_attend(rms_norm(x, norm_mem_q), mem_k, mem_v, w_mq, w_mo)
    x = x + swiglu(rms_norm(x, norm_ffn), w_gate, w_up, w_down)
    return x, conv_buf, sc_buf, s


def setup_inputs(seed: int = 0) -> dict:
    key = jax.random.key(seed)
    ks = jax.random.split(key, 32)

    def nrm(k, shape, scale):
        return jax.random.normal(k, shape, jnp.float32) * scale

    def gain(k, shape):
        return 1.0 + 0.05 * jax.random.normal(k, shape, jnp.float32)

    dt = jnp.exp(jax.random.uniform(ks[10], (DEPTH, DN_HEADS), jnp.float32, math.log(1e-3), math.log(1e-1)))
    return {
        'x_prompt': nrm(ks[0], (BATCH, SEQ, D_MODEL), 1.0),
        'x_sample': nrm(ks[1], (DEC_BATCH, DEC_SEQ, D_MODEL), 1.0),
        'mem_prompt': nrm(ks[2], (BATCH, N_MEM, D_MODEL), 1.0),
        'cache_conv': nrm(ks[3], (DEPTH, DEC_BATCH, CONV_WIDTH - 1, C_CONV), 0.5),
        'state_short_conv': nrm(ks[4], (DEPTH, DEC_BATCH, SHORT_CONV - 1, QKV_COLS), 1.0),
        'state_delta': nrm(ks[5], (DEPTH, DEC_BATCH, DN_HEADS, DN_DK, DN_DV), 0.1),
        'cache_mem_k': nrm(ks[6], (DEPTH, DEC_BATCH, N_MEM, MEM_HEADS, MEM_HD), 1.0),
        'cache_mem_v': nrm(ks[7], (DEPTH, DEC_BATCH, N_MEM, MEM_HEADS, MEM_HD), 1.0),
        'norm_mix': gain(ks[8], (DEPTH, D_MODEL)),
        'w_in': nrm(ks[9], (DEPTH, D_MODEL, IN_COLS), D_MODEL ** -0.5),
        'conv_w': nrm(ks[11], (DEPTH, CONV_WIDTH, C_CONV), CONV_WIDTH ** -0.5),
        'conv_b': nrm(ks[12], (DEPTH, C_CONV), 0.02),
        'conv_ln_g': gain(ks[13], (DEPTH, C_CONV)),
        'conv_ln_b': nrm(ks[14], (DEPTH, C_CONV), 0.02),
        'sc_w': nrm(ks[15], (DEPTH, SHORT_CONV, QKV_COLS), SHORT_CONV ** -0.5),
        'a_log': jnp.log(jax.random.uniform(ks[16], (DEPTH, DN_HEADS), jnp.float32, 1.0, 16.0)),
        'dt_bias': dt + jnp.log(-jnp.expm1(-dt)),
        'dn_norm': gain(ks[17], (DEPTH, DN_DV)),
        'w_out': nrm(ks[18], (DEPTH, D_MIX, D_MODEL), D_MIX ** -0.5),
        'norm_mem_q': gain(ks[19], (DEPTH, D_MODEL)),
        'norm_mem_kv': gain(ks[20], (DEPTH, D_MODEL)),
        'w_mq': nrm(ks[21], (DEPTH, D_MODEL, MEM_HEADS * MEM_HD), D_MODEL ** -0.5),
        'w_mk': nrm(ks[22], (DEPTH, D_MODEL, MEM_HEADS * MEM_HD), D_MODEL ** -0.5),
        'w_mv': nrm(ks[23], (DEPTH, D_MODEL, MEM_HEADS * MEM_HD), D_MODEL ** -0.5),
        'w_mo': nrm(ks[24], (DEPTH, MEM_HEADS * MEM_HD, D_MODEL), (MEM_HEADS * MEM_HD) ** -0.5),
        'norm_ffn': gain(ks[25], (DEPTH, D_MODEL)),
        'w_gate': nrm(ks[26], (DEPTH, D_MODEL, D_FF), D_MODEL ** -0.5),
        'w_up': nrm(ks[27], (DEPTH, D_MODEL, D_FF), D_MODEL ** -0.5),
        'w_down': nrm(ks[28], (DEPTH, D_FF, D_MODEL), D_FF ** -0.5),
        'norm_f': gain(ks[29], (D_MODEL,)),
    }


def reference(x_prompt, x_sample, mem_prompt, cache_conv, state_short_conv, state_delta, cache_mem_k, cache_mem_v,
              norm_mix, w_in, conv_w, conv_b, conv_ln_g, conv_ln_b, sc_w, a_log, dt_bias, dn_norm, w_out,
              norm_mem_q, norm_mem_kv, w_mq, w_mk, w_mv, w_mo, norm_ffn, w_gate, w_up, w_down, norm_f):
    bp = x_prompt.shape[0]
    dt_ = x_prompt.dtype
    xp, xs = x_prompt, x_sample
    conv_p, sc_p, dl_p, mk_p, mv_p = [], [], [], [], []
    conv_s, sc_s, dl_s = [], [], []
    for l in range(DEPTH):
        lw = (norm_mix[l], w_in[l], conv_w[l], conv_b[l], conv_ln_g[l], conv_ln_b[l], sc_w[l], a_log[l],
              dt_bias[l], dn_norm[l], w_out[l], norm_mem_q[l], w_mq[l], w_mo[l], norm_ffn[l], w_gate[l],
              w_up[l], w_down[l])
        mk, mv = memory_kv(mem_prompt, norm_mem_kv[l], w_mk[l], w_mv[l])
        xp, cb, sb, st = decoder_layer(
            xp, jnp.zeros((bp, CONV_WIDTH - 1, C_CONV), dt_), jnp.zeros((bp, SHORT_CONV - 1, QKV_COLS), dt_),
            jnp.zeros((bp, DN_HEADS, DN_DK, DN_DV), dt_), mk, mv, *lw)
        conv_p.append(cb); sc_p.append(sb); dl_p.append(st); mk_p.append(mk); mv_p.append(mv)
        xs, cb, sb, st = decoder_layer(xs, cache_conv[l], state_short_conv[l], state_delta[l], cache_mem_k[l],
                                       cache_mem_v[l], *lw)
        conv_s.append(cb); sc_s.append(sb); dl_s.append(st)
    y_prompt = rms_norm(xp, norm_f)
    y_sample = rms_norm(xs, norm_f)
    return (y_prompt, y_sample, jnp.stack(conv_p), jnp.stack(sc_p), jnp.stack(dl_p), jnp.stack(mk_p),
            jnp.stack(mv_p), jnp.stack(conv_s), jnp.stack(sc_s), jnp.stack(dl_s))
```

```cpp
#include <hip/hip_runtime.h>
#include <cstdio>
#include <cstdint>
#define MK_PER_PHASE 0
namespace pg8 {
#define PG8_LAS __attribute__((address_space(3)))
typedef unsigned short bf16_t;
typedef short bf16x8 __attribute__((ext_vector_type(8)));
typedef float f32x4 __attribute__((ext_vector_type(4)));
typedef unsigned u32x4 __attribute__((ext_vector_type(4)));
constexpr int BM = 256, BK = 64, HALF = 128, HTB = HALF * BK * 2  , STAGE_BYTES = 8 * HTB, NXCD = 8, WGM = 8;

__host__ __device__ __forceinline__ int lds_byte(int r, int c) { const int st = (r >> 4) * 2 + (c >> 5), rr = r & 15, cc = c & 31, ob = rr * 64 + cc * 2; return st * 1024 + (ob ^ (((ob >> 9) & 1) << 5)); }
__host__ __device__ __forceinline__ void stage_rc(int b, int& R, int& C) { const int st = b / 1024, sb = b % 1024, swz = sb ^ (((sb >> 9) & 1) << 5); R = (st >> 1) * 16 + swz / 64; C = (st & 1) * 32 + (swz % 64) / 2; }
__host__ __device__ __forceinline__ int perm32(int rho) { const int n = rho >> 4, i = rho & 15; return 8 * (i >> 2) + 4 * n + (i & 3); }

struct Unit { int pm, pn; };
struct Gemm { const bf16_t* A; const bf16_t* Bt; int M, N, K; };

struct StaticOrder {
    int nM, nN, nwg, G, c;
    __host__ __device__ void init(int M, int N, int G_, int c_) { nM = M / BM; nN = N / BM; nwg = nM * nN; G = G_; c = c_; }
    __host__ __device__ bool next(int i, Unit& u) const {
        const long L = (long)i * G + c; if (L >= nwg) return false;
        int wgid = (int)L; { const int q = nwg / NXCD, r = nwg % NXCD, xcd = wgid % NXCD, off = wgid / NXCD; wgid = (xcd < r ? xcd * (q + 1) : r * (q + 1) + (xcd - r) * q) + off; }
        const int nig = WGM * nN, gid = wgid / nig, fm = gid * WGM, gsz = (nM - fm) < WGM ? (nM - fm) : WGM;
        u.pm = fm + ((wgid % nig) % gsz); u.pn = (wgid % nig) / gsz; return true;
    }
    __device__ __forceinline__ void a_ready(const Unit&) const {}
    __device__ __forceinline__ void done(const Unit&) const {}
};

__device__ __forceinline__ unsigned cvt_pk_bf16(float lo, float hi) { unsigned r; asm volatile("v_cvt_pk_bf16_f32 %0, %1, %2" : "=v"(r) : "v"(lo), "v"(hi)); return r; }
typedef float f32x2_t __attribute__((ext_vector_type(2))); typedef __bf16 bf16x2_t __attribute__((ext_vector_type(2)));
__device__ __forceinline__ unsigned pk2(float lo, float hi) { f32x2_t v = {lo, hi}; bf16x2_t b = __builtin_convertvector(v, bf16x2_t); return __builtin_bit_cast(unsigned, b); }
__device__ __forceinline__ float sigm(float x) { return 1.f / (1.f + __expf(-x)); }
__device__ __forceinline__ float silu(float x) { return x / (1.f + __expf(-x)); }
__device__ __forceinline__ u32x4 pk8(const f32x4& a, const f32x4& b) { u32x4 w; w.x = pk2(a[0], a[1]); w.y = pk2(a[2], a[3]); w.z = pk2(b[0], b[1]); w.w = pk2(b[2], b[3]); return w; }
constexpr int PBLD = 2560;
constexpr int MPROMPT = 16384;
constexpr float RMS_EPS = 1e-6f;

struct EpiIn {
    static constexpr bool PERM = true, AFTER_DRAIN = false;
    bf16_t* PB;
    __device__ __forceinline__ void operator()(const f32x4 (&acc)[2][2][4][2], const Unit& u, int wr, int wc, int fr, int fq) const {
        const int row0 = u.pm * BM + wr * 64 + fr;
        if (u.pn < 4) {
            const int ch0 = u.pn * 128 + wc * 32 + 8 * fq;
#pragma unroll
            for (int ai = 0; ai < 2; ++ai)
#pragma unroll
                for (int m = 0; m < 4; ++m) {
                    bf16_t* rowp = PB + (size_t)(row0 + ai * HALF + m * 16) * PBLD + ch0;
                    f32x4 v0, v1;
#pragma unroll
                    for (int i = 0; i < 4; ++i) { v0[i] = acc[ai][0][m][0][i] * sigm(acc[ai][1][m][0][i]); v1[i] = acc[ai][0][m][1][i] * sigm(acc[ai][1][m][1][i]); }
                    *(u32x4*)rowp = pk8(v0, v1);
                }
        } else {
            const int col0 = u.pn * BM - 512 + wc * 32 + 8 * fq;
#pragma unroll
            for (int ai = 0; ai < 2; ++ai)
#pragma unroll
                for (int m = 0; m < 4; ++m) {
                    bf16_t* rowp = PB + (size_t)(row0 + ai * HALF + m * 16) * PBLD + col0;
#pragma unroll
                    for (int bj = 0; bj < 2; ++bj) *(u32x4*)(rowp + bj * HALF) = pk8(acc[ai][bj][m][0], acc[ai][bj][m][1]);
                }
        }
    }
};

struct EpiKV {
    static constexpr bool PERM = true, AFTER_DRAIN = false;
    float* outK; float* outV; bf16_t* KB; bf16_t* VT;
    __device__ __forceinline__ void operator()(const f32x4 (&acc)[2][2][4][2], const Unit& u, int wr, int wc, int fr, int fq) const {
        const int row0 = u.pm * BM + wr * 64 + fr;
        const bool isv = u.pn >= 4;
        const int c0 = (isv ? u.pn - 4 : u.pn) * BM + wc * 32 + 8 * fq;
        float* outp = isv ? outV : outK;
#pragma unroll
        for (int ai = 0; ai < 2; ++ai)
#pragma unroll
            for (int m = 0; m < 4; ++m) {
                const int row = row0 + ai * HALF + m * 16;
#pragma unroll
                for (int bj = 0; bj < 2; ++bj) {
                    const int col = c0 + bj * HALF;
                    const f32x4 a = acc[ai][bj][m][0], b = acc[ai][bj][m][1];
                    *(f32x4*)(outp + (size_t)row * 1024 + col) = a; *(f32x4*)(outp + (size_t)row * 1024 + col + 4) = b;
                    const u32x4 w = pk8(a, b);
                    if (!isv) *(u32x4*)(KB + (size_t)row * 1024 + col) = w;
                    else {
                        bf16_t* vp = VT + (size_t)col * 2048 + row;
                        vp[0 * 2048] = (bf16_t)(w.x & 0xffffu); vp[1 * 2048] = (bf16_t)(w.x >> 16); vp[2 * 2048] = (bf16_t)(w.y & 0xffffu); vp[3 * 2048] = (bf16_t)(w.y >> 16);
                        vp[4 * 2048] = (bf16_t)(w.z & 0xffffu); vp[5 * 2048] = (bf16_t)(w.z >> 16); vp[6 * 2048] = (bf16_t)(w.w & 0xffffu); vp[7 * 2048] = (bf16_t)(w.w >> 16);
                    }
                }
            }
    }
};

template <bool WRITE_BF> struct EpiRes {
    static constexpr bool PERM = true, AFTER_DRAIN = false;
    const float* base_main; const float* base_tail;
    int load_limit, store_limit;
    float* out; bf16_t* outb; float* ss;
    __device__ __forceinline__ void operator()(const f32x4 (&acc)[2][2][4][2], const Unit& u, int wr, int wc, int fr, int fq) const {
        const int row0 = u.pm * BM + wr * 64 + fr; const int col0 = u.pn * BM + wc * 32 + 8 * fq;
        const float* bp = (u.pm >= 64) ? base_tail - (size_t)MPROMPT * 1024 : base_main;
#pragma unroll
        for (int ai = 0; ai < 2; ++ai)
#pragma unroll
            for (int m = 0; m < 4; ++m) {
                const int row = row0 + ai * HALF + m * 16; const size_t off = (size_t)row * 1024 + col0;
                float s = 0.f;
#pragma unroll
                for (int bj = 0; bj < 2; ++bj) {
                    f32x4 b0 = (f32x4){0.f, 0.f, 0.f, 0.f}, b1 = b0;
                    if (row < load_limit) { b0 = *(const f32x4*)(bp + off + bj * HALF); b1 = *(const f32x4*)(bp + off + bj * HALF + 4); }
                    const f32x4 v0 = acc[ai][bj][m][0] + b0, v1 = acc[ai][bj][m][1] + b1;
                    s += (v0[0] * v0[0] + v0[1] * v0[1]) + (v0[2] * v0[2] + v0[3] * v0[3]) + (v1[0] * v1[0] + v1[1] * v1[1]) + (v1[2] * v1[2] + v1[3] * v1[3]);
                    if (row < store_limit) { *(f32x4*)(out + off + bj * HALF) = v0; *(f32x4*)(out + off + bj * HALF + 4) = v1; }
                    if (WRITE_BF) *(u32x4*)(outb + off + bj * HALF) = pk8(v0, v1);
                }
                s += __shfl_xor(s, 16); s += __shfl_xor(s, 32);
                if (fq == 0) atomicAdd(ss + row, s);
            }
    }
};

struct EpiQ {
    static constexpr bool PERM = true, AFTER_DRAIN = false;
    bf16_t* Q; const float* ss; float c2;
    __device__ __forceinline__ void operator()(const f32x4 (&acc)[2][2][4][2], const Unit& u, int wr, int wc, int fr, int fq) const {
        const int row0 = u.pm * BM + wr * 64 + fr; const int col0 = u.pn * BM + wc * 32 + 8 * fq;
#pragma unroll
        for (int ai = 0; ai < 2; ++ai)
#pragma unroll
            for (int m = 0; m < 4; ++m) {
                const int row = row0 + ai * HALF + m * 16;
                const float rs = __builtin_amdgcn_rsqf(ss[row] * (1.f / 1024.f) + RMS_EPS) * c2;
#pragma unroll
                for (int bj = 0; bj < 2; ++bj) *(u32x4*)(Q + (size_t)row * 1024 + col0 + bj * HALF) = pk8(acc[ai][bj][m][0] * rs, acc[ai][bj][m][1] * rs);
            }
    }
};

struct EpiGU {
    static constexpr bool PERM = true, AFTER_DRAIN = false;
    bf16_t* T; const float* ss;
    __device__ __forceinline__ void operator()(const f32x4 (&acc)[2][2][4][2], const Unit& u, int wr, int wc, int fr, int fq) const {
        const int row0 = u.pm * BM + wr * 64 + fr; const int ch0 = u.pn * 128 + wc * 32 + 8 * fq;
#pragma unroll
        for (int ai = 0; ai < 2; ++ai)
#pragma unroll
            for (int m = 0; m < 4; ++m) {
                const int row = row0 + ai * HALF + m * 16;
                const float rs = __builtin_amdgcn_rsqf(ss[row] * (1.f / 1024.f) + RMS_EPS);
                f32x4 v0, v1;
#pragma unroll
                for (int i = 0; i < 4; ++i) { v0[i] = silu(acc[ai][0][m][0][i] * rs) * (acc[ai][1][m][0][i] * rs); v1[i] = silu(acc[ai][0][m][1][i] * rs) * (acc[ai][1][m][1][i] * rs); }
                *(u32x4*)(T + (size_t)row * 2816 + ch0) = pk8(v0, v1);
            }
    }
};

template <class Epi, class Sched, bool ALIGN_EPI = false, bool SP2 = false>
__device__ __forceinline__ void gemm_phase(PG8_LAS unsigned char* lds, const Gemm g, const Sched& S, const Epi& E) {
    const int tid = threadIdx.x, wid = __builtin_amdgcn_readfirstlane(tid >> 6), lane = tid & 63, wr = wid >> 2, wc = wid & 3, fr = lane & 15, fq = lane >> 4;
    const int K = g.K, nt = K / BK;
    unsigned voffA[2], voffB[2];
#pragma unroll
    for (int i = 0; i < 2; ++i) { int R, C; stage_rc(tid * 16 + i * 8192, R, C); const int Rb = Epi::PERM ? ((R & ~31) + perm32(R & 31)) : R;
        voffA[i] = (unsigned)(R * K + C) * 2u; voffB[i] = (unsigned)(Rb * K + C) * 2u; }
    const size_t kstep = (size_t)(BK * 2);
    const size_t hstep = (size_t)HALF * K * 2;
    const size_t tstep = 2 * hstep;
    const unsigned ldsw = (unsigned)wid * 1024u;
    const int aoff = lds_byte(wr * 64 + fr, fq * 8), boff = lds_byte(wc * 32 + fr, fq * 8);
#define PG8_SA(b, h) (((b) * 2 + (h)) * HTB)
#define PG8_SB(b, h) ((4 + (b) * 2 + (h)) * HTB)
#define PG8_STAGE(bufoff, gbase, voff) do { _Pragma("unroll") for (int _i = 0; _i < 2; ++_i) \
        __builtin_amdgcn_global_load_lds((const unsigned*)((const char*)(gbase) + (voff)[_i]), (PG8_LAS unsigned*)(lds + (bufoff) + ldsw + _i * 8192), 16, 0, 0); } while (0)
#define PG8_LDA(dst, b, h) do { _Pragma("unroll") for (int m = 0; m < 4; ++m) _Pragma("unroll") for (int k = 0; k < 2; ++k) dst[m][k] = *(const PG8_LAS bf16x8*)(lds + PG8_SA(b, h) + aoff + m * 2048 + k * 1024); } while (0)
#define PG8_LDB(dst, b, h) do { _Pragma("unroll") for (int n = 0; n < 2; ++n) _Pragma("unroll") for (int k = 0; k < 2; ++k) dst[n][k] = *(const PG8_LAS bf16x8*)(lds + PG8_SB(b, h) + boff + n * 2048 + k * 1024); } while (0)
#define PG8_MMA(ai, bj, At, Bt) do { __builtin_amdgcn_s_setprio(1); _Pragma("unroll") for (int m = 0; m < 4; ++m) _Pragma("unroll") for (int n = 0; n < 2; ++n) _Pragma("unroll") for (int k = 0; k < 2; ++k) \
        acc[ai][bj][m][n] = __builtin_amdgcn_mfma_f32_16x16x32_bf16(Bt[n][k], At[m][k], acc[ai][bj][m][n], 0, 0, 0); __builtin_amdgcn_s_setprio(0); } while (0)
#define PG8_WAIT_V(n) asm volatile("s_waitcnt vmcnt(" #n ")" ::: "memory")
#define PG8_WAIT_L(n) asm volatile("s_waitcnt lgkmcnt(" #n ")" ::: "memory")
#define PG8_BAR __builtin_amdgcn_s_barrier()
#define PG8_SCHED __builtin_amdgcn_sched_barrier(0)
    Unit cur, nxt; int ui = 0;
    if (!S.next(0, cur)) return;
    f32x4 acc[2][2][4][2];
#pragma unroll
    for (int a = 0; a < 2; ++a)
#pragma unroll
        for (int b = 0; b < 2; ++b)
#pragma unroll
            for (int m = 0; m < 4; ++m)
#pragma unroll
                for (int n = 0; n < 2; ++n) acc[a][b][m][n] = (f32x4){0.f, 0.f, 0.f, 0.f};
    bf16x8 At[4][2], B0[2][2], B1[2][2];
    const char* cA = (const char*)g.A + (size_t)cur.pm * tstep; const char* cB = (const char*)g.Bt + (size_t)cur.pn * tstep;
    S.a_ready(cur);
    if constexpr (SP2) {
        PG8_STAGE(PG8_SB(0, 0), cB, voffB); PG8_STAGE(PG8_SB(0, 1), cB + hstep, voffB); PG8_STAGE(PG8_SA(0, 0), cA, voffA); PG8_STAGE(PG8_SA(0, 1), cA + hstep, voffA);
        if (wr == 1) PG8_BAR;
        PG8_WAIT_V(2); PG8_BAR;
        PG8_STAGE(PG8_SB(1, 0), cB + kstep, voffB); PG8_STAGE(PG8_SA(1, 0), cA + kstep, voffA); PG8_STAGE(PG8_SB(1, 1), cB + hstep + kstep, voffB);
        PG8_WAIT_V(6); PG8_BAR;
    } else {
        PG8_STAGE(PG8_SB(0, 0), cB, voffB); PG8_STAGE(PG8_SA(0, 0), cA, voffA); PG8_STAGE(PG8_SB(0, 1), cB + hstep, voffB); PG8_STAGE(PG8_SA(0, 1), cA + hstep, voffA);
        if (wr == 1) PG8_BAR;
        PG8_WAIT_V(4); PG8_BAR;
        PG8_STAGE(PG8_SB(1, 0), cB + kstep, voffB); PG8_STAGE(PG8_SA(1, 0), cA + kstep, voffA); PG8_STAGE(PG8_SB(1, 1), cB + hstep + kstep, voffB);
        PG8_WAIT_V(6); PG8_BAR;
    }
    for (;;) {
        const bool has_next = S.next(ui + 1, nxt);
        const char* nA = has_next ? (const char*)g.A + (size_t)nxt.pm * tstep : cA; const char* nB = has_next ? (const char*)g.Bt + (size_t)nxt.pn * tstep : cB;
        for (int t = 0; t < nt; t += 2) {
            const bool last = (t == nt - 2);
            const char* a1 = cA + (size_t)(t + 1) * kstep;
            const char* a2 = last ? nA : cA + (size_t)(t + 2) * kstep; const char* b2 = last ? nB : cB + (size_t)(t + 2) * kstep;
            const char* a3 = a2 + kstep; const char* b3 = b2 + kstep;
            if (last && has_next) S.a_ready(nxt);
            if constexpr (SP2) {
            PG8_LDB(B0, 0, 0); PG8_LDB(B1, 0, 1); PG8_SCHED; PG8_LDA(At, 0, 0); PG8_STAGE(PG8_SA(1, 1), a1 + hstep, voffA);
            PG8_WAIT_V(8); PG8_WAIT_L(0); PG8_BAR; PG8_MMA(0, 0, At, B0); PG8_MMA(0, 1, At, B1); PG8_BAR; PG8_SCHED;
            PG8_LDA(At, 0, 1); PG8_STAGE(PG8_SB(0, 0), b2, voffB); PG8_STAGE(PG8_SB(0, 1), b2 + hstep, voffB); PG8_STAGE(PG8_SA(0, 0), a2, voffA);
            PG8_WAIT_V(8); PG8_WAIT_L(0); PG8_BAR; PG8_MMA(1, 0, At, B0); PG8_MMA(1, 1, At, B1); PG8_BAR; PG8_SCHED;
            PG8_LDB(B0, 1, 0); PG8_LDB(B1, 1, 1); PG8_SCHED; PG8_LDA(At, 1, 0); PG8_STAGE(PG8_SA(0, 1), a2 + hstep, voffA);
            PG8_WAIT_V(8); PG8_WAIT_L(0); PG8_BAR; PG8_MMA(0, 0, At, B0); PG8_MMA(0, 1, At, B1); PG8_BAR; PG8_SCHED;
            PG8_LDA(At, 1, 1); PG8_STAGE(PG8_SB(1, 0), b3, voffB); PG8_STAGE(PG8_SB(1, 1), b3 + hstep, voffB); PG8_STAGE(PG8_SA(1, 0), a3, voffA);
            PG8_WAIT_V(8); PG8_WAIT_L(0); PG8_BAR; PG8_MMA(1, 0, At, B0); PG8_MMA(1, 1, At, B1); PG8_BAR; PG8_SCHED;
            } else {
            PG8_LDB(B0, 0, 0); PG8_SCHED; PG8_LDA(At, 0, 0); PG8_STAGE(PG8_SA(1, 1), a1 + hstep, voffA);
            PG8_WAIT_L(8); PG8_BAR; PG8_WAIT_L(0); PG8_MMA(0, 0, At, B0); PG8_BAR; PG8_SCHED;
            PG8_LDB(B1, 0, 1); PG8_STAGE(PG8_SB(0, 0), b2, voffB);
            PG8_BAR; PG8_WAIT_L(0); PG8_MMA(0, 1, At, B1); PG8_BAR;
            PG8_LDA(At, 0, 1); PG8_STAGE(PG8_SA(0, 0), a2, voffA);
            PG8_BAR; PG8_WAIT_L(0); PG8_MMA(1, 0, At, B0); PG8_BAR; PG8_SCHED;
            PG8_STAGE(PG8_SB(0, 1), b2 + hstep, voffB);
            PG8_WAIT_V(6); PG8_BAR; PG8_MMA(1, 1, At, B1); PG8_BAR;
            PG8_LDB(B0, 1, 0); PG8_SCHED; PG8_LDA(At, 1, 0); PG8_STAGE(PG8_SA(0, 1), a2 + hstep, voffA);
            PG8_WAIT_L(8); PG8_BAR; PG8_WAIT_L(0); PG8_MMA(0, 0, At, B0); PG8_BAR; PG8_SCHED;
            PG8_LDB(B1, 1, 1); PG8_STAGE(PG8_SB(1, 0), b3, voffB);
            PG8_BAR; PG8_WAIT_L(0); PG8_MMA(0, 1, At, B1); PG8_BAR;
            PG8_LDA(At, 1, 1); PG8_STAGE(PG8_SA(1, 0), a3, voffA);
            PG8_BAR; PG8_WAIT_L(0); PG8_MMA(1, 0, At, B0); PG8_BAR; PG8_SCHED;
            PG8_STAGE(PG8_SB(1, 1), b3 + hstep, voffB);
            PG8_WAIT_V(6); PG8_BAR; PG8_MMA(1, 1, At, B1); PG8_BAR;
            }
        }
        if constexpr (ALIGN_EPI) { if (wr == 0) PG8_BAR; }
        if constexpr (!Epi::AFTER_DRAIN) { E(acc, cur, wr, wc, fr, fq); S.done(cur); }
        if (!has_next) break;
#pragma unroll
        for (int a = 0; a < 2; ++a)
#pragma unroll
            for (int b = 0; b < 2; ++b)
#pragma unroll
                for (int m = 0; m < 4; ++m)
#pragma unroll
                    for (int n = 0; n < 2; ++n) acc[a][b][m][n] = (f32x4){0.f, 0.f, 0.f, 0.f};
        cur = nxt; cA = nA; cB = nB; ++ui;
        if constexpr (ALIGN_EPI) { if (wr == 1) PG8_BAR; }
    }
    PG8_WAIT_V(0);
    if constexpr (!ALIGN_EPI) { if (wr == 0) PG8_BAR; }
    PG8_BAR;
    if constexpr (Epi::AFTER_DRAIN) { E.fused(acc, cur, wr, wc, fr, fq, lds, wid, lane); S.done(cur); }
#undef PG8_SA
#undef PG8_SB
#undef PG8_STAGE
#undef PG8_LDA
#undef PG8_LDB
#undef PG8_MMA
#undef PG8_WAIT_V
#undef PG8_WAIT_L
#undef PG8_BAR
#undef PG8_SCHED
}
}

constexpr int NWAVES = 8;
#ifndef MK_PER_PHASE
#define MK_PER_PHASE 0
#endif
constexpr int N_PHASES = 13;

constexpr int DM = 1024, NB = 8, SEQ = 2048, MP = NB * SEQ  , DEC = 128, MV = MP + DEC  , MR = 16640  ;
constexpr int CC = 512, CW = 31, NH = 4, DKV = 128, QKVN = 1536, NMEM = 256, MHD = 256, DFF = 2816, INC = 3080;
constexpr int PBLD = pg8::PBLD;
constexpr int NCHUNK = NB * NH * 32;
constexpr float RMS_EPS = 1e-6f;
constexpr float ATT_C2 = 0.0625f * 1.4426950408889634f;

constexpr size_t OUT_YP = 0, OUT_YS = 16777216, OUT_CONVP = 16908288, OUT_SCP = 17031168, OUT_DLP = 17068032, OUT_MKP = 17592320, OUT_MVP = 19689472,
                 OUT_CONVS = 21786624, OUT_SCS = 23752704, OUT_DLS = 24342528, OUT_END = 32731136;

constexpr size_t MiB = 1u << 20;
constexpr size_t WS_CTL = 0, CTL_ZERO_BYTES = 1 * MiB;
constexpr size_t WS_WIN = 1 * MiB, WS_WOUT = 7 * MiB, WS_WMQ = 9 * MiB, WS_WMKV = 11 * MiB, WS_WMO = 15 * MiB, WS_WGU = 17 * MiB, WS_WDN = 28 * MiB;
constexpr size_t WS_BG = 34 * MiB, WS_MEMN = 35 * MiB, WS_KB = 39 * MiB, WS_VT = 43 * MiB, WS_GL = 47 * MiB;
constexpr size_t WS_RA = 48 * MiB;
constexpr size_t WS_RB = 138 * MiB;
constexpr size_t WS_RC = 171 * MiB;
constexpr size_t WS_RD = 220 * MiB;
constexpr size_t WS_U = WS_RD, WS_W = 252 * MiB, WS_QG = 268 * MiB, WS_KDT = 284 * MiB, WS_QK = 300 * MiB;
constexpr size_t WS_RE = 308 * MiB;
constexpr size_t WS_RF = 341 * MiB;
constexpr size_t WS_END = 406 * MiB;
constexpr int CW_TMO = 0, CW_CODE = 1, CW_BAR = 4096, CW_SS1 = 65536, CW_SS2 = 98304, CW_SS3 = 131072;

constexpr int RING_OFF = 0, RING_BYTES = 143360;
constexpr int LDSCTL_OFF = RING_BYTES, MISC_OFF = LDSCTL_OFF + 320;
constexpr int LDS_BYTES = 147456;

#define GAS __attribute__((address_space(1)))
#define LAS __attribute__((address_space(3)))
typedef unsigned short bf16;
typedef unsigned v4u __attribute__((ext_vector_type(4)));
typedef unsigned v2u __attribute__((ext_vector_type(2)));
typedef float f32x4 __attribute__((ext_vector_type(4)));
typedef float f32x16 __attribute__((ext_vector_type(16)));
typedef short bf16x8 __attribute__((ext_vector_type(8)));
typedef GAS unsigned gu32;
#define RLX_AGENT __ATOMIC_RELAXED, __HIP_MEMORY_SCOPE_AGENT
#define LDS_WAIT() asm volatile("s_waitcnt lgkmcnt(0)" ::: "memory")
#define VM_WAIT() asm volatile("s_waitcnt vmcnt(0)" ::: "memory")
using pg8::pk2; using pg8::silu; using pg8::sigm;
__device__ __forceinline__ float bf2f(unsigned b) { return __uint_as_float(b << 16); }
__device__ __forceinline__ float bflo(unsigned w) { return __uint_as_float(w << 16); }
__device__ __forceinline__ float bfhi(unsigned w) { return __uint_as_float(w & 0xffff0000u); }
__device__ __forceinline__ void unpack8(const v4u& w, float (&f)[8]) { f[0] = bflo(w.x); f[1] = bfhi(w.x); f[2] = bflo(w.y); f[3] = bfhi(w.y); f[4] = bflo(w.z); f[5] = bfhi(w.z); f[6] = bflo(w.w); f[7] = bfhi(w.w); }
__device__ __forceinline__ v4u pack8(const float (&f)[8]) { v4u w; w.x = pk2(f[0], f[1]); w.y = pk2(f[2], f[3]); w.z = pk2(f[4], f[5]); w.w = pk2(f[6], f[7]); return w; }
__device__ __forceinline__ float wave_sum(float v) {
#pragma unroll
    for (int o = 1; o < 64; o <<= 1) v += __shfl_xor(v, o);
    return v;
}
__device__ __forceinline__ float wave_max(float v) {
#pragma unroll
    for (int o = 1; o < 64; o <<= 1) v = fmaxf(v, __shfl_xor(v, o));
    return v;
}

#define XB_TMO      128
#define XB_XCNT(j)  (256  + 64 * (j))
#define XB_XSUB(j)  (1280 + 64 * (j))
#define XB_XGEN(j)  (2304 + 64 * (j))
#define XB_TOP      3328
#define XB_TOPGEN   3392
#define XCD_BAR_WORDS 3456
#define XB_SPIN_CAP (1u << 18)

__device__ __forceinline__ unsigned xb_ld(unsigned* p)              { return __hip_atomic_load(p, __ATOMIC_RELAXED, __HIP_MEMORY_SCOPE_AGENT); }
__device__ __forceinline__ unsigned xb_add(unsigned* p, unsigned v) { return __hip_atomic_fetch_add(p, v, __ATOMIC_RELAXED, __HIP_MEMORY_SCOPE_AGENT); }
__device__ __forceinline__ unsigned xb_xcc_id() { return (unsigned)__builtin_amdgcn_s_getreg((3 << 11) | 20) & 0xFu; }
#define XB_SPIN(cond, bar) do { unsigned _sp = 0; while (cond) { __builtin_amdgcn_s_sleep(1); \
    if ((++_sp & 255u) == 0u) { if (xb_ld(&(bar)[XB_TMO])) break; if (_sp > XB_SPIN_CAP) { atomicAdd(&(bar)[XB_TMO], 1u); break; } } } } while (0)

struct XcdBarrier {
    unsigned* bar; unsigned x;
    volatile LAS unsigned* st;
};

__device__ __forceinline__ XcdBarrier xcd_barrier_post(unsigned* bar, volatile LAS unsigned* st) {
    XcdBarrier b; b.bar = bar; b.x = xb_xcc_id(); b.st = st;
    if (threadIdx.x == 0) (void)xb_add(&bar[XB_XCNT(b.x)], 1u);
    return b;
}
__device__ __forceinline__ void xcd_barrier_complete(unsigned* bar, unsigned x, unsigned& nloc, unsigned& nx) {
    const unsigned G = gridDim.x * gridDim.y * gridDim.z;
    unsigned sum, cnt, mine, sp = 0u;
    for (;;) {
        sum = 0u; cnt = 0u; mine = 0u;
#pragma unroll
        for (unsigned j = 0; j < 16; ++j) { const unsigned c = xb_ld(&bar[XB_XCNT(j)]); sum += c; cnt += (c > 0u) ? 1u : 0u; mine = (j == x) ? c : mine; }
        if (sum == G) break;
        __builtin_amdgcn_s_sleep(1);
        if ((++sp & 255u) == 0u) { if (xb_ld(&bar[XB_TMO])) break; if (sp > XB_SPIN_CAP) { atomicAdd(&bar[XB_TMO], 1u); break; } }
    }
    nloc = mine > 0u ? mine : 1u; nx = cnt > 0u ? cnt : 1u;
}

__device__ __forceinline__ void xcd_barrier(const XcdBarrier& b) {
    asm volatile("s_waitcnt vmcnt(0)" ::: "memory");
    __syncthreads();
    if (threadIdx.x == 0) {
        unsigned* bar = b.bar;
        __builtin_amdgcn_s_waitcnt(0);
        unsigned nloc = b.st[0], nx = b.st[1];
        if (nloc == 0u) { xcd_barrier_complete(bar, b.x, nloc, nx); b.st[0] = nloc; b.st[1] = nx; }
        const unsigned old = xb_add(&bar[XB_XSUB(b.x)], 1u);
        const unsigned gen = old / nloc;
        if (old + 1u == (gen + 1u) * nloc) {
            __builtin_amdgcn_fence(__ATOMIC_RELEASE, "agent");
            asm volatile("s_waitcnt vmcnt(0)" ::: "memory");
            const unsigned og = xb_add(&bar[XB_TOP], 1u);
            const unsigned tg = og / nx;
            if (og + 1u == (tg + 1u) * nx) xb_add(&bar[XB_TOPGEN], 1u);
            else XB_SPIN(xb_ld(&bar[XB_TOPGEN]) == tg, bar);
            __builtin_amdgcn_fence(__ATOMIC_ACQUIRE, "agent");
            xb_add(&bar[XB_XGEN(b.x)], 1u);
            asm volatile("s_waitcnt vmcnt(0)" ::: "memory");
        } else {
            XB_SPIN(xb_ld(&bar[XB_XGEN(b.x)]) == gen, bar);
            __builtin_amdgcn_fence(__ATOMIC_ACQUIRE, "agent");
            asm volatile("s_waitcnt vmcnt(0)" ::: "memory");
        }
    }
    __syncthreads();
}

struct Args { const float* in[30]; float* out; unsigned char* ws; int ph_lo, ph_hi, li, pad; };
struct Frame {
    LAS unsigned char* lds;
    volatile LAS unsigned* MISC;
    gu32* ctl;
    int tid, lane, wave;
    int vcu, G;
};
enum { I_XP = 0, I_XS, I_MEM, I_CCONV, I_SSC, I_SDELTA, I_CMK, I_CMV, I_NMIX, I_WIN, I_CONVW, I_CONVB, I_LNG, I_LNB, I_SCW, I_ALOG, I_DTB, I_DNN, I_WOUT,
       I_NMQ, I_NMKV, I_WMQ, I_WMK, I_WMV, I_WMO, I_NFFN, I_WG, I_WU, I_WD, I_NF };

__device__ __forceinline__ void tr_item(const float* W, int ldw, int k0, int c0, const float* gain, bf16* WT, int K, int r0, LAS float* scr, int lane) {
#pragma unroll 8
    for (int i = 0; i < 32; ++i) { const int kk = 2 * i + (lane >> 5); scr[kk * 33 + (lane & 31)] = W[(size_t)(k0 + kk) * ldw + c0 + (lane & 31)]; }
    LDS_WAIT(); asm volatile("" ::: "memory");
    const int c = lane & 7;
    float gv[8];
#pragma unroll
    for (int i = 0; i < 8; ++i) gv[i] = gain ? gain[k0 + 8 * c + i] : 1.f;
#pragma unroll
    for (int j = 0; j < 4; ++j) { const int n = (lane >> 3) + 8 * j; const LAS float* s = scr + (8 * c) * 33 + n;
        v4u o; o.x = pk2(s[0 * 33] * gv[0], s[1 * 33] * gv[1]); o.y = pk2(s[2 * 33] * gv[2], s[3 * 33] * gv[3]); o.z = pk2(s[4 * 33] * gv[4], s[5 * 33] * gv[5]); o.w = pk2(s[6 * 33] * gv[6], s[7 * 33] * gv[7]);
        *(GAS v4u*)(WT + (size_t)(r0 + n) * K + k0 + 8 * c) = o; }
    LDS_WAIT(); asm volatile("" ::: "memory");
}
__device__ __forceinline__ float softplusf_(float x) { return x > 20.f ? x : log1pf(__expf(x)); }

__device__ __forceinline__ void p0_prologue(const Args& A, Frame& F) {
    LAS float* scr = (LAS float*)(F.lds + RING_OFF + F.wave * 8448);
    const int gw = F.vcu * NWAVES + F.wave, NGW = F.G * NWAVES;
    unsigned char* ws = A.ws;
    const float* const pWMK = A.in[I_WMK]; const float* const pWMV = A.in[I_WMV]; const float* const pWG = A.in[I_WG]; const float* const pWU = A.in[I_WU];
    const float* const pXP = A.in[I_XP]; const float* const pXS = A.in[I_XS];
    constexpr int I_A = 96 * 16, I_B = 32 * 16, I_D = 64 * 16, I_F = 176 * 16, I_G = 32 * 44;
    constexpr int NITEMS = I_A + I_B + I_B + I_D + I_B + I_F + I_G;
    for (int it = gw; it < NITEMS; it += NGW) {
        int r = it;
        if (r < I_A) { const int nb = r % 96, kb = r / 96, j0 = 32 * nb; int src = j0;
            if (j0 < 1024) { const int tile = j0 >> 8, local = j0 & 255; src = local < 128 ? 128 * tile + local : 512 + 128 * tile + (local - 128); }
            tr_item(A.in[I_WIN], INC, 64 * kb, src, nullptr, (bf16*)(ws + WS_WIN), DM, j0, scr, F.lane); continue; } r -= I_A;
        if (r < I_B) { const int nb = r % 32, kb = r / 32; tr_item(A.in[I_WOUT], DM, 64 * kb, 32 * nb, nullptr, (bf16*)(ws + WS_WOUT), DM, 32 * nb, scr, F.lane); continue; } r -= I_B;
        if (r < I_B) { const int nb = r % 32, kb = r / 32; tr_item(A.in[I_WMQ], DM, 64 * kb, 32 * nb, A.in[I_NMQ], (bf16*)(ws + WS_WMQ), DM, 32 * nb, scr, F.lane); continue; } r -= I_B;
        if (r < I_D) { const int nb = r % 64, kb = r / 64, j0 = 32 * nb; const bool isv = j0 >= 1024;
            tr_item(isv ? pWMV : pWMK, DM, 64 * kb, isv ? j0 - 1024 : j0, nullptr, (bf16*)(ws + WS_WMKV), DM, j0, scr, F.lane); continue; } r -= I_D;
        if (r < I_B) { const int nb = r % 32, kb = r / 32; tr_item(A.in[I_WMO], DM, 64 * kb, 32 * nb, nullptr, (bf16*)(ws + WS_WMO), DM, 32 * nb, scr, F.lane); continue; } r -= I_B;
        if (r < I_F) { const int nb = r % 176, kb = r / 176, j0 = 32 * nb, tile = j0 >> 8, local = j0 & 255; const bool up = local >= 128;
            tr_item(up ? pWU : pWG, DFF, 64 * kb, 128 * tile + (up ? local - 128 : local), A.in[I_NFFN], (bf16*)(ws + WS_WGU), DM, j0, scr, F.lane); continue; } r -= I_F;
        { const int nb = r % 32, kb = r / 32; tr_item(A.in[I_WD], DM, 64 * kb, 32 * nb, nullptr, (bf16*)(ws + WS_WDN), DFF, 32 * nb, scr, F.lane); }
    }
    {
        bf16* H = (bf16*)(ws + WS_RB); float* BG = (float*)(ws + WS_BG);
        const float* win = A.in[I_WIN]; const float* gain = A.in[I_NMIX];
        float w8[4][4][8];
#pragma unroll
        for (int j = 0; j < 4; ++j)
#pragma unroll
            for (int i = 0; i < 4; ++i) { const int k = 256 * j + 4 * F.lane + i; const f32x4 a = *(const f32x4*)(win + (size_t)k * INC + 3072), b = *(const f32x4*)(win + (size_t)k * INC + 3076);
                w8[j][i][0] = a[0]; w8[j][i][1] = a[1]; w8[j][i][2] = a[2]; w8[j][i][3] = a[3]; w8[j][i][4] = b[0]; w8[j][i][5] = b[1]; w8[j][i][6] = b[2]; w8[j][i][7] = b[3]; }
        f32x4 gn[4];
#pragma unroll
        for (int j = 0; j < 4; ++j) gn[j] = *(const f32x4*)(gain + 256 * j + 4 * F.lane);
        const f32x4 alog4 = *(const f32x4*)A.in[I_ALOG], dtb4 = *(const f32x4*)A.in[I_DTB];
        for (int m = gw; m < MR; m += NGW) {
            GAS unsigned long long* o8 = (GAS unsigned long long*)(H + (size_t)m * DM) + F.lane;
            if (m >= MV) {
#pragma unroll
                for (int j = 0; j < 4; ++j) o8[64 * j] = 0ull;
                if (F.lane < 8) BG[(size_t)m * 8 + F.lane] = 0.f;
                continue;
            }
            const float* xrow = (m < MP) ? pXP + (size_t)m * DM : pXS + (size_t)(m - MP) * DM;
            const GAS f32x4* xr = (const GAS f32x4*)xrow + F.lane;
            f32x4 v[4]; float s2 = 0.f;
#pragma unroll
            for (int j = 0; j < 4; ++j) { v[j] = xr[64 * j]; s2 += (v[j][0] * v[j][0] + v[j][1] * v[j][1]) + (v[j][2] * v[j][2] + v[j][3] * v[j][3]); }
            const float rstd = 1.f / sqrtf(wave_sum(s2) * (1.f / DM) + RMS_EPS);
            float p8[8];
#pragma unroll
            for (int c = 0; c < 8; ++c) p8[c] = 0.f;
#pragma unroll
            for (int j = 0; j < 4; ++j) { v[j] = v[j] * rstd * gn[j];
#pragma unroll
                for (int i = 0; i < 4; ++i)
#pragma unroll
                    for (int c = 0; c < 8; ++c) p8[c] += v[j][i] * w8[j][i][c];
                o8[64 * j] = (unsigned long long)pk2(v[j][0], v[j][1]) | ((unsigned long long)pk2(v[j][2], v[j][3]) << 32); }
#pragma unroll
            for (int c = 0; c < 8; ++c) p8[c] = wave_sum(p8[c]);
            f32x4 bo, go;
#pragma unroll
            for (int c = 0; c < 4; ++c) { bo[c] = 1.f / (1.f + expf(-p8[c])); go[c] = -expf(alog4[c]) * softplusf_(p8[4 + c] + dtb4[c]); }
            if (F.lane == 0) { *(f32x4*)(BG + (size_t)m * 8) = bo; *(f32x4*)(BG + (size_t)m * 8 + 4) = go; }
        }
    }
    {
        bf16* MN = (bf16*)(ws + WS_MEMN); const float* gain = A.in[I_NMKV];
        f32x4 gn[4];
#pragma unroll
        for (int j = 0; j < 4; ++j) gn[j] = *(const f32x4*)(gain + 256 * j + 4 * F.lane);
        for (int m = gw; m < NB * NMEM; m += NGW) {
            const GAS f32x4* xr = (const GAS f32x4*)(A.in[I_MEM] + (size_t)m * DM) + F.lane;
            f32x4 v[4]; float s2 = 0.f;
#pragma unroll
            for (int j = 0; j < 4; ++j) { v[j] = xr[64 * j]; s2 += (v[j][0] * v[j][0] + v[j][1] * v[j][1]) + (v[j][2] * v[j][2] + v[j][3] * v[j][3]); }
            const float rstd = 1.f / sqrtf(wave_sum(s2) * (1.f / DM) + RMS_EPS);
            GAS unsigned long long* o8 = (GAS unsigned long long*)(MN + (size_t)m * DM) + F.lane;
#pragma unroll
            for (int j = 0; j < 4; ++j) { v[j] = v[j] * rstd * gn[j]; o8[64 * j] = (unsigned long long)pk2(v[j][0], v[j][1]) | ((unsigned long long)pk2(v[j][2], v[j][3]) << 32); }
        }
    }
}

__device__ __forceinline__ void conv_tile(const Args& A, Frame& F, int b, int tile) {
    const bf16* PB = (const bf16*)(A.ws + WS_RA); bf16* CD = (bf16*)(A.ws + WS_RB); bf16* QC = (bf16*)(A.ws + WS_RC);
    const int c = F.tid; const int row0 = b * SEQ + tile * 64;
    LAS float* Y = (LAS float*)(F.lds + RING_OFF);
    {
        float w[CW];
#pragma unroll
        for (int j = 0; j < CW; ++j) w[j] = A.in[I_CONVW][j * CC + c];
        const float bias = A.in[I_CONVB][c];
#pragma unroll 1
        for (int seg = 0; seg < 4; ++seg) {
            float uv[46];
#pragma unroll
            for (int i = 0; i < 46; ++i) { const int tk = tile * 64 + seg * 16 - 30 + i; uv[i] = (tk >= 0) ? bf2f(PB[(size_t)(b * SEQ + tk) * PBLD + c]) : 0.f; }
#pragma unroll
            for (int t = 0; t < 16; ++t) { float a = bias;
#pragma unroll
                for (int j = 0; j < CW; ++j) a += w[j] * uv[t + j];
                Y[(seg * 16 + t) * CC + c] = a; }
        }
    }
    __syncthreads();
    {
        const int ch0 = 8 * F.lane;
        const f32x4 g0 = *(const f32x4*)(A.in[I_LNG] + ch0), g1 = *(const f32x4*)(A.in[I_LNG] + ch0 + 4), b0 = *(const f32x4*)(A.in[I_LNB] + ch0), b1 = *(const f32x4*)(A.in[I_LNB] + ch0 + 4);
#pragma unroll 2
        for (int tt = 0; tt < 8; ++tt) { const int t = 8 * F.wave + tt;
            f32x4 y0 = *(const LAS f32x4*)(Y + t * CC + ch0), y1 = *(const LAS f32x4*)(Y + t * CC + ch0 + 4);
            const float mean = wave_sum((y0[0] + y0[1]) + (y0[2] + y0[3]) + (y1[0] + y1[1]) + (y1[2] + y1[3])) * (1.f / CC);
            y0 = y0 - mean; y1 = y1 - mean;
            const float var = wave_sum((y0[0] * y0[0] + y0[1] * y0[1]) + (y0[2] * y0[2] + y0[3] * y0[3]) + (y1[0] * y1[0] + y1[1] * y1[1]) + (y1[2] * y1[2] + y1[3] * y1[3])) * (1.f / CC);
            const float rstd = 1.f / sqrtf(var + 1e-5f);
            y0 = y0 * rstd * g0 + b0; y1 = y1 * rstd * g1 + b1;
            float o[8];
#pragma unroll
            for (int i = 0; i < 4; ++i) { o[i] = silu(y0[i]); o[4 + i] = silu(y1[i]); }
            *(GAS v4u*)(CD + (size_t)(row0 + t) * DM + ch0) = pack8(o); }
    }
    if (tile == 31) {
        float* oc = A.out + OUT_CONVP + (size_t)b * 30 * CC;
        for (int j = 0; j < 30; ++j) oc[j * CC + c] = bf2f(PB[(size_t)(b * SEQ + SEQ - 30 + j) * PBLD + c]);
        float* os = A.out + OUT_SCP + (size_t)b * 3 * QKVN;
        for (int e = F.tid; e < 3 * QKVN; e += NWAVES * 64) { const int j = e / QKVN, ch = e % QKVN; os[e] = bf2f(PB[(size_t)(b * SEQ + SEQ - 3 + j) * PBLD + 512 + ch]); }
    }
    {
        const int t0 = tile * 64 + 8 * F.wave;
#pragma unroll 1
        for (int p = 0; p < 3; ++p) {
            const int ch0 = 512 * p + 8 * F.lane;
            float wsc[4][8];
#pragma unroll
            for (int j = 0; j < 4; ++j) { const f32x4 a = *(const f32x4*)(A.in[I_SCW] + j * QKVN + ch0), bb = *(const f32x4*)(A.in[I_SCW] + j * QKVN + ch0 + 4);
#pragma unroll
                for (int i = 0; i < 4; ++i) { wsc[j][i] = a[i]; wsc[j][4 + i] = bb[i]; } }
            float win[3][8];
#pragma unroll
            for (int j = 0; j < 3; ++j) { const int tk = t0 - 3 + j;
                if (tk >= 0) { const v4u x = *(const GAS v4u*)(PB + (size_t)(b * SEQ + tk) * PBLD + 512 + ch0); unpack8(x, win[j]); }
                else {
#pragma unroll
                    for (int i = 0; i < 8; ++i) win[j][i] = 0.f; } }
#pragma unroll
            for (int tt = 0; tt < 8; ++tt) {
                float cur[8]; { const v4u x = *(const GAS v4u*)(PB + (size_t)(b * SEQ + t0 + tt) * PBLD + 512 + ch0); unpack8(x, cur); }
                float y[8]; float ss = 0.f;
#pragma unroll
                for (int i = 0; i < 8; ++i) { const float a = wsc[0][i] * win[0][i] + wsc[1][i] * win[1][i] + wsc[2][i] * win[2][i] + wsc[3][i] * cur[i]; y[i] = silu(a); ss += y[i] * y[i]; }
                if (p < 2) { ss += __shfl_xor(ss, 1); ss += __shfl_xor(ss, 2); ss += __shfl_xor(ss, 4); ss += __shfl_xor(ss, 8);
                    const float sc = (1.f / sqrtf(ss + 1e-6f)) * (p == 0 ? 0.08838834764831845f : 1.f);
#pragma unroll
                    for (int i = 0; i < 8; ++i) y[i] *= sc; }
                *(GAS v4u*)(QC + (size_t)(b * SEQ + t0 + tt) * QKVN + ch0) = pack8(y);
#pragma unroll
                for (int i = 0; i < 8; ++i) { win[0][i] = win[1][i]; win[1][i] = win[2][i]; win[2][i] = cur[i]; }
            }
        }
    }
    __syncthreads();
}
__device__ __forceinline__ void conv_sample(const Args& A, Frame& F, int s) {
    const bf16* PB = (const bf16*)(A.ws + WS_RA); bf16* CD = (bf16*)(A.ws + WS_RB); bf16* QC = (bf16*)(A.ws + WS_RC);
    const int c = F.tid; const size_t row = (size_t)MP + s;
    LAS float* Y = (LAS float*)(F.lds + RING_OFF);
    {
        const float* cache = A.in[I_CCONV] + (size_t)s * 30 * CC; float* oc = A.out + OUT_CONVS + (size_t)s * 30 * CC;
        const float us = bf2f(PB[row * PBLD + c]);
        float a = A.in[I_CONVB][c];
        float prev = cache[c];
#pragma unroll 6
        for (int j = 0; j < 30; ++j) { a += A.in[I_CONVW][j * CC + c] * prev; const float nx = (j < 29) ? cache[(j + 1) * CC + c] : us; oc[j * CC + c] = nx; prev = nx; }
        a += A.in[I_CONVW][30 * CC + c] * us;
        Y[c] = a;
    }
    __syncthreads();
    if (F.wave == 7) {
        const int ch0 = 8 * F.lane;
        const f32x4 g0 = *(const f32x4*)(A.in[I_LNG] + ch0), g1 = *(const f32x4*)(A.in[I_LNG] + ch0 + 4), b0 = *(const f32x4*)(A.in[I_LNB] + ch0), b1 = *(const f32x4*)(A.in[I_LNB] + ch0 + 4);
        f32x4 y0 = *(const LAS f32x4*)(Y + ch0), y1 = *(const LAS f32x4*)(Y + ch0 + 4);
        const float mean = wave_sum((y0[0] + y0[1]) + (y0[2] + y0[3]) + (y1[0] + y1[1]) + (y1[2] + y1[3])) * (1.f / CC);
        y0 = y0 - mean; y1 = y1 - mean;
        const float var = wave_sum((y0[0] * y0[0] + y0[1] * y0[1]) + (y0[2] * y0[2] + y0[3] * y0[3]) + (y1[0] * y1[0] + y1[1] * y1[1]) + (y1[2] * y1[2] + y1[3] * y1[3])) * (1.f / CC);
        const float rstd = 1.f / sqrtf(var + 1e-5f);
        y0 = y0 * rstd * g0 + b0; y1 = y1 * rstd * g1 + b1;
        float o[8];
#pragma unroll
        for (int i = 0; i < 4; ++i) { o[i] = silu(y0[i]); o[4 + i] = silu(y1[i]); }
        *(GAS v4u*)(CD + row * DM + ch0) = pack8(o);
    }
    if (F.wave < 3) {
        const int p = F.wave; const int ch0 = 512 * p + 8 * F.lane;
        const float* st = A.in[I_SSC] + (size_t)s * 3 * QKVN; float* os = A.out + OUT_SCS + (size_t)s * 3 * QKVN;
        float win[3][8], cur[8], y[8];
#pragma unroll
        for (int j = 0; j < 3; ++j) { const f32x4 a = *(const f32x4*)(st + j * QKVN + ch0), bb = *(const f32x4*)(st + j * QKVN + ch0 + 4);
#pragma unroll
            for (int i = 0; i < 4; ++i) { win[j][i] = a[i]; win[j][4 + i] = bb[i]; } }
        { const v4u x = *(const GAS v4u*)(PB + row * PBLD + 512 + ch0); unpack8(x, cur); }
        float ss = 0.f;
#pragma unroll
        for (int i = 0; i < 8; ++i) { float a = 0.f;
#pragma unroll
            for (int j = 0; j < 3; ++j) a += A.in[I_SCW][j * QKVN + ch0 + i] * win[j][i];
            a += A.in[I_SCW][3 * QKVN + ch0 + i] * cur[i]; y[i] = silu(a); ss += y[i] * y[i]; }
        if (p < 2) { ss += __shfl_xor(ss, 1); ss += __shfl_xor(ss, 2); ss += __shfl_xor(ss, 4); ss += __shfl_xor(ss, 8);
            const float sc = (1.f / sqrtf(ss + 1e-6f)) * (p == 0 ? 0.08838834764831845f : 1.f);
#pragma unroll
            for (int i = 0; i < 8; ++i) y[i] *= sc; }
        *(GAS v4u*)(QC + row * QKVN + ch0) = pack8(y);
#pragma unroll
        for (int j = 0; j < 3; ++j) { f32x4 a, bb;
#pragma unroll
            for (int i = 0; i < 4; ++i) { a[i] = (j < 2) ? win[j + 1][i] : cur[i]; bb[i] = (j < 2) ? win[j + 1][4 + i] : cur[4 + i]; }
            *(f32x4*)(os + j * QKVN + ch0) = a; *(f32x4*)(os + j * QKVN + ch0 + 4) = bb; }
    }
    __syncthreads();
}

__device__ __forceinline__ bf16x8 lds_frag16(const LAS unsigned char* p) { return *(const LAS bf16x8*)p; }
__device__ __forceinline__ void d1_chunk(const Args& A, Frame& F, int ci) {
    using pg8::f32x4;
    const int b = ci >> 7, h = (ci >> 5) & 3, n = ci & 31; const int row0 = b * SEQ + n * 64;
    const bf16* QC = (const bf16*)(A.ws + WS_RC); const float* BG = (const float*)(A.ws + WS_BG);
    float* Ug = (float*)(A.ws + WS_U) + (size_t)ci * 8192; bf16* Wg = (bf16*)(A.ws + WS_W) + (size_t)ci * 8192; bf16* QGg = (bf16*)(A.ws + WS_QG) + (size_t)ci * 8192;
    bf16* KDTg = (bf16*)(A.ws + WS_KDT) + (size_t)ci * 8192; bf16* QKg = (bf16*)(A.ws + WS_QK) + (size_t)ci * 4096; float* GLg = (float*)(A.ws + WS_GL);
    constexpr int OFF_K = 0, OFF_Q = 17408, OFF_VBT = 34816, OFF_KBGT = 53248, OFF_L = 71680, OFF_T = 88064, OFF_GC = 97280, OFF_BETA = 97536, OFF_EG = 97792;
    LAS unsigned char* L = F.lds + RING_OFF;
    LAS float* gcs = (LAS float*)(L + OFF_GC); LAS float* betas = (LAS float*)(L + OFF_BETA); LAS float* egs = (LAS float*)(L + OFF_EG); LAS float* Lm = (LAS float*)(L + OFF_L);
    const int fr = F.lane & 15, fq = F.lane >> 4;
    if (F.wave == 0) {
        float g = BG[(size_t)(row0 + F.lane) * 8 + 4 + h]; const float be = BG[(size_t)(row0 + F.lane) * 8 + h];
#pragma unroll
        for (int o = 1; o < 64; o <<= 1) { const float v = __shfl_up(g, o); if (F.lane >= o) g += v; }
        gcs[F.lane] = g; betas[F.lane] = be; egs[F.lane] = __expf(g);
    }
    __syncthreads();
    {
        const int t = F.tid >> 3, part = F.tid & 7;
        const bf16* rp = QC + (size_t)(row0 + t) * QKVN + h * 128 + part * 16;
        const v4u q0 = *(const GAS v4u*)(rp), q1 = *(const GAS v4u*)(rp + 8), k0 = *(const GAS v4u*)(rp + 512), k1 = *(const GAS v4u*)(rp + 520), v0 = *(const GAS v4u*)(rp + 1024), v1 = *(const GAS v4u*)(rp + 1032);
        *(LAS v4u*)(L + OFF_K + t * 272 + part * 32) = k0; *(LAS v4u*)(L + OFF_K + t * 272 + part * 32 + 16) = k1;
        *(LAS v4u*)(L + OFF_Q + t * 272 + part * 32) = q0; *(LAS v4u*)(L + OFF_Q + t * 272 + part * 32 + 16) = q1;
        const float be = betas[t], beg = be * egs[t];
        float kf[16], vf[16];
        { float tmp[8]; unpack8(k0, tmp);
#pragma unroll
          for (int i = 0; i < 8; ++i) kf[i] = tmp[i]; unpack8(k1, tmp);
#pragma unroll
          for (int i = 0; i < 8; ++i) kf[8 + i] = tmp[i]; unpack8(v0, tmp);
#pragma unroll
          for (int i = 0; i < 8; ++i) vf[i] = tmp[i]; unpack8(v1, tmp);
#pragma unroll
          for (int i = 0; i < 8; ++i) vf[8 + i] = tmp[i]; }
#pragma unroll
        for (int i = 0; i < 16; ++i) { const int d = part * 16 + i;
            *(LAS unsigned short*)(L + OFF_VBT + d * 144 + t * 2) = (unsigned short)(pk2(vf[i] * be, 0.f) & 0xffffu);
            *(LAS unsigned short*)(L + OFF_KBGT + d * 144 + t * 2) = (unsigned short)(pk2(kf[i] * beg, 0.f) & 0xffffu); }
    }
    __syncthreads();
#pragma unroll 1
    for (int x = 0; x < 4; ++x) {
        const int tile = F.wave * 4 + x, which = tile >> 4, ti = (tile >> 2) & 3, tj = tile & 3;
        f32x4 acc = (f32x4){0.f, 0.f, 0.f, 0.f};
        if (ti >= tj) {
            const LAS unsigned char* ap = L + (which ? OFF_Q : OFF_K) + (ti * 16 + fr) * 272 + fq * 16; const LAS unsigned char* bp = L + OFF_K + (tj * 16 + fr) * 272 + fq * 16;
#pragma unroll
            for (int kk = 0; kk < 4; ++kk) acc = __builtin_amdgcn_mfma_f32_16x16x32_bf16(lds_frag16(ap + kk * 64), lds_frag16(bp + kk * 64), acc, 0, 0, 0);
        }
        const int j = tj * 16 + fr; const float gj = gcs[j];
#pragma unroll
        for (int r = 0; r < 4; ++r) { const int i = ti * 16 + 4 * fq + r; const float dec = __expf(gcs[i] - gj);
            if (which == 0) Lm[i * 64 + j] = (i > j) ? betas[i] * acc[r] * dec : 0.f;
            else QKg[i * 64 + j] = (bf16)(pk2((i >= j) ? acc[r] * dec : 0.f, 0.f) & 0xffffu); }
    }
    __syncthreads();
    if (F.wave == 0) {
        float t[64];
        int vz; asm volatile("v_mov_b32 %0, 0" : "=v"(vz));
        const LAS float* Lv = Lm + vz;
#pragma unroll
        for (int i = 0; i < 64; ++i) {
            float a0 = 0.f, a1 = 0.f, a2 = 0.f, a3 = 0.f;
#pragma unroll
            for (int j4 = 0; j4 < (i + 3) / 4; ++j4) { const f32x4 lv = *(const LAS f32x4*)(Lv + i * 64 + 4 * j4);
                if (4 * j4 + 0 < i) a0 += lv[0] * t[4 * j4 + 0]; if (4 * j4 + 1 < i) a1 += lv[1] * t[4 * j4 + 1]; if (4 * j4 + 2 < i) a2 += lv[2] * t[4 * j4 + 2]; if (4 * j4 + 3 < i) a3 += lv[3] * t[4 * j4 + 3]; }
            t[i] = ((F.lane == i) ? 1.f : 0.f) - ((a0 + a1) + (a2 + a3));
        }
#pragma unroll
        for (int i = 0; i < 64; ++i) *(LAS unsigned short*)(L + OFF_T + i * 144 + F.lane * 2) = (unsigned short)(pk2(t[i], 0.f) & 0xffffu);
    } else {
        const int lt = F.tid - 64; const float gl = gcs[63];
        for (int cix = lt; cix < 1024; cix += 448) {
            const int t = cix >> 4, cc = cix & 15; const v4u x = *(const LAS v4u*)(L + OFF_Q + t * 272 + cc * 16); float f[8]; unpack8(x, f); const float e = egs[t];
#pragma unroll
            for (int i = 0; i < 8; ++i) f[i] *= e;
            *(GAS v4u*)(QGg + t * 128 + cc * 8) = pack8(f); }
        for (int cix = lt; cix < 1024; cix += 448) {
            const int dk = cix >> 3, t0 = (cix & 7) * 8; float f[8];
#pragma unroll
            for (int i = 0; i < 8; ++i) f[i] = bf2f(*(const LAS unsigned short*)(L + OFF_K + (t0 + i) * 272 + dk * 2)) * __expf(gl - gcs[t0 + i]);
            *(GAS v4u*)(KDTg + dk * 64 + t0) = pack8(f); }
        if (lt == 0) GLg[ci] = __expf(gl);
    }
    __syncthreads();
#pragma unroll 1
    for (int x = 0; x < 8; ++x) {
        const int tile = F.wave * 8 + x, which = tile >> 5, ti = (tile >> 3) & 3, td = tile & 7;
        const LAS unsigned char* ap = L + OFF_T + (ti * 16 + fr) * 144 + fq * 16; const LAS unsigned char* bp = L + (which ? OFF_KBGT : OFF_VBT) + (td * 16 + fr) * 144 + fq * 16;
        f32x4 acc = (f32x4){0.f, 0.f, 0.f, 0.f};
#pragma unroll
        for (int kk = 0; kk < 2; ++kk) acc = __builtin_amdgcn_mfma_f32_16x16x32_bf16(lds_frag16(ap + kk * 64), lds_frag16(bp + kk * 64), acc, 0, 0, 0);
        const int d = td * 16 + fr;
#pragma unroll
        for (int r = 0; r < 4; ++r) { const int i = ti * 16 + 4 * fq + r;
            if (which == 0) Ug[i * 128 + d] = acc[r]; else Wg[i * 128 + d] = (bf16)(pk2(acc[r], 0.f) & 0xffffu); }
    }
    __syncthreads();
}

constexpr int SC_OW = 0, SC_OQG = 17408, SC_OKDT = 34816, SC_OQK = 53248, SC_OU = 62464, SC_BUF = 66560;
__device__ __forceinline__ void scan_copy(const Args& A, Frame& F, int ci, int sl, LAS unsigned char* dst, int lt, int nl) {
    const unsigned char* Wg = A.ws + WS_W + (size_t)ci * 16384; const unsigned char* QGg = A.ws + WS_QG + (size_t)ci * 16384;
    const unsigned char* KDTg = A.ws + WS_KDT + (size_t)ci * 16384; const unsigned char* QKg = A.ws + WS_QK + (size_t)ci * 8192; const unsigned char* Ug = A.ws + WS_U + (size_t)ci * 32768 + sl * 64;
    for (int c = lt; c < 1024; c += nl) { const int r = c >> 4, cc = c & 15; *(LAS v4u*)(dst + SC_OW + r * 272 + cc * 16) = *(const GAS v4u*)(Wg + r * 256 + cc * 16); }
    for (int c = lt; c < 1024; c += nl) { const int r = c >> 4, cc = c & 15; *(LAS v4u*)(dst + SC_OQG + r * 272 + cc * 16) = *(const GAS v4u*)(QGg + r * 256 + cc * 16); }
    for (int c = lt; c < 1024; c += nl) { const int r = c >> 3, cc = c & 7; *(LAS v4u*)(dst + SC_OKDT + r * 144 + cc * 16) = *(const GAS v4u*)(KDTg + r * 128 + cc * 16); }
    for (int c = lt; c < 512; c += nl) { const int r = c >> 3, cc = c & 7; *(LAS v4u*)(dst + SC_OQK + r * 144 + cc * 16) = *(const GAS v4u*)(QKg + r * 128 + cc * 16); }
    for (int c = lt; c < 256; c += nl) { const int r = c >> 2, cc = c & 3; *(LAS v4u*)(dst + SC_OU + r * 64 + cc * 16) = *(const GAS v4u*)(Ug + r * 512 + cc * 16); }
}
__device__ __forceinline__ bf16x8 lds_fragp(const LAS unsigned char* p) { const v2u lo = *(const LAS v2u*)p, hi = *(const LAS v2u*)(p + 32); v4u w; w.x = lo.x; w.y = lo.y; w.z = hi.x; w.w = hi.y; return __builtin_bit_cast(bf16x8, w); }
__device__ __forceinline__ bf16x8 pack_pair(const pg8::f32x4& a, const pg8::f32x4& b) { v4u w; w.x = pk2(a[0], a[1]); w.y = pk2(a[2], a[3]); w.z = pk2(b[0], b[1]); w.w = pk2(b[2], b[3]); return __builtin_bit_cast(bf16x8, w); }
__device__ __forceinline__ void scan_unit(const Args& A, Frame& F, int b, int h, int sl) {
    using pg8::f32x4;
    LAS unsigned char* L = F.lds + RING_OFF;
    const int ci0 = (b * NH + h) * 32; const int fr = F.lane & 15, fq = F.lane >> 4;
    float* Og = (float*)(A.ws + WS_RE); const float* GLg = (const float*)(A.ws + WS_GL);
    scan_copy(A, F, ci0, sl, L, F.tid, NWAVES * 64);
    __syncthreads();
    f32x4 S[8];
#pragma unroll
    for (int i = 0; i < 8; ++i) S[i] = (f32x4){0.f, 0.f, 0.f, 0.f};
#pragma unroll 1
    for (int n = 0; n < 32; ++n) {
        if (F.wave == 0) {
            const LAS unsigned char* B = L + (n & 1) * SC_BUF;
            const float gl = GLg[ci0 + n];
            bf16x8 Sb[4];
#pragma unroll
            for (int kk = 0; kk < 4; ++kk) Sb[kk] = pack_pair(S[2 * kk], S[2 * kk + 1]);
            f32x4 vn[4];
#pragma unroll
            for (int tb = 0; tb < 4; ++tb) { f32x4 p1 = (f32x4){0.f, 0.f, 0.f, 0.f};
#pragma unroll
                for (int kk = 0; kk < 4; ++kk) p1 = __builtin_amdgcn_mfma_f32_16x16x32_bf16(lds_fragp(B + SC_OW + (16 * tb + fr) * 272 + (32 * kk + 4 * fq) * 2), Sb[kk], p1, 0, 0, 0);
#pragma unroll
                for (int r = 0; r < 4; ++r) vn[tb][r] = *(const LAS float*)(B + SC_OU + (16 * tb + 4 * fq + r) * 64 + fr * 4) - p1[r]; }
            bf16x8 Vb[2]; Vb[0] = pack_pair(vn[0], vn[1]); Vb[1] = pack_pair(vn[2], vn[3]);
            const size_t orow = (size_t)(b * SEQ + n * 64);
#pragma unroll
            for (int tb = 0; tb < 4; ++tb) { f32x4 o = (f32x4){0.f, 0.f, 0.f, 0.f};
#pragma unroll
                for (int kk = 0; kk < 4; ++kk) o = __builtin_amdgcn_mfma_f32_16x16x32_bf16(lds_fragp(B + SC_OQG + (16 * tb + fr) * 272 + (32 * kk + 4 * fq) * 2), Sb[kk], o, 0, 0, 0);
#pragma unroll
                for (int kt = 0; kt < 2; ++kt) o = __builtin_amdgcn_mfma_f32_16x16x32_bf16(lds_fragp(B + SC_OQK + (16 * tb + fr) * 144 + (32 * kt + 4 * fq) * 2), Vb[kt], o, 0, 0, 0);
#pragma unroll
                for (int r = 0; r < 4; ++r) Og[(orow + 16 * tb + 4 * fq + r) * 512 + h * 128 + sl * 16 + fr] = o[r]; }
#pragma unroll
            for (int blk = 0; blk < 8; ++blk) { f32x4 s = S[blk] * gl;
#pragma unroll
                for (int kt = 0; kt < 2; ++kt) s = __builtin_amdgcn_mfma_f32_16x16x32_bf16(lds_fragp(B + SC_OKDT + (16 * blk + fr) * 144 + (32 * kt + 4 * fq) * 2), Vb[kt], s, 0, 0, 0);
                S[blk] = s; }
        } else if (n + 1 < 32) {
            scan_copy(A, F, ci0 + n + 1, sl, L + ((n + 1) & 1) * SC_BUF, F.tid - 64, 448);
        }
        __syncthreads();
    }
    if (F.wave == 0) {
        float* od = A.out + OUT_DLP + (size_t)(b * NH + h) * DKV * DKV;
#pragma unroll
        for (int blk = 0; blk < 8; ++blk)
#pragma unroll
            for (int r = 0; r < 4; ++r) od[(16 * blk + 4 * fq + r) * DKV + sl * 16 + fr] = S[blk][r];
    }
}
__device__ __forceinline__ void delta_sample(const Args& A, Frame& F, int s, int h) {
    const bf16* QC = (const bf16*)(A.ws + WS_RC); const float* BG = (const float*)(A.ws + WS_BG); float* Og = (float*)(A.ws + WS_RE);
    const size_t row = (size_t)MP + s;
    LAS float* qs = (LAS float*)(F.lds + RING_OFF); LAS float* ks = qs + 128; LAS float* red = qs + 256;
    const int dv = F.tid & 127, grp = F.tid >> 7;
    if (F.tid < 128) { qs[F.tid] = bf2f(QC[row * QKVN + h * 128 + F.tid]); ks[F.tid] = bf2f(QC[row * QKVN + 512 + h * 128 + F.tid]); }
    const float v = bf2f(QC[row * QKVN + 1024 + h * 128 + dv]);
    const float beta = BG[row * 8 + h], eg = __expf(BG[row * 8 + 4 + h]);
    const float* S0 = A.in[I_SDELTA] + (size_t)(s * NH + h) * DKV * DKV; float* So = A.out + OUT_DLS + (size_t)(s * NH + h) * DKV * DKV;
    float s0[32];
#pragma unroll
    for (int i = 0; i < 32; ++i) s0[i] = S0[(size_t)(grp * 32 + i) * DKV + dv];
    __syncthreads();
    float part = 0.f;
#pragma unroll
    for (int i = 0; i < 32; ++i) part += ks[grp * 32 + i] * s0[i];
    red[grp * 128 + dv] = part;
    __syncthreads();
    const float kS = (red[dv] + red[128 + dv]) + (red[256 + dv] + red[384 + dv]);
    const float vnew = beta * (v - eg * kS);
    __syncthreads();
    float po = 0.f;
#pragma unroll
    for (int i = 0; i < 32; ++i) { const float sn = eg * s0[i] + ks[grp * 32 + i] * vnew; So[(size_t)(grp * 32 + i) * DKV + dv] = sn; po += qs[grp * 32 + i] * sn; }
    red[grp * 128 + dv] = po;
    __syncthreads();
    if (F.tid < 128) Og[row * 512 + h * 128 + dv] = (red[dv] + red[128 + dv]) + (red[256 + dv] + red[384 + dv]);
    __syncthreads();
}

__device__ __forceinline__ void ogate_phase(const Args& A, Frame& F) {
    const bf16* PB = (const bf16*)(A.ws + WS_RA); bf16* CD = (bf16*)(A.ws + WS_RB); const float* Og = (const float*)(A.ws + WS_RE);
    const int gw = F.vcu * NWAVES + F.wave, NGW = F.G * NWAVES; const int ch0 = 8 * F.lane;
    const f32x4 n0 = *(const f32x4*)(A.in[I_DNN] + (ch0 & 127)), n1 = *(const f32x4*)(A.in[I_DNN] + (ch0 & 127) + 4);
    for (int m = gw; m < MV; m += NGW) {
        const f32x4 o0 = *(const GAS f32x4*)(Og + (size_t)m * 512 + ch0), o1 = *(const GAS f32x4*)(Og + (size_t)m * 512 + ch0 + 4);
        const v4u zz = *(const GAS v4u*)(PB + (size_t)m * PBLD + 2048 + ch0); float z[8]; unpack8(zz, z);
        float ss = (o0[0] * o0[0] + o0[1] * o0[1]) + (o0[2] * o0[2] + o0[3] * o0[3]) + (o1[0] * o1[0] + o1[1] * o1[1]) + (o1[2] * o1[2] + o1[3] * o1[3]);
        ss += __shfl_xor(ss, 1); ss += __shfl_xor(ss, 2); ss += __shfl_xor(ss, 4); ss += __shfl_xor(ss, 8);
        const float rstd = 1.f / sqrtf(ss * (1.f / 128.f) + RMS_EPS);
        float d[8];
#pragma unroll
        for (int i = 0; i < 4; ++i) { d[i] = o0[i] * rstd * n0[i] * silu(z[i]); d[4 + i] = o1[i] * rstd * n1[i] * silu(z[4 + i]); }
        *(GAS v4u*)(CD + (size_t)m * DM + 512 + ch0) = pack8(d);
    }
}

__device__ __forceinline__ void attn_issue(const Args& A, Frame& F, int st, int b, int h, LAS unsigned char* slot) {
    const bf16* KB = (const bf16*)(A.ws + WS_KB); const bf16* VT = (const bf16*)(A.ws + WS_VT);
#pragma unroll
    for (int it = 0; it < 4; ++it) {
        const int idx = it * 512 + F.tid; const bf16* src;
        if (st < 4) { const int r = idx >> 5, p = idx & 31, c = p ^ (r & 15); src = KB + (size_t)(b * NMEM + 64 * st + r) * DM + h * MHD + 8 * c; }
        else { const int r = idx >> 3, p = idx & 7, c = p ^ ((r >> 1) & 7); src = VT + (size_t)(h * MHD + r) * (NB * NMEM) + b * NMEM + 64 * (st - 4) + 8 * c; }
        __builtin_amdgcn_global_load_lds((const unsigned*)src, (LAS unsigned*)(slot + it * 8192 + F.wave * 1024), 16, 0, 0);
    }
}
__device__ __forceinline__ void attn_unit(const Args& A, Frame& F, int rt, int h) {
    using pg8::f32x4;
    const int b = rt >> 4; const int fr = F.lane & 15, fq = F.lane >> 4;
    bf16* Q = (bf16*)(A.ws + WS_RB);
    bf16* qrow = Q + (size_t)(rt * 128 + F.wave * 16 + fr) * DM + h * MHD;
    LAS unsigned char* L = F.lds + RING_OFF;
    bf16x8 qf[8];
#pragma unroll
    for (int ks = 0; ks < 8; ++ks) qf[ks] = *(const GAS bf16x8*)(qrow + 32 * ks + 8 * fq);
    attn_issue(A, F, 0, b, h, L); attn_issue(A, F, 1, b, h, L + 32768);
    f32x4 sacc[16];
#pragma unroll
    for (int st = 0; st < 4; ++st) {
        asm volatile("s_waitcnt vmcnt(4)" ::: "memory");
        __builtin_amdgcn_s_barrier(); asm volatile("" ::: "memory");
        attn_issue(A, F, st + 2, b, h, L + ((st + 2) & 3) * 32768);
        const LAS unsigned char* slot = L + (st & 3) * 32768;
#pragma unroll
        for (int kbl = 0; kbl < 4; ++kbl) { f32x4 acc = (f32x4){0.f, 0.f, 0.f, 0.f}; const int row = 16 * kbl + fr;
#pragma unroll
            for (int ks = 0; ks < 8; ++ks) { const bf16x8 a = *(const LAS bf16x8*)(slot + row * 512 + (((4 * ks + fq) ^ (row & 15)) << 4)); acc = __builtin_amdgcn_mfma_f32_16x16x32_bf16(a, qf[ks], acc, 0, 0, 0); }
            sacc[4 * st + kbl] = acc; }
    }
    float mx = -3.0e38f;
#pragma unroll
    for (int kb = 0; kb < 16; ++kb)
#pragma unroll
        for (int i = 0; i < 4; ++i) mx = fmaxf(mx, sacc[kb][i]);
    mx = fmaxf(mx, __shfl_xor(mx, 16)); mx = fmaxf(mx, __shfl_xor(mx, 32));
    float lsum = 0.f; bf16x8 pb[8];
#pragma unroll
    for (int kb = 0; kb < 16; ++kb)
#pragma unroll
        for (int i = 0; i < 4; ++i) { const float p = __builtin_amdgcn_exp2f(sacc[kb][i] - mx); sacc[kb][i] = p; lsum += p; }
#pragma unroll
    for (int s = 0; s < 8; ++s) pb[s] = pack_pair(sacc[2 * s], sacc[2 * s + 1]);
    lsum += __shfl_xor(lsum, 16); lsum += __shfl_xor(lsum, 32);
    f32x4 oacc[16];
#pragma unroll
    for (int db = 0; db < 16; ++db) oacc[db] = (f32x4){0.f, 0.f, 0.f, 0.f};
#pragma unroll
    for (int st = 4; st < 8; ++st) {
        if (st + 1 < 8) asm volatile("s_waitcnt vmcnt(4)" ::: "memory"); else asm volatile("s_waitcnt vmcnt(0)" ::: "memory");
        __builtin_amdgcn_s_barrier(); asm volatile("" ::: "memory");
        if (st + 2 < 8) attn_issue(A, F, st + 2, b, h, L + ((st + 2) & 3) * 32768);
        const LAS unsigned char* slot = L + (st & 3) * 32768; const int t = st - 4;
#pragma unroll
        for (int db = 0; db < 16; ++db) { const int row = 16 * db + fr; const int sw = (row >> 1) & 7;
#pragma unroll
            for (int s2 = 0; s2 < 2; ++s2) { const int c = 4 * s2 + (fq >> 1);
                const v2u lo = *(const LAS v2u*)(slot + row * 128 + ((c ^ sw) << 4) + 8 * (fq & 1)), hi = *(const LAS v2u*)(slot + row * 128 + (((c + 2) ^ sw) << 4) + 8 * (fq & 1));
                v4u aw; aw.x = lo.x; aw.y = lo.y; aw.z = hi.x; aw.w = hi.y;
                oacc[db] = __builtin_amdgcn_mfma_f32_16x16x32_bf16(__builtin_bit_cast(bf16x8, aw), pb[2 * t + s2], oacc[db], 0, 0, 0); } }
    }
    const float inv = 1.f / lsum;
#pragma unroll
    for (int db = 0; db < 16; ++db) { v2u w; w.x = pk2(oacc[db][0] * inv, oacc[db][1] * inv); w.y = pk2(oacc[db][2] * inv, oacc[db][3] * inv); *(GAS v2u*)(qrow + 16 * db + 4 * fq) = w; }
    LDS_WAIT(); __builtin_amdgcn_s_barrier(); asm volatile("" ::: "memory");
}
__device__ __forceinline__ void attn_sample(const Args& A, Frame& F, int s, int h) {
    bf16* Q = (bf16*)(A.ws + WS_RB); bf16* qrow = Q + (size_t)(MP + s) * DM + h * MHD;
    const float* Kc = A.in[I_CMK] + (size_t)s * NMEM * DM + h * MHD; const float* Vc = A.in[I_CMV] + (size_t)s * NMEM * DM + h * MHD;
    LAS float* pl = (LAS float*)(F.lds + RING_OFF); LAS float* wred = pl + 256; LAS float* ored = pl + 512;
    float q[4]; { const v2u x = *(const GAS v2u*)(qrow + 4 * F.lane); q[0] = bflo(x.x); q[1] = bfhi(x.x); q[2] = bflo(x.y); q[3] = bfhi(x.y); }
    float myscore = 0.f;
#pragma unroll 8
    for (int i = 0; i < 32; ++i) { const f32x4 kv = *(const GAS f32x4*)(Kc + (size_t)(32 * F.wave + i) * DM + 4 * F.lane);
        const float d = wave_sum((kv[0] * q[0] + kv[1] * q[1]) + (kv[2] * q[2] + kv[3] * q[3])); if (F.lane == i) myscore = d; }
    float m = wave_max(F.lane < 32 ? myscore : -3.0e38f);
    if (F.lane == 0) wred[F.wave] = m;
    __syncthreads();
    float gm = wred[0];
#pragma unroll
    for (int i = 1; i < 8; ++i) gm = fmaxf(gm, wred[i]);
    const float p = (F.lane < 32) ? __builtin_amdgcn_exp2f(myscore - gm) : 0.f;
    if (F.lane < 32) pl[32 * F.wave + F.lane] = p;
    const float ws_ = wave_sum(p);
    if (F.lane == 0) wred[8 + F.wave] = ws_;
    __syncthreads();
    float tot = 0.f;
#pragma unroll
    for (int i = 0; i < 8; ++i) tot += wred[8 + i];
    f32x4 acc = (f32x4){0.f, 0.f, 0.f, 0.f};
#pragma unroll 8
    for (int i = 0; i < 32; ++i) { const f32x4 vv = *(const GAS f32x4*)(Vc + (size_t)(32 * F.wave + i) * DM + 4 * F.lane); const float pi = pl[32 * F.wave + i]; acc = acc + vv * pi; }
    *(LAS f32x4*)(ored + F.wave * 256 + 4 * F.lane) = acc;
    __syncthreads();
    if (F.tid < 256) { float o = 0.f;
#pragma unroll
        for (int w = 0; w < 8; ++w) o += ored[w * 256 + F.tid];
        qrow[F.tid] = (bf16)(pk2(o / tot, 0.f) & 0xffffu); }
    __syncthreads();
}

__device__ __forceinline__ void final_norm_phase(const Args& A, Frame& F) {
    const int gw = F.vcu * NWAVES + F.wave, NGW = F.G * NWAVES; const float* ss = (const float*)(F.ctl + CW_SS3);
    f32x4 gn[4];
#pragma unroll
    for (int j = 0; j < 4; ++j) gn[j] = *(const f32x4*)(A.in[I_NF] + 256 * j + 4 * F.lane);
    for (int m = gw; m < MV; m += NGW) {
        GAS f32x4* xr = (GAS f32x4*)(A.out + (size_t)m * DM) + F.lane;
        const float rstd = 1.f / sqrtf(ss[m] * (1.f / DM) + RMS_EPS);
#pragma unroll
        for (int j = 0; j < 4; ++j) { const f32x4 v = xr[64 * j]; xr[64 * j] = v * rstd * gn[j]; }
    }
}

__global__ void __launch_bounds__(NWAVES * 64, 2) hymba_fwd(Args args) {
    extern __shared__ __attribute__((aligned(16))) unsigned char lds[];
    Frame F;
    F.lds = (LAS unsigned char*)lds;
    F.MISC = (volatile LAS unsigned*)(F.lds + MISC_OFF);
    F.tid = threadIdx.x; F.lane = F.tid & 63; F.wave = __builtin_amdgcn_readfirstlane(F.tid >> 6);
    F.G = gridDim.x; { const int bx = blockIdx.x; F.vcu = (F.G % 8 == 0) ? (bx % 8) * (F.G / 8) + bx / 8 : bx; }
    F.ctl = (gu32*)(args.ws + WS_CTL);
    const Args& A = args;
    for (int u = F.tid; u < (LDS_BYTES - LDSCTL_OFF) / 4; u += NWAVES * 64) ((LAS unsigned*)(F.lds + LDSCTL_OFF))[u] = 0u;
    __syncthreads();
#if MK_PER_PHASE
#define GRID_BAR() do { } while (0)
#else
    XcdBarrier bar = xcd_barrier_post((unsigned*)(F.ctl + CW_BAR), F.MISC + 8);
#define GRID_BAR() xcd_barrier(bar)
#endif
    const int lo = args.ph_lo, hi = args.ph_hi;
#ifdef ONLY_PH
#define IN(k) ((k) == ONLY_PH && lo <= (k) && (k) < hi)
#else
#define IN(k) (lo <= (k) && (k) < hi)
#endif
#define BOTH(k) (IN(k) && IN((k) + 1))
    unsigned char* ws = args.ws;
    bf16* const RA = (bf16*)(ws + WS_RA); bf16* const RB = (bf16*)(ws + WS_RB); bf16* const RC = (bf16*)(ws + WS_RC);
    float* const X1 = (float*)(ws + WS_RD); bf16* const X1B = (bf16*)(ws + WS_RE); float* const X2 = (float*)(ws + WS_RF);
    float* const SS1 = (float*)(F.ctl + CW_SS1); float* const SS2 = (float*)(F.ctl + CW_SS2); float* const SS3 = (float*)(F.ctl + CW_SS3);

    if (IN(0)) { p0_prologue(A, F); if (BOTH(0)) GRID_BAR(); }
    if (IN(1)) {
        { pg8::Gemm g{RB, (const bf16*)(ws + WS_WIN), MR, 3072, DM}; pg8::StaticOrder S; S.init(MR, 3072, F.G, (int)blockIdx.x);
          pg8::EpiIn E{RA};
          pg8::gemm_phase<pg8::EpiIn, pg8::StaticOrder, true, true>(F.lds + RING_OFF, g, S, E); }
        { pg8::Gemm g{(const bf16*)(ws + WS_MEMN), (const bf16*)(ws + WS_WMKV), NB * NMEM, 2048, DM}; pg8::StaticOrder S; S.init(NB * NMEM, 2048, F.G, (int)blockIdx.x);
          pg8::EpiKV E{A.out + OUT_MKP, A.out + OUT_MVP, (bf16*)(ws + WS_KB), (bf16*)(ws + WS_VT)};
          pg8::gemm_phase<pg8::EpiKV, pg8::StaticOrder, true, true>(F.lds + RING_OFF, g, S, E); }
        if (BOTH(1)) GRID_BAR();
    }
    if (IN(2)) {
        for (int it = F.vcu; it < 256 + DEC; it += F.G) { if (it < 256) conv_tile(A, F, it >> 5, it & 31); else conv_sample(A, F, it - 256); }
        if (BOTH(2)) GRID_BAR();
    }
    if (IN(3)) {
        for (int ci = F.vcu; ci < NCHUNK; ci += F.G) d1_chunk(A, F, ci);
        if (BOTH(3)) GRID_BAR();
    }
    if (IN(4)) {
        for (int u = F.vcu; u < 256; u += F.G) scan_unit(A, F, u >> 5, (u >> 3) & 3, u & 7);
        for (int it = F.vcu; it < DEC * NH; it += F.G) delta_sample(A, F, it >> 2, it & 3);
        if (BOTH(4)) GRID_BAR();
    }
    if (IN(5)) { ogate_phase(A, F); if (BOTH(5)) GRID_BAR(); }
    if (IN(6)) {
        pg8::Gemm g{RB, (const bf16*)(ws + WS_WOUT), MR, DM, DM}; pg8::StaticOrder S; S.init(MR, DM, F.G, (int)blockIdx.x);
        pg8::EpiRes<true> E{A.in[I_XP], A.in[I_XS], MV, MR, X1, X1B, SS1};
        pg8::gemm_phase<pg8::EpiRes<true>, pg8::StaticOrder, true, true>(F.lds + RING_OFF, g, S, E);
        if (BOTH(6)) GRID_BAR();
    }
    if (IN(7)) {
        pg8::Gemm g{X1B, (const bf16*)(ws + WS_WMQ), MR, DM, DM}; pg8::StaticOrder S; S.init(MR, DM, F.G, (int)blockIdx.x);
        pg8::EpiQ E{RB, SS1, ATT_C2};
        pg8::gemm_phase<pg8::EpiQ, pg8::StaticOrder, true, true>(F.lds + RING_OFF, g, S, E);
        if (BOTH(7)) GRID_BAR();
    }
    if (IN(8)) {
        for (int u = F.vcu; u < 512; u += F.G) { const int bh = u >> 4; attn_unit(A, F, (bh >> 2) * 16 + (u & 15), bh & 3); }
        for (int it = F.vcu; it < DEC * NH; it += F.G) attn_sample(A, F, it >> 2, it & 3);
        if (BOTH(8)) GRID_BAR();
    }
    if (IN(9)) {
        pg8::Gemm g{RB, (const bf16*)(ws + WS_WMO), MR, DM, DM}; pg8::StaticOrder S; S.init(MR, DM, F.G, (int)blockIdx.x);
        pg8::EpiRes<true> E{X1, X1 + (size_t)MP * DM, MR, MR, X2, RC, SS2};
        pg8::gemm_phase<pg8::EpiRes<true>, pg8::StaticOrder, true, true>(F.lds + RING_OFF, g, S, E);
        if (BOTH(9)) GRID_BAR();
    }
    if (IN(10)) {
        pg8::Gemm g{RC, (const bf16*)(ws + WS_WGU), MR, 2 * DFF, DM}; pg8::StaticOrder S; S.init(MR, 2 * DFF, F.G, (int)blockIdx.x);
        pg8::EpiGU E{RA, SS2};
        pg8::gemm_phase<pg8::EpiGU, pg8::StaticOrder, true, true>(F.lds + RING_OFF, g, S, E);
        if (BOTH(10)) GRID_BAR();
    }
    if (IN(11)) {
        pg8::Gemm g{RA, (const bf16*)(ws + WS_WDN), MR, DM, DFF}; pg8::StaticOrder S; S.init(MR, DM, F.G, (int)blockIdx.x);
        pg8::EpiRes<false> E{X2, X2 + (size_t)MP * DM, MR, MV, A.out, nullptr, SS3};
        pg8::gemm_phase<pg8::EpiRes<false>, pg8::StaticOrder, true, true>(F.lds + RING_OFF, g, S, E);
        if (BOTH(11)) GRID_BAR();
    }
    if (IN(12)) final_norm_phase(A, F);
#undef IN
#undef BOTH
}

extern "C" void kernel_launch(void* const* d_in, const int* in_sizes, int n_in, void* d_out, int out_size, void* d_ws, size_t ws_size, hipStream_t stream) {
    static int grid = 0;
    if (grid == 0) {
        if (n_in != 30 || in_sizes[0] != MP * DM || (size_t)out_size != OUT_END || ws_size < WS_END) {
            fprintf(stderr, "kernel_launch: unexpected shapes: n_in %d, in0 %d, out %d, ws %zu (need >= %zu); nothing launched\n", n_in, n_in > 0 ? in_sizes[0] : -1, out_size, ws_size, (size_t)WS_END); grid = -1; return; }
        int dev = 0, cus = 0, per_cu = 0;
        if (hipGetDevice(&dev) != hipSuccess || hipDeviceGetAttribute(&cus, hipDeviceAttributeMultiprocessorCount, dev) != hipSuccess) { fprintf(stderr, "kernel_launch: device query failed\n"); grid = -1; return; }
        if (hipFuncSetAttribute((const void*)hymba_fwd, hipFuncAttributeMaxDynamicSharedMemorySize, LDS_BYTES) != hipSuccess) { fprintf(stderr, "kernel_launch: hipFuncSetAttribute failed\n"); grid = -1; return; }
        if (hipOccupancyMaxActiveBlocksPerMultiprocessor(&per_cu, (const void*)hymba_fwd, NWAVES * 64, LDS_BYTES) != hipSuccess || per_cu < 1)
            fprintf(stderr, "kernel_launch: note: occupancy query reports %d workgroups per CU\n", per_cu);
        (void)hipGetLastError();
        grid = cus;
    }
    if (grid < 0) return;
    if (hipMemsetAsync((char*)d_ws + WS_CTL, 0, CTL_ZERO_BYTES, stream) != hipSuccess) { fprintf(stderr, "kernel_launch: hipMemsetAsync failed\n"); return; }
    Args a{};
    for (int i = 0; i < 30; ++i) a.in[i] = (const float*)d_in[i];
    a.out = (float*)d_out; a.ws = (unsigned char*)d_ws;
#if MK_PER_PHASE
    for (int ph = 0; ph < N_PHASES; ++ph) { a.ph_lo = ph; a.ph_hi = ph + 1; a.li = 0;
        hipLaunchKernelGGL(hymba_fwd, dim3(grid), dim3(NWAVES * 64), LDS_BYTES, stream, a); }
#else
    a.ph_lo = 0; a.ph_hi = N_PHASES; a.li = 0;
    hipLaunchKernelGGL(hymba_fwd, dim3(grid), dim3(NWAVES * 64), LDS_BYTES, stream, a);
#endif
    const hipError_t le = hipPeekAtLastError();
    if (le != hipSuccess) fprintf(stderr, "kernel_launch: launch failed: %s\n", hipGetErrorName(le));
}
```

```cpp
#include <hip/hip_runtime.h>
#include <cstdio>
#include <cstdint>
#define MK_PER_PHASE 0
namespace pg8 {
#define PG8_LAS __attribute__((address_space(3)))
typedef unsigned short bf16_t;
typedef short bf16x8 __attribute__((ext_vector_type(8)));
typedef float f32x4 __attribute__((ext_vector_type(4)));
typedef unsigned u32x4 __attribute__((ext_vector_type(4)));
constexpr int BM = 256, BK = 64, HALF = 128, HTB = HALF * BK * 2  , STAGE_BYTES = 8 * HTB, NXCD = 8, WGM = 8;

__host__ __device__ __forceinline__ int lds_byte(int r, int c) { const int st = (r >> 4) * 2 + (c >> 5), rr = r & 15, cc = c & 31, ob = rr * 64 + cc * 2; return st * 1024 + (ob ^ (((ob >> 9) & 1) << 5)); }
__host__ __device__ __forceinline__ void stage_rc(int b, int& R, int& C) { const int st = b / 1024, sb = b % 1024, swz = sb ^ (((sb >> 9) & 1) << 5); R = (st >> 1) * 16 + swz / 64; C = (st & 1) * 32 + (swz % 64) / 2; }
__host__ __device__ __forceinline__ int perm32(int rho) { const int n = rho >> 4, i = rho & 15; return 8 * (i >> 2) + 4 * n + (i & 3); }

struct Unit { int pm, pn; };
struct Gemm { const bf16_t* A; const bf16_t* Bt; int M, N, K; };

struct StaticOrder {
    int nM, nN, nwg, G, c;
    __host__ __device__ void init(int M, int N, int G_, int c_) { nM = M / BM; nN = N / BM; nwg = nM * nN; G = G_; c = c_; }
    __host__ __device__ bool next(int i, Unit& u) const {
        const long L = (long)i * G + c; if (L >= nwg) return false;
        int wgid = (int)L; { const int q = nwg / NXCD, r = nwg % NXCD, xcd = wgid % NXCD, off = wgid / NXCD; wgid = (xcd < r ? xcd * (q + 1) : r * (q + 1) + (xcd - r) * q) + off; }
        const int nig = WGM * nN, gid = wgid / nig, fm = gid * WGM, gsz = (nM - fm) < WGM ? (nM - fm) : WGM;
        u.pm = fm + ((wgid % nig) % gsz); u.pn = (wgid % nig) / gsz; return true;
    }
    __device__ __forceinline__ void a_ready(const Unit&) const {}
    __device__ __forceinline__ void done(const Unit&) const {}
};

__device__ __forceinline__ unsigned cvt_pk_bf16(float lo, float hi) { unsigned r; asm volatile("v_cvt_pk_bf16_f32 %0, %1, %2" : "=v"(r) : "v"(lo), "v"(hi)); return r; }
typedef float f32x2_t __attribute__((ext_vector_type(2))); typedef __bf16 bf16x2_t __attribute__((ext_vector_type(2)));
__device__ __forceinline__ unsigned pk2(float lo, float hi) { f32x2_t v = {lo, hi}; bf16x2_t b = __builtin_convertvector(v, bf16x2_t); return __builtin_bit_cast(unsigned, b); }
__device__ __forceinline__ float sigm(float x) { return 1.f / (1.f + __expf(-x)); }
__device__ __forceinline__ float silu(float x) { return x / (1.f + __expf(-x)); }
__device__ __forceinline__ u32x4 pk8(const f32x4& a, const f32x4& b) { u32x4 w; w.x = pk2(a[0], a[1]); w.y = pk2(a[2], a[3]); w.z = pk2(b[0], b[1]); w.w = pk2(b[2], b[3]); return w; }
constexpr int PBLD = 2560;
constexpr int MPROMPT = 16384;
constexpr float RMS_EPS = 1e-6f;

struct EpiIn {
    static constexpr bool PERM = true, AFTER_DRAIN = false;
    bf16_t* PB;
    __device__ __forceinline__ void operator()(const f32x4 (&acc)[2][2][4][2], const Unit& u, int wr, int wc, int fr, int fq) const {
        const int row0 = u.pm * BM + wr * 64 + fr;
        if (u.pn < 4) {
            const int ch0 = u.pn * 128 + wc * 32 + 8 * fq;
#pragma unroll
            for (int ai = 0; ai < 2; ++ai)
#pragma unroll
                for (int m = 0; m < 4; ++m) {
                    bf16_t* rowp = PB + (size_t)(row0 + ai * HALF + m * 16) * PBLD + ch0;
                    f32x4 v0, v1;
#pragma unroll
                    for (int i = 0; i < 4; ++i) { v0[i] = acc[ai][0][m][0][i] * sigm(acc[ai][1][m][0][i]); v1[i] = acc[ai][0][m][1][i] * sigm(acc[ai][1][m][1][i]); }
                    *(u32x4*)rowp = pk8(v0, v1);
                }
        } else {
            const int col0 = u.pn * BM - 512 + wc * 32 + 8 * fq;
#pragma unroll
            for (int ai = 0; ai < 2; ++ai)
#pragma unroll
                for (int m = 0; m < 4; ++m) {
                    bf16_t* rowp = PB + (size_t)(row0 + ai * HALF + m * 16) * PBLD + col0;
#pragma unroll
                    for (int bj = 0; bj < 2; ++bj) *(u32x4*)(rowp + bj * HALF) = pk8(acc[ai][bj][m][0], acc[ai][bj][m][1]);
                }
        }
    }
};

struct EpiKV {
    static constexpr bool PERM = true, AFTER_DRAIN = false;
    float* outK; float* outV; bf16_t* KB; bf16_t* VT;
    __device__ __forceinline__ void operator()(const f32x4 (&acc)[2][2][4][2], const Unit& u, int wr, int wc, int fr, int fq) const {
        const int row0 = u.pm * BM + wr * 64 + fr;
        const bool isv = u.pn >= 4;
        const int c0 = (isv ? u.pn - 4 : u.pn) * BM + wc * 32 + 8 * fq;
        float* outp = isv ? outV : outK;
#pragma unroll
        for (int ai = 0; ai < 2; ++ai)
#pragma unroll
            for (int m = 0; m < 4; ++m) {
                const int row = row0 + ai * HALF + m * 16;
#pragma unroll
                for (int bj = 0; bj < 2; ++bj) {
                    const int col = c0 + bj * HALF;
                    const f32x4 a = acc[ai][bj][m][0], b = acc[ai][bj][m][1];
                    *(f32x4*)(outp + (size_t)row * 1024 + col) = a; *(f32x4*)(outp + (size_t)row * 1024 + col + 4) = b;
                    const u32x4 w = pk8(a, b);
                    if (!isv) *(u32x4*)(KB + (size_t)row * 1024 + col) = w;
                    else {
                        bf16_t* vp = VT + (size_t)col * 2048 + row;
                        vp[0 * 2048] = (bf16_t)(w.x & 0xffffu); vp[1 * 2048] = (bf16_t)(w.x >> 16); vp[2 * 2048] = (bf16_t)(w.y & 0xffffu); vp[3 * 2048] = (bf16_t)(w.y >> 16);
                        vp[4 * 2048] = (bf16_t)(w.z & 0xffffu); vp[5 * 2048] = (bf16_t)(w.z >> 16); vp[6 * 2048] = (bf16_t)(w.w & 0xffffu); vp[7 * 2048] = (bf16_t)(w.w >> 16);
                    }
                }
            }
    }
};

template <bool WRITE_BF> struct EpiRes {
    static constexpr bool PERM = true, AFTER_DRAIN = false;
    const float* base_main; const float* base_tail;
    int load_limit, store_limit;
    float* out; bf16_t* outb; float* ss;
    __device__ __forceinline__ void operator()(const f32x4 (&acc)[2][2][4][2], const Unit& u, int wr, int wc, int fr, int fq) const {
        const int row0 = u.pm * BM + wr * 64 + fr; const int col0 = u.pn * BM + wc * 32 + 8 * fq;
        const float* bp = (u.pm >= 64) ? base_tail - (size_t)MPROMPT * 1024 : base_main;
#pragma unroll
        for (int ai = 0; ai < 2; ++ai)
#pragma unroll
            for (int m = 0; m < 4; ++m) {
                const int row = row0 + ai * HALF + m * 16; const size_t off = (size_t)row * 1024 + col0;
                float s = 0.f;
#pragma unroll
                for (int bj = 0; bj < 2; ++bj) {
                    f32x4 b0 = (f32x4){0.f, 0.f, 0.f, 0.f}, b1 = b0;
                    if (row < load_limit) { b0 = *(const f32x4*)(bp + off + bj * HALF); b1 = *(const f32x4*)(bp + off + bj * HALF + 4); }
                    const f32x4 v0 = acc[ai][bj][m][0] + b0, v1 = acc[ai][bj][m][1] + b1;
                    s += (v0[0] * v0[0] + v0[1] * v0[1]) + (v0[2] * v0[2] + v0[3] * v0[3]) + (v1[0] * v1[0] + v1[1] * v1[1]) + (v1[2] * v1[2] + v1[3] * v1[3]);
                    if (row < store_limit) { *(f32x4*)(out + off + bj * HALF) = v0; *(f32x4*)(out + off + bj * HALF + 4) = v1; }
                    if (WRITE_BF) *(u32x4*)(outb + off + bj * HALF) = pk8(v0, v1);
                }
                s += __shfl_xor(s, 16); s += __shfl_xor(s, 32);
                if (fq == 0) atomicAdd(ss + row, s);
            }
    }
};

struct EpiQ {
    static constexpr bool PERM = true, AFTER_DRAIN = false;
    bf16_t* Q; const float* ss; float c2;
    __device__ __forceinline__ void operator()(const f32x4 (&acc)[2][2][4][2], const Unit& u, int wr, int wc, int fr, int fq) const {
        const int row0 = u.pm * BM + wr * 64 + fr; const int col0 = u.pn * BM + wc * 32 + 8 * fq;
#pragma unroll
        for (int ai = 0; ai < 2; ++ai)
#pragma unroll
            for (int m = 0; m < 4; ++m) {
                const int row = row0 + ai * HALF + m * 16;
                const float rs = __builtin_amdgcn_rsqf(ss[row] * (1.f / 1024.f) + RMS_EPS) * c2;
#pragma unroll
                for (int bj = 0; bj < 2; ++bj) *(u32x4*)(Q + (size_t)row * 1024 + col0 + bj * HALF) = pk8(acc[ai][bj][m][0] * rs, acc[ai][bj][m][1] * rs);
            }
    }
};

struct EpiGU {
    static constexpr bool PERM = true, AFTER_DRAIN = false;
    bf16_t* T; const float* ss;
    __device__ __forceinline__ void operator()(const f32x4 (&acc)[2][2][4][2], const Unit& u, int wr, int wc, int fr, int fq) const {
        const int row0 = u.pm * BM + wr * 64 + fr; const int ch0 = u.pn * 128 + wc * 32 + 8 * fq;
#pragma unroll
        for (int ai = 0; ai < 2; ++ai)
#pragma unroll
            for (int m = 0; m < 4; ++m) {
                const int row = row0 + ai * HALF + m * 16;
                const float rs = __builtin_amdgcn_rsqf(ss[row] * (1.f / 1024.f) + RMS_EPS);
                f32x4 v0, v1;
#pragma unroll
                for (int i = 0; i < 4; ++i) { v0[i] = silu(acc[ai][0][m][0][i] * rs) * (acc[ai][1][m][0][i] * rs); v1[i] = silu(acc[ai][0][m][1][i] * rs) * (acc[ai][1][m][1][i] * rs); }
                *(u32x4*)(T + (size_t)row * 2816 + ch0) = pk8(v0, v1);
            }
    }
};

template <class Epi, class Sched, bool ALIGN_EPI = false, bool SP2 = false>
__device__ __forceinline__ void gemm_phase(PG8_LAS unsigned char* lds, const Gemm g, const Sched& S, const Epi& E) {
    const int tid = threadIdx.x, wid = __builtin_amdgcn_readfirstlane(tid >> 6), lane = tid & 63, wr = wid >> 2, wc = wid & 3, fr = lane & 15, fq = lane >> 4;
    const int K = g.K, nt = K / BK;
    unsigned voffA[2], voffB[2];
#pragma unroll
    for (int i = 0; i < 2; ++i) { int R, C; stage_rc(tid * 16 + i * 8192, R, C); const int Rb = Epi::PERM ? ((R & ~31) + perm32(R & 31)) : R;
        voffA[i] = (unsigned)(R * K + C) * 2u; voffB[i] = (unsigned)(Rb * K + C) * 2u; }
    const size_t kstep = (size_t)(BK * 2);
    const size_t hstep = (size_t)HALF * K * 2;
    const size_t tstep = 2 * hstep;
    const unsigned ldsw = (unsigned)wid * 1024u;
    const int aoff = lds_byte(wr * 64 + fr, fq * 8), boff = lds_byte(wc * 32 + fr, fq * 8);
#define PG8_SA(b, h) (((b) * 2 + (h)) * HTB)
#define PG8_SB(b, h) ((4 + (b) * 2 + (h)) * HTB)
#define PG8_STAGE(bufoff, gbase, voff) do { _Pragma("unroll") for (int _i = 0; _i < 2; ++_i) \
        __builtin_amdgcn_global_load_lds((const unsigned*)((const char*)(gbase) + (voff)[_i]), (PG8_LAS unsigned*)(lds + (bufoff) + ldsw + _i * 8192), 16, 0, 0); } while (0)
#define PG8_LDA(dst, b, h) do { _Pragma("unroll") for (int m = 0; m < 4; ++m) _Pragma("unroll") for (int k = 0; k < 2; ++k) dst[m][k] = *(const PG8_LAS bf16x8*)(lds + PG8_SA(b, h) + aoff + m * 2048 + k * 1024); } while (0)
#define PG8_LDB(dst, b, h) do { _Pragma("unroll") for (int n = 0; n < 2; ++n) _Pragma("unroll") for (int k = 0; k < 2; ++k) dst[n][k] = *(const PG8_LAS bf16x8*)(lds + PG8_SB(b, h) + boff + n * 2048 + k * 1024); } while (0)
#define PG8_MMA(ai, bj, At, Bt) do { __builtin_amdgcn_s_setprio(1); _Pragma("unroll") for (int m = 0; m < 4; ++m) _Pragma("unroll") for (int n = 0; n < 2; ++n) _Pragma("unroll") for (int k = 0; k < 2; ++k) \
        acc[ai][bj][m][n] = __builtin_amdgcn_mfma_f32_16x16x32_bf16(Bt[n][k], At[m][k], acc[ai][bj][m][n], 0, 0, 0); __builtin_amdgcn_s_setprio(0); } while (0)
#define PG8_WAIT_V(n) asm volatile("s_waitcnt vmcnt(" #n ")" ::: "memory")
#define PG8_WAIT_L(n) asm volatile("s_waitcnt lgkmcnt(" #n ")" ::: "memory")
#define PG8_BAR __builtin_amdgcn_s_barrier()
#define PG8_SCHED __builtin_amdgcn_sched_barrier(0)
    Unit cur, nxt; int ui = 0;
    if (!S.next(0, cur)) return;
    f32x4 acc[2][2][4][2];
#pragma unroll
    for (int a = 0; a < 2; ++a)
#pragma unroll
        for (int b = 0; b < 2; ++b)
#pragma unroll
            for (int m = 0; m < 4; ++m)
#pragma unroll
                for (int n = 0; n < 2; ++n) acc[a][b][m][n] = (f32x4){0.f, 0.f, 0.f, 0.f};
    bf16x8 At[4][2], B0[2][2], B1[2][2];
    const char* cA = (const char*)g.A + (size_t)cur.pm * tstep; const char* cB = (const char*)g.Bt + (size_t)cur.pn * tstep;
    S.a_ready(cur);
    if constexpr (SP2) {
        PG8_STAGE(PG8_SB(0, 0), cB, voffB); PG8_STAGE(PG8_SB(0, 1), cB + hstep, voffB); PG8_STAGE(PG8_SA(0, 0), cA, voffA); PG8_STAGE(PG8_SA(0, 1), cA + hstep, voffA);
        if (wr == 1) PG8_BAR;
        PG8_WAIT_V(2); PG8_BAR;
        PG8_STAGE(PG8_SB(1, 0), cB + kstep, voffB); PG8_STAGE(PG8_SA(1, 0), cA + kstep, voffA); PG8_STAGE(PG8_SB(1, 1), cB + hstep + kstep, voffB);
        PG8_WAIT_V(6); PG8_BAR;
    } else {
        PG8_STAGE(PG8_SB(0, 0), cB, voffB); PG8_STAGE(PG8_SA(0, 0), cA, voffA); PG8_STAGE(PG8_SB(0, 1), cB + hstep, voffB); PG8_STAGE(PG8_SA(0, 1), cA + hstep, voffA);
        if (wr == 1) PG8_BAR;
        PG8_WAIT_V(4); PG8_BAR;
        PG8_STAGE(PG8_SB(1, 0), cB + kstep, voffB); PG8_STAGE(PG8_SA(1, 0), cA + kstep, voffA); PG8_STAGE(PG8_SB(1, 1), cB + hstep + kstep, voffB);
        PG8_WAIT_V(6); PG8_BAR;
    }
    for (;;) {
        const bool has_next = S.next(ui + 1, nxt);
        const char* nA = has_next ? (const char*)g.A + (size_t)nxt.pm * tstep : cA; const char* nB = has_next ? (const char*)g.Bt + (size_t)nxt.pn * tstep : cB;
        for (int t = 0; t < nt; t += 2) {
            const bool last = (t == nt - 2);
            const char* a1 = cA + (size_t)(t + 1) * kstep;
            const char* a2 = last ? nA : cA + (size_t)(t + 2) * kstep; const char* b2 = last ? nB : cB + (size_t)(t + 2) * kstep;
            const char* a3 = a2 + kstep; const char* b3 = b2 + kstep;
            if (last && has_next) S.a_ready(nxt);
            if constexpr (SP2) {
            PG8_LDB(B0, 0, 0); PG8_LDB(B1, 0, 1); PG8_SCHED; PG8_LDA(At, 0, 0); PG8_STAGE(PG8_SA(1, 1), a1 + hstep, voffA);
            PG8_WAIT_V(8); PG8_WAIT_L(0); PG8_BAR; PG8_MMA(0, 0, At, B0); PG8_MMA(0, 1, At, B1); PG8_BAR; PG8_SCHED;
            PG8_LDA(At, 0, 1); PG8_STAGE(PG8_SB(0, 0), b2, voffB); PG8_STAGE(PG8_SB(0, 1), b2 + hstep, voffB); PG8_STAGE(PG8_SA(0, 0), a2, voffA);
            PG8_WAIT_V(8); PG8_WAIT_L(0); PG8_BAR; PG8_MMA(1, 0, At, B0); PG8_MMA(1, 1, At, B1); PG8_BAR; PG8_SCHED;
            PG8_LDB(B0, 1, 0); PG8_LDB(B1, 1, 1); PG8_SCHED; PG8_LDA(At, 1, 0); PG8_STAGE(PG8_SA(0, 1), a2 + hstep, voffA);
            PG8_WAIT_V(8); PG8_WAIT_L(0); PG8_BAR; PG8_MMA(0, 0, At, B0); PG8_MMA(0, 1, At, B1); PG8_BAR; PG8_SCHED;
            PG8_LDA(At, 1, 1); PG8_STAGE(PG8_SB(1, 0), b3, voffB); PG8_STAGE(PG8_SB(1, 1), b3 + hstep, voffB); PG8_STAGE(PG8_SA(1, 0), a3, voffA);
            PG8_WAIT_V(8); PG8_WAIT_L(0); PG8_BAR; PG8_MMA(1, 0, At, B0); PG8_MMA(1, 1, At, B1); PG8_BAR; PG8_SCHED;
            } else {
            PG8_LDB(B0, 0, 0); PG8_SCHED; PG8_LDA(At, 0, 0); PG8_STAGE(PG8_SA(1, 1), a1 + hstep, voffA);
            PG8_WAIT_L(8); PG8_BAR; PG8_WAIT_L(0); PG8_MMA(0, 0, At, B0); PG8_BAR; PG8_SCHED;
            PG8_LDB(B1, 0, 1); PG8_STAGE(PG8_SB(0, 0), b2, voffB);
            PG8_BAR; PG8_WAIT_L(0); PG8_MMA(0, 1, At, B1); PG8_BAR;
            PG8_LDA(At, 0, 1); PG8_STAGE(PG8_SA(0, 0), a2, voffA);
            PG8_BAR; PG8_WAIT_L(0); PG8_MMA(1, 0, At, B0); PG8_BAR; PG8_SCHED;
            PG8_STAGE(PG8_SB(0, 1), b2 + hstep, voffB);
            PG8_WAIT_V(6); PG8_BAR; PG8_MMA(1, 1, At, B1); PG8_BAR;
            PG8_LDB(B0, 1, 0); PG8_SCHED; PG8_LDA(At, 1, 0); PG8_STAGE(PG8_SA(0, 1), a2 + hstep, voffA);
            PG8_WAIT_L(8); PG8_BAR; PG8_WAIT_L(0); PG8_MMA(0, 0, At, B0); PG8_BAR; PG8_SCHED;
            PG8_LDB(B1, 1, 1); PG8_STAGE(PG8_SB(1, 0), b3, voffB);
            PG8_BAR; PG8_WAIT_L(0); PG8_MMA(0, 1, At, B1); PG8_BAR;
            PG8_LDA(At, 1, 1); PG8_STAGE(PG8_SA(1, 0), a3, voffA);
            PG8_BAR; PG8_WAIT_L(0); PG8_MMA(1, 0, At, B0); PG8_BAR; PG8_SCHED;
            PG8_STAGE(PG8_SB(1, 1), b3 + hstep, voffB);
            PG8_WAIT_V(6); PG8_BAR; PG8_MMA(1, 1, At, B1); PG8_BAR;
            }
        }
        if constexpr (ALIGN_EPI) { if (wr == 0) PG8_BAR; }
        if constexpr (!Epi::AFTER_DRAIN) { E(acc, cur, wr, wc, fr, fq); S.done(cur); }
        if (!has_next) break;
#pragma unroll
        for (int a = 0; a < 2; ++a)
#pragma unroll
            for (int b = 0; b < 2; ++b)
#pragma unroll
                for (int m = 0; m < 4; ++m)
#pragma unroll
                    for (int n = 0; n < 2; ++n) acc[a][b][m][n] = (f32x4){0.f, 0.f, 0.f, 0.f};
        cur = nxt; cA = nA; cB = nB; ++ui;
        if constexpr (ALIGN_EPI) { if (wr == 1) PG8_BAR; }
    }
    PG8_WAIT_V(0);
    if constexpr (!ALIGN_EPI) { if (wr == 0) PG8_BAR; }
    PG8_BAR;
    if constexpr (Epi::AFTER_DRAIN) { E.fused(acc, cur, wr, wc, fr, fq, lds, wid, lane); S.done(cur); }
#undef PG8_SA
#undef PG8_SB
#undef PG8_STAGE
#undef PG8_LDA
#undef PG8_LDB
#undef PG8_MMA
#undef PG8_WAIT_V
#undef PG8_WAIT_L
#undef PG8_BAR
#undef PG8_SCHED
}
}

constexpr int NWAVES = 8;
#ifndef MK_PER_PHASE
#define MK_PER_PHASE 0
#endif
constexpr int N_PHASES = 13;

constexpr int DM = 1024, NB = 8, SEQ = 2048, MP = NB * SEQ  , DEC = 128, MV = MP + DEC  , MR = 16640  ;
constexpr int CC = 512, CW = 31, NH = 4, DKV = 128, QKVN = 1536, NMEM = 256, MHD = 256, DFF = 2816, INC = 3080;
constexpr int PBLD = pg8::PBLD;
constexpr int NCHUNK = NB * NH * 32;
constexpr float RMS_EPS = 1e-6f;
constexpr float ATT_C2 = 0.0625f * 1.4426950408889634f;

constexpr size_t OUT_YP = 0, OUT_YS = 16777216, OUT_CONVP = 16908288, OUT_SCP = 17031168, OUT_DLP = 17068032, OUT_MKP = 17592320, OUT_MVP = 19689472,
                 OUT_CONVS = 21786624, OUT_SCS = 23752704, OUT_DLS = 24342528, OUT_END = 32731136;

constexpr size_t MiB = 1u << 20;
constexpr size_t WS_CTL = 0, CTL_ZERO_BYTES = 1 * MiB;
constexpr size_t WS_WIN = 1 * MiB, WS_WOUT = 7 * MiB, WS_WMQ = 9 * MiB, WS_WMKV = 11 * MiB, WS_WMO = 15 * MiB, WS_WGU = 17 * MiB, WS_WDN = 28 * MiB;
constexpr size_t WS_BG = 34 * MiB, WS_MEMN = 35 * MiB, WS_KB = 39 * MiB, WS_VT = 43 * MiB, WS_GL = 47 * MiB;
constexpr size_t WS_RA = 48 * MiB;
constexpr size_t WS_RB = 138 * MiB;
constexpr size_t WS_RC = 171 * MiB;
constexpr size_t WS_RD = 220 * MiB;
constexpr size_t WS_U = WS_RD, WS_W = 252 * MiB, WS_QG = 268 * MiB, WS_KDT = 284 * MiB, WS_QK = 300 * MiB;
constexpr size_t WS_RE = 308 * MiB;
constexpr size_t WS_RF = 341 * MiB;
constexpr size_t WS_END = 406 * MiB;
constexpr int CW_TMO = 0, CW_CODE = 1, CW_BAR = 4096, CW_SS1 = 65536, CW_SS2 = 98304, CW_SS3 = 131072;

constexpr int RING_OFF = 0, RING_BYTES = 143360;
constexpr int LDSCTL_OFF = RING_BYTES, MISC_OFF = LDSCTL_OFF + 320;
constexpr int LDS_BYTES = 147456;

#define GAS __attribute__((address_space(1)))
#define LAS __attribute__((address_space(3)))
typedef unsigned short bf16;
typedef unsigned v4u __attribute__((ext_vector_type(4)));
typedef unsigned v2u __attribute__((ext_vector_type(2)));
typedef float f32x4 __attribute__((ext_vector_type(4)));
typedef float f32x16 __attribute__((ext_vector_type(16)));
typedef short bf16x8 __attribute__((ext_vector_type(8)));
typedef GAS unsigned gu32;
#define RLX_AGENT __ATOMIC_RELAXED, __HIP_MEMORY_SCOPE_AGENT
#define LDS_WAIT() asm volatile("s_waitcnt lgkmcnt(0)" ::: "memory")
#define VM_WAIT() asm volatile("s_waitcnt vmcnt(0)" ::: "memory")
using pg8::pk2; using pg8::silu; using pg8::sigm;
__device__ __forceinline__ float bf2f(unsigned b) { return __uint_as_float(b << 16); }
__device__ __forceinline__ float bflo(unsigned w) { return __uint_as_float(w << 16); }
__device__ __forceinline__ float bfhi(unsigned w) { return __uint_as_float(w & 0xffff0000u); }
__device__ __forceinline__ void unpack8(const v4u& w, float (&f)[8]) { f[0] = bflo(w.x); f[1] = bfhi(w.x); f[2] = bflo(w.y); f[3] = bfhi(w.y); f[4] = bflo(w.z); f[5] = bfhi(w.z); f[6] = bflo(w.w); f[7] = bfhi(w.w); }
__device__ __forceinline__ v4u pack8(const float (&f)[8]) { v4u w; w.x = pk2(f[0], f[1]); w.y = pk2(f[2], f[3]); w.z = pk2(f[4], f[5]); w.w = pk2(f[6], f[7]); return w; }
__device__ __forceinline__ float wave_sum(float v) {
#pragma unroll
    for (int o = 1; o < 64; o <<= 1) v += __shfl_xor(v, o);
    return v;
}
__device__ __forceinline__ float wave_max(float v) {
#pragma unroll
    for (int o = 1; o < 64; o <<= 1) v = fmaxf(v, __shfl_xor(v, o));
    return v;
}

#define XB_TMO      128
#define XB_XCNT(j)  (256  + 64 * (j))
#define XB_XSUB(j)  (1280 + 64 * (j))
#define XB_XGEN(j)  (2304 + 64 * (j))
#define XB_TOP      3328
#define XB_TOPGEN   3392
#define XCD_BAR_WORDS 3456
#define XB_SPIN_CAP (1u << 18)

__device__ __forceinline__ unsigned xb_ld(unsigned* p)              { return __hip_atomic_load(p, __ATOMIC_RELAXED, __HIP_MEMORY_SCOPE_AGENT); }
__device__ __forceinline__ unsigned xb_add(unsigned* p, unsigned v) { return __hip_atomic_fetch_add(p, v, __ATOMIC_RELAXED, __HIP_MEMORY_SCOPE_AGENT); }
__device__ __forceinline__ unsigned xb_xcc_id() { return (unsigned)__builtin_amdgcn_s_getreg((3 << 11) | 20) & 0xFu; }
#define XB_SPIN(cond, bar) do { unsigned _sp = 0; while (cond) { __builtin_amdgcn_s_sleep(1); \
    if ((++_sp & 255u) == 0u) { if (xb_ld(&(bar)[XB_TMO])) break; if (_sp > XB_SPIN_CAP) { atomicAdd(&(bar)[XB_TMO], 1u); break; } } } } while (0)

struct XcdBarrier {
    unsigned* bar; unsigned x;
    volatile LAS unsigned* st;
};

__device__ __forceinline__ XcdBarrier xcd_barrier_post(unsigned* bar, volatile LAS unsigned* st) {
    XcdBarrier b; b.bar = bar; b.x = xb_xcc_id(); b.st = st;
    if (threadIdx.x == 0) (void)xb_add(&bar[XB_XCNT(b.x)], 1u);
    return b;
}
__device__ __forceinline__ void xcd_barrier_complete(unsigned* bar, unsigned x, unsigned& nloc, unsigned& nx) {
    const unsigned G = gridDim.x * gridDim.y * gridDim.z;
    unsigned sum, cnt, mine, sp = 0u;
    for (;;) {
        sum = 0u; cnt = 0u; mine = 0u;
#pragma unroll
        for (unsigned j = 0; j < 16; ++j) { const unsigned c = xb_ld(&bar[XB_XCNT(j)]); sum += c; cnt += (c > 0u) ? 1u : 0u; mine = (j == x) ? c : mine; }
        if (sum == G) break;
        __builtin_amdgcn_s_sleep(1);
        if ((++sp & 255u) == 0u) { if (xb_ld(&bar[XB_TMO])) break; if (sp > XB_SPIN_CAP) { atomicAdd(&bar[XB_TMO], 1u); break; } }
    }
    nloc = mine > 0u ? mine : 1u; nx = cnt > 0u ? cnt : 1u;
}

__device__ __forceinline__ void xcd_barrier(const XcdBarrier& b) {
    asm volatile("s_waitcnt vmcnt(0)" ::: "memory");
    __syncthreads();
    if (threadIdx.x == 0) {
        unsigned* bar = b.bar;
        __builtin_amdgcn_s_waitcnt(0);
        unsigned nloc = b.st[0], nx = b.st[1];
        if (nloc == 0u) { xcd_barrier_complete(bar, b.x, nloc, nx); b.st[0] = nloc; b.st[1] = nx; }
        const unsigned old = xb_add(&bar[XB_XSUB(b.x)], 1u);
        const unsigned gen = old / nloc;
        if (old + 1u == (gen + 1u) * nloc) {
            __builtin_amdgcn_fence(__ATOMIC_RELEASE, "agent");
            asm volatile("s_waitcnt vmcnt(0)" ::: "memory");
            const unsigned og = xb_add(&bar[XB_TOP], 1u);
            const unsigned tg = og / nx;
            if (og + 1u == (tg + 1u) * nx) xb_add(&bar[XB_TOPGEN], 1u);
            else XB_SPIN(xb_ld(&bar[XB_TOPGEN]) == tg, bar);
            __builtin_amdgcn_fence(__ATOMIC_ACQUIRE, "agent");
            xb_add(&bar[XB_XGEN(b.x)], 1u);
            asm volatile("s_waitcnt vmcnt(0)" ::: "memory");
        } else {
            XB_SPIN(xb_ld(&bar[XB_XGEN(b.x)]) == gen, bar);
            __builtin_amdgcn_fence(__ATOMIC_ACQUIRE, "agent");
            asm volatile("s_waitcnt vmcnt(0)" ::: "memory");
        }
    }
    __syncthreads();
}

struct Args { const float* in[30]; float* out; unsigned char* ws; int ph_lo, ph_hi, li, pad; };
struct Frame {
    LAS unsigned char* lds;
    volatile LAS unsigned* MISC;
    gu32* ctl;
    int tid, lane, wave;
    int vcu, G;
};
enum { I_XP = 0, I_XS, I_MEM, I_CCONV, I_SSC, I_SDELTA, I_CMK, I_CMV, I_NMIX, I_WIN, I_CONVW, I_CONVB, I_LNG, I_LNB, I_SCW, I_ALOG, I_DTB, I_DNN, I_WOUT,
       I_NMQ, I_NMKV, I_WMQ, I_WMK, I_WMV, I_WMO, I_NFFN, I_WG, I_WU, I_WD, I_NF };

__device__ __forceinline__ void tr_item(const float* W, int ldw, int k0, int c0, const float* gain, bf16* WT, int K, int r0, LAS float* scr, int lane) {
#pragma unroll 8
    for (int i = 0; i < 32; ++i) { const int kk = 2 * i + (lane >> 5); scr[kk * 33 + (lane & 31)] = W[(size_t)(k0 + kk) * ldw + c0 + (lane & 31)]; }
    LDS_WAIT(); asm volatile("" ::: "memory");
    const int c = lane & 7;
    float gv[8];
#pragma unroll
    for (int i = 0; i < 8; ++i) gv[i] = gain ? gain[k0 + 8 * c + i] : 1.f;
#pragma unroll
    for (int j = 0; j < 4; ++j) { const int n = (lane >> 3) + 8 * j; const LAS float* s = scr + (8 * c) * 33 + n;
        v4u o; o.x = pk2(s[0 * 33] * gv[0], s[1 * 33] * gv[1]); o.y = pk2(s[2 * 33] * gv[2], s[3 * 33] * gv[3]); o.z = pk2(s[4 * 33] * gv[4], s[5 * 33] * gv[5]); o.w = pk2(s[6 * 33] * gv[6], s[7 * 33] * gv[7]);
        *(GAS v4u*)(WT + (size_t)(r0 + n) * K + k0 + 8 * c) = o; }
    LDS_WAIT(); asm volatile("" ::: "memory");
}
__device__ __forceinline__ float softplusf_(float x) { return x > 20.f ? x : log1pf(__expf(x)); }

__device__ __forceinline__ void p0_prologue(const Args& A, Frame& F) {
    LAS float* scr = (LAS float*)(F.lds + RING_OFF + F.wave * 8448);
    const int gw = F.vcu * NWAVES + F.wave, NGW = F.G * NWAVES;
    unsigned char* ws = A.ws;
    const float* const pWMK = A.in[I_WMK]; const float* const pWMV = A.in[I_WMV]; const float* const pWG = A.in[I_WG]; const float* const pWU = A.in[I_WU];
    const float* const pXP = A.in[I_XP]; const float* const pXS = A.in[I_XS];
    constexpr int I_A = 96 * 16, I_B = 32 * 16, I_D = 64 * 16, I_F = 176 * 16, I_G = 32 * 44;
    constexpr int NITEMS = I_A + I_B + I_B + I_D + I_B + I_F + I_G;
    for (int it = gw; it < NITEMS; it += NGW) {
        int r = it;
        if (r < I_A) { const int nb = r % 96, kb = r / 96, j0 = 32 * nb; int src = j0;
            if (j0 < 1024) { const int tile = j0 >> 8, local = j0 & 255; src = local < 128 ? 128 * tile + local : 512 + 128 * tile + (local - 128); }
            tr_item(A.in[I_WIN], INC, 64 * kb, src, nullptr, (bf16*)(ws + WS_WIN), DM, j0, scr, F.lane); continue; } r -= I_A;
        if (r < I_B) { const int nb = r % 32, kb = r / 32; tr_item(A.in[I_WOUT], DM, 64 * kb, 32 * nb, nullptr, (bf16*)(ws + WS_WOUT), DM, 32 * nb, scr, F.lane); continue; } r -= I_B;
        if (r < I_B) { const int nb = r % 32, kb = r / 32; tr_item(A.in[I_WMQ], DM, 64 * kb, 32 * nb, A.in[I_NMQ], (bf16*)(ws + WS_WMQ), DM, 32 * nb, scr, F.lane); continue; } r -= I_B;
        if (r < I_D) { const int nb = r % 64, kb = r / 64, j0 = 32 * nb; const bool isv = j0 >= 1024;
            tr_item(isv ? pWMV : pWMK, DM, 64 * kb, isv ? j0 - 1024 : j0, nullptr, (bf16*)(ws + WS_WMKV), DM, j0, scr, F.lane); continue; } r -= I_D;
        if (r < I_B) { const int nb = r % 32, kb = r / 32; tr_item(A.in[I_WMO], DM, 64 * kb, 32 * nb, nullptr, (bf16*)(ws + WS_WMO), DM, 32 * nb, scr, F.lane); continue; } r -= I_B;
        if (r < I_F) { const int nb = r % 176, kb = r / 176, j0 = 32 * nb, tile = j0 >> 8, local = j0 & 255; const bool up = local >= 128;
            tr_item(up ? pWU : pWG, DFF, 64 * kb, 128 * tile + (up ? local - 128 : local), A.in[I_NFFN], (bf16*)(ws + WS_WGU), DM, j0, scr, F.lane); continue; } r -= I_F;
        { const int nb = r % 32, kb = r / 32; tr_item(A.in[I_WD], DM, 64 * kb, 32 * nb, nullptr, (bf16*)(ws + WS_WDN), DFF, 32 * nb, scr, F.lane); }
    }
    {
        bf16* H = (bf16*)(ws + WS_RB); float* BG = (float*)(ws + WS_BG);
        const float* win = A.in[I_WIN]; const float* gain = A.in[I_NMIX];
        float w8[4][4][8];
#pragma unroll
        for (int j = 0; j < 4; ++j)
#pragma unroll
            for (int i = 0; i < 4; ++i) { const int k = 256 * j + 4 * F.lane + i; const f32x4 a = *(const f32x4*)(win + (size_t)k * INC + 3072), b = *(const f32x4*)(win + (size_t)k * INC + 3076);
                w8[j][i][0] = a[0]; w8[j][i][1] = a[1]; w8[j][i][2] = a[2]; w8[j][i][3] = a[3]; w8[j][i][4] = b[0]; w8[j][i][5] = b[1]; w8[j][i][6] = b[2]; w8[j][i][7] = b[3]; }
        f32x4 gn[4];
#pragma unroll
        for (int j = 0; j < 4; ++j) gn[j] = *(const f32x4*)(gain + 256 * j + 4 * F.lane);
        const f32x4 alog4 = *(const f32x4*)A.in[I_ALOG], dtb4 = *(const f32x4*)A.in[I_DTB];
        for (int m = gw; m < MR; m += NGW) {
            GAS unsigned long long* o8 = (GAS unsigned long long*)(H + (size_t)m * DM) + F.lane;
            if (m >= MV) {
#pragma unroll
                for (int j = 0; j < 4; ++j) o8[64 * j] = 0ull;
                if (F.lane < 8) BG[(size_t)m * 8 + F.lane] = 0.f;
                continue;
            }
            const float* xrow = (m < MP) ? pXP + (size_t)m * DM : pXS + (size_t)(m - MP) * DM;
            const GAS f32x4* xr = (const GAS f32x4*)xrow + F.lane;
            f32x4 v[4]; float s2 = 0.f;
#pragma unroll
            for (int j = 0; j < 4; ++j) { v[j] = xr[64 * j]; s2 += (v[j][0] * v[j][0] + v[j][1] * v[j][1]) + (v[j][2] * v[j][2] + v[j][3] * v[j][3]); }
            const float rstd = 1.f / sqrtf(wave_sum(s2) * (1.f / DM) + RMS_EPS);
            float p8[8];
#pragma unroll
            for (int c = 0; c < 8; ++c) p8[c] = 0.f;
#pragma unroll
            for (int j = 0; j < 4; ++j) { v[j] = v[j] * rstd * gn[j];
#pragma unroll
                for (int i = 0; i < 4; ++i)
#pragma unroll
                    for (int c = 0; c < 8; ++c) p8[c] += v[j][i] * w8[j][i][c];
                o8[64 * j] = (unsigned long long)pk2(v[j][0], v[j][1]) | ((unsigned long long)pk2(v[j][2], v[j][3]) << 32); }
#pragma unroll
            for (int c = 0; c < 8; ++c) p8[c] = wave_sum(p8[c]);
            f32x4 bo, go;
#pragma unroll
            for (int c = 0; c < 4; ++c) { bo[c] = 1.f / (1.f + expf(-p8[c])); go[c] = -expf(alog4[c]) * softplusf_(p8[4 + c] + dtb4[c]); }
            if (F.lane == 0) { *(f32x4*)(BG + (size_t)m * 8) = bo; *(f32x4*)(BG + (size_t)m * 8 + 4) = go; }
        }
    }
    {
        bf16* MN = (bf16*)(ws + WS_MEMN); const float* gain = A.in[I_NMKV];
        f32x4 gn[4];
#pragma unroll
        for (int j = 0; j < 4; ++j) gn[j] = *(const f32x4*)(gain + 256 * j + 4 * F.lane);
        for (int m = gw; m < NB * NMEM; m += NGW) {
            const GAS f32x4* xr = (const GAS f32x4*)(A.in[I_MEM] + (size_t)m * DM) + F.lane;
            f32x4 v[4]; float s2 = 0.f;
#pragma unroll
            for (int j = 0; j < 4; ++j) { v[j] = xr[64 * j]; s2 += (v[j][0] * v[j][0] + v[j][1] * v[j][1]) + (v[j][2] * v[j][2] + v[j][3] * v[j][3]); }
            const float rstd = 1.f / sqrtf(wave_sum(s2) * (1.f / DM) + RMS_EPS);
            GAS unsigned long long* o8 = (GAS unsigned long long*)(MN + (size_t)m * DM) + F.lane;
#pragma unroll
            for (int j = 0; j < 4; ++j) { v[j] = v[j] * rstd * gn[j]; o8[64 * j] = (unsigned long long)pk2(v[j][0], v[j][1]) | ((unsigned long long)pk2(v[j][2], v[j][3]) << 32); }
        }
    }
}

__device__ __forceinline__ void conv_tile(const Args& A, Frame& F, int b, int tile) {
    const bf16* PB = (const bf16*)(A.ws + WS_RA); bf16* CD = (bf16*)(A.ws + WS_RB); bf16* QC = (bf16*)(A.ws + WS_RC);
    const int c = F.tid; const int row0 = b * SEQ + tile * 64;
    LAS float* Y = (LAS float*)(F.lds + RING_OFF);
    {
        float w[CW];
#pragma unroll
        for (int j = 0; j < CW; ++j) w[j] = A.in[I_CONVW][j * CC + c];
        const float bias = A.in[I_CONVB][c];
        float uv[46];
        const unsigned rb = (unsigned)(b * SEQ + tile * 64);
#pragma unroll
        for (int i = 0; i < 30; ++i) { const int tk = tile * 64 - 30 + i; const unsigned tkc = tk < 0 ? 0u : (unsigned)tk; const float vv = bf2f(PB[(unsigned)(b * SEQ + tkc) * (unsigned)PBLD + (unsigned)c]); uv[i] = (tk >= 0) ? vv : 0.f; }
#pragma unroll 1
        for (int seg = 0; seg < 4; ++seg) {
#pragma unroll
            for (int i = 0; i < 16; ++i) uv[30 + i] = bf2f(PB[(rb + (unsigned)(seg * 16 + i)) * (unsigned)PBLD + (unsigned)c]);
#pragma unroll
            for (int t = 0; t < 16; ++t) { float a = bias;
#pragma unroll
                for (int j = 0; j < CW; ++j) a += w[j] * uv[t + j];
                Y[(seg * 16 + t) * CC + c] = a; }
#pragma unroll
            for (int i = 0; i < 30; ++i) uv[i] = uv[i + 16];
        }
    }
    __syncthreads();
    {
        const int ch0 = 8 * F.lane;
        const f32x4 g0 = *(const f32x4*)(A.in[I_LNG] + ch0), g1 = *(const f32x4*)(A.in[I_LNG] + ch0 + 4), b0 = *(const f32x4*)(A.in[I_LNB] + ch0), b1 = *(const f32x4*)(A.in[I_LNB] + ch0 + 4);
#pragma unroll 2
        for (int tt = 0; tt < 8; ++tt) { const int t = 8 * F.wave + tt;
            f32x4 y0 = *(const LAS f32x4*)(Y + t * CC + ch0), y1 = *(const LAS f32x4*)(Y + t * CC + ch0 + 4);
            const float mean = wave_sum((y0[0] + y0[1]) + (y0[2] + y0[3]) + (y1[0] + y1[1]) + (y1[2] + y1[3])) * (1.f / CC);
            y0 = y0 - mean; y1 = y1 - mean;
            const float var = wave_sum((y0[0] * y0[0] + y0[1] * y0[1]) + (y0[2] * y0[2] + y0[3] * y0[3]) + (y1[0] * y1[0] + y1[1] * y1[1]) + (y1[2] * y1[2] + y1[3] * y1[3])) * (1.f / CC);
            const float rstd = 1.f / sqrtf(var + 1e-5f);
            y0 = y0 * rstd * g0 + b0; y1 = y1 * rstd * g1 + b1;
            float o[8];
#pragma unroll
            for (int i = 0; i < 4; ++i) { o[i] = silu(y0[i]); o[4 + i] = silu(y1[i]); }
            *(GAS v4u*)(CD + (size_t)(row0 + t) * DM + ch0) = pack8(o); }
    }
    if (tile == 31) {
        float* oc = A.out + OUT_CONVP + (size_t)b * 30 * CC;
        for (int j = 0; j < 30; ++j) oc[j * CC + c] = bf2f(PB[(size_t)(b * SEQ + SEQ - 30 + j) * PBLD + c]);
        float* os = A.out + OUT_SCP + (size_t)b * 3 * QKVN;
        for (int e = F.tid; e < 3 * QKVN; e += NWAVES * 64) { const int j = e / QKVN, ch = e % QKVN; os[e] = bf2f(PB[(size_t)(b * SEQ + SEQ - 3 + j) * PBLD + 512 + ch]); }
    }
    {
        const int t0 = tile * 64 + 8 * F.wave;
#pragma unroll 1
        for (int p = 0; p < 3; ++p) {
            const int ch0 = 512 * p + 8 * F.lane;
            float wsc[4][8];
#pragma unroll
            for (int j = 0; j < 4; ++j) { const f32x4 a = *(const f32x4*)(A.in[I_SCW] + j * QKVN + ch0), bb = *(const f32x4*)(A.in[I_SCW] + j * QKVN + ch0 + 4);
#pragma unroll
                for (int i = 0; i < 4; ++i) { wsc[j][i] = a[i]; wsc[j][4 + i] = bb[i]; } }
            float win[3][8];
#pragma unroll
            for (int j = 0; j < 3; ++j) { const int tk = t0 - 3 + j; const int tkc = tk < 0 ? 0 : tk;
                const v4u x = *(const GAS v4u*)(PB + (size_t)(b * SEQ + tkc) * PBLD + 512 + ch0); unpack8(x, win[j]);
#pragma unroll
                for (int i = 0; i < 8; ++i) win[j][i] = (tk >= 0) ? win[j][i] : 0.f; }
#pragma unroll
            for (int tt = 0; tt < 8; ++tt) {
                float cur[8]; { const v4u x = *(const GAS v4u*)(PB + (size_t)(b * SEQ + t0 + tt) * PBLD + 512 + ch0); unpack8(x, cur); }
                float y[8]; float ss = 0.f;
#pragma unroll
                for (int i = 0; i < 8; ++i) { const float a = wsc[0][i] * win[0][i] + wsc[1][i] * win[1][i] + wsc[2][i] * win[2][i] + wsc[3][i] * cur[i]; y[i] = silu(a); ss += y[i] * y[i]; }
                if (p < 2) { ss += __shfl_xor(ss, 1); ss += __shfl_xor(ss, 2); ss += __shfl_xor(ss, 4); ss += __shfl_xor(ss, 8);
                    const float sc = (1.f / sqrtf(ss + 1e-6f)) * (p == 0 ? 0.08838834764831845f : 1.f);
#pragma unroll
                    for (int i = 0; i < 8; ++i) y[i] *= sc; }
                *(GAS v4u*)(QC + (size_t)(b * SEQ + t0 + tt) * QKVN + ch0) = pack8(y);
#pragma unroll
                for (int i = 0; i < 8; ++i) { win[0][i] = win[1][i]; win[1][i] = win[2][i]; win[2][i] = cur[i]; }
            }
        }
    }
    __syncthreads();
}
__device__ __forceinline__ void conv_sample(const Args& A, Frame& F, int s) {
    const bf16* PB = (const bf16*)(A.ws + WS_RA); bf16* CD = (bf16*)(A.ws + WS_RB); bf16* QC = (bf16*)(A.ws + WS_RC);
    const int c = F.tid; const size_t row = (size_t)MP + s;
    LAS float* Y = (LAS float*)(F.lds + RING_OFF);
    {
        const float* cache = A.in[I_CCONV] + (size_t)s * 30 * CC; float* oc = A.out + OUT_CONVS + (size_t)s * 30 * CC;
        const float us = bf2f(PB[row * PBLD + c]);
        float a = A.in[I_CONVB][c];
        float prev = cache[c];
#pragma unroll 6
        for (int j = 0; j < 30; ++j) { a += A.in[I_CONVW][j * CC + c] * prev; const float nx = (j < 29) ? cache[(j + 1) * CC + c] : us; oc[j * CC + c] = nx; prev = nx; }
        a += A.in[I_CONVW][30 * CC + c] * us;
        Y[c] = a;
    }
    __syncthreads();
    if (F.wave == 7) {
        const int ch0 = 8 * F.lane;
        const f32x4 g0 = *(const f32x4*)(A.in[I_LNG] + ch0), g1 = *(const f32x4*)(A.in[I_LNG] + ch0 + 4), b0 = *(const f32x4*)(A.in[I_LNB] + ch0), b1 = *(const f32x4*)(A.in[I_LNB] + ch0 + 4);
        f32x4 y0 = *(const LAS f32x4*)(Y + ch0), y1 = *(const LAS f32x4*)(Y + ch0 + 4);
        const float mean = wave_sum((y0[0] + y0[1]) + (y0[2] + y0[3]) + (y1[0] + y1[1]) + (y1[2] + y1[3])) * (1.f / CC);
        y0 = y0 - mean; y1 = y1 - mean;
        const float var = wave_sum((y0[0] * y0[0] + y0[1] * y0[1]) + (y0[2] * y0[2] + y0[3] * y0[3]) + (y1[0] * y1[0] + y1[1] * y1[1]) + (y1[2] * y1[2] + y1[3] * y1[3])) * (1.f / CC);
        const float rstd = 1.f / sqrtf(var + 1e-5f);
        y0 = y0 * rstd * g0 + b0; y1 = y1 * rstd * g1 + b1;
        float o[8];
#pragma unroll
        for (int i = 0; i < 4; ++i) { o[i] = silu(y0[i]); o[4 + i] = silu(y1[i]); }
        *(GAS v4u*)(CD + row * DM + ch0) = pack8(o);
    }
    if (F.wave < 3) {
        const int p = F.wave; const int ch0 = 512 * p + 8 * F.lane;
        const float* st = A.in[I_SSC] + (size_t)s * 3 * QKVN; float* os = A.out + OUT_SCS + (size_t)s * 3 * QKVN;
        float win[3][8], cur[8], y[8];
#pragma unroll
        for (int j = 0; j < 3; ++j) { const f32x4 a = *(const f32x4*)(st + j * QKVN + ch0), bb = *(const f32x4*)(st + j * QKVN + ch0 + 4);
#pragma unroll
            for (int i = 0; i < 4; ++i) { win[j][i] = a[i]; win[j][4 + i] = bb[i]; } }
        { const v4u x = *(const GAS v4u*)(PB + row * PBLD + 512 + ch0); unpack8(x, cur); }
        float ss = 0.f;
#pragma unroll
        for (int i = 0; i < 8; ++i) { float a = 0.f;
#pragma unroll
            for (int j = 0; j < 3; ++j) a += A.in[I_SCW][j * QKVN + ch0 + i] * win[j][i];
            a += A.in[I_SCW][3 * QKVN + ch0 + i] * cur[i]; y[i] = silu(a); ss += y[i] * y[i]; }
        if (p < 2) { ss += __shfl_xor(ss, 1); ss += __shfl_xor(ss, 2); ss += __shfl_xor(ss, 4); ss += __shfl_xor(ss, 8);
            const float sc = (1.f / sqrtf(ss + 1e-6f)) * (p == 0 ? 0.08838834764831845f : 1.f);
#pragma unroll
            for (int i = 0; i < 8; ++i) y[i] *= sc; }
        *(GAS v4u*)(QC + row * QKVN + ch0) = pack8(y);
#pragma unroll
        for (int j = 0; j < 3; ++j) { f32x4 a, bb;
#pragma unroll
            for (int i = 0; i < 4; ++i) { a[i] = (j < 2) ? win[j + 1][i] : cur[i]; bb[i] = (j < 2) ? win[j + 1][4 + i] : cur[4 + i]; }
            *(f32x4*)(os + j * QKVN + ch0) = a; *(f32x4*)(os + j * QKVN + ch0 + 4) = bb; }
    }
    __syncthreads();
}

__device__ __forceinline__ bf16x8 lds_frag16(const LAS unsigned char* p) { return *(const LAS bf16x8*)p; }
__device__ __forceinline__ void d1_chunk(const Args& A, Frame& F, int ci) {
    using pg8::f32x4;
    const int b = ci >> 7, h = (ci >> 5) & 3, n = ci & 31; const int row0 = b * SEQ + n * 64;
    const bf16* QC = (const bf16*)(A.ws + WS_RC); const float* BG = (const float*)(A.ws + WS_BG);
    float* Ug = (float*)(A.ws + WS_U) + (size_t)ci * 8192; bf16* Wg = (bf16*)(A.ws + WS_W) + (size_t)ci * 8192; bf16* QGg = (bf16*)(A.ws + WS_QG) + (size_t)ci * 8192;
    bf16* KDTg = (bf16*)(A.ws + WS_KDT) + (size_t)ci * 8192; bf16* QKg = (bf16*)(A.ws + WS_QK) + (size_t)ci * 4096; float* GLg = (float*)(A.ws + WS_GL);
    constexpr int OFF_K = 0, OFF_Q = 17408, OFF_VBT = 34816, OFF_KBGT = 53248, OFF_L = 71680, OFF_T = 89088, OFF_GC = 98304, OFF_BETA = 98560, OFF_EG = 98816, OFF_TM = 99072, OFF_X = 116480, LS = 68;
    LAS unsigned char* L = F.lds + RING_OFF;
    LAS float* gcs = (LAS float*)(L + OFF_GC); LAS float* betas = (LAS float*)(L + OFF_BETA); LAS float* egs = (LAS float*)(L + OFF_EG); LAS float* Lm = (LAS float*)(L + OFF_L); LAS float* Tm = (LAS float*)(L + OFF_TM); LAS float* Xm = (LAS float*)(L + OFF_X);
    const int fr = F.lane & 15, fq = F.lane >> 4;
    if (F.wave == 0) {
        float g = BG[(size_t)(row0 + F.lane) * 8 + 4 + h]; const float be = BG[(size_t)(row0 + F.lane) * 8 + h];
#pragma unroll
        for (int o = 1; o < 64; o <<= 1) { const float v = __shfl_up(g, o); if (F.lane >= o) g += v; }
        gcs[F.lane] = g; betas[F.lane] = be; egs[F.lane] = __expf(g);
    }
    __syncthreads();
    {
        const int t = F.tid >> 3, part = F.tid & 7;
        const bf16* rp = QC + (size_t)(row0 + t) * QKVN + h * 128 + part * 16;
        const v4u q0 = *(const GAS v4u*)(rp), q1 = *(const GAS v4u*)(rp + 8), k0 = *(const GAS v4u*)(rp + 512), k1 = *(const GAS v4u*)(rp + 520), v0 = *(const GAS v4u*)(rp + 1024), v1 = *(const GAS v4u*)(rp + 1032);
        *(LAS v4u*)(L + OFF_K + t * 272 + part * 32) = k0; *(LAS v4u*)(L + OFF_K + t * 272 + part * 32 + 16) = k1;
        *(LAS v4u*)(L + OFF_Q + t * 272 + part * 32) = q0; *(LAS v4u*)(L + OFF_Q + t * 272 + part * 32 + 16) = q1;
        const float be = betas[t], beg = be * egs[t];
        float kf[16], vf[16];
        { float tmp[8]; unpack8(k0, tmp);
#pragma unroll
          for (int i = 0; i < 8; ++i) kf[i] = tmp[i]; unpack8(k1, tmp);
#pragma unroll
          for (int i = 0; i < 8; ++i) kf[8 + i] = tmp[i]; unpack8(v0, tmp);
#pragma unroll
          for (int i = 0; i < 8; ++i) vf[i] = tmp[i]; unpack8(v1, tmp);
#pragma unroll
          for (int i = 0; i < 8; ++i) vf[8 + i] = tmp[i]; }
#pragma unroll
        for (int i = 0; i < 16; ++i) { const int d = part * 16 + i;
            *(LAS unsigned short*)(L + OFF_VBT + d * 144 + t * 2) = (unsigned short)(pk2(vf[i] * be, 0.f) & 0xffffu);
            *(LAS unsigned short*)(L + OFF_KBGT + d * 144 + t * 2) = (unsigned short)(pk2(kf[i] * beg, 0.f) & 0xffffu); }
    }
    __syncthreads();
#pragma unroll 1
    for (int x = 0; x < 4; ++x) {
        const int tile = F.wave * 4 + x, which = tile >> 4, ti = (tile >> 2) & 3, tj = tile & 3;
        f32x4 acc = (f32x4){0.f, 0.f, 0.f, 0.f};
        if (ti >= tj) {
            const LAS unsigned char* ap = L + (which ? OFF_Q : OFF_K) + (ti * 16 + fr) * 272 + fq * 16; const LAS unsigned char* bp = L + OFF_K + (tj * 16 + fr) * 272 + fq * 16;
#pragma unroll
            for (int kk = 0; kk < 4; ++kk) acc = __builtin_amdgcn_mfma_f32_16x16x32_bf16(lds_frag16(ap + kk * 64), lds_frag16(bp + kk * 64), acc, 0, 0, 0);
        }
        const int j = tj * 16 + fr; const float gj = gcs[j];
#pragma unroll
        for (int r = 0; r < 4; ++r) { const int i = ti * 16 + 4 * fq + r; const float dec = __expf(gcs[i] - gj);
            if (which == 0) Lm[i * LS + j] = (i > j) ? betas[i] * acc[r] * dec : 0.f;
            else QKg[i * 64 + j] = (bf16)(pk2((i >= j) ? acc[r] * dec : 0.f, 0.f) & 0xffffu); }
    }
    __syncthreads();
    for (int e = F.tid; e < 64 * LS; e += NWAVES * 64) Tm[e] = 0.f;
    __syncthreads();
    if (F.wave == 0) {
        const LAS float* Lb = Lm + (16 * fq) * LS + 16 * fq;
        float t[16];
#pragma unroll
        for (int i = 0; i < 16; ++i) {
            float a0 = 0.f, a1 = 0.f, a2 = 0.f, a3 = 0.f;
#pragma unroll
            for (int j4 = 0; j4 < (i + 3) / 4; ++j4) { const f32x4 lv = *(const LAS f32x4*)(Lb + i * LS + 4 * j4);
                if (4 * j4 + 0 < i) a0 += lv[0] * t[4 * j4 + 0]; if (4 * j4 + 1 < i) a1 += lv[1] * t[4 * j4 + 1]; if (4 * j4 + 2 < i) a2 += lv[2] * t[4 * j4 + 2]; if (4 * j4 + 3 < i) a3 += lv[3] * t[4 * j4 + 3]; }
            t[i] = ((fr == i) ? 1.f : 0.f) - ((a0 + a1) + (a2 + a3));
        }
#pragma unroll
        for (int i = 0; i < 16; ++i) Tm[(16 * fq + i) * LS + 16 * fq + fr] = t[i];
    } else {
        const int lt = F.tid - 64; const float gl = gcs[63];
        for (int cix = lt; cix < 1024; cix += 448) {
            const int t = cix >> 4, cc = cix & 15; const v4u x = *(const LAS v4u*)(L + OFF_Q + t * 272 + cc * 16); float f[8]; unpack8(x, f); const float e = egs[t];
#pragma unroll
            for (int i = 0; i < 8; ++i) f[i] *= e;
            *(GAS v4u*)(QGg + t * 128 + cc * 8) = pack8(f); }
        for (int cix = lt; cix < 1024; cix += 448) {
            const int dk = cix >> 3, t0 = (cix & 7) * 8; float f[8];
#pragma unroll
            for (int i = 0; i < 8; ++i) f[i] = bf2f(*(const LAS unsigned short*)(L + OFF_K + (t0 + i) * 272 + dk * 2)) * __expf(gl - gcs[t0 + i]);
            *(GAS v4u*)(KDTg + dk * 64 + t0) = pack8(f); }
        if (lt == 0) GLg[ci] = __expf(gl);
    }
    __syncthreads();
    if (F.wave < 2) {
        const int pp = F.wave, rb = 16 * (2 * pp + 1), cb = 16 * (2 * pp); f32x4 acc = (f32x4){0.f, 0.f, 0.f, 0.f};
#pragma unroll
        for (int kk = 0; kk < 4; ++kk) acc = __builtin_amdgcn_mfma_f32_16x16x4f32(Lm[(rb + fr) * LS + cb + 4 * kk + fq], Tm[(cb + 4 * kk + fq) * LS + cb + fr], acc, 0, 0, 0);
#pragma unroll
        for (int r = 0; r < 4; ++r) Xm[pp * 576 + (4 * fq + r) * 36 + fr] = acc[r];
    }
    __syncthreads();
    if (F.wave < 2) {
        const int pp = F.wave, rb = 16 * (2 * pp + 1), cb = 16 * (2 * pp); f32x4 acc = (f32x4){0.f, 0.f, 0.f, 0.f};
#pragma unroll
        for (int kk = 0; kk < 4; ++kk) acc = __builtin_amdgcn_mfma_f32_16x16x4f32(Tm[(rb + fr) * LS + rb + 4 * kk + fq], Xm[pp * 576 + (4 * kk + fq) * 36 + fr], acc, 0, 0, 0);
#pragma unroll
        for (int r = 0; r < 4; ++r) Tm[(rb + 4 * fq + r) * LS + cb + fr] = -acc[r];
    }
    __syncthreads();
    if (F.wave < 4) {
        const int bi = F.wave >> 1, bj = F.wave & 1; f32x4 acc = (f32x4){0.f, 0.f, 0.f, 0.f};
#pragma unroll
        for (int kk = 0; kk < 8; ++kk) acc = __builtin_amdgcn_mfma_f32_16x16x4f32(Lm[(32 + 16 * bi + fr) * LS + 4 * kk + fq], Tm[(4 * kk + fq) * LS + 16 * bj + fr], acc, 0, 0, 0);
#pragma unroll
        for (int r = 0; r < 4; ++r) Xm[(16 * bi + 4 * fq + r) * 36 + 16 * bj + fr] = acc[r];
    }
    __syncthreads();
    if (F.wave < 4) {
        const int bi = F.wave >> 1, bj = F.wave & 1; f32x4 acc = (f32x4){0.f, 0.f, 0.f, 0.f};
#pragma unroll
        for (int kk = 0; kk < 8; ++kk) acc = __builtin_amdgcn_mfma_f32_16x16x4f32(Tm[(32 + 16 * bi + fr) * LS + 32 + 4 * kk + fq], Xm[(4 * kk + fq) * 36 + 16 * bj + fr], acc, 0, 0, 0);
#pragma unroll
        for (int r = 0; r < 4; ++r) Tm[(32 + 16 * bi + 4 * fq + r) * LS + 16 * bj + fr] = -acc[r];
    }
    __syncthreads();
    {
        const int i = F.tid >> 3, j0 = (F.tid & 7) * 8; const f32x4 a = *(const LAS f32x4*)(Tm + i * LS + j0), bq = *(const LAS f32x4*)(Tm + i * LS + j0 + 4);
        v4u w; w.x = pk2(a[0], a[1]); w.y = pk2(a[2], a[3]); w.z = pk2(bq[0], bq[1]); w.w = pk2(bq[2], bq[3]);
        *(LAS v4u*)(L + OFF_T + i * 144 + j0 * 2) = w;
    }
    __syncthreads();
#pragma unroll 1
    for (int x = 0; x < 8; ++x) {
        const int tile = F.wave * 8 + x, which = tile >> 5, ti = (tile >> 3) & 3, td = tile & 7;
        const LAS unsigned char* ap = L + OFF_T + (ti * 16 + fr) * 144 + fq * 16; const LAS unsigned char* bp = L + (which ? OFF_KBGT : OFF_VBT) + (td * 16 + fr) * 144 + fq * 16;
        f32x4 acc = (f32x4){0.f, 0.f, 0.f, 0.f};
#pragma unroll
        for (int kk = 0; kk < 2; ++kk) acc = __builtin_amdgcn_mfma_f32_16x16x32_bf16(lds_frag16(ap + kk * 64), lds_frag16(bp + kk * 64), acc, 0, 0, 0);
        const int d = td * 16 + fr;
#pragma unroll
        for (int r = 0; r < 4; ++r) { const int i = ti * 16 + 4 * fq + r;
            if (which == 0) Ug[i * 128 + d] = acc[r]; else Wg[i * 128 + d] = (bf16)(pk2(acc[r], 0.f) & 0xffffu); }
    }
    __syncthreads();
}

constexpr int SC_OW = 0, SC_OQG = 16384, SC_OKDT = 32768, SC_OQK = 49152, SC_OU = 57344, SC_BUF = 61440;
__device__ __forceinline__ void scan_issue(const Args& A, Frame& F, int ci, int sl, LAS unsigned char* dst) {
    const unsigned char* Wg = A.ws + WS_W + (size_t)ci * 16384; const unsigned char* QGg = A.ws + WS_QG + (size_t)ci * 16384;
    const unsigned char* KDTg = A.ws + WS_KDT + (size_t)ci * 16384; const unsigned char* QKg = A.ws + WS_QK + (size_t)ci * 8192; const unsigned char* Ug = A.ws + WS_U + (size_t)ci * 32768 + sl * 64;
#pragma unroll
    for (int j = 0; j < 9; ++j) {
        const int pi = (F.wave - 1) + 7 * j;
        if (pi < 60) {
            const unsigned char* src;
            if (pi < 32) { const int i = (pi & 15) * 64 + F.lane, r = i >> 4, c = (i & 15) ^ (r & 15); src = (pi < 16 ? Wg : QGg) + r * 256 + c * 16; }
            else if (pi < 56) { const int i = (pi < 48 ? pi - 32 : pi - 48) * 64 + F.lane, r = i >> 3, c = (i & 7) ^ ((r >> 1) & 7); src = (pi < 48 ? KDTg : QKg) + r * 128 + c * 16; }
            else { const int i = (pi - 56) * 64 + F.lane, r = i >> 2, c = i & 3; src = Ug + r * 512 + c * 16; }
            __builtin_amdgcn_global_load_lds((const unsigned*)src, (LAS unsigned*)(dst + pi * 1024), 16, 0, 0);
        }
    }
}
__device__ __forceinline__ bf16x8 frag2(const LAS unsigned char* p0, const LAS unsigned char* p1) { const v2u lo = *(const LAS v2u*)p0, hi = *(const LAS v2u*)p1; v4u w; w.x = lo.x; w.y = lo.y; w.z = hi.x; w.w = hi.y; return __builtin_bit_cast(bf16x8, w); }
__device__ __forceinline__ bf16x8 frag256(const LAS unsigned char* tile, int row, int kstep, int fq) { const int c = 4 * kstep + (fq >> 1), sw = row & 15; const LAS unsigned char* rp = tile + row * 256 + 8 * (fq & 1); return frag2(rp + ((c ^ sw) << 4), rp + (((c + 2) ^ sw) << 4)); }
__device__ __forceinline__ bf16x8 frag128(const LAS unsigned char* tile, int row, int kstep, int fq) { const int c = 4 * kstep + (fq >> 1), sw = (row >> 1) & 7; const LAS unsigned char* rp = tile + row * 128 + 8 * (fq & 1); return frag2(rp + ((c ^ sw) << 4), rp + (((c + 2) ^ sw) << 4)); }
__device__ __forceinline__ bf16x8 pack_pair(const pg8::f32x4& a, const pg8::f32x4& b) { v4u w; w.x = pk2(a[0], a[1]); w.y = pk2(a[2], a[3]); w.z = pk2(b[0], b[1]); w.w = pk2(b[2], b[3]); return __builtin_bit_cast(bf16x8, w); }
__device__ __forceinline__ void scan_unit(const Args& A, Frame& F, int b, int h, int sl) {
    using pg8::f32x4;
    LAS unsigned char* L = F.lds + RING_OFF;
    const int ci0 = (b * NH + h) * 32; const int fr = F.lane & 15, fq = F.lane >> 4;
    float* Og = (float*)(A.ws + WS_RE); const float* GLg = (const float*)(A.ws + WS_GL);
    if (F.wave > 0) { scan_issue(A, F, ci0, sl, L); scan_issue(A, F, ci0 + 1, sl, L + SC_BUF); asm volatile("s_waitcnt vmcnt(9)" ::: "memory"); }
    __builtin_amdgcn_s_barrier(); asm volatile("" ::: "memory");
    f32x4 S[8];
#pragma unroll
    for (int i = 0; i < 8; ++i) S[i] = (f32x4){0.f, 0.f, 0.f, 0.f};
    float gl = GLg[ci0];
#pragma unroll 1
    for (int n = 0; n < 32; ++n) {
        if (F.wave == 0) {
            const LAS unsigned char* B = L + (n & 1) * SC_BUF;
            const float gln = GLg[ci0 + (n < 31 ? n + 1 : n)];
            bf16x8 Sb[4];
#pragma unroll
            for (int kk = 0; kk < 4; ++kk) Sb[kk] = pack_pair(S[2 * kk], S[2 * kk + 1]);
            f32x4 vn[4];
#pragma unroll
            for (int tb = 0; tb < 4; ++tb) { f32x4 p1 = (f32x4){0.f, 0.f, 0.f, 0.f};
#pragma unroll
                for (int kk = 0; kk < 4; ++kk) p1 = __builtin_amdgcn_mfma_f32_16x16x32_bf16(frag256(B + SC_OW, 16 * tb + fr, kk, fq), Sb[kk], p1, 0, 0, 0);
#pragma unroll
                for (int r = 0; r < 4; ++r) vn[tb][r] = *(const LAS float*)(B + SC_OU + (16 * tb + 4 * fq + r) * 64 + fr * 4) - p1[r]; }
            bf16x8 Vb[2]; Vb[0] = pack_pair(vn[0], vn[1]); Vb[1] = pack_pair(vn[2], vn[3]);
            const size_t orow = (size_t)(b * SEQ + n * 64);
#pragma unroll
            for (int blk = 0; blk < 8; ++blk) { f32x4 s = S[blk] * gl;
#pragma unroll
                for (int kt = 0; kt < 2; ++kt) s = __builtin_amdgcn_mfma_f32_16x16x32_bf16(frag128(B + SC_OKDT, 16 * blk + fr, kt, fq), Vb[kt], s, 0, 0, 0);
                S[blk] = s; }
#pragma unroll
            for (int tb = 0; tb < 4; ++tb) { f32x4 o = (f32x4){0.f, 0.f, 0.f, 0.f};
#pragma unroll
                for (int kk = 0; kk < 4; ++kk) o = __builtin_amdgcn_mfma_f32_16x16x32_bf16(frag256(B + SC_OQG, 16 * tb + fr, kk, fq), Sb[kk], o, 0, 0, 0);
#pragma unroll
                for (int kt = 0; kt < 2; ++kt) o = __builtin_amdgcn_mfma_f32_16x16x32_bf16(frag128(B + SC_OQK, 16 * tb + fr, kt, fq), Vb[kt], o, 0, 0, 0);
#pragma unroll
                for (int r = 0; r < 4; ++r) Og[(orow + 16 * tb + 4 * fq + r) * 512 + h * 128 + sl * 16 + fr] = o[r]; }
            gl = gln;
            asm volatile("s_waitcnt lgkmcnt(0)" ::: "memory");
        } else {
            asm volatile("s_waitcnt vmcnt(0)" ::: "memory");
        }
        __builtin_amdgcn_s_barrier(); asm volatile("" ::: "memory");
        if (F.wave > 0 && n + 2 < 32) scan_issue(A, F, ci0 + n + 2, sl, L + (n & 1) * SC_BUF);
    }
    if (F.wave == 0) {
        float* od = A.out + OUT_DLP + (size_t)(b * NH + h) * DKV * DKV;
#pragma unroll
        for (int blk = 0; blk < 8; ++blk)
#pragma unroll
            for (int r = 0; r < 4; ++r) od[(16 * blk + 4 * fq + r) * DKV + sl * 16 + fr] = S[blk][r];
    }
    asm volatile("s_waitcnt vmcnt(0) lgkmcnt(0)" ::: "memory"); __builtin_amdgcn_s_barrier(); asm volatile("" ::: "memory");
}
__device__ __forceinline__ void delta_sample(const Args& A, Frame& F, int s, int h) {
    const bf16* QC = (const bf16*)(A.ws + WS_RC); const float* BG = (const float*)(A.ws + WS_BG); float* Og = (float*)(A.ws + WS_RE);
    const size_t row = (size_t)MP + s;
    LAS float* qs = (LAS float*)(F.lds + RING_OFF); LAS float* ks = qs + 128; LAS float* red = qs + 256;
    const int dv = F.tid & 127, grp = F.tid >> 7;
    if (F.tid < 128) { qs[F.tid] = bf2f(QC[row * QKVN + h * 128 + F.tid]); ks[F.tid] = bf2f(QC[row * QKVN + 512 + h * 128 + F.tid]); }
    const float v = bf2f(QC[row * QKVN + 1024 + h * 128 + dv]);
    const float beta = BG[row * 8 + h], eg = __expf(BG[row * 8 + 4 + h]);
    const float* S0 = A.in[I_SDELTA] + (size_t)(s * NH + h) * DKV * DKV; float* So = A.out + OUT_DLS + (size_t)(s * NH + h) * DKV * DKV;
    float s0[32];
#pragma unroll
    for (int i = 0; i < 32; ++i) s0[i] = S0[(size_t)(grp * 32 + i) * DKV + dv];
    __syncthreads();
    float part = 0.f;
#pragma unroll
    for (int i = 0; i < 32; ++i) part += ks[grp * 32 + i] * s0[i];
    red[grp * 128 + dv] = part;
    __syncthreads();
    const float kS = (red[dv] + red[128 + dv]) + (red[256 + dv] + red[384 + dv]);
    const float vnew = beta * (v - eg * kS);
    __syncthreads();
    float po = 0.f;
#pragma unroll
    for (int i = 0; i < 32; ++i) { const float sn = eg * s0[i] + ks[grp * 32 + i] * vnew; So[(size_t)(grp * 32 + i) * DKV + dv] = sn; po += qs[grp * 32 + i] * sn; }
    red[grp * 128 + dv] = po;
    __syncthreads();
    if (F.tid < 128) Og[row * 512 + h * 128 + dv] = (red[dv] + red[128 + dv]) + (red[256 + dv] + red[384 + dv]);
    __syncthreads();
}

__device__ __forceinline__ void ogate_phase(const Args& A, Frame& F) {
    const bf16* PB = (const bf16*)(A.ws + WS_RA); bf16* CD = (bf16*)(A.ws + WS_RB); const float* Og = (const float*)(A.ws + WS_RE);
    const int gw = F.vcu * NWAVES + F.wave, NGW = F.G * NWAVES; const int ch0 = 8 * F.lane;
    const f32x4 n0 = *(const f32x4*)(A.in[I_DNN] + (ch0 & 127)), n1 = *(const f32x4*)(A.in[I_DNN] + (ch0 & 127) + 4);
    for (int m = gw; m < MV; m += NGW) {
        const f32x4 o0 = *(const GAS f32x4*)(Og + (size_t)m * 512 + ch0), o1 = *(const GAS f32x4*)(Og + (size_t)m * 512 + ch0 + 4);
        const v4u zz = *(const GAS v4u*)(PB + (size_t)m * PBLD + 2048 + ch0); float z[8]; unpack8(zz, z);
        float ss = (o0[0] * o0[0] + o0[1] * o0[1]) + (o0[2] * o0[2] + o0[3] * o0[3]) + (o1[0] * o1[0] + o1[1] * o1[1]) + (o1[2] * o1[2] + o1[3] * o1[3]);
        ss += __shfl_xor(ss, 1); ss += __shfl_xor(ss, 2); ss += __shfl_xor(ss, 4); ss += __shfl_xor(ss, 8);
        const float rstd = 1.f / sqrtf(ss * (1.f / 128.f) + RMS_EPS);
        float d[8];
#pragma unroll
        for (int i = 0; i < 4; ++i) { d[i] = o0[i] * rstd * n0[i] * silu(z[i]); d[4 + i] = o1[i] * rstd * n1[i] * silu(z[4 + i]); }
        *(GAS v4u*)(CD + (size_t)m * DM + 512 + ch0) = pack8(d);
    }
}

__device__ __forceinline__ void attn_issue(const Args& A, Frame& F, int st, int b, int h, LAS unsigned char* slot) {
    const bf16* KB = (const bf16*)(A.ws + WS_KB); const bf16* VT = (const bf16*)(A.ws + WS_VT);
#pragma unroll
    for (int it = 0; it < 4; ++it) {
        const int idx = it * 512 + F.tid; const bf16* src;
        if (st < 4) { const int r = idx >> 5, p = idx & 31, c = p ^ (r & 15); src = KB + (size_t)(b * NMEM + 64 * st + r) * DM + h * MHD + 8 * c; }
        else { const int r = idx >> 3, p = idx & 7, c = p ^ ((r >> 1) & 7); src = VT + (size_t)(h * MHD + r) * (NB * NMEM) + b * NMEM + 64 * (st - 4) + 8 * c; }
        __builtin_amdgcn_global_load_lds((const unsigned*)src, (LAS unsigned*)(slot + it * 8192 + F.wave * 1024), 16, 0, 0);
    }
}
__device__ __forceinline__ void attn_unit(const Args& A, Frame& F, int rt, int h) {
    using pg8::f32x4;
    const int b = rt >> 4; const int fr = F.lane & 15, fq = F.lane >> 4;
    bf16* Q = (bf16*)(A.ws + WS_RB);
    bf16* qrow = Q + (size_t)(rt * 128 + F.wave * 16 + fr) * DM + h * MHD;
    LAS unsigned char* L = F.lds + RING_OFF;
    bf16x8 qf[8];
#pragma unroll
    for (int ks = 0; ks < 8; ++ks) qf[ks] = *(const GAS bf16x8*)(qrow + 32 * ks + 8 * fq);
    attn_issue(A, F, 0, b, h, L); attn_issue(A, F, 1, b, h, L + 32768);
    f32x4 sacc[16];
#pragma unroll
    for (int st = 0; st < 4; ++st) {
        asm volatile("s_waitcnt vmcnt(4)" ::: "memory");
        __builtin_amdgcn_s_barrier(); asm volatile("" ::: "memory");
        attn_issue(A, F, st + 2, b, h, L + ((st + 2) & 3) * 32768);
        const LAS unsigned char* slot = L + (st & 3) * 32768;
#pragma unroll
        for (int kbl = 0; kbl < 4; ++kbl) { f32x4 acc = (f32x4){0.f, 0.f, 0.f, 0.f}; const int row = 16 * kbl + fr;
#pragma unroll
            for (int ks = 0; ks < 8; ++ks) { const bf16x8 a = *(const LAS bf16x8*)(slot + row * 512 + (((4 * ks + fq) ^ (row & 15)) << 4)); acc = __builtin_amdgcn_mfma_f32_16x16x32_bf16(a, qf[ks], acc, 0, 0, 0); }
            sacc[4 * st + kbl] = acc; }
    }
    float mx = -3.0e38f;
#pragma unroll
    for (int kb = 0; kb < 16; ++kb)
#pragma unroll
        for (int i = 0; i < 4; ++i) mx = fmaxf(mx, sacc[kb][i]);
    mx = fmaxf(mx, __shfl_xor(mx, 16)); mx = fmaxf(mx, __shfl_xor(mx, 32));
    float lsum = 0.f; bf16x8 pb[8];
#pragma unroll
    for (int kb = 0; kb < 16; ++kb)
#pragma unroll
        for (int i = 0; i < 4; ++i) { const float p = __builtin_amdgcn_exp2f(sacc[kb][i] - mx); sacc[kb][i] = p; lsum += p; }
#pragma unroll
    for (int s = 0; s < 8; ++s) pb[s] = pack_pair(sacc[2 * s], sacc[2 * s + 1]);
    lsum += __shfl_xor(lsum, 16); lsum += __shfl_xor(lsum, 32);
    f32x4 oacc[16];
#pragma unroll
    for (int db = 0; db < 16; ++db) oacc[db] = (f32x4){0.f, 0.f, 0.f, 0.f};
#pragma unroll
    for (int st = 4; st < 8; ++st) {
        if (st + 1 < 8) asm volatile("s_waitcnt vmcnt(4)" ::: "memory"); else asm volatile("s_waitcnt vmcnt(0)" ::: "memory");
        __builtin_amdgcn_s_barrier(); asm volatile("" ::: "memory");
        if (st + 2 < 8) attn_issue(A, F, st + 2, b, h, L + ((st + 2) & 3) * 32768);
        const LAS unsigned char* slot = L + (st & 3) * 32768; const int t = st - 4;
#pragma unroll
        for (int db = 0; db < 16; ++db) { const int row = 16 * db + fr; const int sw = (row >> 1) & 7;
#pragma unroll
            for (int s2 = 0; s2 < 2; ++s2) { const int c = 4 * s2 + (fq >> 1);
                const v2u lo = *(const LAS v2u*)(slot + row * 128 + ((c ^ sw) << 4) + 8 * (fq & 1)), hi = *(const LAS v2u*)(slot + row * 128 + (((c + 2) ^ sw) << 4) + 8 * (fq & 1));
                v4u aw; aw.x = lo.x; aw.y = lo.y; aw.z = hi.x; aw.w = hi.y;
                oacc[db] = __builtin_amdgcn_mfma_f32_16x16x32_bf16(__builtin_bit_cast(bf16x8, aw), pb[2 * t + s2], oacc[db], 0, 0, 0); } }
    }
    const float inv = 1.f / lsum;
#pragma unroll
    for (int db = 0; db < 16; ++db) { v2u w; w.x = pk2(oacc[db][0] * inv, oacc[db][1] * inv); w.y = pk2(oacc[db][2] * inv, oacc[db][3] * inv); *(GAS v2u*)(qrow + 16 * db + 4 * fq) = w; }
    LDS_WAIT(); __builtin_amdgcn_s_barrier(); asm volatile("" ::: "memory");
}
__device__ __forceinline__ void attn_sample(const Args& A, Frame& F, int s, int h) {
    bf16* Q = (bf16*)(A.ws + WS_RB); bf16* qrow = Q + (size_t)(MP + s) * DM + h * MHD;
    const float* Kc = A.in[I_CMK] + (size_t)s * NMEM * DM + h * MHD; const float* Vc = A.in[I_CMV] + (size_t)s * NMEM * DM + h * MHD;
    LAS float* pl = (LAS float*)(F.lds + RING_OFF); LAS float* wred = pl + 256; LAS float* ored = pl + 512;
    float q[4]; { const v2u x = *(const GAS v2u*)(qrow + 4 * F.lane); q[0] = bflo(x.x); q[1] = bfhi(x.x); q[2] = bflo(x.y); q[3] = bfhi(x.y); }
    float myscore = 0.f;
#pragma unroll 8
    for (int i = 0; i < 32; ++i) { const f32x4 kv = *(const GAS f32x4*)(Kc + (size_t)(32 * F.wave + i) * DM + 4 * F.lane);
        const float d = wave_sum((kv[0] * q[0] + kv[1] * q[1]) + (kv[2] * q[2] + kv[3] * q[3])); if (F.lane == i) myscore = d; }
    float m = wave_max(F.lane < 32 ? myscore : -3.0e38f);
    if (F.lane == 0) wred[F.wave] = m;
    __syncthreads();
    float gm = wred[0];
#pragma unroll
    for (int i = 1; i < 8; ++i) gm = fmaxf(gm, wred[i]);
    const float p = (F.lane < 32) ? __builtin_amdgcn_exp2f(myscore - gm) : 0.f;
    if (F.lane < 32) pl[32 * F.wave + F.lane] = p;
    const float ws_ = wave_sum(p);
    if (F.lane == 0) wred[8 + F.wave] = ws_;
    __syncthreads();
    float tot = 0.f;
#pragma unroll
    for (int i = 0; i < 8; ++i) tot += wred[8 + i];
    f32x4 acc = (f32x4){0.f, 0.f, 0.f, 0.f};
#pragma unroll 8
    for (int i = 0; i < 32; ++i) { const f32x4 vv = *(const GAS f32x4*)(Vc + (size_t)(32 * F.wave + i) * DM + 4 * F.lane); const float pi = pl[32 * F.wave + i]; acc = acc + vv * pi; }
    *(LAS f32x4*)(ored + F.wave * 256 + 4 * F.lane) = acc;
    __syncthreads();
    if (F.tid < 256) { float o = 0.f;
#pragma unroll
        for (int w = 0; w < 8; ++w) o += ored[w * 256 + F.tid];
        qrow[F.tid] = (bf16)(pk2(o / tot, 0.f) & 0xffffu); }
    __syncthreads();
}

__device__ __forceinline__ void final_norm_phase(const Args& A, Frame& F) {
    const int gw = F.vcu * NWAVES + F.wave, NGW = F.G * NWAVES; const float* ss = (const float*)(F.ctl + CW_SS3);
    f32x4 gn[4];
#pragma unroll
    for (int j = 0; j < 4; ++j) gn[j] = *(const f32x4*)(A.in[I_NF] + 256 * j + 4 * F.lane);
    for (int m = gw; m < MV; m += NGW) {
        GAS f32x4* xr = (GAS f32x4*)(A.out + (size_t)m * DM) + F.lane;
        const float rstd = 1.f / sqrtf(ss[m] * (1.f / DM) + RMS_EPS);
#pragma unroll
        for (int j = 0; j < 4; ++j) { const f32x4 v = xr[64 * j]; xr[64 * j] = v * rstd * gn[j]; }
    }
}

__global__ void __launch_bounds__(NWAVES * 64, 2) hymba_fwd(Args args) {
    extern __shared__ __attribute__((aligned(16))) unsigned char lds[];
    Frame F;
    F.lds = (LAS unsigned char*)lds;
    F.MISC = (volatile LAS unsigned*)(F.lds + MISC_OFF);
    F.tid = threadIdx.x; F.lane = F.tid & 63; F.wave = __builtin_amdgcn_readfirstlane(F.tid >> 6);
    F.G = gridDim.x; { const int bx = blockIdx.x; F.vcu = (F.G % 8 == 0) ? (bx % 8) * (F.G / 8) + bx / 8 : bx; }
    F.ctl = (gu32*)(args.ws + WS_CTL);
    const Args& A = args;
    for (int u = F.tid; u < (LDS_BYTES - LDSCTL_OFF) / 4; u += NWAVES * 64) ((LAS unsigned*)(F.lds + LDSCTL_OFF))[u] = 0u;
    __syncthreads();
#if MK_PER_PHASE
#define GRID_BAR() do { } while (0)
#else
    XcdBarrier bar = xcd_barrier_post((unsigned*)(F.ctl + CW_BAR), F.MISC + 8);
#define GRID_BAR() xcd_barrier(bar)
#endif
#ifndef REPEAT_MASK
#define REPEAT_MASK 0
#endif
#define NREP(k) ((((REPEAT_MASK) >> (k)) & 1) ? 2 : 1)
    float* const SSD = (float*)(F.ctl + 163840);
    const int lo = args.ph_lo, hi = args.ph_hi;
#ifdef ONLY_PH
#define IN(k) ((k) == ONLY_PH && lo <= (k) && (k) < hi)
#else
#define IN(k) (lo <= (k) && (k) < hi)
#endif
#define BOTH(k) (IN(k) && IN((k) + 1))
    unsigned char* ws = args.ws;
    bf16* const RA = (bf16*)(ws + WS_RA); bf16* const RB = (bf16*)(ws + WS_RB); bf16* const RC = (bf16*)(ws + WS_RC);
    float* const X1 = (float*)(ws + WS_RD); bf16* const X1B = (bf16*)(ws + WS_RE); float* const X2 = (float*)(ws + WS_RF);
    float* const SS1 = (float*)(F.ctl + CW_SS1); float* const SS2 = (float*)(F.ctl + CW_SS2); float* const SS3 = (float*)(F.ctl + CW_SS3);

    if (IN(0)) for (int rep = 0; rep < NREP(0); ++rep) { p0_prologue(A, F); if (BOTH(0)) GRID_BAR(); }
    if (IN(1)) for (int rep = 0; rep < NREP(1); ++rep) {
        { pg8::Gemm g{RB, (const bf16*)(ws + WS_WIN), MR, 3072, DM}; pg8::StaticOrder S; S.init(MR, 3072, F.G, (int)blockIdx.x);
          pg8::EpiIn E{RA};
          pg8::gemm_phase<pg8::EpiIn, pg8::StaticOrder, true, true>(F.lds + RING_OFF, g, S, E); }
        { pg8::Gemm g{(const bf16*)(ws + WS_MEMN), (const bf16*)(ws + WS_WMKV), NB * NMEM, 2048, DM}; pg8::StaticOrder S; S.init(NB * NMEM, 2048, F.G, (int)blockIdx.x);
          pg8::EpiKV E{A.out + OUT_MKP, A.out + OUT_MVP, (bf16*)(ws + WS_KB), (bf16*)(ws + WS_VT)};
          pg8::gemm_phase<pg8::EpiKV, pg8::StaticOrder, true, true>(F.lds + RING_OFF, g, S, E); }
        if (BOTH(1)) GRID_BAR();
    }
    if (IN(2)) for (int rep = 0; rep < NREP(2); ++rep) {
        for (int it = F.vcu; it < 256 + DEC; it += F.G) { if (it < 256) conv_tile(A, F, it >> 5, it & 31); else conv_sample(A, F, it - 256); }
        if (BOTH(2)) GRID_BAR();
    }
    if (IN(3)) for (int rep = 0; rep < NREP(3); ++rep) {
        for (int ci = F.vcu; ci < NCHUNK; ci += F.G) d1_chunk(A, F, ci);
        if (BOTH(3)) GRID_BAR();
    }
    if (IN(4)) for (int rep = 0; rep < NREP(4); ++rep) {
        for (int u = F.vcu; u < 256; u += F.G) scan_unit(A, F, u >> 5, (u >> 3) & 3, u & 7);
        for (int it = F.vcu; it < DEC * NH; it += F.G) delta_sample(A, F, it >> 2, it & 3);
        if (BOTH(4)) GRID_BAR();
    }
    if (IN(5)) for (int rep = 0; rep < NREP(5); ++rep) { ogate_phase(A, F); if (BOTH(5)) GRID_BAR(); }
    if (IN(6)) for (int rep = 0; rep < NREP(6); ++rep) {
        pg8::Gemm g{RB, (const bf16*)(ws + WS_WOUT), MR, DM, DM}; pg8::StaticOrder S; S.init(MR, DM, F.G, (int)blockIdx.x);
        pg8::EpiRes<true> E{A.in[I_XP], A.in[I_XS], MV, MR, X1, X1B, rep ? SSD : SS1};
        pg8::gemm_phase<pg8::EpiRes<true>, pg8::StaticOrder, true, true>(F.lds + RING_OFF, g, S, E);
        if (BOTH(6)) GRID_BAR();
    }
    if (IN(7)) for (int rep = 0; rep < NREP(7); ++rep) {
        pg8::Gemm g{X1B, (const bf16*)(ws + WS_WMQ), MR, DM, DM}; pg8::StaticOrder S; S.init(MR, DM, F.G, (int)blockIdx.x);
        pg8::EpiQ E{RB, SS1, ATT_C2};
        pg8::gemm_phase<pg8::EpiQ, pg8::StaticOrder, true, true>(F.lds + RING_OFF, g, S, E);
        if (BOTH(7)) GRID_BAR();
    }
    if (IN(8)) {
        for (int u = F.vcu; u < 512; u += F.G) { const int bh = u >> 4; attn_unit(A, F, (bh >> 2) * 16 + (u & 15), bh & 3); }
        for (int it = F.vcu; it < DEC * NH; it += F.G) attn_sample(A, F, it >> 2, it & 3);
        if (BOTH(8)) GRID_BAR();
    }
    if (IN(9)) for (int rep = 0; rep < NREP(9); ++rep) {
        pg8::Gemm g{RB, (const bf16*)(ws + WS_WMO), MR, DM, DM}; pg8::StaticOrder S; S.init(MR, DM, F.G, (int)blockIdx.x);
        pg8::EpiRes<true> E{X1, X1 + (size_t)MP * DM, MR, MR, X2, RC, rep ? SSD : SS2};
        pg8::gemm_phase<pg8::EpiRes<true>, pg8::StaticOrder, true, true>(F.lds + RING_OFF, g, S, E);
        if (BOTH(9)) GRID_BAR();
    }
    if (IN(10)) for (int rep = 0; rep < NREP(10); ++rep) {
        pg8::Gemm g{RC, (const bf16*)(ws + WS_WGU), MR, 2 * DFF, DM}; pg8::StaticOrder S; S.init(MR, 2 * DFF, F.G, (int)blockIdx.x);
        pg8::EpiGU E{RA, SS2};
        pg8::gemm_phase<pg8::EpiGU, pg8::StaticOrder, true, true>(F.lds + RING_OFF, g, S, E);
        if (BOTH(10)) GRID_BAR();
    }
    if (IN(11)) for (int rep = 0; rep < NREP(11); ++rep) {
        pg8::Gemm g{RA, (const bf16*)(ws + WS_WDN), MR, DM, DFF}; pg8::StaticOrder S; S.init(MR, DM, F.G, (int)blockIdx.x);
        pg8::EpiRes<false> E{X2, X2 + (size_t)MP * DM, MR, MV, A.out, nullptr, rep ? SSD : SS3};
        pg8::gemm_phase<pg8::EpiRes<false>, pg8::StaticOrder, true, true>(F.lds + RING_OFF, g, S, E);
        if (BOTH(11)) GRID_BAR();
    }
    if (IN(12)) final_norm_phase(A, F);
#undef IN
#undef BOTH
}

extern "C" void kernel_launch(void* const* d_in, const int* in_sizes, int n_in, void* d_out, int out_size, void* d_ws, size_t ws_size, hipStream_t stream) {
    static int grid = 0;
    if (grid == 0) {
        if (n_in != 30 || in_sizes[0] != MP * DM || (size_t)out_size != OUT_END || ws_size < WS_END) {
            fprintf(stderr, "kernel_launch: unexpected shapes: n_in %d, in0 %d, out %d, ws %zu (need >= %zu); nothing launched\n", n_in, n_in > 0 ? in_sizes[0] : -1, out_size, ws_size, (size_t)WS_END); grid = -1; return; }
        int dev = 0, cus = 0, per_cu = 0;
        if (hipGetDevice(&dev) != hipSuccess || hipDeviceGetAttribute(&cus, hipDeviceAttributeMultiprocessorCount, dev) != hipSuccess) { fprintf(stderr, "kernel_launch: device query failed\n"); grid = -1; return; }
        if (hipFuncSetAttribute((const void*)hymba_fwd, hipFuncAttributeMaxDynamicSharedMemorySize, LDS_BYTES) != hipSuccess) { fprintf(stderr, "kernel_launch: hipFuncSetAttribute failed\n"); grid = -1; return; }
        if (hipOccupancyMaxActiveBlocksPerMultiprocessor(&per_cu, (const void*)hymba_fwd, NWAVES * 64, LDS_BYTES) != hipSuccess || per_cu < 1)
            fprintf(stderr, "kernel_launch: note: occupancy query reports %d workgroups per CU\n", per_cu);
        (void)hipGetLastError();
        grid = cus;
    }
    if (grid < 0) return;
    if (hipMemsetAsync((char*)d_ws + WS_CTL, 0, CTL_ZERO_BYTES, stream) != hipSuccess) { fprintf(stderr, "kernel_launch: hipMemsetAsync failed\n"); return; }
    Args a{};
    for (int i = 0; i < 30; ++i) a.in[i] = (const float*)d_in[i];
    a.out = (float*)d_out; a.ws = (unsigned char*)d_ws;
#if MK_PER_PHASE
    for (int ph = 0; ph < N_PHASES; ++ph) { a.ph_lo = ph; a.ph_hi = ph + 1; a.li = 0;
        hipLaunchKernelGGL(hymba_fwd, dim3(grid), dim3(NWAVES * 64), LDS_BYTES, stream, a); }
#else
    a.ph_lo = 0; a.ph_hi = N_PHASES; a.li = 0;
    hipLaunchKernelGGL(hymba_fwd, dim3(grid), dim3(NWAVES * 64), LDS_BYTES, stream, a);
#endif
    const hipError_t le = hipPeekAtLastError();
    if (le != hipSuccess) fprintf(stderr, "kernel_launch: launch failed: %s\n", hipGetErrorName(le));
}
```

```cpp
#include <hip/hip_runtime.h>
#include <cstdio>
#include <cstdint>
#define MK_PER_PHASE 0
namespace pg8 {
#define PG8_LAS __attribute__((address_space(3)))
typedef unsigned short bf16_t;
typedef short bf16x8 __attribute__((ext_vector_type(8)));
typedef float f32x4 __attribute__((ext_vector_type(4)));
typedef unsigned u32x4 __attribute__((ext_vector_type(4)));
constexpr int BM = 256, BK = 64, HALF = 128, HTB = HALF * BK * 2  , STAGE_BYTES = 8 * HTB, NXCD = 8, WGM = 8;

__host__ __device__ __forceinline__ int lds_byte(int r, int c) { const int st = (r >> 4) * 2 + (c >> 5), rr = r & 15, cc = c & 31, ob = rr * 64 + cc * 2; return st * 1024 + (ob ^ (((ob >> 9) & 1) << 5)); }
__host__ __device__ __forceinline__ void stage_rc(int b, int& R, int& C) { const int st = b / 1024, sb = b % 1024, swz = sb ^ (((sb >> 9) & 1) << 5); R = (st >> 1) * 16 + swz / 64; C = (st & 1) * 32 + (swz % 64) / 2; }
__host__ __device__ __forceinline__ int perm32(int rho) { const int n = rho >> 4, i = rho & 15; return 8 * (i >> 2) + 4 * n + (i & 3); }

struct Unit { int pm, pn; };
struct Gemm { const bf16_t* A; const bf16_t* Bt; int M, N, K; };

struct StaticOrder {
    int nM, nN, nwg, G, c;
    __host__ __device__ void init(int M, int N, int G_, int c_) { nM = M / BM; nN = N / BM; nwg = nM * nN; G = G_; c = c_; }
    __host__ __device__ bool next(int i, Unit& u) const {
        const long L = (long)i * G + c; if (L >= nwg) return false;
        int wgid = (int)L; { const int q = nwg / NXCD, r = nwg % NXCD, xcd = wgid % NXCD, off = wgid / NXCD; wgid = (xcd < r ? xcd * (q + 1) : r * (q + 1) + (xcd - r) * q) + off; }
        const int nig = WGM * nN, gid = wgid / nig, fm = gid * WGM, gsz = (nM - fm) < WGM ? (nM - fm) : WGM;
        u.pm = fm + ((wgid % nig) % gsz); u.pn = (wgid % nig) / gsz; return true;
    }
    __device__ __forceinline__ void a_ready(const Unit&) const {}
    __device__ __forceinline__ void done(const Unit&) const {}
};

__device__ __forceinline__ unsigned cvt_pk_bf16(float lo, float hi) { unsigned r; asm volatile("v_cvt_pk_bf16_f32 %0, %1, %2" : "=v"(r) : "v"(lo), "v"(hi)); return r; }
typedef float f32x2_t __attribute__((ext_vector_type(2))); typedef __bf16 bf16x2_t __attribute__((ext_vector_type(2)));
__device__ __forceinline__ unsigned pk2(float lo, float hi) { f32x2_t v = {lo, hi}; bf16x2_t b = __builtin_convertvector(v, bf16x2_t); return __builtin_bit_cast(unsigned, b); }
__device__ __forceinline__ float sigm(float x) { return __builtin_amdgcn_rcpf(1.f + __expf(-x)); }
__device__ __forceinline__ float silu(float x) { return x * __builtin_amdgcn_rcpf(1.f + __expf(-x)); }
__device__ __forceinline__ u32x4 pk8(const f32x4& a, const f32x4& b) { u32x4 w; w.x = pk2(a[0], a[1]); w.y = pk2(a[2], a[3]); w.z = pk2(b[0], b[1]); w.w = pk2(b[2], b[3]); return w; }
constexpr int PBLD = 2560;
constexpr int MPROMPT = 16384;
constexpr float RMS_EPS = 1e-6f;

struct EpiIn {
    static constexpr bool PERM = true, AFTER_DRAIN = false;
    bf16_t* PB;
    __device__ __forceinline__ void operator()(const f32x4 (&acc)[2][2][4][2], const Unit& u, int wr, int wc, int fr, int fq) const {
        const int row0 = u.pm * BM + wr * 64 + fr;
        if (u.pn < 4) {
            const int ch0 = u.pn * 128 + wc * 32 + 8 * fq;
#pragma unroll
            for (int ai = 0; ai < 2; ++ai)
#pragma unroll
                for (int m = 0; m < 4; ++m) {
                    bf16_t* rowp = PB + (size_t)(row0 + ai * HALF + m * 16) * PBLD + ch0;
                    f32x4 v0, v1;
#pragma unroll
                    for (int i = 0; i < 4; ++i) { v0[i] = acc[ai][0][m][0][i] * sigm(acc[ai][1][m][0][i]); v1[i] = acc[ai][0][m][1][i] * sigm(acc[ai][1][m][1][i]); }
                    *(u32x4*)rowp = pk8(v0, v1);
                }
        } else {
            const int col0 = u.pn * BM - 512 + wc * 32 + 8 * fq;
#pragma unroll
            for (int ai = 0; ai < 2; ++ai)
#pragma unroll
                for (int m = 0; m < 4; ++m) {
                    bf16_t* rowp = PB + (size_t)(row0 + ai * HALF + m * 16) * PBLD + col0;
#pragma unroll
                    for (int bj = 0; bj < 2; ++bj) *(u32x4*)(rowp + bj * HALF) = pk8(acc[ai][bj][m][0], acc[ai][bj][m][1]);
                }
        }
    }
};

struct EpiKV {
    static constexpr bool PERM = true, AFTER_DRAIN = false;
    float* outK; float* outV; bf16_t* KB; bf16_t* VT;
    __device__ __forceinline__ void operator()(const f32x4 (&acc)[2][2][4][2], const Unit& u, int wr, int wc, int fr, int fq) const {
        const int row0 = u.pm * BM + wr * 64 + fr;
        const bool isv = u.pn >= 4;
        const int c0 = (isv ? u.pn - 4 : u.pn) * BM + wc * 32 + 8 * fq;
        float* outp = isv ? outV : outK;
#pragma unroll
        for (int ai = 0; ai < 2; ++ai)
#pragma unroll
            for (int m = 0; m < 4; ++m) {
                const int row = row0 + ai * HALF + m * 16;
#pragma unroll
                for (int bj = 0; bj < 2; ++bj) {
                    const int col = c0 + bj * HALF;
                    const f32x4 a = acc[ai][bj][m][0], b = acc[ai][bj][m][1];
                    *(f32x4*)(outp + (size_t)row * 1024 + col) = a; *(f32x4*)(outp + (size_t)row * 1024 + col + 4) = b;
                    const u32x4 w = pk8(a, b);
                    if (!isv) *(u32x4*)(KB + (size_t)row * 1024 + col) = w;
                    else {
                        bf16_t* vp = VT + (size_t)col * 2048 + row;
                        vp[0 * 2048] = (bf16_t)(w.x & 0xffffu); vp[1 * 2048] = (bf16_t)(w.x >> 16); vp[2 * 2048] = (bf16_t)(w.y & 0xffffu); vp[3 * 2048] = (bf16_t)(w.y >> 16);
                        vp[4 * 2048] = (bf16_t)(w.z & 0xffffu); vp[5 * 2048] = (bf16_t)(w.z >> 16); vp[6 * 2048] = (bf16_t)(w.w & 0xffffu); vp[7 * 2048] = (bf16_t)(w.w >> 16);
                    }
                }
            }
    }
};

template <bool WRITE_BF> struct EpiRes {
    static constexpr bool PERM = true, AFTER_DRAIN = false;
    const float* base_main; const float* base_tail;
    int load_limit, store_limit;
    float* out; bf16_t* outb; float* ss;
    __device__ __forceinline__ void operator()(const f32x4 (&acc)[2][2][4][2], const Unit& u, int wr, int wc, int fr, int fq) const {
        const int row0 = u.pm * BM + wr * 64 + fr; const int col0 = u.pn * BM + wc * 32 + 8 * fq;
        const float* bp = (u.pm >= 64) ? base_tail - (size_t)MPROMPT * 1024 : base_main;
#pragma unroll
        for (int ai = 0; ai < 2; ++ai)
#pragma unroll
            for (int m = 0; m < 4; ++m) {
                const int row = row0 + ai * HALF + m * 16; const size_t off = (size_t)row * 1024 + col0;
                float s = 0.f;
#pragma unroll
                for (int bj = 0; bj < 2; ++bj) {
                    f32x4 b0 = (f32x4){0.f, 0.f, 0.f, 0.f}, b1 = b0;
                    if (row < load_limit) { b0 = *(const f32x4*)(bp + off + bj * HALF); b1 = *(const f32x4*)(bp + off + bj * HALF + 4); }
                    const f32x4 v0 = acc[ai][bj][m][0] + b0, v1 = acc[ai][bj][m][1] + b1;
                    s += (v0[0] * v0[0] + v0[1] * v0[1]) + (v0[2] * v0[2] + v0[3] * v0[3]) + (v1[0] * v1[0] + v1[1] * v1[1]) + (v1[2] * v1[2] + v1[3] * v1[3]);
                    if (row < store_limit) { *(f32x4*)(out + off + bj * HALF) = v0; *(f32x4*)(out + off + bj * HALF + 4) = v1; }
                    if (WRITE_BF) *(u32x4*)(outb + off + bj * HALF) = pk8(v0, v1);
                }
                s += __shfl_xor(s, 16); s += __shfl_xor(s, 32);
                if (fq == 0) atomicAdd(ss + row, s);
            }
    }
};

struct EpiQ {
    static constexpr bool PERM = true, AFTER_DRAIN = false;
    bf16_t* Q; const float* ss; float c2;
    __device__ __forceinline__ void operator()(const f32x4 (&acc)[2][2][4][2], const Unit& u, int wr, int wc, int fr, int fq) const {
        const int row0 = u.pm * BM + wr * 64 + fr; const int col0 = u.pn * BM + wc * 32 + 8 * fq;
#pragma unroll
        for (int ai = 0; ai < 2; ++ai)
#pragma unroll
            for (int m = 0; m < 4; ++m) {
                const int row = row0 + ai * HALF + m * 16;
                const float rs = __builtin_amdgcn_rsqf(ss[row] * (1.f / 1024.f) + RMS_EPS) * c2;
#pragma unroll
                for (int bj = 0; bj < 2; ++bj) *(u32x4*)(Q + (size_t)row * 1024 + col0 + bj * HALF) = pk8(acc[ai][bj][m][0] * rs, acc[ai][bj][m][1] * rs);
            }
    }
};

struct EpiGU {
    static constexpr bool PERM = true, AFTER_DRAIN = false;
    bf16_t* T; const float* ss;
    __device__ __forceinline__ void operator()(const f32x4 (&acc)[2][2][4][2], const Unit& u, int wr, int wc, int fr, int fq) const {
        const int row0 = u.pm * BM + wr * 64 + fr; const int ch0 = u.pn * 128 + wc * 32 + 8 * fq;
#pragma unroll
        for (int ai = 0; ai < 2; ++ai)
#pragma unroll
            for (int m = 0; m < 4; ++m) {
                const int row = row0 + ai * HALF + m * 16;
                const float rs = __builtin_amdgcn_rsqf(ss[row] * (1.f / 1024.f) + RMS_EPS);
                f32x4 v0, v1;
#pragma unroll
                for (int i = 0; i < 4; ++i) { v0[i] = silu(acc[ai][0][m][0][i] * rs) * (acc[ai][1][m][0][i] * rs); v1[i] = silu(acc[ai][0][m][1][i] * rs) * (acc[ai][1][m][1][i] * rs); }
                *(u32x4*)(T + (size_t)row * 2816 + ch0) = pk8(v0, v1);
            }
    }
};

template <class Epi, class Sched, bool ALIGN_EPI = false, bool SP2 = false>
__device__ __forceinline__ void gemm_phase(PG8_LAS unsigned char* lds, const Gemm g, const Sched& S, const Epi& E) {
    const int tid = threadIdx.x, wid = __builtin_amdgcn_readfirstlane(tid >> 6), lane = tid & 63, wr = wid >> 2, wc = wid & 3, fr = lane & 15, fq = lane >> 4;
    const int K = g.K, nt = K / BK;
    unsigned voffA[2], voffB[2];
#pragma unroll
    for (int i = 0; i < 2; ++i) { int R, C; stage_rc(tid * 16 + i * 8192, R, C); const int Rb = Epi::PERM ? ((R & ~31) + perm32(R & 31)) : R;
        voffA[i] = (unsigned)(R * K + C) * 2u; voffB[i] = (unsigned)(Rb * K + C) * 2u; }
    const size_t kstep = (size_t)(BK * 2);
    const size_t hstep = (size_t)HALF * K * 2;
    const size_t tstep = 2 * hstep;
    const unsigned ldsw = (unsigned)wid * 1024u;
    const int aoff = lds_byte(wr * 64 + fr, fq * 8), boff = lds_byte(wc * 32 + fr, fq * 8);
#define PG8_SA(b, h) (((b) * 2 + (h)) * HTB)
#define PG8_SB(b, h) ((4 + (b) * 2 + (h)) * HTB)
#define PG8_STAGE(bufoff, gbase, voff) do { _Pragma("unroll") for (int _i = 0; _i < 2; ++_i) \
        __builtin_amdgcn_global_load_lds((const unsigned*)((const char*)(gbase) + (voff)[_i]), (PG8_LAS unsigned*)(lds + (bufoff) + ldsw + _i * 8192), 16, 0, 0); } while (0)
#define PG8_LDA(dst, b, h) do { _Pragma("unroll") for (int m = 0; m < 4; ++m) _Pragma("unroll") for (int k = 0; k < 2; ++k) dst[m][k] = *(const PG8_LAS bf16x8*)(lds + PG8_SA(b, h) + aoff + m * 2048 + k * 1024); } while (0)
#define PG8_LDB(dst, b, h) do { _Pragma("unroll") for (int n = 0; n < 2; ++n) _Pragma("unroll") for (int k = 0; k < 2; ++k) dst[n][k] = *(const PG8_LAS bf16x8*)(lds + PG8_SB(b, h) + boff + n * 2048 + k * 1024); } while (0)
#define PG8_MMA(ai, bj, At, Bt) do { __builtin_amdgcn_s_setprio(1); _Pragma("unroll") for (int m = 0; m < 4; ++m) _Pragma("unroll") for (int n = 0; n < 2; ++n) _Pragma("unroll") for (int k = 0; k < 2; ++k) \
        acc[ai][bj][m][n] = __builtin_amdgcn_mfma_f32_16x16x32_bf16(Bt[n][k], At[m][k], acc[ai][bj][m][n], 0, 0, 0); __builtin_amdgcn_s_setprio(0); } while (0)
#define PG8_WAIT_V(n) asm volatile("s_waitcnt vmcnt(" #n ")" ::: "memory")
#define PG8_WAIT_L(n) asm volatile("s_waitcnt lgkmcnt(" #n ")" ::: "memory")
#define PG8_BAR __builtin_amdgcn_s_barrier()
#define PG8_SCHED __builtin_amdgcn_sched_barrier(0)
    Unit cur, nxt; int ui = 0;
    if (!S.next(0, cur)) return;
    f32x4 acc[2][2][4][2];
#pragma unroll
    for (int a = 0; a < 2; ++a)
#pragma unroll
        for (int b = 0; b < 2; ++b)
#pragma unroll
            for (int m = 0; m < 4; ++m)
#pragma unroll
                for (int n = 0; n < 2; ++n) acc[a][b][m][n] = (f32x4){0.f, 0.f, 0.f, 0.f};
    bf16x8 At[4][2], B0[2][2], B1[2][2];
    const char* cA = (const char*)g.A + (size_t)cur.pm * tstep; const char* cB = (const char*)g.Bt + (size_t)cur.pn * tstep;
    S.a_ready(cur);
    if constexpr (SP2) {
        PG8_STAGE(PG8_SB(0, 0), cB, voffB); PG8_STAGE(PG8_SB(0, 1), cB + hstep, voffB); PG8_STAGE(PG8_SA(0, 0), cA, voffA); PG8_STAGE(PG8_SA(0, 1), cA + hstep, voffA);
        if (wr == 1) PG8_BAR;
        PG8_WAIT_V(2); PG8_BAR;
        PG8_STAGE(PG8_SB(1, 0), cB + kstep, voffB); PG8_STAGE(PG8_SA(1, 0), cA + kstep, voffA); PG8_STAGE(PG8_SB(1, 1), cB + hstep + kstep, voffB);
        PG8_WAIT_V(6); PG8_BAR;
    } else {
        PG8_STAGE(PG8_SB(0, 0), cB, voffB); PG8_STAGE(PG8_SA(0, 0), cA, voffA); PG8_STAGE(PG8_SB(0, 1), cB + hstep, voffB); PG8_STAGE(PG8_SA(0, 1), cA + hstep, voffA);
        if (wr == 1) PG8_BAR;
        PG8_WAIT_V(4); PG8_BAR;
        PG8_STAGE(PG8_SB(1, 0), cB + kstep, voffB); PG8_STAGE(PG8_SA(1, 0), cA + kstep, voffA); PG8_STAGE(PG8_SB(1, 1), cB + hstep + kstep, voffB);
        PG8_WAIT_V(6); PG8_BAR;
    }
    for (;;) {
        const bool has_next = S.next(ui + 1, nxt);
        const char* nA = has_next ? (const char*)g.A + (size_t)nxt.pm * tstep : cA; const char* nB = has_next ? (const char*)g.Bt + (size_t)nxt.pn * tstep : cB;
        for (int t = 0; t < nt; t += 2) {
            const bool last = (t == nt - 2);
            const char* a1 = cA + (size_t)(t + 1) * kstep;
            const char* a2 = last ? nA : cA + (size_t)(t + 2) * kstep; const char* b2 = last ? nB : cB + (size_t)(t + 2) * kstep;
            const char* a3 = a2 + kstep; const char* b3 = b2 + kstep;
            if (last && has_next) S.a_ready(nxt);
            if constexpr (SP2) {
            PG8_LDB(B0, 0, 0); PG8_LDB(B1, 0, 1); PG8_SCHED; PG8_LDA(At, 0, 0); PG8_STAGE(PG8_SA(1, 1), a1 + hstep, voffA);
            PG8_WAIT_V(8); PG8_WAIT_L(0); PG8_BAR; PG8_MMA(0, 0, At, B0); PG8_MMA(0, 1, At, B1); PG8_BAR; PG8_SCHED;
            PG8_LDA(At, 0, 1); PG8_STAGE(PG8_SB(0, 0), b2, voffB); PG8_STAGE(PG8_SB(0, 1), b2 + hstep, voffB); PG8_STAGE(PG8_SA(0, 0), a2, voffA);
            PG8_WAIT_V(8); PG8_WAIT_L(0); PG8_BAR; PG8_MMA(1, 0, At, B0); PG8_MMA(1, 1, At, B1); PG8_BAR; PG8_SCHED;
            PG8_LDB(B0, 1, 0); PG8_LDB(B1, 1, 1); PG8_SCHED; PG8_LDA(At, 1, 0); PG8_STAGE(PG8_SA(0, 1), a2 + hstep, voffA);
            PG8_WAIT_V(8); PG8_WAIT_L(0); PG8_BAR; PG8_MMA(0, 0, At, B0); PG8_MMA(0, 1, At, B1); PG8_BAR; PG8_SCHED;
            PG8_LDA(At, 1, 1); PG8_STAGE(PG8_SB(1, 0), b3, voffB); PG8_STAGE(PG8_SB(1, 1), b3 + hstep, voffB); PG8_STAGE(PG8_SA(1, 0), a3, voffA);
            PG8_WAIT_V(8); PG8_WAIT_L(0); PG8_BAR; PG8_MMA(1, 0, At, B0); PG8_MMA(1, 1, At, B1); PG8_BAR; PG8_SCHED;
            } else {
            PG8_LDB(B0, 0, 0); PG8_SCHED; PG8_LDA(At, 0, 0); PG8_STAGE(PG8_SA(1, 1), a1 + hstep, voffA);
            PG8_WAIT_L(8); PG8_BAR; PG8_WAIT_L(0); PG8_MMA(0, 0, At, B0); PG8_BAR; PG8_SCHED;
            PG8_LDB(B1, 0, 1); PG8_STAGE(PG8_SB(0, 0), b2, voffB);
            PG8_BAR; PG8_WAIT_L(0); PG8_MMA(0, 1, At, B1); PG8_BAR;
            PG8_LDA(At, 0, 1); PG8_STAGE(PG8_SA(0, 0), a2, voffA);
            PG8_BAR; PG8_WAIT_L(0); PG8_MMA(1, 0, At, B0); PG8_BAR; PG8_SCHED;
            PG8_STAGE(PG8_SB(0, 1), b2 + hstep, voffB);
            PG8_WAIT_V(6); PG8_BAR; PG8_MMA(1, 1, At, B1); PG8_BAR;
            PG8_LDB(B0, 1, 0); PG8_SCHED; PG8_LDA(At, 1, 0); PG8_STAGE(PG8_SA(0, 1), a2 + hstep, voffA);
            PG8_WAIT_L(8); PG8_BAR; PG8_WAIT_L(0); PG8_MMA(0, 0, At, B0); PG8_BAR; PG8_SCHED;
            PG8_LDB(B1, 1, 1); PG8_STAGE(PG8_SB(1, 0), b3, voffB);
            PG8_BAR; PG8_WAIT_L(0); PG8_MMA(0, 1, At, B1); PG8_BAR;
            PG8_LDA(At, 1, 1); PG8_STAGE(PG8_SA(1, 0), a3, voffA);
            PG8_BAR; PG8_WAIT_L(0); PG8_MMA(1, 0, At, B0); PG8_BAR; PG8_SCHED;
            PG8_STAGE(PG8_SB(1, 1), b3 + hstep, voffB);
            PG8_WAIT_V(6); PG8_BAR; PG8_MMA(1, 1, At, B1); PG8_BAR;
            }
        }
        if constexpr (ALIGN_EPI) { if (wr == 0) PG8_BAR; }
        if constexpr (!Epi::AFTER_DRAIN) { E(acc, cur, wr, wc, fr, fq); S.done(cur); }
        if (!has_next) break;
#pragma unroll
        for (int a = 0; a < 2; ++a)
#pragma unroll
            for (int b = 0; b < 2; ++b)
#pragma unroll
                for (int m = 0; m < 4; ++m)
#pragma unroll
                    for (int n = 0; n < 2; ++n) acc[a][b][m][n] = (f32x4){0.f, 0.f, 0.f, 0.f};
        cur = nxt; cA = nA; cB = nB; ++ui;
        if constexpr (ALIGN_EPI) { if (wr == 1) PG8_BAR; }
    }
    PG8_WAIT_V(0);
    if constexpr (!ALIGN_EPI) { if (wr == 0) PG8_BAR; }
    PG8_BAR;
    if constexpr (Epi::AFTER_DRAIN) { E.fused(acc, cur, wr, wc, fr, fq, lds, wid, lane); S.done(cur); }
#undef PG8_SA
#undef PG8_SB
#undef PG8_STAGE
#undef PG8_LDA
#undef PG8_LDB
#undef PG8_MMA
#undef PG8_WAIT_V
#undef PG8_WAIT_L
#undef PG8_BAR
#undef PG8_SCHED
}
}

constexpr int NWAVES = 8;
#ifndef MK_PER_PHASE
#define MK_PER_PHASE 0
#endif
constexpr int N_PHASES = 13;

constexpr int DM = 1024, NB = 8, SEQ = 2048, MP = NB * SEQ  , DEC = 128, MV = MP + DEC  , MR = 16640  ;
constexpr int CC = 512, CW = 31, NH = 4, DKV = 128, QKVN = 1536, NMEM = 256, MHD = 256, DFF = 2816, INC = 3080;
constexpr int PBLD = pg8::PBLD;
constexpr int NCHUNK = NB * NH * 32;
constexpr float RMS_EPS = 1e-6f;
constexpr float ATT_C2 = 0.0625f * 1.4426950408889634f;

constexpr size_t OUT_YP = 0, OUT_YS = 16777216, OUT_CONVP = 16908288, OUT_SCP = 17031168, OUT_DLP = 17068032, OUT_MKP = 17592320, OUT_MVP = 19689472,
                 OUT_CONVS = 21786624, OUT_SCS = 23752704, OUT_DLS = 24342528, OUT_END = 32731136;

constexpr size_t MiB = 1u << 20;
constexpr size_t WS_CTL = 0, CTL_ZERO_BYTES = 1 * MiB;
constexpr size_t WS_WIN = 1 * MiB, WS_WOUT = 7 * MiB, WS_WMQ = 9 * MiB, WS_WMKV = 11 * MiB, WS_WMO = 15 * MiB, WS_WGU = 17 * MiB, WS_WDN = 28 * MiB;
constexpr size_t WS_BG = 34 * MiB, WS_MEMN = 35 * MiB, WS_KB = 39 * MiB, WS_VT = 43 * MiB, WS_GL = 47 * MiB;
constexpr size_t WS_RA = 48 * MiB;
constexpr size_t WS_RB = 138 * MiB;
constexpr size_t WS_RC = 171 * MiB;
constexpr size_t WS_RD = 220 * MiB;
constexpr size_t WS_U = WS_RD, WS_W = 252 * MiB, WS_QG = 268 * MiB, WS_KDT = 284 * MiB, WS_QK = 300 * MiB;
constexpr size_t WS_RE = 308 * MiB;
constexpr size_t WS_RF = 341 * MiB;
constexpr size_t WS_END = 406 * MiB;
constexpr int CW_TMO = 0, CW_CODE = 1, CW_BAR = 4096, CW_SS1 = 65536, CW_SS2 = 98304, CW_SS3 = 131072;

constexpr int RING_OFF = 0, RING_BYTES = 143360;
constexpr int LDSCTL_OFF = RING_BYTES, MISC_OFF = LDSCTL_OFF + 320;
constexpr int LDS_BYTES = 147456;

#define GAS __attribute__((address_space(1)))
#define LAS __attribute__((address_space(3)))
typedef unsigned short bf16;
typedef unsigned v4u __attribute__((ext_vector_type(4)));
typedef unsigned v2u __attribute__((ext_vector_type(2)));
typedef float f32x4 __attribute__((ext_vector_type(4)));
typedef float f32x16 __attribute__((ext_vector_type(16)));
typedef short bf16x8 __attribute__((ext_vector_type(8)));
typedef GAS unsigned gu32;
#define RLX_AGENT __ATOMIC_RELAXED, __HIP_MEMORY_SCOPE_AGENT
#define LDS_WAIT() asm volatile("s_waitcnt lgkmcnt(0)" ::: "memory")
#define VM_WAIT() asm volatile("s_waitcnt vmcnt(0)" ::: "memory")
using pg8::pk2; using pg8::silu; using pg8::sigm;
__device__ __forceinline__ float bf2f(unsigned b) { return __uint_as_float(b << 16); }
__device__ __forceinline__ float bflo(unsigned w) { return __uint_as_float(w << 16); }
__device__ __forceinline__ float bfhi(unsigned w) { return __uint_as_float(w & 0xffff0000u); }
__device__ __forceinline__ void unpack8(const v4u& w, float (&f)[8]) { f[0] = bflo(w.x); f[1] = bfhi(w.x); f[2] = bflo(w.y); f[3] = bfhi(w.y); f[4] = bflo(w.z); f[5] = bfhi(w.z); f[6] = bflo(w.w); f[7] = bfhi(w.w); }
__device__ __forceinline__ v4u pack8(const float (&f)[8]) { v4u w; w.x = pk2(f[0], f[1]); w.y = pk2(f[2], f[3]); w.z = pk2(f[4], f[5]); w.w = pk2(f[6], f[7]); return w; }
__device__ __forceinline__ float wave_sum(float v) {
#pragma unroll
    for (int o = 1; o < 64; o <<= 1) v += __shfl_xor(v, o);
    return v;
}
__device__ __forceinline__ float wave_max(float v) {
#pragma unroll
    for (int o = 1; o < 64; o <<= 1) v = fmaxf(v, __shfl_xor(v, o));
    return v;
}

#define XB_TMO      128
#define XB_XCNT(j)  (256  + 64 * (j))
#define XB_XSUB(j)  (1280 + 64 * (j))
#define XB_XGEN(j)  (2304 + 64 * (j))
#define XB_TOP      3328
#define XB_TOPGEN   3392
#define XCD_BAR_WORDS 3456
#define XB_SPIN_CAP (1u << 18)

__device__ __forceinline__ unsigned xb_ld(unsigned* p)              { return __hip_atomic_load(p, __ATOMIC_RELAXED, __HIP_MEMORY_SCOPE_AGENT); }
__device__ __forceinline__ unsigned xb_add(unsigned* p, unsigned v) { return __hip_atomic_fetch_add(p, v, __ATOMIC_RELAXED, __HIP_MEMORY_SCOPE_AGENT); }
__device__ __forceinline__ unsigned xb_xcc_id() { return (unsigned)__builtin_amdgcn_s_getreg((3 << 11) | 20) & 0xFu; }
#define XB_SPIN(cond, bar) do { unsigned _sp = 0; while (cond) { __builtin_amdgcn_s_sleep(1); \
    if ((++_sp & 255u) == 0u) { if (xb_ld(&(bar)[XB_TMO])) break; if (_sp > XB_SPIN_CAP) { atomicAdd(&(bar)[XB_TMO], 1u); break; } } } } while (0)

struct XcdBarrier {
    unsigned* bar; unsigned x;
    volatile LAS unsigned* st;
};

__device__ __forceinline__ XcdBarrier xcd_barrier_post(unsigned* bar, volatile LAS unsigned* st) {
    XcdBarrier b; b.bar = bar; b.x = xb_xcc_id(); b.st = st;
    if (threadIdx.x == 0) (void)xb_add(&bar[XB_XCNT(b.x)], 1u);
    return b;
}
__device__ __forceinline__ void xcd_barrier_complete(unsigned* bar, unsigned x, unsigned& nloc, unsigned& nx) {
    const unsigned G = gridDim.x * gridDim.y * gridDim.z;
    unsigned sum, cnt, mine, sp = 0u;
    for (;;) {
        sum = 0u; cnt = 0u; mine = 0u;
#pragma unroll
        for (unsigned j = 0; j < 16; ++j) { const unsigned c = xb_ld(&bar[XB_XCNT(j)]); sum += c; cnt += (c > 0u) ? 1u : 0u; mine = (j == x) ? c : mine; }
        if (sum == G) break;
        __builtin_amdgcn_s_sleep(1);
        if ((++sp & 255u) == 0u) { if (xb_ld(&bar[XB_TMO])) break; if (sp > XB_SPIN_CAP) { atomicAdd(&bar[XB_TMO], 1u); break; } }
    }
    nloc = mine > 0u ? mine : 1u; nx = cnt > 0u ? cnt : 1u;
}

__device__ __forceinline__ void xcd_barrier(const XcdBarrier& b) {
    asm volatile("s_waitcnt vmcnt(0)" ::: "memory");
    __syncthreads();
    if (threadIdx.x == 0) {
        unsigned* bar = b.bar;
        __builtin_amdgcn_s_waitcnt(0);
        unsigned nloc = b.st[0], nx = b.st[1];
        if (nloc == 0u) { xcd_barrier_complete(bar, b.x, nloc, nx); b.st[0] = nloc; b.st[1] = nx; }
        const unsigned old = xb_add(&bar[XB_XSUB(b.x)], 1u);
        const unsigned gen = old / nloc;
        if (old + 1u == (gen + 1u) * nloc) {
            __builtin_amdgcn_fence(__ATOMIC_RELEASE, "agent");
            asm volatile("s_waitcnt vmcnt(0)" ::: "memory");
            const unsigned og = xb_add(&bar[XB_TOP], 1u);
            const unsigned tg = og / nx;
            if (og + 1u == (tg + 1u) * nx) xb_add(&bar[XB_TOPGEN], 1u);
            else XB_SPIN(xb_ld(&bar[XB_TOPGEN]) == tg, bar);
            __builtin_amdgcn_fence(__ATOMIC_ACQUIRE, "agent");
            xb_add(&bar[XB_XGEN(b.x)], 1u);
            asm volatile("s_waitcnt vmcnt(0)" ::: "memory");
        } else {
            XB_SPIN(xb_ld(&bar[XB_XGEN(b.x)]) == gen, bar);
            __builtin_amdgcn_fence(__ATOMIC_ACQUIRE, "agent");
            asm volatile("s_waitcnt vmcnt(0)" ::: "memory");
        }
    }
    __syncthreads();
}

struct Args { const float* in[30]; float* out; unsigned char* ws; int ph_lo, ph_hi, li, pad; };
struct Frame {
    LAS unsigned char* lds;
    volatile LAS unsigned* MISC;
    gu32* ctl;
    int tid, lane, wave;
    int vcu, G;
};
enum { I_XP = 0, I_XS, I_MEM, I_CCONV, I_SSC, I_SDELTA, I_CMK, I_CMV, I_NMIX, I_WIN, I_CONVW, I_CONVB, I_LNG, I_LNB, I_SCW, I_ALOG, I_DTB, I_DNN, I_WOUT,
       I_NMQ, I_NMKV, I_WMQ, I_WMK, I_WMV, I_WMO, I_NFFN, I_WG, I_WU, I_WD, I_NF };

__device__ __forceinline__ void tr_item(const float* W, int ldw, int k0, int c0, const float* gain, bf16* WT, int K, int r0, LAS float* scr, int lane) {
#pragma unroll 8
    for (int i = 0; i < 32; ++i) { const int kk = 2 * i + (lane >> 5); scr[kk * 33 + (lane & 31)] = W[(size_t)(k0 + kk) * ldw + c0 + (lane & 31)]; }
    LDS_WAIT(); asm volatile("" ::: "memory");
    const int c = lane & 7;
    float gv[8];
#pragma unroll
    for (int i = 0; i < 8; ++i) gv[i] = gain ? gain[k0 + 8 * c + i] : 1.f;
#pragma unroll
    for (int j = 0; j < 4; ++j) { const int n = (lane >> 3) + 8 * j; const LAS float* s = scr + (8 * c) * 33 + n;
        v4u o; o.x = pk2(s[0 * 33] * gv[0], s[1 * 33] * gv[1]); o.y = pk2(s[2 * 33] * gv[2], s[3 * 33] * gv[3]); o.z = pk2(s[4 * 33] * gv[4], s[5 * 33] * gv[5]); o.w = pk2(s[6 * 33] * gv[6], s[7 * 33] * gv[7]);
        *(GAS v4u*)(WT + (size_t)(r0 + n) * K + k0 + 8 * c) = o; }
    LDS_WAIT(); asm volatile("" ::: "memory");
}
__device__ __forceinline__ float softplusf_(float x) { return x > 20.f ? x : log1pf(__expf(x)); }

__device__ __forceinline__ void p0_prologue(const Args& A, Frame& F) {
    LAS float* scr = (LAS float*)(F.lds + RING_OFF + F.wave * 8448);
    const int gw = F.vcu * NWAVES + F.wave, NGW = F.G * NWAVES;
    unsigned char* ws = A.ws;
    const float* const pWMK = A.in[I_WMK]; const float* const pWMV = A.in[I_WMV]; const float* const pWG = A.in[I_WG]; const float* const pWU = A.in[I_WU];
    const float* const pXP = A.in[I_XP]; const float* const pXS = A.in[I_XS];
    constexpr int I_A = 96 * 16, I_B = 32 * 16, I_D = 64 * 16, I_F = 176 * 16, I_G = 32 * 44;
    constexpr int NITEMS = I_A + I_B + I_B + I_D + I_B + I_F + I_G;
    for (int it = gw; it < NITEMS; it += NGW) {
        int r = it;
        if (r < I_A) { const int nb = r % 96, kb = r / 96, j0 = 32 * nb; int src = j0;
            if (j0 < 1024) { const int tile = j0 >> 8, local = j0 & 255; src = local < 128 ? 128 * tile + local : 512 + 128 * tile + (local - 128); }
            tr_item(A.in[I_WIN], INC, 64 * kb, src, nullptr, (bf16*)(ws + WS_WIN), DM, j0, scr, F.lane); continue; } r -= I_A;
        if (r < I_B) { const int nb = r % 32, kb = r / 32; tr_item(A.in[I_WOUT], DM, 64 * kb, 32 * nb, nullptr, (bf16*)(ws + WS_WOUT), DM, 32 * nb, scr, F.lane); continue; } r -= I_B;
        if (r < I_B) { const int nb = r % 32, kb = r / 32; tr_item(A.in[I_WMQ], DM, 64 * kb, 32 * nb, A.in[I_NMQ], (bf16*)(ws + WS_WMQ), DM, 32 * nb, scr, F.lane); continue; } r -= I_B;
        if (r < I_D) { const int nb = r % 64, kb = r / 64, j0 = 32 * nb; const bool isv = j0 >= 1024;
            tr_item(isv ? pWMV : pWMK, DM, 64 * kb, isv ? j0 - 1024 : j0, nullptr, (bf16*)(ws + WS_WMKV), DM, j0, scr, F.lane); continue; } r -= I_D;
        if (r < I_B) { const int nb = r % 32, kb = r / 32; tr_item(A.in[I_WMO], DM, 64 * kb, 32 * nb, nullptr, (bf16*)(ws + WS_WMO), DM, 32 * nb, scr, F.lane); continue; } r -= I_B;
        if (r < I_F) { const int nb = r % 176, kb = r / 176, j0 = 32 * nb, tile = j0 >> 8, local = j0 & 255; const bool up = local >= 128;
            tr_item(up ? pWU : pWG, DFF, 64 * kb, 128 * tile + (up ? local - 128 : local), A.in[I_NFFN], (bf16*)(ws + WS_WGU), DM, j0, scr, F.lane); continue; } r -= I_F;
        { const int nb = r % 32, kb = r / 32; tr_item(A.in[I_WD], DM, 64 * kb, 32 * nb, nullptr, (bf16*)(ws + WS_WDN), DFF, 32 * nb, scr, F.lane); }
    }
    {
        bf16* H = (bf16*)(ws + WS_RB); float* BG = (float*)(ws + WS_BG);
        const float* win = A.in[I_WIN]; const float* gain = A.in[I_NMIX];
        float w8[4][4][8];
#pragma unroll
        for (int j = 0; j < 4; ++j)
#pragma unroll
            for (int i = 0; i < 4; ++i) { const int k = 256 * j + 4 * F.lane + i; const f32x4 a = *(const f32x4*)(win + (size_t)k * INC + 3072), b = *(const f32x4*)(win + (size_t)k * INC + 3076);
                w8[j][i][0] = a[0]; w8[j][i][1] = a[1]; w8[j][i][2] = a[2]; w8[j][i][3] = a[3]; w8[j][i][4] = b[0]; w8[j][i][5] = b[1]; w8[j][i][6] = b[2]; w8[j][i][7] = b[3]; }
        f32x4 gn[4];
#pragma unroll
        for (int j = 0; j < 4; ++j) gn[j] = *(const f32x4*)(gain + 256 * j + 4 * F.lane);
        const f32x4 alog4 = *(const f32x4*)A.in[I_ALOG], dtb4 = *(const f32x4*)A.in[I_DTB];
        for (int m = gw; m < MR; m += NGW) {
            GAS unsigned long long* o8 = (GAS unsigned long long*)(H + (size_t)m * DM) + F.lane;
            if (m >= MV) {
#pragma unroll
                for (int j = 0; j < 4; ++j) o8[64 * j] = 0ull;
                if (F.lane < 8) BG[(size_t)m * 8 + F.lane] = 0.f;
                continue;
            }
            const float* xrow = (m < MP) ? pXP + (size_t)m * DM : pXS + (size_t)(m - MP) * DM;
            const GAS f32x4* xr = (const GAS f32x4*)xrow + F.lane;
            f32x4 v[4]; float s2 = 0.f;
#pragma unroll
            for (int j = 0; j < 4; ++j) { v[j] = xr[64 * j]; s2 += (v[j][0] * v[j][0] + v[j][1] * v[j][1]) + (v[j][2] * v[j][2] + v[j][3] * v[j][3]); }
            const float rstd = 1.f / sqrtf(wave_sum(s2) * (1.f / DM) + RMS_EPS);
            float p8[8];
#pragma unroll
            for (int c = 0; c < 8; ++c) p8[c] = 0.f;
#pragma unroll
            for (int j = 0; j < 4; ++j) { v[j] = v[j] * rstd * gn[j];
#pragma unroll
                for (int i = 0; i < 4; ++i)
#pragma unroll
                    for (int c = 0; c < 8; ++c) p8[c] += v[j][i] * w8[j][i][c];
                o8[64 * j] = (unsigned long long)pk2(v[j][0], v[j][1]) | ((unsigned long long)pk2(v[j][2], v[j][3]) << 32); }
#pragma unroll
            for (int c = 0; c < 8; ++c) p8[c] = wave_sum(p8[c]);
            f32x4 bo, go;
#pragma unroll
            for (int c = 0; c < 4; ++c) { bo[c] = 1.f / (1.f + expf(-p8[c])); go[c] = -expf(alog4[c]) * softplusf_(p8[4 + c] + dtb4[c]); }
            if (F.lane == 0) { *(f32x4*)(BG + (size_t)m * 8) = bo; *(f32x4*)(BG + (size_t)m * 8 + 4) = go; }
        }
    }
    {
        bf16* MN = (bf16*)(ws + WS_MEMN); const float* gain = A.in[I_NMKV];
        f32x4 gn[4];
#pragma unroll
        for (int j = 0; j < 4; ++j) gn[j] = *(const f32x4*)(gain + 256 * j + 4 * F.lane);
        for (int m = gw; m < NB * NMEM; m += NGW) {
            const GAS f32x4* xr = (const GAS f32x4*)(A.in[I_MEM] + (size_t)m * DM) + F.lane;
            f32x4 v[4]; float s2 = 0.f;
#pragma unroll
            for (int j = 0; j < 4; ++j) { v[j] = xr[64 * j]; s2 += (v[j][0] * v[j][0] + v[j][1] * v[j][1]) + (v[j][2] * v[j][2] + v[j][3] * v[j][3]); }
            const float rstd = 1.f / sqrtf(wave_sum(s2) * (1.f / DM) + RMS_EPS);
            GAS unsigned long long* o8 = (GAS unsigned long long*)(MN + (size_t)m * DM) + F.lane;
#pragma unroll
            for (int j = 0; j < 4; ++j) { v[j] = v[j] * rstd * gn[j]; o8[64 * j] = (unsigned long long)pk2(v[j][0], v[j][1]) | ((unsigned long long)pk2(v[j][2], v[j][3]) << 32); }
        }
    }
}

__device__ __forceinline__ void conv_tile(const Args& A, Frame& F, int b, int tile) {
    const bf16* PB = (const bf16*)(A.ws + WS_RA); bf16* CD = (bf16*)(A.ws + WS_RB); bf16* QC = (bf16*)(A.ws + WS_RC);
    const int c = F.tid; const int row0 = b * SEQ + tile * 64;
    LAS float* Y = (LAS float*)(F.lds + RING_OFF);
    {
        float w[CW];
#pragma unroll
        for (int j = 0; j < CW; ++j) w[j] = A.in[I_CONVW][j * CC + c];
        const float bias = A.in[I_CONVB][c];
        float uv[46];
        const unsigned rb = (unsigned)(b * SEQ + tile * 64);
#pragma unroll
        for (int i = 0; i < 30; ++i) { const int tk = tile * 64 - 30 + i; const unsigned tkc = tk < 0 ? 0u : (unsigned)tk; const float vv = bf2f(PB[(unsigned)(b * SEQ + tkc) * (unsigned)PBLD + (unsigned)c]); uv[i] = (tk >= 0) ? vv : 0.f; }
#pragma unroll 1
        for (int seg = 0; seg < 4; ++seg) {
#pragma unroll
            for (int i = 0; i < 16; ++i) uv[30 + i] = bf2f(PB[(rb + (unsigned)(seg * 16 + i)) * (unsigned)PBLD + (unsigned)c]);
#pragma unroll
            for (int t = 0; t < 16; ++t) { float a = bias;
#pragma unroll
                for (int j = 0; j < CW; ++j) a += w[j] * uv[t + j];
                Y[(seg * 16 + t) * CC + c] = a; }
#pragma unroll
            for (int i = 0; i < 30; ++i) uv[i] = uv[i + 16];
        }
    }
    __syncthreads();
    {
        const int ch0 = 8 * F.lane;
        const f32x4 g0 = *(const f32x4*)(A.in[I_LNG] + ch0), g1 = *(const f32x4*)(A.in[I_LNG] + ch0 + 4), b0 = *(const f32x4*)(A.in[I_LNB] + ch0), b1 = *(const f32x4*)(A.in[I_LNB] + ch0 + 4);
#pragma unroll 2
        for (int tt = 0; tt < 8; ++tt) { const int t = 8 * F.wave + tt;
            f32x4 y0 = *(const LAS f32x4*)(Y + t * CC + ch0), y1 = *(const LAS f32x4*)(Y + t * CC + ch0 + 4);
            const float mean = wave_sum((y0[0] + y0[1]) + (y0[2] + y0[3]) + (y1[0] + y1[1]) + (y1[2] + y1[3])) * (1.f / CC);
            y0 = y0 - mean; y1 = y1 - mean;
            const float var = wave_sum((y0[0] * y0[0] + y0[1] * y0[1]) + (y0[2] * y0[2] + y0[3] * y0[3]) + (y1[0] * y1[0] + y1[1] * y1[1]) + (y1[2] * y1[2] + y1[3] * y1[3])) * (1.f / CC);
            const float rstd = 1.f / sqrtf(var + 1e-5f);
            y0 = y0 * rstd * g0 + b0; y1 = y1 * rstd * g1 + b1;
            float o[8];
#pragma unroll
            for (int i = 0; i < 4; ++i) { o[i] = silu(y0[i]); o[4 + i] = silu(y1[i]); }
            *(GAS v4u*)(CD + (size_t)(row0 + t) * DM + ch0) = pack8(o); }
    }
    if (tile == 31) {
        float* oc = A.out + OUT_CONVP + (size_t)b * 30 * CC;
        for (int j = 0; j < 30; ++j) oc[j * CC + c] = bf2f(PB[(size_t)(b * SEQ + SEQ - 30 + j) * PBLD + c]);
        float* os = A.out + OUT_SCP + (size_t)b * 3 * QKVN;
        for (int e = F.tid; e < 3 * QKVN; e += NWAVES * 64) { const int j = e / QKVN, ch = e % QKVN; os[e] = bf2f(PB[(size_t)(b * SEQ + SEQ - 3 + j) * PBLD + 512 + ch]); }
    }
    {
        const int t0 = tile * 64 + 8 * F.wave;
#pragma unroll 1
        for (int p = 0; p < 3; ++p) {
            const int ch0 = 512 * p + 8 * F.lane;
            float wsc[4][8];
#pragma unroll
            for (int j = 0; j < 4; ++j) { const f32x4 a = *(const f32x4*)(A.in[I_SCW] + j * QKVN + ch0), bb = *(const f32x4*)(A.in[I_SCW] + j * QKVN + ch0 + 4);
#pragma unroll
                for (int i = 0; i < 4; ++i) { wsc[j][i] = a[i]; wsc[j][4 + i] = bb[i]; } }
            float win[3][8];
#pragma unroll
            for (int j = 0; j < 3; ++j) { const int tk = t0 - 3 + j; const int tkc = tk < 0 ? 0 : tk;
                const v4u x = *(const GAS v4u*)(PB + (size_t)(b * SEQ + tkc) * PBLD + 512 + ch0); unpack8(x, win[j]);
#pragma unroll
                for (int i = 0; i < 8; ++i) win[j][i] = (tk >= 0) ? win[j][i] : 0.f; }
#pragma unroll
            for (int tt = 0; tt < 8; ++tt) {
                float cur[8]; { const v4u x = *(const GAS v4u*)(PB + (size_t)(b * SEQ + t0 + tt) * PBLD + 512 + ch0); unpack8(x, cur); }
                float y[8]; float ss = 0.f;
#pragma unroll
                for (int i = 0; i < 8; ++i) { const float a = wsc[0][i] * win[0][i] + wsc[1][i] * win[1][i] + wsc[2][i] * win[2][i] + wsc[3][i] * cur[i]; y[i] = silu(a); ss += y[i] * y[i]; }
                if (p < 2) { ss += __shfl_xor(ss, 1); ss += __shfl_xor(ss, 2); ss += __shfl_xor(ss, 4); ss += __shfl_xor(ss, 8);
                    const float sc = (1.f / sqrtf(ss + 1e-6f)) * (p == 0 ? 0.08838834764831845f : 1.f);
#pragma unroll
                    for (int i = 0; i < 8; ++i) y[i] *= sc; }
                *(GAS v4u*)(QC + (size_t)(b * SEQ + t0 + tt) * QKVN + ch0) = pack8(y);
#pragma unroll
                for (int i = 0; i < 8; ++i) { win[0][i] = win[1][i]; win[1][i] = win[2][i]; win[2][i] = cur[i]; }
            }
        }
    }
    __syncthreads();
}
__device__ __forceinline__ void conv_sample(const Args& A, Frame& F, int s) {
    const bf16* PB = (const bf16*)(A.ws + WS_RA); bf16* CD = (bf16*)(A.ws + WS_RB); bf16* QC = (bf16*)(A.ws + WS_RC);
    const int c = F.tid; const size_t row = (size_t)MP + s;
    LAS float* Y = (LAS float*)(F.lds + RING_OFF);
    {
        const float* cache = A.in[I_CCONV] + (size_t)s * 30 * CC; float* oc = A.out + OUT_CONVS + (size_t)s * 30 * CC;
        const float us = bf2f(PB[row * PBLD + c]);
        float a = A.in[I_CONVB][c];
        float prev = cache[c];
#pragma unroll 6
        for (int j = 0; j < 30; ++j) { a += A.in[I_CONVW][j * CC + c] * prev; const float nx = (j < 29) ? cache[(j + 1) * CC + c] : us; oc[j * CC + c] = nx; prev = nx; }
        a += A.in[I_CONVW][30 * CC + c] * us;
        Y[c] = a;
    }
    __syncthreads();
    if (F.wave == 7) {
        const int ch0 = 8 * F.lane;
        const f32x4 g0 = *(const f32x4*)(A.in[I_LNG] + ch0), g1 = *(const f32x4*)(A.in[I_LNG] + ch0 + 4), b0 = *(const f32x4*)(A.in[I_LNB] + ch0), b1 = *(const f32x4*)(A.in[I_LNB] + ch0 + 4);
        f32x4 y0 = *(const LAS f32x4*)(Y + ch0), y1 = *(const LAS f32x4*)(Y + ch0 + 4);
        const float mean = wave_sum((y0[0] + y0[1]) + (y0[2] + y0[3]) + (y1[0] + y1[1]) + (y1[2] + y1[3])) * (1.f / CC);
        y0 = y0 - mean; y1 = y1 - mean;
        const float var = wave_sum((y0[0] * y0[0] + y0[1] * y0[1]) + (y0[2] * y0[2] + y0[3] * y0[3]) + (y1[0] * y1[0] + y1[1] * y1[1]) + (y1[2] * y1[2] + y1[3] * y1[3])) * (1.f / CC);
        const float rstd = 1.f / sqrtf(var + 1e-5f);
        y0 = y0 * rstd * g0 + b0; y1 = y1 * rstd * g1 + b1;
        float o[8];
#pragma unroll
        for (int i = 0; i < 4; ++i) { o[i] = silu(y0[i]); o[4 + i] = silu(y1[i]); }
        *(GAS v4u*)(CD + row * DM + ch0) = pack8(o);
    }
    if (F.wave < 3) {
        const int p = F.wave; const int ch0 = 512 * p + 8 * F.lane;
        const float* st = A.in[I_SSC] + (size_t)s * 3 * QKVN; float* os = A.out + OUT_SCS + (size_t)s * 3 * QKVN;
        float win[3][8], cur[8], y[8];
#pragma unroll
        for (int j = 0; j < 3; ++j) { const f32x4 a = *(const f32x4*)(st + j * QKVN + ch0), bb = *(const f32x4*)(st + j * QKVN + ch0 + 4);
#pragma unroll
            for (int i = 0; i < 4; ++i) { win[j][i] = a[i]; win[j][4 + i] = bb[i]; } }
        { const v4u x = *(const GAS v4u*)(PB + row * PBLD + 512 + ch0); unpack8(x, cur); }
        float ss = 0.f;
#pragma unroll
        for (int i = 0; i < 8; ++i) { float a = 0.f;
#pragma unroll
            for (int j = 0; j < 3; ++j) a += A.in[I_SCW][j * QKVN + ch0 + i] * win[j][i];
            a += A.in[I_SCW][3 * QKVN + ch0 + i] * cur[i]; y[i] = silu(a); ss += y[i] * y[i]; }
        if (p < 2) { ss += __shfl_xor(ss, 1); ss += __shfl_xor(ss, 2); ss += __shfl_xor(ss, 4); ss += __shfl_xor(ss, 8);
            const float sc = (1.f / sqrtf(ss + 1e-6f)) * (p == 0 ? 0.08838834764831845f : 1.f);
#pragma unroll
            for (int i = 0; i < 8; ++i) y[i] *= sc; }
        *(GAS v4u*)(QC + row * QKVN + ch0) = pack8(y);
#pragma unroll
        for (int j = 0; j < 3; ++j) { f32x4 a, bb;
#pragma unroll
            for (int i = 0; i < 4; ++i) { a[i] = (j < 2) ? win[j + 1][i] : cur[i]; bb[i] = (j < 2) ? win[j + 1][4 + i] : cur[4 + i]; }
            *(f32x4*)(os + j * QKVN + ch0) = a; *(f32x4*)(os + j * QKVN + ch0 + 4) = bb; }
    }
    __syncthreads();
}

__device__ __forceinline__ bf16x8 lds_frag16(const LAS unsigned char* p) { return *(const LAS bf16x8*)p; }
__device__ __forceinline__ void d1_chunk(const Args& A, Frame& F, int ci) {
    using pg8::f32x4;
    const int b = ci >> 7, h = (ci >> 5) & 3, n = ci & 31; const int row0 = b * SEQ + n * 64;
    const bf16* QC = (const bf16*)(A.ws + WS_RC); const float* BG = (const float*)(A.ws + WS_BG);
    float* Ug = (float*)(A.ws + WS_U) + (size_t)ci * 8192; bf16* Wg = (bf16*)(A.ws + WS_W) + (size_t)ci * 8192; bf16* QGg = (bf16*)(A.ws + WS_QG) + (size_t)ci * 8192;
    bf16* KDTg = (bf16*)(A.ws + WS_KDT) + (size_t)ci * 8192; bf16* QKg = (bf16*)(A.ws + WS_QK) + (size_t)ci * 4096; float* GLg = (float*)(A.ws + WS_GL);
    constexpr int OFF_K = 0, OFF_Q = 17408, OFF_VBT = 34816, OFF_KBGT = 53248, OFF_L = 71680, OFF_T = 89088, OFF_GC = 98304, OFF_BETA = 98560, OFF_EG = 98816, OFF_TM = 99072, OFF_X = 116480, LS = 68;
    LAS unsigned char* L = F.lds + RING_OFF;
    LAS float* gcs = (LAS float*)(L + OFF_GC); LAS float* betas = (LAS float*)(L + OFF_BETA); LAS float* egs = (LAS float*)(L + OFF_EG); LAS float* Lm = (LAS float*)(L + OFF_L); LAS float* Tm = (LAS float*)(L + OFF_TM); LAS float* Xm = (LAS float*)(L + OFF_X);
    const int fr = F.lane & 15, fq = F.lane >> 4;
    if (F.wave == 0) {
        float g = BG[(size_t)(row0 + F.lane) * 8 + 4 + h]; const float be = BG[(size_t)(row0 + F.lane) * 8 + h];
#pragma unroll
        for (int o = 1; o < 64; o <<= 1) { const float v = __shfl_up(g, o); if (F.lane >= o) g += v; }
        gcs[F.lane] = g; betas[F.lane] = be; egs[F.lane] = __expf(g);
    }
    __syncthreads();
    {
        const int t = F.tid >> 3, part = F.tid & 7;
        const bf16* rp = QC + (size_t)(row0 + t) * QKVN + h * 128 + part * 16;
        const v4u q0 = *(const GAS v4u*)(rp), q1 = *(const GAS v4u*)(rp + 8), k0 = *(const GAS v4u*)(rp + 512), k1 = *(const GAS v4u*)(rp + 520), v0 = *(const GAS v4u*)(rp + 1024), v1 = *(const GAS v4u*)(rp + 1032);
        *(LAS v4u*)(L + OFF_K + t * 272 + part * 32) = k0; *(LAS v4u*)(L + OFF_K + t * 272 + part * 32 + 16) = k1;
        *(LAS v4u*)(L + OFF_Q + t * 272 + part * 32) = q0; *(LAS v4u*)(L + OFF_Q + t * 272 + part * 32 + 16) = q1;
        const float be = betas[t], beg = be * egs[t];
        float kf[16], vf[16];
        { float tmp[8]; unpack8(k0, tmp);
#pragma unroll
          for (int i = 0; i < 8; ++i) kf[i] = tmp[i]; unpack8(k1, tmp);
#pragma unroll
          for (int i = 0; i < 8; ++i) kf[8 + i] = tmp[i]; unpack8(v0, tmp);
#pragma unroll
          for (int i = 0; i < 8; ++i) vf[i] = tmp[i]; unpack8(v1, tmp);
#pragma unroll
          for (int i = 0; i < 8; ++i) vf[8 + i] = tmp[i]; }
#pragma unroll
        for (int i = 0; i < 16; ++i) { const int d = part * 16 + i;
            *(LAS unsigned short*)(L + OFF_VBT + d * 144 + t * 2) = (unsigned short)(pk2(vf[i] * be, 0.f) & 0xffffu);
            *(LAS unsigned short*)(L + OFF_KBGT + d * 144 + t * 2) = (unsigned short)(pk2(kf[i] * beg, 0.f) & 0xffffu); }
    }
    __syncthreads();
#pragma unroll 1
    for (int x = 0; x < 4; ++x) {
        const int tile = F.wave * 4 + x, which = tile >> 4, ti = (tile >> 2) & 3, tj = tile & 3;
        f32x4 acc = (f32x4){0.f, 0.f, 0.f, 0.f};
        if (ti >= tj) {
            const LAS unsigned char* ap = L + (which ? OFF_Q : OFF_K) + (ti * 16 + fr) * 272 + fq * 16; const LAS unsigned char* bp = L + OFF_K + (tj * 16 + fr) * 272 + fq * 16;
#pragma unroll
            for (int kk = 0; kk < 4; ++kk) acc = __builtin_amdgcn_mfma_f32_16x16x32_bf16(lds_frag16(ap + kk * 64), lds_frag16(bp + kk * 64), acc, 0, 0, 0);
        }
        const int j = tj * 16 + fr; const float gj = gcs[j];
#pragma unroll
        for (int r = 0; r < 4; ++r) { const int i = ti * 16 + 4 * fq + r; const float dec = __expf(gcs[i] - gj);
            if (which == 0) Lm[i * LS + j] = (i > j) ? betas[i] * acc[r] * dec : 0.f;
            else QKg[i * 64 + j] = (bf16)(pk2((i >= j) ? acc[r] * dec : 0.f, 0.f) & 0xffffu); }
    }
    __syncthreads();
    for (int e = F.tid; e < 64 * LS; e += NWAVES * 64) Tm[e] = 0.f;
    __syncthreads();
    if (F.wave == 0) {
        const LAS float* Lb = Lm + (16 * fq) * LS + 16 * fq;
        float t[16];
#pragma unroll
        for (int i = 0; i < 16; ++i) {
            float a0 = 0.f, a1 = 0.f, a2 = 0.f, a3 = 0.f;
#pragma unroll
            for (int j4 = 0; j4 < (i + 3) / 4; ++j4) { const f32x4 lv = *(const LAS f32x4*)(Lb + i * LS + 4 * j4);
                if (4 * j4 + 0 < i) a0 += lv[0] * t[4 * j4 + 0]; if (4 * j4 + 1 < i) a1 += lv[1] * t[4 * j4 + 1]; if (4 * j4 + 2 < i) a2 += lv[2] * t[4 * j4 + 2]; if (4 * j4 + 3 < i) a3 += lv[3] * t[4 * j4 + 3]; }
            t[i] = ((fr == i) ? 1.f : 0.f) - ((a0 + a1) + (a2 + a3));
        }
#pragma unroll
        for (int i = 0; i < 16; ++i) Tm[(16 * fq + i) * LS + 16 * fq + fr] = t[i];
    } else {
        const int lt = F.tid - 64; const float gl = gcs[63];
        for (int cix = lt; cix < 1024; cix += 448) {
            const int t = cix >> 4, cc = cix & 15; const v4u x = *(const LAS v4u*)(L + OFF_Q + t * 272 + cc * 16); float f[8]; unpack8(x, f); const float e = egs[t];
#pragma unroll
            for (int i = 0; i < 8; ++i) f[i] *= e;
            *(GAS v4u*)(QGg + t * 128 + cc * 8) = pack8(f); }
        for (int cix = lt; cix < 1024; cix += 448) {
            const int dk = cix >> 3, t0 = (cix & 7) * 8; float f[8];
#pragma unroll
            for (int i = 0; i < 8; ++i) f[i] = bf2f(*(const LAS unsigned short*)(L + OFF_K + (t0 + i) * 272 + dk * 2)) * __expf(gl - gcs[t0 + i]);
            *(GAS v4u*)(KDTg + dk * 64 + t0) = pack8(f); }
        if (lt == 0) GLg[ci] = __expf(gl);
    }
    __syncthreads();
    if (F.wave < 2) {
        const int pp = F.wave, rb = 16 * (2 * pp + 1), cb = 16 * (2 * pp); f32x4 acc = (f32x4){0.f, 0.f, 0.f, 0.f};
#pragma unroll
        for (int kk = 0; kk < 4; ++kk) acc = __builtin_amdgcn_mfma_f32_16x16x4f32(Lm[(rb + fr) * LS + cb + 4 * kk + fq], Tm[(cb + 4 * kk + fq) * LS + cb + fr], acc, 0, 0, 0);
#pragma unroll
        for (int r = 0; r < 4; ++r) Xm[pp * 576 + (4 * fq + r) * 36 + fr] = acc[r];
    }
    __syncthreads();
    if (F.wave < 2) {
        const int pp = F.wave, rb = 16 * (2 * pp + 1), cb = 16 * (2 * pp); f32x4 acc = (f32x4){0.f, 0.f, 0.f, 0.f};
#pragma unroll
        for (int kk = 0; kk < 4; ++kk) acc = __builtin_amdgcn_mfma_f32_16x16x4f32(Tm[(rb + fr) * LS + rb + 4 * kk + fq], Xm[pp * 576 + (4 * kk + fq) * 36 + fr], acc, 0, 0, 0);
#pragma unroll
        for (int r = 0; r < 4; ++r) Tm[(rb + 4 * fq + r) * LS + cb + fr] = -acc[r];
    }
    __syncthreads();
    if (F.wave < 4) {
        const int bi = F.wave >> 1, bj = F.wave & 1; f32x4 acc = (f32x4){0.f, 0.f, 0.f, 0.f};
#pragma unroll
        for (int kk = 0; kk < 8; ++kk) acc = __builtin_amdgcn_mfma_f32_16x16x4f32(Lm[(32 + 16 * bi + fr) * LS + 4 * kk + fq], Tm[(4 * kk + fq) * LS + 16 * bj + fr], acc, 0, 0, 0);
#pragma unroll
        for (int r = 0; r < 4; ++r) Xm[(16 * bi + 4 * fq + r) * 36 + 16 * bj + fr] = acc[r];
    }
    __syncthreads();
    if (F.wave < 4) {
        const int bi = F.wave >> 1, bj = F.wave & 1; f32x4 acc = (f32x4){0.f, 0.f, 0.f, 0.f};
#pragma unroll
        for (int kk = 0; kk < 8; ++kk) acc = __builtin_amdgcn_mfma_f32_16x16x4f32(Tm[(32 + 16 * bi + fr) * LS + 32 + 4 * kk + fq], Xm[(4 * kk + fq) * 36 + 16 * bj + fr], acc, 0, 0, 0);
#pragma unroll
        for (int r = 0; r < 4; ++r) Tm[(32 + 16 * bi + 4 * fq + r) * LS + 16 * bj + fr] = -acc[r];
    }
    __syncthreads();
    {
        const int i = F.tid >> 3, j0 = (F.tid & 7) * 8; const f32x4 a = *(const LAS f32x4*)(Tm + i * LS + j0), bq = *(const LAS f32x4*)(Tm + i * LS + j0 + 4);
        v4u w; w.x = pk2(a[0], a[1]); w.y = pk2(a[2], a[3]); w.z = pk2(bq[0], bq[1]); w.w = pk2(bq[2], bq[3]);
        *(LAS v4u*)(L + OFF_T + i * 144 + j0 * 2) = w;
    }
    __syncthreads();
#pragma unroll 1
    for (int x = 0; x < 8; ++x) {
        const int tile = F.wave * 8 + x, which = tile >> 5, ti = (tile >> 3) & 3, td = tile & 7;
        const LAS unsigned char* ap = L + OFF_T + (ti * 16 + fr) * 144 + fq * 16; const LAS unsigned char* bp = L + (which ? OFF_KBGT : OFF_VBT) + (td * 16 + fr) * 144 + fq * 16;
        f32x4 acc = (f32x4){0.f, 0.f, 0.f, 0.f};
#pragma unroll
        for (int kk = 0; kk < 2; ++kk) acc = __builtin_amdgcn_mfma_f32_16x16x32_bf16(lds_frag16(ap + kk * 64), lds_frag16(bp + kk * 64), acc, 0, 0, 0);
        const int d = td * 16 + fr;
#pragma unroll
        for (int r = 0; r < 4; ++r) { const int i = ti * 16 + 4 * fq + r;
            if (which == 0) Ug[i * 128 + d] = acc[r]; else Wg[i * 128 + d] = (bf16)(pk2(acc[r], 0.f) & 0xffffu); }
    }
    __syncthreads();
}

constexpr int SC_OW = 0, SC_OQG = 16384, SC_OKDT = 32768, SC_OQK = 49152, SC_OU = 57344, SC_BUF = 61440;
__device__ __forceinline__ void scan_issue(const Args& A, Frame& F, int ci, int sl, LAS unsigned char* dst) {
    const unsigned char* Wg = A.ws + WS_W + (size_t)ci * 16384; const unsigned char* QGg = A.ws + WS_QG + (size_t)ci * 16384;
    const unsigned char* KDTg = A.ws + WS_KDT + (size_t)ci * 16384; const unsigned char* QKg = A.ws + WS_QK + (size_t)ci * 8192; const unsigned char* Ug = A.ws + WS_U + (size_t)ci * 32768 + sl * 64;
#pragma unroll
    for (int j = 0; j < 9; ++j) {
        const int pi = (F.wave - 1) + 7 * j;
        if (pi < 60) {
            const unsigned char* src;
            if (pi < 32) { const int i = (pi & 15) * 64 + F.lane, r = i >> 4, c = (i & 15) ^ (r & 15); src = (pi < 16 ? Wg : QGg) + r * 256 + c * 16; }
            else if (pi < 56) { const int i = (pi < 48 ? pi - 32 : pi - 48) * 64 + F.lane, r = i >> 3, c = (i & 7) ^ ((r >> 1) & 7); src = (pi < 48 ? KDTg : QKg) + r * 128 + c * 16; }
            else { const int i = (pi - 56) * 64 + F.lane, r = i >> 2, c = i & 3; src = Ug + r * 512 + c * 16; }
            __builtin_amdgcn_global_load_lds((const unsigned*)src, (LAS unsigned*)(dst + pi * 1024), 16, 0, 0);
        }
    }
}
__device__ __forceinline__ bf16x8 frag2(const LAS unsigned char* p0, const LAS unsigned char* p1) { const v2u lo = *(const LAS v2u*)p0, hi = *(const LAS v2u*)p1; v4u w; w.x = lo.x; w.y = lo.y; w.z = hi.x; w.w = hi.y; return __builtin_bit_cast(bf16x8, w); }
__device__ __forceinline__ bf16x8 frag256(const LAS unsigned char* tile, int row, int kstep, int fq) { const int c = 4 * kstep + (fq >> 1), sw = row & 15; const LAS unsigned char* rp = tile + row * 256 + 8 * (fq & 1); return frag2(rp + ((c ^ sw) << 4), rp + (((c + 2) ^ sw) << 4)); }
__device__ __forceinline__ bf16x8 frag128(const LAS unsigned char* tile, int row, int kstep, int fq) { const int c = 4 * kstep + (fq >> 1), sw = (row >> 1) & 7; const LAS unsigned char* rp = tile + row * 128 + 8 * (fq & 1); return frag2(rp + ((c ^ sw) << 4), rp + (((c + 2) ^ sw) << 4)); }
__device__ __forceinline__ bf16x8 pack_pair(const pg8::f32x4& a, const pg8::f32x4& b) { v4u w; w.x = pk2(a[0], a[1]); w.y = pk2(a[2], a[3]); w.z = pk2(b[0], b[1]); w.w = pk2(b[2], b[3]); return __builtin_bit_cast(bf16x8, w); }
__device__ __forceinline__ void scan_unit(const Args& A, Frame& F, int b, int h, int sl) {
    using pg8::f32x4;
    LAS unsigned char* L = F.lds + RING_OFF;
    const int ci0 = (b * NH + h) * 32; const int fr = F.lane & 15, fq = F.lane >> 4;
    float* Og = (float*)(A.ws + WS_RE); const float* GLg = (const float*)(A.ws + WS_GL);
    if (F.wave > 0) { scan_issue(A, F, ci0, sl, L); scan_issue(A, F, ci0 + 1, sl, L + SC_BUF); asm volatile("s_waitcnt vmcnt(9)" ::: "memory"); }
    __builtin_amdgcn_s_barrier(); asm volatile("" ::: "memory");
    f32x4 S[8];
#pragma unroll
    for (int i = 0; i < 8; ++i) S[i] = (f32x4){0.f, 0.f, 0.f, 0.f};
    float gl = GLg[ci0];
#pragma unroll 1
    for (int n = 0; n < 32; ++n) {
        if (F.wave == 0) {
            const LAS unsigned char* B = L + (n & 1) * SC_BUF;
            const float gln = GLg[ci0 + (n < 31 ? n + 1 : n)];
            bf16x8 Sb[4];
#pragma unroll
            for (int kk = 0; kk < 4; ++kk) Sb[kk] = pack_pair(S[2 * kk], S[2 * kk + 1]);
            f32x4 vn[4];
#pragma unroll
            for (int tb = 0; tb < 4; ++tb) { f32x4 p1 = (f32x4){0.f, 0.f, 0.f, 0.f};
#pragma unroll
                for (int kk = 0; kk < 4; ++kk) p1 = __builtin_amdgcn_mfma_f32_16x16x32_bf16(frag256(B + SC_OW, 16 * tb + fr, kk, fq), Sb[kk], p1, 0, 0, 0);
#pragma unroll
                for (int r = 0; r < 4; ++r) vn[tb][r] = *(const LAS float*)(B + SC_OU + (16 * tb + 4 * fq + r) * 64 + fr * 4) - p1[r]; }
            bf16x8 Vb[2]; Vb[0] = pack_pair(vn[0], vn[1]); Vb[1] = pack_pair(vn[2], vn[3]);
            const size_t orow = (size_t)(b * SEQ + n * 64);
#pragma unroll
            for (int blk = 0; blk < 8; ++blk) { f32x4 s = S[blk] * gl;
#pragma unroll
                for (int kt = 0; kt < 2; ++kt) s = __builtin_amdgcn_mfma_f32_16x16x32_bf16(frag128(B + SC_OKDT, 16 * blk + fr, kt, fq), Vb[kt], s, 0, 0, 0);
                S[blk] = s; }
#pragma unroll
            for (int tb = 0; tb < 4; ++tb) { f32x4 o = (f32x4){0.f, 0.f, 0.f, 0.f};
#pragma unroll
                for (int kk = 0; kk < 4; ++kk) o = __builtin_amdgcn_mfma_f32_16x16x32_bf16(frag256(B + SC_OQG, 16 * tb + fr, kk, fq), Sb[kk], o, 0, 0, 0);
#pragma unroll
                for (int kt = 0; kt < 2; ++kt) o = __builtin_amdgcn_mfma_f32_16x16x32_bf16(frag128(B + SC_OQK, 16 * tb + fr, kt, fq), Vb[kt], o, 0, 0, 0);
#pragma unroll
                for (int r = 0; r < 4; ++r) Og[(orow + 16 * tb + 4 * fq + r) * 512 + h * 128 + sl * 16 + fr] = o[r]; }
            gl = gln;
            asm volatile("s_waitcnt lgkmcnt(0)" ::: "memory");
        } else {
            asm volatile("s_waitcnt vmcnt(0)" ::: "memory");
        }
        __builtin_amdgcn_s_barrier(); asm volatile("" ::: "memory");
        if (F.wave > 0 && n + 2 < 32) scan_issue(A, F, ci0 + n + 2, sl, L + (n & 1) * SC_BUF);
    }
    if (F.wave == 0) {
        float* od = A.out + OUT_DLP + (size_t)(b * NH + h) * DKV * DKV;
#pragma unroll
        for (int blk = 0; blk < 8; ++blk)
#pragma unroll
            for (int r = 0; r < 4; ++r) od[(16 * blk + 4 * fq + r) * DKV + sl * 16 + fr] = S[blk][r];
    }
    asm volatile("s_waitcnt vmcnt(0) lgkmcnt(0)" ::: "memory"); __builtin_amdgcn_s_barrier(); asm volatile("" ::: "memory");
}
__device__ __forceinline__ void delta_sample(const Args& A, Frame& F, int s, int h) {
    const bf16* QC = (const bf16*)(A.ws + WS_RC); const float* BG = (const float*)(A.ws + WS_BG); float* Og = (float*)(A.ws + WS_RE);
    const size_t row = (size_t)MP + s;
    LAS float* qs = (LAS float*)(F.lds + RING_OFF); LAS float* ks = qs + 128; LAS float* red = qs + 256;
    const int dv = F.tid & 127, grp = F.tid >> 7;
    if (F.tid < 128) { qs[F.tid] = bf2f(QC[row * QKVN + h * 128 + F.tid]); ks[F.tid] = bf2f(QC[row * QKVN + 512 + h * 128 + F.tid]); }
    const float v = bf2f(QC[row * QKVN + 1024 + h * 128 + dv]);
    const float beta = BG[row * 8 + h], eg = __expf(BG[row * 8 + 4 + h]);
    const float* S0 = A.in[I_SDELTA] + (size_t)(s * NH + h) * DKV * DKV; float* So = A.out + OUT_DLS + (size_t)(s * NH + h) * DKV * DKV;
    float s0[32];
#pragma unroll
    for (int i = 0; i < 32; ++i) s0[i] = S0[(size_t)(grp * 32 + i) * DKV + dv];
    __syncthreads();
    float part = 0.f;
#pragma unroll
    for (int i = 0; i < 32; ++i) part += ks[grp * 32 + i] * s0[i];
    red[grp * 128 + dv] = part;
    __syncthreads();
    const float kS = (red[dv] + red[128 + dv]) + (red[256 + dv] + red[384 + dv]);
    const float vnew = beta * (v - eg * kS);
    __syncthreads();
    float po = 0.f;
#pragma unroll
    for (int i = 0; i < 32; ++i) { const float sn = eg * s0[i] + ks[grp * 32 + i] * vnew; So[(size_t)(grp * 32 + i) * DKV + dv] = sn; po += qs[grp * 32 + i] * sn; }
    red[grp * 128 + dv] = po;
    __syncthreads();
    if (F.tid < 128) Og[row * 512 + h * 128 + dv] = (red[dv] + red[128 + dv]) + (red[256 + dv] + red[384 + dv]);
    __syncthreads();
}

__device__ __forceinline__ void ogate_phase(const Args& A, Frame& F) {
    const bf16* PB = (const bf16*)(A.ws + WS_RA); bf16* CD = (bf16*)(A.ws + WS_RB); const float* Og = (const float*)(A.ws + WS_RE);
    const int gw = F.vcu * NWAVES + F.wave, NGW = F.G * NWAVES; const int ch0 = 8 * F.lane;
    const f32x4 n0 = *(const f32x4*)(A.in[I_DNN] + (ch0 & 127)), n1 = *(const f32x4*)(A.in[I_DNN] + (ch0 & 127) + 4);
    for (int m = gw; m < MV; m += NGW) {
        const f32x4 o0 = *(const GAS f32x4*)(Og + (size_t)m * 512 + ch0), o1 = *(const GAS f32x4*)(Og + (size_t)m * 512 + ch0 + 4);
        const v4u zz = *(const GAS v4u*)(PB + (size_t)m * PBLD + 2048 + ch0); float z[8]; unpack8(zz, z);
        float ss = (o0[0] * o0[0] + o0[1] * o0[1]) + (o0[2] * o0[2] + o0[3] * o0[3]) + (o1[0] * o1[0] + o1[1] * o1[1]) + (o1[2] * o1[2] + o1[3] * o1[3]);
        ss += __shfl_xor(ss, 1); ss += __shfl_xor(ss, 2); ss += __shfl_xor(ss, 4); ss += __shfl_xor(ss, 8);
        const float rstd = 1.f / sqrtf(ss * (1.f / 128.f) + RMS_EPS);
        float d[8];
#pragma unroll
        for (int i = 0; i < 4; ++i) { d[i] = o0[i] * rstd * n0[i] * silu(z[i]); d[4 + i] = o1[i] * rstd * n1[i] * silu(z[4 + i]); }
        *(GAS v4u*)(CD + (size_t)m * DM + 512 + ch0) = pack8(d);
    }
}

__device__ __forceinline__ void attn_issue(const Args& A, Frame& F, int st, int b, int h, LAS unsigned char* slot) {
    const bf16* KB = (const bf16*)(A.ws + WS_KB); const bf16* VT = (const bf16*)(A.ws + WS_VT);
#pragma unroll
    for (int it = 0; it < 4; ++it) {
        const int idx = it * 512 + F.tid; const bf16* src;
        if (st < 4) { const int r = idx >> 5, p = idx & 31, c = p ^ (r & 15); src = KB + (size_t)(b * NMEM + 64 * st + r) * DM + h * MHD + 8 * c; }
        else { const int r = idx >> 3, p = idx & 7, c = p ^ ((r >> 1) & 7); src = VT + (size_t)(h * MHD + r) * (NB * NMEM) + b * NMEM + 64 * (st - 4) + 8 * c; }
        __builtin_amdgcn_global_load_lds((const unsigned*)src, (LAS unsigned*)(slot + it * 8192 + F.wave * 1024), 16, 0, 0);
    }
}
__device__ __forceinline__ void attn_unit(const Args& A, Frame& F, int rt, int h) {
    using pg8::f32x4;
    const int b = rt >> 4; const int fr = F.lane & 15, fq = F.lane >> 4;
    bf16* Q = (bf16*)(A.ws + WS_RB);
    bf16* qrow = Q + (size_t)(rt * 128 + F.wave * 16 + fr) * DM + h * MHD;
    LAS unsigned char* L = F.lds + RING_OFF;
    bf16x8 qf[8];
#pragma unroll
    for (int ks = 0; ks < 8; ++ks) qf[ks] = *(const GAS bf16x8*)(qrow + 32 * ks + 8 * fq);
    attn_issue(A, F, 0, b, h, L); attn_issue(A, F, 1, b, h, L + 32768);
    f32x4 sacc[16];
#pragma unroll
    for (int st = 0; st < 4; ++st) {
        asm volatile("s_waitcnt vmcnt(4)" ::: "memory");
        __builtin_amdgcn_s_barrier(); asm volatile("" ::: "memory");
        attn_issue(A, F, st + 2, b, h, L + ((st + 2) & 3) * 32768);
        const LAS unsigned char* slot = L + (st & 3) * 32768;
#pragma unroll
        for (int kbl = 0; kbl < 4; ++kbl) { f32x4 acc = (f32x4){0.f, 0.f, 0.f, 0.f}; const int row = 16 * kbl + fr;
#pragma unroll
            for (int ks = 0; ks < 8; ++ks) { const bf16x8 a = *(const LAS bf16x8*)(slot + row * 512 + (((4 * ks + fq) ^ (row & 15)) << 4)); acc = __builtin_amdgcn_mfma_f32_16x16x32_bf16(a, qf[ks], acc, 0, 0, 0); }
            sacc[4 * st + kbl] = acc; }
    }
    float mx = -3.0e38f;
#pragma unroll
    for (int kb = 0; kb < 16; ++kb)
#pragma unroll
        for (int i = 0; i < 4; ++i) mx = fmaxf(mx, sacc[kb][i]);
    mx = fmaxf(mx, __shfl_xor(mx, 16)); mx = fmaxf(mx, __shfl_xor(mx, 32));
    float lsum = 0.f; bf16x8 pb[8];
#pragma unroll
    for (int kb = 0; kb < 16; ++kb)
#pragma unroll
        for (int i = 0; i < 4; ++i) { const float p = __builtin_amdgcn_exp2f(sacc[kb][i] - mx); sacc[kb][i] = p; lsum += p; }
#pragma unroll
    for (int s = 0; s < 8; ++s) pb[s] = pack_pair(sacc[2 * s], sacc[2 * s + 1]);
    lsum += __shfl_xor(lsum, 16); lsum += __shfl_xor(lsum, 32);
    f32x4 oacc[16];
#pragma unroll
    for (int db = 0; db < 16; ++db) oacc[db] = (f32x4){0.f, 0.f, 0.f, 0.f};
#pragma unroll
    for (int st = 4; st < 8; ++st) {
        if (st + 1 < 8) asm volatile("s_waitcnt vmcnt(4)" ::: "memory"); else asm volatile("s_waitcnt vmcnt(0)" ::: "memory");
        __builtin_amdgcn_s_barrier(); asm volatile("" ::: "memory");
        if (st + 2 < 8) attn_issue(A, F, st + 2, b, h, L + ((st + 2) & 3) * 32768);
        const LAS unsigned char* slot = L + (st & 3) * 32768; const int t = st - 4;
#pragma unroll
        for (int db = 0; db < 16; ++db) { const int row = 16 * db + fr; const int sw = (row >> 1) & 7;
#pragma unroll
            for (int s2 = 0; s2 < 2; ++s2) { const int c = 4 * s2 + (fq >> 1);
                const v2u lo = *(const LAS v2u*)(slot + row * 128 + ((c ^ sw) << 4) + 8 * (fq & 1)), hi = *(const LAS v2u*)(slot + row * 128 + (((c + 2) ^ sw) << 4) + 8 * (fq & 1));
                v4u aw; aw.x = lo.x; aw.y = lo.y; aw.z = hi.x; aw.w = hi.y;
                oacc[db] = __builtin_amdgcn_mfma_f32_16x16x32_bf16(__builtin_bit_cast(bf16x8, aw), pb[2 * t + s2], oacc[db], 0, 0, 0); } }
    }
    const float inv = 1.f / lsum;
#pragma unroll
    for (int db = 0; db < 16; ++db) { v2u w; w.x = pk2(oacc[db][0] * inv, oacc[db][1] * inv); w.y = pk2(oacc[db][2] * inv, oacc[db][3] * inv); *(GAS v2u*)(qrow + 16 * db + 4 * fq) = w; }
    LDS_WAIT(); __builtin_amdgcn_s_barrier(); asm volatile("" ::: "memory");
}
__device__ __forceinline__ void attn_sample(const Args& A, Frame& F, int s, int h) {
    bf16* Q = (bf16*)(A.ws + WS_RB); bf16* qrow = Q + (size_t)(MP + s) * DM + h * MHD;
    const float* Kc = A.in[I_CMK] + (size_t)s * NMEM * DM + h * MHD; const float* Vc = A.in[I_CMV] + (size_t)s * NMEM * DM + h * MHD;
    LAS float* pl = (LAS float*)(F.lds + RING_OFF); LAS float* wred = pl + 256; LAS float* ored = pl + 512;
    float q[4]; { const v2u x = *(const GAS v2u*)(qrow + 4 * F.lane); q[0] = bflo(x.x); q[1] = bfhi(x.x); q[2] = bflo(x.y); q[3] = bfhi(x.y); }
    float myscore = 0.f;
#pragma unroll 8
    for (int i = 0; i < 32; ++i) { const f32x4 kv = *(const GAS f32x4*)(Kc + (size_t)(32 * F.wave + i) * DM + 4 * F.lane);
        const float d = wave_sum((kv[0] * q[0] + kv[1] * q[1]) + (kv[2] * q[2] + kv[3] * q[3])); if (F.lane == i) myscore = d; }
    float m = wave_max(F.lane < 32 ? myscore : -3.0e38f);
    if (F.lane == 0) wred[F.wave] = m;
    __syncthreads();
    float gm = wred[0];
#pragma unroll
    for (int i = 1; i < 8; ++i) gm = fmaxf(gm, wred[i]);
    const float p = (F.lane < 32) ? __builtin_amdgcn_exp2f(myscore - gm) : 0.f;
    if (F.lane < 32) pl[32 * F.wave + F.lane] = p;
    const float ws_ = wave_sum(p);
    if (F.lane == 0) wred[8 + F.wave] = ws_;
    __syncthreads();
    float tot = 0.f;
#pragma unroll
    for (int i = 0; i < 8; ++i) tot += wred[8 + i];
    f32x4 acc = (f32x4){0.f, 0.f, 0.f, 0.f};
#pragma unroll 8
    for (int i = 0; i < 32; ++i) { const f32x4 vv = *(const GAS f32x4*)(Vc + (size_t)(32 * F.wave + i) * DM + 4 * F.lane); const float pi = pl[32 * F.wave + i]; acc = acc + vv * pi; }
    *(LAS f32x4*)(ored + F.wave * 256 + 4 * F.lane) = acc;
    __syncthreads();
    if (F.tid < 256) { float o = 0.f;
#pragma unroll
        for (int w = 0; w < 8; ++w) o += ored[w * 256 + F.tid];
        qrow[F.tid] = (bf16)(pk2(o / tot, 0.f) & 0xffffu); }
    __syncthreads();
}


typedef unsigned v2u_ __attribute__((ext_vector_type(2)));
template <int NKS, class Epi>
__device__ __forceinline__ void small_gemm_item(const Frame& F, const bf16* Arow0, const bf16* Bt, int pn, int j, int rq, const Epi& E) {
    using pg8::f32x4;
    constexpr int K = NKS * 256;
    const int fr = F.lane & 15, fq = F.lane >> 4;
    const bf16* ap = Arow0 + (size_t)(32 * rq + fr) * K + F.wave * (K / 8) + 8 * fq;
    const bf16* b0 = Bt + (size_t)(256 * pn + 16 * j + fr) * K + F.wave * (K / 8) + 8 * fq; const bf16* b1 = b0 + (size_t)128 * K;
    bf16x8 a0[NKS], a1[NKS], x0[NKS], x1[NKS];
#pragma unroll
    for (int u = 0; u < NKS; ++u) { a0[u] = *(const GAS bf16x8*)(ap + 32 * u); a1[u] = *(const GAS bf16x8*)(ap + (size_t)16 * K + 32 * u); x0[u] = *(const GAS bf16x8*)(b0 + 32 * u); x1[u] = *(const GAS bf16x8*)(b1 + 32 * u); }
    __builtin_amdgcn_sched_barrier(0);
    f32x4 c00 = (f32x4){0.f, 0.f, 0.f, 0.f}, c01 = c00, c10 = c00, c11 = c00;
#pragma unroll
    for (int u = 0; u < NKS; ++u) {
        c00 = __builtin_amdgcn_mfma_f32_16x16x32_bf16(x0[u], a0[u], c00, 0, 0, 0); c01 = __builtin_amdgcn_mfma_f32_16x16x32_bf16(x1[u], a0[u], c01, 0, 0, 0);
        c10 = __builtin_amdgcn_mfma_f32_16x16x32_bf16(x0[u], a1[u], c10, 0, 0, 0); c11 = __builtin_amdgcn_mfma_f32_16x16x32_bf16(x1[u], a1[u], c11, 0, 0, 0);
    }
    LAS f32x4* red = (LAS f32x4*)(F.lds + RING_OFF);
    red[(F.wave * 4 + 0) * 64 + F.lane] = c00; red[(F.wave * 4 + 1) * 64 + F.lane] = c01; red[(F.wave * 4 + 2) * 64 + F.lane] = c10; red[(F.wave * 4 + 3) * 64 + F.lane] = c11;
    __syncthreads();
    if (F.wave < 2) {
        f32x4 sA = (f32x4){0.f, 0.f, 0.f, 0.f}, sB = sA;
#pragma unroll
        for (int w = 0; w < 8; ++w) { sA = sA + red[(w * 4 + 2 * F.wave) * 64 + F.lane]; sB = sB + red[(w * 4 + 2 * F.wave + 1) * 64 + F.lane]; }
        E(32 * rq + 16 * F.wave + fr, pn, j, fq, sA, sB);
    }
    __syncthreads();
}
__device__ __forceinline__ v2u_ pk4(const pg8::f32x4& a) { v2u_ w; w.x = pk2(a[0], a[1]); w.y = pk2(a[2], a[3]); return w; }
struct SEpiIn { bf16* PBs;
    __device__ __forceinline__ void operator()(int m, int pn, int j, int fq, const pg8::f32x4& a, const pg8::f32x4& b) const {
        if (pn < 4) { pg8::f32x4 v;
#pragma unroll
            for (int i = 0; i < 4; ++i) v[i] = a[i] * sigm(b[i]);
            *(GAS v2u_*)(PBs + (size_t)m * PBLD + 128 * pn + 16 * j + 4 * fq) = pk4(v); }
        else { bf16* rp = PBs + (size_t)m * PBLD + 256 * pn - 512 + 16 * j + 4 * fq; *(GAS v2u_*)rp = pk4(a); *(GAS v2u_*)(rp + 128) = pk4(b); }
    } };
template <bool WRITE_BF> struct SEpiRes { const float* base; float* out; bf16* outb; float* ss;
    __device__ __forceinline__ void operator()(int m, int pn, int j, int fq, const pg8::f32x4& a, const pg8::f32x4& b) const {
        const size_t off = (size_t)m * DM + 256 * pn + 16 * j + 4 * fq;
        const pg8::f32x4 v0 = a + *(const GAS pg8::f32x4*)(base + off), v1 = b + *(const GAS pg8::f32x4*)(base + off + 128);
        *(GAS pg8::f32x4*)(out + off) = v0; *(GAS pg8::f32x4*)(out + off + 128) = v1;
        if (WRITE_BF) { *(GAS v2u_*)(outb + off) = pk4(v0); *(GAS v2u_*)(outb + off + 128) = pk4(v1); }
        float s = (v0[0] * v0[0] + v0[1] * v0[1]) + (v0[2] * v0[2] + v0[3] * v0[3]) + (v1[0] * v1[0] + v1[1] * v1[1]) + (v1[2] * v1[2] + v1[3] * v1[3]);
        s += __shfl_xor(s, 16); s += __shfl_xor(s, 32);
        if (fq == 0) atomicAdd(ss + m, s);
    } };
struct SEpiQ { bf16* Qs; const float* ss; float c2;
    __device__ __forceinline__ void operator()(int m, int pn, int j, int fq, const pg8::f32x4& a, const pg8::f32x4& b) const {
        const float rs = __builtin_amdgcn_rsqf(ss[m] * (1.f / 1024.f) + RMS_EPS) * c2; bf16* rp = Qs + (size_t)m * DM + 256 * pn + 16 * j + 4 * fq;
        *(GAS v2u_*)rp = pk4(a * rs); *(GAS v2u_*)(rp + 128) = pk4(b * rs);
    } };
struct SEpiGU { bf16* Ts; const float* ss;
    __device__ __forceinline__ void operator()(int m, int pn, int j, int fq, const pg8::f32x4& a, const pg8::f32x4& b) const {
        const float rs = __builtin_amdgcn_rsqf(ss[m] * (1.f / 1024.f) + RMS_EPS); pg8::f32x4 v;
#pragma unroll
        for (int i = 0; i < 4; ++i) v[i] = silu(a[i] * rs) * (b[i] * rs);
        *(GAS v2u_*)(Ts + (size_t)m * DFF + 128 * pn + 16 * j + 4 * fq) = pk4(v);
    } };

__device__ __forceinline__ void final_norm_phase(const Args& A, Frame& F) {
    const int gw = F.vcu * NWAVES + F.wave, NGW = F.G * NWAVES; const float* ss = (const float*)(F.ctl + CW_SS3);
    f32x4 gn[4];
#pragma unroll
    for (int j = 0; j < 4; ++j) gn[j] = *(const f32x4*)(A.in[I_NF] + 256 * j + 4 * F.lane);
    for (int m = gw; m < MV; m += NGW) {
        GAS f32x4* xr = (GAS f32x4*)(A.out + (size_t)m * DM) + F.lane;
        const float rstd = 1.f / sqrtf(ss[m] * (1.f / DM) + RMS_EPS);
#pragma unroll
        for (int j = 0; j < 4; ++j) { const f32x4 v = xr[64 * j]; xr[64 * j] = v * rstd * gn[j]; }
    }
}

__global__ void __launch_bounds__(NWAVES * 64, 2) hymba_fwd(Args args) {
    extern __shared__ __attribute__((aligned(16))) unsigned char lds[];
    Frame F;
    F.lds = (LAS unsigned char*)lds;
    F.MISC = (volatile LAS unsigned*)(F.lds + MISC_OFF);
    F.tid = threadIdx.x; F.lane = F.tid & 63; F.wave = __builtin_amdgcn_readfirstlane(F.tid >> 6);
    F.G = gridDim.x; { const int bx = blockIdx.x; F.vcu = (F.G % 8 == 0) ? (bx % 8) * (F.G / 8) + bx / 8 : bx; }
    F.ctl = (gu32*)(args.ws + WS_CTL);
    const Args& A = args;
    for (int u = F.tid; u < (LDS_BYTES - LDSCTL_OFF) / 4; u += NWAVES * 64) ((LAS unsigned*)(F.lds + LDSCTL_OFF))[u] = 0u;
    __syncthreads();
#if MK_PER_PHASE
#define GRID_BAR() do { } while (0)
#else
    XcdBarrier bar = xcd_barrier_post((unsigned*)(F.ctl + CW_BAR) + args.li * XCD_BAR_WORDS, F.MISC + 8);
#define GRID_BAR() xcd_barrier(bar)
#endif
#if 1
    const int lo = args.ph_lo, hi = args.ph_hi;
    const bool rep = (args.li != 0);
#define REPK(k) (rep && lo == (k))
#define IN(k) (lo <= (k) && (k) < hi)
#else
#define REPK(k) false
#define IN(k) true
#endif
#define BOTH(k) (IN(k) && IN((k) + 1))
#define PH_PTRS unsigned char* const ws = args.ws; bf16* const RA = (bf16*)(ws + WS_RA); bf16* const RB = (bf16*)(ws + WS_RB); bf16* const RC = (bf16*)(ws + WS_RC); \
    float* const X1 = (float*)(ws + WS_RD); bf16* const X1B = (bf16*)(ws + WS_RE); float* const X2 = (float*)(ws + WS_RF); \
    float* const SS1 = (float*)(ws + WS_CTL) + CW_SS1; float* const SS2 = (float*)(ws + WS_CTL) + CW_SS2; float* const SS3 = (float*)(ws + WS_CTL) + CW_SS3; float* const SSD = (float*)(ws + WS_CTL) + 163840; \
    (void)RA; (void)RB; (void)RC; (void)X1; (void)X1B; (void)X2; (void)SS1; (void)SS2; (void)SS3; (void)SSD;

    if (IN(0)) { p0_prologue(A, F); if (BOTH(0)) GRID_BAR(); }
    if (IN(1)) { PH_PTRS
        { pg8::Gemm g{RB, (const bf16*)(ws + WS_WIN), MP, 3072, DM}; pg8::StaticOrder S; S.init(MP, 3072, F.G, (int)blockIdx.x);
          pg8::EpiIn E{RA};
          pg8::gemm_phase<pg8::EpiIn, pg8::StaticOrder, true, true>(F.lds + RING_OFF, g, S, E); }
        { pg8::Gemm g{(const bf16*)(ws + WS_MEMN), (const bf16*)(ws + WS_WMKV), NB * NMEM, 2048, DM}; pg8::StaticOrder S; S.init(NB * NMEM, 2048, F.G, (int)blockIdx.x);
          pg8::EpiKV E{A.out + OUT_MKP, A.out + OUT_MVP, (bf16*)(ws + WS_KB), (bf16*)(ws + WS_VT)};
          pg8::gemm_phase<pg8::EpiKV, pg8::StaticOrder, true, true>(F.lds + RING_OFF, g, S, E); }
        { const SEpiIn E{RA + (size_t)MP * PBLD};
          for (int i = F.G - 1 - (int)blockIdx.x; i < 96 * 4; i += F.G) small_gemm_item<4>(F, RB + (size_t)MP * DM, (const bf16*)(ws + WS_WIN), i >> 5, (i >> 2) & 7, i & 3, E); }
        if (BOTH(1)) GRID_BAR();
    }
    if (IN(2)) {
        for (int it = F.vcu; it < 256 + DEC; it += F.G) { if (it < 256) conv_tile(A, F, it >> 5, it & 31); else conv_sample(A, F, it - 256); }
        if (BOTH(2)) GRID_BAR();
    }
    if (IN(3)) {
        for (int ci = F.vcu; ci < NCHUNK; ci += F.G) d1_chunk(A, F, ci);
        if (BOTH(3)) GRID_BAR();
    }
    if (IN(4)) {
        for (int u = F.vcu; u < 256; u += F.G) scan_unit(A, F, u >> 5, (u >> 3) & 3, u & 7);
        for (int it = F.vcu; it < DEC * NH; it += F.G) delta_sample(A, F, it >> 2, it & 3);
        if (BOTH(4)) GRID_BAR();
    }
    if (IN(5)) { ogate_phase(A, F); if (BOTH(5)) GRID_BAR(); }
#ifdef PROBE_BAR
    for (int xb = 0; xb < 10; ++xb) GRID_BAR();
#endif
    if (IN(6)) { PH_PTRS
        pg8::Gemm g{RB, (const bf16*)(ws + WS_WOUT), MP, DM, DM}; pg8::StaticOrder S; S.init(MP, DM, F.G, (int)blockIdx.x);
        pg8::EpiRes<true> E{A.in[I_XP], A.in[I_XS], MV, MR, X1, X1B, REPK(6) ? SSD : SS1};
        pg8::gemm_phase<pg8::EpiRes<true>, pg8::StaticOrder, true, true>(F.lds + RING_OFF, g, S, E);
        { const SEpiRes<true> SE{A.in[I_XS], X1 + (size_t)MP * DM, X1B + (size_t)MP * DM, (REPK(6) ? SSD : SS1) + MP};
          for (int i = F.G - 1 - (int)blockIdx.x; i < 32 * 4; i += F.G) small_gemm_item<4>(F, RB + (size_t)MP * DM, (const bf16*)(ws + WS_WOUT), i >> 5, (i >> 2) & 7, i & 3, SE); }
        if (BOTH(6)) GRID_BAR();
    }
    if (IN(7)) { PH_PTRS
        { pg8::Gemm g{X1B, (const bf16*)(ws + WS_WMQ), MP, DM, DM}; pg8::StaticOrder S; S.init(MP, DM, F.G, (int)blockIdx.x);
        pg8::EpiQ E{RB, SS1, ATT_C2};
        pg8::gemm_phase<pg8::EpiQ, pg8::StaticOrder, true, true>(F.lds + RING_OFF, g, S, E); }
        { const SEpiQ SE{RB + (size_t)MP * DM, SS1 + MP, ATT_C2};
          for (int i = F.G - 1 - (int)blockIdx.x; i < 32 * 4; i += F.G) small_gemm_item<4>(F, X1B + (size_t)MP * DM, (const bf16*)(ws + WS_WMQ), i >> 5, (i >> 2) & 7, i & 3, SE); }
        if (BOTH(7)) GRID_BAR();
    }
    if (IN(8)) {
        for (int u = F.vcu; u < 512; u += F.G) { const int bh = u >> 4; attn_unit(A, F, (bh >> 2) * 16 + (u & 15), bh & 3); }
        for (int it = F.vcu; it < DEC * NH; it += F.G) attn_sample(A, F, it >> 2, it & 3);
        if (BOTH(8)) GRID_BAR();
    }
    if (IN(9)) { PH_PTRS
        pg8::Gemm g{RB, (const bf16*)(ws + WS_WMO), MP, DM, DM}; pg8::StaticOrder S; S.init(MP, DM, F.G, (int)blockIdx.x);
        pg8::EpiRes<true> E{X1, X1 + (size_t)MP * DM, MR, MR, X2, RC, REPK(9) ? SSD : SS2};
        pg8::gemm_phase<pg8::EpiRes<true>, pg8::StaticOrder, true, true>(F.lds + RING_OFF, g, S, E);
        { const SEpiRes<true> SE{X1 + (size_t)MP * DM, X2 + (size_t)MP * DM, RC + (size_t)MP * DM, (REPK(9) ? SSD : SS2) + MP};
          for (int i = F.G - 1 - (int)blockIdx.x; i < 32 * 4; i += F.G) small_gemm_item<4>(F, RB + (size_t)MP * DM, (const bf16*)(ws + WS_WMO), i >> 5, (i >> 2) & 7, i & 3, SE); }
        if (BOTH(9)) GRID_BAR();
    }
    if (IN(10)) { PH_PTRS
        pg8::Gemm g{RC, (const bf16*)(ws + WS_WGU), MP, 2 * DFF, DM}; pg8::StaticOrder S; S.init(MP, 2 * DFF, F.G, (int)blockIdx.x);
        pg8::EpiGU E{RA, SS2};
        pg8::gemm_phase<pg8::EpiGU, pg8::StaticOrder, true, true>(F.lds + RING_OFF, g, S, E);
        { const SEpiGU SE{RA + (size_t)MP * DFF, SS2 + MP};
          for (int i = F.G - 1 - (int)blockIdx.x; i < 176 * 4; i += F.G) small_gemm_item<4>(F, RC + (size_t)MP * DM, (const bf16*)(ws + WS_WGU), i >> 5, (i >> 2) & 7, i & 3, SE); }
        if (BOTH(10)) GRID_BAR();
    }
#ifdef PROBE_X
    {   PH_PTRS
        GRID_BAR();
        pg8::Gemm g{RC, (const bf16*)(ws + WS_WGU), MP, PROBE_X, DM}; pg8::StaticOrder S; S.init(MP, PROBE_X, F.G, (int)blockIdx.x);
        pg8::EpiGU E{RA, SS2};
        pg8::gemm_phase<pg8::EpiGU, pg8::StaticOrder, true, true>(F.lds + RING_OFF, g, S, E);
        GRID_BAR();
    }
#endif
    if (IN(11)) { PH_PTRS
        pg8::Gemm g{RA, (const bf16*)(ws + WS_WDN), MP, DM, DFF}; pg8::StaticOrder S; S.init(MP, DM, F.G, (int)blockIdx.x);
        pg8::EpiRes<false> E{X2, X2 + (size_t)MP * DM, MR, MV, A.out, nullptr, REPK(11) ? SSD : SS3};
        pg8::gemm_phase<pg8::EpiRes<false>, pg8::StaticOrder, true, true>(F.lds + RING_OFF, g, S, E);
        { const SEpiRes<false> SE{X2 + (size_t)MP * DM, A.out + (size_t)MP * DM, nullptr, (REPK(11) ? SSD : SS3) + MP};
          for (int i = F.G - 1 - (int)blockIdx.x; i < 32 * 4; i += F.G) small_gemm_item<11>(F, RA + (size_t)MP * DFF, (const bf16*)(ws + WS_WDN), i >> 5, (i >> 2) & 7, i & 3, SE); }
        if (BOTH(11)) GRID_BAR();
    }
    if (IN(12)) final_norm_phase(A, F);
#undef IN
#undef BOTH
}

extern "C" void kernel_launch(void* const* d_in, const int* in_sizes, int n_in, void* d_out, int out_size, void* d_ws, size_t ws_size, hipStream_t stream) {
    static int grid = 0;
    if (grid == 0) {
        if (n_in != 30 || in_sizes[0] != MP * DM || (size_t)out_size != OUT_END || ws_size < WS_END) {
            fprintf(stderr, "kernel_launch: unexpected shapes: n_in %d, in0 %d, out %d, ws %zu (need >= %zu); nothing launched\n", n_in, n_in > 0 ? in_sizes[0] : -1, out_size, ws_size, (size_t)WS_END); grid = -1; return; }
        int dev = 0, cus = 0, per_cu = 0;
        if (hipGetDevice(&dev) != hipSuccess || hipDeviceGetAttribute(&cus, hipDeviceAttributeMultiprocessorCount, dev) != hipSuccess) { fprintf(stderr, "kernel_launch: device query failed\n"); grid = -1; return; }
        if (hipFuncSetAttribute((const void*)hymba_fwd, hipFuncAttributeMaxDynamicSharedMemorySize, LDS_BYTES) != hipSuccess) { fprintf(stderr, "kernel_launch: hipFuncSetAttribute failed\n"); grid = -1; return; }
        if (hipOccupancyMaxActiveBlocksPerMultiprocessor(&per_cu, (const void*)hymba_fwd, NWAVES * 64, LDS_BYTES) != hipSuccess || per_cu < 1)
            fprintf(stderr, "kernel_launch: note: occupancy query reports %d workgroups per CU\n", per_cu);
        (void)hipGetLastError();
        grid = cus;
    }
    if (grid < 0) return;
    if (hipMemsetAsync((char*)d_ws + WS_CTL, 0, CTL_ZERO_BYTES, stream) != hipSuccess) { fprintf(stderr, "kernel_launch: hipMemsetAsync failed\n"); return; }
    Args a{};
    for (int i = 0; i < 30; ++i) a.in[i] = (const float*)d_in[i];
    a.out = (float*)d_out; a.ws = (unsigned char*)d_ws;
#if MK_PER_PHASE
    for (int ph = 0; ph < N_PHASES; ++ph) { a.ph_lo = ph; a.ph_hi = ph + 1; a.li = 0;
        hipLaunchKernelGGL(hymba_fwd, dim3(grid), dim3(NWAVES * 64), LDS_BYTES, stream, a); }
#else
#ifdef PROBE_PH
    a.ph_lo = 0; a.ph_hi = PROBE_PH + 1; a.li = 0;
    hipLaunchKernelGGL(hymba_fwd, dim3(grid), dim3(NWAVES * 64), LDS_BYTES, stream, a);
#ifdef PROBE_REPS
    for (int r_ = 0; r_ < PROBE_REPS; ++r_) { a.ph_lo = PROBE_PH; a.ph_hi = PROBE_PH + 1; a.li = 2 + r_; a.pad = PROBE_MODE; hipLaunchKernelGGL(hymba_fwd, dim3(grid), dim3(NWAVES * 64), LDS_BYTES, stream, a); }
#endif
    a.ph_lo = PROBE_PH; a.ph_hi = N_PHASES; a.li = 1; a.pad = 0;
    hipLaunchKernelGGL(hymba_fwd, dim3(grid), dim3(NWAVES * 64), LDS_BYTES, stream, a);
#else
    a.ph_lo = 0; a.ph_hi = N_PHASES; a.li = 0;
    hipLaunchKernelGGL(hymba_fwd, dim3(grid), dim3(NWAVES * 64), LDS_BYTES, stream, a);
#endif
#endif
    const hipError_t le = hipPeekAtLastError();
    if (le != hipSuccess) fprintf(stderr, "kernel_launch: launch failed: %s\n", hipGetErrorName(le));
}
```

```cpp
#include <hip/hip_runtime.h>
#include <cstdio>
#include <cstdint>
#define MK_PER_PHASE 0
namespace pg8 {
#define PG8_LAS __attribute__((address_space(3)))
typedef unsigned short bf16_t;
typedef short bf16x8 __attribute__((ext_vector_type(8)));
typedef float f32x4 __attribute__((ext_vector_type(4)));
typedef unsigned u32x4 __attribute__((ext_vector_type(4)));
constexpr int BM = 256, BK = 64, HALF = 128, HTB = HALF * BK * 2  , STAGE_BYTES = 8 * HTB, NXCD = 8, WGM = 8;

__host__ __device__ __forceinline__ int lds_byte(int r, int c) { const int st = (r >> 4) * 2 + (c >> 5), rr = r & 15, cc = c & 31, ob = rr * 64 + cc * 2; return st * 1024 + (ob ^ (((ob >> 9) & 1) << 5)); }
__host__ __device__ __forceinline__ void stage_rc(int b, int& R, int& C) { const int st = b / 1024, sb = b % 1024, swz = sb ^ (((sb >> 9) & 1) << 5); R = (st >> 1) * 16 + swz / 64; C = (st & 1) * 32 + (swz % 64) / 2; }
__host__ __device__ __forceinline__ int perm32(int rho) { const int n = rho >> 4, i = rho & 15; return 8 * (i >> 2) + 4 * n + (i & 3); }

struct Unit { int pm, pn; };
struct Gemm { const bf16_t* A; const bf16_t* Bt; int M, N, K; };

struct StaticOrder {
    int nM, nN, nwg, G, c;
    __host__ __device__ __forceinline__ void init(int M, int N, int G_, int c_) { nM = M / BM; nN = N / BM; nwg = nM * nN; G = G_; c = c_; }
    __host__ __device__ __forceinline__ bool next(int i, Unit& u) const {
        const long L = (long)i * G + c; if (L >= nwg) return false;
        int wgid = (int)L; { const int q = nwg / NXCD, r = nwg % NXCD, xcd = wgid % NXCD, off = wgid / NXCD; wgid = (xcd < r ? xcd * (q + 1) : r * (q + 1) + (xcd - r) * q) + off; }
        const int nig = WGM * nN, gid = wgid / nig, fm = gid * WGM, gsz = (nM - fm) < WGM ? (nM - fm) : WGM;
        u.pm = fm + ((wgid % nig) % gsz); u.pn = (wgid % nig) / gsz; return true;
    }
    __device__ __forceinline__ void a_ready(const Unit&) const {}
    __device__ __forceinline__ void done(const Unit&) const {}
};

__device__ __forceinline__ unsigned cvt_pk_bf16(float lo, float hi) { unsigned r; asm volatile("v_cvt_pk_bf16_f32 %0, %1, %2" : "=v"(r) : "v"(lo), "v"(hi)); return r; }
typedef float f32x2_t __attribute__((ext_vector_type(2))); typedef __bf16 bf16x2_t __attribute__((ext_vector_type(2)));
__device__ __forceinline__ unsigned pk2(float lo, float hi) { f32x2_t v = {lo, hi}; bf16x2_t b = __builtin_convertvector(v, bf16x2_t); return __builtin_bit_cast(unsigned, b); }
__device__ __forceinline__ float sigm(float x) { return __builtin_amdgcn_rcpf(1.f + __expf(-x)); }
__device__ __forceinline__ float silu(float x) { return x * __builtin_amdgcn_rcpf(1.f + __expf(-x)); }
__device__ __forceinline__ u32x4 pk8(const f32x4& a, const f32x4& b) { u32x4 w; w.x = pk2(a[0], a[1]); w.y = pk2(a[2], a[3]); w.z = pk2(b[0], b[1]); w.w = pk2(b[2], b[3]); return w; }
constexpr int PBLD = 2560;
constexpr int MPROMPT = 16384;
constexpr float RMS_EPS = 1e-6f;

struct EpiIn {
    static constexpr bool PERM = true, AFTER_DRAIN = false;
    bf16_t* PB;
    __device__ __forceinline__ void operator()(const f32x4 (&acc)[2][2][4][2], const Unit& u, int wr, int wc, int fr, int fq) const {
        const int row0 = u.pm * BM + wr * 64 + fr;
        if (u.pn < 4) {
            const int ch0 = u.pn * 128 + wc * 32 + 8 * fq;
#pragma unroll
            for (int ai = 0; ai < 2; ++ai)
#pragma unroll
                for (int m = 0; m < 4; ++m) {
                    bf16_t* rowp = PB + (size_t)(row0 + ai * HALF + m * 16) * PBLD + ch0;
                    f32x4 v0, v1;
#pragma unroll
                    for (int i = 0; i < 4; ++i) { v0[i] = acc[ai][0][m][0][i] * sigm(acc[ai][1][m][0][i]); v1[i] = acc[ai][0][m][1][i] * sigm(acc[ai][1][m][1][i]); }
                    *(u32x4*)rowp = pk8(v0, v1);
                }
        } else {
            const int col0 = u.pn * BM - 512 + wc * 32 + 8 * fq;
#pragma unroll
            for (int ai = 0; ai < 2; ++ai)
#pragma unroll
                for (int m = 0; m < 4; ++m) {
                    bf16_t* rowp = PB + (size_t)(row0 + ai * HALF + m * 16) * PBLD + col0;
#pragma unroll
                    for (int bj = 0; bj < 2; ++bj) *(u32x4*)(rowp + bj * HALF) = pk8(acc[ai][bj][m][0], acc[ai][bj][m][1]);
                }
        }
    }
};

struct EpiKV {
    static constexpr bool PERM = true, AFTER_DRAIN = false;
    float* outK; float* outV; bf16_t* KB; bf16_t* VT;
    __device__ __forceinline__ void operator()(const f32x4 (&acc)[2][2][4][2], const Unit& u, int wr, int wc, int fr, int fq) const {
        const int row0 = u.pm * BM + wr * 64 + fr;
        const bool isv = u.pn >= 4;
        const int c0 = (isv ? u.pn - 4 : u.pn) * BM + wc * 32 + 8 * fq;
        float* outp = isv ? outV : outK;
#pragma unroll
        for (int ai = 0; ai < 2; ++ai)
#pragma unroll
            for (int m = 0; m < 4; ++m) {
                const int row = row0 + ai * HALF + m * 16;
#pragma unroll
                for (int bj = 0; bj < 2; ++bj) {
                    const int col = c0 + bj * HALF;
                    const f32x4 a = acc[ai][bj][m][0], b = acc[ai][bj][m][1];
                    *(f32x4*)(outp + (size_t)row * 1024 + col) = a; *(f32x4*)(outp + (size_t)row * 1024 + col + 4) = b;
                    const u32x4 w = pk8(a, b);
                    if (!isv) *(u32x4*)(KB + (size_t)row * 1024 + col) = w;
                    else {
                        bf16_t* vp = VT + (size_t)col * 2048 + row;
                        vp[0 * 2048] = (bf16_t)(w.x & 0xffffu); vp[1 * 2048] = (bf16_t)(w.x >> 16); vp[2 * 2048] = (bf16_t)(w.y & 0xffffu); vp[3 * 2048] = (bf16_t)(w.y >> 16);
                        vp[4 * 2048] = (bf16_t)(w.z & 0xffffu); vp[5 * 2048] = (bf16_t)(w.z >> 16); vp[6 * 2048] = (bf16_t)(w.w & 0xffffu); vp[7 * 2048] = (bf16_t)(w.w >> 16);
                    }
                }
            }
    }
};

template <bool WRITE_BF> struct EpiRes {
    static constexpr bool PERM = true, AFTER_DRAIN = false;
    const float* base_main; const float* base_tail;
    int load_limit, store_limit;
    float* out; bf16_t* outb; float* ss;
    __device__ __forceinline__ void operator()(const f32x4 (&acc)[2][2][4][2], const Unit& u, int wr, int wc, int fr, int fq) const {
        const int row0 = u.pm * BM + wr * 64 + fr; const int col0 = u.pn * BM + wc * 32 + 8 * fq;
        const float* bp = (u.pm >= 64) ? base_tail - (size_t)MPROMPT * 1024 : base_main;
#pragma unroll
        for (int ai = 0; ai < 2; ++ai)
#pragma unroll
            for (int m = 0; m < 4; ++m) {
                const int row = row0 + ai * HALF + m * 16; const size_t off = (size_t)row * 1024 + col0;
                float s = 0.f;
#pragma unroll
                for (int bj = 0; bj < 2; ++bj) {
                    f32x4 b0 = (f32x4){0.f, 0.f, 0.f, 0.f}, b1 = b0;
                    if (row < load_limit) { b0 = *(const f32x4*)(bp + off + bj * HALF); b1 = *(const f32x4*)(bp + off + bj * HALF + 4); }
                    const f32x4 v0 = acc[ai][bj][m][0] + b0, v1 = acc[ai][bj][m][1] + b1;
                    s += (v0[0] * v0[0] + v0[1] * v0[1]) + (v0[2] * v0[2] + v0[3] * v0[3]) + (v1[0] * v1[0] + v1[1] * v1[1]) + (v1[2] * v1[2] + v1[3] * v1[3]);
                    if (row < store_limit) { *(f32x4*)(out + off + bj * HALF) = v0; *(f32x4*)(out + off + bj * HALF + 4) = v1; }
                    if (WRITE_BF) *(u32x4*)(outb + off + bj * HALF) = pk8(v0, v1);
                }
                s += __shfl_xor(s, 16); s += __shfl_xor(s, 32);
                if (fq == 0) atomicAdd(ss + row, s);
            }
    }
};

struct EpiQ {
    static constexpr bool PERM = true, AFTER_DRAIN = false;
    bf16_t* Q; const float* ss; float c2;
    __device__ __forceinline__ void operator()(const f32x4 (&acc)[2][2][4][2], const Unit& u, int wr, int wc, int fr, int fq) const {
        const int row0 = u.pm * BM + wr * 64 + fr; const int col0 = u.pn * BM + wc * 32 + 8 * fq;
#pragma unroll
        for (int ai = 0; ai < 2; ++ai)
#pragma unroll
            for (int m = 0; m < 4; ++m) {
                const int row = row0 + ai * HALF + m * 16;
                const float rs = __builtin_amdgcn_rsqf(ss[row] * (1.f / 1024.f) + RMS_EPS) * c2;
#pragma unroll
                for (int bj = 0; bj < 2; ++bj) *(u32x4*)(Q + (size_t)row * 1024 + col0 + bj * HALF) = pk8(acc[ai][bj][m][0] * rs, acc[ai][bj][m][1] * rs);
            }
    }
};

struct EpiGU {
    static constexpr bool PERM = true, AFTER_DRAIN = false;
    bf16_t* T; const float* ss;
    __device__ __forceinline__ void operator()(const f32x4 (&acc)[2][2][4][2], const Unit& u, int wr, int wc, int fr, int fq) const {
        const int row0 = u.pm * BM + wr * 64 + fr; const int ch0 = u.pn * 128 + wc * 32 + 8 * fq;
#pragma unroll
        for (int ai = 0; ai < 2; ++ai)
#pragma unroll
            for (int m = 0; m < 4; ++m) {
                const int row = row0 + ai * HALF + m * 16;
                const float rs = __builtin_amdgcn_rsqf(ss[row] * (1.f / 1024.f) + RMS_EPS);
                f32x4 v0, v1;
#pragma unroll
                for (int i = 0; i < 4; ++i) { v0[i] = silu(acc[ai][0][m][0][i] * rs) * (acc[ai][1][m][0][i] * rs); v1[i] = silu(acc[ai][0][m][1][i] * rs) * (acc[ai][1][m][1][i] * rs); }
                *(u32x4*)(T + (size_t)row * 2816 + ch0) = pk8(v0, v1);
            }
    }
};

template <class Epi, class Sched, bool ALIGN_EPI = false, bool SP2 = false>
__device__ __forceinline__ void gemm_phase(PG8_LAS unsigned char* lds, const Gemm g, const Sched& S, const Epi& E) {
    const int tid = threadIdx.x, wid = __builtin_amdgcn_readfirstlane(tid >> 6), lane = tid & 63, wr = wid >> 2, wc = wid & 3, fr = lane & 15, fq = lane >> 4;
    const int K = g.K, nt = K / BK;
    unsigned voffA[2], voffB[2];
#pragma unroll
    for (int i = 0; i < 2; ++i) { int R, C; stage_rc(tid * 16 + i * 8192, R, C); const int Rb = Epi::PERM ? ((R & ~31) + perm32(R & 31)) : R;
        voffA[i] = (unsigned)(R * K + C) * 2u; voffB[i] = (unsigned)(Rb * K + C) * 2u; }
    const size_t kstep = (size_t)(BK * 2);
    const size_t hstep = (size_t)HALF * K * 2;
    const size_t tstep = 2 * hstep;
    const unsigned ldsw = (unsigned)wid * 1024u;
    const int aoff = lds_byte(wr * 64 + fr, fq * 8), boff = lds_byte(wc * 32 + fr, fq * 8);
#define PG8_SA(b, h) (((b) * 2 + (h)) * HTB)
#define PG8_SB(b, h) ((4 + (b) * 2 + (h)) * HTB)
#define PG8_STAGE(bufoff, gbase, voff) do { _Pragma("unroll") for (int _i = 0; _i < 2; ++_i) \
        __builtin_amdgcn_global_load_lds((const unsigned*)((const char*)(gbase) + (voff)[_i]), (PG8_LAS unsigned*)(lds + (bufoff) + ldsw + _i * 8192), 16, 0, 0); } while (0)
#define PG8_LDA(dst, b, h) do { _Pragma("unroll") for (int m = 0; m < 4; ++m) _Pragma("unroll") for (int k = 0; k < 2; ++k) dst[m][k] = *(const PG8_LAS bf16x8*)(lds + PG8_SA(b, h) + aoff + m * 2048 + k * 1024); } while (0)
#define PG8_LDB(dst, b, h) do { _Pragma("unroll") for (int n = 0; n < 2; ++n) _Pragma("unroll") for (int k = 0; k < 2; ++k) dst[n][k] = *(const PG8_LAS bf16x8*)(lds + PG8_SB(b, h) + boff + n * 2048 + k * 1024); } while (0)
#define PG8_MMA(ai, bj, At, Bt) do { __builtin_amdgcn_s_setprio(1); _Pragma("unroll") for (int m = 0; m < 4; ++m) _Pragma("unroll") for (int n = 0; n < 2; ++n) _Pragma("unroll") for (int k = 0; k < 2; ++k) \
        acc[ai][bj][m][n] = __builtin_amdgcn_mfma_f32_16x16x32_bf16(Bt[n][k], At[m][k], acc[ai][bj][m][n], 0, 0, 0); __builtin_amdgcn_s_setprio(0); } while (0)
#define PG8_WAIT_V(n) asm volatile("s_waitcnt vmcnt(" #n ")" ::: "memory")
#define PG8_WAIT_L(n) asm volatile("s_waitcnt lgkmcnt(" #n ")" ::: "memory")
#define PG8_BAR __builtin_amdgcn_s_barrier()
#define PG8_SCHED __builtin_amdgcn_sched_barrier(0)
    Unit cur, nxt; int ui = 0;
    if (!S.next(0, cur)) return;
    f32x4 acc[2][2][4][2];
#pragma unroll
    for (int a = 0; a < 2; ++a)
#pragma unroll
        for (int b = 0; b < 2; ++b)
#pragma unroll
            for (int m = 0; m < 4; ++m)
#pragma unroll
                for (int n = 0; n < 2; ++n) acc[a][b][m][n] = (f32x4){0.f, 0.f, 0.f, 0.f};
    bf16x8 At[4][2], B0[2][2], B1[2][2];
    const char* cA = (const char*)g.A + (size_t)cur.pm * tstep; const char* cB = (const char*)g.Bt + (size_t)cur.pn * tstep;
    S.a_ready(cur);
    if constexpr (SP2) {
        PG8_STAGE(PG8_SB(0, 0), cB, voffB); PG8_STAGE(PG8_SB(0, 1), cB + hstep, voffB); PG8_STAGE(PG8_SA(0, 0), cA, voffA); PG8_STAGE(PG8_SA(0, 1), cA + hstep, voffA);
        if (wr == 1) PG8_BAR;
        PG8_WAIT_V(2); PG8_BAR;
        PG8_STAGE(PG8_SB(1, 0), cB + kstep, voffB); PG8_STAGE(PG8_SA(1, 0), cA + kstep, voffA); PG8_STAGE(PG8_SB(1, 1), cB + hstep + kstep, voffB);
        PG8_WAIT_V(6); PG8_BAR;
    } else {
        PG8_STAGE(PG8_SB(0, 0), cB, voffB); PG8_STAGE(PG8_SA(0, 0), cA, voffA); PG8_STAGE(PG8_SB(0, 1), cB + hstep, voffB); PG8_STAGE(PG8_SA(0, 1), cA + hstep, voffA);
        if (wr == 1) PG8_BAR;
        PG8_WAIT_V(4); PG8_BAR;
        PG8_STAGE(PG8_SB(1, 0), cB + kstep, voffB); PG8_STAGE(PG8_SA(1, 0), cA + kstep, voffA); PG8_STAGE(PG8_SB(1, 1), cB + hstep + kstep, voffB);
        PG8_WAIT_V(6); PG8_BAR;
    }
    for (;;) {
        const bool has_next = S.next(ui + 1, nxt);
        const char* nA = has_next ? (const char*)g.A + (size_t)nxt.pm * tstep : cA; const char* nB = has_next ? (const char*)g.Bt + (size_t)nxt.pn * tstep : cB;
        for (int t = 0; t < nt; t += 2) {
            const bool last = (t == nt - 2);
            const char* a1 = cA + (size_t)(t + 1) * kstep;
            const char* a2 = last ? nA : cA + (size_t)(t + 2) * kstep; const char* b2 = last ? nB : cB + (size_t)(t + 2) * kstep;
            const char* a3 = a2 + kstep; const char* b3 = b2 + kstep;
            if (last && has_next) S.a_ready(nxt);
            if constexpr (SP2) {
            PG8_LDB(B0, 0, 0); PG8_LDB(B1, 0, 1); PG8_SCHED; PG8_LDA(At, 0, 0); PG8_STAGE(PG8_SA(1, 1), a1 + hstep, voffA);
            PG8_WAIT_V(8); PG8_WAIT_L(0); PG8_BAR; PG8_MMA(0, 0, At, B0); PG8_MMA(0, 1, At, B1); PG8_BAR; PG8_SCHED;
            PG8_LDA(At, 0, 1); PG8_STAGE(PG8_SB(0, 0), b2, voffB); PG8_STAGE(PG8_SB(0, 1), b2 + hstep, voffB); PG8_STAGE(PG8_SA(0, 0), a2, voffA);
            PG8_WAIT_V(8); PG8_WAIT_L(0); PG8_BAR; PG8_MMA(1, 0, At, B0); PG8_MMA(1, 1, At, B1); PG8_BAR; PG8_SCHED;
            PG8_LDB(B0, 1, 0); PG8_LDB(B1, 1, 1); PG8_SCHED; PG8_LDA(At, 1, 0); PG8_STAGE(PG8_SA(0, 1), a2 + hstep, voffA);
            PG8_WAIT_V(8); PG8_WAIT_L(0); PG8_BAR; PG8_MMA(0, 0, At, B0); PG8_MMA(0, 1, At, B1); PG8_BAR; PG8_SCHED;
            PG8_LDA(At, 1, 1); PG8_STAGE(PG8_SB(1, 0), b3, voffB); PG8_STAGE(PG8_SB(1, 1), b3 + hstep, voffB); PG8_STAGE(PG8_SA(1, 0), a3, voffA);
            PG8_WAIT_V(8); PG8_WAIT_L(0); PG8_BAR; PG8_MMA(1, 0, At, B0); PG8_MMA(1, 1, At, B1); PG8_BAR; PG8_SCHED;
            } else {
            PG8_LDB(B0, 0, 0); PG8_SCHED; PG8_LDA(At, 0, 0); PG8_STAGE(PG8_SA(1, 1), a1 + hstep, voffA);
            PG8_WAIT_L(8); PG8_BAR; PG8_WAIT_L(0); PG8_MMA(0, 0, At, B0); PG8_BAR; PG8_SCHED;
            PG8_LDB(B1, 0, 1); PG8_STAGE(PG8_SB(0, 0), b2, voffB);
            PG8_BAR; PG8_WAIT_L(0); PG8_MMA(0, 1, At, B1); PG8_BAR;
            PG8_LDA(At, 0, 1); PG8_STAGE(PG8_SA(0, 0), a2, voffA);
            PG8_BAR; PG8_WAIT_L(0); PG8_MMA(1, 0, At, B0); PG8_BAR; PG8_SCHED;
            PG8_STAGE(PG8_SB(0, 1), b2 + hstep, voffB);
            PG8_WAIT_V(6); PG8_BAR; PG8_MMA(1, 1, At, B1); PG8_BAR;
            PG8_LDB(B0, 1, 0); PG8_SCHED; PG8_LDA(At, 1, 0); PG8_STAGE(PG8_SA(0, 1), a2 + hstep, voffA);
            PG8_WAIT_L(8); PG8_BAR; PG8_WAIT_L(0); PG8_MMA(0, 0, At, B0); PG8_BAR; PG8_SCHED;
            PG8_LDB(B1, 1, 1); PG8_STAGE(PG8_SB(1, 0), b3, voffB);
            PG8_BAR; PG8_WAIT_L(0); PG8_MMA(0, 1, At, B1); PG8_BAR;
            PG8_LDA(At, 1, 1); PG8_STAGE(PG8_SA(1, 0), a3, voffA);
            PG8_BAR; PG8_WAIT_L(0); PG8_MMA(1, 0, At, B0); PG8_BAR; PG8_SCHED;
            PG8_STAGE(PG8_SB(1, 1), b3 + hstep, voffB);
            PG8_WAIT_V(6); PG8_BAR; PG8_MMA(1, 1, At, B1); PG8_BAR;
            }
        }
        if constexpr (ALIGN_EPI) { if (wr == 0) PG8_BAR; }
        if constexpr (!Epi::AFTER_DRAIN) { E(acc, cur, wr, wc, fr, fq); S.done(cur); }
        if (!has_next) break;
#pragma unroll
        for (int a = 0; a < 2; ++a)
#pragma unroll
            for (int b = 0; b < 2; ++b)
#pragma unroll
                for (int m = 0; m < 4; ++m)
#pragma unroll
                    for (int n = 0; n < 2; ++n) acc[a][b][m][n] = (f32x4){0.f, 0.f, 0.f, 0.f};
        cur = nxt; cA = nA; cB = nB; ++ui;
        if constexpr (ALIGN_EPI) { if (wr == 1) PG8_BAR; }
    }
    PG8_WAIT_V(0);
    if constexpr (!ALIGN_EPI) { if (wr == 0) PG8_BAR; }
    PG8_BAR;
    if constexpr (Epi::AFTER_DRAIN) { E.fused(acc, cur, wr, wc, fr, fq, lds, wid, lane); S.done(cur); }
#undef PG8_SA
#undef PG8_SB
#undef PG8_STAGE
#undef PG8_LDA
#undef PG8_LDB
#undef PG8_MMA
#undef PG8_WAIT_V
#undef PG8_WAIT_L
#undef PG8_BAR
#undef PG8_SCHED
}
}

constexpr int NWAVES = 8;
#ifndef MK_PER_PHASE
#define MK_PER_PHASE 0
#endif
constexpr int N_PHASES = 11;

constexpr int DM = 1024, NB = 8, SEQ = 2048, MP = NB * SEQ  , DEC = 128, MV = MP + DEC  , MR = 16640  ;
constexpr int CC = 512, CW = 31, NH = 4, DKV = 128, QKVN = 1536, NMEM = 256, MHD = 256, DFF = 2816, INC = 3080;
constexpr int PBLD = pg8::PBLD;
constexpr int NCHUNK = NB * NH * 32;
constexpr float RMS_EPS = 1e-6f;
constexpr float ATT_C2 = 0.0625f * 1.4426950408889634f;

constexpr size_t OUT_YP = 0, OUT_YS = 16777216, OUT_CONVP = 16908288, OUT_SCP = 17031168, OUT_DLP = 17068032, OUT_MKP = 17592320, OUT_MVP = 19689472,
                 OUT_CONVS = 21786624, OUT_SCS = 23752704, OUT_DLS = 24342528, OUT_END = 32731136;

constexpr size_t MiB = 1u << 20;
constexpr size_t WS_CTL = 0, CTL_ZERO_BYTES = 1 * MiB;
constexpr size_t WS_WIN = 1 * MiB, WS_WOUT = 7 * MiB, WS_WMQ = 9 * MiB, WS_WMKV = 11 * MiB, WS_WMO = 15 * MiB, WS_WGU = 17 * MiB, WS_WDN = 28 * MiB;
constexpr size_t WS_BG = 34 * MiB, WS_MEMN = 35 * MiB, WS_KB = 39 * MiB, WS_VT = 43 * MiB, WS_GL = 47 * MiB, WS_X1S = 47 * MiB + 65536;
constexpr size_t WS_RA = 48 * MiB;
constexpr size_t WS_RB = 138 * MiB;
constexpr size_t WS_RC = 171 * MiB;
constexpr size_t WS_RD = 220 * MiB;
constexpr size_t WS_U = WS_RD, WS_W = 252 * MiB, WS_QG = 268 * MiB, WS_KDT = 284 * MiB, WS_QK = 300 * MiB;
constexpr size_t WS_RE = 308 * MiB;
constexpr size_t WS_RF = 341 * MiB;
constexpr size_t WS_END = 406 * MiB;
constexpr int CW_TMO = 0, CW_CODE = 1, CW_BAR = 4096, CW_SS1 = 65536, CW_SS2 = 98304, CW_SS3 = 131072;

constexpr int RING_OFF = 0, RING_BYTES = 143360;
constexpr int LDSCTL_OFF = RING_BYTES, MISC_OFF = LDSCTL_OFF + 320;
constexpr int LDS_BYTES = 147456;

#define GAS __attribute__((address_space(1)))
#define LAS __attribute__((address_space(3)))
typedef unsigned short bf16;
typedef unsigned v4u __attribute__((ext_vector_type(4)));
typedef unsigned v2u __attribute__((ext_vector_type(2)));
typedef float f32x4 __attribute__((ext_vector_type(4)));
typedef float f32x16 __attribute__((ext_vector_type(16)));
typedef short bf16x8 __attribute__((ext_vector_type(8)));
typedef GAS unsigned gu32;
#define RLX_AGENT __ATOMIC_RELAXED, __HIP_MEMORY_SCOPE_AGENT
#define LDS_WAIT() asm volatile("s_waitcnt lgkmcnt(0)" ::: "memory")
#define VM_WAIT() asm volatile("s_waitcnt vmcnt(0)" ::: "memory")
using pg8::pk2; using pg8::silu; using pg8::sigm;
__device__ __forceinline__ float bf2f(unsigned b) { return __uint_as_float(b << 16); }
__device__ __forceinline__ float bflo(unsigned w) { return __uint_as_float(w << 16); }
__device__ __forceinline__ float bfhi(unsigned w) { return __uint_as_float(w & 0xffff0000u); }
__device__ __forceinline__ void unpack8(const v4u& w, float (&f)[8]) { f[0] = bflo(w.x); f[1] = bfhi(w.x); f[2] = bflo(w.y); f[3] = bfhi(w.y); f[4] = bflo(w.z); f[5] = bfhi(w.z); f[6] = bflo(w.w); f[7] = bfhi(w.w); }
__device__ __forceinline__ v4u pack8(const float (&f)[8]) { v4u w; w.x = pk2(f[0], f[1]); w.y = pk2(f[2], f[3]); w.z = pk2(f[4], f[5]); w.w = pk2(f[6], f[7]); return w; }
__device__ __forceinline__ float wave_sum(float v) {
#pragma unroll
    for (int o = 1; o < 64; o <<= 1) v += __shfl_xor(v, o);
    return v;
}
__device__ __forceinline__ float wave_max(float v) {
#pragma unroll
    for (int o = 1; o < 64; o <<= 1) v = fmaxf(v, __shfl_xor(v, o));
    return v;
}

#define XB_TMO      128
#define XB_XCNT(j)  (256  + 64 * (j))
#define XB_XSUB(j)  (1280 + 64 * (j))
#define XB_XGEN(j)  (2304 + 64 * (j))
#define XB_TOP      3328
#define XB_TOPGEN   3392
#define XCD_BAR_WORDS 3456
#define XB_SPIN_CAP (1u << 18)

__device__ __forceinline__ unsigned xb_ld(unsigned* p)              { return __hip_atomic_load(p, __ATOMIC_RELAXED, __HIP_MEMORY_SCOPE_AGENT); }
__device__ __forceinline__ unsigned xb_add(unsigned* p, unsigned v) { return __hip_atomic_fetch_add(p, v, __ATOMIC_RELAXED, __HIP_MEMORY_SCOPE_AGENT); }
__device__ __forceinline__ unsigned xb_xcc_id() { return (unsigned)__builtin_amdgcn_s_getreg((3 << 11) | 20) & 0xFu; }
#define XB_SPIN(cond, bar) do { unsigned _sp = 0; while (cond) { __builtin_amdgcn_s_sleep(1); \
    if ((++_sp & 255u) == 0u) { if (xb_ld(&(bar)[XB_TMO])) break; if (_sp > XB_SPIN_CAP) { atomicAdd(&(bar)[XB_TMO], 1u); break; } } } } while (0)

struct XcdBarrier {
    unsigned* bar; unsigned x;
    volatile LAS unsigned* st;
};

__device__ __forceinline__ XcdBarrier xcd_barrier_post(unsigned* bar, volatile LAS unsigned* st) {
    XcdBarrier b; b.bar = bar; b.x = xb_xcc_id(); b.st = st;
    if (threadIdx.x == 0) (void)xb_add(&bar[XB_XCNT(b.x)], 1u);
    return b;
}
__device__ __forceinline__ void xcd_barrier_complete(unsigned* bar, unsigned x, unsigned& nloc, unsigned& nx) {
    const unsigned G = gridDim.x * gridDim.y * gridDim.z;
    unsigned sum, cnt, mine, sp = 0u;
    for (;;) {
        sum = 0u; cnt = 0u; mine = 0u;
#pragma unroll
        for (unsigned j = 0; j < 16; ++j) { const unsigned c = xb_ld(&bar[XB_XCNT(j)]); sum += c; cnt += (c > 0u) ? 1u : 0u; mine = (j == x) ? c : mine; }
        if (sum == G) break;
        __builtin_amdgcn_s_sleep(1);
        if ((++sp & 255u) == 0u) { if (xb_ld(&bar[XB_TMO])) break; if (sp > XB_SPIN_CAP) { atomicAdd(&bar[XB_TMO], 1u); break; } }
    }
    nloc = mine > 0u ? mine : 1u; nx = cnt > 0u ? cnt : 1u;
}

__device__ __forceinline__ void xcd_barrier(const XcdBarrier& b) {
    asm volatile("s_waitcnt vmcnt(0)" ::: "memory");
    __syncthreads();
    if (threadIdx.x == 0) {
        unsigned* bar = b.bar;
        __builtin_amdgcn_s_waitcnt(0);
        unsigned nloc = b.st[0], nx = b.st[1];
        if (nloc == 0u) { xcd_barrier_complete(bar, b.x, nloc, nx); b.st[0] = nloc; b.st[1] = nx; }
        const unsigned old = xb_add(&bar[XB_XSUB(b.x)], 1u);
        const unsigned gen = old / nloc;
        if (old + 1u == (gen + 1u) * nloc) {
            __builtin_amdgcn_fence(__ATOMIC_RELEASE, "agent");
            asm volatile("s_waitcnt vmcnt(0)" ::: "memory");
            const unsigned og = xb_add(&bar[XB_TOP], 1u);
            const unsigned tg = og / nx;
            if (og + 1u == (tg + 1u) * nx) xb_add(&bar[XB_TOPGEN], 1u);
            else XB_SPIN(xb_ld(&bar[XB_TOPGEN]) == tg, bar);
            __builtin_amdgcn_fence(__ATOMIC_ACQUIRE, "agent");
            xb_add(&bar[XB_XGEN(b.x)], 1u);
            asm volatile("s_waitcnt vmcnt(0)" ::: "memory");
        } else {
            XB_SPIN(xb_ld(&bar[XB_XGEN(b.x)]) == gen, bar);
            __builtin_amdgcn_fence(__ATOMIC_ACQUIRE, "agent");
            asm volatile("s_waitcnt vmcnt(0)" ::: "memory");
        }
    }
    __syncthreads();
}

struct Args { const float* in[30]; float* out; unsigned char* ws; int ph_lo, ph_hi, li, pad; };
struct Frame {
    LAS unsigned char* lds;
    volatile LAS unsigned* MISC;
    gu32* ctl;
    int tid, lane, wave;
    int vcu, G;
};
enum { I_XP = 0, I_XS, I_MEM, I_CCONV, I_SSC, I_SDELTA, I_CMK, I_CMV, I_NMIX, I_WIN, I_CONVW, I_CONVB, I_LNG, I_LNB, I_SCW, I_ALOG, I_DTB, I_DNN, I_WOUT,
       I_NMQ, I_NMKV, I_WMQ, I_WMK, I_WMV, I_WMO, I_NFFN, I_WG, I_WU, I_WD, I_NF };

__device__ __forceinline__ void tr_item(const float* W, int ldw, int k0, int c0, const float* gain, bf16* WT, int K, int r0, LAS float* scr, int lane) {
#pragma unroll 8
    for (int i = 0; i < 32; ++i) { const int kk = 2 * i + (lane >> 5); scr[kk * 33 + (lane & 31)] = W[(size_t)(k0 + kk) * ldw + c0 + (lane & 31)]; }
    LDS_WAIT(); asm volatile("" ::: "memory");
    const int c = lane & 7;
    float gv[8];
#pragma unroll
    for (int i = 0; i < 8; ++i) gv[i] = gain ? gain[k0 + 8 * c + i] : 1.f;
#pragma unroll
    for (int j = 0; j < 4; ++j) { const int n = (lane >> 3) + 8 * j; const LAS float* s = scr + (8 * c) * 33 + n;
        v4u o; o.x = pk2(s[0 * 33] * gv[0], s[1 * 33] * gv[1]); o.y = pk2(s[2 * 33] * gv[2], s[3 * 33] * gv[3]); o.z = pk2(s[4 * 33] * gv[4], s[5 * 33] * gv[5]); o.w = pk2(s[6 * 33] * gv[6], s[7 * 33] * gv[7]);
        *(GAS v4u*)(WT + (size_t)(r0 + n) * K + k0 + 8 * c) = o; }
    LDS_WAIT(); asm volatile("" ::: "memory");
}
__device__ __forceinline__ float softplusf_(float x) { return x > 20.f ? x : log1pf(__expf(x)); }

__device__ __forceinline__ void p0_prologue(const Args& A, Frame& F) {
    LAS float* scr = (LAS float*)(F.lds + RING_OFF + F.wave * 8448);
    const int gw = F.vcu * NWAVES + F.wave, NGW = F.G * NWAVES;
    unsigned char* ws = A.ws;
    const float* const pWMK = A.in[I_WMK]; const float* const pWMV = A.in[I_WMV]; const float* const pWG = A.in[I_WG]; const float* const pWU = A.in[I_WU];
    const float* const pXP = A.in[I_XP]; const float* const pXS = A.in[I_XS];
    constexpr int I_A = 96 * 16, I_B = 32 * 16, I_D = 64 * 16, I_F = 176 * 16, I_G = 32 * 44;
    constexpr int NITEMS = I_A + I_B + I_B + I_D + I_B + I_F + I_G;
    for (int it = gw; it < NITEMS; it += NGW) {
        int r = it;
        if (r < I_A) { const int nb = r % 96, kb = r / 96, j0 = 32 * nb; int src = j0;
            if (j0 < 1024) { const int tile = j0 >> 8, local = j0 & 255; src = local < 128 ? 128 * tile + local : 512 + 128 * tile + (local - 128); }
            tr_item(A.in[I_WIN], INC, 64 * kb, src, nullptr, (bf16*)(ws + WS_WIN), DM, j0, scr, F.lane); continue; } r -= I_A;
        if (r < I_B) { const int nb = r % 32, kb = r / 32; tr_item(A.in[I_WOUT], DM, 64 * kb, 32 * nb, nullptr, (bf16*)(ws + WS_WOUT), DM, 32 * nb, scr, F.lane); continue; } r -= I_B;
        if (r < I_B) { const int nb = r % 32, kb = r / 32; tr_item(A.in[I_WMQ], DM, 64 * kb, 32 * nb, A.in[I_NMQ], (bf16*)(ws + WS_WMQ), DM, 32 * nb, scr, F.lane); continue; } r -= I_B;
        if (r < I_D) { const int nb = r % 64, kb = r / 64, j0 = 32 * nb; const bool isv = j0 >= 1024;
            tr_item(isv ? pWMV : pWMK, DM, 64 * kb, isv ? j0 - 1024 : j0, nullptr, (bf16*)(ws + WS_WMKV), DM, j0, scr, F.lane); continue; } r -= I_D;
        if (r < I_B) { const int nb = r % 32, kb = r / 32; tr_item(A.in[I_WMO], DM, 64 * kb, 32 * nb, nullptr, (bf16*)(ws + WS_WMO), DM, 32 * nb, scr, F.lane); continue; } r -= I_B;
        if (r < I_F) { const int nb = r % 176, kb = r / 176, j0 = 32 * nb, tile = j0 >> 8, local = j0 & 255; const bool up = local >= 128;
            tr_item(up ? pWU : pWG, DFF, 64 * kb, 128 * tile + (up ? local - 128 : local), A.in[I_NFFN], (bf16*)(ws + WS_WGU), DM, j0, scr, F.lane); continue; } r -= I_F;
        { const int nb = r % 32, kb = r / 32; tr_item(A.in[I_WD], DM, 64 * kb, 32 * nb, nullptr, (bf16*)(ws + WS_WDN), DFF, 32 * nb, scr, F.lane); }
    }
    {
        bf16* H = (bf16*)(ws + WS_RB); float* BG = (float*)(ws + WS_BG);
        const float* win = A.in[I_WIN]; const float* gain = A.in[I_NMIX];
        float w8[4][4][8];
#pragma unroll
        for (int j = 0; j < 4; ++j)
#pragma unroll
            for (int i = 0; i < 4; ++i) { const int k = 256 * j + 4 * F.lane + i; const f32x4 a = *(const f32x4*)(win + (size_t)k * INC + 3072), b = *(const f32x4*)(win + (size_t)k * INC + 3076);
                w8[j][i][0] = a[0]; w8[j][i][1] = a[1]; w8[j][i][2] = a[2]; w8[j][i][3] = a[3]; w8[j][i][4] = b[0]; w8[j][i][5] = b[1]; w8[j][i][6] = b[2]; w8[j][i][7] = b[3]; }
        f32x4 gn[4];
#pragma unroll
        for (int j = 0; j < 4; ++j) gn[j] = *(const f32x4*)(gain + 256 * j + 4 * F.lane);
        const f32x4 alog4 = *(const f32x4*)A.in[I_ALOG], dtb4 = *(const f32x4*)A.in[I_DTB];
        for (int m = gw; m < MR; m += NGW) {
            GAS unsigned long long* o8 = (GAS unsigned long long*)(H + (size_t)m * DM) + F.lane;
            if (m >= MV) {
#pragma unroll
                for (int j = 0; j < 4; ++j) o8[64 * j] = 0ull;
                if (F.lane < 8) BG[(size_t)m * 8 + F.lane] = 0.f;
                continue;
            }
            const float* xrow = (m < MP) ? pXP + (size_t)m * DM : pXS + (size_t)(m - MP) * DM;
            const GAS f32x4* xr = (const GAS f32x4*)xrow + F.lane;
            f32x4 v[4]; float s2 = 0.f;
#pragma unroll
            for (int j = 0; j < 4; ++j) { v[j] = xr[64 * j]; s2 += (v[j][0] * v[j][0] + v[j][1] * v[j][1]) + (v[j][2] * v[j][2] + v[j][3] * v[j][3]); }
            const float rstd = 1.f / sqrtf(wave_sum(s2) * (1.f / DM) + RMS_EPS);
            float p8[8];
#pragma unroll
            for (int c = 0; c < 8; ++c) p8[c] = 0.f;
#pragma unroll
            for (int j = 0; j < 4; ++j) { v[j] = v[j] * rstd * gn[j];
#pragma unroll
                for (int i = 0; i < 4; ++i)
#pragma unroll
                    for (int c = 0; c < 8; ++c) p8[c] += v[j][i] * w8[j][i][c];
                o8[64 * j] = (unsigned long long)pk2(v[j][0], v[j][1]) | ((unsigned long long)pk2(v[j][2], v[j][3]) << 32); }
#pragma unroll
            for (int c = 0; c < 8; ++c) p8[c] = wave_sum(p8[c]);
            f32x4 bo, go;
#pragma unroll
            for (int c = 0; c < 4; ++c) { bo[c] = 1.f / (1.f + expf(-p8[c])); go[c] = -expf(alog4[c]) * softplusf_(p8[4 + c] + dtb4[c]); }
            if (F.lane == 0) { *(f32x4*)(BG + (size_t)m * 8) = bo; *(f32x4*)(BG + (size_t)m * 8 + 4) = go; }
        }
    }
    {
        bf16* MN = (bf16*)(ws + WS_MEMN); const float* gain = A.in[I_NMKV];
        f32x4 gn[4];
#pragma unroll
        for (int j = 0; j < 4; ++j) gn[j] = *(const f32x4*)(gain + 256 * j + 4 * F.lane);
        for (int m = gw; m < NB * NMEM; m += NGW) {
            const GAS f32x4* xr = (const GAS f32x4*)(A.in[I_MEM] + (size_t)m * DM) + F.lane;
            f32x4 v[4]; float s2 = 0.f;
#pragma unroll
            for (int j = 0; j < 4; ++j) { v[j] = xr[64 * j]; s2 += (v[j][0] * v[j][0] + v[j][1] * v[j][1]) + (v[j][2] * v[j][2] + v[j][3] * v[j][3]); }
            const float rstd = 1.f / sqrtf(wave_sum(s2) * (1.f / DM) + RMS_EPS);
            GAS unsigned long long* o8 = (GAS unsigned long long*)(MN + (size_t)m * DM) + F.lane;
#pragma unroll
            for (int j = 0; j < 4; ++j) { v[j] = v[j] * rstd * gn[j]; o8[64 * j] = (unsigned long long)pk2(v[j][0], v[j][1]) | ((unsigned long long)pk2(v[j][2], v[j][3]) << 32); }
        }
    }
}

__device__ __forceinline__ void conv_tile(const Args& A, Frame& F, int b, int tile) {
    const bf16* PB = (const bf16*)(A.ws + WS_RA); bf16* CD = (bf16*)(A.ws + WS_RB); bf16* QC = (bf16*)(A.ws + WS_RC);
    int oz; asm volatile("v_mov_b32 %0, 0" : "=v"(oz));
    const int c = F.tid + oz; const int row0 = b * SEQ + tile * 64;
    LAS float* Y = (LAS float*)(F.lds + RING_OFF);
    {
        float w[CW];
#pragma unroll
        for (int j = 0; j < CW; ++j) w[j] = A.in[I_CONVW][j * CC + c];
        const float bias = A.in[I_CONVB][c];
        float uv[46];
        const unsigned rb = (unsigned)(b * SEQ + tile * 64);
#pragma unroll
        for (int i = 0; i < 30; ++i) { const int tk = tile * 64 - 30 + i; const unsigned tkc = tk < 0 ? 0u : (unsigned)tk; const float vv = bf2f(PB[(unsigned)(b * SEQ + tkc) * (unsigned)PBLD + (unsigned)c]); uv[i] = (tk >= 0) ? vv : 0.f; }
#pragma unroll 1
        for (int seg = 0; seg < 4; ++seg) {
#pragma unroll
            for (int i = 0; i < 16; ++i) uv[30 + i] = bf2f(PB[(rb + (unsigned)(seg * 16 + i)) * (unsigned)PBLD + (unsigned)c]);
#pragma unroll
            for (int t = 0; t < 16; ++t) { float a = bias;
#pragma unroll
                for (int j = 0; j < CW; ++j) a += w[j] * uv[t + j];
                Y[(seg * 16 + t) * CC + c] = a; }
#pragma unroll
            for (int i = 0; i < 30; ++i) uv[i] = uv[i + 16];
        }
    }
    __syncthreads();
    {
        const int ch0 = 8 * F.lane + oz;
        const f32x4 g0 = *(const f32x4*)(A.in[I_LNG] + ch0), g1 = *(const f32x4*)(A.in[I_LNG] + ch0 + 4), b0 = *(const f32x4*)(A.in[I_LNB] + ch0), b1 = *(const f32x4*)(A.in[I_LNB] + ch0 + 4);
#pragma unroll 2
        for (int tt = 0; tt < 8; ++tt) { const int t = 8 * F.wave + tt;
            f32x4 y0 = *(const LAS f32x4*)(Y + t * CC + ch0), y1 = *(const LAS f32x4*)(Y + t * CC + ch0 + 4);
            const float mean = wave_sum((y0[0] + y0[1]) + (y0[2] + y0[3]) + (y1[0] + y1[1]) + (y1[2] + y1[3])) * (1.f / CC);
            y0 = y0 - mean; y1 = y1 - mean;
            const float var = wave_sum((y0[0] * y0[0] + y0[1] * y0[1]) + (y0[2] * y0[2] + y0[3] * y0[3]) + (y1[0] * y1[0] + y1[1] * y1[1]) + (y1[2] * y1[2] + y1[3] * y1[3])) * (1.f / CC);
            const float rstd = 1.f / sqrtf(var + 1e-5f);
            y0 = y0 * rstd * g0 + b0; y1 = y1 * rstd * g1 + b1;
            float o[8];
#pragma unroll
            for (int i = 0; i < 4; ++i) { o[i] = silu(y0[i]); o[4 + i] = silu(y1[i]); }
            *(GAS v4u*)(CD + (size_t)(row0 + t) * DM + ch0) = pack8(o); }
    }
    if (tile == 31) {
        float* oc = A.out + OUT_CONVP + (size_t)b * 30 * CC;
        for (int j = 0; j < 30; ++j) oc[j * CC + c] = bf2f(PB[(size_t)(b * SEQ + SEQ - 30 + j) * PBLD + c]);
        float* os = A.out + OUT_SCP + (size_t)b * 3 * QKVN;
        for (int e = F.tid; e < 3 * QKVN; e += NWAVES * 64) { const int j = e / QKVN, ch = e % QKVN; os[e] = bf2f(PB[(size_t)(b * SEQ + SEQ - 3 + j) * PBLD + 512 + ch]); }
    }
    {
        const int t0 = tile * 64 + 8 * F.wave;
#pragma unroll 1
        for (int p = 0; p < 3; ++p) {
            const int ch0 = 512 * p + 8 * F.lane + oz;
            float wsc[4][8];
#pragma unroll
            for (int j = 0; j < 4; ++j) { const f32x4 a = *(const f32x4*)(A.in[I_SCW] + j * QKVN + ch0), bb = *(const f32x4*)(A.in[I_SCW] + j * QKVN + ch0 + 4);
#pragma unroll
                for (int i = 0; i < 4; ++i) { wsc[j][i] = a[i]; wsc[j][4 + i] = bb[i]; } }
            float win[3][8];
#pragma unroll
            for (int j = 0; j < 3; ++j) { const int tk = t0 - 3 + j; const int tkc = tk < 0 ? 0 : tk;
                const v4u x = *(const GAS v4u*)(PB + (size_t)(b * SEQ + tkc) * PBLD + 512 + ch0); unpack8(x, win[j]);
#pragma unroll
                for (int i = 0; i < 8; ++i) win[j][i] = (tk >= 0) ? win[j][i] : 0.f; }
#pragma unroll
            for (int tt = 0; tt < 8; ++tt) {
                float cur[8]; { const v4u x = *(const GAS v4u*)(PB + (size_t)(b * SEQ + t0 + tt) * PBLD + 512 + ch0); unpack8(x, cur); }
                float y[8]; float ss = 0.f;
#pragma unroll
                for (int i = 0; i < 8; ++i) { const float a = wsc[0][i] * win[0][i] + wsc[1][i] * win[1][i] + wsc[2][i] * win[2][i] + wsc[3][i] * cur[i]; y[i] = silu(a); ss += y[i] * y[i]; }
                if (p < 2) { ss += __shfl_xor(ss, 1); ss += __shfl_xor(ss, 2); ss += __shfl_xor(ss, 4); ss += __shfl_xor(ss, 8);
                    const float sc = (1.f / sqrtf(ss + 1e-6f)) * (p == 0 ? 0.08838834764831845f : 1.f);
#pragma unroll
                    for (int i = 0; i < 8; ++i) y[i] *= sc; }
                *(GAS v4u*)(QC + (size_t)(b * SEQ + t0 + tt) * QKVN + ch0) = pack8(y);
#pragma unroll
                for (int i = 0; i < 8; ++i) { win[0][i] = win[1][i]; win[1][i] = win[2][i]; win[2][i] = cur[i]; }
            }
        }
    }
    __syncthreads();
}
__device__ __forceinline__ void conv_sample(const Args& A, Frame& F, int s) {
    const bf16* PB = (const bf16*)(A.ws + WS_RA); bf16* CD = (bf16*)(A.ws + WS_RB); bf16* QC = (bf16*)(A.ws + WS_RC);
    const int c = F.tid; const size_t row = (size_t)MP + s;
    LAS float* Y = (LAS float*)(F.lds + RING_OFF);
    {
        const float* cache = A.in[I_CCONV] + (size_t)s * 30 * CC; float* oc = A.out + OUT_CONVS + (size_t)s * 30 * CC;
        const float us = bf2f(PB[row * PBLD + c]);
        float a = A.in[I_CONVB][c];
        float prev = cache[c];
#pragma unroll 6
        for (int j = 0; j < 30; ++j) { a += A.in[I_CONVW][j * CC + c] * prev; const float nx = (j < 29) ? cache[(j + 1) * CC + c] : us; oc[j * CC + c] = nx; prev = nx; }
        a += A.in[I_CONVW][30 * CC + c] * us;
        Y[c] = a;
    }
    __syncthreads();
    if (F.wave == 7) {
        const int ch0 = 8 * F.lane;
        const f32x4 g0 = *(const f32x4*)(A.in[I_LNG] + ch0), g1 = *(const f32x4*)(A.in[I_LNG] + ch0 + 4), b0 = *(const f32x4*)(A.in[I_LNB] + ch0), b1 = *(const f32x4*)(A.in[I_LNB] + ch0 + 4);
        f32x4 y0 = *(const LAS f32x4*)(Y + ch0), y1 = *(const LAS f32x4*)(Y + ch0 + 4);
        const float mean = wave_sum((y0[0] + y0[1]) + (y0[2] + y0[3]) + (y1[0] + y1[1]) + (y1[2] + y1[3])) * (1.f / CC);
        y0 = y0 - mean; y1 = y1 - mean;
        const float var = wave_sum((y0[0] * y0[0] + y0[1] * y0[1]) + (y0[2] * y0[2] + y0[3] * y0[3]) + (y1[0] * y1[0] + y1[1] * y1[1]) + (y1[2] * y1[2] + y1[3] * y1[3])) * (1.f / CC);
        const float rstd = 1.f / sqrtf(var + 1e-5f);
        y0 = y0 * rstd * g0 + b0; y1 = y1 * rstd * g1 + b1;
        float o[8];
#pragma unroll
        for (int i = 0; i < 4; ++i) { o[i] = silu(y0[i]); o[4 + i] = silu(y1[i]); }
        *(GAS v4u*)(CD + row * DM + ch0) = pack8(o);
    }
    if (F.wave < 3) {
        const int p = F.wave; const int ch0 = 512 * p + 8 * F.lane;
        const float* st = A.in[I_SSC] + (size_t)s * 3 * QKVN; float* os = A.out + OUT_SCS + (size_t)s * 3 * QKVN;
        float win[3][8], cur[8], y[8];
#pragma unroll
        for (int j = 0; j < 3; ++j) { const f32x4 a = *(const f32x4*)(st + j * QKVN + ch0), bb = *(const f32x4*)(st + j * QKVN + ch0 + 4);
#pragma unroll
            for (int i = 0; i < 4; ++i) { win[j][i] = a[i]; win[j][4 + i] = bb[i]; } }
        { const v4u x = *(const GAS v4u*)(PB + row * PBLD + 512 + ch0); unpack8(x, cur); }
        float ss = 0.f;
#pragma unroll
        for (int i = 0; i < 8; ++i) { float a = 0.f;
#pragma unroll
            for (int j = 0; j < 3; ++j) a += A.in[I_SCW][j * QKVN + ch0 + i] * win[j][i];
            a += A.in[I_SCW][3 * QKVN + ch0 + i] * cur[i]; y[i] = silu(a); ss += y[i] * y[i]; }
        if (p < 2) { ss += __shfl_xor(ss, 1); ss += __shfl_xor(ss, 2); ss += __shfl_xor(ss, 4); ss += __shfl_xor(ss, 8);
            const float sc = (1.f / sqrtf(ss + 1e-6f)) * (p == 0 ? 0.08838834764831845f : 1.f);
#pragma unroll
            for (int i = 0; i < 8; ++i) y[i] *= sc; }
        *(GAS v4u*)(QC + row * QKVN + ch0) = pack8(y);
#pragma unroll
        for (int j = 0; j < 3; ++j) { f32x4 a, bb;
#pragma unroll
            for (int i = 0; i < 4; ++i) { a[i] = (j < 2) ? win[j + 1][i] : cur[i]; bb[i] = (j < 2) ? win[j + 1][4 + i] : cur[4 + i]; }
            *(f32x4*)(os + j * QKVN + ch0) = a; *(f32x4*)(os + j * QKVN + ch0 + 4) = bb; }
    }
    __syncthreads();
}

__device__ __forceinline__ bf16x8 lds_frag16(const LAS unsigned char* p) { return *(const LAS bf16x8*)p; }
__device__ __forceinline__ void d1_chunk(const Args& A, Frame& F, int ci) {
    using pg8::f32x4;
    const int b = ci >> 7, h = (ci >> 5) & 3, n = ci & 31; const int row0 = b * SEQ + n * 64;
    const bf16* QC = (const bf16*)(A.ws + WS_RC); const float* BG = (const float*)(A.ws + WS_BG);
    float* Ug = (float*)(A.ws + WS_U) + (size_t)ci * 8192; bf16* Wg = (bf16*)(A.ws + WS_W) + (size_t)ci * 8192; bf16* QGg = (bf16*)(A.ws + WS_QG) + (size_t)ci * 8192;
    bf16* KDTg = (bf16*)(A.ws + WS_KDT) + (size_t)ci * 8192; bf16* QKg = (bf16*)(A.ws + WS_QK) + (size_t)ci * 4096; float* GLg = (float*)(A.ws + WS_GL);
    constexpr int OFF_K = 0, OFF_Q = 17408, OFF_VBT = 34816, OFF_KBGT = 53248, OFF_L = 71680, OFF_T = 89088, OFF_GC = 98304, OFF_BETA = 98560, OFF_EG = 98816, OFF_TM = 99072, OFF_X = 116480, LS = 68;
    LAS unsigned char* L = F.lds + RING_OFF;
    LAS float* gcs = (LAS float*)(L + OFF_GC); LAS float* betas = (LAS float*)(L + OFF_BETA); LAS float* egs = (LAS float*)(L + OFF_EG); LAS float* Lm = (LAS float*)(L + OFF_L); LAS float* Tm = (LAS float*)(L + OFF_TM); LAS float* Xm = (LAS float*)(L + OFF_X);
    const int fr = F.lane & 15, fq = F.lane >> 4;
    if (F.wave == 0) {
        float g = BG[(size_t)(row0 + F.lane) * 8 + 4 + h]; const float be = BG[(size_t)(row0 + F.lane) * 8 + h];
#pragma unroll
        for (int o = 1; o < 64; o <<= 1) { const float v = __shfl_up(g, o); if (F.lane >= o) g += v; }
        gcs[F.lane] = g; betas[F.lane] = be; egs[F.lane] = __expf(g);
    }
    __syncthreads();
    {
        const int t = F.tid >> 3, part = F.tid & 7;
        const bf16* rp = QC + (size_t)(row0 + t) * QKVN + h * 128 + part * 16;
        const v4u q0 = *(const GAS v4u*)(rp), q1 = *(const GAS v4u*)(rp + 8), k0 = *(const GAS v4u*)(rp + 512), k1 = *(const GAS v4u*)(rp + 520), v0 = *(const GAS v4u*)(rp + 1024), v1 = *(const GAS v4u*)(rp + 1032);
        *(LAS v4u*)(L + OFF_K + t * 272 + part * 32) = k0; *(LAS v4u*)(L + OFF_K + t * 272 + part * 32 + 16) = k1;
        *(LAS v4u*)(L + OFF_Q + t * 272 + part * 32) = q0; *(LAS v4u*)(L + OFF_Q + t * 272 + part * 32 + 16) = q1;
        const float be = betas[t], beg = be * egs[t];
        float kf[16], vf[16];
        { float tmp[8]; unpack8(k0, tmp);
#pragma unroll
          for (int i = 0; i < 8; ++i) kf[i] = tmp[i]; unpack8(k1, tmp);
#pragma unroll
          for (int i = 0; i < 8; ++i) kf[8 + i] = tmp[i]; unpack8(v0, tmp);
#pragma unroll
          for (int i = 0; i < 8; ++i) vf[i] = tmp[i]; unpack8(v1, tmp);
#pragma unroll
          for (int i = 0; i < 8; ++i) vf[8 + i] = tmp[i]; }
#pragma unroll
        for (int i = 0; i < 16; ++i) { const int d = part * 16 + i;
            *(LAS unsigned short*)(L + OFF_VBT + d * 144 + t * 2) = (unsigned short)(pk2(vf[i] * be, 0.f) & 0xffffu);
            *(LAS unsigned short*)(L + OFF_KBGT + d * 144 + t * 2) = (unsigned short)(pk2(kf[i] * beg, 0.f) & 0xffffu); }
    }
    __syncthreads();
#pragma unroll 1
    for (int x = 0; x < 4; ++x) {
        const int tile = F.wave * 4 + x, which = tile >> 4, ti = (tile >> 2) & 3, tj = tile & 3;
        f32x4 acc = (f32x4){0.f, 0.f, 0.f, 0.f};
        if (ti >= tj) {
            const LAS unsigned char* ap = L + (which ? OFF_Q : OFF_K) + (ti * 16 + fr) * 272 + fq * 16; const LAS unsigned char* bp = L + OFF_K + (tj * 16 + fr) * 272 + fq * 16;
#pragma unroll
            for (int kk = 0; kk < 4; ++kk) acc = __builtin_amdgcn_mfma_f32_16x16x32_bf16(lds_frag16(ap + kk * 64), lds_frag16(bp + kk * 64), acc, 0, 0, 0);
        }
        const int j = tj * 16 + fr; const float gj = gcs[j];
#pragma unroll
        for (int r = 0; r < 4; ++r) { const int i = ti * 16 + 4 * fq + r; const float dec = __expf(gcs[i] - gj);
            if (which == 0) Lm[i * LS + j] = (i > j) ? betas[i] * acc[r] * dec : 0.f;
            else QKg[i * 64 + j] = (bf16)(pk2((i >= j) ? acc[r] * dec : 0.f, 0.f) & 0xffffu); }
    }
    __syncthreads();
    for (int e = F.tid; e < 64 * LS; e += NWAVES * 64) Tm[e] = 0.f;
    __syncthreads();
    if (F.wave == 0) {
        const LAS float* Lb = Lm + (16 * fq) * LS + 16 * fq;
        float t[16];
#pragma unroll
        for (int i = 0; i < 16; ++i) {
            float a0 = 0.f, a1 = 0.f, a2 = 0.f, a3 = 0.f;
#pragma unroll
            for (int j4 = 0; j4 < (i + 3) / 4; ++j4) { const f32x4 lv = *(const LAS f32x4*)(Lb + i * LS + 4 * j4);
                if (4 * j4 + 0 < i) a0 += lv[0] * t[4 * j4 + 0]; if (4 * j4 + 1 < i) a1 += lv[1] * t[4 * j4 + 1]; if (4 * j4 + 2 < i) a2 += lv[2] * t[4 * j4 + 2]; if (4 * j4 + 3 < i) a3 += lv[3] * t[4 * j4 + 3]; }
            t[i] = ((fr == i) ? 1.f : 0.f) - ((a0 + a1) + (a2 + a3));
        }
#pragma unroll
        for (int i = 0; i < 16; ++i) Tm[(16 * fq + i) * LS + 16 * fq + fr] = t[i];
    } else {
        const int lt = F.tid - 64; const float gl = gcs[63];
        for (int cix = lt; cix < 1024; cix += 448) {
            const int t = cix >> 4, cc = cix & 15; const v4u x = *(const LAS v4u*)(L + OFF_Q + t * 272 + cc * 16); float f[8]; unpack8(x, f); const float e = egs[t];
#pragma unroll
            for (int i = 0; i < 8; ++i) f[i] *= e;
            *(GAS v4u*)(QGg + t * 128 + cc * 8) = pack8(f); }
        for (int cix = lt; cix < 1024; cix += 448) {
            const int dk = cix >> 3, t0 = (cix & 7) * 8; float f[8];
#pragma unroll
            for (int i = 0; i < 8; ++i) f[i] = bf2f(*(const LAS unsigned short*)(L + OFF_K + (t0 + i) * 272 + dk * 2)) * __expf(gl - gcs[t0 + i]);
            *(GAS v4u*)(KDTg + dk * 64 + t0) = pack8(f); }
        if (lt == 0) GLg[ci] = __expf(gl);
    }
    __syncthreads();
    if (F.wave < 2) {
        const int pp = F.wave, rb = 16 * (2 * pp + 1), cb = 16 * (2 * pp); f32x4 acc = (f32x4){0.f, 0.f, 0.f, 0.f};
#pragma unroll
        for (int kk = 0; kk < 4; ++kk) acc = __builtin_amdgcn_mfma_f32_16x16x4f32(Lm[(rb + fr) * LS + cb + 4 * kk + fq], Tm[(cb + 4 * kk + fq) * LS + cb + fr], acc, 0, 0, 0);
#pragma unroll
        for (int r = 0; r < 4; ++r) Xm[pp * 576 + (4 * fq + r) * 36 + fr] = acc[r];
    }
    __syncthreads();
    if (F.wave < 2) {
        const int pp = F.wave, rb = 16 * (2 * pp + 1), cb = 16 * (2 * pp); f32x4 acc = (f32x4){0.f, 0.f, 0.f, 0.f};
#pragma unroll
        for (int kk = 0; kk < 4; ++kk) acc = __builtin_amdgcn_mfma_f32_16x16x4f32(Tm[(rb + fr) * LS + rb + 4 * kk + fq], Xm[pp * 576 + (4 * kk + fq) * 36 + fr], acc, 0, 0, 0);
#pragma unroll
        for (int r = 0; r < 4; ++r) Tm[(rb + 4 * fq + r) * LS + cb + fr] = -acc[r];
    }
    __syncthreads();
    if (F.wave < 4) {
        const int bi = F.wave >> 1, bj = F.wave & 1; f32x4 acc = (f32x4){0.f, 0.f, 0.f, 0.f};
#pragma unroll
        for (int kk = 0; kk < 8; ++kk) acc = __builtin_amdgcn_mfma_f32_16x16x4f32(Lm[(32 + 16 * bi + fr) * LS + 4 * kk + fq], Tm[(4 * kk + fq) * LS + 16 * bj + fr], acc, 0, 0, 0);
#pragma unroll
        for (int r = 0; r < 4; ++r) Xm[(16 * bi + 4 * fq + r) * 36 + 16 * bj + fr] = acc[r];
    }
    __syncthreads();
    if (F.wave < 4) {
        const int bi = F.wave >> 1, bj = F.wave & 1; f32x4 acc = (f32x4){0.f, 0.f, 0.f, 0.f};
#pragma unroll
        for (int kk = 0; kk < 8; ++kk) acc = __builtin_amdgcn_mfma_f32_16x16x4f32(Tm[(32 + 16 * bi + fr) * LS + 32 + 4 * kk + fq], Xm[(4 * kk + fq) * 36 + 16 * bj + fr], acc, 0, 0, 0);
#pragma unroll
        for (int r = 0; r < 4; ++r) Tm[(32 + 16 * bi + 4 * fq + r) * LS + 16 * bj + fr] = -acc[r];
    }
    __syncthreads();
    {
        const int i = F.tid >> 3, j0 = (F.tid & 7) * 8; const f32x4 a = *(const LAS f32x4*)(Tm + i * LS + j0), bq = *(const LAS f32x4*)(Tm + i * LS + j0 + 4);
        v4u w; w.x = pk2(a[0], a[1]); w.y = pk2(a[2], a[3]); w.z = pk2(bq[0], bq[1]); w.w = pk2(bq[2], bq[3]);
        *(LAS v4u*)(L + OFF_T + i * 144 + j0 * 2) = w;
    }
    __syncthreads();
#pragma unroll 1
    for (int x = 0; x < 8; ++x) {
        const int tile = F.wave * 8 + x, which = tile >> 5, ti = (tile >> 3) & 3, td = tile & 7;
        const LAS unsigned char* ap = L + OFF_T + (ti * 16 + fr) * 144 + fq * 16; const LAS unsigned char* bp = L + (which ? OFF_KBGT : OFF_VBT) + (td * 16 + fr) * 144 + fq * 16;
        f32x4 acc = (f32x4){0.f, 0.f, 0.f, 0.f};
#pragma unroll
        for (int kk = 0; kk < 2; ++kk) acc = __builtin_amdgcn_mfma_f32_16x16x32_bf16(lds_frag16(ap + kk * 64), lds_frag16(bp + kk * 64), acc, 0, 0, 0);
        const int d = td * 16 + fr;
#pragma unroll
        for (int r = 0; r < 4; ++r) { const int i = ti * 16 + 4 * fq + r;
            if (which == 0) Ug[i * 128 + d] = acc[r]; else Wg[i * 128 + d] = (bf16)(pk2(acc[r], 0.f) & 0xffffu); }
    }
    __syncthreads();
}

constexpr int SC_OW = 0, SC_OQG = 16384, SC_OKDT = 32768, SC_OQK = 49152, SC_OU = 57344, SC_BUF = 61440;
__device__ __forceinline__ void scan_issue(const Args& A, Frame& F, int ci, int sl, LAS unsigned char* dst) {
    const unsigned char* Wg = A.ws + WS_W + (size_t)ci * 16384; const unsigned char* QGg = A.ws + WS_QG + (size_t)ci * 16384;
    const unsigned char* KDTg = A.ws + WS_KDT + (size_t)ci * 16384; const unsigned char* QKg = A.ws + WS_QK + (size_t)ci * 8192; const unsigned char* Ug = A.ws + WS_U + (size_t)ci * 32768 + sl * 64;
#pragma unroll
    for (int j = 0; j < 9; ++j) {
        const int pi = (F.wave - 1) + 7 * j;
        if (pi < 60) {
            const unsigned char* src;
            if (pi < 32) { const int i = (pi & 15) * 64 + F.lane, r = i >> 4, c = (i & 15) ^ (r & 15); src = (pi < 16 ? Wg : QGg) + r * 256 + c * 16; }
            else if (pi < 56) { const int i = (pi < 48 ? pi - 32 : pi - 48) * 64 + F.lane, r = i >> 3, c = (i & 7) ^ ((r >> 1) & 7); src = (pi < 48 ? KDTg : QKg) + r * 128 + c * 16; }
            else { const int i = (pi - 56) * 64 + F.lane, r = i >> 2, c = i & 3; src = Ug + r * 512 + c * 16; }
            __builtin_amdgcn_global_load_lds((const unsigned*)src, (LAS unsigned*)(dst + pi * 1024), 16, 0, 0);
        }
    }
}
__device__ __forceinline__ bf16x8 frag2(const LAS unsigned char* p0, const LAS unsigned char* p1) { const v2u lo = *(const LAS v2u*)p0, hi = *(const LAS v2u*)p1; v4u w; w.x = lo.x; w.y = lo.y; w.z = hi.x; w.w = hi.y; return __builtin_bit_cast(bf16x8, w); }
__device__ __forceinline__ bf16x8 frag256(const LAS unsigned char* tile, int row, int kstep, int fq) { const int c = 4 * kstep + (fq >> 1), sw = row & 15; const LAS unsigned char* rp = tile + row * 256 + 8 * (fq & 1); return frag2(rp + ((c ^ sw) << 4), rp + (((c + 2) ^ sw) << 4)); }
__device__ __forceinline__ bf16x8 frag128(const LAS unsigned char* tile, int row, int kstep, int fq) { const int c = 4 * kstep + (fq >> 1), sw = (row >> 1) & 7; const LAS unsigned char* rp = tile + row * 128 + 8 * (fq & 1); return frag2(rp + ((c ^ sw) << 4), rp + (((c + 2) ^ sw) << 4)); }
__device__ __forceinline__ bf16x8 pack_pair(const pg8::f32x4& a, const pg8::f32x4& b) { v4u w; w.x = pk2(a[0], a[1]); w.y = pk2(a[2], a[3]); w.z = pk2(b[0], b[1]); w.w = pk2(b[2], b[3]); return __builtin_bit_cast(bf16x8, w); }
__device__ __forceinline__ void scan_unit(const Args& A, Frame& F, int b, int h, int sl) {
    using pg8::f32x4;
    LAS unsigned char* L = F.lds + RING_OFF;
    const int ci0 = (b * NH + h) * 32; const int fr = F.lane & 15, fq = F.lane >> 4;
    float* Og = (float*)(A.ws + WS_RE); const float* GLg = (const float*)(A.ws + WS_GL);
    if (F.wave > 0) { scan_issue(A, F, ci0, sl, L); scan_issue(A, F, ci0 + 1, sl, L + SC_BUF); asm volatile("s_waitcnt vmcnt(9)" ::: "memory"); }
    __builtin_amdgcn_s_barrier(); asm volatile("" ::: "memory");
    f32x4 S[8];
#pragma unroll
    for (int i = 0; i < 8; ++i) S[i] = (f32x4){0.f, 0.f, 0.f, 0.f};
    float gl = GLg[ci0];
#pragma unroll 1
    for (int n = 0; n < 32; ++n) {
        if (F.wave == 0) {
            const LAS unsigned char* B = L + (n & 1) * SC_BUF;
            const float gln = GLg[ci0 + (n < 31 ? n + 1 : n)];
            bf16x8 Sb[4];
#pragma unroll
            for (int kk = 0; kk < 4; ++kk) Sb[kk] = pack_pair(S[2 * kk], S[2 * kk + 1]);
            f32x4 vn[4];
#pragma unroll
            for (int tb = 0; tb < 4; ++tb) { f32x4 p1 = (f32x4){0.f, 0.f, 0.f, 0.f};
#pragma unroll
                for (int kk = 0; kk < 4; ++kk) p1 = __builtin_amdgcn_mfma_f32_16x16x32_bf16(frag256(B + SC_OW, 16 * tb + fr, kk, fq), Sb[kk], p1, 0, 0, 0);
#pragma unroll
                for (int r = 0; r < 4; ++r) vn[tb][r] = *(const LAS float*)(B + SC_OU + (16 * tb + 4 * fq + r) * 64 + fr * 4) - p1[r]; }
            bf16x8 Vb[2]; Vb[0] = pack_pair(vn[0], vn[1]); Vb[1] = pack_pair(vn[2], vn[3]);
            const size_t orow = (size_t)(b * SEQ + n * 64);
#pragma unroll
            for (int blk = 0; blk < 8; ++blk) { f32x4 s = S[blk] * gl;
#pragma unroll
                for (int kt = 0; kt < 2; ++kt) s = __builtin_amdgcn_mfma_f32_16x16x32_bf16(frag128(B + SC_OKDT, 16 * blk + fr, kt, fq), Vb[kt], s, 0, 0, 0);
                S[blk] = s; }
#pragma unroll
            for (int tb = 0; tb < 4; ++tb) { f32x4 o = (f32x4){0.f, 0.f, 0.f, 0.f};
#pragma unroll
                for (int kk = 0; kk < 4; ++kk) o = __builtin_amdgcn_mfma_f32_16x16x32_bf16(frag256(B + SC_OQG, 16 * tb + fr, kk, fq), Sb[kk], o, 0, 0, 0);
#pragma unroll
                for (int kt = 0; kt < 2; ++kt) o = __builtin_amdgcn_mfma_f32_16x16x32_bf16(frag128(B + SC_OQK, 16 * tb + fr, kt, fq), Vb[kt], o, 0, 0, 0);
#pragma unroll
                for (int r = 0; r < 4; ++r) Og[(orow + 16 * tb + 4 * fq + r) * 512 + h * 128 + sl * 16 + fr] = o[r]; }
            gl = gln;
            asm volatile("s_waitcnt lgkmcnt(0)" ::: "memory");
        } else {
            asm volatile("s_waitcnt vmcnt(0)" ::: "memory");
        }
        __builtin_amdgcn_s_barrier(); asm volatile("" ::: "memory");
        if (F.wave > 0 && n + 2 < 32) scan_issue(A, F, ci0 + n + 2, sl, L + (n & 1) * SC_BUF);
    }
    if (F.wave == 0) {
        float* od = A.out + OUT_DLP + (size_t)(b * NH + h) * DKV * DKV;
#pragma unroll
        for (int blk = 0; blk < 8; ++blk)
#pragma unroll
            for (int r = 0; r < 4; ++r) od[(16 * blk + 4 * fq + r) * DKV + sl * 16 + fr] = S[blk][r];
    }
    asm volatile("s_waitcnt vmcnt(0) lgkmcnt(0)" ::: "memory"); __builtin_amdgcn_s_barrier(); asm volatile("" ::: "memory");
}
__device__ __forceinline__ void delta_sample(const Args& A, Frame& F, int s, int h) {
    const bf16* QC = (const bf16*)(A.ws + WS_RC); const float* BG = (const float*)(A.ws + WS_BG); float* Og = (float*)(A.ws + WS_RE);
    const size_t row = (size_t)MP + s;
    LAS float* qs = (LAS float*)(F.lds + RING_OFF); LAS float* ks = qs + 128; LAS float* red = qs + 256;
    const int dv = F.tid & 127, grp = F.tid >> 7;
    if (F.tid < 128) { qs[F.tid] = bf2f(QC[row * QKVN + h * 128 + F.tid]); ks[F.tid] = bf2f(QC[row * QKVN + 512 + h * 128 + F.tid]); }
    const float v = bf2f(QC[row * QKVN + 1024 + h * 128 + dv]);
    const float beta = BG[row * 8 + h], eg = __expf(BG[row * 8 + 4 + h]);
    const float* S0 = A.in[I_SDELTA] + (size_t)(s * NH + h) * DKV * DKV; float* So = A.out + OUT_DLS + (size_t)(s * NH + h) * DKV * DKV;
    float s0[32];
#pragma unroll
    for (int i = 0; i < 32; ++i) s0[i] = S0[(size_t)(grp * 32 + i) * DKV + dv];
    __syncthreads();
    float part = 0.f;
#pragma unroll
    for (int i = 0; i < 32; ++i) part += ks[grp * 32 + i] * s0[i];
    red[grp * 128 + dv] = part;
    __syncthreads();
    const float kS = (red[dv] + red[128 + dv]) + (red[256 + dv] + red[384 + dv]);
    const float vnew = beta * (v - eg * kS);
    __syncthreads();
    float po = 0.f;
#pragma unroll
    for (int i = 0; i < 32; ++i) { const float sn = eg * s0[i] + ks[grp * 32 + i] * vnew; So[(size_t)(grp * 32 + i) * DKV + dv] = sn; po += qs[grp * 32 + i] * sn; }
    red[grp * 128 + dv] = po;
    __syncthreads();
    if (F.tid < 128) Og[row * 512 + h * 128 + dv] = (red[dv] + red[128 + dv]) + (red[256 + dv] + red[384 + dv]);
    __syncthreads();
}

__device__ __forceinline__ void ogate_row(const Args& A, Frame& F, int m, const pg8::f32x4& n0, const pg8::f32x4& n1) {
    const bf16* PB = (const bf16*)(A.ws + WS_RA); bf16* CD = (bf16*)(A.ws + WS_RB); const float* Og = (const float*)(A.ws + WS_RE); const int ch0 = 8 * F.lane;
    const f32x4 o0 = *(const GAS f32x4*)(Og + (size_t)m * 512 + ch0), o1 = *(const GAS f32x4*)(Og + (size_t)m * 512 + ch0 + 4);
    const v4u zz = *(const GAS v4u*)(PB + (size_t)m * PBLD + 2048 + ch0); float z[8]; unpack8(zz, z);
    float ss = (o0[0] * o0[0] + o0[1] * o0[1]) + (o0[2] * o0[2] + o0[3] * o0[3]) + (o1[0] * o1[0] + o1[1] * o1[1]) + (o1[2] * o1[2] + o1[3] * o1[3]);
    ss += __shfl_xor(ss, 1); ss += __shfl_xor(ss, 2); ss += __shfl_xor(ss, 4); ss += __shfl_xor(ss, 8);
    const float rstd = 1.f / sqrtf(ss * (1.f / 128.f) + RMS_EPS);
    float d[8];
#pragma unroll
    for (int i = 0; i < 4; ++i) { d[i] = o0[i] * rstd * n0[i] * silu(z[i]); d[4 + i] = o1[i] * rstd * n1[i] * silu(z[4 + i]); }
    *(GAS v4u*)(CD + (size_t)m * DM + 512 + ch0) = pack8(d);
}
__device__ __forceinline__ void ogate_phase(const Args& A, Frame& F) {
    const int gw = F.vcu * NWAVES + F.wave, NGW = F.G * NWAVES; const int ch0 = 8 * F.lane;
    const f32x4 n0 = *(const f32x4*)(A.in[I_DNN] + (ch0 & 127)), n1 = *(const f32x4*)(A.in[I_DNN] + (ch0 & 127) + 4);
    for (int m = gw; m < MP; m += NGW) ogate_row(A, F, m, n0, n1);
}
__device__ __forceinline__ void sample_mixer(const Args& A, Frame& F, int s) {
    conv_sample(A, F, s);
    VM_WAIT(); __syncthreads();
    _Pragma("unroll 1") for (int h = 0; h < NH; ++h) delta_sample(A, F, s, h);
    VM_WAIT(); __syncthreads();
    if (F.wave == 0) { const int ch0 = 8 * F.lane; const f32x4 n0 = *(const f32x4*)(A.in[I_DNN] + (ch0 & 127)), n1 = *(const f32x4*)(A.in[I_DNN] + (ch0 & 127) + 4); ogate_row(A, F, MP + s, n0, n1); }
}

__device__ __forceinline__ void attn_issue(const Args& A, Frame& F, int st, int b, int h, LAS unsigned char* slot) {
    const bf16* KB = (const bf16*)(A.ws + WS_KB); const bf16* VT = (const bf16*)(A.ws + WS_VT);
#pragma unroll
    for (int it = 0; it < 4; ++it) {
        const int idx = it * 512 + F.tid; const bf16* src;
        if (st < 4) { const int r = idx >> 5, p = idx & 31, c = p ^ (r & 15); src = KB + (size_t)(b * NMEM + 64 * st + r) * DM + h * MHD + 8 * c; }
        else { const int r = idx >> 3, p = idx & 7, c = p ^ ((r >> 1) & 7); src = VT + (size_t)(h * MHD + r) * (NB * NMEM) + b * NMEM + 64 * (st - 4) + 8 * c; }
        __builtin_amdgcn_global_load_lds((const unsigned*)src, (LAS unsigned*)(slot + it * 8192 + F.wave * 1024), 16, 0, 0);
    }
}
__device__ __forceinline__ void attn_unit(const Args& A, Frame& F, int rt, int h) {
    using pg8::f32x4;
    const int b = rt >> 4; const int fr = F.lane & 15, fq = F.lane >> 4;
    const bf16* Q = (const bf16*)(A.ws + WS_RB); bf16* AO = (bf16*)(A.ws + WS_RE);
    const size_t qoff = (size_t)(rt * 128 + F.wave * 16 + fr) * DM + h * MHD;
    const bf16* qrow = Q + qoff; bf16* orow = AO + qoff;
    LAS unsigned char* L = F.lds + RING_OFF;
    bf16x8 qf[8];
#pragma unroll
    for (int ks = 0; ks < 8; ++ks) qf[ks] = *(const GAS bf16x8*)(qrow + 32 * ks + 8 * fq);
    attn_issue(A, F, 0, b, h, L); attn_issue(A, F, 1, b, h, L + 32768);
    f32x4 sacc[16];
#pragma unroll
    for (int st = 0; st < 4; ++st) {
        asm volatile("s_waitcnt vmcnt(4)" ::: "memory");
        __builtin_amdgcn_s_barrier(); asm volatile("" ::: "memory");
        attn_issue(A, F, st + 2, b, h, L + ((st + 2) & 3) * 32768);
        const LAS unsigned char* slot = L + (st & 3) * 32768;
#pragma unroll
        for (int kbl = 0; kbl < 4; ++kbl) { f32x4 acc = (f32x4){0.f, 0.f, 0.f, 0.f}; const int row = 16 * kbl + fr;
#pragma unroll
            for (int ks = 0; ks < 8; ++ks) { const bf16x8 a = *(const LAS bf16x8*)(slot + row * 512 + (((4 * ks + fq) ^ (row & 15)) << 4)); acc = __builtin_amdgcn_mfma_f32_16x16x32_bf16(a, qf[ks], acc, 0, 0, 0); }
            sacc[4 * st + kbl] = acc; }
    }
    float mx = -3.0e38f;
#pragma unroll
    for (int kb = 0; kb < 16; ++kb)
#pragma unroll
        for (int i = 0; i < 4; ++i) mx = fmaxf(mx, sacc[kb][i]);
    mx = fmaxf(mx, __shfl_xor(mx, 16)); mx = fmaxf(mx, __shfl_xor(mx, 32));
    float lsum = 0.f; bf16x8 pb[8];
#pragma unroll
    for (int kb = 0; kb < 16; ++kb)
#pragma unroll
        for (int i = 0; i < 4; ++i) { const float p = __builtin_amdgcn_exp2f(sacc[kb][i] - mx); sacc[kb][i] = p; lsum += p; }
#pragma unroll
    for (int s = 0; s < 8; ++s) pb[s] = pack_pair(sacc[2 * s], sacc[2 * s + 1]);
    lsum += __shfl_xor(lsum, 16); lsum += __shfl_xor(lsum, 32);
    f32x4 oacc[16];
#pragma unroll
    for (int db = 0; db < 16; ++db) oacc[db] = (f32x4){0.f, 0.f, 0.f, 0.f};
#pragma unroll
    for (int st = 4; st < 8; ++st) {
        if (st + 1 < 8) asm volatile("s_waitcnt vmcnt(4)" ::: "memory"); else asm volatile("s_waitcnt vmcnt(0)" ::: "memory");
        __builtin_amdgcn_s_barrier(); asm volatile("" ::: "memory");
        if (st + 2 < 8) attn_issue(A, F, st + 2, b, h, L + ((st + 2) & 3) * 32768);
        const LAS unsigned char* slot = L + (st & 3) * 32768; const int t = st - 4;
#pragma unroll
        for (int db = 0; db < 16; ++db) { const int row = 16 * db + fr; const int sw = (row >> 1) & 7;
#pragma unroll
            for (int s2 = 0; s2 < 2; ++s2) { const int c = 4 * s2 + (fq >> 1);
                const v2u lo = *(const LAS v2u*)(slot + row * 128 + ((c ^ sw) << 4) + 8 * (fq & 1)), hi = *(const LAS v2u*)(slot + row * 128 + (((c + 2) ^ sw) << 4) + 8 * (fq & 1));
                v4u aw; aw.x = lo.x; aw.y = lo.y; aw.z = hi.x; aw.w = hi.y;
                oacc[db] = __builtin_amdgcn_mfma_f32_16x16x32_bf16(__builtin_bit_cast(bf16x8, aw), pb[2 * t + s2], oacc[db], 0, 0, 0); } }
    }
    const float inv = 1.f / lsum;
#pragma unroll
    for (int db = 0; db < 16; ++db) { v2u w; w.x = pk2(oacc[db][0] * inv, oacc[db][1] * inv); w.y = pk2(oacc[db][2] * inv, oacc[db][3] * inv); *(GAS v2u*)(orow + 16 * db + 4 * fq) = w; }
    LDS_WAIT(); __builtin_amdgcn_s_barrier(); asm volatile("" ::: "memory");
}
__device__ __forceinline__ void attn_sample(const Args& A, Frame& F, int s, int h) {
    const bf16* qrow = (const bf16*)(A.ws + WS_RB) + (size_t)(MP + s) * DM + h * MHD; bf16* orow = (bf16*)(A.ws + WS_RE) + (size_t)(MP + s) * DM + h * MHD;
    const float* Kc = A.in[I_CMK] + (size_t)s * NMEM * DM + h * MHD; const float* Vc = A.in[I_CMV] + (size_t)s * NMEM * DM + h * MHD;
    LAS float* pl = (LAS float*)(F.lds + RING_OFF); LAS float* wred = pl + 256; LAS float* ored = pl + 512;
    float q[4]; { const v2u x = *(const GAS v2u*)(qrow + 4 * F.lane); q[0] = bflo(x.x); q[1] = bfhi(x.x); q[2] = bflo(x.y); q[3] = bfhi(x.y); }
    float myscore = 0.f;
#pragma unroll 8
    for (int i = 0; i < 32; ++i) { const f32x4 kv = *(const GAS f32x4*)(Kc + (size_t)(32 * F.wave + i) * DM + 4 * F.lane);
        const float d = wave_sum((kv[0] * q[0] + kv[1] * q[1]) + (kv[2] * q[2] + kv[3] * q[3])); if (F.lane == i) myscore = d; }
    float m = wave_max(F.lane < 32 ? myscore : -3.0e38f);
    if (F.lane == 0) wred[F.wave] = m;
    __syncthreads();
    float gm = wred[0];
#pragma unroll
    for (int i = 1; i < 8; ++i) gm = fmaxf(gm, wred[i]);
    const float p = (F.lane < 32) ? __builtin_amdgcn_exp2f(myscore - gm) : 0.f;
    if (F.lane < 32) pl[32 * F.wave + F.lane] = p;
    const float ws_ = wave_sum(p);
    if (F.lane == 0) wred[8 + F.wave] = ws_;
    __syncthreads();
    float tot = 0.f;
#pragma unroll
    for (int i = 0; i < 8; ++i) tot += wred[8 + i];
    f32x4 acc = (f32x4){0.f, 0.f, 0.f, 0.f};
#pragma unroll 8
    for (int i = 0; i < 32; ++i) { const f32x4 vv = *(const GAS f32x4*)(Vc + (size_t)(32 * F.wave + i) * DM + 4 * F.lane); const float pi = pl[32 * F.wave + i]; acc = acc + vv * pi; }
    *(LAS f32x4*)(ored + F.wave * 256 + 4 * F.lane) = acc;
    __syncthreads();
    if (F.tid < 256) { float o = 0.f;
#pragma unroll
        for (int w = 0; w < 8; ++w) o += ored[w * 256 + F.tid];
        orow[F.tid] = (bf16)(pk2(o / tot, 0.f) & 0xffffu); }
    __syncthreads();
}


typedef unsigned v2u_ __attribute__((ext_vector_type(2)));
template <int NKS, class Epi>
__device__ __forceinline__ void small_gemm_item(const Frame& F, const bf16* Arow0, const bf16* Bt, int pn, int j, int rq, const Epi& E) {
    using pg8::f32x4;
    constexpr int K = NKS * 256;
    const int fr = F.lane & 15, fq = F.lane >> 4;
    const bf16* ap = Arow0 + (size_t)(32 * rq + fr) * K + F.wave * (K / 8) + 8 * fq;
    const bf16* b0 = Bt + (size_t)(256 * pn + 16 * j + fr) * K + F.wave * (K / 8) + 8 * fq; const bf16* b1 = b0 + (size_t)128 * K;
    bf16x8 a0[NKS], a1[NKS], x0[NKS], x1[NKS];
#pragma unroll
    for (int u = 0; u < NKS; ++u) { a0[u] = *(const GAS bf16x8*)(ap + 32 * u); a1[u] = *(const GAS bf16x8*)(ap + (size_t)16 * K + 32 * u); x0[u] = *(const GAS bf16x8*)(b0 + 32 * u); x1[u] = *(const GAS bf16x8*)(b1 + 32 * u); }
    __builtin_amdgcn_sched_barrier(0);
    f32x4 c00 = (f32x4){0.f, 0.f, 0.f, 0.f}, c01 = c00, c10 = c00, c11 = c00;
#pragma unroll
    for (int u = 0; u < NKS; ++u) {
        c00 = __builtin_amdgcn_mfma_f32_16x16x32_bf16(x0[u], a0[u], c00, 0, 0, 0); c01 = __builtin_amdgcn_mfma_f32_16x16x32_bf16(x1[u], a0[u], c01, 0, 0, 0);
        c10 = __builtin_amdgcn_mfma_f32_16x16x32_bf16(x0[u], a1[u], c10, 0, 0, 0); c11 = __builtin_amdgcn_mfma_f32_16x16x32_bf16(x1[u], a1[u], c11, 0, 0, 0);
    }
    LAS f32x4* red = (LAS f32x4*)(F.lds + RING_OFF);
    red[(F.wave * 4 + 0) * 64 + F.lane] = c00; red[(F.wave * 4 + 1) * 64 + F.lane] = c01; red[(F.wave * 4 + 2) * 64 + F.lane] = c10; red[(F.wave * 4 + 3) * 64 + F.lane] = c11;
    __syncthreads();
    if (F.wave < 2) {
        f32x4 sA = (f32x4){0.f, 0.f, 0.f, 0.f}, sB = sA;
#pragma unroll
        for (int w = 0; w < 8; ++w) { sA = sA + red[(w * 4 + 2 * F.wave) * 64 + F.lane]; sB = sB + red[(w * 4 + 2 * F.wave + 1) * 64 + F.lane]; }
        E(32 * rq + 16 * F.wave + fr, pn, j, fq, sA, sB);
    }
    __syncthreads();
}
__device__ __forceinline__ v2u_ pk4(const pg8::f32x4& a) { v2u_ w; w.x = pk2(a[0], a[1]); w.y = pk2(a[2], a[3]); return w; }
struct SEpiIn { bf16* PBs;
    __device__ __forceinline__ void operator()(int m, int pn, int j, int fq, const pg8::f32x4& a, const pg8::f32x4& b) const {
        if (pn < 4) { pg8::f32x4 v;
#pragma unroll
            for (int i = 0; i < 4; ++i) v[i] = a[i] * sigm(b[i]);
            *(GAS v2u_*)(PBs + (size_t)m * PBLD + 128 * pn + 16 * j + 4 * fq) = pk4(v); }
        else { bf16* rp = PBs + (size_t)m * PBLD + 256 * pn - 512 + 16 * j + 4 * fq; *(GAS v2u_*)rp = pk4(a); *(GAS v2u_*)(rp + 128) = pk4(b); }
    } };
template <bool WRITE_BF> struct SEpiRes { const float* base; float* out; bf16* outb; float* ss;
    __device__ __forceinline__ void operator()(int m, int pn, int j, int fq, const pg8::f32x4& a, const pg8::f32x4& b) const {
        const size_t off = (size_t)m * DM + 256 * pn + 16 * j + 4 * fq;
        const pg8::f32x4 v0 = a + *(const GAS pg8::f32x4*)(base + off), v1 = b + *(const GAS pg8::f32x4*)(base + off + 128);
        *(GAS pg8::f32x4*)(out + off) = v0; *(GAS pg8::f32x4*)(out + off + 128) = v1;
        if (WRITE_BF) { *(GAS v2u_*)(outb + off) = pk4(v0); *(GAS v2u_*)(outb + off + 128) = pk4(v1); }
        float s = (v0[0] * v0[0] + v0[1] * v0[1]) + (v0[2] * v0[2] + v0[3] * v0[3]) + (v1[0] * v1[0] + v1[1] * v1[1]) + (v1[2] * v1[2] + v1[3] * v1[3]);
        s += __shfl_xor(s, 16); s += __shfl_xor(s, 32);
        if (fq == 0) atomicAdd(ss + m, s);
    } };
struct SEpiQ { bf16* Qs; const float* ss; float c2;
    __device__ __forceinline__ void operator()(int m, int pn, int j, int fq, const pg8::f32x4& a, const pg8::f32x4& b) const {
        const float rs = __builtin_amdgcn_rsqf(ss[m] * (1.f / 1024.f) + RMS_EPS) * c2; bf16* rp = Qs + (size_t)m * DM + 256 * pn + 16 * j + 4 * fq;
        *(GAS v2u_*)rp = pk4(a * rs); *(GAS v2u_*)(rp + 128) = pk4(b * rs);
    } };
struct SEpiGU { bf16* Ts; const float* ss;
    __device__ __forceinline__ void operator()(int m, int pn, int j, int fq, const pg8::f32x4& a, const pg8::f32x4& b) const {
        const float rs = __builtin_amdgcn_rsqf(ss[m] * (1.f / 1024.f) + RMS_EPS); pg8::f32x4 v;
#pragma unroll
        for (int i = 0; i < 4; ++i) v[i] = silu(a[i] * rs) * (b[i] * rs);
        *(GAS v2u_*)(Ts + (size_t)m * DFF + 128 * pn + 16 * j + 4 * fq) = pk4(v);
    } };

__device__ __forceinline__ void final_norm_phase(const Args& A, Frame& F) {
    const int gw = F.vcu * NWAVES + F.wave, NGW = F.G * NWAVES; const float* ss = (const float*)(F.ctl + CW_SS3);
    f32x4 gn[4];
#pragma unroll
    for (int j = 0; j < 4; ++j) gn[j] = *(const f32x4*)(A.in[I_NF] + 256 * j + 4 * F.lane);
    for (int m = gw; m < MV; m += NGW) {
        GAS f32x4* xr = (GAS f32x4*)(A.out + (size_t)m * DM) + F.lane;
        const float rstd = 1.f / sqrtf(ss[m] * (1.f / DM) + RMS_EPS);
#pragma unroll
        for (int j = 0; j < 4; ++j) { const f32x4 v = xr[64 * j]; xr[64 * j] = v * rstd * gn[j]; }
    }
}

__global__ void __launch_bounds__(NWAVES * 64, 2) hymba_fwd(Args args) {
    extern __shared__ __attribute__((aligned(16))) unsigned char lds[];
    Frame F;
    F.lds = (LAS unsigned char*)lds;
    F.MISC = (volatile LAS unsigned*)(F.lds + MISC_OFF);
    F.tid = threadIdx.x; F.lane = F.tid & 63; F.wave = __builtin_amdgcn_readfirstlane(F.tid >> 6);
    F.G = gridDim.x; { const int bx = blockIdx.x; F.vcu = (F.G % 8 == 0) ? (bx % 8) * (F.G / 8) + bx / 8 : bx; }
    F.ctl = (gu32*)(args.ws + WS_CTL);
    const Args& A = args;
    for (int u = F.tid; u < (LDS_BYTES - LDSCTL_OFF) / 4; u += NWAVES * 64) ((LAS unsigned*)(F.lds + LDSCTL_OFF))[u] = 0u;
    __syncthreads();
#if MK_PER_PHASE
#define GRID_BAR() do { } while (0)
#else
    XcdBarrier bar = xcd_barrier_post((unsigned*)(F.ctl + CW_BAR) + args.li * XCD_BAR_WORDS, F.MISC + 8);
#define GRID_BAR() xcd_barrier(bar)
#endif
#if 1
    const int lo = args.ph_lo, hi = args.ph_hi;
    const bool rep = (args.li != 0);
#define REPK(k) (rep && lo == (k))
#ifdef ONLY_PH
#define IN(k) ((k) == ONLY_PH && lo <= (k) && (k) < hi)
#else
#define IN(k) (lo <= (k) && (k) < hi)
#endif
#else
#define REPK(k) false
#define IN(k) true
#endif
#define BOTH(k) (IN(k) && IN((k) + 1))
#define PH_PTRS unsigned char* const ws = args.ws; bf16* const RA = (bf16*)(ws + WS_RA); bf16* const RB = (bf16*)(ws + WS_RB); bf16* const RC = (bf16*)(ws + WS_RC); \
    float* const X1 = (float*)(ws + WS_RD); bf16* const X1B = (bf16*)(ws + WS_RE); float* const X2 = (float*)(ws + WS_RF); \
    float* const SS1 = (float*)(ws + WS_CTL) + CW_SS1; float* const SS2 = (float*)(ws + WS_CTL) + CW_SS2; float* const SS3 = (float*)(ws + WS_CTL) + CW_SS3; float* const SSD = (float*)(ws + WS_CTL) + 163840; \
    (void)RA; (void)RB; (void)RC; (void)X1; (void)X1B; (void)X2; (void)SS1; (void)SS2; (void)SS3; (void)SSD;

    if (IN(0)) { p0_prologue(A, F); if (BOTH(0)) GRID_BAR(); }
    if (IN(1)) { PH_PTRS
        { pg8::Gemm g{RB, (const bf16*)(ws + WS_WIN), MP, 3072, DM}; pg8::StaticOrder S; S.init(MP, 3072, F.G, (int)blockIdx.x);
          pg8::EpiIn E{RA};
          pg8::gemm_phase<pg8::EpiIn, pg8::StaticOrder, true, true>(F.lds + RING_OFF, g, S, E); }
        { pg8::Gemm g{(const bf16*)(ws + WS_MEMN), (const bf16*)(ws + WS_WMKV), NB * NMEM, 2048, DM}; pg8::StaticOrder S; S.init(NB * NMEM, 2048, F.G, (int)blockIdx.x);
          pg8::EpiKV E{A.out + OUT_MKP, A.out + OUT_MVP, (bf16*)(ws + WS_KB), (bf16*)(ws + WS_VT)};
          pg8::gemm_phase<pg8::EpiKV, pg8::StaticOrder, true, true>(F.lds + RING_OFF, g, S, E); }
        { const SEpiIn E{RA + (size_t)MP * PBLD};
          for (int i = F.G - 1 - (int)blockIdx.x; i < 96 * 4; i += F.G) small_gemm_item<4>(F, RB + (size_t)MP * DM, (const bf16*)(ws + WS_WIN), i >> 5, (i >> 2) & 7, i & 3, E); }
        if (BOTH(1)) GRID_BAR();
    }
    if (IN(2)) {
        for (int it = F.vcu; it < 256; it += F.G) { const int b = it >> 5, tile = it & 31; conv_tile(A, F, b, tile); VM_WAIT(); __syncthreads();
            _Pragma("unroll 1") for (int h = 0; h < NH; ++h) d1_chunk(A, F, (b * NH + h) * 32 + tile); }
        for (int s = F.G - 1 - F.vcu; s < DEC; s += F.G) sample_mixer(A, F, s);
        if (BOTH(2)) GRID_BAR();
    }
    if (IN(3)) { PH_PTRS
        for (int u = F.vcu; u < 256; u += F.G) scan_unit(A, F, u >> 5, (u >> 3) & 3, u & 7);
        { const SEpiRes<true> SE{A.in[I_XS], (float*)(ws + WS_X1S), X1B + (size_t)MP * DM, (REPK(3) ? SSD : SS1) + MP};
          for (int i = F.G - 1 - (int)blockIdx.x; i < 32 * 4; i += F.G) small_gemm_item<4>(F, RB + (size_t)MP * DM, (const bf16*)(ws + WS_WOUT), i >> 5, (i >> 2) & 7, i & 3, SE); }
        if (BOTH(3)) GRID_BAR();
    }
    if (IN(4)) { PH_PTRS
        ogate_phase(A, F);
        { const SEpiQ SE{RB + (size_t)MP * DM, SS1 + MP, ATT_C2};
          for (int i = F.G - 1 - (int)blockIdx.x; i < 32 * 4; i += F.G) small_gemm_item<4>(F, X1B + (size_t)MP * DM, (const bf16*)(ws + WS_WMQ), i >> 5, (i >> 2) & 7, i & 3, SE); }
        if (BOTH(4)) GRID_BAR();
    }
    if (IN(5)) { PH_PTRS
        pg8::Gemm g{RB, (const bf16*)(ws + WS_WOUT), MP, DM, DM}; pg8::StaticOrder S; S.init(MP, DM, F.G, (int)blockIdx.x);
        pg8::EpiRes<true> E{A.in[I_XP], A.in[I_XS], MV, MR, X1, X1B, REPK(5) ? SSD : SS1};
        pg8::gemm_phase<pg8::EpiRes<true>, pg8::StaticOrder, true, true>(F.lds + RING_OFF, g, S, E);
        for (int it = F.vcu; it < DEC * NH; it += F.G) attn_sample(A, F, it >> 2, it & 3);
        if (BOTH(5)) GRID_BAR();
    }
    if (IN(6)) { PH_PTRS
        pg8::Gemm g{X1B, (const bf16*)(ws + WS_WMQ), MP, DM, DM}; pg8::StaticOrder S; S.init(MP, DM, F.G, (int)blockIdx.x);
        pg8::EpiQ E{RB, SS1, ATT_C2};
        pg8::gemm_phase<pg8::EpiQ, pg8::StaticOrder, true, true>(F.lds + RING_OFF, g, S, E);
        { pg8::Unit u; _Pragma("unroll 1") for (int i = 0; i < 2 * 64; ++i) { if (!S.next(i >> 1, u)) break; attn_unit(A, F, 2 * u.pm + (i & 1), u.pn); } }
        { const SEpiRes<true> SE{(const float*)(ws + WS_X1S), X2 + (size_t)MP * DM, RC + (size_t)MP * DM, (REPK(6) ? SSD : SS2) + MP};
          for (int i = F.G - 1 - (int)blockIdx.x; i < 32 * 4; i += F.G) small_gemm_item<4>(F, X1B + (size_t)MP * DM, (const bf16*)(ws + WS_WMO), i >> 5, (i >> 2) & 7, i & 3, SE); }
        if (BOTH(6)) GRID_BAR();
    }
    if (IN(7)) { PH_PTRS
        pg8::Gemm g{X1B, (const bf16*)(ws + WS_WMO), MP, DM, DM}; pg8::StaticOrder S; S.init(MP, DM, F.G, (int)blockIdx.x);
        pg8::EpiRes<true> E{X1, X1, MR, MR, X2, RC, REPK(7) ? SSD : SS2};
        pg8::gemm_phase<pg8::EpiRes<true>, pg8::StaticOrder, true, true>(F.lds + RING_OFF, g, S, E);
        { const SEpiGU SE{RA + (size_t)MP * DFF, SS2 + MP};
          for (int i = F.G - 1 - (int)blockIdx.x; i < 176 * 4; i += F.G) small_gemm_item<4>(F, RC + (size_t)MP * DM, (const bf16*)(ws + WS_WGU), i >> 5, (i >> 2) & 7, i & 3, SE); }
        if (BOTH(7)) GRID_BAR();
    }
    if (IN(8)) { PH_PTRS
        pg8::Gemm g{RC, (const bf16*)(ws + WS_WGU), MP, 2 * DFF, DM}; pg8::StaticOrder S; S.init(MP, 2 * DFF, F.G, (int)blockIdx.x);
        pg8::EpiGU E{RA, SS2};
        pg8::gemm_phase<pg8::EpiGU, pg8::StaticOrder, true, true>(F.lds + RING_OFF, g, S, E);
        { const SEpiRes<false> SE{X2 + (size_t)MP * DM, A.out + (size_t)MP * DM, nullptr, (REPK(8) ? SSD : SS3) + MP};
          for (int i = F.G - 1 - (int)blockIdx.x; i < 32 * 4; i += F.G) small_gemm_item<11>(F, RA + (size_t)MP * DFF, (const bf16*)(ws + WS_WDN), i >> 5, (i >> 2) & 7, i & 3, SE); }
        if (BOTH(8)) GRID_BAR();
    }
    if (IN(9)) { PH_PTRS
        pg8::Gemm g{RA, (const bf16*)(ws + WS_WDN), MP, DM, DFF}; pg8::StaticOrder S; S.init(MP, DM, F.G, (int)blockIdx.x);
        pg8::EpiRes<false> E{X2, X2, MR, MV, A.out, nullptr, REPK(9) ? SSD : SS3};
        pg8::gemm_phase<pg8::EpiRes<false>, pg8::StaticOrder, true, true>(F.lds + RING_OFF, g, S, E);
        if (BOTH(9)) GRID_BAR();
    }
    if (IN(10)) final_norm_phase(A, F);
#undef IN
#undef BOTH
}

extern "C" void kernel_launch(void* const* d_in, const int* in_sizes, int n_in, void* d_out, int out_size, void* d_ws, size_t ws_size, hipStream_t stream) {
    static int grid = 0;
    if (grid == 0) {
        if (n_in != 30 || in_sizes[0] != MP * DM || (size_t)out_size != OUT_END || ws_size < WS_END) {
            fprintf(stderr, "kernel_launch: unexpected shapes: n_in %d, in0 %d, out %d, ws %zu (need >= %zu); nothing launched\n", n_in, n_in > 0 ? in_sizes[0] : -1, out_size, ws_size, (size_t)WS_END); grid = -1; return; }
        int dev = 0, cus = 0, per_cu = 0;
        if (hipGetDevice(&dev) != hipSuccess || hipDeviceGetAttribute(&cus, hipDeviceAttributeMultiprocessorCount, dev) != hipSuccess) { fprintf(stderr, "kernel_launch: device query failed\n"); grid = -1; return; }
        if (hipFuncSetAttribute((const void*)hymba_fwd, hipFuncAttributeMaxDynamicSharedMemorySize, LDS_BYTES) != hipSuccess) { fprintf(stderr, "kernel_launch: hipFuncSetAttribute failed\n"); grid = -1; return; }
        if (hipOccupancyMaxActiveBlocksPerMultiprocessor(&per_cu, (const void*)hymba_fwd, NWAVES * 64, LDS_BYTES) != hipSuccess || per_cu < 1)
            fprintf(stderr, "kernel_launch: note: occupancy query reports %d workgroups per CU\n", per_cu);
        (void)hipGetLastError();
        grid = cus;
    }
    if (grid < 0) return;
    if (hipMemsetAsync((char*)d_ws + WS_CTL, 0, CTL_ZERO_BYTES, stream) != hipSuccess) { fprintf(stderr, "kernel_launch: hipMemsetAsync failed\n"); return; }
    Args a{};
    for (int i = 0; i < 30; ++i) a.in[i] = (const float*)d_in[i];
    a.out = (float*)d_out; a.ws = (unsigned char*)d_ws;
#if MK_PER_PHASE
    for (int ph = 0; ph < N_PHASES; ++ph) { a.ph_lo = ph; a.ph_hi = ph + 1; a.li = 0;
        hipLaunchKernelGGL(hymba_fwd, dim3(grid), dim3(NWAVES * 64), LDS_BYTES, stream, a); }
#else
#ifdef PROBE_PH
    a.ph_lo = 0; a.ph_hi = PROBE_PH + 1; a.li = 0;
    hipLaunchKernelGGL(hymba_fwd, dim3(grid), dim3(NWAVES * 64), LDS_BYTES, stream, a);
#ifdef PROBE_REPS
    for (int r_ = 0; r_ < PROBE_REPS; ++r_) { a.ph_lo = PROBE_PH; a.ph_hi = PROBE_PH + 1; a.li = 2 + r_; a.pad = PROBE_MODE; hipLaunchKernelGGL(hymba_fwd, dim3(grid), dim3(NWAVES * 64), LDS_BYTES, stream, a); }
#endif
    a.ph_lo = PROBE_PH; a.ph_hi = N_PHASES; a.li = 1; a.pad = 0;
    hipLaunchKernelGGL(hymba_fwd, dim3(grid), dim3(NWAVES * 64), LDS_BYTES, stream, a);
#else
    a.ph_lo = 0; a.ph_hi = N_PHASES; a.li = 0;
    hipLaunchKernelGGL(hymba_fwd, dim3(grid), dim3(NWAVES * 64), LDS_BYTES, stream, a);
#endif
#endif
    const hipError_t le = hipPeekAtLastError();
    if (le != hipSuccess) fprintf(stderr, "kernel_launch: launch failed: %s\n", hipGetErrorName(le));
}
```

```cpp
#include <hip/hip_runtime.h>
#include <cstdio>
#include <cstdint>
#define MK_PER_PHASE 0
namespace pg8 {
#define PG8_LAS __attribute__((address_space(3)))
typedef unsigned short bf16_t;
typedef short bf16x8 __attribute__((ext_vector_type(8)));
typedef float f32x4 __attribute__((ext_vector_type(4)));
typedef unsigned u32x4 __attribute__((ext_vector_type(4)));
constexpr int BM = 256, BK = 64, HALF = 128, HTB = HALF * BK * 2  , STAGE_BYTES = 8 * HTB, NXCD = 8, WGM = 8;

__host__ __device__ __forceinline__ int lds_byte(int r, int c) { const int st = (r >> 4) * 2 + (c >> 5), rr = r & 15, cc = c & 31, ob = rr * 64 + cc * 2; return st * 1024 + (ob ^ (((ob >> 9) & 1) << 5)); }
__host__ __device__ __forceinline__ void stage_rc(int b, int& R, int& C) { const int st = b / 1024, sb = b % 1024, swz = sb ^ (((sb >> 9) & 1) << 5); R = (st >> 1) * 16 + swz / 64; C = (st & 1) * 32 + (swz % 64) / 2; }
__host__ __device__ __forceinline__ int perm32(int rho) { const int n = rho >> 4, i = rho & 15; return 8 * (i >> 2) + 4 * n + (i & 3); }

struct Unit { int pm, pn; };
struct Gemm { const bf16_t* A; const bf16_t* Bt; int M, N, K; };

struct StaticOrder {
    int nM, nN, nwg, G, c;
    __host__ __device__ __forceinline__ void init(int M, int N, int G_, int c_) { nM = M / BM; nN = N / BM; nwg = nM * nN; G = G_; c = c_; }
    __host__ __device__ __forceinline__ bool next(int i, Unit& u) const {
        const long L = (long)i * G + c; if (L >= nwg) return false;
        int wgid = (int)L; { const int q = nwg / NXCD, r = nwg % NXCD, xcd = wgid % NXCD, off = wgid / NXCD; wgid = (xcd < r ? xcd * (q + 1) : r * (q + 1) + (xcd - r) * q) + off; }
        const int nig = WGM * nN, gid = wgid / nig, fm = gid * WGM, gsz = (nM - fm) < WGM ? (nM - fm) : WGM;
        u.pm = fm + ((wgid % nig) % gsz); u.pn = (wgid % nig) / gsz; return true;
    }
    __device__ __forceinline__ void a_ready(const Unit&) const {}
    __device__ __forceinline__ void done(const Unit&) const {}
};

__device__ __forceinline__ unsigned cvt_pk_bf16(float lo, float hi) { unsigned r; asm volatile("v_cvt_pk_bf16_f32 %0, %1, %2" : "=v"(r) : "v"(lo), "v"(hi)); return r; }
typedef float f32x2_t __attribute__((ext_vector_type(2))); typedef __bf16 bf16x2_t __attribute__((ext_vector_type(2)));
__device__ __forceinline__ unsigned pk2(float lo, float hi) { f32x2_t v = {lo, hi}; bf16x2_t b = __builtin_convertvector(v, bf16x2_t); return __builtin_bit_cast(unsigned, b); }
__device__ __forceinline__ float sigm(float x) { return __builtin_amdgcn_rcpf(1.f + __expf(-x)); }
__device__ __forceinline__ float silu(float x) { return x * __builtin_amdgcn_rcpf(1.f + __expf(-x)); }
__device__ __forceinline__ u32x4 pk8(const f32x4& a, const f32x4& b) { u32x4 w; w.x = pk2(a[0], a[1]); w.y = pk2(a[2], a[3]); w.z = pk2(b[0], b[1]); w.w = pk2(b[2], b[3]); return w; }
constexpr int PBLD = 2560;
constexpr int MPROMPT = 16384;
constexpr float RMS_EPS = 1e-6f;

struct EpiIn {
    static constexpr bool PERM = true, AFTER_DRAIN = false;
    bf16_t* PB;
    __device__ __forceinline__ void operator()(const f32x4 (&acc)[2][2][4][2], const Unit& u, int wr, int wc, int fr, int fq) const {
        const int row0 = u.pm * BM + wr * 64 + fr;
        if (u.pn < 4) {
            const int ch0 = u.pn * 128 + wc * 32 + 8 * fq;
#pragma unroll
            for (int ai = 0; ai < 2; ++ai)
#pragma unroll
                for (int m = 0; m < 4; ++m) {
                    bf16_t* rowp = PB + (size_t)(row0 + ai * HALF + m * 16) * PBLD + ch0;
                    f32x4 v0, v1;
#pragma unroll
                    for (int i = 0; i < 4; ++i) { v0[i] = acc[ai][0][m][0][i] * sigm(acc[ai][1][m][0][i]); v1[i] = acc[ai][0][m][1][i] * sigm(acc[ai][1][m][1][i]); }
                    *(u32x4*)rowp = pk8(v0, v1);
                }
        } else {
            const int col0 = u.pn * BM - 512 + wc * 32 + 8 * fq;
#pragma unroll
            for (int ai = 0; ai < 2; ++ai)
#pragma unroll
                for (int m = 0; m < 4; ++m) {
                    bf16_t* rowp = PB + (size_t)(row0 + ai * HALF + m * 16) * PBLD + col0;
#pragma unroll
                    for (int bj = 0; bj < 2; ++bj) *(u32x4*)(rowp + bj * HALF) = pk8(acc[ai][bj][m][0], acc[ai][bj][m][1]);
                }
        }
    }
};

struct EpiKV {
    static constexpr bool PERM = true, AFTER_DRAIN = false;
    float* outK; float* outV; bf16_t* KB; bf16_t* VT;
    __device__ __forceinline__ void operator()(const f32x4 (&acc)[2][2][4][2], const Unit& u, int wr, int wc, int fr, int fq) const {
        const int row0 = u.pm * BM + wr * 64 + fr;
        const bool isv = u.pn >= 4;
        const int c0 = (isv ? u.pn - 4 : u.pn) * BM + wc * 32 + 8 * fq;
        float* outp = isv ? outV : outK;
#pragma unroll
        for (int ai = 0; ai < 2; ++ai)
#pragma unroll
            for (int m = 0; m < 4; ++m) {
                const int row = row0 + ai * HALF + m * 16;
#pragma unroll
                for (int bj = 0; bj < 2; ++bj) {
                    const int col = c0 + bj * HALF;
                    const f32x4 a = acc[ai][bj][m][0], b = acc[ai][bj][m][1];
                    *(f32x4*)(outp + (size_t)row * 1024 + col) = a; *(f32x4*)(outp + (size_t)row * 1024 + col + 4) = b;
                    const u32x4 w = pk8(a, b);
                    if (!isv) *(u32x4*)(KB + (size_t)row * 1024 + col) = w;
                    else {
                        bf16_t* vp = VT + (size_t)col * 2048 + row;
                        vp[0 * 2048] = (bf16_t)(w.x & 0xffffu); vp[1 * 2048] = (bf16_t)(w.x >> 16); vp[2 * 2048] = (bf16_t)(w.y & 0xffffu); vp[3 * 2048] = (bf16_t)(w.y >> 16);
                        vp[4 * 2048] = (bf16_t)(w.z & 0xffffu); vp[5 * 2048] = (bf16_t)(w.z >> 16); vp[6 * 2048] = (bf16_t)(w.w & 0xffffu); vp[7 * 2048] = (bf16_t)(w.w >> 16);
                    }
                }
            }
    }
};

template <bool WRITE_BF> struct EpiRes {
    static constexpr bool PERM = true, AFTER_DRAIN = false;
    const float* base_main; const float* base_tail;
    int load_limit, store_limit;
    float* out; bf16_t* outb; float* ss;
    __device__ __forceinline__ void operator()(const f32x4 (&acc)[2][2][4][2], const Unit& u, int wr, int wc, int fr, int fq) const {
        const int row0 = u.pm * BM + wr * 64 + fr; const int col0 = u.pn * BM + wc * 32 + 8 * fq;
        const float* bp = (u.pm >= 64) ? base_tail - (size_t)MPROMPT * 1024 : base_main;
#pragma unroll
        for (int ai = 0; ai < 2; ++ai)
#pragma unroll
            for (int m = 0; m < 4; ++m) {
                const int row = row0 + ai * HALF + m * 16; const size_t off = (size_t)row * 1024 + col0;
                float s = 0.f;
#pragma unroll
                for (int bj = 0; bj < 2; ++bj) {
                    f32x4 b0 = (f32x4){0.f, 0.f, 0.f, 0.f}, b1 = b0;
                    if (row < load_limit) { b0 = *(const f32x4*)(bp + off + bj * HALF); b1 = *(const f32x4*)(bp + off + bj * HALF + 4); }
                    const f32x4 v0 = acc[ai][bj][m][0] + b0, v1 = acc[ai][bj][m][1] + b1;
                    s += (v0[0] * v0[0] + v0[1] * v0[1]) + (v0[2] * v0[2] + v0[3] * v0[3]) + (v1[0] * v1[0] + v1[1] * v1[1]) + (v1[2] * v1[2] + v1[3] * v1[3]);
                    if (row < store_limit) { *(f32x4*)(out + off + bj * HALF) = v0; *(f32x4*)(out + off + bj * HALF + 4) = v1; }
                    if (WRITE_BF) *(u32x4*)(outb + off + bj * HALF) = pk8(v0, v1);
                }
                s += __shfl_xor(s, 16); s += __shfl_xor(s, 32);
                if (fq == 0) atomicAdd(ss + row, s);
            }
    }
};

struct EpiQ {
    static constexpr bool PERM = true, AFTER_DRAIN = false;
    bf16_t* Q; const float* ss; float c2;
    __device__ __forceinline__ void operator()(const f32x4 (&acc)[2][2][4][2], const Unit& u, int wr, int wc, int fr, int fq) const {
        const int row0 = u.pm * BM + wr * 64 + fr; const int col0 = u.pn * BM + wc * 32 + 8 * fq;
#pragma unroll
        for (int ai = 0; ai < 2; ++ai)
#pragma unroll
            for (int m = 0; m < 4; ++m) {
                const int row = row0 + ai * HALF + m * 16;
                const float rs = __builtin_amdgcn_rsqf(ss[row] * (1.f / 1024.f) + RMS_EPS) * c2;
#pragma unroll
                for (int bj = 0; bj < 2; ++bj) *(u32x4*)(Q + (size_t)row * 1024 + col0 + bj * HALF) = pk8(acc[ai][bj][m][0] * rs, acc[ai][bj][m][1] * rs);
            }
    }
};

struct EpiGU {
    static constexpr bool PERM = true, AFTER_DRAIN = false;
    bf16_t* T; const float* ss;
    __device__ __forceinline__ void operator()(const f32x4 (&acc)[2][2][4][2], const Unit& u, int wr, int wc, int fr, int fq) const {
        const int row0 = u.pm * BM + wr * 64 + fr; const int ch0 = u.pn * 128 + wc * 32 + 8 * fq;
#pragma unroll
        for (int ai = 0; ai < 2; ++ai)
#pragma unroll
            for (int m = 0; m < 4; ++m) {
                const int row = row0 + ai * HALF + m * 16;
                const float rs = __builtin_amdgcn_rsqf(ss[row] * (1.f / 1024.f) + RMS_EPS);
                f32x4 v0, v1;
#pragma unroll
                for (int i = 0; i < 4; ++i) { v0[i] = silu(acc[ai][0][m][0][i] * rs) * (acc[ai][1][m][0][i] * rs); v1[i] = silu(acc[ai][0][m][1][i] * rs) * (acc[ai][1][m][1][i] * rs); }
                *(u32x4*)(T + (size_t)row * 2816 + ch0) = pk8(v0, v1);
            }
    }
};


struct EpiResNorm {
    static constexpr bool PERM = true, AFTER_DRAIN = true;
    const float* base; float* out; const float* gain; float* xbuf; unsigned* cnt; unsigned* tmo;
    __device__ __forceinline__ void fused(f32x4 (&acc)[2][2][4][2], const Unit& u, int wr, int wc, int fr, int fq, PG8_LAS unsigned char* lds, int wid, int lane) const {
        PG8_LAS float* P = (PG8_LAS float*)lds;
        PG8_LAS float* S = (PG8_LAS float*)(lds + 4096);
        PG8_LAS unsigned* flag = (PG8_LAS unsigned*)(lds + 4096 + 1024);
        const int row0 = u.pm * BM + wr * 64 + fr; const int col0 = u.pn * BM + wc * 32 + 8 * fq;
#pragma unroll
        for (int ai = 0; ai < 2; ++ai)
#pragma unroll
            for (int m = 0; m < 4; ++m) {
                const size_t off = (size_t)(row0 + ai * HALF + m * 16) * 1024 + col0; float s = 0.f;
#pragma unroll
                for (int bj = 0; bj < 2; ++bj) {
                    const f32x4 v0 = acc[ai][bj][m][0] + *(const f32x4*)(base + off + bj * HALF), v1 = acc[ai][bj][m][1] + *(const f32x4*)(base + off + bj * HALF + 4);
                    acc[ai][bj][m][0] = v0; acc[ai][bj][m][1] = v1;
                    s += (v0[0] * v0[0] + v0[1] * v0[1]) + (v0[2] * v0[2] + v0[3] * v0[3]) + (v1[0] * v1[0] + v1[1] * v1[1]) + (v1[2] * v1[2] + v1[3] * v1[3]);
                }
                s += __shfl_xor(s, 16); s += __shfl_xor(s, 32);
                if (fq == 0) P[(ai * HALF + wr * 64 + m * 16 + fr) * 4 + wc] = s;
                if (m & 1) asm volatile("" ::: "memory");
            }
        asm volatile("s_waitcnt lgkmcnt(0)" ::: "memory"); __builtin_amdgcn_s_barrier(); asm volatile("" ::: "memory");
        const int row = wid * 64 + lane;
        if (wid < 4) {
            const float t = (P[row * 4 + 0] + P[row * 4 + 1]) + (P[row * 4 + 2] + P[row * 4 + 3]);
            __hip_atomic_store(xbuf + (size_t)(u.pm * BM + row) * 4 + u.pn, t, __ATOMIC_RELAXED, __HIP_MEMORY_SCOPE_AGENT);
            asm volatile("s_waitcnt vmcnt(0)" ::: "memory");
            if (lane == 0) __hip_atomic_fetch_add(cnt + 64 * u.pm, 1u, __ATOMIC_RELAXED, __HIP_MEMORY_SCOPE_AGENT);
        }
        if (wid == 0) {
            unsigned spins = 0; bool dead = false;
            while ((unsigned)__builtin_amdgcn_readfirstlane(__hip_atomic_load(cnt + 64 * u.pm, __ATOMIC_RELAXED, __HIP_MEMORY_SCOPE_AGENT)) < 16u) {
                __builtin_amdgcn_s_sleep(2);
                if (++spins > (1u << 22)) { dead = true; if (lane == 0) __hip_atomic_store(tmo, 1u, __ATOMIC_RELAXED, __HIP_MEMORY_SCOPE_AGENT); break; }
            }
            __builtin_amdgcn_fence(__ATOMIC_ACQUIRE, "agent");
            if (lane == 0) flag[0] = dead ? 1u : 0u;
        }
        asm volatile("s_waitcnt vmcnt(0) lgkmcnt(0)" ::: "memory"); __builtin_amdgcn_s_barrier(); asm volatile("" ::: "memory");
        if (wid < 4) {
            const float* sl = xbuf + (size_t)(u.pm * BM + row) * 4; float t = 0.f;
#pragma unroll
            for (int q = 0; q < 4; ++q) t += __hip_atomic_load(sl + q, __ATOMIC_RELAXED, __HIP_MEMORY_SCOPE_AGENT);
            S[row] = __builtin_amdgcn_rsqf(t * (1.f / 1024.f) + RMS_EPS);
        }
        asm volatile("s_waitcnt vmcnt(0) lgkmcnt(0)" ::: "memory"); __builtin_amdgcn_s_barrier(); asm volatile("" ::: "memory");
        f32x4 gv[2][2];
#pragma unroll
        for (int bj = 0; bj < 2; ++bj) { gv[bj][0] = *(const f32x4*)(gain + col0 + bj * HALF); gv[bj][1] = *(const f32x4*)(gain + col0 + bj * HALF + 4); }
#pragma unroll
        for (int ai = 0; ai < 2; ++ai)
#pragma unroll
            for (int m = 0; m < 4; ++m) {
                const int rl = ai * HALF + wr * 64 + m * 16 + fr; const float rs = S[rl]; const size_t off = (size_t)(u.pm * BM + rl) * 1024 + col0;
#pragma unroll
                for (int bj = 0; bj < 2; ++bj) { *(f32x4*)(out + off + bj * HALF) = acc[ai][bj][m][0] * rs * gv[bj][0]; *(f32x4*)(out + off + bj * HALF + 4) = acc[ai][bj][m][1] * rs * gv[bj][1]; }
            }
    }
};

template <class Epi, class Sched, bool ALIGN_EPI = false, bool SP2 = false>
__device__ __forceinline__ void gemm_phase(PG8_LAS unsigned char* lds, const Gemm g, const Sched& S, const Epi& E) {
    const int tid = threadIdx.x, wid = __builtin_amdgcn_readfirstlane(tid >> 6), lane = tid & 63, wr = wid >> 2, wc = wid & 3, fr = lane & 15, fq = lane >> 4;
    const int K = g.K, nt = K / BK;
    unsigned voffA[2], voffB[2];
#pragma unroll
    for (int i = 0; i < 2; ++i) { int R, C; stage_rc(tid * 16 + i * 8192, R, C); const int Rb = Epi::PERM ? ((R & ~31) + perm32(R & 31)) : R;
        voffA[i] = (unsigned)(R * K + C) * 2u; voffB[i] = (unsigned)(Rb * K + C) * 2u; }
    const size_t kstep = (size_t)(BK * 2);
    const size_t hstep = (size_t)HALF * K * 2;
    const size_t tstep = 2 * hstep;
    const unsigned ldsw = (unsigned)wid * 1024u;
    const int aoff = lds_byte(wr * 64 + fr, fq * 8), boff = lds_byte(wc * 32 + fr, fq * 8);
#define PG8_SA(b, h) (((b) * 2 + (h)) * HTB)
#define PG8_SB(b, h) ((4 + (b) * 2 + (h)) * HTB)
#define PG8_STAGE(bufoff, gbase, voff) do { _Pragma("unroll") for (int _i = 0; _i < 2; ++_i) \
        __builtin_amdgcn_global_load_lds((const unsigned*)((const char*)(gbase) + (voff)[_i]), (PG8_LAS unsigned*)(lds + (bufoff) + ldsw + _i * 8192), 16, 0, 0); } while (0)
#define PG8_LDA(dst, b, h) do { _Pragma("unroll") for (int m = 0; m < 4; ++m) _Pragma("unroll") for (int k = 0; k < 2; ++k) dst[m][k] = *(const PG8_LAS bf16x8*)(lds + PG8_SA(b, h) + aoff + m * 2048 + k * 1024); } while (0)
#define PG8_LDB(dst, b, h) do { _Pragma("unroll") for (int n = 0; n < 2; ++n) _Pragma("unroll") for (int k = 0; k < 2; ++k) dst[n][k] = *(const PG8_LAS bf16x8*)(lds + PG8_SB(b, h) + boff + n * 2048 + k * 1024); } while (0)
#define PG8_MMA(ai, bj, At, Bt) do { __builtin_amdgcn_s_setprio(1); _Pragma("unroll") for (int m = 0; m < 4; ++m) _Pragma("unroll") for (int n = 0; n < 2; ++n) _Pragma("unroll") for (int k = 0; k < 2; ++k) \
        acc[ai][bj][m][n] = __builtin_amdgcn_mfma_f32_16x16x32_bf16(Bt[n][k], At[m][k], acc[ai][bj][m][n], 0, 0, 0); __builtin_amdgcn_s_setprio(0); } while (0)
#define PG8_WAIT_V(n) asm volatile("s_waitcnt vmcnt(" #n ")" ::: "memory")
#define PG8_WAIT_L(n) asm volatile("s_waitcnt lgkmcnt(" #n ")" ::: "memory")
#define PG8_BAR __builtin_amdgcn_s_barrier()
#define PG8_SCHED __builtin_amdgcn_sched_barrier(0)
    Unit cur, nxt; int ui = 0;
    if (!S.next(0, cur)) return;
    f32x4 acc[2][2][4][2];
#pragma unroll
    for (int a = 0; a < 2; ++a)
#pragma unroll
        for (int b = 0; b < 2; ++b)
#pragma unroll
            for (int m = 0; m < 4; ++m)
#pragma unroll
                for (int n = 0; n < 2; ++n) acc[a][b][m][n] = (f32x4){0.f, 0.f, 0.f, 0.f};
    bf16x8 At[4][2], B0[2][2], B1[2][2];
    const char* cA = (const char*)g.A + (size_t)cur.pm * tstep; const char* cB = (const char*)g.Bt + (size_t)cur.pn * tstep;
    S.a_ready(cur);
    if constexpr (SP2) {
        PG8_STAGE(PG8_SB(0, 0), cB, voffB); PG8_STAGE(PG8_SB(0, 1), cB + hstep, voffB); PG8_STAGE(PG8_SA(0, 0), cA, voffA); PG8_STAGE(PG8_SA(0, 1), cA + hstep, voffA);
        if (wr == 1) PG8_BAR;
        PG8_WAIT_V(2); PG8_BAR;
        PG8_STAGE(PG8_SB(1, 0), cB + kstep, voffB); PG8_STAGE(PG8_SA(1, 0), cA + kstep, voffA); PG8_STAGE(PG8_SB(1, 1), cB + hstep + kstep, voffB);
        PG8_WAIT_V(6); PG8_BAR;
    } else {
        PG8_STAGE(PG8_SB(0, 0), cB, voffB); PG8_STAGE(PG8_SA(0, 0), cA, voffA); PG8_STAGE(PG8_SB(0, 1), cB + hstep, voffB); PG8_STAGE(PG8_SA(0, 1), cA + hstep, voffA);
        if (wr == 1) PG8_BAR;
        PG8_WAIT_V(4); PG8_BAR;
        PG8_STAGE(PG8_SB(1, 0), cB + kstep, voffB); PG8_STAGE(PG8_SA(1, 0), cA + kstep, voffA); PG8_STAGE(PG8_SB(1, 1), cB + hstep + kstep, voffB);
        PG8_WAIT_V(6); PG8_BAR;
    }
    for (;;) {
        const bool has_next = S.next(ui + 1, nxt);
        const char* nA = has_next ? (const char*)g.A + (size_t)nxt.pm * tstep : cA; const char* nB = has_next ? (const char*)g.Bt + (size_t)nxt.pn * tstep : cB;
        for (int t = 0; t < nt; t += 2) {
            const bool last = (t == nt - 2);
            const char* a1 = cA + (size_t)(t + 1) * kstep;
            const char* a2 = last ? nA : cA + (size_t)(t + 2) * kstep; const char* b2 = last ? nB : cB + (size_t)(t + 2) * kstep;
            const char* a3 = a2 + kstep; const char* b3 = b2 + kstep;
            if (last && has_next) S.a_ready(nxt);
            if constexpr (SP2) {
            PG8_LDB(B0, 0, 0); PG8_LDB(B1, 0, 1); PG8_SCHED; PG8_LDA(At, 0, 0); PG8_STAGE(PG8_SA(1, 1), a1 + hstep, voffA);
            PG8_WAIT_V(8); PG8_WAIT_L(0); PG8_BAR; PG8_MMA(0, 0, At, B0); PG8_MMA(0, 1, At, B1); PG8_BAR; PG8_SCHED;
            PG8_LDA(At, 0, 1); PG8_STAGE(PG8_SB(0, 0), b2, voffB); PG8_STAGE(PG8_SB(0, 1), b2 + hstep, voffB); PG8_STAGE(PG8_SA(0, 0), a2, voffA);
            PG8_WAIT_V(8); PG8_WAIT_L(0); PG8_BAR; PG8_MMA(1, 0, At, B0); PG8_MMA(1, 1, At, B1); PG8_BAR; PG8_SCHED;
            PG8_LDB(B0, 1, 0); PG8_LDB(B1, 1, 1); PG8_SCHED; PG8_LDA(At, 1, 0); PG8_STAGE(PG8_SA(0, 1), a2 + hstep, voffA);
            PG8_WAIT_V(8); PG8_WAIT_L(0); PG8_BAR; PG8_MMA(0, 0, At, B0); PG8_MMA(0, 1, At, B1); PG8_BAR; PG8_SCHED;
            PG8_LDA(At, 1, 1); PG8_STAGE(PG8_SB(1, 0), b3, voffB); PG8_STAGE(PG8_SB(1, 1), b3 + hstep, voffB); PG8_STAGE(PG8_SA(1, 0), a3, voffA);
            PG8_WAIT_V(8); PG8_WAIT_L(0); PG8_BAR; PG8_MMA(1, 0, At, B0); PG8_MMA(1, 1, At, B1); PG8_BAR; PG8_SCHED;
            } else {
            PG8_LDB(B0, 0, 0); PG8_SCHED; PG8_LDA(At, 0, 0); PG8_STAGE(PG8_SA(1, 1), a1 + hstep, voffA);
            PG8_WAIT_L(8); PG8_BAR; PG8_WAIT_L(0); PG8_MMA(0, 0, At, B0); PG8_BAR; PG8_SCHED;
            PG8_LDB(B1, 0, 1); PG8_STAGE(PG8_SB(0, 0), b2, voffB);
            PG8_BAR; PG8_WAIT_L(0); PG8_MMA(0, 1, At, B1); PG8_BAR;
            PG8_LDA(At, 0, 1); PG8_STAGE(PG8_SA(0, 0), a2, voffA);
            PG8_BAR; PG8_WAIT_L(0); PG8_MMA(1, 0, At, B0); PG8_BAR; PG8_SCHED;
            PG8_STAGE(PG8_SB(0, 1), b2 + hstep, voffB);
            PG8_WAIT_V(6); PG8_BAR; PG8_MMA(1, 1, At, B1); PG8_BAR;
            PG8_LDB(B0, 1, 0); PG8_SCHED; PG8_LDA(At, 1, 0); PG8_STAGE(PG8_SA(0, 1), a2 + hstep, voffA);
            PG8_WAIT_L(8); PG8_BAR; PG8_WAIT_L(0); PG8_MMA(0, 0, At, B0); PG8_BAR; PG8_SCHED;
            PG8_LDB(B1, 1, 1); PG8_STAGE(PG8_SB(1, 0), b3, voffB);
            PG8_BAR; PG8_WAIT_L(0); PG8_MMA(0, 1, At, B1); PG8_BAR;
            PG8_LDA(At, 1, 1); PG8_STAGE(PG8_SA(1, 0), a3, voffA);
            PG8_BAR; PG8_WAIT_L(0); PG8_MMA(1, 0, At, B0); PG8_BAR; PG8_SCHED;
            PG8_STAGE(PG8_SB(1, 1), b3 + hstep, voffB);
            PG8_WAIT_V(6); PG8_BAR; PG8_MMA(1, 1, At, B1); PG8_BAR;
            }
        }
        if constexpr (ALIGN_EPI) { if (wr == 0) PG8_BAR; }
        if constexpr (!Epi::AFTER_DRAIN) { E(acc, cur, wr, wc, fr, fq); S.done(cur); }
        if (!has_next) break;
#pragma unroll
        for (int a = 0; a < 2; ++a)
#pragma unroll
            for (int b = 0; b < 2; ++b)
#pragma unroll
                for (int m = 0; m < 4; ++m)
#pragma unroll
                    for (int n = 0; n < 2; ++n) acc[a][b][m][n] = (f32x4){0.f, 0.f, 0.f, 0.f};
        cur = nxt; cA = nA; cB = nB; ++ui;
        if constexpr (ALIGN_EPI) { if (wr == 1) PG8_BAR; }
    }
    PG8_WAIT_V(0);
    if constexpr (!ALIGN_EPI) { if (wr == 0) PG8_BAR; }
    PG8_BAR;
    if constexpr (Epi::AFTER_DRAIN) { E.fused(acc, cur, wr, wc, fr, fq, lds, wid, lane); S.done(cur); }
#undef PG8_SA
#undef PG8_SB
#undef PG8_STAGE
#undef PG8_LDA
#undef PG8_LDB
#undef PG8_MMA
#undef PG8_WAIT_V
#undef PG8_WAIT_L
#undef PG8_BAR
#undef PG8_SCHED
}
}

constexpr int NWAVES = 8;
#ifndef MK_PER_PHASE
#define MK_PER_PHASE 0
#endif
constexpr int N_PHASES = 10;

constexpr int DM = 1024, NB = 8, SEQ = 2048, MP = NB * SEQ  , DEC = 128, MV = MP + DEC  , MR = 16640  ;
constexpr int CC = 512, CW = 31, NH = 4, DKV = 128, QKVN = 1536, NMEM = 256, MHD = 256, DFF = 2816, INC = 3080;
constexpr int PBLD = pg8::PBLD;
constexpr int NCHUNK = NB * NH * 32;
constexpr float RMS_EPS = 1e-6f;
constexpr float ATT_C2 = 0.0625f * 1.4426950408889634f;

constexpr size_t OUT_YP = 0, OUT_YS = 16777216, OUT_CONVP = 16908288, OUT_SCP = 17031168, OUT_DLP = 17068032, OUT_MKP = 17592320, OUT_MVP = 19689472,
                 OUT_CONVS = 21786624, OUT_SCS = 23752704, OUT_DLS = 24342528, OUT_END = 32731136;

constexpr size_t MiB = 1u << 20;
constexpr size_t WS_CTL = 0, CTL_ZERO_BYTES = 1 * MiB;
constexpr size_t WS_WIN = 1 * MiB, WS_WOUT = 7 * MiB, WS_WMQ = 9 * MiB, WS_WMKV = 11 * MiB, WS_WMO = 15 * MiB, WS_WGU = 17 * MiB, WS_WDN = 28 * MiB;
constexpr size_t WS_BG = 34 * MiB, WS_MEMN = 35 * MiB, WS_KB = 39 * MiB, WS_VT = 43 * MiB, WS_GL = 47 * MiB, WS_X1S = 47 * MiB + 65536, WS_XBUF = 47 * MiB + 655360;
constexpr size_t WS_RA = 48 * MiB;
constexpr size_t WS_RB = 138 * MiB;
constexpr size_t WS_RC = 171 * MiB;
constexpr size_t WS_RD = 220 * MiB;
constexpr size_t WS_U = WS_RD, WS_W = 252 * MiB, WS_QG = 268 * MiB, WS_KDT = 284 * MiB, WS_QK = 300 * MiB;
constexpr size_t WS_RE = 308 * MiB;
constexpr size_t WS_RF = 341 * MiB;
constexpr size_t WS_END = 406 * MiB;
constexpr int CW_TMO = 0, CW_CODE = 1, CW_BAR = 4096, CW_SS1 = 65536, CW_SS2 = 98304, CW_SS3 = 131072, CW_PANEL = 200000;

constexpr int RING_OFF = 0, RING_BYTES = 143360;
constexpr int LDSCTL_OFF = RING_BYTES, MISC_OFF = LDSCTL_OFF + 320;
constexpr int LDS_BYTES = 147456;

#define GAS __attribute__((address_space(1)))
#define LAS __attribute__((address_space(3)))
typedef unsigned short bf16;
typedef unsigned v4u __attribute__((ext_vector_type(4)));
typedef unsigned v2u __attribute__((ext_vector_type(2)));
typedef float f32x4 __attribute__((ext_vector_type(4)));
typedef float f32x16 __attribute__((ext_vector_type(16)));
typedef short bf16x8 __attribute__((ext_vector_type(8)));
typedef GAS unsigned gu32;
#define RLX_AGENT __ATOMIC_RELAXED, __HIP_MEMORY_SCOPE_AGENT
#define LDS_WAIT() asm volatile("s_waitcnt lgkmcnt(0)" ::: "memory")
#define VM_WAIT() asm volatile("s_waitcnt vmcnt(0)" ::: "memory")
using pg8::pk2; using pg8::silu; using pg8::sigm;
__device__ __forceinline__ float bf2f(unsigned b) { return __uint_as_float(b << 16); }
__device__ __forceinline__ float bflo(unsigned w) { return __uint_as_float(w << 16); }
__device__ __forceinline__ float bfhi(unsigned w) { return __uint_as_float(w & 0xffff0000u); }
__device__ __forceinline__ void unpack8(const v4u& w, float (&f)[8]) { f[0] = bflo(w.x); f[1] = bfhi(w.x); f[2] = bflo(w.y); f[3] = bfhi(w.y); f[4] = bflo(w.z); f[5] = bfhi(w.z); f[6] = bflo(w.w); f[7] = bfhi(w.w); }
__device__ __forceinline__ v4u pack8(const float (&f)[8]) { v4u w; w.x = pk2(f[0], f[1]); w.y = pk2(f[2], f[3]); w.z = pk2(f[4], f[5]); w.w = pk2(f[6], f[7]); return w; }
__device__ __forceinline__ float wave_sum(float v) {
#pragma unroll
    for (int o = 1; o < 64; o <<= 1) v += __shfl_xor(v, o);
    return v;
}
__device__ __forceinline__ float wave_max(float v) {
#pragma unroll
    for (int o = 1; o < 64; o <<= 1) v = fmaxf(v, __shfl_xor(v, o));
    return v;
}

#define XB_TMO      128
#define XB_XCNT(j)  (256  + 64 * (j))
#define XB_XSUB(j)  (1280 + 64 * (j))
#define XB_XGEN(j)  (2304 + 64 * (j))
#define XB_TOP      3328
#define XB_TOPGEN   3392
#define XCD_BAR_WORDS 3456
#define XB_SPIN_CAP (1u << 18)

__device__ __forceinline__ unsigned xb_ld(unsigned* p)              { return __hip_atomic_load(p, __ATOMIC_RELAXED, __HIP_MEMORY_SCOPE_AGENT); }
__device__ __forceinline__ unsigned xb_add(unsigned* p, unsigned v) { return __hip_atomic_fetch_add(p, v, __ATOMIC_RELAXED, __HIP_MEMORY_SCOPE_AGENT); }
__device__ __forceinline__ unsigned xb_xcc_id() { return (unsigned)__builtin_amdgcn_s_getreg((3 << 11) | 20) & 0xFu; }
#define XB_SPIN(cond, bar) do { unsigned _sp = 0; while (cond) { __builtin_amdgcn_s_sleep(1); \
    if ((++_sp & 255u) == 0u) { if (xb_ld(&(bar)[XB_TMO])) break; if (_sp > XB_SPIN_CAP) { atomicAdd(&(bar)[XB_TMO], 1u); break; } } } } while (0)

struct XcdBarrier {
    unsigned* bar; unsigned x;
    volatile LAS unsigned* st;
};

__device__ __forceinline__ XcdBarrier xcd_barrier_post(unsigned* bar, volatile LAS unsigned* st) {
    XcdBarrier b; b.bar = bar; b.x = xb_xcc_id(); b.st = st;
    if (threadIdx.x == 0) (void)xb_add(&bar[XB_XCNT(b.x)], 1u);
    return b;
}
__device__ __forceinline__ void xcd_barrier_complete(unsigned* bar, unsigned x, unsigned& nloc, unsigned& nx) {
    const unsigned G = gridDim.x * gridDim.y * gridDim.z;
    unsigned sum, cnt, mine, sp = 0u;
    for (;;) {
        sum = 0u; cnt = 0u; mine = 0u;
#pragma unroll
        for (unsigned j = 0; j < 16; ++j) { const unsigned c = xb_ld(&bar[XB_XCNT(j)]); sum += c; cnt += (c > 0u) ? 1u : 0u; mine = (j == x) ? c : mine; }
        if (sum == G) break;
        __builtin_amdgcn_s_sleep(1);
        if ((++sp & 255u) == 0u) { if (xb_ld(&bar[XB_TMO])) break; if (sp > XB_SPIN_CAP) { atomicAdd(&bar[XB_TMO], 1u); break; } }
    }
    nloc = mine > 0u ? mine : 1u; nx = cnt > 0u ? cnt : 1u;
}

__device__ __forceinline__ void xcd_barrier(const XcdBarrier& b) {
    asm volatile("s_waitcnt vmcnt(0)" ::: "memory");
    __syncthreads();
    if (threadIdx.x == 0) {
        unsigned* bar = b.bar;
        __builtin_amdgcn_s_waitcnt(0);
        unsigned nloc = b.st[0], nx = b.st[1];
        if (nloc == 0u) { xcd_barrier_complete(bar, b.x, nloc, nx); b.st[0] = nloc; b.st[1] = nx; }
        const unsigned old = xb_add(&bar[XB_XSUB(b.x)], 1u);
        const unsigned gen = old / nloc;
        if (old + 1u == (gen + 1u) * nloc) {
            __builtin_amdgcn_fence(__ATOMIC_RELEASE, "agent");
            asm volatile("s_waitcnt vmcnt(0)" ::: "memory");
            const unsigned og = xb_add(&bar[XB_TOP], 1u);
            const unsigned tg = og / nx;
            if (og + 1u == (tg + 1u) * nx) xb_add(&bar[XB_TOPGEN], 1u);
            else XB_SPIN(xb_ld(&bar[XB_TOPGEN]) == tg, bar);
            __builtin_amdgcn_fence(__ATOMIC_ACQUIRE, "agent");
            xb_add(&bar[XB_XGEN(b.x)], 1u);
            asm volatile("s_waitcnt vmcnt(0)" ::: "memory");
        } else {
            XB_SPIN(xb_ld(&bar[XB_XGEN(b.x)]) == gen, bar);
            __builtin_amdgcn_fence(__ATOMIC_ACQUIRE, "agent");
            asm volatile("s_waitcnt vmcnt(0)" ::: "memory");
        }
    }
    __syncthreads();
}

struct Args { const float* in[30]; float* out; unsigned char* ws; int ph_lo, ph_hi, li, pad; };
struct Frame {
    LAS unsigned char* lds;
    volatile LAS unsigned* MISC;
    gu32* ctl;
    int tid, lane, wave;
    int vcu, G;
};
enum { I_XP = 0, I_XS, I_MEM, I_CCONV, I_SSC, I_SDELTA, I_CMK, I_CMV, I_NMIX, I_WIN, I_CONVW, I_CONVB, I_LNG, I_LNB, I_SCW, I_ALOG, I_DTB, I_DNN, I_WOUT,
       I_NMQ, I_NMKV, I_WMQ, I_WMK, I_WMV, I_WMO, I_NFFN, I_WG, I_WU, I_WD, I_NF };

__device__ __forceinline__ void tr_item(const float* W, int ldw, int k0, int c0, const float* gain, bf16* WT, int K, int r0, LAS float* scr, int lane) {
#pragma unroll 8
    for (int i = 0; i < 32; ++i) { const int kk = 2 * i + (lane >> 5); scr[kk * 33 + (lane & 31)] = W[(size_t)(k0 + kk) * ldw + c0 + (lane & 31)]; }
    LDS_WAIT(); asm volatile("" ::: "memory");
    const int c = lane & 7;
    float gv[8];
#pragma unroll
    for (int i = 0; i < 8; ++i) gv[i] = gain ? gain[k0 + 8 * c + i] : 1.f;
#pragma unroll
    for (int j = 0; j < 4; ++j) { const int n = (lane >> 3) + 8 * j; const LAS float* s = scr + (8 * c) * 33 + n;
        v4u o; o.x = pk2(s[0 * 33] * gv[0], s[1 * 33] * gv[1]); o.y = pk2(s[2 * 33] * gv[2], s[3 * 33] * gv[3]); o.z = pk2(s[4 * 33] * gv[4], s[5 * 33] * gv[5]); o.w = pk2(s[6 * 33] * gv[6], s[7 * 33] * gv[7]);
        *(GAS v4u*)(WT + (size_t)(r0 + n) * K + k0 + 8 * c) = o; }
    LDS_WAIT(); asm volatile("" ::: "memory");
}
__device__ __forceinline__ float softplusf_(float x) { return x > 20.f ? x : log1pf(__expf(x)); }

__device__ __forceinline__ void p0_prologue(const Args& A, Frame& F) {
    LAS float* scr = (LAS float*)(F.lds + RING_OFF + F.wave * 8448);
    const int gw = F.vcu * NWAVES + F.wave, NGW = F.G * NWAVES;
    unsigned char* ws = A.ws;
    const float* const pWMK = A.in[I_WMK]; const float* const pWMV = A.in[I_WMV]; const float* const pWG = A.in[I_WG]; const float* const pWU = A.in[I_WU];
    const float* const pXP = A.in[I_XP]; const float* const pXS = A.in[I_XS];
    constexpr int I_A = 96 * 16, I_B = 32 * 16, I_D = 64 * 16, I_F = 176 * 16, I_G = 32 * 44;
    constexpr int NITEMS = I_A + I_B + I_B + I_D + I_B + I_F + I_G;
    for (int it = gw; it < NITEMS; it += NGW) {
        int r = it;
        if (r < I_A) { const int nb = r % 96, kb = r / 96, j0 = 32 * nb; int src = j0;
            if (j0 < 1024) { const int tile = j0 >> 8, local = j0 & 255; src = local < 128 ? 128 * tile + local : 512 + 128 * tile + (local - 128); }
            tr_item(A.in[I_WIN], INC, 64 * kb, src, nullptr, (bf16*)(ws + WS_WIN), DM, j0, scr, F.lane); continue; } r -= I_A;
        if (r < I_B) { const int nb = r % 32, kb = r / 32; tr_item(A.in[I_WOUT], DM, 64 * kb, 32 * nb, nullptr, (bf16*)(ws + WS_WOUT), DM, 32 * nb, scr, F.lane); continue; } r -= I_B;
        if (r < I_B) { const int nb = r % 32, kb = r / 32; tr_item(A.in[I_WMQ], DM, 64 * kb, 32 * nb, A.in[I_NMQ], (bf16*)(ws + WS_WMQ), DM, 32 * nb, scr, F.lane); continue; } r -= I_B;
        if (r < I_D) { const int nb = r % 64, kb = r / 64, j0 = 32 * nb; const bool isv = j0 >= 1024;
            tr_item(isv ? pWMV : pWMK, DM, 64 * kb, isv ? j0 - 1024 : j0, nullptr, (bf16*)(ws + WS_WMKV), DM, j0, scr, F.lane); continue; } r -= I_D;
        if (r < I_B) { const int nb = r % 32, kb = r / 32; tr_item(A.in[I_WMO], DM, 64 * kb, 32 * nb, nullptr, (bf16*)(ws + WS_WMO), DM, 32 * nb, scr, F.lane); continue; } r -= I_B;
        if (r < I_F) { const int nb = r % 176, kb = r / 176, j0 = 32 * nb, tile = j0 >> 8, local = j0 & 255; const bool up = local >= 128;
            tr_item(up ? pWU : pWG, DFF, 64 * kb, 128 * tile + (up ? local - 128 : local), A.in[I_NFFN], (bf16*)(ws + WS_WGU), DM, j0, scr, F.lane); continue; } r -= I_F;
        { const int nb = r % 32, kb = r / 32; tr_item(A.in[I_WD], DM, 64 * kb, 32 * nb, nullptr, (bf16*)(ws + WS_WDN), DFF, 32 * nb, scr, F.lane); }
    }
    {
        bf16* H = (bf16*)(ws + WS_RB); float* BG = (float*)(ws + WS_BG);
        const float* win = A.in[I_WIN]; const float* gain = A.in[I_NMIX];
        float w8[4][4][8];
#pragma unroll
        for (int j = 0; j < 4; ++j)
#pragma unroll
            for (int i = 0; i < 4; ++i) { const int k = 256 * j + 4 * F.lane + i; const f32x4 a = *(const f32x4*)(win + (size_t)k * INC + 3072), b = *(const f32x4*)(win + (size_t)k * INC + 3076);
                w8[j][i][0] = a[0]; w8[j][i][1] = a[1]; w8[j][i][2] = a[2]; w8[j][i][3] = a[3]; w8[j][i][4] = b[0]; w8[j][i][5] = b[1]; w8[j][i][6] = b[2]; w8[j][i][7] = b[3]; }
        f32x4 gn[4];
#pragma unroll
        for (int j = 0; j < 4; ++j) gn[j] = *(const f32x4*)(gain + 256 * j + 4 * F.lane);
        const f32x4 alog4 = *(const f32x4*)A.in[I_ALOG], dtb4 = *(const f32x4*)A.in[I_DTB];
        for (int m = gw; m < MR; m += NGW) {
            GAS unsigned long long* o8 = (GAS unsigned long long*)(H + (size_t)m * DM) + F.lane;
            if (m >= MV) {
#pragma unroll
                for (int j = 0; j < 4; ++j) o8[64 * j] = 0ull;
                if (F.lane < 8) BG[(size_t)m * 8 + F.lane] = 0.f;
                continue;
            }
            const float* xrow = (m < MP) ? pXP + (size_t)m * DM : pXS + (size_t)(m - MP) * DM;
            const GAS f32x4* xr = (const GAS f32x4*)xrow + F.lane;
            f32x4 v[4]; float s2 = 0.f;
#pragma unroll
            for (int j = 0; j < 4; ++j) { v[j] = xr[64 * j]; s2 += (v[j][0] * v[j][0] + v[j][1] * v[j][1]) + (v[j][2] * v[j][2] + v[j][3] * v[j][3]); }
            const float rstd = 1.f / sqrtf(wave_sum(s2) * (1.f / DM) + RMS_EPS);
            float p8[8];
#pragma unroll
            for (int c = 0; c < 8; ++c) p8[c] = 0.f;
#pragma unroll
            for (int j = 0; j < 4; ++j) { v[j] = v[j] * rstd * gn[j];
#pragma unroll
                for (int i = 0; i < 4; ++i)
#pragma unroll
                    for (int c = 0; c < 8; ++c) p8[c] += v[j][i] * w8[j][i][c];
                o8[64 * j] = (unsigned long long)pk2(v[j][0], v[j][1]) | ((unsigned long long)pk2(v[j][2], v[j][3]) << 32); }
#pragma unroll
            for (int c = 0; c < 8; ++c) p8[c] = wave_sum(p8[c]);
            f32x4 bo, go;
#pragma unroll
            for (int c = 0; c < 4; ++c) { bo[c] = 1.f / (1.f + expf(-p8[c])); go[c] = -expf(alog4[c]) * softplusf_(p8[4 + c] + dtb4[c]); }
            if (F.lane == 0) { *(f32x4*)(BG + (size_t)m * 8) = bo; *(f32x4*)(BG + (size_t)m * 8 + 4) = go; }
        }
    }
    {
        bf16* MN = (bf16*)(ws + WS_MEMN); const float* gain = A.in[I_NMKV];
        f32x4 gn[4];
#pragma unroll
        for (int j = 0; j < 4; ++j) gn[j] = *(const f32x4*)(gain + 256 * j + 4 * F.lane);
        for (int m = gw; m < NB * NMEM; m += NGW) {
            const GAS f32x4* xr = (const GAS f32x4*)(A.in[I_MEM] + (size_t)m * DM) + F.lane;
            f32x4 v[4]; float s2 = 0.f;
#pragma unroll
            for (int j = 0; j < 4; ++j) { v[j] = xr[64 * j]; s2 += (v[j][0] * v[j][0] + v[j][1] * v[j][1]) + (v[j][2] * v[j][2] + v[j][3] * v[j][3]); }
            const float rstd = 1.f / sqrtf(wave_sum(s2) * (1.f / DM) + RMS_EPS);
            GAS unsigned long long* o8 = (GAS unsigned long long*)(MN + (size_t)m * DM) + F.lane;
#pragma unroll
            for (int j = 0; j < 4; ++j) { v[j] = v[j] * rstd * gn[j]; o8[64 * j] = (unsigned long long)pk2(v[j][0], v[j][1]) | ((unsigned long long)pk2(v[j][2], v[j][3]) << 32); }
        }
    }
}

__device__ __forceinline__ void conv_tile(const Args& A, Frame& F, int b, int tile) {
    const bf16* PB = (const bf16*)(A.ws + WS_RA); bf16* CD = (bf16*)(A.ws + WS_RB); bf16* QC = (bf16*)(A.ws + WS_RC);
    int oz; asm volatile("v_mov_b32 %0, 0" : "=v"(oz));
    const int c = F.tid + oz; const int row0 = b * SEQ + tile * 64;
    LAS float* Y = (LAS float*)(F.lds + RING_OFF);
    {
        float w[CW];
#pragma unroll
        for (int j = 0; j < CW; ++j) w[j] = A.in[I_CONVW][j * CC + c];
        const float bias = A.in[I_CONVB][c];
        float uv[46];
        const unsigned rb = (unsigned)(b * SEQ + tile * 64);
#pragma unroll
        for (int i = 0; i < 30; ++i) { const int tk = tile * 64 - 30 + i; const unsigned tkc = tk < 0 ? 0u : (unsigned)tk; const float vv = bf2f(PB[(unsigned)(b * SEQ + tkc) * (unsigned)PBLD + (unsigned)c]); uv[i] = (tk >= 0) ? vv : 0.f; }
#pragma unroll 1
        for (int seg = 0; seg < 4; ++seg) {
#pragma unroll
            for (int i = 0; i < 16; ++i) uv[30 + i] = bf2f(PB[(rb + (unsigned)(seg * 16 + i)) * (unsigned)PBLD + (unsigned)c]);
#pragma unroll
            for (int t = 0; t < 16; ++t) { float a = bias;
#pragma unroll
                for (int j = 0; j < CW; ++j) a += w[j] * uv[t + j];
                Y[(seg * 16 + t) * CC + c] = a; }
#pragma unroll
            for (int i = 0; i < 30; ++i) uv[i] = uv[i + 16];
        }
    }
    __syncthreads();
    {
        const int ch0 = 8 * F.lane + oz;
        const f32x4 g0 = *(const f32x4*)(A.in[I_LNG] + ch0), g1 = *(const f32x4*)(A.in[I_LNG] + ch0 + 4), b0 = *(const f32x4*)(A.in[I_LNB] + ch0), b1 = *(const f32x4*)(A.in[I_LNB] + ch0 + 4);
#pragma unroll 2
        for (int tt = 0; tt < 8; ++tt) { const int t = 8 * F.wave + tt;
            f32x4 y0 = *(const LAS f32x4*)(Y + t * CC + ch0), y1 = *(const LAS f32x4*)(Y + t * CC + ch0 + 4);
            const float mean = wave_sum((y0[0] + y0[1]) + (y0[2] + y0[3]) + (y1[0] + y1[1]) + (y1[2] + y1[3])) * (1.f / CC);
            y0 = y0 - mean; y1 = y1 - mean;
            const float var = wave_sum((y0[0] * y0[0] + y0[1] * y0[1]) + (y0[2] * y0[2] + y0[3] * y0[3]) + (y1[0] * y1[0] + y1[1] * y1[1]) + (y1[2] * y1[2] + y1[3] * y1[3])) * (1.f / CC);
            const float rstd = 1.f / sqrtf(var + 1e-5f);
            y0 = y0 * rstd * g0 + b0; y1 = y1 * rstd * g1 + b1;
            float o[8];
#pragma unroll
            for (int i = 0; i < 4; ++i) { o[i] = silu(y0[i]); o[4 + i] = silu(y1[i]); }
            *(GAS v4u*)(CD + (size_t)(row0 + t) * DM + ch0) = pack8(o); }
    }
    if (tile == 31) {
        float* oc = A.out + OUT_CONVP + (size_t)b * 30 * CC;
        for (int j = 0; j < 30; ++j) oc[j * CC + c] = bf2f(PB[(size_t)(b * SEQ + SEQ - 30 + j) * PBLD + c]);
        float* os = A.out + OUT_SCP + (size_t)b * 3 * QKVN;
        for (int e = F.tid; e < 3 * QKVN; e += NWAVES * 64) { const int j = e / QKVN, ch = e % QKVN; os[e] = bf2f(PB[(size_t)(b * SEQ + SEQ - 3 + j) * PBLD + 512 + ch]); }
    }
    {
        const int t0 = tile * 64 + 8 * F.wave;
#pragma unroll 1
        for (int p = 0; p < 3; ++p) {
            const int ch0 = 512 * p + 8 * F.lane + oz;
            float wsc[4][8];
#pragma unroll
            for (int j = 0; j < 4; ++j) { const f32x4 a = *(const f32x4*)(A.in[I_SCW] + j * QKVN + ch0), bb = *(const f32x4*)(A.in[I_SCW] + j * QKVN + ch0 + 4);
#pragma unroll
                for (int i = 0; i < 4; ++i) { wsc[j][i] = a[i]; wsc[j][4 + i] = bb[i]; } }
            float win[3][8];
#pragma unroll
            for (int j = 0; j < 3; ++j) { const int tk = t0 - 3 + j; const int tkc = tk < 0 ? 0 : tk;
                const v4u x = *(const GAS v4u*)(PB + (size_t)(b * SEQ + tkc) * PBLD + 512 + ch0); unpack8(x, win[j]);
#pragma unroll
                for (int i = 0; i < 8; ++i) win[j][i] = (tk >= 0) ? win[j][i] : 0.f; }
#pragma unroll
            for (int tt = 0; tt < 8; ++tt) {
                float cur[8]; { const v4u x = *(const GAS v4u*)(PB + (size_t)(b * SEQ + t0 + tt) * PBLD + 512 + ch0); unpack8(x, cur); }
                float y[8]; float ss = 0.f;
#pragma unroll
                for (int i = 0; i < 8; ++i) { const float a = wsc[0][i] * win[0][i] + wsc[1][i] * win[1][i] + wsc[2][i] * win[2][i] + wsc[3][i] * cur[i]; y[i] = silu(a); ss += y[i] * y[i]; }
                if (p < 2) { ss += __shfl_xor(ss, 1); ss += __shfl_xor(ss, 2); ss += __shfl_xor(ss, 4); ss += __shfl_xor(ss, 8);
                    const float sc = (1.f / sqrtf(ss + 1e-6f)) * (p == 0 ? 0.08838834764831845f : 1.f);
#pragma unroll
                    for (int i = 0; i < 8; ++i) y[i] *= sc; }
                *(GAS v4u*)(QC + (size_t)(b * SEQ + t0 + tt) * QKVN + ch0) = pack8(y);
#pragma unroll
                for (int i = 0; i < 8; ++i) { win[0][i] = win[1][i]; win[1][i] = win[2][i]; win[2][i] = cur[i]; }
            }
        }
    }
    __syncthreads();
}
__device__ __forceinline__ void conv_sample(const Args& A, Frame& F, int s) {
    const bf16* PB = (const bf16*)(A.ws + WS_RA); bf16* CD = (bf16*)(A.ws + WS_RB); bf16* QC = (bf16*)(A.ws + WS_RC);
    const int c = F.tid; const size_t row = (size_t)MP + s;
    LAS float* Y = (LAS float*)(F.lds + RING_OFF);
    {
        const float* cache = A.in[I_CCONV] + (size_t)s * 30 * CC; float* oc = A.out + OUT_CONVS + (size_t)s * 30 * CC;
        const float us = bf2f(PB[row * PBLD + c]);
        float a = A.in[I_CONVB][c];
        float prev = cache[c];
#pragma unroll 6
        for (int j = 0; j < 30; ++j) { a += A.in[I_CONVW][j * CC + c] * prev; const float nx = (j < 29) ? cache[(j + 1) * CC + c] : us; oc[j * CC + c] = nx; prev = nx; }
        a += A.in[I_CONVW][30 * CC + c] * us;
        Y[c] = a;
    }
    __syncthreads();
    if (F.wave == 7) {
        const int ch0 = 8 * F.lane;
        const f32x4 g0 = *(const f32x4*)(A.in[I_LNG] + ch0), g1 = *(const f32x4*)(A.in[I_LNG] + ch0 + 4), b0 = *(const f32x4*)(A.in[I_LNB] + ch0), b1 = *(const f32x4*)(A.in[I_LNB] + ch0 + 4);
        f32x4 y0 = *(const LAS f32x4*)(Y + ch0), y1 = *(const LAS f32x4*)(Y + ch0 + 4);
        const float mean = wave_sum((y0[0] + y0[1]) + (y0[2] + y0[3]) + (y1[0] + y1[1]) + (y1[2] + y1[3])) * (1.f / CC);
        y0 = y0 - mean; y1 = y1 - mean;
        const float var = wave_sum((y0[0] * y0[0] + y0[1] * y0[1]) + (y0[2] * y0[2] + y0[3] * y0[3]) + (y1[0] * y1[0] + y1[1] * y1[1]) + (y1[2] * y1[2] + y1[3] * y1[3])) * (1.f / CC);
        const float rstd = 1.f / sqrtf(var + 1e-5f);
        y0 = y0 * rstd * g0 + b0; y1 = y1 * rstd * g1 + b1;
        float o[8];
#pragma unroll
        for (int i = 0; i < 4; ++i) { o[i] = silu(y0[i]); o[4 + i] = silu(y1[i]); }
        *(GAS v4u*)(CD + row * DM + ch0) = pack8(o);
    }
    if (F.wave < 3) {
        const int p = F.wave; const int ch0 = 512 * p + 8 * F.lane;
        const float* st = A.in[I_SSC] + (size_t)s * 3 * QKVN; float* os = A.out + OUT_SCS + (size_t)s * 3 * QKVN;
        float win[3][8], cur[8], y[8];
#pragma unroll
        for (int j = 0; j < 3; ++j) { const f32x4 a = *(const f32x4*)(st + j * QKVN + ch0), bb = *(const f32x4*)(st + j * QKVN + ch0 + 4);
#pragma unroll
            for (int i = 0; i < 4; ++i) { win[j][i] = a[i]; win[j][4 + i] = bb[i]; } }
        { const v4u x = *(const GAS v4u*)(PB + row * PBLD + 512 + ch0); unpack8(x, cur); }
        float ss = 0.f;
#pragma unroll
        for (int i = 0; i < 8; ++i) { float a = 0.f;
#pragma unroll
            for (int j = 0; j < 3; ++j) a += A.in[I_SCW][j * QKVN + ch0 + i] * win[j][i];
            a += A.in[I_SCW][3 * QKVN + ch0 + i] * cur[i]; y[i] = silu(a); ss += y[i] * y[i]; }
        if (p < 2) { ss += __shfl_xor(ss, 1); ss += __shfl_xor(ss, 2); ss += __shfl_xor(ss, 4); ss += __shfl_xor(ss, 8);
            const float sc = (1.f / sqrtf(ss + 1e-6f)) * (p == 0 ? 0.08838834764831845f : 1.f);
#pragma unroll
            for (int i = 0; i < 8; ++i) y[i] *= sc; }
        *(GAS v4u*)(QC + row * QKVN + ch0) = pack8(y);
#pragma unroll
        for (int j = 0; j < 3; ++j) { f32x4 a, bb;
#pragma unroll
            for (int i = 0; i < 4; ++i) { a[i] = (j < 2) ? win[j + 1][i] : cur[i]; bb[i] = (j < 2) ? win[j + 1][4 + i] : cur[4 + i]; }
            *(f32x4*)(os + j * QKVN + ch0) = a; *(f32x4*)(os + j * QKVN + ch0 + 4) = bb; }
    }
    __syncthreads();
}

__device__ __forceinline__ bf16x8 lds_frag16(const LAS unsigned char* p) { return *(const LAS bf16x8*)p; }
__device__ __forceinline__ void d1_chunk(const Args& A, Frame& F, int ci) {
    using pg8::f32x4;
    const int b = ci >> 7, h = (ci >> 5) & 3, n = ci & 31; const int row0 = b * SEQ + n * 64;
    const bf16* QC = (const bf16*)(A.ws + WS_RC); const float* BG = (const float*)(A.ws + WS_BG);
    float* Ug = (float*)(A.ws + WS_U) + (size_t)ci * 8192; bf16* Wg = (bf16*)(A.ws + WS_W) + (size_t)ci * 8192; bf16* QGg = (bf16*)(A.ws + WS_QG) + (size_t)ci * 8192;
    bf16* KDTg = (bf16*)(A.ws + WS_KDT) + (size_t)ci * 8192; bf16* QKg = (bf16*)(A.ws + WS_QK) + (size_t)ci * 4096; float* GLg = (float*)(A.ws + WS_GL);
    constexpr int OFF_K = 0, OFF_Q = 17408, OFF_VBT = 34816, OFF_KBGT = 53248, OFF_L = 71680, OFF_T = 89088, OFF_GC = 98304, OFF_BETA = 98560, OFF_EG = 98816, OFF_TM = 99072, OFF_X = 116480, LS = 68;
    LAS unsigned char* L = F.lds + RING_OFF;
    LAS float* gcs = (LAS float*)(L + OFF_GC); LAS float* betas = (LAS float*)(L + OFF_BETA); LAS float* egs = (LAS float*)(L + OFF_EG); LAS float* Lm = (LAS float*)(L + OFF_L); LAS float* Tm = (LAS float*)(L + OFF_TM); LAS float* Xm = (LAS float*)(L + OFF_X);
    const int fr = F.lane & 15, fq = F.lane >> 4;
    if (F.wave == 0) {
        float g = BG[(size_t)(row0 + F.lane) * 8 + 4 + h]; const float be = BG[(size_t)(row0 + F.lane) * 8 + h];
#pragma unroll
        for (int o = 1; o < 64; o <<= 1) { const float v = __shfl_up(g, o); if (F.lane >= o) g += v; }
        gcs[F.lane] = g; betas[F.lane] = be; egs[F.lane] = __expf(g);
    }
    __syncthreads();
    {
        const int t = F.tid >> 3, part = F.tid & 7;
        const bf16* rp = QC + (size_t)(row0 + t) * QKVN + h * 128 + part * 16;
        const v4u q0 = *(const GAS v4u*)(rp), q1 = *(const GAS v4u*)(rp + 8), k0 = *(const GAS v4u*)(rp + 512), k1 = *(const GAS v4u*)(rp + 520), v0 = *(const GAS v4u*)(rp + 1024), v1 = *(const GAS v4u*)(rp + 1032);
        *(LAS v4u*)(L + OFF_K + t * 272 + part * 32) = k0; *(LAS v4u*)(L + OFF_K + t * 272 + part * 32 + 16) = k1;
        *(LAS v4u*)(L + OFF_Q + t * 272 + part * 32) = q0; *(LAS v4u*)(L + OFF_Q + t * 272 + part * 32 + 16) = q1;
        const float be = betas[t], beg = be * egs[t];
        float kf[16], vf[16];
        { float tmp[8]; unpack8(k0, tmp);
#pragma unroll
          for (int i = 0; i < 8; ++i) kf[i] = tmp[i]; unpack8(k1, tmp);
#pragma unroll
          for (int i = 0; i < 8; ++i) kf[8 + i] = tmp[i]; unpack8(v0, tmp);
#pragma unroll
          for (int i = 0; i < 8; ++i) vf[i] = tmp[i]; unpack8(v1, tmp);
#pragma unroll
          for (int i = 0; i < 8; ++i) vf[8 + i] = tmp[i]; }
#pragma unroll
        for (int i = 0; i < 16; ++i) { const int d = part * 16 + i;
            *(LAS unsigned short*)(L + OFF_VBT + d * 144 + t * 2) = (unsigned short)(pk2(vf[i] * be, 0.f) & 0xffffu);
            *(LAS unsigned short*)(L + OFF_KBGT + d * 144 + t * 2) = (unsigned short)(pk2(kf[i] * beg, 0.f) & 0xffffu); }
    }
    __syncthreads();
#pragma unroll 1
    for (int x = 0; x < 4; ++x) {
        const int tile = F.wave * 4 + x, which = tile >> 4, ti = (tile >> 2) & 3, tj = tile & 3;
        f32x4 acc = (f32x4){0.f, 0.f, 0.f, 0.f};
        if (ti >= tj) {
            const LAS unsigned char* ap = L + (which ? OFF_Q : OFF_K) + (ti * 16 + fr) * 272 + fq * 16; const LAS unsigned char* bp = L + OFF_K + (tj * 16 + fr) * 272 + fq * 16;
#pragma unroll
            for (int kk = 0; kk < 4; ++kk) acc = __builtin_amdgcn_mfma_f32_16x16x32_bf16(lds_frag16(ap + kk * 64), lds_frag16(bp + kk * 64), acc, 0, 0, 0);
        }
        const int j = tj * 16 + fr; const float gj = gcs[j];
#pragma unroll
        for (int r = 0; r < 4; ++r) { const int i = ti * 16 + 4 * fq + r; const float dec = __expf(gcs[i] - gj);
            if (which == 0) Lm[i * LS + j] = (i > j) ? betas[i] * acc[r] * dec : 0.f;
            else QKg[i * 64 + j] = (bf16)(pk2((i >= j) ? acc[r] * dec : 0.f, 0.f) & 0xffffu); }
    }
    __syncthreads();
    for (int e = F.tid; e < 64 * LS; e += NWAVES * 64) Tm[e] = 0.f;
    __syncthreads();
    if (F.wave == 0) {
        const LAS float* Lb = Lm + (16 * fq) * LS + 16 * fq;
        float t[16];
#pragma unroll
        for (int i = 0; i < 16; ++i) {
            float a0 = 0.f, a1 = 0.f, a2 = 0.f, a3 = 0.f;
#pragma unroll
            for (int j4 = 0; j4 < (i + 3) / 4; ++j4) { const f32x4 lv = *(const LAS f32x4*)(Lb + i * LS + 4 * j4);
                if (4 * j4 + 0 < i) a0 += lv[0] * t[4 * j4 + 0]; if (4 * j4 + 1 < i) a1 += lv[1] * t[4 * j4 + 1]; if (4 * j4 + 2 < i) a2 += lv[2] * t[4 * j4 + 2]; if (4 * j4 + 3 < i) a3 += lv[3] * t[4 * j4 + 3]; }
            t[i] = ((fr == i) ? 1.f : 0.f) - ((a0 + a1) + (a2 + a3));
        }
#pragma unroll
        for (int i = 0; i < 16; ++i) Tm[(16 * fq + i) * LS + 16 * fq + fr] = t[i];
    } else {
        const int lt = F.tid - 64; const float gl = gcs[63];
        for (int cix = lt; cix < 1024; cix += 448) {
            const int t = cix >> 4, cc = cix & 15; const v4u x = *(const LAS v4u*)(L + OFF_Q + t * 272 + cc * 16); float f[8]; unpack8(x, f); const float e = egs[t];
#pragma unroll
            for (int i = 0; i < 8; ++i) f[i] *= e;
            *(GAS v4u*)(QGg + t * 128 + cc * 8) = pack8(f); }
        for (int cix = lt; cix < 1024; cix += 448) {
            const int dk = cix >> 3, t0 = (cix & 7) * 8; float f[8];
#pragma unroll
            for (int i = 0; i < 8; ++i) f[i] = bf2f(*(const LAS unsigned short*)(L + OFF_K + (t0 + i) * 272 + dk * 2)) * __expf(gl - gcs[t0 + i]);
            *(GAS v4u*)(KDTg + dk * 64 + t0) = pack8(f); }
        if (lt == 0) GLg[ci] = __expf(gl);
    }
    __syncthreads();
    if (F.wave < 2) {
        const int pp = F.wave, rb = 16 * (2 * pp + 1), cb = 16 * (2 * pp); f32x4 acc = (f32x4){0.f, 0.f, 0.f, 0.f};
#pragma unroll
        for (int kk = 0; kk < 4; ++kk) acc = __builtin_amdgcn_mfma_f32_16x16x4f32(Lm[(rb + fr) * LS + cb + 4 * kk + fq], Tm[(cb + 4 * kk + fq) * LS + cb + fr], acc, 0, 0, 0);
#pragma unroll
        for (int r = 0; r < 4; ++r) Xm[pp * 576 + (4 * fq + r) * 36 + fr] = acc[r];
    }
    __syncthreads();
    if (F.wave < 2) {
        const int pp = F.wave, rb = 16 * (2 * pp + 1), cb = 16 * (2 * pp); f32x4 acc = (f32x4){0.f, 0.f, 0.f, 0.f};
#pragma unroll
        for (int kk = 0; kk < 4; ++kk) acc = __builtin_amdgcn_mfma_f32_16x16x4f32(Tm[(rb + fr) * LS + rb + 4 * kk + fq], Xm[pp * 576 + (4 * kk + fq) * 36 + fr], acc, 0, 0, 0);
#pragma unroll
        for (int r = 0; r < 4; ++r) Tm[(rb + 4 * fq + r) * LS + cb + fr] = -acc[r];
    }
    __syncthreads();
    if (F.wave < 4) {
        const int bi = F.wave >> 1, bj = F.wave & 1; f32x4 acc = (f32x4){0.f, 0.f, 0.f, 0.f};
#pragma unroll
        for (int kk = 0; kk < 8; ++kk) acc = __builtin_amdgcn_mfma_f32_16x16x4f32(Lm[(32 + 16 * bi + fr) * LS + 4 * kk + fq], Tm[(4 * kk + fq) * LS + 16 * bj + fr], acc, 0, 0, 0);
#pragma unroll
        for (int r = 0; r < 4; ++r) Xm[(16 * bi + 4 * fq + r) * 36 + 16 * bj + fr] = acc[r];
    }
    __syncthreads();
    if (F.wave < 4) {
        const int bi = F.wave >> 1, bj = F.wave & 1; f32x4 acc = (f32x4){0.f, 0.f, 0.f, 0.f};
#pragma unroll
        for (int kk = 0; kk < 8; ++kk) acc = __builtin_amdgcn_mfma_f32_16x16x4f32(Tm[(32 + 16 * bi + fr) * LS + 32 + 4 * kk + fq], Xm[(4 * kk + fq) * 36 + 16 * bj + fr], acc, 0, 0, 0);
#pragma unroll
        for (int r = 0; r < 4; ++r) Tm[(32 + 16 * bi + 4 * fq + r) * LS + 16 * bj + fr] = -acc[r];
    }
    __syncthreads();
    {
        const int i = F.tid >> 3, j0 = (F.tid & 7) * 8; const f32x4 a = *(const LAS f32x4*)(Tm + i * LS + j0), bq = *(const LAS f32x4*)(Tm + i * LS + j0 + 4);
        v4u w; w.x = pk2(a[0], a[1]); w.y = pk2(a[2], a[3]); w.z = pk2(bq[0], bq[1]); w.w = pk2(bq[2], bq[3]);
        *(LAS v4u*)(L + OFF_T + i * 144 + j0 * 2) = w;
    }
    __syncthreads();
#pragma unroll 1
    for (int x = 0; x < 8; ++x) {
        const int tile = F.wave * 8 + x, which = tile >> 5, ti = (tile >> 3) & 3, td = tile & 7;
        const LAS unsigned char* ap = L + OFF_T + (ti * 16 + fr) * 144 + fq * 16; const LAS unsigned char* bp = L + (which ? OFF_KBGT : OFF_VBT) + (td * 16 + fr) * 144 + fq * 16;
        f32x4 acc = (f32x4){0.f, 0.f, 0.f, 0.f};
#pragma unroll
        for (int kk = 0; kk < 2; ++kk) acc = __builtin_amdgcn_mfma_f32_16x16x32_bf16(lds_frag16(ap + kk * 64), lds_frag16(bp + kk * 64), acc, 0, 0, 0);
        const int d = td * 16 + fr;
#pragma unroll
        for (int r = 0; r < 4; ++r) { const int i = ti * 16 + 4 * fq + r;
            if (which == 0) Ug[i * 128 + d] = acc[r]; else Wg[i * 128 + d] = (bf16)(pk2(acc[r], 0.f) & 0xffffu); }
    }
    __syncthreads();
}

constexpr int SC_OW = 0, SC_OQG = 16384, SC_OKDT = 32768, SC_OQK = 49152, SC_OU = 57344, SC_BUF = 61440;
__device__ __forceinline__ void scan_issue(const Args& A, Frame& F, int ci, int sl, LAS unsigned char* dst) {
    const unsigned char* Wg = A.ws + WS_W + (size_t)ci * 16384; const unsigned char* QGg = A.ws + WS_QG + (size_t)ci * 16384;
    const unsigned char* KDTg = A.ws + WS_KDT + (size_t)ci * 16384; const unsigned char* QKg = A.ws + WS_QK + (size_t)ci * 8192; const unsigned char* Ug = A.ws + WS_U + (size_t)ci * 32768 + sl * 64;
#pragma unroll
    for (int j = 0; j < 9; ++j) {
        const int pi = (F.wave - 1) + 7 * j;
        if (pi < 60) {
            const unsigned char* src;
            if (pi < 32) { const int i = (pi & 15) * 64 + F.lane, r = i >> 4, c = (i & 15) ^ (r & 15); src = (pi < 16 ? Wg : QGg) + r * 256 + c * 16; }
            else if (pi < 56) { const int i = (pi < 48 ? pi - 32 : pi - 48) * 64 + F.lane, r = i >> 3, c = (i & 7) ^ ((r >> 1) & 7); src = (pi < 48 ? KDTg : QKg) + r * 128 + c * 16; }
            else { const int i = (pi - 56) * 64 + F.lane, r = i >> 2, c = i & 3; src = Ug + r * 512 + c * 16; }
            __builtin_amdgcn_global_load_lds((const unsigned*)src, (LAS unsigned*)(dst + pi * 1024), 16, 0, 0);
        }
    }
}
__device__ __forceinline__ bf16x8 frag2(const LAS unsigned char* p0, const LAS unsigned char* p1) { const v2u lo = *(const LAS v2u*)p0, hi = *(const LAS v2u*)p1; v4u w; w.x = lo.x; w.y = lo.y; w.z = hi.x; w.w = hi.y; return __builtin_bit_cast(bf16x8, w); }
__device__ __forceinline__ bf16x8 frag256(const LAS unsigned char* tile, int row, int kstep, int fq) { const int c = 4 * kstep + (fq >> 1), sw = row & 15; const LAS unsigned char* rp = tile + row * 256 + 8 * (fq & 1); return frag2(rp + ((c ^ sw) << 4), rp + (((c + 2) ^ sw) << 4)); }
__device__ __forceinline__ bf16x8 frag128(const LAS unsigned char* tile, int row, int kstep, int fq) { const int c = 4 * kstep + (fq >> 1), sw = (row >> 1) & 7; const LAS unsigned char* rp = tile + row * 128 + 8 * (fq & 1); return frag2(rp + ((c ^ sw) << 4), rp + (((c + 2) ^ sw) << 4)); }
__device__ __forceinline__ bf16x8 pack_pair(const pg8::f32x4& a, const pg8::f32x4& b) { v4u w; w.x = pk2(a[0], a[1]); w.y = pk2(a[2], a[3]); w.z = pk2(b[0], b[1]); w.w = pk2(b[2], b[3]); return __builtin_bit_cast(bf16x8, w); }
__device__ __forceinline__ void scan_unit(const Args& A, Frame& F, int b, int h, int sl) {
    using pg8::f32x4;
    LAS unsigned char* L = F.lds + RING_OFF;
    const int ci0 = (b * NH + h) * 32; const int fr = F.lane & 15, fq = F.lane >> 4;
    float* Og = (float*)(A.ws + WS_RE); const float* GLg = (const float*)(A.ws + WS_GL);
    if (F.wave > 0) { scan_issue(A, F, ci0, sl, L); scan_issue(A, F, ci0 + 1, sl, L + SC_BUF); asm volatile("s_waitcnt vmcnt(9)" ::: "memory"); }
    __builtin_amdgcn_s_barrier(); asm volatile("" ::: "memory");
    f32x4 S[8];
#pragma unroll
    for (int i = 0; i < 8; ++i) S[i] = (f32x4){0.f, 0.f, 0.f, 0.f};
    float gl = GLg[ci0];
#pragma unroll 1
    for (int n = 0; n < 32; ++n) {
        if (F.wave == 0) {
            const LAS unsigned char* B = L + (n & 1) * SC_BUF;
            const float gln = GLg[ci0 + (n < 31 ? n + 1 : n)];
            bf16x8 Sb[4];
#pragma unroll
            for (int kk = 0; kk < 4; ++kk) Sb[kk] = pack_pair(S[2 * kk], S[2 * kk + 1]);
            f32x4 vn[4];
#pragma unroll
            for (int tb = 0; tb < 4; ++tb) { f32x4 p1 = (f32x4){0.f, 0.f, 0.f, 0.f};
#pragma unroll
                for (int kk = 0; kk < 4; ++kk) p1 = __builtin_amdgcn_mfma_f32_16x16x32_bf16(frag256(B + SC_OW, 16 * tb + fr, kk, fq), Sb[kk], p1, 0, 0, 0);
#pragma unroll
                for (int r = 0; r < 4; ++r) vn[tb][r] = *(const LAS float*)(B + SC_OU + (16 * tb + 4 * fq + r) * 64 + fr * 4) - p1[r]; }
            bf16x8 Vb[2]; Vb[0] = pack_pair(vn[0], vn[1]); Vb[1] = pack_pair(vn[2], vn[3]);
            const size_t orow = (size_t)(b * SEQ + n * 64);
#pragma unroll
            for (int blk = 0; blk < 8; ++blk) { f32x4 s = S[blk] * gl;
#pragma unroll
                for (int kt = 0; kt < 2; ++kt) s = __builtin_amdgcn_mfma_f32_16x16x32_bf16(frag128(B + SC_OKDT, 16 * blk + fr, kt, fq), Vb[kt], s, 0, 0, 0);
                S[blk] = s; }
#pragma unroll
            for (int tb = 0; tb < 4; ++tb) { f32x4 o = (f32x4){0.f, 0.f, 0.f, 0.f};
#pragma unroll
                for (int kk = 0; kk < 4; ++kk) o = __builtin_amdgcn_mfma_f32_16x16x32_bf16(frag256(B + SC_OQG, 16 * tb + fr, kk, fq), Sb[kk], o, 0, 0, 0);
#pragma unroll
                for (int kt = 0; kt < 2; ++kt) o = __builtin_amdgcn_mfma_f32_16x16x32_bf16(frag128(B + SC_OQK, 16 * tb + fr, kt, fq), Vb[kt], o, 0, 0, 0);
#pragma unroll
                for (int r = 0; r < 4; ++r) Og[(orow + 16 * tb + 4 * fq + r) * 512 + h * 128 + sl * 16 + fr] = o[r]; }
            gl = gln;
            asm volatile("s_waitcnt lgkmcnt(0)" ::: "memory");
        } else {
            asm volatile("s_waitcnt vmcnt(0)" ::: "memory");
        }
        __builtin_amdgcn_s_barrier(); asm volatile("" ::: "memory");
        if (F.wave > 0 && n + 2 < 32) scan_issue(A, F, ci0 + n + 2, sl, L + (n & 1) * SC_BUF);
    }
    if (F.wave == 0) {
        float* od = A.out + OUT_DLP + (size_t)(b * NH + h) * DKV * DKV;
#pragma unroll
        for (int blk = 0; blk < 8; ++blk)
#pragma unroll
            for (int r = 0; r < 4; ++r) od[(16 * blk + 4 * fq + r) * DKV + sl * 16 + fr] = S[blk][r];
    }
    asm volatile("s_waitcnt vmcnt(0) lgkmcnt(0)" ::: "memory"); __builtin_amdgcn_s_barrier(); asm volatile("" ::: "memory");
}
__device__ __forceinline__ void delta_sample(const Args& A, Frame& F, int s, int h) {
    const bf16* QC = (const bf16*)(A.ws + WS_RC); const float* BG = (const float*)(A.ws + WS_BG); float* Og = (float*)(A.ws + WS_RE);
    const size_t row = (size_t)MP + s;
    LAS float* qs = (LAS float*)(F.lds + RING_OFF); LAS float* ks = qs + 128; LAS float* red = qs + 256;
    const int dv = F.tid & 127, grp = F.tid >> 7;
    if (F.tid < 128) { qs[F.tid] = bf2f(QC[row * QKVN + h * 128 + F.tid]); ks[F.tid] = bf2f(QC[row * QKVN + 512 + h * 128 + F.tid]); }
    const float v = bf2f(QC[row * QKVN + 1024 + h * 128 + dv]);
    const float beta = BG[row * 8 + h], eg = __expf(BG[row * 8 + 4 + h]);
    const float* S0 = A.in[I_SDELTA] + (size_t)(s * NH + h) * DKV * DKV; float* So = A.out + OUT_DLS + (size_t)(s * NH + h) * DKV * DKV;
    float s0[32];
#pragma unroll
    for (int i = 0; i < 32; ++i) s0[i] = S0[(size_t)(grp * 32 + i) * DKV + dv];
    __syncthreads();
    float part = 0.f;
#pragma unroll
    for (int i = 0; i < 32; ++i) part += ks[grp * 32 + i] * s0[i];
    red[grp * 128 + dv] = part;
    __syncthreads();
    const float kS = (red[dv] + red[128 + dv]) + (red[256 + dv] + red[384 + dv]);
    const float vnew = beta * (v - eg * kS);
    __syncthreads();
    float po = 0.f;
#pragma unroll
    for (int i = 0; i < 32; ++i) { const float sn = eg * s0[i] + ks[grp * 32 + i] * vnew; So[(size_t)(grp * 32 + i) * DKV + dv] = sn; po += qs[grp * 32 + i] * sn; }
    red[grp * 128 + dv] = po;
    __syncthreads();
    if (F.tid < 128) Og[row * 512 + h * 128 + dv] = (red[dv] + red[128 + dv]) + (red[256 + dv] + red[384 + dv]);
    __syncthreads();
}

__device__ __forceinline__ void ogate_row(const Args& A, Frame& F, int m, const pg8::f32x4& n0, const pg8::f32x4& n1) {
    const bf16* PB = (const bf16*)(A.ws + WS_RA); bf16* CD = (bf16*)(A.ws + WS_RB); const float* Og = (const float*)(A.ws + WS_RE); const int ch0 = 8 * F.lane;
    const f32x4 o0 = *(const GAS f32x4*)(Og + (size_t)m * 512 + ch0), o1 = *(const GAS f32x4*)(Og + (size_t)m * 512 + ch0 + 4);
    const v4u zz = *(const GAS v4u*)(PB + (size_t)m * PBLD + 2048 + ch0); float z[8]; unpack8(zz, z);
    float ss = (o0[0] * o0[0] + o0[1] * o0[1]) + (o0[2] * o0[2] + o0[3] * o0[3]) + (o1[0] * o1[0] + o1[1] * o1[1]) + (o1[2] * o1[2] + o1[3] * o1[3]);
    ss += __shfl_xor(ss, 1); ss += __shfl_xor(ss, 2); ss += __shfl_xor(ss, 4); ss += __shfl_xor(ss, 8);
    const float rstd = 1.f / sqrtf(ss * (1.f / 128.f) + RMS_EPS);
    float d[8];
#pragma unroll
    for (int i = 0; i < 4; ++i) { d[i] = o0[i] * rstd * n0[i] * silu(z[i]); d[4 + i] = o1[i] * rstd * n1[i] * silu(z[4 + i]); }
    *(GAS v4u*)(CD + (size_t)m * DM + 512 + ch0) = pack8(d);
}
__device__ __forceinline__ void ogate_phase(const Args& A, Frame& F) {
    const int gw = F.vcu * NWAVES + F.wave, NGW = F.G * NWAVES; const int ch0 = 8 * F.lane;
    const f32x4 n0 = *(const f32x4*)(A.in[I_DNN] + (ch0 & 127)), n1 = *(const f32x4*)(A.in[I_DNN] + (ch0 & 127) + 4);
    for (int m = gw; m < MP; m += NGW) ogate_row(A, F, m, n0, n1);
}
__device__ __forceinline__ void sample_mixer(const Args& A, Frame& F, int s) {
    conv_sample(A, F, s);
    VM_WAIT(); __syncthreads();
    _Pragma("unroll 1") for (int h = 0; h < NH; ++h) delta_sample(A, F, s, h);
    VM_WAIT(); __syncthreads();
    if (F.wave == 0) { const int ch0 = 8 * F.lane; const f32x4 n0 = *(const f32x4*)(A.in[I_DNN] + (ch0 & 127)), n1 = *(const f32x4*)(A.in[I_DNN] + (ch0 & 127) + 4); ogate_row(A, F, MP + s, n0, n1); }
}

__device__ __forceinline__ void attn_issue(const Args& A, Frame& F, int st, int b, int h, LAS unsigned char* slot) {
    const bf16* KB = (const bf16*)(A.ws + WS_KB); const bf16* VT = (const bf16*)(A.ws + WS_VT);
#pragma unroll
    for (int it = 0; it < 4; ++it) {
        const int idx = it * 512 + F.tid; const bf16* src;
        if (st < 4) { const int r = idx >> 5, p = idx & 31, c = p ^ (r & 15); src = KB + (size_t)(b * NMEM + 64 * st + r) * DM + h * MHD + 8 * c; }
        else { const int r = idx >> 3, p = idx & 7, c = p ^ ((r >> 1) & 7); src = VT + (size_t)(h * MHD + r) * (NB * NMEM) + b * NMEM + 64 * (st - 4) + 8 * c; }
        __builtin_amdgcn_global_load_lds((const unsigned*)src, (LAS unsigned*)(slot + it * 8192 + F.wave * 1024), 16, 0, 0);
    }
}
__device__ __forceinline__ void attn_unit(const Args& A, Frame& F, int rt, int h) {
    using pg8::f32x4;
    const int b = rt >> 4; const int fr = F.lane & 15, fq = F.lane >> 4;
    const bf16* Q = (const bf16*)(A.ws + WS_RB); bf16* AO = (bf16*)(A.ws + WS_RE);
    const size_t qoff = (size_t)(rt * 128 + F.wave * 16 + fr) * DM + h * MHD;
    const bf16* qrow = Q + qoff; bf16* orow = AO + qoff;
    LAS unsigned char* L = F.lds + RING_OFF;
    bf16x8 qf[8];
#pragma unroll
    for (int ks = 0; ks < 8; ++ks) qf[ks] = *(const GAS bf16x8*)(qrow + 32 * ks + 8 * fq);
    attn_issue(A, F, 0, b, h, L); attn_issue(A, F, 1, b, h, L + 32768);
    f32x4 sacc[16];
#pragma unroll
    for (int st = 0; st < 4; ++st) {
        asm volatile("s_waitcnt vmcnt(4)" ::: "memory");
        __builtin_amdgcn_s_barrier(); asm volatile("" ::: "memory");
        attn_issue(A, F, st + 2, b, h, L + ((st + 2) & 3) * 32768);
        const LAS unsigned char* slot = L + (st & 3) * 32768;
#pragma unroll
        for (int kbl = 0; kbl < 4; ++kbl) { f32x4 acc = (f32x4){0.f, 0.f, 0.f, 0.f}; const int row = 16 * kbl + fr;
#pragma unroll
            for (int ks = 0; ks < 8; ++ks) { const bf16x8 a = *(const LAS bf16x8*)(slot + row * 512 + (((4 * ks + fq) ^ (row & 15)) << 4)); acc = __builtin_amdgcn_mfma_f32_16x16x32_bf16(a, qf[ks], acc, 0, 0, 0); }
            sacc[4 * st + kbl] = acc; }
    }
    float mx = -3.0e38f;
#pragma unroll
    for (int kb = 0; kb < 16; ++kb)
#pragma unroll
        for (int i = 0; i < 4; ++i) mx = fmaxf(mx, sacc[kb][i]);
    mx = fmaxf(mx, __shfl_xor(mx, 16)); mx = fmaxf(mx, __shfl_xor(mx, 32));
    float lsum = 0.f; bf16x8 pb[8];
#pragma unroll
    for (int kb = 0; kb < 16; ++kb)
#pragma unroll
        for (int i = 0; i < 4; ++i) { const float p = __builtin_amdgcn_exp2f(sacc[kb][i] - mx); sacc[kb][i] = p; lsum += p; }
#pragma unroll
    for (int s = 0; s < 8; ++s) pb[s] = pack_pair(sacc[2 * s], sacc[2 * s + 1]);
    lsum += __shfl_xor(lsum, 16); lsum += __shfl_xor(lsum, 32);
    f32x4 oacc[16];
#pragma unroll
    for (int db = 0; db < 16; ++db) oacc[db] = (f32x4){0.f, 0.f, 0.f, 0.f};
#pragma unroll
    for (int st = 4; st < 8; ++st) {
        if (st + 1 < 8) asm volatile("s_waitcnt vmcnt(4)" ::: "memory"); else asm volatile("s_waitcnt vmcnt(0)" ::: "memory");
        __builtin_amdgcn_s_barrier(); asm volatile("" ::: "memory");
        if (st + 2 < 8) attn_issue(A, F, st + 2, b, h, L + ((st + 2) & 3) * 32768);
        const LAS unsigned char* slot = L + (st & 3) * 32768; const int t = st - 4;
#pragma unroll
        for (int db = 0; db < 16; ++db) { const int row = 16 * db + fr; const int sw = (row >> 1) & 7;
#pragma unroll
            for (int s2 = 0; s2 < 2; ++s2) { const int c = 4 * s2 + (fq >> 1);
                const v2u lo = *(const LAS v2u*)(slot + row * 128 + ((c ^ sw) << 4) + 8 * (fq & 1)), hi = *(const LAS v2u*)(slot + row * 128 + (((c + 2) ^ sw) << 4) + 8 * (fq & 1));
                v4u aw; aw.x = lo.x; aw.y = lo.y; aw.z = hi.x; aw.w = hi.y;
                oacc[db] = __builtin_amdgcn_mfma_f32_16x16x32_bf16(__builtin_bit_cast(bf16x8, aw), pb[2 * t + s2], oacc[db], 0, 0, 0); } }
    }
    const float inv = 1.f / lsum;
#pragma unroll
    for (int db = 0; db < 16; ++db) { v2u w; w.x = pk2(oacc[db][0] * inv, oacc[db][1] * inv); w.y = pk2(oacc[db][2] * inv, oacc[db][3] * inv); *(GAS v2u*)(orow + 16 * db + 4 * fq) = w; }
    LDS_WAIT(); __builtin_amdgcn_s_barrier(); asm volatile("" ::: "memory");
}
__device__ __forceinline__ void attn_sample(const Args& A, Frame& F, int s, int h) {
    const bf16* qrow = (const bf16*)(A.ws + WS_RB) + (size_t)(MP + s) * DM + h * MHD; bf16* orow = (bf16*)(A.ws + WS_RE) + (size_t)(MP + s) * DM + h * MHD;
    const float* Kc = A.in[I_CMK] + (size_t)s * NMEM * DM + h * MHD; const float* Vc = A.in[I_CMV] + (size_t)s * NMEM * DM + h * MHD;
    LAS float* pl = (LAS float*)(F.lds + RING_OFF); LAS float* wred = pl + 256; LAS float* ored = pl + 512;
    float q[4]; { const v2u x = *(const GAS v2u*)(qrow + 4 * F.lane); q[0] = bflo(x.x); q[1] = bfhi(x.x); q[2] = bflo(x.y); q[3] = bfhi(x.y); }
    float myscore = 0.f;
#pragma unroll 8
    for (int i = 0; i < 32; ++i) { const f32x4 kv = *(const GAS f32x4*)(Kc + (size_t)(32 * F.wave + i) * DM + 4 * F.lane);
        const float d = wave_sum((kv[0] * q[0] + kv[1] * q[1]) + (kv[2] * q[2] + kv[3] * q[3])); if (F.lane == i) myscore = d; }
    float m = wave_max(F.lane < 32 ? myscore : -3.0e38f);
    if (F.lane == 0) wred[F.wave] = m;
    __syncthreads();
    float gm = wred[0];
#pragma unroll
    for (int i = 1; i < 8; ++i) gm = fmaxf(gm, wred[i]);
    const float p = (F.lane < 32) ? __builtin_amdgcn_exp2f(myscore - gm) : 0.f;
    if (F.lane < 32) pl[32 * F.wave + F.lane] = p;
    const float ws_ = wave_sum(p);
    if (F.lane == 0) wred[8 + F.wave] = ws_;
    __syncthreads();
    float tot = 0.f;
#pragma unroll
    for (int i = 0; i < 8; ++i) tot += wred[8 + i];
    f32x4 acc = (f32x4){0.f, 0.f, 0.f, 0.f};
#pragma unroll 8
    for (int i = 0; i < 32; ++i) { const f32x4 vv = *(const GAS f32x4*)(Vc + (size_t)(32 * F.wave + i) * DM + 4 * F.lane); const float pi = pl[32 * F.wave + i]; acc = acc + vv * pi; }
    *(LAS f32x4*)(ored + F.wave * 256 + 4 * F.lane) = acc;
    __syncthreads();
    if (F.tid < 256) { float o = 0.f;
#pragma unroll
        for (int w = 0; w < 8; ++w) o += ored[w * 256 + F.tid];
        orow[F.tid] = (bf16)(pk2(o / tot, 0.f) & 0xffffu); }
    __syncthreads();
}


typedef unsigned v2u_ __attribute__((ext_vector_type(2)));
template <int NKS, class Epi>
__device__ __forceinline__ void small_gemm_item(const Frame& F, const bf16* Arow0, const bf16* Bt, int pn, int j, int rq, const Epi& E) {
    using pg8::f32x4;
    constexpr int K = NKS * 256;
    const int fr = F.lane & 15, fq = F.lane >> 4;
    const bf16* ap = Arow0 + (size_t)(32 * rq + fr) * K + F.wave * (K / 8) + 8 * fq;
    const bf16* b0 = Bt + (size_t)(256 * pn + 16 * j + fr) * K + F.wave * (K / 8) + 8 * fq; const bf16* b1 = b0 + (size_t)128 * K;
    bf16x8 a0[NKS], a1[NKS], x0[NKS], x1[NKS];
#pragma unroll
    for (int u = 0; u < NKS; ++u) { a0[u] = *(const GAS bf16x8*)(ap + 32 * u); a1[u] = *(const GAS bf16x8*)(ap + (size_t)16 * K + 32 * u); x0[u] = *(const GAS bf16x8*)(b0 + 32 * u); x1[u] = *(const GAS bf16x8*)(b1 + 32 * u); }
    __builtin_amdgcn_sched_barrier(0);
    f32x4 c00 = (f32x4){0.f, 0.f, 0.f, 0.f}, c01 = c00, c10 = c00, c11 = c00;
#pragma unroll
    for (int u = 0; u < NKS; ++u) {
        c00 = __builtin_amdgcn_mfma_f32_16x16x32_bf16(x0[u], a0[u], c00, 0, 0, 0); c01 = __builtin_amdgcn_mfma_f32_16x16x32_bf16(x1[u], a0[u], c01, 0, 0, 0);
        c10 = __builtin_amdgcn_mfma_f32_16x16x32_bf16(x0[u], a1[u], c10, 0, 0, 0); c11 = __builtin_amdgcn_mfma_f32_16x16x32_bf16(x1[u], a1[u], c11, 0, 0, 0);
    }
    LAS f32x4* red = (LAS f32x4*)(F.lds + RING_OFF);
    red[(F.wave * 4 + 0) * 64 + F.lane] = c00; red[(F.wave * 4 + 1) * 64 + F.lane] = c01; red[(F.wave * 4 + 2) * 64 + F.lane] = c10; red[(F.wave * 4 + 3) * 64 + F.lane] = c11;
    __syncthreads();
    if (F.wave < 2) {
        f32x4 sA = (f32x4){0.f, 0.f, 0.f, 0.f}, sB = sA;
#pragma unroll
        for (int w = 0; w < 8; ++w) { sA = sA + red[(w * 4 + 2 * F.wave) * 64 + F.lane]; sB = sB + red[(w * 4 + 2 * F.wave + 1) * 64 + F.lane]; }
        E(32 * rq + 16 * F.wave + fr, pn, j, fq, sA, sB);
    }
    __syncthreads();
}
__device__ __forceinline__ v2u_ pk4(const pg8::f32x4& a) { v2u_ w; w.x = pk2(a[0], a[1]); w.y = pk2(a[2], a[3]); return w; }
struct SEpiIn { bf16* PBs;
    __device__ __forceinline__ void operator()(int m, int pn, int j, int fq, const pg8::f32x4& a, const pg8::f32x4& b) const {
        if (pn < 4) { pg8::f32x4 v;
#pragma unroll
            for (int i = 0; i < 4; ++i) v[i] = a[i] * sigm(b[i]);
            *(GAS v2u_*)(PBs + (size_t)m * PBLD + 128 * pn + 16 * j + 4 * fq) = pk4(v); }
        else { bf16* rp = PBs + (size_t)m * PBLD + 256 * pn - 512 + 16 * j + 4 * fq; *(GAS v2u_*)rp = pk4(a); *(GAS v2u_*)(rp + 128) = pk4(b); }
    } };
template <bool WRITE_BF> struct SEpiRes { const float* base; float* out; bf16* outb; float* ss;
    __device__ __forceinline__ void operator()(int m, int pn, int j, int fq, const pg8::f32x4& a, const pg8::f32x4& b) const {
        const size_t off = (size_t)m * DM + 256 * pn + 16 * j + 4 * fq;
        const pg8::f32x4 v0 = a + *(const GAS pg8::f32x4*)(base + off), v1 = b + *(const GAS pg8::f32x4*)(base + off + 128);
        *(GAS pg8::f32x4*)(out + off) = v0; *(GAS pg8::f32x4*)(out + off + 128) = v1;
        if (WRITE_BF) { *(GAS v2u_*)(outb + off) = pk4(v0); *(GAS v2u_*)(outb + off + 128) = pk4(v1); }
        float s = (v0[0] * v0[0] + v0[1] * v0[1]) + (v0[2] * v0[2] + v0[3] * v0[3]) + (v1[0] * v1[0] + v1[1] * v1[1]) + (v1[2] * v1[2] + v1[3] * v1[3]);
        s += __shfl_xor(s, 16); s += __shfl_xor(s, 32);
        if (fq == 0) atomicAdd(ss + m, s);
    } };
struct SEpiQ { bf16* Qs; const float* ss; float c2;
    __device__ __forceinline__ void operator()(int m, int pn, int j, int fq, const pg8::f32x4& a, const pg8::f32x4& b) const {
        const float rs = __builtin_amdgcn_rsqf(ss[m] * (1.f / 1024.f) + RMS_EPS) * c2; bf16* rp = Qs + (size_t)m * DM + 256 * pn + 16 * j + 4 * fq;
        *(GAS v2u_*)rp = pk4(a * rs); *(GAS v2u_*)(rp + 128) = pk4(b * rs);
    } };
struct SEpiGU { bf16* Ts; const float* ss;
    __device__ __forceinline__ void operator()(int m, int pn, int j, int fq, const pg8::f32x4& a, const pg8::f32x4& b) const {
        const float rs = __builtin_amdgcn_rsqf(ss[m] * (1.f / 1024.f) + RMS_EPS); pg8::f32x4 v;
#pragma unroll
        for (int i = 0; i < 4; ++i) v[i] = silu(a[i] * rs) * (b[i] * rs);
        *(GAS v2u_*)(Ts + (size_t)m * DFF + 128 * pn + 16 * j + 4 * fq) = pk4(v);
    } };

__device__ __forceinline__ void final_norm_phase(const Args& A, Frame& F) {
    const int gw = F.vcu * NWAVES + F.wave, NGW = F.G * NWAVES; const float* ss = (const float*)(F.ctl + CW_SS3);
    f32x4 gn[4];
#pragma unroll
    for (int j = 0; j < 4; ++j) gn[j] = *(const f32x4*)(A.in[I_NF] + 256 * j + 4 * F.lane);
    for (int m = MP + gw; m < MV; m += NGW) {
        GAS f32x4* xr = (GAS f32x4*)(A.out + (size_t)m * DM) + F.lane;
        const float rstd = 1.f / sqrtf(ss[m] * (1.f / DM) + RMS_EPS);
#pragma unroll
        for (int j = 0; j < 4; ++j) { const f32x4 v = xr[64 * j]; xr[64 * j] = v * rstd * gn[j]; }
    }
}

__global__ void __launch_bounds__(NWAVES * 64, 2) hymba_fwd(Args args) {
    extern __shared__ __attribute__((aligned(16))) unsigned char lds[];
    Frame F;
    F.lds = (LAS unsigned char*)lds;
    F.MISC = (volatile LAS unsigned*)(F.lds + MISC_OFF);
    F.tid = threadIdx.x; F.lane = F.tid & 63; F.wave = __builtin_amdgcn_readfirstlane(F.tid >> 6);
    F.G = gridDim.x; { const int bx = blockIdx.x; F.vcu = (F.G % 8 == 0) ? (bx % 8) * (F.G / 8) + bx / 8 : bx; }
    F.ctl = (gu32*)(args.ws + WS_CTL);
    const Args& A = args;
    for (int u = F.tid; u < (LDS_BYTES - LDSCTL_OFF) / 4; u += NWAVES * 64) ((LAS unsigned*)(F.lds + LDSCTL_OFF))[u] = 0u;
    __syncthreads();
#if MK_PER_PHASE
#define GRID_BAR() do { } while (0)
#else
    XcdBarrier bar = xcd_barrier_post((unsigned*)(F.ctl + CW_BAR) + args.li * XCD_BAR_WORDS, F.MISC + 8);
#define GRID_BAR() xcd_barrier(bar)
#endif
#if 1
    const int lo = args.ph_lo, hi = args.ph_hi;
    const bool rep = (args.li != 0);
#define REPK(k) (rep && lo == (k))
#ifdef ONLY_PH
#define IN(k) ((k) == ONLY_PH && lo <= (k) && (k) < hi)
#else
#define IN(k) (lo <= (k) && (k) < hi)
#endif
#else
#define REPK(k) false
#define IN(k) true
#endif
#define BOTH(k) (IN(k) && IN((k) + 1))
#define PH_PTRS unsigned char* const ws = args.ws; bf16* const RA = (bf16*)(ws + WS_RA); bf16* const RB = (bf16*)(ws + WS_RB); bf16* const RC = (bf16*)(ws + WS_RC); \
    float* const X1 = (float*)(ws + WS_RD); bf16* const X1B = (bf16*)(ws + WS_RE); float* const X2 = (float*)(ws + WS_RF); \
    float* const SS1 = (float*)(ws + WS_CTL) + CW_SS1; float* const SS2 = (float*)(ws + WS_CTL) + CW_SS2; float* const SS3 = (float*)(ws + WS_CTL) + CW_SS3; float* const SSD = (float*)(ws + WS_CTL) + 163840; \
    (void)RA; (void)RB; (void)RC; (void)X1; (void)X1B; (void)X2; (void)SS1; (void)SS2; (void)SS3; (void)SSD;

    if (IN(0)) { p0_prologue(A, F); if (BOTH(0)) GRID_BAR(); }
    if (IN(1)) { PH_PTRS
        { pg8::Gemm g{RB, (const bf16*)(ws + WS_WIN), MP, 3072, DM}; pg8::StaticOrder S; S.init(MP, 3072, F.G, (int)blockIdx.x);
          pg8::EpiIn E{RA};
          pg8::gemm_phase<pg8::EpiIn, pg8::StaticOrder, true, true>(F.lds + RING_OFF, g, S, E); }
        { pg8::Gemm g{(const bf16*)(ws + WS_MEMN), (const bf16*)(ws + WS_WMKV), NB * NMEM, 2048, DM}; pg8::StaticOrder S; S.init(NB * NMEM, 2048, F.G, (int)blockIdx.x);
          pg8::EpiKV E{A.out + OUT_MKP, A.out + OUT_MVP, (bf16*)(ws + WS_KB), (bf16*)(ws + WS_VT)};
          pg8::gemm_phase<pg8::EpiKV, pg8::StaticOrder, true, true>(F.lds + RING_OFF, g, S, E); }
        { const SEpiIn E{RA + (size_t)MP * PBLD};
          for (int i = F.G - 1 - (int)blockIdx.x; i < 96 * 4; i += F.G) small_gemm_item<4>(F, RB + (size_t)MP * DM, (const bf16*)(ws + WS_WIN), i >> 5, (i >> 2) & 7, i & 3, E); }
        if (BOTH(1)) GRID_BAR();
    }
    if (IN(2)) {
        for (int it = F.vcu; it < 256; it += F.G) { const int b = it >> 5, tile = it & 31; conv_tile(A, F, b, tile); VM_WAIT(); __syncthreads();
            _Pragma("unroll 1") for (int h = 0; h < NH; ++h) d1_chunk(A, F, (b * NH + h) * 32 + tile); }
        for (int s = F.G - 1 - F.vcu; s < DEC; s += F.G) sample_mixer(A, F, s);
        if (BOTH(2)) GRID_BAR();
    }
    if (IN(3)) { PH_PTRS
        for (int u = F.vcu; u < 256; u += F.G) scan_unit(A, F, u >> 5, (u >> 3) & 3, u & 7);
        { const SEpiRes<true> SE{A.in[I_XS], (float*)(ws + WS_X1S), X1B + (size_t)MP * DM, (REPK(3) ? SSD : SS1) + MP};
          for (int i = F.G - 1 - (int)blockIdx.x; i < 32 * 4; i += F.G) small_gemm_item<4>(F, RB + (size_t)MP * DM, (const bf16*)(ws + WS_WOUT), i >> 5, (i >> 2) & 7, i & 3, SE); }
        if (BOTH(3)) GRID_BAR();
    }
    if (IN(4)) { PH_PTRS
        ogate_phase(A, F);
        { const SEpiQ SE{RB + (size_t)MP * DM, SS1 + MP, ATT_C2};
          for (int i = F.G - 1 - (int)blockIdx.x; i < 32 * 4; i += F.G) small_gemm_item<4>(F, X1B + (size_t)MP * DM, (const bf16*)(ws + WS_WMQ), i >> 5, (i >> 2) & 7, i & 3, SE); }
        if (BOTH(4)) GRID_BAR();
    }
    if (IN(5)) { PH_PTRS
        pg8::Gemm g{RB, (const bf16*)(ws + WS_WOUT), MP, DM, DM}; pg8::StaticOrder S; S.init(MP, DM, F.G, (int)blockIdx.x);
        pg8::EpiRes<true> E{A.in[I_XP], A.in[I_XS], MV, MR, X1, X1B, REPK(5) ? SSD : SS1};
        pg8::gemm_phase<pg8::EpiRes<true>, pg8::StaticOrder, true, true>(F.lds + RING_OFF, g, S, E);
        for (int it = F.vcu; it < DEC * NH; it += F.G) attn_sample(A, F, it >> 2, it & 3);
        if (BOTH(5)) GRID_BAR();
    }
    if (IN(6)) { PH_PTRS
        pg8::Gemm g{X1B, (const bf16*)(ws + WS_WMQ), MP, DM, DM}; pg8::StaticOrder S; S.init(MP, DM, F.G, (int)blockIdx.x);
        pg8::EpiQ E{RB, SS1, ATT_C2};
        pg8::gemm_phase<pg8::EpiQ, pg8::StaticOrder, true, true>(F.lds + RING_OFF, g, S, E);
        { pg8::Unit u; _Pragma("unroll 1") for (int i = 0; i < 2 * 64; ++i) { if (!S.next(i >> 1, u)) break; attn_unit(A, F, 2 * u.pm + (i & 1), u.pn); } }
        { const SEpiRes<true> SE{(const float*)(ws + WS_X1S), X2 + (size_t)MP * DM, RC + (size_t)MP * DM, (REPK(6) ? SSD : SS2) + MP};
          for (int i = F.G - 1 - (int)blockIdx.x; i < 32 * 4; i += F.G) small_gemm_item<4>(F, X1B + (size_t)MP * DM, (const bf16*)(ws + WS_WMO), i >> 5, (i >> 2) & 7, i & 3, SE); }
        if (BOTH(6)) GRID_BAR();
    }
    if (IN(7)) { PH_PTRS
        pg8::Gemm g{X1B, (const bf16*)(ws + WS_WMO), MP, DM, DM}; pg8::StaticOrder S; S.init(MP, DM, F.G, (int)blockIdx.x);
        pg8::EpiRes<true> E{X1, X1, MR, MR, X2, RC, REPK(7) ? SSD : SS2};
        pg8::gemm_phase<pg8::EpiRes<true>, pg8::StaticOrder, true, true>(F.lds + RING_OFF, g, S, E);
        { const SEpiGU SE{RA + (size_t)MP * DFF, SS2 + MP};
          for (int i = F.G - 1 - (int)blockIdx.x; i < 176 * 4; i += F.G) small_gemm_item<4>(F, RC + (size_t)MP * DM, (const bf16*)(ws + WS_WGU), i >> 5, (i >> 2) & 7, i & 3, SE); }
        if (BOTH(7)) GRID_BAR();
    }
    if (IN(8)) { PH_PTRS
        pg8::Gemm g{RC, (const bf16*)(ws + WS_WGU), MP, 2 * DFF, DM}; pg8::StaticOrder S; S.init(MP, 2 * DFF, F.G, (int)blockIdx.x);
        pg8::EpiGU E{RA, SS2};
        pg8::gemm_phase<pg8::EpiGU, pg8::StaticOrder, true, true>(F.lds + RING_OFF, g, S, E);
        { const SEpiRes<false> SE{X2 + (size_t)MP * DM, A.out + (size_t)MP * DM, nullptr, (REPK(8) ? SSD : SS3) + MP};
          for (int i = F.G - 1 - (int)blockIdx.x; i < 32 * 4; i += F.G) small_gemm_item<11>(F, RA + (size_t)MP * DFF, (const bf16*)(ws + WS_WDN), i >> 5, (i >> 2) & 7, i & 3, SE); }
        if (BOTH(8)) GRID_BAR();
    }
    if (IN(9)) { PH_PTRS
        final_norm_phase(A, F);
        pg8::Gemm g{RA, (const bf16*)(ws + WS_WDN), MP, DM, DFF}; pg8::StaticOrder S; S.init(MP, DM, F.G, (int)blockIdx.x);
        pg8::EpiResNorm E{X2, A.out, A.in[I_NF], (float*)(ws + WS_XBUF), (unsigned*)(ws + WS_CTL) + CW_PANEL, (unsigned*)(ws + WS_CTL) + CW_TMO};
        pg8::gemm_phase<pg8::EpiResNorm, pg8::StaticOrder, false, true>(F.lds + RING_OFF, g, S, E);
    }
#undef IN
#undef BOTH
}

extern "C" void kernel_launch(void* const* d_in, const int* in_sizes, int n_in, void* d_out, int out_size, void* d_ws, size_t ws_size, hipStream_t stream) {
    static int grid = 0;
    if (grid == 0) {
        if (n_in != 30 || in_sizes[0] != MP * DM || (size_t)out_size != OUT_END || ws_size < WS_END) {
            fprintf(stderr, "kernel_launch: unexpected shapes: n_in %d, in0 %d, out %d, ws %zu (need >= %zu); nothing launched\n", n_in, n_in > 0 ? in_sizes[0] : -1, out_size, ws_size, (size_t)WS_END); grid = -1; return; }
        int dev = 0, cus = 0, per_cu = 0;
        if (hipGetDevice(&dev) != hipSuccess || hipDeviceGetAttribute(&cus, hipDeviceAttributeMultiprocessorCount, dev) != hipSuccess) { fprintf(stderr, "kernel_launch: device query failed\n"); grid = -1; return; }
        if (hipFuncSetAttribute((const void*)hymba_fwd, hipFuncAttributeMaxDynamicSharedMemorySize, LDS_BYTES) != hipSuccess) { fprintf(stderr, "kernel_launch: hipFuncSetAttribute failed\n"); grid = -1; return; }
        if (hipOccupancyMaxActiveBlocksPerMultiprocessor(&per_cu, (const void*)hymba_fwd, NWAVES * 64, LDS_BYTES) != hipSuccess || per_cu < 1)
            fprintf(stderr, "kernel_launch: note: occupancy query reports %d workgroups per CU\n", per_cu);
        (void)hipGetLastError();
        grid = cus;
        if (grid != 256) { fprintf(stderr, "kernel_launch: built for 256 CUs (one 256x256 unit per workgroup in the fused final-norm phase); found %d; nothing launched\n", grid); grid = -1; return; }
    }
    if (grid < 0) return;
    if (hipMemsetAsync((char*)d_ws + WS_CTL, 0, CTL_ZERO_BYTES, stream) != hipSuccess) { fprintf(stderr, "kernel_launch: hipMemsetAsync failed\n"); return; }
    Args a{};
    for (int i = 0; i < 30; ++i) a.in[i] = (const float*)d_in[i];
    a.out = (float*)d_out; a.ws = (unsigned char*)d_ws;
#if MK_PER_PHASE
    for (int ph = 0; ph < N_PHASES; ++ph) { a.ph_lo = ph; a.ph_hi = ph + 1; a.li = 0;
        hipLaunchKernelGGL(hymba_fwd, dim3(grid), dim3(NWAVES * 64), LDS_BYTES, stream, a); }
#else
#ifdef PROBE_PH
    a.ph_lo = 0; a.ph_hi = PROBE_PH + 1; a.li = 0;
    hipLaunchKernelGGL(hymba_fwd, dim3(grid), dim3(NWAVES * 64), LDS_BYTES, stream, a);
#ifdef PROBE_REPS
    for (int r_ = 0; r_ < PROBE_REPS; ++r_) { a.ph_lo = PROBE_PH; a.ph_hi = PROBE_PH + 1; a.li = 2 + r_; a.pad = PROBE_MODE; hipLaunchKernelGGL(hymba_fwd, dim3(grid), dim3(NWAVES * 64), LDS_BYTES, stream, a); }
#endif
    a.ph_lo = PROBE_PH; a.ph_hi = N_PHASES; a.li = 1; a.pad = 0;
    hipLaunchKernelGGL(hymba_fwd, dim3(grid), dim3(NWAVES * 64), LDS_BYTES, stream, a);
#else
    a.ph_lo = 0; a.ph_hi = N_PHASES; a.li = 0;
    hipLaunchKernelGGL(hymba_fwd, dim3(grid), dim3(NWAVES * 64), LDS_BYTES, stream, a);
#endif
#endif
    const hipError_t le = hipPeekAtLastError();
    if (le != hipSuccess) fprintf(stderr, "kernel_launch: launch failed: %s\n", hipGetErrorName(le));
}
```

```cpp
#include <hip/hip_runtime.h>
#include <cstdio>
#include <cstdint>
#define MK_PER_PHASE 0
namespace pg8 {
#define PG8_LAS __attribute__((address_space(3)))
typedef unsigned short bf16_t;
typedef short bf16x8 __attribute__((ext_vector_type(8)));
typedef float f32x4 __attribute__((ext_vector_type(4)));
typedef unsigned u32x4 __attribute__((ext_vector_type(4)));
constexpr int BM = 256, BK = 64, HALF = 128, HTB = HALF * BK * 2  , STAGE_BYTES = 8 * HTB, NXCD = 8, WGM = 8;

__host__ __device__ __forceinline__ int lds_byte(int r, int c) { const int st = (r >> 4) * 2 + (c >> 5), rr = r & 15, cc = c & 31, ob = rr * 64 + cc * 2; return st * 1024 + (ob ^ (((ob >> 9) & 1) << 5)); }
__host__ __device__ __forceinline__ void stage_rc(int b, int& R, int& C) { const int st = b / 1024, sb = b % 1024, swz = sb ^ (((sb >> 9) & 1) << 5); R = (st >> 1) * 16 + swz / 64; C = (st & 1) * 32 + (swz % 64) / 2; }
__host__ __device__ __forceinline__ int perm32(int rho) { const int n = rho >> 4, i = rho & 15; return 8 * (i >> 2) + 4 * n + (i & 3); }

struct Unit { int pm, pn; };
struct Gemm { const bf16_t* A; const bf16_t* Bt; int M, N, K; };

struct StaticOrder {
    int nM, nN, nwg, G, c;
    __host__ __device__ __forceinline__ void init(int M, int N, int G_, int c_) { nM = M / BM; nN = N / BM; nwg = nM * nN; G = G_; c = c_; }
    __host__ __device__ __forceinline__ bool next(int i, Unit& u) const {
        const long L = (long)i * G + c; if (L >= nwg) return false;
        int wgid = (int)L; { const int q = nwg / NXCD, r = nwg % NXCD, xcd = wgid % NXCD, off = wgid / NXCD; wgid = (xcd < r ? xcd * (q + 1) : r * (q + 1) + (xcd - r) * q) + off; }
        const int nig = WGM * nN, gid = wgid / nig, fm = gid * WGM, gsz = (nM - fm) < WGM ? (nM - fm) : WGM;
        u.pm = fm + ((wgid % nig) % gsz); u.pn = (wgid % nig) / gsz; return true;
    }
    __device__ __forceinline__ void a_ready(const Unit&) const {}
    __device__ __forceinline__ void done(const Unit&) const {}
};

__device__ __forceinline__ unsigned cvt_pk_bf16(float lo, float hi) { unsigned r; asm volatile("v_cvt_pk_bf16_f32 %0, %1, %2" : "=v"(r) : "v"(lo), "v"(hi)); return r; }
typedef float f32x2_t __attribute__((ext_vector_type(2))); typedef __bf16 bf16x2_t __attribute__((ext_vector_type(2)));
__device__ __forceinline__ unsigned pk2(float lo, float hi) { f32x2_t v = {lo, hi}; bf16x2_t b = __builtin_convertvector(v, bf16x2_t); return __builtin_bit_cast(unsigned, b); }
__device__ __forceinline__ float sigm(float x) { return __builtin_amdgcn_rcpf(1.f + __expf(-x)); }
__device__ __forceinline__ float silu(float x) { return x * __builtin_amdgcn_rcpf(1.f + __expf(-x)); }
__device__ __forceinline__ u32x4 pk8(const f32x4& a, const f32x4& b) { u32x4 w; w.x = pk2(a[0], a[1]); w.y = pk2(a[2], a[3]); w.z = pk2(b[0], b[1]); w.w = pk2(b[2], b[3]); return w; }
constexpr int PBLD = 2560;
constexpr int MPROMPT = 16384;
constexpr float RMS_EPS = 1e-6f;

struct EpiIn {
    static constexpr bool PERM = true, AFTER_DRAIN = false;
    bf16_t* PB;
    __device__ __forceinline__ void operator()(const f32x4 (&acc)[2][2][4][2], const Unit& u, int wr, int wc, int fr, int fq) const {
        const int row0 = u.pm * BM + wr * 64 + fr;
        if (u.pn < 4) {
            const int ch0 = u.pn * 128 + wc * 32 + 8 * fq;
#pragma unroll
            for (int ai = 0; ai < 2; ++ai)
#pragma unroll
                for (int m = 0; m < 4; ++m) {
                    bf16_t* rowp = PB + (size_t)(row0 + ai * HALF + m * 16) * PBLD + ch0;
                    f32x4 v0, v1;
#pragma unroll
                    for (int i = 0; i < 4; ++i) { v0[i] = acc[ai][0][m][0][i] * sigm(acc[ai][1][m][0][i]); v1[i] = acc[ai][0][m][1][i] * sigm(acc[ai][1][m][1][i]); }
                    *(u32x4*)rowp = pk8(v0, v1);
                }
        } else {
            const int col0 = u.pn * BM - 512 + wc * 32 + 8 * fq;
#pragma unroll
            for (int ai = 0; ai < 2; ++ai)
#pragma unroll
                for (int m = 0; m < 4; ++m) {
                    bf16_t* rowp = PB + (size_t)(row0 + ai * HALF + m * 16) * PBLD + col0;
#pragma unroll
                    for (int bj = 0; bj < 2; ++bj) *(u32x4*)(rowp + bj * HALF) = pk8(acc[ai][bj][m][0], acc[ai][bj][m][1]);
                }
        }
    }
};

struct EpiKV {
    static constexpr bool PERM = true, AFTER_DRAIN = false;
    float* outK; float* outV; bf16_t* KB; bf16_t* VT;
    __device__ __forceinline__ void operator()(const f32x4 (&acc)[2][2][4][2], const Unit& u, int wr, int wc, int fr, int fq) const {
        const int row0 = u.pm * BM + wr * 64 + fr;
        const bool isv = u.pn >= 4;
        const int c0 = (isv ? u.pn - 4 : u.pn) * BM + wc * 32 + 8 * fq;
        float* outp = isv ? outV : outK;
#pragma unroll
        for (int ai = 0; ai < 2; ++ai)
#pragma unroll
            for (int m = 0; m < 4; ++m) {
                const int row = row0 + ai * HALF + m * 16;
#pragma unroll
                for (int bj = 0; bj < 2; ++bj) {
                    const int col = c0 + bj * HALF;
                    const f32x4 a = acc[ai][bj][m][0], b = acc[ai][bj][m][1];
                    *(f32x4*)(outp + (size_t)row * 1024 + col) = a; *(f32x4*)(outp + (size_t)row * 1024 + col + 4) = b;
                    const u32x4 w = pk8(a, b);
                    if (!isv) *(u32x4*)(KB + (size_t)row * 1024 + col) = w;
                    else {
                        bf16_t* vp = VT + (size_t)col * 2048 + row;
                        vp[0 * 2048] = (bf16_t)(w.x & 0xffffu); vp[1 * 2048] = (bf16_t)(w.x >> 16); vp[2 * 2048] = (bf16_t)(w.y & 0xffffu); vp[3 * 2048] = (bf16_t)(w.y >> 16);
                        vp[4 * 2048] = (bf16_t)(w.z & 0xffffu); vp[5 * 2048] = (bf16_t)(w.z >> 16); vp[6 * 2048] = (bf16_t)(w.w & 0xffffu); vp[7 * 2048] = (bf16_t)(w.w >> 16);
                    }
                }
            }
    }
};

template <bool WRITE_BF> struct EpiRes {
    static constexpr bool PERM = true, AFTER_DRAIN = false;
    const float* base_main; const float* base_tail;
    int load_limit, store_limit;
    float* out; bf16_t* outb; float* ss;
    __device__ __forceinline__ void operator()(const f32x4 (&acc)[2][2][4][2], const Unit& u, int wr, int wc, int fr, int fq) const {
        const int row0 = u.pm * BM + wr * 64 + fr; const int col0 = u.pn * BM + wc * 32 + 8 * fq;
        const float* bp = (u.pm >= 64) ? base_tail - (size_t)MPROMPT * 1024 : base_main;
#pragma unroll
        for (int ai = 0; ai < 2; ++ai)
#pragma unroll
            for (int m = 0; m < 4; ++m) {
                const int row = row0 + ai * HALF + m * 16; const size_t off = (size_t)row * 1024 + col0;
                float s = 0.f;
#pragma unroll
                for (int bj = 0; bj < 2; ++bj) {
                    f32x4 b0 = (f32x4){0.f, 0.f, 0.f, 0.f}, b1 = b0;
                    if (row < load_limit) { b0 = *(const f32x4*)(bp + off + bj * HALF); b1 = *(const f32x4*)(bp + off + bj * HALF + 4); }
                    const f32x4 v0 = acc[ai][bj][m][0] + b0, v1 = acc[ai][bj][m][1] + b1;
                    s += (v0[0] * v0[0] + v0[1] * v0[1]) + (v0[2] * v0[2] + v0[3] * v0[3]) + (v1[0] * v1[0] + v1[1] * v1[1]) + (v1[2] * v1[2] + v1[3] * v1[3]);
                    if (row < store_limit) { *(f32x4*)(out + off + bj * HALF) = v0; *(f32x4*)(out + off + bj * HALF + 4) = v1; }
                    if (WRITE_BF) *(u32x4*)(outb + off + bj * HALF) = pk8(v0, v1);
                }
                s += __shfl_xor(s, 16); s += __shfl_xor(s, 32);
                if (fq == 0) atomicAdd(ss + row, s);
            }
    }
};

struct EpiQ {
    static constexpr bool PERM = true, AFTER_DRAIN = false;
    bf16_t* Q; const float* ss; float c2;
    __device__ __forceinline__ void operator()(const f32x4 (&acc)[2][2][4][2], const Unit& u, int wr, int wc, int fr, int fq) const {
        const int row0 = u.pm * BM + wr * 64 + fr; const int col0 = u.pn * BM + wc * 32 + 8 * fq;
#pragma unroll
        for (int ai = 0; ai < 2; ++ai)
#pragma unroll
            for (int m = 0; m < 4; ++m) {
                const int row = row0 + ai * HALF + m * 16;
                const float rs = __builtin_amdgcn_rsqf(ss[row] * (1.f / 1024.f) + RMS_EPS) * c2;
#pragma unroll
                for (int bj = 0; bj < 2; ++bj) *(u32x4*)(Q + (size_t)row * 1024 + col0 + bj * HALF) = pk8(acc[ai][bj][m][0] * rs, acc[ai][bj][m][1] * rs);
            }
    }
};

struct EpiGU {
    static constexpr bool PERM = true, AFTER_DRAIN = false;
    bf16_t* T; const float* ss;
    __device__ __forceinline__ void operator()(const f32x4 (&acc)[2][2][4][2], const Unit& u, int wr, int wc, int fr, int fq) const {
        const int row0 = u.pm * BM + wr * 64 + fr; const int ch0 = u.pn * 128 + wc * 32 + 8 * fq;
#pragma unroll
        for (int ai = 0; ai < 2; ++ai)
#pragma unroll
            for (int m = 0; m < 4; ++m) {
                const int row = row0 + ai * HALF + m * 16;
                const float rs = __builtin_amdgcn_rsqf(ss[row] * (1.f / 1024.f) + RMS_EPS);
                f32x4 v0, v1;
#pragma unroll
                for (int i = 0; i < 4; ++i) { v0[i] = silu(acc[ai][0][m][0][i] * rs) * (acc[ai][1][m][0][i] * rs); v1[i] = silu(acc[ai][0][m][1][i] * rs) * (acc[ai][1][m][1][i] * rs); }
                *(u32x4*)(T + (size_t)row * 2816 + ch0) = pk8(v0, v1);
            }
    }
};


struct EpiResNorm {
    static constexpr bool PERM = true, AFTER_DRAIN = true;
    const float* base; float* out; const float* gain; float* xbuf; unsigned* cnt; unsigned* tmo;
    __device__ __forceinline__ void fused(f32x4 (&acc)[2][2][4][2], const Unit& u, int wr, int wc, int fr, int fq, PG8_LAS unsigned char* lds, int wid, int lane) const {
        PG8_LAS float* P = (PG8_LAS float*)lds;
        PG8_LAS float* S = (PG8_LAS float*)(lds + 4096);
        PG8_LAS unsigned* flag = (PG8_LAS unsigned*)(lds + 4096 + 1024);
        const int row0 = u.pm * BM + wr * 64 + fr; const int col0 = u.pn * BM + wc * 32 + 8 * fq;
#pragma unroll
        for (int ai = 0; ai < 2; ++ai)
#pragma unroll
            for (int m = 0; m < 4; ++m) {
                const size_t off = (size_t)(row0 + ai * HALF + m * 16) * 1024 + col0; float s = 0.f;
#pragma unroll
                for (int bj = 0; bj < 2; ++bj) {
                    const f32x4 v0 = acc[ai][bj][m][0] + *(const f32x4*)(base + off + bj * HALF), v1 = acc[ai][bj][m][1] + *(const f32x4*)(base + off + bj * HALF + 4);
                    acc[ai][bj][m][0] = v0; acc[ai][bj][m][1] = v1;
                    s += (v0[0] * v0[0] + v0[1] * v0[1]) + (v0[2] * v0[2] + v0[3] * v0[3]) + (v1[0] * v1[0] + v1[1] * v1[1]) + (v1[2] * v1[2] + v1[3] * v1[3]);
                }
                s += __shfl_xor(s, 16); s += __shfl_xor(s, 32);
                if (fq == 0) P[(ai * HALF + wr * 64 + m * 16 + fr) * 4 + wc] = s;
                if (m & 1) asm volatile("" ::: "memory");
            }
        asm volatile("s_waitcnt lgkmcnt(0)" ::: "memory"); __builtin_amdgcn_s_barrier(); asm volatile("" ::: "memory");
        const int row = wid * 64 + lane;
        if (wid < 4) {
            const float t = (P[row * 4 + 0] + P[row * 4 + 1]) + (P[row * 4 + 2] + P[row * 4 + 3]);
            __hip_atomic_store(xbuf + (size_t)(u.pm * BM + row) * 4 + u.pn, t, __ATOMIC_RELAXED, __HIP_MEMORY_SCOPE_AGENT);
            asm volatile("s_waitcnt vmcnt(0)" ::: "memory");
            if (lane == 0) __hip_atomic_fetch_add(cnt + 64 * u.pm, 1u, __ATOMIC_RELAXED, __HIP_MEMORY_SCOPE_AGENT);
        }
        if (wid == 0) {
            unsigned spins = 0; bool dead = false;
            while ((unsigned)__builtin_amdgcn_readfirstlane(__hip_atomic_load(cnt + 64 * u.pm, __ATOMIC_RELAXED, __HIP_MEMORY_SCOPE_AGENT)) < 16u) {
                __builtin_amdgcn_s_sleep(2);
                if (++spins > (1u << 22)) { dead = true; if (lane == 0) __hip_atomic_store(tmo, 1u, __ATOMIC_RELAXED, __HIP_MEMORY_SCOPE_AGENT); break; }
            }
            __builtin_amdgcn_fence(__ATOMIC_ACQUIRE, "agent");
            if (lane == 0) flag[0] = dead ? 1u : 0u;
        }
        asm volatile("s_waitcnt vmcnt(0) lgkmcnt(0)" ::: "memory"); __builtin_amdgcn_s_barrier(); asm volatile("" ::: "memory");
        if (wid < 4) {
            const float* sl = xbuf + (size_t)(u.pm * BM + row) * 4; float t = 0.f;
#pragma unroll
            for (int q = 0; q < 4; ++q) t += __hip_atomic_load(sl + q, __ATOMIC_RELAXED, __HIP_MEMORY_SCOPE_AGENT);
            S[row] = __builtin_amdgcn_rsqf(t * (1.f / 1024.f) + RMS_EPS);
        }
        asm volatile("s_waitcnt vmcnt(0) lgkmcnt(0)" ::: "memory"); __builtin_amdgcn_s_barrier(); asm volatile("" ::: "memory");
        f32x4 gv[2][2];
#pragma unroll
        for (int bj = 0; bj < 2; ++bj) { gv[bj][0] = *(const f32x4*)(gain + col0 + bj * HALF); gv[bj][1] = *(const f32x4*)(gain + col0 + bj * HALF + 4); }
#pragma unroll
        for (int ai = 0; ai < 2; ++ai)
#pragma unroll
            for (int m = 0; m < 4; ++m) {
                const int rl = ai * HALF + wr * 64 + m * 16 + fr; const float rs = S[rl]; const size_t off = (size_t)(u.pm * BM + rl) * 1024 + col0;
#pragma unroll
                for (int bj = 0; bj < 2; ++bj) { *(f32x4*)(out + off + bj * HALF) = acc[ai][bj][m][0] * rs * gv[bj][0]; *(f32x4*)(out + off + bj * HALF + 4) = acc[ai][bj][m][1] * rs * gv[bj][1]; }
            }
    }
};

template <class Epi, class Sched, bool ALIGN_EPI = false, bool SP2 = false>
__device__ __forceinline__ void gemm_phase(PG8_LAS unsigned char* lds, const Gemm g, const Sched& S, const Epi& E) {
    const int tid = threadIdx.x, wid = __builtin_amdgcn_readfirstlane(tid >> 6), lane = tid & 63, wr = wid >> 2, wc = wid & 3, fr = lane & 15, fq = lane >> 4;
    const int K = g.K, nt = K / BK;
    unsigned voffA[2], voffB[2];
#pragma unroll
    for (int i = 0; i < 2; ++i) { int R, C; stage_rc(tid * 16 + i * 8192, R, C); const int Rb = Epi::PERM ? ((R & ~31) + perm32(R & 31)) : R;
        voffA[i] = (unsigned)(R * K + C) * 2u; voffB[i] = (unsigned)(Rb * K + C) * 2u; }
    const size_t kstep = (size_t)(BK * 2);
    const size_t hstep = (size_t)HALF * K * 2;
    const size_t tstep = 2 * hstep;
    const unsigned ldsw = (unsigned)wid * 1024u;
    const int aoff = lds_byte(wr * 64 + fr, fq * 8), boff = lds_byte(wc * 32 + fr, fq * 8);
#define PG8_SA(b, h) (((b) * 2 + (h)) * HTB)
#define PG8_SB(b, h) ((4 + (b) * 2 + (h)) * HTB)
#define PG8_STAGE(bufoff, gbase, voff) do { _Pragma("unroll") for (int _i = 0; _i < 2; ++_i) \
        __builtin_amdgcn_global_load_lds((const unsigned*)((const char*)(gbase) + (voff)[_i]), (PG8_LAS unsigned*)(lds + (bufoff) + ldsw + _i * 8192), 16, 0, 0); } while (0)
#define PG8_LDA(dst, b, h) do { _Pragma("unroll") for (int m = 0; m < 4; ++m) _Pragma("unroll") for (int k = 0; k < 2; ++k) dst[m][k] = *(const PG8_LAS bf16x8*)(lds + PG8_SA(b, h) + aoff + m * 2048 + k * 1024); } while (0)
#define PG8_LDB(dst, b, h) do { _Pragma("unroll") for (int n = 0; n < 2; ++n) _Pragma("unroll") for (int k = 0; k < 2; ++k) dst[n][k] = *(const PG8_LAS bf16x8*)(lds + PG8_SB(b, h) + boff + n * 2048 + k * 1024); } while (0)
#define PG8_MMA(ai, bj, At, Bt) do { __builtin_amdgcn_s_setprio(1); _Pragma("unroll") for (int m = 0; m < 4; ++m) _Pragma("unroll") for (int n = 0; n < 2; ++n) _Pragma("unroll") for (int k = 0; k < 2; ++k) \
        acc[ai][bj][m][n] = __builtin_amdgcn_mfma_f32_16x16x32_bf16(Bt[n][k], At[m][k], acc[ai][bj][m][n], 0, 0, 0); __builtin_amdgcn_s_setprio(0); } while (0)
#define PG8_WAIT_V(n) asm volatile("s_waitcnt vmcnt(" #n ")" ::: "memory")
#define PG8_WAIT_L(n) asm volatile("s_waitcnt lgkmcnt(" #n ")" ::: "memory")
#define PG8_BAR __builtin_amdgcn_s_barrier()
#define PG8_SCHED __builtin_amdgcn_sched_barrier(0)
    Unit cur, nxt; int ui = 0;
    if (!S.next(0, cur)) return;
    f32x4 acc[2][2][4][2];
#pragma unroll
    for (int a = 0; a < 2; ++a)
#pragma unroll
        for (int b = 0; b < 2; ++b)
#pragma unroll
            for (int m = 0; m < 4; ++m)
#pragma unroll
                for (int n = 0; n < 2; ++n) acc[a][b][m][n] = (f32x4){0.f, 0.f, 0.f, 0.f};
    bf16x8 At[4][2], B0[2][2], B1[2][2];
    const char* cA = (const char*)g.A + (size_t)cur.pm * tstep; const char* cB = (const char*)g.Bt + (size_t)cur.pn * tstep;
    S.a_ready(cur);
    if constexpr (SP2) {
        PG8_STAGE(PG8_SB(0, 0), cB, voffB); PG8_STAGE(PG8_SB(0, 1), cB + hstep, voffB); PG8_STAGE(PG8_SA(0, 0), cA, voffA); PG8_STAGE(PG8_SA(0, 1), cA + hstep, voffA);
        if (wr == 1) PG8_BAR;
        PG8_WAIT_V(2); PG8_BAR;
        PG8_STAGE(PG8_SB(1, 0), cB + kstep, voffB); PG8_STAGE(PG8_SA(1, 0), cA + kstep, voffA); PG8_STAGE(PG8_SB(1, 1), cB + hstep + kstep, voffB);
        PG8_WAIT_V(6); PG8_BAR;
    } else {
        PG8_STAGE(PG8_SB(0, 0), cB, voffB); PG8_STAGE(PG8_SA(0, 0), cA, voffA); PG8_STAGE(PG8_SB(0, 1), cB + hstep, voffB); PG8_STAGE(PG8_SA(0, 1), cA + hstep, voffA);
        if (wr == 1) PG8_BAR;
        PG8_WAIT_V(4); PG8_BAR;
        PG8_STAGE(PG8_SB(1, 0), cB + kstep, voffB); PG8_STAGE(PG8_SA(1, 0), cA + kstep, voffA); PG8_STAGE(PG8_SB(1, 1), cB + hstep + kstep, voffB);
        PG8_WAIT_V(6); PG8_BAR;
    }
    for (;;) {
        const bool has_next = S.next(ui + 1, nxt);
        const char* nA = has_next ? (const char*)g.A + (size_t)nxt.pm * tstep : cA; const char* nB = has_next ? (const char*)g.Bt + (size_t)nxt.pn * tstep : cB;
        for (int t = 0; t < nt; t += 2) {
            const bool last = (t == nt - 2);
            const char* a1 = cA + (size_t)(t + 1) * kstep;
            const char* a2 = last ? nA : cA + (size_t)(t + 2) * kstep; const char* b2 = last ? nB : cB + (size_t)(t + 2) * kstep;
            const char* a3 = a2 + kstep; const char* b3 = b2 + kstep;
            if (last && has_next) S.a_ready(nxt);
            if constexpr (SP2) {
            PG8_LDB(B0, 0, 0); PG8_LDB(B1, 0, 1); PG8_SCHED; PG8_LDA(At, 0, 0); PG8_STAGE(PG8_SA(1, 1), a1 + hstep, voffA);
            PG8_WAIT_V(8); PG8_WAIT_L(0); PG8_BAR; PG8_MMA(0, 0, At, B0); PG8_MMA(0, 1, At, B1); PG8_BAR; PG8_SCHED;
            PG8_LDA(At, 0, 1); PG8_STAGE(PG8_SB(0, 0), b2, voffB); PG8_STAGE(PG8_SB(0, 1), b2 + hstep, voffB); PG8_STAGE(PG8_SA(0, 0), a2, voffA);
            PG8_WAIT_V(8); PG8_WAIT_L(0); PG8_BAR; PG8_MMA(1, 0, At, B0); PG8_MMA(1, 1, At, B1); PG8_BAR; PG8_SCHED;
            PG8_LDB(B0, 1, 0); PG8_LDB(B1, 1, 1); PG8_SCHED; PG8_LDA(At, 1, 0); PG8_STAGE(PG8_SA(0, 1), a2 + hstep, voffA);
            PG8_WAIT_V(8); PG8_WAIT_L(0); PG8_BAR; PG8_MMA(0, 0, At, B0); PG8_MMA(0, 1, At, B1); PG8_BAR; PG8_SCHED;
            PG8_LDA(At, 1, 1); PG8_STAGE(PG8_SB(1, 0), b3, voffB); PG8_STAGE(PG8_SB(1, 1), b3 + hstep, voffB); PG8_STAGE(PG8_SA(1, 0), a3, voffA);
            PG8_WAIT_V(8); PG8_WAIT_L(0); PG8_BAR; PG8_MMA(1, 0, At, B0); PG8_MMA(1, 1, At, B1); PG8_BAR; PG8_SCHED;
            } else {
            PG8_LDB(B0, 0, 0); PG8_SCHED; PG8_LDA(At, 0, 0); PG8_STAGE(PG8_SA(1, 1), a1 + hstep, voffA);
            PG8_WAIT_L(8); PG8_BAR; PG8_WAIT_L(0); PG8_MMA(0, 0, At, B0); PG8_BAR; PG8_SCHED;
            PG8_LDB(B1, 0, 1); PG8_STAGE(PG8_SB(0, 0), b2, voffB);
            PG8_BAR; PG8_WAIT_L(0); PG8_MMA(0, 1, At, B1); PG8_BAR;
            PG8_LDA(At, 0, 1); PG8_STAGE(PG8_SA(0, 0), a2, voffA);
            PG8_BAR; PG8_WAIT_L(0); PG8_MMA(1, 0, At, B0); PG8_BAR; PG8_SCHED;
            PG8_STAGE(PG8_SB(0, 1), b2 + hstep, voffB);
            PG8_WAIT_V(6); PG8_BAR; PG8_MMA(1, 1, At, B1); PG8_BAR;
            PG8_LDB(B0, 1, 0); PG8_SCHED; PG8_LDA(At, 1, 0); PG8_STAGE(PG8_SA(0, 1), a2 + hstep, voffA);
            PG8_WAIT_L(8); PG8_BAR; PG8_WAIT_L(0); PG8_MMA(0, 0, At, B0); PG8_BAR; PG8_SCHED;
            PG8_LDB(B1, 1, 1); PG8_STAGE(PG8_SB(1, 0), b3, voffB);
            PG8_BAR; PG8_WAIT_L(0); PG8_MMA(0, 1, At, B1); PG8_BAR;
            PG8_LDA(At, 1, 1); PG8_STAGE(PG8_SA(1, 0), a3, voffA);
            PG8_BAR; PG8_WAIT_L(0); PG8_MMA(1, 0, At, B0); PG8_BAR; PG8_SCHED;
            PG8_STAGE(PG8_SB(1, 1), b3 + hstep, voffB);
            PG8_WAIT_V(6); PG8_BAR; PG8_MMA(1, 1, At, B1); PG8_BAR;
            }
        }
        if constexpr (ALIGN_EPI) { if (wr == 0) PG8_BAR; }
        if constexpr (!Epi::AFTER_DRAIN) { E(acc, cur, wr, wc, fr, fq); S.done(cur); }
        if (!has_next) break;
#pragma unroll
        for (int a = 0; a < 2; ++a)
#pragma unroll
            for (int b = 0; b < 2; ++b)
#pragma unroll
                for (int m = 0; m < 4; ++m)
#pragma unroll
                    for (int n = 0; n < 2; ++n) acc[a][b][m][n] = (f32x4){0.f, 0.f, 0.f, 0.f};
        cur = nxt; cA = nA; cB = nB; ++ui;
        if constexpr (ALIGN_EPI) { if (wr == 1) PG8_BAR; }
    }
    PG8_WAIT_V(0);
    if constexpr (!ALIGN_EPI) { if (wr == 0) PG8_BAR; }
    PG8_BAR;
    if constexpr (Epi::AFTER_DRAIN) { E.fused(acc, cur, wr, wc, fr, fq, lds, wid, lane); S.done(cur); }
#undef PG8_SA
#undef PG8_SB
#undef PG8_STAGE
#undef PG8_LDA
#undef PG8_LDB
#undef PG8_MMA
#undef PG8_WAIT_V
#undef PG8_WAIT_L
#undef PG8_BAR
#undef PG8_SCHED
}
}

constexpr int NWAVES = 8;
#ifndef MK_PER_PHASE
#define MK_PER_PHASE 0
#endif
constexpr int N_PHASES = 10;

constexpr int DM = 1024, NB = 8, SEQ = 2048, MP = NB * SEQ  , DEC = 128, MV = MP + DEC  , MR = 16640  ;
constexpr int CC = 512, CW = 31, NH = 4, DKV = 128, QKVN = 1536, NMEM = 256, MHD = 256, DFF = 2816, INC = 3080;
constexpr int PBLD = pg8::PBLD;
constexpr int NCHUNK = NB * NH * 32;
constexpr float RMS_EPS = 1e-6f;
constexpr float ATT_C2 = 0.0625f * 1.4426950408889634f;

constexpr size_t OUT_YP = 0, OUT_YS = 16777216, OUT_CONVP = 16908288, OUT_SCP = 17031168, OUT_DLP = 17068032, OUT_MKP = 17592320, OUT_MVP = 19689472,
                 OUT_CONVS = 21786624, OUT_SCS = 23752704, OUT_DLS = 24342528, OUT_END = 32731136;

constexpr size_t MiB = 1u << 20;
constexpr size_t WS_CTL = 0, CTL_ZERO_BYTES = 1 * MiB;
constexpr size_t WS_WIN = 1 * MiB, WS_WOUT = 7 * MiB, WS_WMQ = 9 * MiB, WS_WMKV = 11 * MiB, WS_WMO = 15 * MiB, WS_WGU = 17 * MiB, WS_WDN = 28 * MiB;
constexpr size_t WS_BG = 34 * MiB, WS_MEMN = 35 * MiB, WS_KB = 39 * MiB, WS_VT = 43 * MiB, WS_GL = 47 * MiB, WS_X1S = 47 * MiB + 65536, WS_XBUF = 47 * MiB + 655360;
constexpr size_t WS_RA = 48 * MiB;
constexpr size_t WS_RB = 138 * MiB;
constexpr size_t WS_RC = 171 * MiB;
constexpr size_t WS_RD = 220 * MiB;
constexpr size_t WS_U = WS_RD, WS_W = 252 * MiB, WS_QG = 268 * MiB, WS_KDT = 284 * MiB, WS_QK = 300 * MiB;
constexpr size_t WS_RE = 308 * MiB;
constexpr size_t WS_RF = 341 * MiB;
constexpr size_t WS_END = 406 * MiB;
constexpr int CW_TMO = 0, CW_CODE = 1, CW_BAR = 4096, CW_SS1 = 65536, CW_SS2 = 98304, CW_SS3 = 131072, CW_PANEL = 200000;

constexpr int RING_OFF = 0, RING_BYTES = 143360;
constexpr int LDSCTL_OFF = RING_BYTES, MISC_OFF = LDSCTL_OFF + 320;
constexpr int LDS_BYTES = 147456;

#define GAS __attribute__((address_space(1)))
#define LAS __attribute__((address_space(3)))
typedef unsigned short bf16;
typedef unsigned v4u __attribute__((ext_vector_type(4)));
typedef unsigned v2u __attribute__((ext_vector_type(2)));
typedef float f32x4 __attribute__((ext_vector_type(4)));
typedef float f32x16 __attribute__((ext_vector_type(16)));
typedef short bf16x8 __attribute__((ext_vector_type(8)));
typedef GAS unsigned gu32;
#define RLX_AGENT __ATOMIC_RELAXED, __HIP_MEMORY_SCOPE_AGENT
#define LDS_WAIT() asm volatile("s_waitcnt lgkmcnt(0)" ::: "memory")
#define VM_WAIT() asm volatile("s_waitcnt vmcnt(0)" ::: "memory")
using pg8::pk2; using pg8::silu; using pg8::sigm;
__device__ __forceinline__ float bf2f(unsigned b) { return __uint_as_float(b << 16); }
__device__ __forceinline__ float bflo(unsigned w) { return __uint_as_float(w << 16); }
__device__ __forceinline__ float bfhi(unsigned w) { return __uint_as_float(w & 0xffff0000u); }
__device__ __forceinline__ void unpack8(const v4u& w, float (&f)[8]) { f[0] = bflo(w.x); f[1] = bfhi(w.x); f[2] = bflo(w.y); f[3] = bfhi(w.y); f[4] = bflo(w.z); f[5] = bfhi(w.z); f[6] = bflo(w.w); f[7] = bfhi(w.w); }
__device__ __forceinline__ v4u pack8(const float (&f)[8]) { v4u w; w.x = pk2(f[0], f[1]); w.y = pk2(f[2], f[3]); w.z = pk2(f[4], f[5]); w.w = pk2(f[6], f[7]); return w; }
__device__ __forceinline__ float wave_sum(float v) {
#pragma unroll
    for (int o = 1; o < 64; o <<= 1) v += __shfl_xor(v, o);
    return v;
}
__device__ __forceinline__ float wave_max(float v) {
#pragma unroll
    for (int o = 1; o < 64; o <<= 1) v = fmaxf(v, __shfl_xor(v, o));
    return v;
}

#define XB_TMO      128
#define XB_XCNT(j)  (256  + 64 * (j))
#define XB_XSUB(j)  (1280 + 64 * (j))
#define XB_XGEN(j)  (2304 + 64 * (j))
#define XB_TOP      3328
#define XB_TOPGEN   3392
#define XCD_BAR_WORDS 3456
#define XB_SPIN_CAP (1u << 18)

__device__ __forceinline__ unsigned xb_ld(unsigned* p)              { return __hip_atomic_load(p, __ATOMIC_RELAXED, __HIP_MEMORY_SCOPE_AGENT); }
__device__ __forceinline__ unsigned xb_add(unsigned* p, unsigned v) { return __hip_atomic_fetch_add(p, v, __ATOMIC_RELAXED, __HIP_MEMORY_SCOPE_AGENT); }
__device__ __forceinline__ unsigned xb_xcc_id() { return (unsigned)__builtin_amdgcn_s_getreg((3 << 11) | 20) & 0xFu; }
#define XB_SPIN(cond, bar) do { unsigned _sp = 0; while (cond) { __builtin_amdgcn_s_sleep(1); \
    if ((++_sp & 255u) == 0u) { if (xb_ld(&(bar)[XB_TMO])) break; if (_sp > XB_SPIN_CAP) { atomicAdd(&(bar)[XB_TMO], 1u); break; } } } } while (0)

struct XcdBarrier {
    unsigned* bar; unsigned x;
    volatile LAS unsigned* st;
};

__device__ __forceinline__ XcdBarrier xcd_barrier_post(unsigned* bar, volatile LAS unsigned* st) {
    XcdBarrier b; b.bar = bar; b.x = xb_xcc_id(); b.st = st;
    if (threadIdx.x == 0) (void)xb_add(&bar[XB_XCNT(b.x)], 1u);
    return b;
}
__device__ __forceinline__ void xcd_barrier_complete(unsigned* bar, unsigned x, unsigned& nloc, unsigned& nx) {
    const unsigned G = gridDim.x * gridDim.y * gridDim.z;
    unsigned sum, cnt, mine, sp = 0u;
    for (;;) {
        sum = 0u; cnt = 0u; mine = 0u;
#pragma unroll
        for (unsigned j = 0; j < 16; ++j) { const unsigned c = xb_ld(&bar[XB_XCNT(j)]); sum += c; cnt += (c > 0u) ? 1u : 0u; mine = (j == x) ? c : mine; }
        if (sum == G) break;
        __builtin_amdgcn_s_sleep(1);
        if ((++sp & 255u) == 0u) { if (xb_ld(&bar[XB_TMO])) break; if (sp > XB_SPIN_CAP) { atomicAdd(&bar[XB_TMO], 1u); break; } }
    }
    nloc = mine > 0u ? mine : 1u; nx = cnt > 0u ? cnt : 1u;
}

__device__ __forceinline__ void xcd_barrier(const XcdBarrier& b) {
    asm volatile("s_waitcnt vmcnt(0)" ::: "memory");
    __syncthreads();
    if (threadIdx.x == 0) {
        unsigned* bar = b.bar;
        __builtin_amdgcn_s_waitcnt(0);
        unsigned nloc = b.st[0], nx = b.st[1];
        if (nloc == 0u) { xcd_barrier_complete(bar, b.x, nloc, nx); b.st[0] = nloc; b.st[1] = nx; }
        const unsigned old = xb_add(&bar[XB_XSUB(b.x)], 1u);
        const unsigned gen = old / nloc;
        if (old + 1u == (gen + 1u) * nloc) {
            __builtin_amdgcn_fence(__ATOMIC_RELEASE, "agent");
            asm volatile("s_waitcnt vmcnt(0)" ::: "memory");
            const unsigned og = xb_add(&bar[XB_TOP], 1u);
            const unsigned tg = og / nx;
            if (og + 1u == (tg + 1u) * nx) xb_add(&bar[XB_TOPGEN], 1u);
            else XB_SPIN(xb_ld(&bar[XB_TOPGEN]) == tg, bar);
            __builtin_amdgcn_fence(__ATOMIC_ACQUIRE, "agent");
            xb_add(&bar[XB_XGEN(b.x)], 1u);
            asm volatile("s_waitcnt vmcnt(0)" ::: "memory");
        } else {
            XB_SPIN(xb_ld(&bar[XB_XGEN(b.x)]) == gen, bar);
            __builtin_amdgcn_fence(__ATOMIC_ACQUIRE, "agent");
            asm volatile("s_waitcnt vmcnt(0)" ::: "memory");
        }
    }
    __syncthreads();
}

struct Args { const float* in[30]; float* out; unsigned char* ws; int ph_lo, ph_hi, li, pad; };
struct Frame {
    LAS unsigned char* lds;
    volatile LAS unsigned* MISC;
    gu32* ctl;
    int tid, lane, wave;
    int vcu, G;
};
enum { I_XP = 0, I_XS, I_MEM, I_CCONV, I_SSC, I_SDELTA, I_CMK, I_CMV, I_NMIX, I_WIN, I_CONVW, I_CONVB, I_LNG, I_LNB, I_SCW, I_ALOG, I_DTB, I_DNN, I_WOUT,
       I_NMQ, I_NMKV, I_WMQ, I_WMK, I_WMV, I_WMO, I_NFFN, I_WG, I_WU, I_WD, I_NF };

struct TrJob { const float* W; const float* gain; bf16* WT; int ldw, k0, c0, K, r0; };
__device__ __forceinline__ void tr_load(const TrJob& j, int lane, f32x4 (&v)[8]) {
    const float* p = j.W + (size_t)(j.k0 + (lane >> 3)) * j.ldw + j.c0 + (lane & 7) * 4;
#pragma unroll
    for (int i = 0; i < 8; ++i) v[i] = *(const GAS f32x4*)(p + (size_t)(8 * i) * j.ldw);
}
__device__ __forceinline__ void tr_finish(const TrJob& j, const f32x4 (&v)[8], LAS float* scr, int lane) {
#pragma unroll
    for (int i = 0; i < 8; ++i) { LAS float* d = scr + (8 * i + (lane >> 3)) * 33 + (lane & 7) * 4; d[0] = v[i][0]; d[1] = v[i][1]; d[2] = v[i][2]; d[3] = v[i][3]; }
    LDS_WAIT(); asm volatile("" ::: "memory");
    const int c = lane & 7;
    float gv[8];
#pragma unroll
    for (int i = 0; i < 8; ++i) gv[i] = j.gain ? j.gain[j.k0 + 8 * c + i] : 1.f;
#pragma unroll
    for (int q = 0; q < 4; ++q) { const int n = (lane >> 3) + 8 * q; const LAS float* s = scr + (8 * c) * 33 + n;
        v4u o; o.x = pk2(s[0 * 33] * gv[0], s[1 * 33] * gv[1]); o.y = pk2(s[2 * 33] * gv[2], s[3 * 33] * gv[3]); o.z = pk2(s[4 * 33] * gv[4], s[5 * 33] * gv[5]); o.w = pk2(s[6 * 33] * gv[6], s[7 * 33] * gv[7]);
        *(GAS v4u*)(j.WT + (size_t)(j.r0 + n) * j.K + j.k0 + 8 * c) = o; }
    LDS_WAIT(); asm volatile("" ::: "memory");
}
__device__ __forceinline__ float softplusf_(float x) { return x > 20.f ? x : log1pf(__expf(x)); }

__device__ __forceinline__ void p0_prologue(const Args& A, Frame& F) {
    LAS float* scr = (LAS float*)(F.lds + RING_OFF + F.wave * 8448);
    const int gw = F.vcu * NWAVES + F.wave, NGW = F.G * NWAVES;
    unsigned char* ws = A.ws;
    const float* const pWMK = A.in[I_WMK]; const float* const pWMV = A.in[I_WMV]; const float* const pWG = A.in[I_WG]; const float* const pWU = A.in[I_WU];
    const float* const pXP = A.in[I_XP]; const float* const pXS = A.in[I_XS];
    constexpr int I_A = 96 * 16, I_B = 32 * 16, I_D = 64 * 16, I_F = 176 * 16, I_G = 32 * 44;
    constexpr int NITEMS = I_A + I_B + I_B + I_D + I_B + I_F + I_G;
    const float* const pWIN = A.in[I_WIN]; const float* const pWOUT = A.in[I_WOUT]; const float* const pWMQ = A.in[I_WMQ]; const float* const pWMO = A.in[I_WMO]; const float* const pWD = A.in[I_WD];
    const float* const pNMQ = A.in[I_NMQ]; const float* const pNFFN = A.in[I_NFFN];
#define TR_DECODE(J, IT) do { int r = (IT); \
        if (r < I_A) { const int nb = r % 96, kb = r / 96, j0 = 32 * nb; int src = j0; \
            if (j0 < 1024) { const int tile = j0 >> 8, local = j0 & 255; src = local < 128 ? 128 * tile + local : 512 + 128 * tile + (local - 128); } \
            J = TrJob{pWIN, nullptr, (bf16*)(ws + WS_WIN), INC, 64 * kb, src, DM, j0}; break; } r -= I_A; \
        if (r < I_B) { const int nb = r % 32, kb = r / 32; J = TrJob{pWOUT, nullptr, (bf16*)(ws + WS_WOUT), DM, 64 * kb, 32 * nb, DM, 32 * nb}; break; } r -= I_B; \
        if (r < I_B) { const int nb = r % 32, kb = r / 32; J = TrJob{pWMQ, pNMQ, (bf16*)(ws + WS_WMQ), DM, 64 * kb, 32 * nb, DM, 32 * nb}; break; } r -= I_B; \
        if (r < I_D) { const int nb = r % 64, kb = r / 64, j0 = 32 * nb; const bool isv = j0 >= 1024; \
            J = TrJob{isv ? pWMV : pWMK, nullptr, (bf16*)(ws + WS_WMKV), DM, 64 * kb, isv ? j0 - 1024 : j0, DM, j0}; break; } r -= I_D; \
        if (r < I_B) { const int nb = r % 32, kb = r / 32; J = TrJob{pWMO, nullptr, (bf16*)(ws + WS_WMO), DM, 64 * kb, 32 * nb, DM, 32 * nb}; break; } r -= I_B; \
        if (r < I_F) { const int nb = r % 176, kb = r / 176, j0 = 32 * nb, tile = j0 >> 8, local = j0 & 255; const bool up = local >= 128; \
            J = TrJob{up ? pWU : pWG, pNFFN, (bf16*)(ws + WS_WGU), DFF, 64 * kb, 128 * tile + (up ? local - 128 : local), DM, j0}; break; } r -= I_F; \
        { const int nb = r % 32, kb = r / 32; J = TrJob{pWD, nullptr, (bf16*)(ws + WS_WDN), DM, 64 * kb, 32 * nb, DFF, 32 * nb}; } } while (0)
    {
        TrJob jc, jn; f32x4 vc[8], vn[8];
        int it = gw;
        if (it < NITEMS) { TR_DECODE(jc, it); tr_load(jc, F.lane, vc); }
#pragma unroll 1
        for (; it < NITEMS; it += NGW) {
            const int itn = it + NGW;
            if (itn < NITEMS) { TR_DECODE(jn, itn); tr_load(jn, F.lane, vn); }
            tr_finish(jc, vc, scr, F.lane);
            jc = jn;
#pragma unroll
            for (int i = 0; i < 8; ++i) vc[i] = vn[i];
        }
    }
#undef TR_DECODE
    {
        bf16* H = (bf16*)(ws + WS_RB); float* BG = (float*)(ws + WS_BG);
        const float* win = A.in[I_WIN]; const float* gain = A.in[I_NMIX];
        float w8[4][4][8];
#pragma unroll
        for (int j = 0; j < 4; ++j)
#pragma unroll
            for (int i = 0; i < 4; ++i) { const int k = 256 * j + 4 * F.lane + i; const f32x4 a = *(const f32x4*)(win + (size_t)k * INC + 3072), b = *(const f32x4*)(win + (size_t)k * INC + 3076);
                w8[j][i][0] = a[0]; w8[j][i][1] = a[1]; w8[j][i][2] = a[2]; w8[j][i][3] = a[3]; w8[j][i][4] = b[0]; w8[j][i][5] = b[1]; w8[j][i][6] = b[2]; w8[j][i][7] = b[3]; }
        f32x4 gn[4];
#pragma unroll
        for (int j = 0; j < 4; ++j) gn[j] = *(const f32x4*)(gain + 256 * j + 4 * F.lane);
        const f32x4 alog4 = *(const f32x4*)A.in[I_ALOG], dtb4 = *(const f32x4*)A.in[I_DTB];
        const bool hi5 = (F.lane & 32) != 0, b4 = (F.lane & 16) != 0, b3 = (F.lane & 8) != 0; const int cidx = (hi5 ? 4 : 0) + (b4 ? 2 : 0) + (b3 ? 1 : 0), c3 = cidx & 3;
        const float myea = expf(c3 == 0 ? alog4[0] : c3 == 1 ? alog4[1] : c3 == 2 ? alog4[2] : alog4[3]);
        const float mydtb = (cidx < 4) ? 0.f : (c3 == 0 ? dtb4[0] : c3 == 1 ? dtb4[1] : c3 == 2 ? dtb4[2] : dtb4[3]);
        f32x4 v[4], nv[4];
        { const int m0 = gw; if (m0 < MV) { const GAS f32x4* xr = (const GAS f32x4*)((m0 < MP) ? pXP + (size_t)m0 * DM : pXS + (size_t)(m0 - MP) * DM) + F.lane;
#pragma unroll
            for (int j = 0; j < 4; ++j) v[j] = xr[64 * j]; } }
#pragma unroll 1
        for (int m = gw; m < MR; m += NGW) {
            GAS unsigned long long* o8 = (GAS unsigned long long*)(H + (size_t)m * DM) + F.lane;
            { const int mn = m + NGW; if (mn < MV) { const GAS f32x4* xr = (const GAS f32x4*)((mn < MP) ? pXP + (size_t)mn * DM : pXS + (size_t)(mn - MP) * DM) + F.lane;
#pragma unroll
                for (int j = 0; j < 4; ++j) nv[j] = xr[64 * j]; } }
            if (m >= MV) {
#pragma unroll
                for (int j = 0; j < 4; ++j) o8[64 * j] = 0ull;
                if (F.lane < 8) BG[(size_t)m * 8 + F.lane] = 0.f;
                continue;
            }
            float s2 = 0.f;
#pragma unroll
            for (int j = 0; j < 4; ++j) s2 += (v[j][0] * v[j][0] + v[j][1] * v[j][1]) + (v[j][2] * v[j][2] + v[j][3] * v[j][3]);
            const float rstd = 1.f / sqrtf(wave_sum(s2) * (1.f / DM) + RMS_EPS);
            float p8[8];
#pragma unroll
            for (int c = 0; c < 8; ++c) p8[c] = 0.f;
#pragma unroll
            for (int j = 0; j < 4; ++j) { v[j] = v[j] * rstd * gn[j];
#pragma unroll
                for (int i = 0; i < 4; ++i)
#pragma unroll
                    for (int c = 0; c < 8; ++c) p8[c] += v[j][i] * w8[j][i][c];
                o8[64 * j] = (unsigned long long)pk2(v[j][0], v[j][1]) | ((unsigned long long)pk2(v[j][2], v[j][3]) << 32); }
            float z;
            { float r4[4], q2[2];
#pragma unroll
              for (int i = 0; i < 4; ++i) { const float send = hi5 ? p8[i] : p8[4 + i], keep = hi5 ? p8[4 + i] : p8[i]; r4[i] = keep + __shfl_xor(send, 32); }
#pragma unroll
              for (int i = 0; i < 2; ++i) { const float send = b4 ? r4[i] : r4[2 + i], keep = b4 ? r4[2 + i] : r4[i]; q2[i] = keep + __shfl_xor(send, 16); }
              { const float send = b3 ? q2[0] : q2[1], keep = b3 ? q2[1] : q2[0]; z = keep + __shfl_xor(send, 8); }
              z += __shfl_xor(z, 4); z += __shfl_xor(z, 2); z += __shfl_xor(z, 1); }
            { const float xs = z + mydtb;
              const float sp = xs > 20.f ? xs : (xs < -15.f ? __expf(xs) : __logf(1.f + __expf(xs)));
              const float val = (cidx < 4) ? __builtin_amdgcn_rcpf(1.f + __expf(-z)) : -myea * sp;
              if ((F.lane & 7) == 0) BG[(size_t)m * 8 + cidx] = val; }
#pragma unroll
            for (int j = 0; j < 4; ++j) v[j] = nv[j];
        }
    }
    {
        bf16* MN = (bf16*)(ws + WS_MEMN); const float* gain = A.in[I_NMKV];
        f32x4 gn[4];
#pragma unroll
        for (int j = 0; j < 4; ++j) gn[j] = *(const f32x4*)(gain + 256 * j + 4 * F.lane);
        for (int m = gw; m < NB * NMEM; m += NGW) {
            const GAS f32x4* xr = (const GAS f32x4*)(A.in[I_MEM] + (size_t)m * DM) + F.lane;
            f32x4 v[4]; float s2 = 0.f;
#pragma unroll
            for (int j = 0; j < 4; ++j) { v[j] = xr[64 * j]; s2 += (v[j][0] * v[j][0] + v[j][1] * v[j][1]) + (v[j][2] * v[j][2] + v[j][3] * v[j][3]); }
            const float rstd = 1.f / sqrtf(wave_sum(s2) * (1.f / DM) + RMS_EPS);
            GAS unsigned long long* o8 = (GAS unsigned long long*)(MN + (size_t)m * DM) + F.lane;
#pragma unroll
            for (int j = 0; j < 4; ++j) { v[j] = v[j] * rstd * gn[j]; o8[64 * j] = (unsigned long long)pk2(v[j][0], v[j][1]) | ((unsigned long long)pk2(v[j][2], v[j][3]) << 32); }
        }
    }
}

__device__ __forceinline__ void conv_tile(const Args& A, Frame& F, int b, int tile) {
    const bf16* PB = (const bf16*)(A.ws + WS_RA); bf16* CD = (bf16*)(A.ws + WS_RB); bf16* QC = (bf16*)(A.ws + WS_RC);
    int oz; asm volatile("v_mov_b32 %0, 0" : "=v"(oz));
    const int c = F.tid + oz; const int row0 = b * SEQ + tile * 64;
    LAS float* Y = (LAS float*)(F.lds + RING_OFF);
    {
        float w[CW];
#pragma unroll
        for (int j = 0; j < CW; ++j) w[j] = A.in[I_CONVW][j * CC + c];
        const float bias = A.in[I_CONVB][c];
        float uv[46];
        const unsigned rb = (unsigned)(b * SEQ + tile * 64);
#pragma unroll
        for (int i = 0; i < 30; ++i) { const int tk = tile * 64 - 30 + i; const unsigned tkc = tk < 0 ? 0u : (unsigned)tk; const float vv = bf2f(PB[(unsigned)(b * SEQ + tkc) * (unsigned)PBLD + (unsigned)c]); uv[i] = (tk >= 0) ? vv : 0.f; }
#pragma unroll 1
        for (int seg = 0; seg < 4; ++seg) {
#pragma unroll
            for (int i = 0; i < 16; ++i) uv[30 + i] = bf2f(PB[(rb + (unsigned)(seg * 16 + i)) * (unsigned)PBLD + (unsigned)c]);
#pragma unroll
            for (int t = 0; t < 16; ++t) { float a = bias;
#pragma unroll
                for (int j = 0; j < CW; ++j) a += w[j] * uv[t + j];
                Y[(seg * 16 + t) * CC + c] = a; }
#pragma unroll
            for (int i = 0; i < 30; ++i) uv[i] = uv[i + 16];
        }
    }
    __syncthreads();
    {
        const int ch0 = 8 * F.lane + oz;
        const f32x4 g0 = *(const f32x4*)(A.in[I_LNG] + ch0), g1 = *(const f32x4*)(A.in[I_LNG] + ch0 + 4), b0 = *(const f32x4*)(A.in[I_LNB] + ch0), b1 = *(const f32x4*)(A.in[I_LNB] + ch0 + 4);
#pragma unroll 2
        for (int tt = 0; tt < 8; ++tt) { const int t = 8 * F.wave + tt;
            f32x4 y0 = *(const LAS f32x4*)(Y + t * CC + ch0), y1 = *(const LAS f32x4*)(Y + t * CC + ch0 + 4);
            const float mean = wave_sum((y0[0] + y0[1]) + (y0[2] + y0[3]) + (y1[0] + y1[1]) + (y1[2] + y1[3])) * (1.f / CC);
            y0 = y0 - mean; y1 = y1 - mean;
            const float var = wave_sum((y0[0] * y0[0] + y0[1] * y0[1]) + (y0[2] * y0[2] + y0[3] * y0[3]) + (y1[0] * y1[0] + y1[1] * y1[1]) + (y1[2] * y1[2] + y1[3] * y1[3])) * (1.f / CC);
            const float rstd = 1.f / sqrtf(var + 1e-5f);
            y0 = y0 * rstd * g0 + b0; y1 = y1 * rstd * g1 + b1;
            float o[8];
#pragma unroll
            for (int i = 0; i < 4; ++i) { o[i] = silu(y0[i]); o[4 + i] = silu(y1[i]); }
            *(GAS v4u*)(CD + (size_t)(row0 + t) * DM + ch0) = pack8(o); }
    }
    if (tile == 31) {
        float* oc = A.out + OUT_CONVP + (size_t)b * 30 * CC;
        float tv[30];
#pragma unroll
        for (int j = 0; j < 30; ++j) tv[j] = bf2f(PB[(size_t)(b * SEQ + SEQ - 30 + j) * PBLD + c]);
        __builtin_amdgcn_sched_barrier(0);
#pragma unroll
        for (int j = 0; j < 30; ++j) oc[j * CC + c] = tv[j];
        float* os = A.out + OUT_SCP + (size_t)b * 3 * QKVN;
        float sv[9];
#pragma unroll
        for (int q = 0; q < 9; ++q) { const int e = F.tid + q * (NWAVES * 64); const int j = e / QKVN, ch = e % QKVN; sv[q] = bf2f(PB[(size_t)(b * SEQ + SEQ - 3 + j) * PBLD + 512 + ch]); }
        __builtin_amdgcn_sched_barrier(0);
#pragma unroll
        for (int q = 0; q < 9; ++q) os[F.tid + q * (NWAVES * 64)] = sv[q];
    }
    {
        const int t0 = tile * 64 + 8 * F.wave;
#pragma unroll 1
        for (int p = 0; p < 3; ++p) {
            const int ch0 = 512 * p + 8 * F.lane + oz;
            float wsc[4][8];
#pragma unroll
            for (int j = 0; j < 4; ++j) { const f32x4 a = *(const f32x4*)(A.in[I_SCW] + j * QKVN + ch0), bb = *(const f32x4*)(A.in[I_SCW] + j * QKVN + ch0 + 4);
#pragma unroll
                for (int i = 0; i < 4; ++i) { wsc[j][i] = a[i]; wsc[j][4 + i] = bb[i]; } }
            float win[3][8];
#pragma unroll
            for (int j = 0; j < 3; ++j) { const int tk = t0 - 3 + j; const int tkc = tk < 0 ? 0 : tk;
                const v4u x = *(const GAS v4u*)(PB + (size_t)(b * SEQ + tkc) * PBLD + 512 + ch0); unpack8(x, win[j]);
#pragma unroll
                for (int i = 0; i < 8; ++i) win[j][i] = (tk >= 0) ? win[j][i] : 0.f; }
#pragma unroll
            for (int tt = 0; tt < 8; ++tt) {
                float cur[8]; { const v4u x = *(const GAS v4u*)(PB + (size_t)(b * SEQ + t0 + tt) * PBLD + 512 + ch0); unpack8(x, cur); }
                float y[8]; float ss = 0.f;
#pragma unroll
                for (int i = 0; i < 8; ++i) { const float a = wsc[0][i] * win[0][i] + wsc[1][i] * win[1][i] + wsc[2][i] * win[2][i] + wsc[3][i] * cur[i]; y[i] = silu(a); ss += y[i] * y[i]; }
                if (p < 2) { ss += __shfl_xor(ss, 1); ss += __shfl_xor(ss, 2); ss += __shfl_xor(ss, 4); ss += __shfl_xor(ss, 8);
                    const float sc = (1.f / sqrtf(ss + 1e-6f)) * (p == 0 ? 0.08838834764831845f : 1.f);
#pragma unroll
                    for (int i = 0; i < 8; ++i) y[i] *= sc; }
                *(GAS v4u*)(QC + (size_t)(b * SEQ + t0 + tt) * QKVN + ch0) = pack8(y);
#pragma unroll
                for (int i = 0; i < 8; ++i) { win[0][i] = win[1][i]; win[1][i] = win[2][i]; win[2][i] = cur[i]; }
            }
        }
    }
    __syncthreads();
}
__device__ __forceinline__ void conv_sample(const Args& A, Frame& F, int s) {
    const bf16* PB = (const bf16*)(A.ws + WS_RA); bf16* CD = (bf16*)(A.ws + WS_RB); bf16* QC = (bf16*)(A.ws + WS_RC);
    const int c = F.tid; const size_t row = (size_t)MP + s;
    LAS float* Y = (LAS float*)(F.lds + RING_OFF);
    {
        const float* cache = A.in[I_CCONV] + (size_t)s * 30 * CC; float* oc = A.out + OUT_CONVS + (size_t)s * 30 * CC;
        const float us = bf2f(PB[row * PBLD + c]);
        float a = A.in[I_CONVB][c];
        float cv[30], wv[31];
#pragma unroll
        for (int j = 0; j < 30; ++j) { cv[j] = cache[j * CC + c]; wv[j] = A.in[I_CONVW][j * CC + c]; }
        wv[30] = A.in[I_CONVW][30 * CC + c];
        __builtin_amdgcn_sched_barrier(0);
#pragma unroll
        for (int j = 0; j < 30; ++j) { a += wv[j] * cv[j]; oc[j * CC + c] = (j < 29) ? cv[j + 1] : us; }
        a += wv[30] * us;
        Y[c] = a;
    }
    __syncthreads();
    if (F.wave == 7) {
        const int ch0 = 8 * F.lane;
        const f32x4 g0 = *(const f32x4*)(A.in[I_LNG] + ch0), g1 = *(const f32x4*)(A.in[I_LNG] + ch0 + 4), b0 = *(const f32x4*)(A.in[I_LNB] + ch0), b1 = *(const f32x4*)(A.in[I_LNB] + ch0 + 4);
        f32x4 y0 = *(const LAS f32x4*)(Y + ch0), y1 = *(const LAS f32x4*)(Y + ch0 + 4);
        const float mean = wave_sum((y0[0] + y0[1]) + (y0[2] + y0[3]) + (y1[0] + y1[1]) + (y1[2] + y1[3])) * (1.f / CC);
        y0 = y0 - mean; y1 = y1 - mean;
        const float var = wave_sum((y0[0] * y0[0] + y0[1] * y0[1]) + (y0[2] * y0[2] + y0[3] * y0[3]) + (y1[0] * y1[0] + y1[1] * y1[1]) + (y1[2] * y1[2] + y1[3] * y1[3])) * (1.f / CC);
        const float rstd = 1.f / sqrtf(var + 1e-5f);
        y0 = y0 * rstd * g0 + b0; y1 = y1 * rstd * g1 + b1;
        float o[8];
#pragma unroll
        for (int i = 0; i < 4; ++i) { o[i] = silu(y0[i]); o[4 + i] = silu(y1[i]); }
        *(GAS v4u*)(CD + row * DM + ch0) = pack8(o);
    }
    if (F.wave < 3) {
        const int p = F.wave; const int ch0 = 512 * p + 8 * F.lane;
        const float* st = A.in[I_SSC] + (size_t)s * 3 * QKVN; float* os = A.out + OUT_SCS + (size_t)s * 3 * QKVN;
        float win[3][8], cur[8], y[8];
#pragma unroll
        for (int j = 0; j < 3; ++j) { const f32x4 a = *(const f32x4*)(st + j * QKVN + ch0), bb = *(const f32x4*)(st + j * QKVN + ch0 + 4);
#pragma unroll
            for (int i = 0; i < 4; ++i) { win[j][i] = a[i]; win[j][4 + i] = bb[i]; } }
        { const v4u x = *(const GAS v4u*)(PB + row * PBLD + 512 + ch0); unpack8(x, cur); }
        float ss = 0.f;
#pragma unroll
        for (int i = 0; i < 8; ++i) { float a = 0.f;
#pragma unroll
            for (int j = 0; j < 3; ++j) a += A.in[I_SCW][j * QKVN + ch0 + i] * win[j][i];
            a += A.in[I_SCW][3 * QKVN + ch0 + i] * cur[i]; y[i] = silu(a); ss += y[i] * y[i]; }
        if (p < 2) { ss += __shfl_xor(ss, 1); ss += __shfl_xor(ss, 2); ss += __shfl_xor(ss, 4); ss += __shfl_xor(ss, 8);
            const float sc = (1.f / sqrtf(ss + 1e-6f)) * (p == 0 ? 0.08838834764831845f : 1.f);
#pragma unroll
            for (int i = 0; i < 8; ++i) y[i] *= sc; }
        *(GAS v4u*)(QC + row * QKVN + ch0) = pack8(y);
#pragma unroll
        for (int j = 0; j < 3; ++j) { f32x4 a, bb;
#pragma unroll
            for (int i = 0; i < 4; ++i) { a[i] = (j < 2) ? win[j + 1][i] : cur[i]; bb[i] = (j < 2) ? win[j + 1][4 + i] : cur[4 + i]; }
            *(f32x4*)(os + j * QKVN + ch0) = a; *(f32x4*)(os + j * QKVN + ch0 + 4) = bb; }
    }
    __syncthreads();
}

__device__ __forceinline__ bf16x8 lds_frag16(const LAS unsigned char* p) { return *(const LAS bf16x8*)p; }
__device__ __forceinline__ void d1_chunk(const Args& A, Frame& F, int ci) {
    using pg8::f32x4;
    const int b = ci >> 7, h = (ci >> 5) & 3, n = ci & 31; const int row0 = b * SEQ + n * 64;
    const bf16* QC = (const bf16*)(A.ws + WS_RC); const float* BG = (const float*)(A.ws + WS_BG);
    float* Ug = (float*)(A.ws + WS_U) + (size_t)ci * 8192; bf16* Wg = (bf16*)(A.ws + WS_W) + (size_t)ci * 8192; bf16* QGg = (bf16*)(A.ws + WS_QG) + (size_t)ci * 8192;
    bf16* KDTg = (bf16*)(A.ws + WS_KDT) + (size_t)ci * 8192; bf16* QKg = (bf16*)(A.ws + WS_QK) + (size_t)ci * 4096; float* GLg = (float*)(A.ws + WS_GL);
    constexpr int OFF_K = 0, OFF_Q = 17408, OFF_VBT = 34816, OFF_KBGT = 53248, OFF_L = 71680, OFF_T = 89088, OFF_GC = 98304, OFF_BETA = 98560, OFF_EG = 98816, OFF_TM = 99072, OFF_X = 116480, LS = 68;
    LAS unsigned char* L = F.lds + RING_OFF;
    LAS float* gcs = (LAS float*)(L + OFF_GC); LAS float* betas = (LAS float*)(L + OFF_BETA); LAS float* egs = (LAS float*)(L + OFF_EG); LAS float* Lm = (LAS float*)(L + OFF_L); LAS float* Tm = (LAS float*)(L + OFF_TM); LAS float* Xm = (LAS float*)(L + OFF_X);
    const int fr = F.lane & 15, fq = F.lane >> 4;
    if (F.wave == 0) {
        float g = BG[(size_t)(row0 + F.lane) * 8 + 4 + h]; const float be = BG[(size_t)(row0 + F.lane) * 8 + h];
#pragma unroll
        for (int o = 1; o < 64; o <<= 1) { const float v = __shfl_up(g, o); if (F.lane >= o) g += v; }
        gcs[F.lane] = g; betas[F.lane] = be; egs[F.lane] = __expf(g);
    }
    __syncthreads();
    {
        const int t = F.tid >> 3, part = F.tid & 7;
        const bf16* rp = QC + (size_t)(row0 + t) * QKVN + h * 128 + part * 16;
        const v4u q0 = *(const GAS v4u*)(rp), q1 = *(const GAS v4u*)(rp + 8), k0 = *(const GAS v4u*)(rp + 512), k1 = *(const GAS v4u*)(rp + 520), v0 = *(const GAS v4u*)(rp + 1024), v1 = *(const GAS v4u*)(rp + 1032);
        *(LAS v4u*)(L + OFF_K + t * 272 + part * 32) = k0; *(LAS v4u*)(L + OFF_K + t * 272 + part * 32 + 16) = k1;
        *(LAS v4u*)(L + OFF_Q + t * 272 + part * 32) = q0; *(LAS v4u*)(L + OFF_Q + t * 272 + part * 32 + 16) = q1;
        const float be = betas[t], beg = be * egs[t];
        float kf[16], vf[16];
        { float tmp[8]; unpack8(k0, tmp);
#pragma unroll
          for (int i = 0; i < 8; ++i) kf[i] = tmp[i]; unpack8(k1, tmp);
#pragma unroll
          for (int i = 0; i < 8; ++i) kf[8 + i] = tmp[i]; unpack8(v0, tmp);
#pragma unroll
          for (int i = 0; i < 8; ++i) vf[i] = tmp[i]; unpack8(v1, tmp);
#pragma unroll
          for (int i = 0; i < 8; ++i) vf[8 + i] = tmp[i]; }
#pragma unroll
        for (int i = 0; i < 16; ++i) { const int d = part * 16 + i;
            *(LAS unsigned short*)(L + OFF_VBT + d * 144 + t * 2) = (unsigned short)(pk2(vf[i] * be, 0.f) & 0xffffu);
            *(LAS unsigned short*)(L + OFF_KBGT + d * 144 + t * 2) = (unsigned short)(pk2(kf[i] * beg, 0.f) & 0xffffu); }
    }
    __syncthreads();
#pragma unroll 1
    for (int x = 0; x < 4; ++x) {
        const int tile = F.wave * 4 + x, which = tile >> 4, ti = (tile >> 2) & 3, tj = tile & 3;
        f32x4 acc = (f32x4){0.f, 0.f, 0.f, 0.f};
        if (ti >= tj) {
            const LAS unsigned char* ap = L + (which ? OFF_Q : OFF_K) + (ti * 16 + fr) * 272 + fq * 16; const LAS unsigned char* bp = L + OFF_K + (tj * 16 + fr) * 272 + fq * 16;
#pragma unroll
            for (int kk = 0; kk < 4; ++kk) acc = __builtin_amdgcn_mfma_f32_16x16x32_bf16(lds_frag16(ap + kk * 64), lds_frag16(bp + kk * 64), acc, 0, 0, 0);
        }
        const int j = tj * 16 + fr; const float gj = gcs[j];
#pragma unroll
        for (int r = 0; r < 4; ++r) { const int i = ti * 16 + 4 * fq + r; const float dec = __expf(gcs[i] - gj);
            if (which == 0) Lm[i * LS + j] = (i > j) ? betas[i] * acc[r] * dec : 0.f;
            else QKg[i * 64 + j] = (bf16)(pk2((i >= j) ? acc[r] * dec : 0.f, 0.f) & 0xffffu); }
    }
    __syncthreads();
    for (int e = F.tid; e < 64 * LS; e += NWAVES * 64) Tm[e] = 0.f;
    __syncthreads();
    if (F.wave == 0) {
        const LAS float* Lb = Lm + (16 * fq) * LS + 16 * fq;
        float t[16];
#pragma unroll
        for (int i = 0; i < 16; ++i) {
            float a0 = 0.f, a1 = 0.f, a2 = 0.f, a3 = 0.f;
#pragma unroll
            for (int j4 = 0; j4 < (i + 3) / 4; ++j4) { const f32x4 lv = *(const LAS f32x4*)(Lb + i * LS + 4 * j4);
                if (4 * j4 + 0 < i) a0 += lv[0] * t[4 * j4 + 0]; if (4 * j4 + 1 < i) a1 += lv[1] * t[4 * j4 + 1]; if (4 * j4 + 2 < i) a2 += lv[2] * t[4 * j4 + 2]; if (4 * j4 + 3 < i) a3 += lv[3] * t[4 * j4 + 3]; }
            t[i] = ((fr == i) ? 1.f : 0.f) - ((a0 + a1) + (a2 + a3));
        }
#pragma unroll
        for (int i = 0; i < 16; ++i) Tm[(16 * fq + i) * LS + 16 * fq + fr] = t[i];
    } else {
        const int lt = F.tid - 64; const float gl = gcs[63];
        for (int cix = lt; cix < 1024; cix += 448) {
            const int t = cix >> 4, cc = cix & 15; const v4u x = *(const LAS v4u*)(L + OFF_Q + t * 272 + cc * 16); float f[8]; unpack8(x, f); const float e = egs[t];
#pragma unroll
            for (int i = 0; i < 8; ++i) f[i] *= e;
            *(GAS v4u*)(QGg + t * 128 + cc * 8) = pack8(f); }
        for (int cix = lt; cix < 1024; cix += 448) {
            const int dk = cix >> 3, t0 = (cix & 7) * 8; float f[8];
#pragma unroll
            for (int i = 0; i < 8; ++i) f[i] = bf2f(*(const LAS unsigned short*)(L + OFF_K + (t0 + i) * 272 + dk * 2)) * __expf(gl - gcs[t0 + i]);
            *(GAS v4u*)(KDTg + dk * 64 + t0) = pack8(f); }
        if (lt == 0) GLg[ci] = __expf(gl);
    }
    __syncthreads();
    if (F.wave < 2) {
        const int pp = F.wave, rb = 16 * (2 * pp + 1), cb = 16 * (2 * pp); f32x4 acc = (f32x4){0.f, 0.f, 0.f, 0.f};
#pragma unroll
        for (int kk = 0; kk < 4; ++kk) acc = __builtin_amdgcn_mfma_f32_16x16x4f32(Lm[(rb + fr) * LS + cb + 4 * kk + fq], Tm[(cb + 4 * kk + fq) * LS + cb + fr], acc, 0, 0, 0);
#pragma unroll
        for (int r = 0; r < 4; ++r) Xm[pp * 576 + (4 * fq + r) * 36 + fr] = acc[r];
    }
    __syncthreads();
    if (F.wave < 2) {
        const int pp = F.wave, rb = 16 * (2 * pp + 1), cb = 16 * (2 * pp); f32x4 acc = (f32x4){0.f, 0.f, 0.f, 0.f};
#pragma unroll
        for (int kk = 0; kk < 4; ++kk) acc = __builtin_amdgcn_mfma_f32_16x16x4f32(Tm[(rb + fr) * LS + rb + 4 * kk + fq], Xm[pp * 576 + (4 * kk + fq) * 36 + fr], acc, 0, 0, 0);
#pragma unroll
        for (int r = 0; r < 4; ++r) Tm[(rb + 4 * fq + r) * LS + cb + fr] = -acc[r];
    }
    __syncthreads();
    if (F.wave < 4) {
        const int bi = F.wave >> 1, bj = F.wave & 1; f32x4 acc = (f32x4){0.f, 0.f, 0.f, 0.f};
#pragma unroll
        for (int kk = 0; kk < 8; ++kk) acc = __builtin_amdgcn_mfma_f32_16x16x4f32(Lm[(32 + 16 * bi + fr) * LS + 4 * kk + fq], Tm[(4 * kk + fq) * LS + 16 * bj + fr], acc, 0, 0, 0);
#pragma unroll
        for (int r = 0; r < 4; ++r) Xm[(16 * bi + 4 * fq + r) * 36 + 16 * bj + fr] = acc[r];
    }
    __syncthreads();
    if (F.wave < 4) {
        const int bi = F.wave >> 1, bj = F.wave & 1; f32x4 acc = (f32x4){0.f, 0.f, 0.f, 0.f};
#pragma unroll
        for (int kk = 0; kk < 8; ++kk) acc = __builtin_amdgcn_mfma_f32_16x16x4f32(Tm[(32 + 16 * bi + fr) * LS + 32 + 4 * kk + fq], Xm[(4 * kk + fq) * 36 + 16 * bj + fr], acc, 0, 0, 0);
#pragma unroll
        for (int r = 0; r < 4; ++r) Tm[(32 + 16 * bi + 4 * fq + r) * LS + 16 * bj + fr] = -acc[r];
    }
    __syncthreads();
    {
        const int i = F.tid >> 3, j0 = (F.tid & 7) * 8; const f32x4 a = *(const LAS f32x4*)(Tm + i * LS + j0), bq = *(const LAS f32x4*)(Tm + i * LS + j0 + 4);
        v4u w; w.x = pk2(a[0], a[1]); w.y = pk2(a[2], a[3]); w.z = pk2(bq[0], bq[1]); w.w = pk2(bq[2], bq[3]);
        *(LAS v4u*)(L + OFF_T + i * 144 + j0 * 2) = w;
    }
    __syncthreads();
#pragma unroll 1
    for (int x = 0; x < 8; ++x) {
        const int tile = F.wave * 8 + x, which = tile >> 5, ti = (tile >> 3) & 3, td = tile & 7;
        const LAS unsigned char* ap = L + OFF_T + (ti * 16 + fr) * 144 + fq * 16; const LAS unsigned char* bp = L + (which ? OFF_KBGT : OFF_VBT) + (td * 16 + fr) * 144 + fq * 16;
        f32x4 acc = (f32x4){0.f, 0.f, 0.f, 0.f};
#pragma unroll
        for (int kk = 0; kk < 2; ++kk) acc = __builtin_amdgcn_mfma_f32_16x16x32_bf16(lds_frag16(ap + kk * 64), lds_frag16(bp + kk * 64), acc, 0, 0, 0);
        const int d = td * 16 + fr;
#pragma unroll
        for (int r = 0; r < 4; ++r) { const int i = ti * 16 + 4 * fq + r;
            if (which == 0) Ug[i * 128 + d] = acc[r]; else Wg[i * 128 + d] = (bf16)(pk2(acc[r], 0.f) & 0xffffu); }
    }
    __syncthreads();
}

constexpr int SC_OW = 0, SC_OQG = 16384, SC_OKDT = 32768, SC_OQK = 49152, SC_OU = 57344, SC_BUF = 61440;
__device__ __forceinline__ void scan_issue(const Args& A, Frame& F, int ci, int sl, LAS unsigned char* dst) {
    const unsigned char* Wg = A.ws + WS_W + (size_t)ci * 16384; const unsigned char* QGg = A.ws + WS_QG + (size_t)ci * 16384;
    const unsigned char* KDTg = A.ws + WS_KDT + (size_t)ci * 16384; const unsigned char* QKg = A.ws + WS_QK + (size_t)ci * 8192; const unsigned char* Ug = A.ws + WS_U + (size_t)ci * 32768 + sl * 64;
#pragma unroll
    for (int j = 0; j < 9; ++j) {
        const int pi = (F.wave - 1) + 7 * j;
        if (pi < 60) {
            const unsigned char* src;
            if (pi < 32) { const int i = (pi & 15) * 64 + F.lane, r = i >> 4, c = (i & 15) ^ (r & 15); src = (pi < 16 ? Wg : QGg) + r * 256 + c * 16; }
            else if (pi < 56) { const int i = (pi < 48 ? pi - 32 : pi - 48) * 64 + F.lane, r = i >> 3, c = (i & 7) ^ ((r >> 1) & 7); src = (pi < 48 ? KDTg : QKg) + r * 128 + c * 16; }
            else { const int i = (pi - 56) * 64 + F.lane, r = i >> 2, c = i & 3; src = Ug + r * 512 + c * 16; }
            __builtin_amdgcn_global_load_lds((const unsigned*)src, (LAS unsigned*)(dst + pi * 1024), 16, 0, 0);
        }
    }
}
__device__ __forceinline__ bf16x8 frag2(const LAS unsigned char* p0, const LAS unsigned char* p1) { const v2u lo = *(const LAS v2u*)p0, hi = *(const LAS v2u*)p1; v4u w; w.x = lo.x; w.y = lo.y; w.z = hi.x; w.w = hi.y; return __builtin_bit_cast(bf16x8, w); }
__device__ __forceinline__ bf16x8 frag256(const LAS unsigned char* tile, int row, int kstep, int fq) { const int c = 4 * kstep + (fq >> 1), sw = row & 15; const LAS unsigned char* rp = tile + row * 256 + 8 * (fq & 1); return frag2(rp + ((c ^ sw) << 4), rp + (((c + 2) ^ sw) << 4)); }
__device__ __forceinline__ bf16x8 frag128(const LAS unsigned char* tile, int row, int kstep, int fq) { const int c = 4 * kstep + (fq >> 1), sw = (row >> 1) & 7; const LAS unsigned char* rp = tile + row * 128 + 8 * (fq & 1); return frag2(rp + ((c ^ sw) << 4), rp + (((c + 2) ^ sw) << 4)); }
__device__ __forceinline__ bf16x8 pack_pair(const pg8::f32x4& a, const pg8::f32x4& b) { v4u w; w.x = pk2(a[0], a[1]); w.y = pk2(a[2], a[3]); w.z = pk2(b[0], b[1]); w.w = pk2(b[2], b[3]); return __builtin_bit_cast(bf16x8, w); }
__device__ __forceinline__ void scan_unit(const Args& A, Frame& F, int b, int h, int sl) {
    using pg8::f32x4;
    LAS unsigned char* L = F.lds + RING_OFF;
    const int ci0 = (b * NH + h) * 32; const int fr = F.lane & 15, fq = F.lane >> 4;
    float* Og = (float*)(A.ws + WS_RE); const float* GLg = (const float*)(A.ws + WS_GL);
    if (F.wave > 0) { scan_issue(A, F, ci0, sl, L); scan_issue(A, F, ci0 + 1, sl, L + SC_BUF); asm volatile("s_waitcnt vmcnt(9)" ::: "memory"); }
    __builtin_amdgcn_s_barrier(); asm volatile("" ::: "memory");
    f32x4 S[8];
#pragma unroll
    for (int i = 0; i < 8; ++i) S[i] = (f32x4){0.f, 0.f, 0.f, 0.f};
    float gl = GLg[ci0];
#pragma unroll 1
    for (int n = 0; n < 32; ++n) {
        if (F.wave == 0) {
            const LAS unsigned char* B = L + (n & 1) * SC_BUF;
            const float gln = GLg[ci0 + (n < 31 ? n + 1 : n)];
            bf16x8 Sb[4];
#pragma unroll
            for (int kk = 0; kk < 4; ++kk) Sb[kk] = pack_pair(S[2 * kk], S[2 * kk + 1]);
            f32x4 vn[4];
#pragma unroll
            for (int tb = 0; tb < 4; ++tb) { f32x4 p1 = (f32x4){0.f, 0.f, 0.f, 0.f};
#pragma unroll
                for (int kk = 0; kk < 4; ++kk) p1 = __builtin_amdgcn_mfma_f32_16x16x32_bf16(frag256(B + SC_OW, 16 * tb + fr, kk, fq), Sb[kk], p1, 0, 0, 0);
#pragma unroll
                for (int r = 0; r < 4; ++r) vn[tb][r] = *(const LAS float*)(B + SC_OU + (16 * tb + 4 * fq + r) * 64 + fr * 4) - p1[r]; }
            bf16x8 Vb[2]; Vb[0] = pack_pair(vn[0], vn[1]); Vb[1] = pack_pair(vn[2], vn[3]);
            const size_t orow = (size_t)(b * SEQ + n * 64);
#pragma unroll
            for (int blk = 0; blk < 8; ++blk) { f32x4 s = S[blk] * gl;
#pragma unroll
                for (int kt = 0; kt < 2; ++kt) s = __builtin_amdgcn_mfma_f32_16x16x32_bf16(frag128(B + SC_OKDT, 16 * blk + fr, kt, fq), Vb[kt], s, 0, 0, 0);
                S[blk] = s; }
#pragma unroll
            for (int tb = 0; tb < 4; ++tb) { f32x4 o = (f32x4){0.f, 0.f, 0.f, 0.f};
#pragma unroll
                for (int kk = 0; kk < 4; ++kk) o = __builtin_amdgcn_mfma_f32_16x16x32_bf16(frag256(B + SC_OQG, 16 * tb + fr, kk, fq), Sb[kk], o, 0, 0, 0);
#pragma unroll
                for (int kt = 0; kt < 2; ++kt) o = __builtin_amdgcn_mfma_f32_16x16x32_bf16(frag128(B + SC_OQK, 16 * tb + fr, kt, fq), Vb[kt], o, 0, 0, 0);
#pragma unroll
                for (int r = 0; r < 4; ++r) Og[(orow + 16 * tb + 4 * fq + r) * 512 + h * 128 + sl * 16 + fr] = o[r]; }
            gl = gln;
            asm volatile("s_waitcnt lgkmcnt(0)" ::: "memory");
        } else {
            asm volatile("s_waitcnt vmcnt(0)" ::: "memory");
        }
        __builtin_amdgcn_s_barrier(); asm volatile("" ::: "memory");
        if (F.wave > 0 && n + 2 < 32) scan_issue(A, F, ci0 + n + 2, sl, L + (n & 1) * SC_BUF);
    }
    if (F.wave == 0) {
        float* od = A.out + OUT_DLP + (size_t)(b * NH + h) * DKV * DKV;
#pragma unroll
        for (int blk = 0; blk < 8; ++blk)
#pragma unroll
            for (int r = 0; r < 4; ++r) od[(16 * blk + 4 * fq + r) * DKV + sl * 16 + fr] = S[blk][r];
    }
    asm volatile("s_waitcnt vmcnt(0) lgkmcnt(0)" ::: "memory"); __builtin_amdgcn_s_barrier(); asm volatile("" ::: "memory");
}
__device__ __forceinline__ void delta_sample_seq(const Args& A, Frame& F, int s) {
    const bf16* QC = (const bf16*)(A.ws + WS_RC); const float* BG = (const float*)(A.ws + WS_BG); float* Og = (float*)(A.ws + WS_RE);
    const size_t row = (size_t)MP + s;
    LAS float* qs = (LAS float*)(F.lds + RING_OFF); LAS float* ks = qs + 128; LAS float* red = qs + 256;
    const int dv = F.tid & 127, grp = F.tid >> 7;
    const float* S0b = A.in[I_SDELTA] + (size_t)s * NH * DKV * DKV + (size_t)(grp * 32) * DKV + dv; float* Sob = A.out + OUT_DLS + (size_t)s * NH * DKV * DKV + (size_t)(grp * 32) * DKV + dv;
    float s0[32], s1[32];
#pragma unroll
    for (int i = 0; i < 32; ++i) s0[i] = S0b[(size_t)i * DKV];
#pragma unroll 1
    for (int h = 0; h < NH; ++h) {
        if (h + 1 < NH) {
#pragma unroll
            for (int i = 0; i < 32; ++i) s1[i] = S0b[(size_t)(h + 1) * DKV * DKV + (size_t)i * DKV]; }
        if (F.tid < 128) { qs[F.tid] = bf2f(QC[row * QKVN + h * 128 + F.tid]); ks[F.tid] = bf2f(QC[row * QKVN + 512 + h * 128 + F.tid]); }
        const float v = bf2f(QC[row * QKVN + 1024 + h * 128 + dv]);
        const float beta = BG[row * 8 + h], eg = __expf(BG[row * 8 + 4 + h]);
        __syncthreads();
        float part = 0.f;
#pragma unroll
        for (int i = 0; i < 32; ++i) part += ks[grp * 32 + i] * s0[i];
        red[grp * 128 + dv] = part;
        __syncthreads();
        const float kS = (red[dv] + red[128 + dv]) + (red[256 + dv] + red[384 + dv]);
        const float vnew = beta * (v - eg * kS);
        __syncthreads();
        float po = 0.f;
#pragma unroll
        for (int i = 0; i < 32; ++i) { const float sn = eg * s0[i] + ks[grp * 32 + i] * vnew; Sob[(size_t)h * DKV * DKV + (size_t)i * DKV] = sn; po += qs[grp * 32 + i] * sn; }
        red[grp * 128 + dv] = po;
        __syncthreads();
        if (F.tid < 128) Og[row * 512 + h * 128 + dv] = (red[dv] + red[128 + dv]) + (red[256 + dv] + red[384 + dv]);
        __syncthreads();
#pragma unroll
        for (int i = 0; i < 32; ++i) s0[i] = s1[i];
    }
}

__device__ __forceinline__ void ogate_row(const Args& A, Frame& F, int m, const pg8::f32x4& n0, const pg8::f32x4& n1) {
    const bf16* PB = (const bf16*)(A.ws + WS_RA); bf16* CD = (bf16*)(A.ws + WS_RB); const float* Og = (const float*)(A.ws + WS_RE); const int ch0 = 8 * F.lane;
    const f32x4 o0 = *(const GAS f32x4*)(Og + (size_t)m * 512 + ch0), o1 = *(const GAS f32x4*)(Og + (size_t)m * 512 + ch0 + 4);
    const v4u zz = *(const GAS v4u*)(PB + (size_t)m * PBLD + 2048 + ch0); float z[8]; unpack8(zz, z);
    float ss = (o0[0] * o0[0] + o0[1] * o0[1]) + (o0[2] * o0[2] + o0[3] * o0[3]) + (o1[0] * o1[0] + o1[1] * o1[1]) + (o1[2] * o1[2] + o1[3] * o1[3]);
    ss += __shfl_xor(ss, 1); ss += __shfl_xor(ss, 2); ss += __shfl_xor(ss, 4); ss += __shfl_xor(ss, 8);
    const float rstd = 1.f / sqrtf(ss * (1.f / 128.f) + RMS_EPS);
    float d[8];
#pragma unroll
    for (int i = 0; i < 4; ++i) { d[i] = o0[i] * rstd * n0[i] * silu(z[i]); d[4 + i] = o1[i] * rstd * n1[i] * silu(z[4 + i]); }
    *(GAS v4u*)(CD + (size_t)m * DM + 512 + ch0) = pack8(d);
}
__device__ __forceinline__ void ogate_phase(const Args& A, Frame& F, int blk, int nblk) {
    const int gw = blk * NWAVES + F.wave, NGW = nblk * NWAVES; const int ch0 = 8 * F.lane;
    const f32x4 n0 = *(const f32x4*)(A.in[I_DNN] + (ch0 & 127)), n1 = *(const f32x4*)(A.in[I_DNN] + (ch0 & 127) + 4);
    for (int m = gw; m < MP; m += NGW) ogate_row(A, F, m, n0, n1);
}
__device__ __forceinline__ void sample_mixer(const Args& A, Frame& F, int s) {
    conv_sample(A, F, s);
    VM_WAIT(); __syncthreads();
    delta_sample_seq(A, F, s);
    VM_WAIT(); __syncthreads();
    if (F.wave == 0) { const int ch0 = 8 * F.lane; const f32x4 n0 = *(const f32x4*)(A.in[I_DNN] + (ch0 & 127)), n1 = *(const f32x4*)(A.in[I_DNN] + (ch0 & 127) + 4); ogate_row(A, F, MP + s, n0, n1); }
}

__device__ __forceinline__ void attn_issue(const Args& A, Frame& F, int st, int b, int h, LAS unsigned char* slot) {
    const bf16* KB = (const bf16*)(A.ws + WS_KB); const bf16* VT = (const bf16*)(A.ws + WS_VT);
#pragma unroll
    for (int it = 0; it < 4; ++it) {
        const int idx = it * 512 + F.tid; const bf16* src;
        if (st < 4) { const int r = idx >> 5, p = idx & 31, c = p ^ (r & 15); src = KB + (size_t)(b * NMEM + 64 * st + r) * DM + h * MHD + 8 * c; }
        else { const int r = idx >> 3, p = idx & 7, c = p ^ ((r >> 1) & 7); src = VT + (size_t)(h * MHD + r) * (NB * NMEM) + b * NMEM + 64 * (st - 4) + 8 * c; }
        __builtin_amdgcn_global_load_lds((const unsigned*)src, (LAS unsigned*)(slot + it * 8192 + F.wave * 1024), 16, 0, 0);
    }
}
__device__ __forceinline__ void attn_unit(const Args& A, Frame& F, int rt, int h) {
    using pg8::f32x4;
    const int b = rt >> 4; const int fr = F.lane & 15, fq = F.lane >> 4;
    const bf16* Q = (const bf16*)(A.ws + WS_RB); bf16* AO = (bf16*)(A.ws + WS_RE);
    const size_t qoff = (size_t)(rt * 128 + F.wave * 16 + fr) * DM + h * MHD;
    const bf16* qrow = Q + qoff; bf16* orow = AO + qoff;
    LAS unsigned char* L = F.lds + RING_OFF;
    bf16x8 qf[8];
#pragma unroll
    for (int ks = 0; ks < 8; ++ks) qf[ks] = *(const GAS bf16x8*)(qrow + 32 * ks + 8 * fq);
    attn_issue(A, F, 0, b, h, L); attn_issue(A, F, 1, b, h, L + 32768);
    f32x4 sacc[16];
#pragma unroll
    for (int st = 0; st < 4; ++st) {
        asm volatile("s_waitcnt vmcnt(4)" ::: "memory");
        __builtin_amdgcn_s_barrier(); asm volatile("" ::: "memory");
        attn_issue(A, F, st + 2, b, h, L + ((st + 2) & 3) * 32768);
        const LAS unsigned char* slot = L + (st & 3) * 32768;
#pragma unroll
        for (int kbl = 0; kbl < 4; ++kbl) { f32x4 acc = (f32x4){0.f, 0.f, 0.f, 0.f}; const int row = 16 * kbl + fr;
#pragma unroll
            for (int ks = 0; ks < 8; ++ks) { const bf16x8 a = *(const LAS bf16x8*)(slot + row * 512 + (((4 * ks + fq) ^ (row & 15)) << 4)); acc = __builtin_amdgcn_mfma_f32_16x16x32_bf16(a, qf[ks], acc, 0, 0, 0); }
            sacc[4 * st + kbl] = acc; }
    }
    float mx = -3.0e38f;
#pragma unroll
    for (int kb = 0; kb < 16; ++kb)
#pragma unroll
        for (int i = 0; i < 4; ++i) mx = fmaxf(mx, sacc[kb][i]);
    mx = fmaxf(mx, __shfl_xor(mx, 16)); mx = fmaxf(mx, __shfl_xor(mx, 32));
    float lsum = 0.f; bf16x8 pb[8];
#pragma unroll
    for (int kb = 0; kb < 16; ++kb)
#pragma unroll
        for (int i = 0; i < 4; ++i) { const float p = __builtin_amdgcn_exp2f(sacc[kb][i] - mx); sacc[kb][i] = p; lsum += p; }
#pragma unroll
    for (int s = 0; s < 8; ++s) pb[s] = pack_pair(sacc[2 * s], sacc[2 * s + 1]);
    lsum += __shfl_xor(lsum, 16); lsum += __shfl_xor(lsum, 32);
    f32x4 oacc[16];
#pragma unroll
    for (int db = 0; db < 16; ++db) oacc[db] = (f32x4){0.f, 0.f, 0.f, 0.f};
#pragma unroll
    for (int st = 4; st < 8; ++st) {
        if (st + 1 < 8) asm volatile("s_waitcnt vmcnt(4)" ::: "memory"); else asm volatile("s_waitcnt vmcnt(0)" ::: "memory");
        __builtin_amdgcn_s_barrier(); asm volatile("" ::: "memory");
        if (st + 2 < 8) attn_issue(A, F, st + 2, b, h, L + ((st + 2) & 3) * 32768);
        const LAS unsigned char* slot = L + (st & 3) * 32768; const int t = st - 4;
#pragma unroll
        for (int db = 0; db < 16; ++db) { const int row = 16 * db + fr; const int sw = (row >> 1) & 7;
#pragma unroll
            for (int s2 = 0; s2 < 2; ++s2) { const int c = 4 * s2 + (fq >> 1);
                const v2u lo = *(const LAS v2u*)(slot + row * 128 + ((c ^ sw) << 4) + 8 * (fq & 1)), hi = *(const LAS v2u*)(slot + row * 128 + (((c + 2) ^ sw) << 4) + 8 * (fq & 1));
                v4u aw; aw.x = lo.x; aw.y = lo.y; aw.z = hi.x; aw.w = hi.y;
                oacc[db] = __builtin_amdgcn_mfma_f32_16x16x32_bf16(__builtin_bit_cast(bf16x8, aw), pb[2 * t + s2], oacc[db], 0, 0, 0); } }
    }
    const float inv = 1.f / lsum;
#pragma unroll
    for (int db = 0; db < 16; ++db) { v2u w; w.x = pk2(oacc[db][0] * inv, oacc[db][1] * inv); w.y = pk2(oacc[db][2] * inv, oacc[db][3] * inv); *(GAS v2u*)(orow + 16 * db + 4 * fq) = w; }
    LDS_WAIT(); __builtin_amdgcn_s_barrier(); asm volatile("" ::: "memory");
}
__device__ __forceinline__ void attn_sample(const Args& A, Frame& F, int s, int h) {
    const bf16* qrow = (const bf16*)(A.ws + WS_RB) + (size_t)(MP + s) * DM + h * MHD; bf16* orow = (bf16*)(A.ws + WS_RE) + (size_t)(MP + s) * DM + h * MHD;
    const float* Kc = A.in[I_CMK] + (size_t)s * NMEM * DM + h * MHD; const float* Vc = A.in[I_CMV] + (size_t)s * NMEM * DM + h * MHD;
    LAS float* pl = (LAS float*)(F.lds + RING_OFF); LAS float* wred = pl + 256; LAS float* ored = pl + 512;
    float q[4]; { const v2u x = *(const GAS v2u*)(qrow + 4 * F.lane); q[0] = bflo(x.x); q[1] = bfhi(x.x); q[2] = bflo(x.y); q[3] = bfhi(x.y); }
    float myscore = 0.f;
#pragma unroll 8
    for (int i = 0; i < 32; ++i) { const f32x4 kv = *(const GAS f32x4*)(Kc + (size_t)(32 * F.wave + i) * DM + 4 * F.lane);
        const float d = wave_sum((kv[0] * q[0] + kv[1] * q[1]) + (kv[2] * q[2] + kv[3] * q[3])); if (F.lane == i) myscore = d; }
    float m = wave_max(F.lane < 32 ? myscore : -3.0e38f);
    if (F.lane == 0) wred[F.wave] = m;
    __syncthreads();
    float gm = wred[0];
#pragma unroll
    for (int i = 1; i < 8; ++i) gm = fmaxf(gm, wred[i]);
    const float p = (F.lane < 32) ? __builtin_amdgcn_exp2f(myscore - gm) : 0.f;
    if (F.lane < 32) pl[32 * F.wave + F.lane] = p;
    const float ws_ = wave_sum(p);
    if (F.lane == 0) wred[8 + F.wave] = ws_;
    __syncthreads();
    float tot = 0.f;
#pragma unroll
    for (int i = 0; i < 8; ++i) tot += wred[8 + i];
    f32x4 acc = (f32x4){0.f, 0.f, 0.f, 0.f};
#pragma unroll 8
    for (int i = 0; i < 32; ++i) { const f32x4 vv = *(const GAS f32x4*)(Vc + (size_t)(32 * F.wave + i) * DM + 4 * F.lane); const float pi = pl[32 * F.wave + i]; acc = acc + vv * pi; }
    *(LAS f32x4*)(ored + F.wave * 256 + 4 * F.lane) = acc;
    __syncthreads();
    if (F.tid < 256) { float o = 0.f;
#pragma unroll
        for (int w = 0; w < 8; ++w) o += ored[w * 256 + F.tid];
        orow[F.tid] = (bf16)(pk2(o / tot, 0.f) & 0xffffu); }
    __syncthreads();
}


typedef unsigned v2u_ __attribute__((ext_vector_type(2)));
template <int NKS, class Epi>
__device__ __forceinline__ void small_gemm_item(const Frame& F, const bf16* Arow0, const bf16* Bt, int pn, int j, int rq, const Epi& E) {
    using pg8::f32x4;
    constexpr int K = NKS * 256;
    const int fr = F.lane & 15, fq = F.lane >> 4;
    const bf16* ap = Arow0 + (size_t)(32 * rq + fr) * K + F.wave * (K / 8) + 8 * fq;
    const bf16* b0 = Bt + (size_t)(256 * pn + 16 * j + fr) * K + F.wave * (K / 8) + 8 * fq; const bf16* b1 = b0 + (size_t)128 * K;
    bf16x8 a0[NKS], a1[NKS], x0[NKS], x1[NKS];
#pragma unroll
    for (int u = 0; u < NKS; ++u) { a0[u] = *(const GAS bf16x8*)(ap + 32 * u); a1[u] = *(const GAS bf16x8*)(ap + (size_t)16 * K + 32 * u); x0[u] = *(const GAS bf16x8*)(b0 + 32 * u); x1[u] = *(const GAS bf16x8*)(b1 + 32 * u); }
    __builtin_amdgcn_sched_barrier(0);
    f32x4 c00 = (f32x4){0.f, 0.f, 0.f, 0.f}, c01 = c00, c10 = c00, c11 = c00;
#pragma unroll
    for (int u = 0; u < NKS; ++u) {
        c00 = __builtin_amdgcn_mfma_f32_16x16x32_bf16(x0[u], a0[u], c00, 0, 0, 0); c01 = __builtin_amdgcn_mfma_f32_16x16x32_bf16(x1[u], a0[u], c01, 0, 0, 0);
        c10 = __builtin_amdgcn_mfma_f32_16x16x32_bf16(x0[u], a1[u], c10, 0, 0, 0); c11 = __builtin_amdgcn_mfma_f32_16x16x32_bf16(x1[u], a1[u], c11, 0, 0, 0);
    }
    LAS f32x4* red = (LAS f32x4*)(F.lds + RING_OFF);
    red[(F.wave * 4 + 0) * 64 + F.lane] = c00; red[(F.wave * 4 + 1) * 64 + F.lane] = c01; red[(F.wave * 4 + 2) * 64 + F.lane] = c10; red[(F.wave * 4 + 3) * 64 + F.lane] = c11;
    __syncthreads();
    if (F.wave < 2) {
        f32x4 sA = (f32x4){0.f, 0.f, 0.f, 0.f}, sB = sA;
#pragma unroll
        for (int w = 0; w < 8; ++w) { sA = sA + red[(w * 4 + 2 * F.wave) * 64 + F.lane]; sB = sB + red[(w * 4 + 2 * F.wave + 1) * 64 + F.lane]; }
        E(32 * rq + 16 * F.wave + fr, pn, j, fq, sA, sB);
    }
    __syncthreads();
}
__device__ __forceinline__ v2u_ pk4(const pg8::f32x4& a) { v2u_ w; w.x = pk2(a[0], a[1]); w.y = pk2(a[2], a[3]); return w; }
struct SEpiIn { bf16* PBs;
    __device__ __forceinline__ void operator()(int m, int pn, int j, int fq, const pg8::f32x4& a, const pg8::f32x4& b) const {
        if (pn < 4) { pg8::f32x4 v;
#pragma unroll
            for (int i = 0; i < 4; ++i) v[i] = a[i] * sigm(b[i]);
            *(GAS v2u_*)(PBs + (size_t)m * PBLD + 128 * pn + 16 * j + 4 * fq) = pk4(v); }
        else { bf16* rp = PBs + (size_t)m * PBLD + 256 * pn - 512 + 16 * j + 4 * fq; *(GAS v2u_*)rp = pk4(a); *(GAS v2u_*)(rp + 128) = pk4(b); }
    } };
template <bool WRITE_BF> struct SEpiRes { const float* base; float* out; bf16* outb; float* ss;
    __device__ __forceinline__ void operator()(int m, int pn, int j, int fq, const pg8::f32x4& a, const pg8::f32x4& b) const {
        const size_t off = (size_t)m * DM + 256 * pn + 16 * j + 4 * fq;
        const pg8::f32x4 v0 = a + *(const GAS pg8::f32x4*)(base + off), v1 = b + *(const GAS pg8::f32x4*)(base + off + 128);
        *(GAS pg8::f32x4*)(out + off) = v0; *(GAS pg8::f32x4*)(out + off + 128) = v1;
        if (WRITE_BF) { *(GAS v2u_*)(outb + off) = pk4(v0); *(GAS v2u_*)(outb + off + 128) = pk4(v1); }
        float s = (v0[0] * v0[0] + v0[1] * v0[1]) + (v0[2] * v0[2] + v0[3] * v0[3]) + (v1[0] * v1[0] + v1[1] * v1[1]) + (v1[2] * v1[2] + v1[3] * v1[3]);
        s += __shfl_xor(s, 16); s += __shfl_xor(s, 32);
        if (fq == 0) atomicAdd(ss + m, s);
    } };
struct SEpiQ { bf16* Qs; const float* ss; float c2;
    __device__ __forceinline__ void operator()(int m, int pn, int j, int fq, const pg8::f32x4& a, const pg8::f32x4& b) const {
        const float rs = __builtin_amdgcn_rsqf(ss[m] * (1.f / 1024.f) + RMS_EPS) * c2; bf16* rp = Qs + (size_t)m * DM + 256 * pn + 16 * j + 4 * fq;
        *(GAS v2u_*)rp = pk4(a * rs); *(GAS v2u_*)(rp + 128) = pk4(b * rs);
    } };
struct SEpiGU { bf16* Ts; const float* ss;
    __device__ __forceinline__ void operator()(int m, int pn, int j, int fq, const pg8::f32x4& a, const pg8::f32x4& b) const {
        const float rs = __builtin_amdgcn_rsqf(ss[m] * (1.f / 1024.f) + RMS_EPS); pg8::f32x4 v;
#pragma unroll
        for (int i = 0; i < 4; ++i) v[i] = silu(a[i] * rs) * (b[i] * rs);
        *(GAS v2u_*)(Ts + (size_t)m * DFF + 128 * pn + 16 * j + 4 * fq) = pk4(v);
    } };

__device__ __forceinline__ void final_norm_phase(const Args& A, Frame& F) {
    const int gw = F.vcu * NWAVES + F.wave, NGW = F.G * NWAVES; const float* ss = (const float*)(F.ctl + CW_SS3);
    f32x4 gn[4];
#pragma unroll
    for (int j = 0; j < 4; ++j) gn[j] = *(const f32x4*)(A.in[I_NF] + 256 * j + 4 * F.lane);
    for (int m = MP + gw; m < MV; m += NGW) {
        GAS f32x4* xr = (GAS f32x4*)(A.out + (size_t)m * DM) + F.lane;
        const float rstd = 1.f / sqrtf(ss[m] * (1.f / DM) + RMS_EPS);
#pragma unroll
        for (int j = 0; j < 4; ++j) { const f32x4 v = xr[64 * j]; xr[64 * j] = v * rstd * gn[j]; }
    }
}

__global__ void __launch_bounds__(NWAVES * 64, 2) hymba_fwd(Args args) {
    extern __shared__ __attribute__((aligned(16))) unsigned char lds[];
    Frame F;
    F.lds = (LAS unsigned char*)lds;
    F.MISC = (volatile LAS unsigned*)(F.lds + MISC_OFF);
    F.tid = threadIdx.x; F.lane = F.tid & 63; F.wave = __builtin_amdgcn_readfirstlane(F.tid >> 6);
    F.G = gridDim.x; { const int bx = blockIdx.x; F.vcu = (F.G % 8 == 0) ? (bx % 8) * (F.G / 8) + bx / 8 : bx; }
    F.ctl = (gu32*)(args.ws + WS_CTL);
    const Args& A = args;
    for (int u = F.tid; u < (LDS_BYTES - LDSCTL_OFF) / 4; u += NWAVES * 64) ((LAS unsigned*)(F.lds + LDSCTL_OFF))[u] = 0u;
    __syncthreads();
#if MK_PER_PHASE
#define GRID_BAR() do { } while (0)
#else
    XcdBarrier bar = xcd_barrier_post((unsigned*)(F.ctl + CW_BAR) + args.li * XCD_BAR_WORDS, F.MISC + 8);
#define GRID_BAR() xcd_barrier(bar)
#endif
#if 1
    const int lo = args.ph_lo, hi = args.ph_hi;
    const bool rep = (args.li != 0);
#define REPK(k) (rep && lo == (k))
#ifdef ONLY_PH
#define IN(k) ((k) == ONLY_PH && lo <= (k) && (k) < hi)
#else
#define IN(k) (lo <= (k) && (k) < hi)
#endif
#else
#define REPK(k) false
#define IN(k) true
#endif
#define BOTH(k) (IN(k) && IN((k) + 1))
#define PH_PTRS unsigned char* const ws = args.ws; bf16* const RA = (bf16*)(ws + WS_RA); bf16* const RB = (bf16*)(ws + WS_RB); bf16* const RC = (bf16*)(ws + WS_RC); \
    float* const X1 = (float*)(ws + WS_RD); bf16* const X1B = (bf16*)(ws + WS_RE); float* const X2 = (float*)(ws + WS_RF); \
    float* const SS1 = (float*)(ws + WS_CTL) + CW_SS1; float* const SS2 = (float*)(ws + WS_CTL) + CW_SS2; float* const SS3 = (float*)(ws + WS_CTL) + CW_SS3; float* const SSD = (float*)(ws + WS_CTL) + 163840; \
    (void)RA; (void)RB; (void)RC; (void)X1; (void)X1B; (void)X2; (void)SS1; (void)SS2; (void)SS3; (void)SSD;

    if (IN(0)) { p0_prologue(A, F); if (BOTH(0)) GRID_BAR(); }
    if (IN(1)) { PH_PTRS
        { pg8::Gemm g{RB, (const bf16*)(ws + WS_WIN), MP, 3072, DM}; pg8::StaticOrder S; S.init(MP, 3072, F.G, (int)blockIdx.x);
          pg8::EpiIn E{RA};
          pg8::gemm_phase<pg8::EpiIn, pg8::StaticOrder, true, true>(F.lds + RING_OFF, g, S, E); }
        { const SEpiIn E{RA + (size_t)MP * PBLD};
          for (int i = F.G - 1 - (int)blockIdx.x; i < 96 * 4; i += F.G) small_gemm_item<4>(F, RB + (size_t)MP * DM, (const bf16*)(ws + WS_WIN), i >> 5, (i >> 2) & 7, i & 3, E); }
        if (BOTH(1)) GRID_BAR();
    }
    if (IN(2)) {
        for (int it = F.vcu; it < 256; it += F.G) { const int b = it >> 5, tile = it & 31; conv_tile(A, F, b, tile); VM_WAIT(); __syncthreads();
            _Pragma("unroll 1") for (int h = 0; h < NH; ++h) d1_chunk(A, F, (b * NH + h) * 32 + tile); }
        for (int s = F.G - 1 - F.vcu; s < DEC; s += F.G) sample_mixer(A, F, s);
        if (BOTH(2)) GRID_BAR();
    }
    if (IN(3)) { PH_PTRS
        for (int u = F.vcu; u < 256; u += F.G) scan_unit(A, F, u >> 5, (u >> 3) & 3, u & 7);
        { const SEpiRes<true> SE{A.in[I_XS], (float*)(ws + WS_X1S), X1B + (size_t)MP * DM, (REPK(3) ? SSD : SS1) + MP};
          for (int i = F.G - 1 - (int)blockIdx.x; i < 32 * 4; i += F.G) small_gemm_item<4>(F, RB + (size_t)MP * DM, (const bf16*)(ws + WS_WOUT), i >> 5, (i >> 2) & 7, i & 3, SE); }
        if (BOTH(3)) GRID_BAR();
    }
    if (IN(4)) { PH_PTRS
        if ((int)blockIdx.x < 64 && F.G > 64) {
            pg8::Gemm g{(const bf16*)(ws + WS_MEMN), (const bf16*)(ws + WS_WMKV), NB * NMEM, 2048, DM}; pg8::StaticOrder S; S.init(NB * NMEM, 2048, 64, (int)blockIdx.x);
            pg8::EpiKV E{A.out + OUT_MKP, A.out + OUT_MVP, (bf16*)(ws + WS_KB), (bf16*)(ws + WS_VT)};
            pg8::gemm_phase<pg8::EpiKV, pg8::StaticOrder, true, true>(F.lds + RING_OFF, g, S, E);
        } else ogate_phase(A, F, (int)blockIdx.x - 64, F.G - 64);
        { const SEpiQ SE{RB + (size_t)MP * DM, SS1 + MP, ATT_C2};
          for (int i = F.G - 1 - (int)blockIdx.x; i < 32 * 4; i += F.G) small_gemm_item<4>(F, X1B + (size_t)MP * DM, (const bf16*)(ws + WS_WMQ), i >> 5, (i >> 2) & 7, i & 3, SE); }
        if (BOTH(4)) GRID_BAR();
    }
    if (IN(5)) { PH_PTRS
        pg8::Gemm g{RB, (const bf16*)(ws + WS_WOUT), MP, DM, DM}; pg8::StaticOrder S; S.init(MP, DM, F.G, (int)blockIdx.x);
        pg8::EpiRes<true> E{A.in[I_XP], A.in[I_XS], MV, MR, X1, X1B, REPK(5) ? SSD : SS1};
        pg8::gemm_phase<pg8::EpiRes<true>, pg8::StaticOrder, true, true>(F.lds + RING_OFF, g, S, E);
        for (int it = F.vcu; it < DEC * NH; it += F.G) attn_sample(A, F, it >> 2, it & 3);
        if (BOTH(5)) GRID_BAR();
    }
    if (IN(6)) { PH_PTRS
        pg8::Gemm g{X1B, (const bf16*)(ws + WS_WMQ), MP, DM, DM}; pg8::StaticOrder S; S.init(MP, DM, F.G, (int)blockIdx.x);
        pg8::EpiQ E{RB, SS1, ATT_C2};
        pg8::gemm_phase<pg8::EpiQ, pg8::StaticOrder, true, true>(F.lds + RING_OFF, g, S, E);
        { pg8::Unit u; _Pragma("unroll 1") for (int i = 0; i < 2 * 64; ++i) { if (!S.next(i >> 1, u)) break; attn_unit(A, F, 2 * u.pm + (i & 1), u.pn); } }
        { const SEpiRes<true> SE{(const float*)(ws + WS_X1S), X2 + (size_t)MP * DM, RC + (size_t)MP * DM, (REPK(6) ? SSD : SS2) + MP};
          for (int i = F.G - 1 - (int)blockIdx.x; i < 32 * 4; i += F.G) small_gemm_item<4>(F, X1B + (size_t)MP * DM, (const bf16*)(ws + WS_WMO), i >> 5, (i >> 2) & 7, i & 3, SE); }
        if (BOTH(6)) GRID_BAR();
    }
    if (IN(7)) { PH_PTRS
        pg8::Gemm g{X1B, (const bf16*)(ws + WS_WMO), MP, DM, DM}; pg8::StaticOrder S; S.init(MP, DM, F.G, (int)blockIdx.x);
        pg8::EpiRes<true> E{X1, X1, MR, MR, X2, RC, REPK(7) ? SSD : SS2};
        pg8::gemm_phase<pg8::EpiRes<true>, pg8::StaticOrder, true, true>(F.lds + RING_OFF, g, S, E);
        { const SEpiGU SE{RA + (size_t)MP * DFF, SS2 + MP};
          for (int i = F.G - 1 - (int)blockIdx.x; i < 176 * 4; i += F.G) small_gemm_item<4>(F, RC + (size_t)MP * DM, (const bf16*)(ws + WS_WGU), i >> 5, (i >> 2) & 7, i & 3, SE); }
        if (BOTH(7)) GRID_BAR();
    }
    if (IN(8)) { PH_PTRS
        pg8::Gemm g{RC, (const bf16*)(ws + WS_WGU), MP, 2 * DFF, DM}; pg8::StaticOrder S; S.init(MP, 2 * DFF, F.G, (int)blockIdx.x);
        pg8::EpiGU E{RA, SS2};
        pg8::gemm_phase<pg8::EpiGU, pg8::StaticOrder, true, true>(F.lds + RING_OFF, g, S, E);
        { const SEpiRes<false> SE{X2 + (size_t)MP * DM, A.out + (size_t)MP * DM, nullptr, (REPK(8) ? SSD : SS3) + MP};
          for (int i = F.G - 1 - (int)blockIdx.x; i < 32 * 4; i += F.G) small_gemm_item<11>(F, RA + (size_t)MP * DFF, (const bf16*)(ws + WS_WDN), i >> 5, (i >> 2) & 7, i & 3, SE); }
        if (BOTH(8)) GRID_BAR();
    }
    if (IN(9)) { PH_PTRS
        final_norm_phase(A, F);
        pg8::Gemm g{RA, (const bf16*)(ws + WS_WDN), MP, DM, DFF}; pg8::StaticOrder S; S.init(MP, DM, F.G, (int)blockIdx.x);
        pg8::EpiResNorm E{X2, A.out, A.in[I_NF], (float*)(ws + WS_XBUF), (unsigned*)(ws + WS_CTL) + CW_PANEL, (unsigned*)(ws + WS_CTL) + CW_TMO};
        pg8::gemm_phase<pg8::EpiResNorm, pg8::StaticOrder, false, true>(F.lds + RING_OFF, g, S, E);
    }
#undef IN
#undef BOTH
}

extern "C" void kernel_launch(void* const* d_in, const int* in_sizes, int n_in, void* d_out, int out_size, void* d_ws, size_t ws_size, hipStream_t stream) {
    static int grid = 0;
    if (grid == 0) {
        if (n_in != 30 || in_sizes[0] != MP * DM || (size_t)out_size != OUT_END || ws_size < WS_END) {
            fprintf(stderr, "kernel_launch: unexpected shapes: n_in %d, in0 %d, out %d, ws %zu (need >= %zu); nothing launched\n", n_in, n_in > 0 ? in_sizes[0] : -1, out_size, ws_size, (size_t)WS_END); grid = -1; return; }
        int dev = 0, cus = 0, per_cu = 0;
        if (hipGetDevice(&dev) != hipSuccess || hipDeviceGetAttribute(&cus, hipDeviceAttributeMultiprocessorCount, dev) != hipSuccess) { fprintf(stderr, "kernel_launch: device query failed\n"); grid = -1; return; }
        if (hipFuncSetAttribute((const void*)hymba_fwd, hipFuncAttributeMaxDynamicSharedMemorySize, LDS_BYTES) != hipSuccess) { fprintf(stderr, "kernel_launch: hipFuncSetAttribute failed\n"); grid = -1; return; }
        if (hipOccupancyMaxActiveBlocksPerMultiprocessor(&per_cu, (const void*)hymba_fwd, NWAVES * 64, LDS_BYTES) != hipSuccess || per_cu < 1)
            fprintf(stderr, "kernel_launch: note: occupancy query reports %d workgroups per CU\n", per_cu);
        (void)hipGetLastError();
        grid = cus;
        if (grid != 256) { fprintf(stderr, "kernel_launch: built for 256 CUs (one 256x256 unit per workgroup in the fused final-norm phase); found %d; nothing launched\n", grid); grid = -1; return; }
    }
    if (grid < 0) return;
    if (hipMemsetAsync((char*)d_ws + WS_CTL, 0, CTL_ZERO_BYTES, stream) != hipSuccess) { fprintf(stderr, "kernel_launch: hipMemsetAsync failed\n"); return; }
    Args a{};
    for (int i = 0; i < 30; ++i) a.in[i] = (const float*)d_in[i];
    a.out = (float*)d_out; a.ws = (unsigned char*)d_ws;
#if MK_PER_PHASE
    for (int ph = 0; ph < N_PHASES; ++ph) { a.ph_lo = ph; a.ph_hi = ph + 1; a.li = 0;
        hipLaunchKernelGGL(hymba_fwd, dim3(grid), dim3(NWAVES * 64), LDS_BYTES, stream, a); }
#else
#ifdef PROBE_PH
    a.ph_lo = 0; a.ph_hi = PROBE_PH + 1; a.li = 0;
    hipLaunchKernelGGL(hymba_fwd, dim3(grid), dim3(NWAVES * 64), LDS_BYTES, stream, a);
#ifdef PROBE_REPS
    for (int r_ = 0; r_ < PROBE_REPS; ++r_) { a.ph_lo = PROBE_PH; a.ph_hi = PROBE_PH + 1; a.li = 2 + r_; a.pad = PROBE_MODE; hipLaunchKernelGGL(hymba_fwd, dim3(grid), dim3(NWAVES * 64), LDS_BYTES, stream, a); }
#endif
    a.ph_lo = PROBE_PH; a.ph_hi = N_PHASES; a.li = 1; a.pad = 0;
    hipLaunchKernelGGL(hymba_fwd, dim3(grid), dim3(NWAVES * 64), LDS_BYTES, stream, a);
#else
    a.ph_lo = 0; a.ph_hi = N_PHASES; a.li = 0;
    hipLaunchKernelGGL(hymba_fwd, dim3(grid), dim3(NWAVES * 64), LDS_BYTES, stream, a);
#endif
#endif
    const hipError_t le = hipPeekAtLastError();
    if (le != hipSuccess) fprintf(stderr, "kernel_launch: launch failed: %s\n", hipGetErrorName(le));
}
```

```cpp
#include <hip/hip_runtime.h>
#include <cstdio>
#include <cstdint>
#define MK_PER_PHASE 0
namespace pg8 {
#define PG8_LAS __attribute__((address_space(3)))
typedef unsigned short bf16_t;
typedef short bf16x8 __attribute__((ext_vector_type(8)));
typedef float f32x4 __attribute__((ext_vector_type(4)));
typedef unsigned u32x4 __attribute__((ext_vector_type(4)));
constexpr int BM = 256, BK = 64, HALF = 128, HTB = HALF * BK * 2  , STAGE_BYTES = 8 * HTB, NXCD = 8, WGM = 8;

__host__ __device__ __forceinline__ int lds_byte(int r, int c) { const int st = (r >> 4) * 2 + (c >> 5), rr = r & 15, cc = c & 31, ob = rr * 64 + cc * 2; return st * 1024 + (ob ^ (((ob >> 9) & 1) << 5)); }
__host__ __device__ __forceinline__ void stage_rc(int b, int& R, int& C) { const int st = b / 1024, sb = b % 1024, swz = sb ^ (((sb >> 9) & 1) << 5); R = (st >> 1) * 16 + swz / 64; C = (st & 1) * 32 + (swz % 64) / 2; }
__host__ __device__ __forceinline__ int perm32(int rho) { const int n = rho >> 4, i = rho & 15; return 8 * (i >> 2) + 4 * n + (i & 3); }

struct Unit { int pm, pn; };
struct Gemm { const bf16_t* A; const bf16_t* Bt; int M, N, K; };

struct StaticOrder {
    int nM, nN, nwg, G, c;
    __host__ __device__ __forceinline__ void init(int M, int N, int G_, int c_) { nM = M / BM; nN = N / BM; nwg = nM * nN; G = G_; c = c_; }
    __host__ __device__ __forceinline__ bool next(int i, Unit& u) const {
        const long L = (long)i * G + c; if (L >= nwg) return false;
        int wgid = (int)L; { const int q = nwg / NXCD, r = nwg % NXCD, xcd = wgid % NXCD, off = wgid / NXCD; wgid = (xcd < r ? xcd * (q + 1) : r * (q + 1) + (xcd - r) * q) + off; }
        const int nig = WGM * nN, gid = wgid / nig, fm = gid * WGM, gsz = (nM - fm) < WGM ? (nM - fm) : WGM;
        u.pm = fm + ((wgid % nig) % gsz); u.pn = (wgid % nig) / gsz; return true;
    }
    __device__ __forceinline__ void a_ready(const Unit&) const {}
    __device__ __forceinline__ void done(const Unit&) const {}
};

__device__ __forceinline__ unsigned cvt_pk_bf16(float lo, float hi) { unsigned r; asm volatile("v_cvt_pk_bf16_f32 %0, %1, %2" : "=v"(r) : "v"(lo), "v"(hi)); return r; }
typedef float f32x2_t __attribute__((ext_vector_type(2))); typedef __bf16 bf16x2_t __attribute__((ext_vector_type(2)));
__device__ __forceinline__ unsigned pk2(float lo, float hi) { f32x2_t v = {lo, hi}; bf16x2_t b = __builtin_convertvector(v, bf16x2_t); return __builtin_bit_cast(unsigned, b); }
__device__ __forceinline__ float sigm(float x) { return __builtin_amdgcn_rcpf(1.f + __expf(-x)); }
__device__ __forceinline__ float silu(float x) { return x * __builtin_amdgcn_rcpf(1.f + __expf(-x)); }
__device__ __forceinline__ u32x4 pk8(const f32x4& a, const f32x4& b) { u32x4 w; w.x = pk2(a[0], a[1]); w.y = pk2(a[2], a[3]); w.z = pk2(b[0], b[1]); w.w = pk2(b[2], b[3]); return w; }
constexpr int PBLD = 2560;
constexpr int MPROMPT = 16384;
constexpr float RMS_EPS = 1e-6f;

struct EpiIn {
    static constexpr bool PERM = true, AFTER_DRAIN = false;
    bf16_t* PB;
    __device__ __forceinline__ void operator()(const f32x4 (&acc)[2][2][4][2], const Unit& u, int wr, int wc, int fr, int fq) const {
        const int row0 = u.pm * BM + wr * 64 + fr;
        if (u.pn < 4) {
            const int ch0 = u.pn * 128 + wc * 32 + 8 * fq;
#pragma unroll
            for (int ai = 0; ai < 2; ++ai)
#pragma unroll
                for (int m = 0; m < 4; ++m) {
                    bf16_t* rowp = PB + (size_t)(row0 + ai * HALF + m * 16) * PBLD + ch0;
                    f32x4 v0, v1;
#pragma unroll
                    for (int i = 0; i < 4; ++i) { v0[i] = acc[ai][0][m][0][i] * sigm(acc[ai][1][m][0][i]); v1[i] = acc[ai][0][m][1][i] * sigm(acc[ai][1][m][1][i]); }
                    *(u32x4*)rowp = pk8(v0, v1);
                }
        } else {
            const int col0 = u.pn * BM - 512 + wc * 32 + 8 * fq;
#pragma unroll
            for (int ai = 0; ai < 2; ++ai)
#pragma unroll
                for (int m = 0; m < 4; ++m) {
                    bf16_t* rowp = PB + (size_t)(row0 + ai * HALF + m * 16) * PBLD + col0;
#pragma unroll
                    for (int bj = 0; bj < 2; ++bj) *(u32x4*)(rowp + bj * HALF) = pk8(acc[ai][bj][m][0], acc[ai][bj][m][1]);
                }
        }
    }
};

struct EpiKV {
    static constexpr bool PERM = true, AFTER_DRAIN = false;
    float* outK; float* outV; bf16_t* KB; bf16_t* VT;
    __device__ __forceinline__ void operator()(const f32x4 (&acc)[2][2][4][2], const Unit& u, int wr, int wc, int fr, int fq) const {
        const int row0 = u.pm * BM + wr * 64 + fr;
        const bool isv = u.pn >= 4;
        const int c0 = (isv ? u.pn - 4 : u.pn) * BM + wc * 32 + 8 * fq;
        float* outp = isv ? outV : outK;
#pragma unroll
        for (int ai = 0; ai < 2; ++ai)
#pragma unroll
            for (int m = 0; m < 4; ++m) {
                const int row = row0 + ai * HALF + m * 16;
#pragma unroll
                for (int bj = 0; bj < 2; ++bj) {
                    const int col = c0 + bj * HALF;
                    const f32x4 a = acc[ai][bj][m][0], b = acc[ai][bj][m][1];
                    *(f32x4*)(outp + (size_t)row * 1024 + col) = a; *(f32x4*)(outp + (size_t)row * 1024 + col + 4) = b;
                    const u32x4 w = pk8(a, b);
                    if (!isv) *(u32x4*)(KB + (size_t)row * 1024 + col) = w;
                    else {
                        bf16_t* vp = VT + (size_t)col * 2048 + row;
                        vp[0 * 2048] = (bf16_t)(w.x & 0xffffu); vp[1 * 2048] = (bf16_t)(w.x >> 16); vp[2 * 2048] = (bf16_t)(w.y & 0xffffu); vp[3 * 2048] = (bf16_t)(w.y >> 16);
                        vp[4 * 2048] = (bf16_t)(w.z & 0xffffu); vp[5 * 2048] = (bf16_t)(w.z >> 16); vp[6 * 2048] = (bf16_t)(w.w & 0xffffu); vp[7 * 2048] = (bf16_t)(w.w >> 16);
                    }
                }
            }
    }
};

__device__ __forceinline__ f32x4 bf4lo(unsigned a, unsigned b) { return (f32x4){__uint_as_float(a << 16), __uint_as_float(a & 0xffff0000u), __uint_as_float(b << 16), __uint_as_float(b & 0xffff0000u)}; }
template <bool BASE_F32> struct EpiRes {
    static constexpr bool PERM = true, AFTER_DRAIN = false;
    const float* basef; const bf16_t* baseb; bf16_t* outb; float* ss;
    __device__ __forceinline__ void operator()(const f32x4 (&acc)[2][2][4][2], const Unit& u, int wr, int wc, int fr, int fq) const {
        const int row0 = u.pm * BM + wr * 64 + fr; const int col0 = u.pn * BM + wc * 32 + 8 * fq;
#pragma unroll
        for (int ai = 0; ai < 2; ++ai) {
            f32x4 pre[4][2][2];
#pragma unroll
            for (int m = 0; m < 4; ++m)
#pragma unroll
                for (int bj = 0; bj < 2; ++bj) { const size_t off = (size_t)(row0 + ai * HALF + m * 16) * 1024 + col0 + bj * HALF;
                    if (BASE_F32) { pre[m][bj][0] = *(const f32x4*)(basef + off); pre[m][bj][1] = *(const f32x4*)(basef + off + 4); }
                    else { const u32x4 w = *(const u32x4*)(baseb + off); pre[m][bj][0] = bf4lo(w.x, w.y); pre[m][bj][1] = bf4lo(w.z, w.w); } }
            __builtin_amdgcn_sched_barrier(0);
#pragma unroll
            for (int m = 0; m < 4; ++m) {
                const int row = row0 + ai * HALF + m * 16; const size_t off = (size_t)row * 1024 + col0;
                float s = 0.f;
#pragma unroll
                for (int bj = 0; bj < 2; ++bj) {
                    const f32x4 v0 = acc[ai][bj][m][0] + pre[m][bj][0], v1 = acc[ai][bj][m][1] + pre[m][bj][1];
                    s += (v0[0] * v0[0] + v0[1] * v0[1]) + (v0[2] * v0[2] + v0[3] * v0[3]) + (v1[0] * v1[0] + v1[1] * v1[1]) + (v1[2] * v1[2] + v1[3] * v1[3]);
                    *(u32x4*)(outb + off + bj * HALF) = pk8(v0, v1);
                }
                s += __shfl_xor(s, 16); s += __shfl_xor(s, 32);
                if (fq == 0) atomicAdd(ss + row, s);
            }
        }
    }
};

struct EpiQ {
    static constexpr bool PERM = true, AFTER_DRAIN = false;
    bf16_t* Q; const float* ss; float c2;
    __device__ __forceinline__ void operator()(const f32x4 (&acc)[2][2][4][2], const Unit& u, int wr, int wc, int fr, int fq) const {
        const int row0 = u.pm * BM + wr * 64 + fr; const int col0 = u.pn * BM + wc * 32 + 8 * fq;
#pragma unroll
        for (int ai = 0; ai < 2; ++ai)
#pragma unroll
            for (int m = 0; m < 4; ++m) {
                const int row = row0 + ai * HALF + m * 16;
                const float rs = __builtin_amdgcn_rsqf(ss[row] * (1.f / 1024.f) + RMS_EPS) * c2;
#pragma unroll
                for (int bj = 0; bj < 2; ++bj) *(u32x4*)(Q + (size_t)row * 1024 + col0 + bj * HALF) = pk8(acc[ai][bj][m][0] * rs, acc[ai][bj][m][1] * rs);
            }
    }
};

struct EpiGU {
    static constexpr bool PERM = true, AFTER_DRAIN = false;
    bf16_t* T; const float* ss;
    __device__ __forceinline__ void operator()(const f32x4 (&acc)[2][2][4][2], const Unit& u, int wr, int wc, int fr, int fq) const {
        const int row0 = u.pm * BM + wr * 64 + fr; const int ch0 = u.pn * 128 + wc * 32 + 8 * fq;
#pragma unroll
        for (int ai = 0; ai < 2; ++ai)
#pragma unroll
            for (int m = 0; m < 4; ++m) {
                const int row = row0 + ai * HALF + m * 16;
                const float rs = __builtin_amdgcn_rsqf(ss[row] * (1.f / 1024.f) + RMS_EPS);
                f32x4 v0, v1;
#pragma unroll
                for (int i = 0; i < 4; ++i) { v0[i] = silu(acc[ai][0][m][0][i] * rs) * (acc[ai][1][m][0][i] * rs); v1[i] = silu(acc[ai][0][m][1][i] * rs) * (acc[ai][1][m][1][i] * rs); }
                *(u32x4*)(T + (size_t)row * 2816 + ch0) = pk8(v0, v1);
            }
    }
};


struct EpiResNorm {
    static constexpr bool PERM = true, AFTER_DRAIN = true;
    const bf16_t* base; float* out; const float* gain; float* xbuf; unsigned* cnt; unsigned* tmo;
    __device__ __forceinline__ void fused(f32x4 (&acc)[2][2][4][2], const Unit& u, int wr, int wc, int fr, int fq, PG8_LAS unsigned char* lds, int wid, int lane) const {
        PG8_LAS float* P = (PG8_LAS float*)lds;
        PG8_LAS float* S = (PG8_LAS float*)(lds + 4096);
        PG8_LAS unsigned* flag = (PG8_LAS unsigned*)(lds + 4096 + 1024);
        const int row0 = u.pm * BM + wr * 64 + fr; const int col0 = u.pn * BM + wc * 32 + 8 * fq;
#pragma unroll
        for (int ai = 0; ai < 2; ++ai) {
            f32x4 pre[4][2][2];
#pragma unroll
            for (int m = 0; m < 4; ++m)
#pragma unroll
                for (int bj = 0; bj < 2; ++bj) { const size_t off = (size_t)(row0 + ai * HALF + m * 16) * 1024 + col0 + bj * HALF; const u32x4 w = *(const u32x4*)(base + off); pre[m][bj][0] = bf4lo(w.x, w.y); pre[m][bj][1] = bf4lo(w.z, w.w); }
            __builtin_amdgcn_sched_barrier(0);
#pragma unroll
            for (int m = 0; m < 4; ++m) {
                float s = 0.f;
#pragma unroll
                for (int bj = 0; bj < 2; ++bj) {
                    const f32x4 v0 = acc[ai][bj][m][0] + pre[m][bj][0], v1 = acc[ai][bj][m][1] + pre[m][bj][1];
                    acc[ai][bj][m][0] = v0; acc[ai][bj][m][1] = v1;
                    s += (v0[0] * v0[0] + v0[1] * v0[1]) + (v0[2] * v0[2] + v0[3] * v0[3]) + (v1[0] * v1[0] + v1[1] * v1[1]) + (v1[2] * v1[2] + v1[3] * v1[3]);
                }
                s += __shfl_xor(s, 16); s += __shfl_xor(s, 32);
                if (fq == 0) P[(ai * HALF + wr * 64 + m * 16 + fr) * 4 + wc] = s;
            }
        }
        asm volatile("s_waitcnt lgkmcnt(0)" ::: "memory"); __builtin_amdgcn_s_barrier(); asm volatile("" ::: "memory");
        const int row = wid * 64 + lane;
        if (wid < 4) {
            const float t = (P[row * 4 + 0] + P[row * 4 + 1]) + (P[row * 4 + 2] + P[row * 4 + 3]);
            __hip_atomic_store(xbuf + (size_t)(u.pm * BM + row) * 4 + u.pn, t, __ATOMIC_RELAXED, __HIP_MEMORY_SCOPE_AGENT);
            asm volatile("s_waitcnt vmcnt(0)" ::: "memory");
            if (lane == 0) __hip_atomic_fetch_add(cnt + 64 * u.pm, 1u, __ATOMIC_RELAXED, __HIP_MEMORY_SCOPE_AGENT);
        }
        if (wid == 0) {
            unsigned spins = 0; bool dead = false;
            while ((unsigned)__builtin_amdgcn_readfirstlane(__hip_atomic_load(cnt + 64 * u.pm, __ATOMIC_RELAXED, __HIP_MEMORY_SCOPE_AGENT)) < 16u) {
                __builtin_amdgcn_s_sleep(2);
                if (++spins > (1u << 22)) { dead = true; if (lane == 0) __hip_atomic_store(tmo, 1u, __ATOMIC_RELAXED, __HIP_MEMORY_SCOPE_AGENT); break; }
            }
            __builtin_amdgcn_fence(__ATOMIC_ACQUIRE, "agent");
            if (lane == 0) flag[0] = dead ? 1u : 0u;
        }
        asm volatile("s_waitcnt vmcnt(0) lgkmcnt(0)" ::: "memory"); __builtin_amdgcn_s_barrier(); asm volatile("" ::: "memory");
        if (wid < 4) {
            const float* sl = xbuf + (size_t)(u.pm * BM + row) * 4; float t = 0.f;
#pragma unroll
            for (int q = 0; q < 4; ++q) t += __hip_atomic_load(sl + q, __ATOMIC_RELAXED, __HIP_MEMORY_SCOPE_AGENT);
            S[row] = __builtin_amdgcn_rsqf(t * (1.f / 1024.f) + RMS_EPS);
        }
        asm volatile("s_waitcnt vmcnt(0) lgkmcnt(0)" ::: "memory"); __builtin_amdgcn_s_barrier(); asm volatile("" ::: "memory");
        f32x4 gv[2][2];
#pragma unroll
        for (int bj = 0; bj < 2; ++bj) { gv[bj][0] = *(const f32x4*)(gain + col0 + bj * HALF); gv[bj][1] = *(const f32x4*)(gain + col0 + bj * HALF + 4); }
#pragma unroll
        for (int ai = 0; ai < 2; ++ai)
#pragma unroll
            for (int m = 0; m < 4; ++m) {
                const int rl = ai * HALF + wr * 64 + m * 16 + fr; const float rs = S[rl]; const size_t off = (size_t)(u.pm * BM + rl) * 1024 + col0;
#pragma unroll
                for (int bj = 0; bj < 2; ++bj) { *(f32x4*)(out + off + bj * HALF) = acc[ai][bj][m][0] * rs * gv[bj][0]; *(f32x4*)(out + off + bj * HALF + 4) = acc[ai][bj][m][1] * rs * gv[bj][1]; }
            }
    }
};

template <class Epi, class Sched, bool ALIGN_EPI = false, bool SP2 = false>
__device__ __forceinline__ void gemm_phase(PG8_LAS unsigned char* lds, const Gemm g, const Sched& S, const Epi& E) {
    const int tid = threadIdx.x, wid = __builtin_amdgcn_readfirstlane(tid >> 6), lane = tid & 63, wr = wid >> 2, wc = wid & 3, fr = lane & 15, fq = lane >> 4;
    const int K = g.K, nt = K / BK;
    unsigned voffA[2], voffB[2];
#pragma unroll
    for (int i = 0; i < 2; ++i) { int R, C; stage_rc(tid * 16 + i * 8192, R, C); const int Rb = Epi::PERM ? ((R & ~31) + perm32(R & 31)) : R;
        voffA[i] = (unsigned)(R * K + C) * 2u; voffB[i] = (unsigned)(Rb * K + C) * 2u; }
    const size_t kstep = (size_t)(BK * 2);
    const size_t hstep = (size_t)HALF * K * 2;
    const size_t tstep = 2 * hstep;
    const unsigned ldsw = (unsigned)wid * 1024u;
    const int aoff = lds_byte(wr * 64 + fr, fq * 8), boff = lds_byte(wc * 32 + fr, fq * 8);
#define PG8_SA(b, h) (((b) * 2 + (h)) * HTB)
#define PG8_SB(b, h) ((4 + (b) * 2 + (h)) * HTB)
#define PG8_STAGE(bufoff, gbase, voff) do { _Pragma("unroll") for (int _i = 0; _i < 2; ++_i) \
        __builtin_amdgcn_global_load_lds((const unsigned*)((const char*)(gbase) + (voff)[_i]), (PG8_LAS unsigned*)(lds + (bufoff) + ldsw + _i * 8192), 16, 0, 0); } while (0)
#define PG8_LDA(dst, b, h) do { _Pragma("unroll") for (int m = 0; m < 4; ++m) _Pragma("unroll") for (int k = 0; k < 2; ++k) dst[m][k] = *(const PG8_LAS bf16x8*)(lds + PG8_SA(b, h) + aoff + m * 2048 + k * 1024); } while (0)
#define PG8_LDB(dst, b, h) do { _Pragma("unroll") for (int n = 0; n < 2; ++n) _Pragma("unroll") for (int k = 0; k < 2; ++k) dst[n][k] = *(const PG8_LAS bf16x8*)(lds + PG8_SB(b, h) + boff + n * 2048 + k * 1024); } while (0)
#define PG8_MMA(ai, bj, At, Bt) do { __builtin_amdgcn_s_setprio(1); _Pragma("unroll") for (int m = 0; m < 4; ++m) _Pragma("unroll") for (int n = 0; n < 2; ++n) _Pragma("unroll") for (int k = 0; k < 2; ++k) \
        acc[ai][bj][m][n] = __builtin_amdgcn_mfma_f32_16x16x32_bf16(Bt[n][k], At[m][k], acc[ai][bj][m][n], 0, 0, 0); __builtin_amdgcn_s_setprio(0); } while (0)
#define PG8_WAIT_V(n) asm volatile("s_waitcnt vmcnt(" #n ")" ::: "memory")
#define PG8_WAIT_L(n) asm volatile("s_waitcnt lgkmcnt(" #n ")" ::: "memory")
#define PG8_BAR __builtin_amdgcn_s_barrier()
#define PG8_SCHED __builtin_amdgcn_sched_barrier(0)
    Unit cur, nxt; int ui = 0;
    if (!S.next(0, cur)) return;
    f32x4 acc[2][2][4][2];
#pragma unroll
    for (int a = 0; a < 2; ++a)
#pragma unroll
        for (int b = 0; b < 2; ++b)
#pragma unroll
            for (int m = 0; m < 4; ++m)
#pragma unroll
                for (int n = 0; n < 2; ++n) acc[a][b][m][n] = (f32x4){0.f, 0.f, 0.f, 0.f};
    bf16x8 At[4][2], B0[2][2], B1[2][2];
    const char* cA = (const char*)g.A + (size_t)cur.pm * tstep; const char* cB = (const char*)g.Bt + (size_t)cur.pn * tstep;
    S.a_ready(cur);
    if constexpr (SP2) {
        PG8_STAGE(PG8_SB(0, 0), cB, voffB); PG8_STAGE(PG8_SB(0, 1), cB + hstep, voffB); PG8_STAGE(PG8_SA(0, 0), cA, voffA); PG8_STAGE(PG8_SA(0, 1), cA + hstep, voffA);
        if (wr == 1) PG8_BAR;
        PG8_WAIT_V(2); PG8_BAR;
        PG8_STAGE(PG8_SB(1, 0), cB + kstep, voffB); PG8_STAGE(PG8_SA(1, 0), cA + kstep, voffA); PG8_STAGE(PG8_SB(1, 1), cB + hstep + kstep, voffB);
        PG8_WAIT_V(6); PG8_BAR;
    } else {
        PG8_STAGE(PG8_SB(0, 0), cB, voffB); PG8_STAGE(PG8_SA(0, 0), cA, voffA); PG8_STAGE(PG8_SB(0, 1), cB + hstep, voffB); PG8_STAGE(PG8_SA(0, 1), cA + hstep, voffA);
        if (wr == 1) PG8_BAR;
        PG8_WAIT_V(4); PG8_BAR;
        PG8_STAGE(PG8_SB(1, 0), cB + kstep, voffB); PG8_STAGE(PG8_SA(1, 0), cA + kstep, voffA); PG8_STAGE(PG8_SB(1, 1), cB + hstep + kstep, voffB);
        PG8_WAIT_V(6); PG8_BAR;
    }
    for (;;) {
        const bool has_next = S.next(ui + 1, nxt);
        const char* nA = has_next ? (const char*)g.A + (size_t)nxt.pm * tstep : cA; const char* nB = has_next ? (const char*)g.Bt + (size_t)nxt.pn * tstep : cB;
        for (int t = 0; t < nt; t += 2) {
            const bool last = (t == nt - 2);
            const char* a1 = cA + (size_t)(t + 1) * kstep;
            const char* a2 = last ? nA : cA + (size_t)(t + 2) * kstep; const char* b2 = last ? nB : cB + (size_t)(t + 2) * kstep;
            const char* a3 = a2 + kstep; const char* b3 = b2 + kstep;
            if (last && has_next) S.a_ready(nxt);
            if constexpr (SP2) {
            PG8_LDB(B0, 0, 0); PG8_LDB(B1, 0, 1); PG8_SCHED; PG8_LDA(At, 0, 0); PG8_STAGE(PG8_SA(1, 1), a1 + hstep, voffA);
            PG8_WAIT_V(8); PG8_WAIT_L(0); PG8_BAR; PG8_MMA(0, 0, At, B0); PG8_MMA(0, 1, At, B1); PG8_BAR; PG8_SCHED;
            PG8_LDA(At, 0, 1); PG8_STAGE(PG8_SB(0, 0), b2, voffB); PG8_STAGE(PG8_SB(0, 1), b2 + hstep, voffB); PG8_STAGE(PG8_SA(0, 0), a2, voffA);
            PG8_WAIT_V(8); PG8_WAIT_L(0); PG8_BAR; PG8_MMA(1, 0, At, B0); PG8_MMA(1, 1, At, B1); PG8_BAR; PG8_SCHED;
            PG8_LDB(B0, 1, 0); PG8_LDB(B1, 1, 1); PG8_SCHED; PG8_LDA(At, 1, 0); PG8_STAGE(PG8_SA(0, 1), a2 + hstep, voffA);
            PG8_WAIT_V(8); PG8_WAIT_L(0); PG8_BAR; PG8_MMA(0, 0, At, B0); PG8_MMA(0, 1, At, B1); PG8_BAR; PG8_SCHED;
            PG8_LDA(At, 1, 1); PG8_STAGE(PG8_SB(1, 0), b3, voffB); PG8_STAGE(PG8_SB(1, 1), b3 + hstep, voffB); PG8_STAGE(PG8_SA(1, 0), a3, voffA);
            PG8_WAIT_V(8); PG8_WAIT_L(0); PG8_BAR; PG8_MMA(1, 0, At, B0); PG8_MMA(1, 1, At, B1); PG8_BAR; PG8_SCHED;
            } else {
            PG8_LDB(B0, 0, 0); PG8_SCHED; PG8_LDA(At, 0, 0); PG8_STAGE(PG8_SA(1, 1), a1 + hstep, voffA);
            PG8_WAIT_L(8); PG8_BAR; PG8_WAIT_L(0); PG8_MMA(0, 0, At, B0); PG8_BAR; PG8_SCHED;
            PG8_LDB(B1, 0, 1); PG8_STAGE(PG8_SB(0, 0), b2, voffB);
            PG8_BAR; PG8_WAIT_L(0); PG8_MMA(0, 1, At, B1); PG8_BAR;
            PG8_LDA(At, 0, 1); PG8_STAGE(PG8_SA(0, 0), a2, voffA);
            PG8_BAR; PG8_WAIT_L(0); PG8_MMA(1, 0, At, B0); PG8_BAR; PG8_SCHED;
            PG8_STAGE(PG8_SB(0, 1), b2 + hstep, voffB);
            PG8_WAIT_V(6); PG8_BAR; PG8_MMA(1, 1, At, B1); PG8_BAR;
            PG8_LDB(B0, 1, 0); PG8_SCHED; PG8_LDA(At, 1, 0); PG8_STAGE(PG8_SA(0, 1), a2 + hstep, voffA);
            PG8_WAIT_L(8); PG8_BAR; PG8_WAIT_L(0); PG8_MMA(0, 0, At, B0); PG8_BAR; PG8_SCHED;
            PG8_LDB(B1, 1, 1); PG8_STAGE(PG8_SB(1, 0), b3, voffB);
            PG8_BAR; PG8_WAIT_L(0); PG8_MMA(0, 1, At, B1); PG8_BAR;
            PG8_LDA(At, 1, 1); PG8_STAGE(PG8_SA(1, 0), a3, voffA);
            PG8_BAR; PG8_WAIT_L(0); PG8_MMA(1, 0, At, B0); PG8_BAR; PG8_SCHED;
            PG8_STAGE(PG8_SB(1, 1), b3 + hstep, voffB);
            PG8_WAIT_V(6); PG8_BAR; PG8_MMA(1, 1, At, B1); PG8_BAR;
            }
        }
        if constexpr (ALIGN_EPI) { if (wr == 0) PG8_BAR; }
        if constexpr (!Epi::AFTER_DRAIN) { E(acc, cur, wr, wc, fr, fq); S.done(cur); }
        if (!has_next) break;
#pragma unroll
        for (int a = 0; a < 2; ++a)
#pragma unroll
            for (int b = 0; b < 2; ++b)
#pragma unroll
                for (int m = 0; m < 4; ++m)
#pragma unroll
                    for (int n = 0; n < 2; ++n) acc[a][b][m][n] = (f32x4){0.f, 0.f, 0.f, 0.f};
        cur = nxt; cA = nA; cB = nB; ++ui;
        if constexpr (ALIGN_EPI) { if (wr == 1) PG8_BAR; }
    }
    PG8_WAIT_V(0);
    if constexpr (!ALIGN_EPI) { if (wr == 0) PG8_BAR; }
    PG8_BAR;
    if constexpr (Epi::AFTER_DRAIN) { E.fused(acc, cur, wr, wc, fr, fq, lds, wid, lane); S.done(cur); }
#undef PG8_SA
#undef PG8_SB
#undef PG8_STAGE
#undef PG8_LDA
#undef PG8_LDB
#undef PG8_MMA
#undef PG8_WAIT_V
#undef PG8_WAIT_L
#undef PG8_BAR
#undef PG8_SCHED
}
}

constexpr int NWAVES = 8;
#ifndef MK_PER_PHASE
#define MK_PER_PHASE 0
#endif
constexpr int N_PHASES = 10;

constexpr int DM = 1024, NB = 8, SEQ = 2048, MP = NB * SEQ  , DEC = 128, MV = MP + DEC  , MR = 16640  ;
constexpr int CC = 512, CW = 31, NH = 4, DKV = 128, QKVN = 1536, NMEM = 256, MHD = 256, DFF = 2816, INC = 3080;
constexpr int PBLD = pg8::PBLD;
constexpr int NCHUNK = NB * NH * 32;
constexpr float RMS_EPS = 1e-6f;
constexpr float ATT_C2 = 0.0625f * 1.4426950408889634f;

constexpr size_t OUT_YP = 0, OUT_YS = 16777216, OUT_CONVP = 16908288, OUT_SCP = 17031168, OUT_DLP = 17068032, OUT_MKP = 17592320, OUT_MVP = 19689472,
                 OUT_CONVS = 21786624, OUT_SCS = 23752704, OUT_DLS = 24342528, OUT_END = 32731136;

constexpr size_t MiB = 1u << 20;
constexpr size_t WS_CTL = 0, CTL_ZERO_BYTES = 1 * MiB;
constexpr size_t WS_WIN = 1 * MiB, WS_WOUT = 7 * MiB, WS_WMQ = 9 * MiB, WS_WMKV = 11 * MiB, WS_WMO = 15 * MiB, WS_WGU = 17 * MiB, WS_WDN = 28 * MiB;
constexpr size_t WS_BG = 34 * MiB, WS_MEMN = 35 * MiB, WS_KB = 39 * MiB, WS_VT = 43 * MiB, WS_GL = 47 * MiB, WS_X1S = 47 * MiB + 65536, WS_XBUF = 47 * MiB + 655360;
constexpr size_t WS_RA = 48 * MiB;
constexpr size_t WS_RB = 138 * MiB;
constexpr size_t WS_RC = 171 * MiB;
constexpr size_t WS_RD = 220 * MiB;
constexpr size_t WS_U = WS_RD, WS_W = 252 * MiB, WS_QG = 268 * MiB, WS_KDT = 284 * MiB, WS_QK = 300 * MiB;
constexpr size_t WS_RE = 308 * MiB;
constexpr size_t WS_RF = 341 * MiB;
constexpr size_t WS_END = 406 * MiB;
constexpr int CW_TMO = 0, CW_CODE = 1, CW_BAR = 4096, CW_SS1 = 65536, CW_SS2 = 98304, CW_SS3 = 131072, CW_PANEL = 200000;

constexpr int RING_OFF = 0, RING_BYTES = 143360;
constexpr int LDSCTL_OFF = RING_BYTES, MISC_OFF = LDSCTL_OFF + 320;
constexpr int LDS_BYTES = 147456;

#define GAS __attribute__((address_space(1)))
#define LAS __attribute__((address_space(3)))
typedef unsigned short bf16;
typedef unsigned v4u __attribute__((ext_vector_type(4)));
typedef unsigned v2u __attribute__((ext_vector_type(2)));
typedef float f32x4 __attribute__((ext_vector_type(4)));
typedef float f32x16 __attribute__((ext_vector_type(16)));
typedef short bf16x8 __attribute__((ext_vector_type(8)));
typedef GAS unsigned gu32;
#define RLX_AGENT __ATOMIC_RELAXED, __HIP_MEMORY_SCOPE_AGENT
#define LDS_WAIT() asm volatile("s_waitcnt lgkmcnt(0)" ::: "memory")
#define VM_WAIT() asm volatile("s_waitcnt vmcnt(0)" ::: "memory")
using pg8::pk2; using pg8::silu; using pg8::sigm;
__device__ __forceinline__ float bf2f(unsigned b) { return __uint_as_float(b << 16); }
__device__ __forceinline__ float bflo(unsigned w) { return __uint_as_float(w << 16); }
__device__ __forceinline__ float bfhi(unsigned w) { return __uint_as_float(w & 0xffff0000u); }
__device__ __forceinline__ void unpack8(const v4u& w, float (&f)[8]) { f[0] = bflo(w.x); f[1] = bfhi(w.x); f[2] = bflo(w.y); f[3] = bfhi(w.y); f[4] = bflo(w.z); f[5] = bfhi(w.z); f[6] = bflo(w.w); f[7] = bfhi(w.w); }
__device__ __forceinline__ v4u pack8(const float (&f)[8]) { v4u w; w.x = pk2(f[0], f[1]); w.y = pk2(f[2], f[3]); w.z = pk2(f[4], f[5]); w.w = pk2(f[6], f[7]); return w; }
__device__ __forceinline__ float wave_sum(float v) {
#pragma unroll
    for (int o = 1; o < 64; o <<= 1) v += __shfl_xor(v, o);
    return v;
}
__device__ __forceinline__ float wave_max(float v) {
#pragma unroll
    for (int o = 1; o < 64; o <<= 1) v = fmaxf(v, __shfl_xor(v, o));
    return v;
}

#define XB_TMO      128
#define XB_XCNT(j)  (256  + 64 * (j))
#define XB_XSUB(j)  (1280 + 64 * (j))
#define XB_XGEN(j)  (2304 + 64 * (j))
#define XB_TOP      3328
#define XB_TOPGEN   3392
#define XCD_BAR_WORDS 3456
#define XB_SPIN_CAP (1u << 18)

__device__ __forceinline__ unsigned xb_ld(unsigned* p)              { return __hip_atomic_load(p, __ATOMIC_RELAXED, __HIP_MEMORY_SCOPE_AGENT); }
__device__ __forceinline__ unsigned xb_add(unsigned* p, unsigned v) { return __hip_atomic_fetch_add(p, v, __ATOMIC_RELAXED, __HIP_MEMORY_SCOPE_AGENT); }
__device__ __forceinline__ unsigned xb_xcc_id() { return (unsigned)__builtin_amdgcn_s_getreg((3 << 11) | 20) & 0xFu; }
#define XB_SPIN(cond, bar) do { unsigned _sp = 0; while (cond) { __builtin_amdgcn_s_sleep(1); \
    if ((++_sp & 255u) == 0u) { if (xb_ld(&(bar)[XB_TMO])) break; if (_sp > XB_SPIN_CAP) { atomicAdd(&(bar)[XB_TMO], 1u); break; } } } } while (0)

struct XcdBarrier {
    unsigned* bar; unsigned x;
    volatile LAS unsigned* st;
};

__device__ __forceinline__ XcdBarrier xcd_barrier_post(unsigned* bar, volatile LAS unsigned* st) {
    XcdBarrier b; b.bar = bar; b.x = xb_xcc_id(); b.st = st;
    if (threadIdx.x == 0) (void)xb_add(&bar[XB_XCNT(b.x)], 1u);
    return b;
}
__device__ __forceinline__ void xcd_barrier_complete(unsigned* bar, unsigned x, unsigned& nloc, unsigned& nx) {
    const unsigned G = gridDim.x * gridDim.y * gridDim.z;
    unsigned sum, cnt, mine, sp = 0u;
    for (;;) {
        sum = 0u; cnt = 0u; mine = 0u;
#pragma unroll
        for (unsigned j = 0; j < 16; ++j) { const unsigned c = xb_ld(&bar[XB_XCNT(j)]); sum += c; cnt += (c > 0u) ? 1u : 0u; mine = (j == x) ? c : mine; }
        if (sum == G) break;
        __builtin_amdgcn_s_sleep(1);
        if ((++sp & 255u) == 0u) { if (xb_ld(&bar[XB_TMO])) break; if (sp > XB_SPIN_CAP) { atomicAdd(&bar[XB_TMO], 1u); break; } }
    }
    nloc = mine > 0u ? mine : 1u; nx = cnt > 0u ? cnt : 1u;
}

__device__ __forceinline__ void xcd_barrier(const XcdBarrier& b) {
    asm volatile("s_waitcnt vmcnt(0)" ::: "memory");
    __syncthreads();
    if (threadIdx.x == 0) {
        unsigned* bar = b.bar;
        __builtin_amdgcn_s_waitcnt(0);
        unsigned nloc = b.st[0], nx = b.st[1];
        if (nloc == 0u) { xcd_barrier_complete(bar, b.x, nloc, nx); b.st[0] = nloc; b.st[1] = nx; }
        const unsigned old = xb_add(&bar[XB_XSUB(b.x)], 1u);
        const unsigned gen = old / nloc;
        if (old + 1u == (gen + 1u) * nloc) {
            __builtin_amdgcn_fence(__ATOMIC_RELEASE, "agent");
            asm volatile("s_waitcnt vmcnt(0)" ::: "memory");
            const unsigned og = xb_add(&bar[XB_TOP], 1u);
            const unsigned tg = og / nx;
            if (og + 1u == (tg + 1u) * nx) xb_add(&bar[XB_TOPGEN], 1u);
            else XB_SPIN(xb_ld(&bar[XB_TOPGEN]) == tg, bar);
            __builtin_amdgcn_fence(__ATOMIC_ACQUIRE, "agent");
            xb_add(&bar[XB_XGEN(b.x)], 1u);
            asm volatile("s_waitcnt vmcnt(0)" ::: "memory");
        } else {
            XB_SPIN(xb_ld(&bar[XB_XGEN(b.x)]) == gen, bar);
            __builtin_amdgcn_fence(__ATOMIC_ACQUIRE, "agent");
            asm volatile("s_waitcnt vmcnt(0)" ::: "memory");
        }
    }
    __syncthreads();
}

struct Args { const float* in[30]; float* out; unsigned char* ws; int ph_lo, ph_hi, li, pad; };
struct Frame {
    LAS unsigned char* lds;
    volatile LAS unsigned* MISC;
    gu32* ctl;
    int tid, lane, wave;
    int vcu, G;
};
enum { I_XP = 0, I_XS, I_MEM, I_CCONV, I_SSC, I_SDELTA, I_CMK, I_CMV, I_NMIX, I_WIN, I_CONVW, I_CONVB, I_LNG, I_LNB, I_SCW, I_ALOG, I_DTB, I_DNN, I_WOUT,
       I_NMQ, I_NMKV, I_WMQ, I_WMK, I_WMV, I_WMO, I_NFFN, I_WG, I_WU, I_WD, I_NF };

struct TrJob { const float* W; const float* gain; bf16* WT; int ldw, k0, c0, K, r0; };
__device__ __forceinline__ void tr_load(const TrJob& j, int lane, f32x4 (&v)[8]) {
    const float* p = j.W + (size_t)(j.k0 + (lane >> 3)) * j.ldw + j.c0 + (lane & 7) * 4;
#pragma unroll
    for (int i = 0; i < 8; ++i) v[i] = *(const GAS f32x4*)(p + (size_t)(8 * i) * j.ldw);
}
__device__ __forceinline__ void tr_finish(const TrJob& j, const f32x4 (&v)[8], LAS float* scr, int lane) {
#pragma unroll
    for (int i = 0; i < 8; ++i) { LAS float* d = scr + (8 * i + (lane >> 3)) * 33 + (lane & 7) * 4; d[0] = v[i][0]; d[1] = v[i][1]; d[2] = v[i][2]; d[3] = v[i][3]; }
    LDS_WAIT(); asm volatile("" ::: "memory");
    const int c = lane & 7;
    float gv[8];
#pragma unroll
    for (int i = 0; i < 8; ++i) gv[i] = j.gain ? j.gain[j.k0 + 8 * c + i] : 1.f;
#pragma unroll
    for (int q = 0; q < 4; ++q) { const int n = (lane >> 3) + 8 * q; const LAS float* s = scr + (8 * c) * 33 + n;
        v4u o; o.x = pk2(s[0 * 33] * gv[0], s[1 * 33] * gv[1]); o.y = pk2(s[2 * 33] * gv[2], s[3 * 33] * gv[3]); o.z = pk2(s[4 * 33] * gv[4], s[5 * 33] * gv[5]); o.w = pk2(s[6 * 33] * gv[6], s[7 * 33] * gv[7]);
        *(GAS v4u*)(j.WT + (size_t)(j.r0 + n) * j.K + j.k0 + 8 * c) = o; }
    LDS_WAIT(); asm volatile("" ::: "memory");
}
__device__ __forceinline__ float softplusf_(float x) { return x > 20.f ? x : log1pf(__expf(x)); }

__device__ __forceinline__ void p0_prologue(const Args& A, Frame& F) {
    LAS float* scr = (LAS float*)(F.lds + RING_OFF + F.wave * 8448);
    const int gw = F.vcu * NWAVES + F.wave, NGW = F.G * NWAVES;
    unsigned char* ws = A.ws;
    const float* const pWMK = A.in[I_WMK]; const float* const pWMV = A.in[I_WMV]; const float* const pWG = A.in[I_WG]; const float* const pWU = A.in[I_WU];
    const float* const pXP = A.in[I_XP]; const float* const pXS = A.in[I_XS];
    constexpr int I_A = 96 * 16, I_B = 32 * 16, I_D = 64 * 16, I_F = 176 * 16, I_G = 32 * 44;
    constexpr int NITEMS = I_A + I_B + I_B + I_D + I_B + I_F + I_G;
    const float* const pWIN = A.in[I_WIN]; const float* const pWOUT = A.in[I_WOUT]; const float* const pWMQ = A.in[I_WMQ]; const float* const pWMO = A.in[I_WMO]; const float* const pWD = A.in[I_WD];
    const float* const pNMQ = A.in[I_NMQ]; const float* const pNFFN = A.in[I_NFFN];
#define TR_DECODE(J, IT) do { int r = (IT); \
        if (r < I_A) { const int nb = r % 96, kb = r / 96, j0 = 32 * nb; int src = j0; \
            if (j0 < 1024) { const int tile = j0 >> 8, local = j0 & 255; src = local < 128 ? 128 * tile + local : 512 + 128 * tile + (local - 128); } \
            J = TrJob{pWIN, nullptr, (bf16*)(ws + WS_WIN), INC, 64 * kb, src, DM, j0}; break; } r -= I_A; \
        if (r < I_B) { const int nb = r % 32, kb = r / 32; J = TrJob{pWOUT, nullptr, (bf16*)(ws + WS_WOUT), DM, 64 * kb, 32 * nb, DM, 32 * nb}; break; } r -= I_B; \
        if (r < I_B) { const int nb = r % 32, kb = r / 32; J = TrJob{pWMQ, pNMQ, (bf16*)(ws + WS_WMQ), DM, 64 * kb, 32 * nb, DM, 32 * nb}; break; } r -= I_B; \
        if (r < I_D) { const int nb = r % 64, kb = r / 64, j0 = 32 * nb; const bool isv = j0 >= 1024; \
            J = TrJob{isv ? pWMV : pWMK, nullptr, (bf16*)(ws + WS_WMKV), DM, 64 * kb, isv ? j0 - 1024 : j0, DM, j0}; break; } r -= I_D; \
        if (r < I_B) { const int nb = r % 32, kb = r / 32; J = TrJob{pWMO, nullptr, (bf16*)(ws + WS_WMO), DM, 64 * kb, 32 * nb, DM, 32 * nb}; break; } r -= I_B; \
        if (r < I_F) { const int nb = r % 176, kb = r / 176, j0 = 32 * nb, tile = j0 >> 8, local = j0 & 255; const bool up = local >= 128; \
            J = TrJob{up ? pWU : pWG, pNFFN, (bf16*)(ws + WS_WGU), DFF, 64 * kb, 128 * tile + (up ? local - 128 : local), DM, j0}; break; } r -= I_F; \
        { const int nb = r % 32, kb = r / 32; J = TrJob{pWD, nullptr, (bf16*)(ws + WS_WDN), DM, 64 * kb, 32 * nb, DFF, 32 * nb}; } } while (0)
    {
        TrJob jc, jn; f32x4 vc[8], vn[8];
        int it = gw;
        if (it < NITEMS) { TR_DECODE(jc, it); tr_load(jc, F.lane, vc); }
#pragma unroll 1
        for (; it < NITEMS; it += NGW) {
            const int itn = it + NGW;
            if (itn < NITEMS) { TR_DECODE(jn, itn); tr_load(jn, F.lane, vn); }
            tr_finish(jc, vc, scr, F.lane);
            jc = jn;
#pragma unroll
            for (int i = 0; i < 8; ++i) vc[i] = vn[i];
        }
    }
#undef TR_DECODE
    {
        bf16* H = (bf16*)(ws + WS_RB); float* BG = (float*)(ws + WS_BG);
        const float* win = A.in[I_WIN]; const float* gain = A.in[I_NMIX];
        float w8[4][4][8];
#pragma unroll
        for (int j = 0; j < 4; ++j)
#pragma unroll
            for (int i = 0; i < 4; ++i) { const int k = 256 * j + 4 * F.lane + i; const f32x4 a = *(const f32x4*)(win + (size_t)k * INC + 3072), b = *(const f32x4*)(win + (size_t)k * INC + 3076);
                w8[j][i][0] = a[0]; w8[j][i][1] = a[1]; w8[j][i][2] = a[2]; w8[j][i][3] = a[3]; w8[j][i][4] = b[0]; w8[j][i][5] = b[1]; w8[j][i][6] = b[2]; w8[j][i][7] = b[3]; }
        f32x4 gn[4];
#pragma unroll
        for (int j = 0; j < 4; ++j) gn[j] = *(const f32x4*)(gain + 256 * j + 4 * F.lane);
        const f32x4 alog4 = *(const f32x4*)A.in[I_ALOG], dtb4 = *(const f32x4*)A.in[I_DTB];
        const bool hi5 = (F.lane & 32) != 0, b4 = (F.lane & 16) != 0, b3 = (F.lane & 8) != 0; const int cidx = (hi5 ? 4 : 0) + (b4 ? 2 : 0) + (b3 ? 1 : 0), c3 = cidx & 3;
        const float myea = expf(c3 == 0 ? alog4[0] : c3 == 1 ? alog4[1] : c3 == 2 ? alog4[2] : alog4[3]);
        const float mydtb = (cidx < 4) ? 0.f : (c3 == 0 ? dtb4[0] : c3 == 1 ? dtb4[1] : c3 == 2 ? dtb4[2] : dtb4[3]);
        f32x4 v[4], nv[4];
        { const int m0 = gw; if (m0 < MV) { const GAS f32x4* xr = (const GAS f32x4*)((m0 < MP) ? pXP + (size_t)m0 * DM : pXS + (size_t)(m0 - MP) * DM) + F.lane;
#pragma unroll
            for (int j = 0; j < 4; ++j) v[j] = xr[64 * j]; } }
#pragma unroll 1
        for (int m = gw; m < MR; m += NGW) {
            GAS unsigned long long* o8 = (GAS unsigned long long*)(H + (size_t)m * DM) + F.lane;
            { const int mn = m + NGW; if (mn < MV) { const GAS f32x4* xr = (const GAS f32x4*)((mn < MP) ? pXP + (size_t)mn * DM : pXS + (size_t)(mn - MP) * DM) + F.lane;
#pragma unroll
                for (int j = 0; j < 4; ++j) nv[j] = xr[64 * j]; } }
            if (m >= MV) {
#pragma unroll
                for (int j = 0; j < 4; ++j) o8[64 * j] = 0ull;
                if (F.lane < 8) BG[(size_t)m * 8 + F.lane] = 0.f;
                continue;
            }
            float s2 = 0.f;
#pragma unroll
            for (int j = 0; j < 4; ++j) s2 += (v[j][0] * v[j][0] + v[j][1] * v[j][1]) + (v[j][2] * v[j][2] + v[j][3] * v[j][3]);
            const float rstd = 1.f / sqrtf(wave_sum(s2) * (1.f / DM) + RMS_EPS);
            float p8[8];
#pragma unroll
            for (int c = 0; c < 8; ++c) p8[c] = 0.f;
#pragma unroll
            for (int j = 0; j < 4; ++j) { v[j] = v[j] * rstd * gn[j];
#pragma unroll
                for (int i = 0; i < 4; ++i)
#pragma unroll
                    for (int c = 0; c < 8; ++c) p8[c] += v[j][i] * w8[j][i][c];
                o8[64 * j] = (unsigned long long)pk2(v[j][0], v[j][1]) | ((unsigned long long)pk2(v[j][2], v[j][3]) << 32); }
            float z;
            { float r4[4], q2[2];
#pragma unroll
              for (int i = 0; i < 4; ++i) { const float send = hi5 ? p8[i] : p8[4 + i], keep = hi5 ? p8[4 + i] : p8[i]; r4[i] = keep + __shfl_xor(send, 32); }
#pragma unroll
              for (int i = 0; i < 2; ++i) { const float send = b4 ? r4[i] : r4[2 + i], keep = b4 ? r4[2 + i] : r4[i]; q2[i] = keep + __shfl_xor(send, 16); }
              { const float send = b3 ? q2[0] : q2[1], keep = b3 ? q2[1] : q2[0]; z = keep + __shfl_xor(send, 8); }
              z += __shfl_xor(z, 4); z += __shfl_xor(z, 2); z += __shfl_xor(z, 1); }
            { const float xs = z + mydtb;
              const float sp = xs > 20.f ? xs : (xs < -15.f ? __expf(xs) : __logf(1.f + __expf(xs)));
              const float val = (cidx < 4) ? __builtin_amdgcn_rcpf(1.f + __expf(-z)) : -myea * sp;
              if ((F.lane & 7) == 0) BG[(size_t)m * 8 + cidx] = val; }
#pragma unroll
            for (int j = 0; j < 4; ++j) v[j] = nv[j];
        }
    }
    {
        bf16* MN = (bf16*)(ws + WS_MEMN); const float* gain = A.in[I_NMKV];
        f32x4 gn[4];
#pragma unroll
        for (int j = 0; j < 4; ++j) gn[j] = *(const f32x4*)(gain + 256 * j + 4 * F.lane);
        for (int m = gw; m < NB * NMEM; m += NGW) {
            const GAS f32x4* xr = (const GAS f32x4*)(A.in[I_MEM] + (size_t)m * DM) + F.lane;
            f32x4 v[4]; float s2 = 0.f;
#pragma unroll
            for (int j = 0; j < 4; ++j) { v[j] = xr[64 * j]; s2 += (v[j][0] * v[j][0] + v[j][1] * v[j][1]) + (v[j][2] * v[j][2] + v[j][3] * v[j][3]); }
            const float rstd = 1.f / sqrtf(wave_sum(s2) * (1.f / DM) + RMS_EPS);
            GAS unsigned long long* o8 = (GAS unsigned long long*)(MN + (size_t)m * DM) + F.lane;
#pragma unroll
            for (int j = 0; j < 4; ++j) { v[j] = v[j] * rstd * gn[j]; o8[64 * j] = (unsigned long long)pk2(v[j][0], v[j][1]) | ((unsigned long long)pk2(v[j][2], v[j][3]) << 32); }
        }
    }
}

__device__ __forceinline__ void conv_tile(const Args& A, Frame& F, int b, int tile) {
    const bf16* PB = (const bf16*)(A.ws + WS_RA); bf16* CD = (bf16*)(A.ws + WS_RB); bf16* QC = (bf16*)(A.ws + WS_RC);
    int oz; asm volatile("v_mov_b32 %0, 0" : "=v"(oz));
    const int c = F.tid + oz; const int row0 = b * SEQ + tile * 64;
    LAS float* Y = (LAS float*)(F.lds + RING_OFF);
    {
        float w[CW];
#pragma unroll
        for (int j = 0; j < CW; ++j) w[j] = A.in[I_CONVW][j * CC + c];
        const float bias = A.in[I_CONVB][c];
        float uv[46];
        const unsigned rb = (unsigned)(b * SEQ + tile * 64);
#pragma unroll
        for (int i = 0; i < 30; ++i) { const int tk = tile * 64 - 30 + i; const unsigned tkc = tk < 0 ? 0u : (unsigned)tk; const float vv = bf2f(PB[(unsigned)(b * SEQ + tkc) * (unsigned)PBLD + (unsigned)c]); uv[i] = (tk >= 0) ? vv : 0.f; }
#pragma unroll 1
        for (int seg = 0; seg < 4; ++seg) {
#pragma unroll
            for (int i = 0; i < 16; ++i) uv[30 + i] = bf2f(PB[(rb + (unsigned)(seg * 16 + i)) * (unsigned)PBLD + (unsigned)c]);
#pragma unroll
            for (int t = 0; t < 16; ++t) { float a = bias;
#pragma unroll
                for (int j = 0; j < CW; ++j) a += w[j] * uv[t + j];
                Y[(seg * 16 + t) * CC + c] = a; }
#pragma unroll
            for (int i = 0; i < 30; ++i) uv[i] = uv[i + 16];
        }
    }
    __syncthreads();
    {
        const int ch0 = 8 * F.lane + oz;
        const f32x4 g0 = *(const f32x4*)(A.in[I_LNG] + ch0), g1 = *(const f32x4*)(A.in[I_LNG] + ch0 + 4), b0 = *(const f32x4*)(A.in[I_LNB] + ch0), b1 = *(const f32x4*)(A.in[I_LNB] + ch0 + 4);
#pragma unroll 2
        for (int tt = 0; tt < 8; ++tt) { const int t = 8 * F.wave + tt;
            f32x4 y0 = *(const LAS f32x4*)(Y + t * CC + ch0), y1 = *(const LAS f32x4*)(Y + t * CC + ch0 + 4);
            const float mean = wave_sum((y0[0] + y0[1]) + (y0[2] + y0[3]) + (y1[0] + y1[1]) + (y1[2] + y1[3])) * (1.f / CC);
            y0 = y0 - mean; y1 = y1 - mean;
            const float var = wave_sum((y0[0] * y0[0] + y0[1] * y0[1]) + (y0[2] * y0[2] + y0[3] * y0[3]) + (y1[0] * y1[0] + y1[1] * y1[1]) + (y1[2] * y1[2] + y1[3] * y1[3])) * (1.f / CC);
            const float rstd = 1.f / sqrtf(var + 1e-5f);
            y0 = y0 * rstd * g0 + b0; y1 = y1 * rstd * g1 + b1;
            float o[8];
#pragma unroll
            for (int i = 0; i < 4; ++i) { o[i] = silu(y0[i]); o[4 + i] = silu(y1[i]); }
            *(GAS v4u*)(CD + (size_t)(row0 + t) * DM + ch0) = pack8(o); }
    }
    if (tile == 31) {
        float* oc = A.out + OUT_CONVP + (size_t)b * 30 * CC;
        float tv[30];
#pragma unroll
        for (int j = 0; j < 30; ++j) tv[j] = bf2f(PB[(size_t)(b * SEQ + SEQ - 30 + j) * PBLD + c]);
        __builtin_amdgcn_sched_barrier(0);
#pragma unroll
        for (int j = 0; j < 30; ++j) oc[j * CC + c] = tv[j];
        float* os = A.out + OUT_SCP + (size_t)b * 3 * QKVN;
        float sv[9];
#pragma unroll
        for (int q = 0; q < 9; ++q) { const int e = F.tid + q * (NWAVES * 64); const int j = e / QKVN, ch = e % QKVN; sv[q] = bf2f(PB[(size_t)(b * SEQ + SEQ - 3 + j) * PBLD + 512 + ch]); }
        __builtin_amdgcn_sched_barrier(0);
#pragma unroll
        for (int q = 0; q < 9; ++q) os[F.tid + q * (NWAVES * 64)] = sv[q];
    }
    {
        const int t0 = tile * 64 + 8 * F.wave;
#pragma unroll 1
        for (int p = 0; p < 3; ++p) {
            const int ch0 = 512 * p + 8 * F.lane + oz;
            float wsc[4][8];
#pragma unroll
            for (int j = 0; j < 4; ++j) { const f32x4 a = *(const f32x4*)(A.in[I_SCW] + j * QKVN + ch0), bb = *(const f32x4*)(A.in[I_SCW] + j * QKVN + ch0 + 4);
#pragma unroll
                for (int i = 0; i < 4; ++i) { wsc[j][i] = a[i]; wsc[j][4 + i] = bb[i]; } }
            float win[3][8];
#pragma unroll
            for (int j = 0; j < 3; ++j) { const int tk = t0 - 3 + j; const int tkc = tk < 0 ? 0 : tk;
                const v4u x = *(const GAS v4u*)(PB + (size_t)(b * SEQ + tkc) * PBLD + 512 + ch0); unpack8(x, win[j]);
#pragma unroll
                for (int i = 0; i < 8; ++i) win[j][i] = (tk >= 0) ? win[j][i] : 0.f; }
#pragma unroll
            for (int tt = 0; tt < 8; ++tt) {
                float cur[8]; { const v4u x = *(const GAS v4u*)(PB + (size_t)(b * SEQ + t0 + tt) * PBLD + 512 + ch0); unpack8(x, cur); }
                float y[8]; float ss = 0.f;
#pragma unroll
                for (int i = 0; i < 8; ++i) { const float a = wsc[0][i] * win[0][i] + wsc[1][i] * win[1][i] + wsc[2][i] * win[2][i] + wsc[3][i] * cur[i]; y[i] = silu(a); ss += y[i] * y[i]; }
                if (p < 2) { ss += __shfl_xor(ss, 1); ss += __shfl_xor(ss, 2); ss += __shfl_xor(ss, 4); ss += __shfl_xor(ss, 8);
                    const float sc = (1.f / sqrtf(ss + 1e-6f)) * (p == 0 ? 0.08838834764831845f : 1.f);
#pragma unroll
                    for (int i = 0; i < 8; ++i) y[i] *= sc; }
                *(GAS v4u*)(QC + (size_t)(b * SEQ + t0 + tt) * QKVN + ch0) = pack8(y);
#pragma unroll
                for (int i = 0; i < 8; ++i) { win[0][i] = win[1][i]; win[1][i] = win[2][i]; win[2][i] = cur[i]; }
            }
        }
    }
    __syncthreads();
}
__device__ __forceinline__ void conv_sample(const Args& A, Frame& F, int s) {
    const bf16* PB = (const bf16*)(A.ws + WS_RA); bf16* CD = (bf16*)(A.ws + WS_RB); bf16* QC = (bf16*)(A.ws + WS_RC);
    const int c = F.tid; const size_t row = (size_t)MP + s;
    LAS float* Y = (LAS float*)(F.lds + RING_OFF);
    {
        const float* cache = A.in[I_CCONV] + (size_t)s * 30 * CC; float* oc = A.out + OUT_CONVS + (size_t)s * 30 * CC;
        const float us = bf2f(PB[row * PBLD + c]);
        float a = A.in[I_CONVB][c];
        float cv[30], wv[31];
#pragma unroll
        for (int j = 0; j < 30; ++j) { cv[j] = cache[j * CC + c]; wv[j] = A.in[I_CONVW][j * CC + c]; }
        wv[30] = A.in[I_CONVW][30 * CC + c];
        __builtin_amdgcn_sched_barrier(0);
#pragma unroll
        for (int j = 0; j < 30; ++j) { a += wv[j] * cv[j]; oc[j * CC + c] = (j < 29) ? cv[j + 1] : us; }
        a += wv[30] * us;
        Y[c] = a;
    }
    __syncthreads();
    if (F.wave == 7) {
        const int ch0 = 8 * F.lane;
        const f32x4 g0 = *(const f32x4*)(A.in[I_LNG] + ch0), g1 = *(const f32x4*)(A.in[I_LNG] + ch0 + 4), b0 = *(const f32x4*)(A.in[I_LNB] + ch0), b1 = *(const f32x4*)(A.in[I_LNB] + ch0 + 4);
        f32x4 y0 = *(const LAS f32x4*)(Y + ch0), y1 = *(const LAS f32x4*)(Y + ch0 + 4);
        const float mean = wave_sum((y0[0] + y0[1]) + (y0[2] + y0[3]) + (y1[0] + y1[1]) + (y1[2] + y1[3])) * (1.f / CC);
        y0 = y0 - mean; y1 = y1 - mean;
        const float var = wave_sum((y0[0] * y0[0] + y0[1] * y0[1]) + (y0[2] * y0[2] + y0[3] * y0[3]) + (y1[0] * y1[0] + y1[1] * y1[1]) + (y1[2] * y1[2] + y1[3] * y1[3])) * (1.f / CC);
        const float rstd = 1.f / sqrtf(var + 1e-5f);
        y0 = y0 * rstd * g0 + b0; y1 = y1 * rstd * g1 + b1;
        float o[8];
#pragma unroll
        for (int i = 0; i < 4; ++i) { o[i] = silu(y0[i]); o[4 + i] = silu(y1[i]); }
        *(GAS v4u*)(CD + row * DM + ch0) = pack8(o);
    }
    if (F.wave < 3) {
        const int p = F.wave; const int ch0 = 512 * p + 8 * F.lane;
        const float* st = A.in[I_SSC] + (size_t)s * 3 * QKVN; float* os = A.out + OUT_SCS + (size_t)s * 3 * QKVN;
        float win[3][8], cur[8], y[8];
#pragma unroll
        for (int j = 0; j < 3; ++j) { const f32x4 a = *(const f32x4*)(st + j * QKVN + ch0), bb = *(const f32x4*)(st + j * QKVN + ch0 + 4);
#pragma unroll
            for (int i = 0; i < 4; ++i) { win[j][i] = a[i]; win[j][4 + i] = bb[i]; } }
        { const v4u x = *(const GAS v4u*)(PB + row * PBLD + 512 + ch0); unpack8(x, cur); }
        float ss = 0.f;
#pragma unroll
        for (int i = 0; i < 8; ++i) { float a = 0.f;
#pragma unroll
            for (int j = 0; j < 3; ++j) a += A.in[I_SCW][j * QKVN + ch0 + i] * win[j][i];
            a += A.in[I_SCW][3 * QKVN + ch0 + i] * cur[i]; y[i] = silu(a); ss += y[i] * y[i]; }
        if (p < 2) { ss += __shfl_xor(ss, 1); ss += __shfl_xor(ss, 2); ss += __shfl_xor(ss, 4); ss += __shfl_xor(ss, 8);
            const float sc = (1.f / sqrtf(ss + 1e-6f)) * (p == 0 ? 0.08838834764831845f : 1.f);
#pragma unroll
            for (int i = 0; i < 8; ++i) y[i] *= sc; }
        *(GAS v4u*)(QC + row * QKVN + ch0) = pack8(y);
#pragma unroll
        for (int j = 0; j < 3; ++j) { f32x4 a, bb;
#pragma unroll
            for (int i = 0; i < 4; ++i) { a[i] = (j < 2) ? win[j + 1][i] : cur[i]; bb[i] = (j < 2) ? win[j + 1][4 + i] : cur[4 + i]; }
            *(f32x4*)(os + j * QKVN + ch0) = a; *(f32x4*)(os + j * QKVN + ch0 + 4) = bb; }
    }
    __syncthreads();
}

__device__ __forceinline__ bf16x8 lds_frag16(const LAS unsigned char* p) { return *(const LAS bf16x8*)p; }
__device__ __forceinline__ void d1_chunk(const Args& A, Frame& F, int ci) {
    using pg8::f32x4;
    const int b = ci >> 7, h = (ci >> 5) & 3, n = ci & 31; const int row0 = b * SEQ + n * 64;
    const bf16* QC = (const bf16*)(A.ws + WS_RC); const float* BG = (const float*)(A.ws + WS_BG);
    float* Ug = (float*)(A.ws + WS_U) + (size_t)ci * 8192; bf16* Wg = (bf16*)(A.ws + WS_W) + (size_t)ci * 8192; bf16* QGg = (bf16*)(A.ws + WS_QG) + (size_t)ci * 8192;
    bf16* KDTg = (bf16*)(A.ws + WS_KDT) + (size_t)ci * 8192; bf16* QKg = (bf16*)(A.ws + WS_QK) + (size_t)ci * 4096; float* GLg = (float*)(A.ws + WS_GL);
    constexpr int OFF_K = 0, OFF_Q = 17408, OFF_VBT = 34816, OFF_KBGT = 53248, OFF_L = 71680, OFF_T = 89088, OFF_GC = 98304, OFF_BETA = 98560, OFF_EG = 98816, OFF_TM = 99072, OFF_X = 116480, LS = 68;
    LAS unsigned char* L = F.lds + RING_OFF;
    LAS float* gcs = (LAS float*)(L + OFF_GC); LAS float* betas = (LAS float*)(L + OFF_BETA); LAS float* egs = (LAS float*)(L + OFF_EG); LAS float* Lm = (LAS float*)(L + OFF_L); LAS float* Tm = (LAS float*)(L + OFF_TM); LAS float* Xm = (LAS float*)(L + OFF_X);
    const int fr = F.lane & 15, fq = F.lane >> 4;
    if (F.wave == 0) {
        float g = BG[(size_t)(row0 + F.lane) * 8 + 4 + h]; const float be = BG[(size_t)(row0 + F.lane) * 8 + h];
#pragma unroll
        for (int o = 1; o < 64; o <<= 1) { const float v = __shfl_up(g, o); if (F.lane >= o) g += v; }
        gcs[F.lane] = g; betas[F.lane] = be; egs[F.lane] = __expf(g);
    }
    __syncthreads();
    {
        const int t = F.tid >> 3, part = F.tid & 7;
        const bf16* rp = QC + (size_t)(row0 + t) * QKVN + h * 128 + part * 16;
        const v4u q0 = *(const GAS v4u*)(rp), q1 = *(const GAS v4u*)(rp + 8), k0 = *(const GAS v4u*)(rp + 512), k1 = *(const GAS v4u*)(rp + 520), v0 = *(const GAS v4u*)(rp + 1024), v1 = *(const GAS v4u*)(rp + 1032);
        *(LAS v4u*)(L + OFF_K + t * 272 + part * 32) = k0; *(LAS v4u*)(L + OFF_K + t * 272 + part * 32 + 16) = k1;
        *(LAS v4u*)(L + OFF_Q + t * 272 + part * 32) = q0; *(LAS v4u*)(L + OFF_Q + t * 272 + part * 32 + 16) = q1;
        const float be = betas[t], beg = be * egs[t];
        float kf[16], vf[16];
        { float tmp[8]; unpack8(k0, tmp);
#pragma unroll
          for (int i = 0; i < 8; ++i) kf[i] = tmp[i]; unpack8(k1, tmp);
#pragma unroll
          for (int i = 0; i < 8; ++i) kf[8 + i] = tmp[i]; unpack8(v0, tmp);
#pragma unroll
          for (int i = 0; i < 8; ++i) vf[i] = tmp[i]; unpack8(v1, tmp);
#pragma unroll
          for (int i = 0; i < 8; ++i) vf[8 + i] = tmp[i]; }
#pragma unroll
        for (int i = 0; i < 16; ++i) { const int d = part * 16 + i;
            *(LAS unsigned short*)(L + OFF_VBT + d * 144 + t * 2) = (unsigned short)(pk2(vf[i] * be, 0.f) & 0xffffu);
            *(LAS unsigned short*)(L + OFF_KBGT + d * 144 + t * 2) = (unsigned short)(pk2(kf[i] * beg, 0.f) & 0xffffu); }
    }
    __syncthreads();
#pragma unroll 1
    for (int x = 0; x < 4; ++x) {
        const int tile = F.wave * 4 + x, which = tile >> 4, ti = (tile >> 2) & 3, tj = tile & 3;
        f32x4 acc = (f32x4){0.f, 0.f, 0.f, 0.f};
        if (ti >= tj) {
            const LAS unsigned char* ap = L + (which ? OFF_Q : OFF_K) + (ti * 16 + fr) * 272 + fq * 16; const LAS unsigned char* bp = L + OFF_K + (tj * 16 + fr) * 272 + fq * 16;
#pragma unroll
            for (int kk = 0; kk < 4; ++kk) acc = __builtin_amdgcn_mfma_f32_16x16x32_bf16(lds_frag16(ap + kk * 64), lds_frag16(bp + kk * 64), acc, 0, 0, 0);
        }
        const int j = tj * 16 + fr; const float gj = gcs[j];
#pragma unroll
        for (int r = 0; r < 4; ++r) { const int i = ti * 16 + 4 * fq + r; const float dec = __expf(gcs[i] - gj);
            if (which == 0) Lm[i * LS + j] = (i > j) ? betas[i] * acc[r] * dec : 0.f;
            else QKg[i * 64 + j] = (bf16)(pk2((i >= j) ? acc[r] * dec : 0.f, 0.f) & 0xffffu); }
    }
    __syncthreads();
    for (int e = F.tid; e < 64 * LS; e += NWAVES * 64) Tm[e] = 0.f;
    __syncthreads();
    if (F.wave == 0) {
        const LAS float* Lb = Lm + (16 * fq) * LS + 16 * fq;
        float t[16];
#pragma unroll
        for (int i = 0; i < 16; ++i) {
            float a0 = 0.f, a1 = 0.f, a2 = 0.f, a3 = 0.f;
#pragma unroll
            for (int j4 = 0; j4 < (i + 3) / 4; ++j4) { const f32x4 lv = *(const LAS f32x4*)(Lb + i * LS + 4 * j4);
                if (4 * j4 + 0 < i) a0 += lv[0] * t[4 * j4 + 0]; if (4 * j4 + 1 < i) a1 += lv[1] * t[4 * j4 + 1]; if (4 * j4 + 2 < i) a2 += lv[2] * t[4 * j4 + 2]; if (4 * j4 + 3 < i) a3 += lv[3] * t[4 * j4 + 3]; }
            t[i] = ((fr == i) ? 1.f : 0.f) - ((a0 + a1) + (a2 + a3));
        }
#pragma unroll
        for (int i = 0; i < 16; ++i) Tm[(16 * fq + i) * LS + 16 * fq + fr] = t[i];
    } else {
        const int lt = F.tid - 64; const float gl = gcs[63];
        for (int cix = lt; cix < 1024; cix += 448) {
            const int t = cix >> 4, cc = cix & 15; const v4u x = *(const LAS v4u*)(L + OFF_Q + t * 272 + cc * 16); float f[8]; unpack8(x, f); const float e = egs[t];
#pragma unroll
            for (int i = 0; i < 8; ++i) f[i] *= e;
            *(GAS v4u*)(QGg + t * 128 + cc * 8) = pack8(f); }
        for (int cix = lt; cix < 1024; cix += 448) {
            const int dk = cix >> 3, t0 = (cix & 7) * 8; float f[8];
#pragma unroll
            for (int i = 0; i < 8; ++i) f[i] = bf2f(*(const LAS unsigned short*)(L + OFF_K + (t0 + i) * 272 + dk * 2)) * __expf(gl - gcs[t0 + i]);
            *(GAS v4u*)(KDTg + dk * 64 + t0) = pack8(f); }
        if (lt == 0) GLg[ci] = __expf(gl);
    }
    __syncthreads();
    if (F.wave < 2) {
        const int pp = F.wave, rb = 16 * (2 * pp + 1), cb = 16 * (2 * pp); f32x4 acc = (f32x4){0.f, 0.f, 0.f, 0.f};
#pragma unroll
        for (int kk = 0; kk < 4; ++kk) acc = __builtin_amdgcn_mfma_f32_16x16x4f32(Lm[(rb + fr) * LS + cb + 4 * kk + fq], Tm[(cb + 4 * kk + fq) * LS + cb + fr], acc, 0, 0, 0);
#pragma unroll
        for (int r = 0; r < 4; ++r) Xm[pp * 576 + (4 * fq + r) * 36 + fr] = acc[r];
    }
    __syncthreads();
    if (F.wave < 2) {
        const int pp = F.wave, rb = 16 * (2 * pp + 1), cb = 16 * (2 * pp); f32x4 acc = (f32x4){0.f, 0.f, 0.f, 0.f};
#pragma unroll
        for (int kk = 0; kk < 4; ++kk) acc = __builtin_amdgcn_mfma_f32_16x16x4f32(Tm[(rb + fr) * LS + rb + 4 * kk + fq], Xm[pp * 576 + (4 * kk + fq) * 36 + fr], acc, 0, 0, 0);
#pragma unroll
        for (int r = 0; r < 4; ++r) Tm[(rb + 4 * fq + r) * LS + cb + fr] = -acc[r];
    }
    __syncthreads();
    if (F.wave < 4) {
        const int bi = F.wave >> 1, bj = F.wave & 1; f32x4 acc = (f32x4){0.f, 0.f, 0.f, 0.f};
#pragma unroll
        for (int kk = 0; kk < 8; ++kk) acc = __builtin_amdgcn_mfma_f32_16x16x4f32(Lm[(32 + 16 * bi + fr) * LS + 4 * kk + fq], Tm[(4 * kk + fq) * LS + 16 * bj + fr], acc, 0, 0, 0);
#pragma unroll
        for (int r = 0; r < 4; ++r) Xm[(16 * bi + 4 * fq + r) * 36 + 16 * bj + fr] = acc[r];
    }
    __syncthreads();
    if (F.wave < 4) {
        const int bi = F.wave >> 1, bj = F.wave & 1; f32x4 acc = (f32x4){0.f, 0.f, 0.f, 0.f};
#pragma unroll
        for (int kk = 0; kk < 8; ++kk) acc = __builtin_amdgcn_mfma_f32_16x16x4f32(Tm[(32 + 16 * bi + fr) * LS + 32 + 4 * kk + fq], Xm[(4 * kk + fq) * 36 + 16 * bj + fr], acc, 0, 0, 0);
#pragma unroll
        for (int r = 0; r < 4; ++r) Tm[(32 + 16 * bi + 4 * fq + r) * LS + 16 * bj + fr] = -acc[r];
    }
    __syncthreads();
    {
        const int i = F.tid >> 3, j0 = (F.tid & 7) * 8; const f32x4 a = *(const LAS f32x4*)(Tm + i * LS + j0), bq = *(const LAS f32x4*)(Tm + i * LS + j0 + 4);
        v4u w; w.x = pk2(a[0], a[1]); w.y = pk2(a[2], a[3]); w.z = pk2(bq[0], bq[1]); w.w = pk2(bq[2], bq[3]);
        *(LAS v4u*)(L + OFF_T + i * 144 + j0 * 2) = w;
    }
    __syncthreads();
#pragma unroll 1
    for (int x = 0; x < 8; ++x) {
        const int tile = F.wave * 8 + x, which = tile >> 5, ti = (tile >> 3) & 3, td = tile & 7;
        const LAS unsigned char* ap = L + OFF_T + (ti * 16 + fr) * 144 + fq * 16; const LAS unsigned char* bp = L + (which ? OFF_KBGT : OFF_VBT) + (td * 16 + fr) * 144 + fq * 16;
        f32x4 acc = (f32x4){0.f, 0.f, 0.f, 0.f};
#pragma unroll
        for (int kk = 0; kk < 2; ++kk) acc = __builtin_amdgcn_mfma_f32_16x16x32_bf16(lds_frag16(ap + kk * 64), lds_frag16(bp + kk * 64), acc, 0, 0, 0);
        const int d = td * 16 + fr;
#pragma unroll
        for (int r = 0; r < 4; ++r) { const int i = ti * 16 + 4 * fq + r;
            if (which == 0) Ug[i * 128 + d] = acc[r]; else Wg[i * 128 + d] = (bf16)(pk2(acc[r], 0.f) & 0xffffu); }
    }
    __syncthreads();
}

constexpr int SC_OW = 0, SC_OQG = 16384, SC_OKDT = 32768, SC_OQK = 49152, SC_OU = 57344, SC_BUF = 61440;
__device__ __forceinline__ void scan_issue(const Args& A, Frame& F, int ci, int sl, LAS unsigned char* dst) {
    const unsigned char* Wg = A.ws + WS_W + (size_t)ci * 16384; const unsigned char* QGg = A.ws + WS_QG + (size_t)ci * 16384;
    const unsigned char* KDTg = A.ws + WS_KDT + (size_t)ci * 16384; const unsigned char* QKg = A.ws + WS_QK + (size_t)ci * 8192; const unsigned char* Ug = A.ws + WS_U + (size_t)ci * 32768 + sl * 64;
#pragma unroll
    for (int j = 0; j < 9; ++j) {
        const int pi = (F.wave - 1) + 7 * j;
        if (pi < 60) {
            const unsigned char* src;
            if (pi < 32) { const int i = (pi & 15) * 64 + F.lane, r = i >> 4, c = (i & 15) ^ (r & 15); src = (pi < 16 ? Wg : QGg) + r * 256 + c * 16; }
            else if (pi < 56) { const int i = (pi < 48 ? pi - 32 : pi - 48) * 64 + F.lane, r = i >> 3, c = (i & 7) ^ ((r >> 1) & 7); src = (pi < 48 ? KDTg : QKg) + r * 128 + c * 16; }
            else { const int i = (pi - 56) * 64 + F.lane, r = i >> 2, c = i & 3; src = Ug + r * 512 + c * 16; }
            __builtin_amdgcn_global_load_lds((const unsigned*)src, (LAS unsigned*)(dst + pi * 1024), 16, 0, 0);
        }
    }
}
__device__ __forceinline__ bf16x8 frag2(const LAS unsigned char* p0, const LAS unsigned char* p1) { const v2u lo = *(const LAS v2u*)p0, hi = *(const LAS v2u*)p1; v4u w; w.x = lo.x; w.y = lo.y; w.z = hi.x; w.w = hi.y; return __builtin_bit_cast(bf16x8, w); }
__device__ __forceinline__ bf16x8 frag256(const LAS unsigned char* tile, int row, int kstep, int fq) { const int c = 4 * kstep + (fq >> 1), sw = row & 15; const LAS unsigned char* rp = tile + row * 256 + 8 * (fq & 1); return frag2(rp + ((c ^ sw) << 4), rp + (((c + 2) ^ sw) << 4)); }
__device__ __forceinline__ bf16x8 frag128(const LAS unsigned char* tile, int row, int kstep, int fq) { const int c = 4 * kstep + (fq >> 1), sw = (row >> 1) & 7; const LAS unsigned char* rp = tile + row * 128 + 8 * (fq & 1); return frag2(rp + ((c ^ sw) << 4), rp + (((c + 2) ^ sw) << 4)); }
__device__ __forceinline__ bf16x8 pack_pair(const pg8::f32x4& a, const pg8::f32x4& b) { v4u w; w.x = pk2(a[0], a[1]); w.y = pk2(a[2], a[3]); w.z = pk2(b[0], b[1]); w.w = pk2(b[2], b[3]); return __builtin_bit_cast(bf16x8, w); }
__device__ __forceinline__ void scan_unit(const Args& A, Frame& F, int b, int h, int sl) {
    using pg8::f32x4;
    LAS unsigned char* L = F.lds + RING_OFF;
    const int ci0 = (b * NH + h) * 32; const int fr = F.lane & 15, fq = F.lane >> 4;
    float* Og = (float*)(A.ws + WS_RE); const float* GLg = (const float*)(A.ws + WS_GL);
    if (F.wave > 0) { scan_issue(A, F, ci0, sl, L); scan_issue(A, F, ci0 + 1, sl, L + SC_BUF); asm volatile("s_waitcnt vmcnt(9)" ::: "memory"); }
    __builtin_amdgcn_s_barrier(); asm volatile("" ::: "memory");
    f32x4 S[8];
#pragma unroll
    for (int i = 0; i < 8; ++i) S[i] = (f32x4){0.f, 0.f, 0.f, 0.f};
    float gl = GLg[ci0];
#pragma unroll 1
    for (int n = 0; n < 32; ++n) {
        if (F.wave == 0) {
            const LAS unsigned char* B = L + (n & 1) * SC_BUF;
            const float gln = GLg[ci0 + (n < 31 ? n + 1 : n)];
            bf16x8 Sb[4];
#pragma unroll
            for (int kk = 0; kk < 4; ++kk) Sb[kk] = pack_pair(S[2 * kk], S[2 * kk + 1]);
            f32x4 vn[4];
#pragma unroll
            for (int tb = 0; tb < 4; ++tb) { f32x4 p1 = (f32x4){0.f, 0.f, 0.f, 0.f};
#pragma unroll
                for (int kk = 0; kk < 4; ++kk) p1 = __builtin_amdgcn_mfma_f32_16x16x32_bf16(frag256(B + SC_OW, 16 * tb + fr, kk, fq), Sb[kk], p1, 0, 0, 0);
#pragma unroll
                for (int r = 0; r < 4; ++r) vn[tb][r] = *(const LAS float*)(B + SC_OU + (16 * tb + 4 * fq + r) * 64 + fr * 4) - p1[r]; }
            bf16x8 Vb[2]; Vb[0] = pack_pair(vn[0], vn[1]); Vb[1] = pack_pair(vn[2], vn[3]);
            const size_t orow = (size_t)(b * SEQ + n * 64);
#pragma unroll
            for (int blk = 0; blk < 8; ++blk) { f32x4 s = S[blk] * gl;
#pragma unroll
                for (int kt = 0; kt < 2; ++kt) s = __builtin_amdgcn_mfma_f32_16x16x32_bf16(frag128(B + SC_OKDT, 16 * blk + fr, kt, fq), Vb[kt], s, 0, 0, 0);
                S[blk] = s; }
#pragma unroll
            for (int tb = 0; tb < 4; ++tb) { f32x4 o = (f32x4){0.f, 0.f, 0.f, 0.f};
#pragma unroll
                for (int kk = 0; kk < 4; ++kk) o = __builtin_amdgcn_mfma_f32_16x16x32_bf16(frag256(B + SC_OQG, 16 * tb + fr, kk, fq), Sb[kk], o, 0, 0, 0);
#pragma unroll
                for (int kt = 0; kt < 2; ++kt) o = __builtin_amdgcn_mfma_f32_16x16x32_bf16(frag128(B + SC_OQK, 16 * tb + fr, kt, fq), Vb[kt], o, 0, 0, 0);
#pragma unroll
                for (int r = 0; r < 4; ++r) Og[(orow + 16 * tb + 4 * fq + r) * 512 + h * 128 + sl * 16 + fr] = o[r]; }
            gl = gln;
            asm volatile("s_waitcnt lgkmcnt(0)" ::: "memory");
        } else {
            asm volatile("s_waitcnt vmcnt(0)" ::: "memory");
        }
        __builtin_amdgcn_s_barrier(); asm volatile("" ::: "memory");
        if (F.wave > 0 && n + 2 < 32) scan_issue(A, F, ci0 + n + 2, sl, L + (n & 1) * SC_BUF);
    }
    if (F.wave == 0) {
        float* od = A.out + OUT_DLP + (size_t)(b * NH + h) * DKV * DKV;
#pragma unroll
        for (int blk = 0; blk < 8; ++blk)
#pragma unroll
            for (int r = 0; r < 4; ++r) od[(16 * blk + 4 * fq + r) * DKV + sl * 16 + fr] = S[blk][r];
    }
    asm volatile("s_waitcnt vmcnt(0) lgkmcnt(0)" ::: "memory"); __builtin_amdgcn_s_barrier(); asm volatile("" ::: "memory");
}
__device__ __forceinline__ void delta_sample_seq(const Args& A, Frame& F, int s) {
    const bf16* QC = (const bf16*)(A.ws + WS_RC); const float* BG = (const float*)(A.ws + WS_BG); float* Og = (float*)(A.ws + WS_RE);
    const size_t row = (size_t)MP + s;
    LAS float* qs = (LAS float*)(F.lds + RING_OFF); LAS float* ks = qs + 128; LAS float* red = qs + 256;
    const int dv = F.tid & 127, grp = F.tid >> 7;
    const float* S0b = A.in[I_SDELTA] + (size_t)s * NH * DKV * DKV + (size_t)(grp * 32) * DKV + dv; float* Sob = A.out + OUT_DLS + (size_t)s * NH * DKV * DKV + (size_t)(grp * 32) * DKV + dv;
    float s0[32], s1[32];
#pragma unroll
    for (int i = 0; i < 32; ++i) s0[i] = S0b[(size_t)i * DKV];
#pragma unroll 1
    for (int h = 0; h < NH; ++h) {
        if (h + 1 < NH) {
#pragma unroll
            for (int i = 0; i < 32; ++i) s1[i] = S0b[(size_t)(h + 1) * DKV * DKV + (size_t)i * DKV]; }
        if (F.tid < 128) { qs[F.tid] = bf2f(QC[row * QKVN + h * 128 + F.tid]); ks[F.tid] = bf2f(QC[row * QKVN + 512 + h * 128 + F.tid]); }
        const float v = bf2f(QC[row * QKVN + 1024 + h * 128 + dv]);
        const float beta = BG[row * 8 + h], eg = __expf(BG[row * 8 + 4 + h]);
        __syncthreads();
        float part = 0.f;
#pragma unroll
        for (int i = 0; i < 32; ++i) part += ks[grp * 32 + i] * s0[i];
        red[grp * 128 + dv] = part;
        __syncthreads();
        const float kS = (red[dv] + red[128 + dv]) + (red[256 + dv] + red[384 + dv]);
        const float vnew = beta * (v - eg * kS);
        __syncthreads();
        float po = 0.f;
#pragma unroll
        for (int i = 0; i < 32; ++i) { const float sn = eg * s0[i] + ks[grp * 32 + i] * vnew; Sob[(size_t)h * DKV * DKV + (size_t)i * DKV] = sn; po += qs[grp * 32 + i] * sn; }
        red[grp * 128 + dv] = po;
        __syncthreads();
        if (F.tid < 128) Og[row * 512 + h * 128 + dv] = (red[dv] + red[128 + dv]) + (red[256 + dv] + red[384 + dv]);
        __syncthreads();
#pragma unroll
        for (int i = 0; i < 32; ++i) s0[i] = s1[i];
    }
}

__device__ __forceinline__ void ogate_row(const Args& A, Frame& F, int m, const pg8::f32x4& n0, const pg8::f32x4& n1) {
    const bf16* PB = (const bf16*)(A.ws + WS_RA); bf16* CD = (bf16*)(A.ws + WS_RB); const float* Og = (const float*)(A.ws + WS_RE); const int ch0 = 8 * F.lane;
    const f32x4 o0 = *(const GAS f32x4*)(Og + (size_t)m * 512 + ch0), o1 = *(const GAS f32x4*)(Og + (size_t)m * 512 + ch0 + 4);
    const v4u zz = *(const GAS v4u*)(PB + (size_t)m * PBLD + 2048 + ch0); float z[8]; unpack8(zz, z);
    float ss = (o0[0] * o0[0] + o0[1] * o0[1]) + (o0[2] * o0[2] + o0[3] * o0[3]) + (o1[0] * o1[0] + o1[1] * o1[1]) + (o1[2] * o1[2] + o1[3] * o1[3]);
    ss += __shfl_xor(ss, 1); ss += __shfl_xor(ss, 2); ss += __shfl_xor(ss, 4); ss += __shfl_xor(ss, 8);
    const float rstd = 1.f / sqrtf(ss * (1.f / 128.f) + RMS_EPS);
    float d[8];
#pragma unroll
    for (int i = 0; i < 4; ++i) { d[i] = o0[i] * rstd * n0[i] * silu(z[i]); d[4 + i] = o1[i] * rstd * n1[i] * silu(z[4 + i]); }
    *(GAS v4u*)(CD + (size_t)m * DM + 512 + ch0) = pack8(d);
}
__device__ __forceinline__ void ogate_phase(const Args& A, Frame& F, int blk, int nblk) {
    const int gw = blk * NWAVES + F.wave, NGW = nblk * NWAVES; const int ch0 = 8 * F.lane;
    const f32x4 n0 = *(const f32x4*)(A.in[I_DNN] + (ch0 & 127)), n1 = *(const f32x4*)(A.in[I_DNN] + (ch0 & 127) + 4);
    for (int m = gw; m < MP; m += NGW) ogate_row(A, F, m, n0, n1);
}
__device__ __forceinline__ void sample_mixer(const Args& A, Frame& F, int s) {
    conv_sample(A, F, s);
    VM_WAIT(); __syncthreads();
    delta_sample_seq(A, F, s);
    VM_WAIT(); __syncthreads();
    if (F.wave == 0) { const int ch0 = 8 * F.lane; const f32x4 n0 = *(const f32x4*)(A.in[I_DNN] + (ch0 & 127)), n1 = *(const f32x4*)(A.in[I_DNN] + (ch0 & 127) + 4); ogate_row(A, F, MP + s, n0, n1); }
}

__device__ __forceinline__ void attn_issue(const Args& A, Frame& F, int st, int b, int h, LAS unsigned char* slot) {
    const bf16* KB = (const bf16*)(A.ws + WS_KB); const bf16* VT = (const bf16*)(A.ws + WS_VT);
#pragma unroll
    for (int it = 0; it < 4; ++it) {
        const int idx = it * 512 + F.tid; const bf16* src;
        if (st < 4) { const int r = idx >> 5, p = idx & 31, c = p ^ (r & 15); src = KB + (size_t)(b * NMEM + 64 * st + r) * DM + h * MHD + 8 * c; }
        else { const int r = idx >> 3, p = idx & 7, c = p ^ ((r >> 1) & 7); src = VT + (size_t)(h * MHD + r) * (NB * NMEM) + b * NMEM + 64 * (st - 4) + 8 * c; }
        __builtin_amdgcn_global_load_lds((const unsigned*)src, (LAS unsigned*)(slot + it * 8192 + F.wave * 1024), 16, 0, 0);
    }
}
__device__ __forceinline__ void attn_unit(const Args& A, Frame& F, int rt, int h) {
    using pg8::f32x4;
    const int b = rt >> 4; const int fr = F.lane & 15, fq = F.lane >> 4;
    const bf16* Q = (const bf16*)(A.ws + WS_RB); bf16* AO = (bf16*)(A.ws + WS_RD);
    const size_t qoff = (size_t)(rt * 128 + F.wave * 16 + fr) * DM + h * MHD;
    const bf16* qrow = Q + qoff; bf16* orow = AO + qoff;
    LAS unsigned char* L = F.lds + RING_OFF;
    bf16x8 qf[8];
#pragma unroll
    for (int ks = 0; ks < 8; ++ks) qf[ks] = *(const GAS bf16x8*)(qrow + 32 * ks + 8 * fq);
    attn_issue(A, F, 0, b, h, L); attn_issue(A, F, 1, b, h, L + 32768);
    f32x4 sacc[16];
#pragma unroll
    for (int st = 0; st < 4; ++st) {
        asm volatile("s_waitcnt vmcnt(4)" ::: "memory");
        __builtin_amdgcn_s_barrier(); asm volatile("" ::: "memory");
        attn_issue(A, F, st + 2, b, h, L + ((st + 2) & 3) * 32768);
        const LAS unsigned char* slot = L + (st & 3) * 32768;
#pragma unroll
        for (int kbl = 0; kbl < 4; ++kbl) { f32x4 acc = (f32x4){0.f, 0.f, 0.f, 0.f}; const int row = 16 * kbl + fr;
#pragma unroll
            for (int ks = 0; ks < 8; ++ks) { const bf16x8 a = *(const LAS bf16x8*)(slot + row * 512 + (((4 * ks + fq) ^ (row & 15)) << 4)); acc = __builtin_amdgcn_mfma_f32_16x16x32_bf16(a, qf[ks], acc, 0, 0, 0); }
            sacc[4 * st + kbl] = acc; }
    }
    float mx = -3.0e38f;
#pragma unroll
    for (int kb = 0; kb < 16; ++kb)
#pragma unroll
        for (int i = 0; i < 4; ++i) mx = fmaxf(mx, sacc[kb][i]);
    mx = fmaxf(mx, __shfl_xor(mx, 16)); mx = fmaxf(mx, __shfl_xor(mx, 32));
    float lsum = 0.f; bf16x8 pb[8];
#pragma unroll
    for (int kb = 0; kb < 16; ++kb)
#pragma unroll
        for (int i = 0; i < 4; ++i) { const float p = __builtin_amdgcn_exp2f(sacc[kb][i] - mx); sacc[kb][i] = p; lsum += p; }
#pragma unroll
    for (int s = 0; s < 8; ++s) pb[s] = pack_pair(sacc[2 * s], sacc[2 * s + 1]);
    lsum += __shfl_xor(lsum, 16); lsum += __shfl_xor(lsum, 32);
    f32x4 oacc[16];
#pragma unroll
    for (int db = 0; db < 16; ++db) oacc[db] = (f32x4){0.f, 0.f, 0.f, 0.f};
#pragma unroll
    for (int st = 4; st < 8; ++st) {
        if (st + 1 < 8) asm volatile("s_waitcnt vmcnt(4)" ::: "memory"); else asm volatile("s_waitcnt vmcnt(0)" ::: "memory");
        __builtin_amdgcn_s_barrier(); asm volatile("" ::: "memory");
        if (st + 2 < 8) attn_issue(A, F, st + 2, b, h, L + ((st + 2) & 3) * 32768);
        const LAS unsigned char* slot = L + (st & 3) * 32768; const int t = st - 4;
#pragma unroll
        for (int db = 0; db < 16; ++db) { const int row = 16 * db + fr; const int sw = (row >> 1) & 7;
#pragma unroll
            for (int s2 = 0; s2 < 2; ++s2) { const int c = 4 * s2 + (fq >> 1);
                const v2u lo = *(const LAS v2u*)(slot + row * 128 + ((c ^ sw) << 4) + 8 * (fq & 1)), hi = *(const LAS v2u*)(slot + row * 128 + (((c + 2) ^ sw) << 4) + 8 * (fq & 1));
                v4u aw; aw.x = lo.x; aw.y = lo.y; aw.z = hi.x; aw.w = hi.y;
                oacc[db] = __builtin_amdgcn_mfma_f32_16x16x32_bf16(__builtin_bit_cast(bf16x8, aw), pb[2 * t + s2], oacc[db], 0, 0, 0); } }
    }
    const float inv = 1.f / lsum;
#pragma unroll
    for (int db = 0; db < 16; ++db) { v2u w; w.x = pk2(oacc[db][0] * inv, oacc[db][1] * inv); w.y = pk2(oacc[db][2] * inv, oacc[db][3] * inv); *(GAS v2u*)(orow + 16 * db + 4 * fq) = w; }
    LDS_WAIT(); __builtin_amdgcn_s_barrier(); asm volatile("" ::: "memory");
}
__device__ __forceinline__ void attn_sample(const Args& A, Frame& F, int s, int h) {
    const bf16* qrow = (const bf16*)(A.ws + WS_RB) + (size_t)(MP + s) * DM + h * MHD; bf16* orow = (bf16*)(A.ws + WS_RD) + (size_t)(MP + s) * DM + h * MHD;
    const int g = F.lane >> 4, dl = F.lane & 15;
    const float* Kc = A.in[I_CMK] + (size_t)s * NMEM * DM + h * MHD + (size_t)(32 * F.wave + g) * DM + 4 * dl;
    const float* Vc = A.in[I_CMV] + (size_t)s * NMEM * DM + h * MHD + (size_t)(32 * F.wave + g) * DM + 4 * dl;
    LAS float* pl = (LAS float*)(F.lds + RING_OFF); LAS float* wred = pl + 256; LAS float* ored = pl + 512;
    f32x4 kv[8][4];
#pragma unroll
    for (int it = 0; it < 8; ++it)
#pragma unroll
        for (int i = 0; i < 4; ++i) kv[it][i] = *(const GAS f32x4*)(Kc + (size_t)(4 * it) * DM + 64 * i);
    f32x4 q[4];
#pragma unroll
    for (int i = 0; i < 4; ++i) { const v2u x = *(const GAS v2u*)(qrow + 64 * i + 4 * dl); q[i] = (f32x4){bflo(x.x), bfhi(x.x), bflo(x.y), bfhi(x.y)}; }
    __builtin_amdgcn_sched_barrier(0);
    float myscore = -3.0e38f;
#pragma unroll
    for (int it = 0; it < 8; ++it) { float d = 0.f;
#pragma unroll
        for (int i = 0; i < 4; ++i) d += (kv[it][i][0] * q[i][0] + kv[it][i][1] * q[i][1]) + (kv[it][i][2] * q[i][2] + kv[it][i][3] * q[i][3]);
        d += __shfl_xor(d, 1); d += __shfl_xor(d, 2); d += __shfl_xor(d, 4); d += __shfl_xor(d, 8);
        if (dl == it) myscore = d; }
#pragma unroll
    for (int it = 0; it < 8; ++it)
#pragma unroll
        for (int i = 0; i < 4; ++i) kv[it][i] = *(const GAS f32x4*)(Vc + (size_t)(4 * it) * DM + 64 * i);
    const float m = wave_max(myscore);
    if (F.lane == 0) wred[F.wave] = m;
    __syncthreads();
    float gm = wred[0];
#pragma unroll
    for (int i = 1; i < 8; ++i) gm = fmaxf(gm, wred[i]);
    const float p = (dl < 8) ? __builtin_amdgcn_exp2f(myscore - gm) : 0.f;
    if (dl < 8) pl[32 * F.wave + 4 * dl + g] = p;
    const float ws_ = wave_sum(p);
    if (F.lane == 0) wred[8 + F.wave] = ws_;
    __syncthreads();
    float tot = 0.f;
#pragma unroll
    for (int i = 0; i < 8; ++i) tot += wred[8 + i];
    f32x4 acc[4];
#pragma unroll
    for (int i = 0; i < 4; ++i) acc[i] = (f32x4){0.f, 0.f, 0.f, 0.f};
#pragma unroll
    for (int it = 0; it < 8; ++it) { const float pi = pl[32 * F.wave + 4 * it + g];
#pragma unroll
        for (int i = 0; i < 4; ++i) acc[i] = acc[i] + kv[it][i] * pi; }
#pragma unroll
    for (int i = 0; i < 4; ++i)
#pragma unroll
        for (int e = 0; e < 4; ++e) { float v = acc[i][e]; v += __shfl_xor(v, 16); v += __shfl_xor(v, 32); acc[i][e] = v; }
    if (g == 0) {
#pragma unroll
        for (int i = 0; i < 4; ++i) *(LAS f32x4*)(ored + F.wave * 256 + 64 * i + 4 * dl) = acc[i]; }
    __syncthreads();
    if (F.tid < 256) { float o = 0.f;
#pragma unroll
        for (int w = 0; w < 8; ++w) o += ored[w * 256 + F.tid];
        orow[F.tid] = (bf16)(pk2(o / tot, 0.f) & 0xffffu); }
    __syncthreads();
}

typedef unsigned v2u_ __attribute__((ext_vector_type(2)));
template <int NKS, class Epi>
__device__ __forceinline__ void small_gemm_item(const Frame& F, const bf16* Arow0, const bf16* Bt, int pn, int j, int rq, const Epi& E) {
    using pg8::f32x4;
    constexpr int K = NKS * 256;
    const int fr = F.lane & 15, fq = F.lane >> 4;
    const bf16* ap = Arow0 + (size_t)(32 * rq + fr) * K + F.wave * (K / 8) + 8 * fq;
    const bf16* b0 = Bt + (size_t)(256 * pn + 16 * j + fr) * K + F.wave * (K / 8) + 8 * fq; const bf16* b1 = b0 + (size_t)128 * K;
    bf16x8 a0[NKS], a1[NKS], x0[NKS], x1[NKS];
#pragma unroll
    for (int u = 0; u < NKS; ++u) { a0[u] = *(const GAS bf16x8*)(ap + 32 * u); a1[u] = *(const GAS bf16x8*)(ap + (size_t)16 * K + 32 * u); x0[u] = *(const GAS bf16x8*)(b0 + 32 * u); x1[u] = *(const GAS bf16x8*)(b1 + 32 * u); }
    __builtin_amdgcn_sched_barrier(0);
    f32x4 c00 = (f32x4){0.f, 0.f, 0.f, 0.f}, c01 = c00, c10 = c00, c11 = c00;
#pragma unroll
    for (int u = 0; u < NKS; ++u) {
        c00 = __builtin_amdgcn_mfma_f32_16x16x32_bf16(x0[u], a0[u], c00, 0, 0, 0); c01 = __builtin_amdgcn_mfma_f32_16x16x32_bf16(x1[u], a0[u], c01, 0, 0, 0);
        c10 = __builtin_amdgcn_mfma_f32_16x16x32_bf16(x0[u], a1[u], c10, 0, 0, 0); c11 = __builtin_amdgcn_mfma_f32_16x16x32_bf16(x1[u], a1[u], c11, 0, 0, 0);
    }
    LAS f32x4* red = (LAS f32x4*)(F.lds + RING_OFF);
    red[(F.wave * 4 + 0) * 64 + F.lane] = c00; red[(F.wave * 4 + 1) * 64 + F.lane] = c01; red[(F.wave * 4 + 2) * 64 + F.lane] = c10; red[(F.wave * 4 + 3) * 64 + F.lane] = c11;
    __syncthreads();
    if (F.wave < 2) {
        f32x4 sA = (f32x4){0.f, 0.f, 0.f, 0.f}, sB = sA;
#pragma unroll
        for (int w = 0; w < 8; ++w) { sA = sA + red[(w * 4 + 2 * F.wave) * 64 + F.lane]; sB = sB + red[(w * 4 + 2 * F.wave + 1) * 64 + F.lane]; }
        E(32 * rq + 16 * F.wave + fr, pn, j, fq, sA, sB);
    }
    __syncthreads();
}
__device__ __forceinline__ v2u_ pk4(const pg8::f32x4& a) { v2u_ w; w.x = pk2(a[0], a[1]); w.y = pk2(a[2], a[3]); return w; }
struct SEpiIn { bf16* PBs;
    __device__ __forceinline__ void operator()(int m, int pn, int j, int fq, const pg8::f32x4& a, const pg8::f32x4& b) const {
        if (pn < 4) { pg8::f32x4 v;
#pragma unroll
            for (int i = 0; i < 4; ++i) v[i] = a[i] * sigm(b[i]);
            *(GAS v2u_*)(PBs + (size_t)m * PBLD + 128 * pn + 16 * j + 4 * fq) = pk4(v); }
        else { bf16* rp = PBs + (size_t)m * PBLD + 256 * pn - 512 + 16 * j + 4 * fq; *(GAS v2u_*)rp = pk4(a); *(GAS v2u_*)(rp + 128) = pk4(b); }
    } };
template <int MODE> struct SEpiRes { const float* basef; const bf16* baseb; float* outf; bf16* outb; float* ss;
    __device__ __forceinline__ void operator()(int m, int pn, int j, int fq, const pg8::f32x4& a, const pg8::f32x4& b) const {
        const size_t off = (size_t)m * DM + 256 * pn + 16 * j + 4 * fq;
        pg8::f32x4 b0, b1;
        if (MODE == 0) { b0 = *(const GAS pg8::f32x4*)(basef + off); b1 = *(const GAS pg8::f32x4*)(basef + off + 128); }
        else { const v2u_ w0 = *(const GAS v2u_*)(baseb + off), w1 = *(const GAS v2u_*)(baseb + off + 128); b0 = pg8::bf4lo(w0.x, w0.y); b1 = pg8::bf4lo(w1.x, w1.y); }
        const pg8::f32x4 v0 = a + b0, v1 = b + b1;
        if (MODE == 2) { *(GAS pg8::f32x4*)(outf + off) = v0; *(GAS pg8::f32x4*)(outf + off + 128) = v1; }
        else { *(GAS v2u_*)(outb + off) = pk4(v0); *(GAS v2u_*)(outb + off + 128) = pk4(v1); }
        float s = (v0[0] * v0[0] + v0[1] * v0[1]) + (v0[2] * v0[2] + v0[3] * v0[3]) + (v1[0] * v1[0] + v1[1] * v1[1]) + (v1[2] * v1[2] + v1[3] * v1[3]);
        s += __shfl_xor(s, 16); s += __shfl_xor(s, 32);
        if (fq == 0) atomicAdd(ss + m, s);
    } };
struct SEpiQ { bf16* Qs; const float* ss; float c2;
    __device__ __forceinline__ void operator()(int m, int pn, int j, int fq, const pg8::f32x4& a, const pg8::f32x4& b) const {
        const float rs = __builtin_amdgcn_rsqf(ss[m] * (1.f / 1024.f) + RMS_EPS) * c2; bf16* rp = Qs + (size_t)m * DM + 256 * pn + 16 * j + 4 * fq;
        *(GAS v2u_*)rp = pk4(a * rs); *(GAS v2u_*)(rp + 128) = pk4(b * rs);
    } };
struct SEpiGU { bf16* Ts; const float* ss;
    __device__ __forceinline__ void operator()(int m, int pn, int j, int fq, const pg8::f32x4& a, const pg8::f32x4& b) const {
        const float rs = __builtin_amdgcn_rsqf(ss[m] * (1.f / 1024.f) + RMS_EPS); pg8::f32x4 v;
#pragma unroll
        for (int i = 0; i < 4; ++i) v[i] = silu(a[i] * rs) * (b[i] * rs);
        *(GAS v2u_*)(Ts + (size_t)m * DFF + 128 * pn + 16 * j + 4 * fq) = pk4(v);
    } };

__device__ __forceinline__ void final_norm_phase(const Args& A, Frame& F) {
    const int gw = F.vcu * NWAVES + F.wave, NGW = F.G * NWAVES; const float* ss = (const float*)(F.ctl + CW_SS3);
    f32x4 gn[4];
#pragma unroll
    for (int j = 0; j < 4; ++j) gn[j] = *(const f32x4*)(A.in[I_NF] + 256 * j + 4 * F.lane);
    for (int m = MP + gw; m < MV; m += NGW) {
        GAS f32x4* xr = (GAS f32x4*)(A.out + (size_t)m * DM) + F.lane;
        const float rstd = 1.f / sqrtf(ss[m] * (1.f / DM) + RMS_EPS);
#pragma unroll
        for (int j = 0; j < 4; ++j) { const f32x4 v = xr[64 * j]; xr[64 * j] = v * rstd * gn[j]; }
    }
}

__global__ void __launch_bounds__(NWAVES * 64, 2) hymba_fwd(Args args) {
    extern __shared__ __attribute__((aligned(16))) unsigned char lds[];
    Frame F;
    F.lds = (LAS unsigned char*)lds;
    F.MISC = (volatile LAS unsigned*)(F.lds + MISC_OFF);
    F.tid = threadIdx.x; F.lane = F.tid & 63; F.wave = __builtin_amdgcn_readfirstlane(F.tid >> 6);
    F.G = gridDim.x; { const int bx = blockIdx.x; F.vcu = (F.G % 8 == 0) ? (bx % 8) * (F.G / 8) + bx / 8 : bx; }
    F.ctl = (gu32*)(args.ws + WS_CTL);
    const Args& A = args;
    for (int u = F.tid; u < (LDS_BYTES - LDSCTL_OFF) / 4; u += NWAVES * 64) ((LAS unsigned*)(F.lds + LDSCTL_OFF))[u] = 0u;
    __syncthreads();
#if MK_PER_PHASE
#define GRID_BAR() do { } while (0)
#else
    XcdBarrier bar = xcd_barrier_post((unsigned*)(F.ctl + CW_BAR) + args.li * XCD_BAR_WORDS, F.MISC + 8);
#define GRID_BAR() xcd_barrier(bar)
#endif
#if 1
    const int lo = args.ph_lo, hi = args.ph_hi;
    const bool rep = (args.li != 0);
#define REPK(k) (rep && lo == (k))
#ifdef ONLY_PH
#define IN(k) ((k) == ONLY_PH && lo <= (k) && (k) < hi)
#else
#define IN(k) (lo <= (k) && (k) < hi)
#endif
#else
#define REPK(k) false
#define IN(k) true
#endif
#define BOTH(k) (IN(k) && IN((k) + 1))
#define PH_PTRS unsigned char* const ws = args.ws; bf16* const RA = (bf16*)(ws + WS_RA); bf16* const RB = (bf16*)(ws + WS_RB); bf16* const RC = (bf16*)(ws + WS_RC); \
    bf16* const AO = (bf16*)(ws + WS_RD); bf16* const X1B = (bf16*)(ws + WS_RE); \
    float* const SS1 = (float*)(ws + WS_CTL) + CW_SS1; float* const SS2 = (float*)(ws + WS_CTL) + CW_SS2; float* const SS3 = (float*)(ws + WS_CTL) + CW_SS3; float* const SSD = (float*)(ws + WS_CTL) + 163840; \
    (void)RA; (void)RB; (void)RC; (void)AO; (void)X1B; (void)SS1; (void)SS2; (void)SS3; (void)SSD;

    if (IN(0)) { p0_prologue(A, F); if (BOTH(0)) GRID_BAR(); }
    if (IN(1)) { PH_PTRS
        { pg8::Gemm g{RB, (const bf16*)(ws + WS_WIN), MP, 3072, DM}; pg8::StaticOrder S; S.init(MP, 3072, F.G, (int)blockIdx.x);
          pg8::EpiIn E{RA};
          pg8::gemm_phase<pg8::EpiIn, pg8::StaticOrder, true, true>(F.lds + RING_OFF, g, S, E); }
        { const SEpiIn E{RA + (size_t)MP * PBLD};
          for (int i = F.G - 1 - (int)blockIdx.x; i < 96 * 4; i += F.G) small_gemm_item<4>(F, RB + (size_t)MP * DM, (const bf16*)(ws + WS_WIN), i >> 5, (i >> 2) & 7, i & 3, E); }
        if (BOTH(1)) GRID_BAR();
    }
    if (IN(2)) {
        for (int it = F.vcu; it < 256; it += F.G) { const int b = it >> 5, tile = it & 31;
#ifdef PROBE_PH
            if (!(args.pad & 1))
#endif
            conv_tile(A, F, b, tile);
            VM_WAIT(); __syncthreads();
#ifdef PROBE_PH
            if (!(args.pad & 2))
#endif
            _Pragma("unroll 1") for (int h = 0; h < NH; ++h) d1_chunk(A, F, (b * NH + h) * 32 + tile); }
#ifdef PROBE_PH
        if (!(args.pad & 4))
#endif
        for (int s = F.G - 1 - F.vcu; s < DEC; s += F.G) sample_mixer(A, F, s);
        if (BOTH(2)) GRID_BAR();
    }
    if (IN(3)) { PH_PTRS
        for (int u = F.vcu; u < 256; u += F.G) scan_unit(A, F, u >> 5, (u >> 3) & 3, u & 7);
        { const SEpiRes<0> SE{A.in[I_XS], nullptr, nullptr, X1B + (size_t)MP * DM, (REPK(3) ? SSD : SS1) + MP};
          for (int i = F.G - 1 - (int)blockIdx.x; i < 32 * 4; i += F.G) small_gemm_item<4>(F, RB + (size_t)MP * DM, (const bf16*)(ws + WS_WOUT), i >> 5, (i >> 2) & 7, i & 3, SE); }
        if (BOTH(3)) GRID_BAR();
    }
    if (IN(4)) { PH_PTRS
        if ((int)blockIdx.x < 64 && F.G > 64) {
            pg8::Gemm g{(const bf16*)(ws + WS_MEMN), (const bf16*)(ws + WS_WMKV), NB * NMEM, 2048, DM}; pg8::StaticOrder S; S.init(NB * NMEM, 2048, 64, (int)blockIdx.x);
            pg8::EpiKV E{A.out + OUT_MKP, A.out + OUT_MVP, (bf16*)(ws + WS_KB), (bf16*)(ws + WS_VT)};
            pg8::gemm_phase<pg8::EpiKV, pg8::StaticOrder, true, true>(F.lds + RING_OFF, g, S, E);
        } else ogate_phase(A, F, (int)blockIdx.x - 64, F.G - 64);
        { const SEpiQ SE{RB + (size_t)MP * DM, SS1 + MP, ATT_C2};
          for (int i = F.G - 1 - (int)blockIdx.x; i < 32 * 4; i += F.G) small_gemm_item<4>(F, X1B + (size_t)MP * DM, (const bf16*)(ws + WS_WMQ), i >> 5, (i >> 2) & 7, i & 3, SE); }
        if (BOTH(4)) GRID_BAR();
    }
    if (IN(5)) { PH_PTRS
        const bool stream_first = (((int)blockIdx.x >> 3) & 1) != 0;
        if (stream_first) { _Pragma("unroll 1") for (int it = F.vcu; it < DEC * NH; it += F.G) attn_sample(A, F, it >> 2, it & 3); }
        { pg8::Gemm g{RB, (const bf16*)(ws + WS_WOUT), MP, DM, DM}; pg8::StaticOrder S; S.init(MP, DM, F.G, (int)blockIdx.x);
          pg8::EpiRes<true> E{A.in[I_XP], nullptr, X1B, REPK(5) ? SSD : SS1};
          pg8::gemm_phase<pg8::EpiRes<true>, pg8::StaticOrder, true, true>(F.lds + RING_OFF, g, S, E); }
        if (!stream_first) { _Pragma("unroll 1") for (int it = F.vcu; it < DEC * NH; it += F.G) attn_sample(A, F, it >> 2, it & 3); }
        if (BOTH(5)) GRID_BAR();
    }
    if (IN(6)) { PH_PTRS
        pg8::Gemm g{X1B, (const bf16*)(ws + WS_WMQ), MP, DM, DM}; pg8::StaticOrder S; S.init(MP, DM, F.G, (int)blockIdx.x);
        pg8::EpiQ E{RB, SS1, ATT_C2};
        pg8::gemm_phase<pg8::EpiQ, pg8::StaticOrder, true, true>(F.lds + RING_OFF, g, S, E);
        { pg8::Unit u; _Pragma("unroll 1") for (int i = 0; i < 2 * 64; ++i) { if (!S.next(i >> 1, u)) break; attn_unit(A, F, 2 * u.pm + (i & 1), u.pn); } }
        { const SEpiRes<1> SE{nullptr, X1B + (size_t)MP * DM, nullptr, RC + (size_t)MP * DM, (REPK(6) ? SSD : SS2) + MP};
          for (int i = F.G - 1 - (int)blockIdx.x; i < 32 * 4; i += F.G) small_gemm_item<4>(F, AO + (size_t)MP * DM, (const bf16*)(ws + WS_WMO), i >> 5, (i >> 2) & 7, i & 3, SE); }
        if (BOTH(6)) GRID_BAR();
    }
    if (IN(7)) { PH_PTRS
        pg8::Gemm g{AO, (const bf16*)(ws + WS_WMO), MP, DM, DM}; pg8::StaticOrder S; S.init(MP, DM, F.G, (int)blockIdx.x);
        pg8::EpiRes<false> E{nullptr, X1B, RC, REPK(7) ? SSD : SS2};
        pg8::gemm_phase<pg8::EpiRes<false>, pg8::StaticOrder, true, true>(F.lds + RING_OFF, g, S, E);
        { const SEpiGU SE{RA + (size_t)MP * DFF, SS2 + MP};
          for (int i = F.G - 1 - (int)blockIdx.x; i < 176 * 4; i += F.G) small_gemm_item<4>(F, RC + (size_t)MP * DM, (const bf16*)(ws + WS_WGU), i >> 5, (i >> 2) & 7, i & 3, SE); }
        if (BOTH(7)) GRID_BAR();
    }
    if (IN(8)) { PH_PTRS
        pg8::Gemm g{RC, (const bf16*)(ws + WS_WGU), MP, 2 * DFF, DM}; pg8::StaticOrder S; S.init(MP, 2 * DFF, F.G, (int)blockIdx.x);
        pg8::EpiGU E{RA, SS2};
        pg8::gemm_phase<pg8::EpiGU, pg8::StaticOrder, true, true>(F.lds + RING_OFF, g, S, E);
        { const SEpiRes<2> SE{nullptr, RC + (size_t)MP * DM, A.out + (size_t)MP * DM, nullptr, (REPK(8) ? SSD : SS3) + MP};
          for (int i = F.G - 1 - (int)blockIdx.x; i < 32 * 4; i += F.G) small_gemm_item<11>(F, RA + (size_t)MP * DFF, (const bf16*)(ws + WS_WDN), i >> 5, (i >> 2) & 7, i & 3, SE); }
        if (BOTH(8)) GRID_BAR();
    }
    if (IN(9)) { PH_PTRS
        final_norm_phase(A, F);
        pg8::Gemm g{RA, (const bf16*)(ws + WS_WDN), MP, DM, DFF}; pg8::StaticOrder S; S.init(MP, DM, F.G, (int)blockIdx.x);
        pg8::EpiResNorm E{RC, A.out, A.in[I_NF], (float*)(ws + WS_XBUF), (unsigned*)(ws + WS_CTL) + CW_PANEL, (unsigned*)(ws + WS_CTL) + CW_TMO};
        pg8::gemm_phase<pg8::EpiResNorm, pg8::StaticOrder, false, true>(F.lds + RING_OFF, g, S, E);
    }
#undef IN
#undef BOTH
}

extern "C" void kernel_launch(void* const* d_in, const int* in_sizes, int n_in, void* d_out, int out_size, void* d_ws, size_t ws_size, hipStream_t stream) {
    static int grid = 0;
    if (grid == 0) {
        if (n_in != 30 || in_sizes[0] != MP * DM || (size_t)out_size != OUT_END || ws_size < WS_END) {
            fprintf(stderr, "kernel_launch: unexpected shapes: n_in %d, in0 %d, out %d, ws %zu (need >= %zu); nothing launched\n", n_in, n_in > 0 ? in_sizes[0] : -1, out_size, ws_size, (size_t)WS_END); grid = -1; return; }
        int dev = 0, cus = 0, per_cu = 0;
        if (hipGetDevice(&dev) != hipSuccess || hipDeviceGetAttribute(&cus, hipDeviceAttributeMultiprocessorCount, dev) != hipSuccess) { fprintf(stderr, "kernel_launch: device query failed\n"); grid = -1; return; }
        if (hipFuncSetAttribute((const void*)hymba_fwd, hipFuncAttributeMaxDynamicSharedMemorySize, LDS_BYTES) != hipSuccess) { fprintf(stderr, "kernel_launch: hipFuncSetAttribute failed\n"); grid = -1; return; }
        if (hipOccupancyMaxActiveBlocksPerMultiprocessor(&per_cu, (const void*)hymba_fwd, NWAVES * 64, LDS_BYTES) != hipSuccess || per_cu < 1)
            fprintf(stderr, "kernel_launch: note: occupancy query reports %d workgroups per CU\n", per_cu);
        (void)hipGetLastError();
        grid = cus;
        if (grid != 256) { fprintf(stderr, "kernel_launch: built for 256 CUs (one 256x256 unit per workgroup in the fused final-norm phase); found %d; nothing launched\n", grid); grid = -1; return; }
    }
    if (grid < 0) return;
    if (hipMemsetAsync((char*)d_ws + WS_CTL, 0, CTL_ZERO_BYTES, stream) != hipSuccess) { fprintf(stderr, "kernel_launch: hipMemsetAsync failed\n"); return; }
    Args a{};
    for (int i = 0; i < 30; ++i) a.in[i] = (const float*)d_in[i];
    a.out = (float*)d_out; a.ws = (unsigned char*)d_ws;
#if MK_PER_PHASE
    for (int ph = 0; ph < N_PHASES; ++ph) { a.ph_lo = ph; a.ph_hi = ph + 1; a.li = 0;
        hipLaunchKernelGGL(hymba_fwd, dim3(grid), dim3(NWAVES * 64), LDS_BYTES, stream, a); }
#else
#ifdef PROBE_PH
    a.ph_lo = 0; a.ph_hi = PROBE_PH + 1; a.li = 0;
    hipLaunchKernelGGL(hymba_fwd, dim3(grid), dim3(NWAVES * 64), LDS_BYTES, stream, a);
#ifdef PROBE_REPS
    for (int r_ = 0; r_ < PROBE_REPS; ++r_) { a.ph_lo = PROBE_PH; a.ph_hi = PROBE_PH + 1; a.li = 2 + r_; a.pad = PROBE_MODE; hipLaunchKernelGGL(hymba_fwd, dim3(grid), dim3(NWAVES * 64), LDS_BYTES, stream, a); }
#endif
    a.ph_lo = PROBE_PH; a.ph_hi = N_PHASES; a.li = 1; a.pad = 0;
    hipLaunchKernelGGL(hymba_fwd, dim3(grid), dim3(NWAVES * 64), LDS_BYTES, stream, a);
#else
    a.ph_lo = 0; a.ph_hi = N_PHASES; a.li = 0;
    hipLaunchKernelGGL(hymba_fwd, dim3(grid), dim3(NWAVES * 64), LDS_BYTES, stream, a);
#endif
#endif
    const hipError_t le = hipPeekAtLastError();
    if (le != hipSuccess) fprintf(stderr, "kernel_launch: launch failed: %s\n", hipGetErrorName(le));
}
```

```cpp
#include <hip/hip_runtime.h>
#include <cstdio>
#include <cstdint>
#define MK_PER_PHASE 0
namespace pg8 {
#define PG8_LAS __attribute__((address_space(3)))
typedef unsigned short bf16_t;
typedef short bf16x8 __attribute__((ext_vector_type(8)));
typedef float f32x4 __attribute__((ext_vector_type(4)));
typedef unsigned u32x4 __attribute__((ext_vector_type(4)));
constexpr int BM = 256, BK = 64, HALF = 128, HTB = HALF * BK * 2  , STAGE_BYTES = 8 * HTB, NXCD = 8, WGM = 8;

__host__ __device__ __forceinline__ int lds_byte(int r, int c) { const int st = (r >> 4) * 2 + (c >> 5), rr = r & 15, cc = c & 31, ob = rr * 64 + cc * 2; return st * 1024 + (ob ^ (((ob >> 9) & 1) << 5)); }
__host__ __device__ __forceinline__ void stage_rc(int b, int& R, int& C) { const int st = b / 1024, sb = b % 1024, swz = sb ^ (((sb >> 9) & 1) << 5); R = (st >> 1) * 16 + swz / 64; C = (st & 1) * 32 + (swz % 64) / 2; }
__host__ __device__ __forceinline__ int perm32(int rho) { const int n = rho >> 4, i = rho & 15; return 8 * (i >> 2) + 4 * n + (i & 3); }

struct Unit { int pm, pn; };
struct Gemm { const bf16_t* A; const bf16_t* Bt; int M, N, K; };

struct StaticOrder {
    int nM, nN, nwg, G, c;
    __host__ __device__ __forceinline__ void init(int M, int N, int G_, int c_) { nM = M / BM; nN = N / BM; nwg = nM * nN; G = G_; c = c_; }
    __host__ __device__ __forceinline__ bool next(int i, Unit& u) const {
        const long L = (long)i * G + c; if (L >= nwg) return false;
        int wgid = (int)L; { const int q = nwg / NXCD, r = nwg % NXCD, xcd = wgid % NXCD, off = wgid / NXCD; wgid = (xcd < r ? xcd * (q + 1) : r * (q + 1) + (xcd - r) * q) + off; }
        const int nig = WGM * nN, gid = wgid / nig, fm = gid * WGM, gsz = (nM - fm) < WGM ? (nM - fm) : WGM;
        u.pm = fm + ((wgid % nig) % gsz); u.pn = (wgid % nig) / gsz; return true;
    }
    __device__ __forceinline__ void a_ready(const Unit&) const {}
    __device__ __forceinline__ void done(const Unit&) const {}
};

__device__ __forceinline__ unsigned cvt_pk_bf16(float lo, float hi) { unsigned r; asm volatile("v_cvt_pk_bf16_f32 %0, %1, %2" : "=v"(r) : "v"(lo), "v"(hi)); return r; }
typedef float f32x2_t __attribute__((ext_vector_type(2))); typedef __bf16 bf16x2_t __attribute__((ext_vector_type(2)));
__device__ __forceinline__ unsigned pk2(float lo, float hi) { f32x2_t v = {lo, hi}; bf16x2_t b = __builtin_convertvector(v, bf16x2_t); return __builtin_bit_cast(unsigned, b); }
__device__ __forceinline__ float sigm(float x) { return __builtin_amdgcn_rcpf(1.f + __expf(-x)); }
__device__ __forceinline__ float silu(float x) { return x * __builtin_amdgcn_rcpf(1.f + __expf(-x)); }
__device__ __forceinline__ u32x4 pk8(const f32x4& a, const f32x4& b) { u32x4 w; w.x = pk2(a[0], a[1]); w.y = pk2(a[2], a[3]); w.z = pk2(b[0], b[1]); w.w = pk2(b[2], b[3]); return w; }
constexpr int PBLD = 2560;
constexpr int MPROMPT = 16384;
constexpr float RMS_EPS = 1e-6f;

struct EpiIn {
    static constexpr bool PERM = true, AFTER_DRAIN = false;
    bf16_t* PB;
    __device__ __forceinline__ void operator()(const f32x4 (&acc)[2][2][4][2], const Unit& u, int wr, int wc, int fr, int fq) const {
        const int row0 = u.pm * BM + wr * 64 + fr;
        if (u.pn < 4) {
            const int ch0 = u.pn * 128 + wc * 32 + 8 * fq;
#pragma unroll
            for (int ai = 0; ai < 2; ++ai)
#pragma unroll
                for (int m = 0; m < 4; ++m) {
                    bf16_t* rowp = PB + (size_t)(row0 + ai * HALF + m * 16) * PBLD + ch0;
                    f32x4 v0, v1;
#pragma unroll
                    for (int i = 0; i < 4; ++i) { v0[i] = acc[ai][0][m][0][i] * sigm(acc[ai][1][m][0][i]); v1[i] = acc[ai][0][m][1][i] * sigm(acc[ai][1][m][1][i]); }
                    *(u32x4*)rowp = pk8(v0, v1);
                }
        } else {
            const int col0 = u.pn * BM - 512 + wc * 32 + 8 * fq;
#pragma unroll
            for (int ai = 0; ai < 2; ++ai)
#pragma unroll
                for (int m = 0; m < 4; ++m) {
                    bf16_t* rowp = PB + (size_t)(row0 + ai * HALF + m * 16) * PBLD + col0;
#pragma unroll
                    for (int bj = 0; bj < 2; ++bj) *(u32x4*)(rowp + bj * HALF) = pk8(acc[ai][bj][m][0], acc[ai][bj][m][1]);
                }
        }
    }
};

struct EpiKV {
    static constexpr bool PERM = true, AFTER_DRAIN = false;
    float* outK; float* outV; bf16_t* KB; bf16_t* VT;
    __device__ __forceinline__ void operator()(const f32x4 (&acc)[2][2][4][2], const Unit& u, int wr, int wc, int fr, int fq) const {
        const int row0 = u.pm * BM + wr * 64 + fr;
        const bool isv = u.pn >= 4;
        const int c0 = (isv ? u.pn - 4 : u.pn) * BM + wc * 32 + 8 * fq;
        float* outp = isv ? outV : outK;
#pragma unroll
        for (int ai = 0; ai < 2; ++ai)
#pragma unroll
            for (int m = 0; m < 4; ++m) {
                const int row = row0 + ai * HALF + m * 16;
#pragma unroll
                for (int bj = 0; bj < 2; ++bj) {
                    const int col = c0 + bj * HALF;
                    const f32x4 a = acc[ai][bj][m][0], b = acc[ai][bj][m][1];
                    *(f32x4*)(outp + (size_t)row * 1024 + col) = a; *(f32x4*)(outp + (size_t)row * 1024 + col + 4) = b;
                    const u32x4 w = pk8(a, b);
                    if (!isv) *(u32x4*)(KB + (size_t)row * 1024 + col) = w;
                    else {
                        bf16_t* vp = VT + (size_t)col * 2048 + row;
                        vp[0 * 2048] = (bf16_t)(w.x & 0xffffu); vp[1 * 2048] = (bf16_t)(w.x >> 16); vp[2 * 2048] = (bf16_t)(w.y & 0xffffu); vp[3 * 2048] = (bf16_t)(w.y >> 16);
                        vp[4 * 2048] = (bf16_t)(w.z & 0xffffu); vp[5 * 2048] = (bf16_t)(w.z >> 16); vp[6 * 2048] = (bf16_t)(w.w & 0xffffu); vp[7 * 2048] = (bf16_t)(w.w >> 16);
                    }
                }
            }
    }
};

__device__ __forceinline__ f32x4 bf4lo(unsigned a, unsigned b) { return (f32x4){__uint_as_float(a << 16), __uint_as_float(a & 0xffff0000u), __uint_as_float(b << 16), __uint_as_float(b & 0xffff0000u)}; }
template <bool BASE_F32> struct EpiRes {
    static constexpr bool PERM = true, AFTER_DRAIN = false;
    const float* basef; const bf16_t* baseb; bf16_t* outb; float* ss;
    __device__ __forceinline__ void operator()(const f32x4 (&acc)[2][2][4][2], const Unit& u, int wr, int wc, int fr, int fq) const {
        const int row0 = u.pm * BM + wr * 64 + fr; const int col0 = u.pn * BM + wc * 32 + 8 * fq;
#pragma unroll
        for (int ai = 0; ai < 2; ++ai) {
            f32x4 pre[4][2][2];
#pragma unroll
            for (int m = 0; m < 4; ++m)
#pragma unroll
                for (int bj = 0; bj < 2; ++bj) { const size_t off = (size_t)(row0 + ai * HALF + m * 16) * 1024 + col0 + bj * HALF;
                    if (BASE_F32) { pre[m][bj][0] = *(const f32x4*)(basef + off); pre[m][bj][1] = *(const f32x4*)(basef + off + 4); }
                    else { const u32x4 w = *(const u32x4*)(baseb + off); pre[m][bj][0] = bf4lo(w.x, w.y); pre[m][bj][1] = bf4lo(w.z, w.w); } }
            __builtin_amdgcn_sched_barrier(0);
#pragma unroll
            for (int m = 0; m < 4; ++m) {
                const int row = row0 + ai * HALF + m * 16; const size_t off = (size_t)row * 1024 + col0;
                float s = 0.f;
#pragma unroll
                for (int bj = 0; bj < 2; ++bj) {
                    const f32x4 v0 = acc[ai][bj][m][0] + pre[m][bj][0], v1 = acc[ai][bj][m][1] + pre[m][bj][1];
                    s += (v0[0] * v0[0] + v0[1] * v0[1]) + (v0[2] * v0[2] + v0[3] * v0[3]) + (v1[0] * v1[0] + v1[1] * v1[1]) + (v1[2] * v1[2] + v1[3] * v1[3]);
                    *(u32x4*)(outb + off + bj * HALF) = pk8(v0, v1);
                }
                s += __shfl_xor(s, 16); s += __shfl_xor(s, 32);
                if (fq == 0) atomicAdd(ss + row, s);
            }
        }
    }
};

struct EpiQ {
    static constexpr bool PERM = true, AFTER_DRAIN = false;
    bf16_t* Q; const float* ss; float c2;
    __device__ __forceinline__ void operator()(const f32x4 (&acc)[2][2][4][2], const Unit& u, int wr, int wc, int fr, int fq) const {
        const int row0 = u.pm * BM + wr * 64 + fr; const int col0 = u.pn * BM + wc * 32 + 8 * fq;
#pragma unroll
        for (int ai = 0; ai < 2; ++ai)
#pragma unroll
            for (int m = 0; m < 4; ++m) {
                const int row = row0 + ai * HALF + m * 16;
                const float rs = __builtin_amdgcn_rsqf(ss[row] * (1.f / 1024.f) + RMS_EPS) * c2;
#pragma unroll
                for (int bj = 0; bj < 2; ++bj) *(u32x4*)(Q + (size_t)row * 1024 + col0 + bj * HALF) = pk8(acc[ai][bj][m][0] * rs, acc[ai][bj][m][1] * rs);
            }
    }
};

struct EpiGU {
    static constexpr bool PERM = true, AFTER_DRAIN = false;
    bf16_t* T; const float* ss;
    __device__ __forceinline__ void operator()(const f32x4 (&acc)[2][2][4][2], const Unit& u, int wr, int wc, int fr, int fq) const {
        const int row0 = u.pm * BM + wr * 64 + fr; const int ch0 = u.pn * 128 + wc * 32 + 8 * fq;
#pragma unroll
        for (int ai = 0; ai < 2; ++ai)
#pragma unroll
            for (int m = 0; m < 4; ++m) {
                const int row = row0 + ai * HALF + m * 16;
                const float rs = __builtin_amdgcn_rsqf(ss[row] * (1.f / 1024.f) + RMS_EPS);
                f32x4 v0, v1;
#pragma unroll
                for (int i = 0; i < 4; ++i) { v0[i] = silu(acc[ai][0][m][0][i] * rs) * (acc[ai][1][m][0][i] * rs); v1[i] = silu(acc[ai][0][m][1][i] * rs) * (acc[ai][1][m][1][i] * rs); }
                *(u32x4*)(T + (size_t)row * 2816 + ch0) = pk8(v0, v1);
            }
    }
};


struct EpiResNorm {
    static constexpr bool PERM = true, AFTER_DRAIN = true;
    const bf16_t* base; float* out; const float* gain; float* xbuf; unsigned* cnt; unsigned* tmo;
    __device__ __forceinline__ void fused(f32x4 (&acc)[2][2][4][2], const Unit& u, int wr, int wc, int fr, int fq, PG8_LAS unsigned char* lds, int wid, int lane) const {
        PG8_LAS float* P = (PG8_LAS float*)lds;
        PG8_LAS float* S = (PG8_LAS float*)(lds + 4096);
        PG8_LAS unsigned* flag = (PG8_LAS unsigned*)(lds + 4096 + 1024);
        const int row0 = u.pm * BM + wr * 64 + fr; const int col0 = u.pn * BM + wc * 32 + 8 * fq;
#pragma unroll
        for (int ai = 0; ai < 2; ++ai) {
            f32x4 pre[4][2][2];
#pragma unroll
            for (int m = 0; m < 4; ++m)
#pragma unroll
                for (int bj = 0; bj < 2; ++bj) { const size_t off = (size_t)(row0 + ai * HALF + m * 16) * 1024 + col0 + bj * HALF; const u32x4 w = *(const u32x4*)(base + off); pre[m][bj][0] = bf4lo(w.x, w.y); pre[m][bj][1] = bf4lo(w.z, w.w); }
            __builtin_amdgcn_sched_barrier(0);
#pragma unroll
            for (int m = 0; m < 4; ++m) {
                float s = 0.f;
#pragma unroll
                for (int bj = 0; bj < 2; ++bj) {
                    const f32x4 v0 = acc[ai][bj][m][0] + pre[m][bj][0], v1 = acc[ai][bj][m][1] + pre[m][bj][1];
                    acc[ai][bj][m][0] = v0; acc[ai][bj][m][1] = v1;
                    s += (v0[0] * v0[0] + v0[1] * v0[1]) + (v0[2] * v0[2] + v0[3] * v0[3]) + (v1[0] * v1[0] + v1[1] * v1[1]) + (v1[2] * v1[2] + v1[3] * v1[3]);
                }
                s += __shfl_xor(s, 16); s += __shfl_xor(s, 32);
                if (fq == 0) P[(ai * HALF + wr * 64 + m * 16 + fr) * 4 + wc] = s;
            }
        }
        asm volatile("s_waitcnt lgkmcnt(0)" ::: "memory"); __builtin_amdgcn_s_barrier(); asm volatile("" ::: "memory");
        const int row = wid * 64 + lane;
        if (wid < 4) {
            const float t = (P[row * 4 + 0] + P[row * 4 + 1]) + (P[row * 4 + 2] + P[row * 4 + 3]);
            __hip_atomic_store(xbuf + (size_t)(u.pm * BM + row) * 4 + u.pn, t, __ATOMIC_RELAXED, __HIP_MEMORY_SCOPE_AGENT);
            asm volatile("s_waitcnt vmcnt(0)" ::: "memory");
            if (lane == 0) __hip_atomic_fetch_add(cnt + 64 * u.pm, 1u, __ATOMIC_RELAXED, __HIP_MEMORY_SCOPE_AGENT);
        }
        if (wid == 0) {
            unsigned spins = 0; bool dead = false;
            while ((unsigned)__builtin_amdgcn_readfirstlane(__hip_atomic_load(cnt + 64 * u.pm, __ATOMIC_RELAXED, __HIP_MEMORY_SCOPE_AGENT)) < 16u) {
                __builtin_amdgcn_s_sleep(2);
                if (++spins > (1u << 22)) { dead = true; if (lane == 0) __hip_atomic_store(tmo, 1u, __ATOMIC_RELAXED, __HIP_MEMORY_SCOPE_AGENT); break; }
            }
            __builtin_amdgcn_fence(__ATOMIC_ACQUIRE, "agent");
            if (lane == 0) flag[0] = dead ? 1u : 0u;
        }
        asm volatile("s_waitcnt vmcnt(0) lgkmcnt(0)" ::: "memory"); __builtin_amdgcn_s_barrier(); asm volatile("" ::: "memory");
        if (wid < 4) {
            const float* sl = xbuf + (size_t)(u.pm * BM + row) * 4; float t = 0.f;
#pragma unroll
            for (int q = 0; q < 4; ++q) t += __hip_atomic_load(sl + q, __ATOMIC_RELAXED, __HIP_MEMORY_SCOPE_AGENT);
            S[row] = __builtin_amdgcn_rsqf(t * (1.f / 1024.f) + RMS_EPS);
        }
        asm volatile("s_waitcnt vmcnt(0) lgkmcnt(0)" ::: "memory"); __builtin_amdgcn_s_barrier(); asm volatile("" ::: "memory");
        f32x4 gv[2][2];
#pragma unroll
        for (int bj = 0; bj < 2; ++bj) { gv[bj][0] = *(const f32x4*)(gain + col0 + bj * HALF); gv[bj][1] = *(const f32x4*)(gain + col0 + bj * HALF + 4); }
#pragma unroll
        for (int ai = 0; ai < 2; ++ai)
#pragma unroll
            for (int m = 0; m < 4; ++m) {
                const int rl = ai * HALF + wr * 64 + m * 16 + fr; const float rs = S[rl]; const size_t off = (size_t)(u.pm * BM + rl) * 1024 + col0;
#pragma unroll
                for (int bj = 0; bj < 2; ++bj) { *(f32x4*)(out + off + bj * HALF) = acc[ai][bj][m][0] * rs * gv[bj][0]; *(f32x4*)(out + off + bj * HALF + 4) = acc[ai][bj][m][1] * rs * gv[bj][1]; }
            }
    }
};

template <class Epi, class Sched, bool ALIGN_EPI = false, bool SP2 = false>
__device__ __forceinline__ void gemm_phase(PG8_LAS unsigned char* lds, const Gemm g, const Sched& S, const Epi& E) {
    const int tid = threadIdx.x, wid = __builtin_amdgcn_readfirstlane(tid >> 6), lane = tid & 63, wr = wid >> 2, wc = wid & 3, fr = lane & 15, fq = lane >> 4;
    const int K = g.K, nt = K / BK;
    unsigned voffA[2], voffB[2];
#pragma unroll
    for (int i = 0; i < 2; ++i) { int R, C; stage_rc(tid * 16 + i * 8192, R, C); const int Rb = Epi::PERM ? ((R & ~31) + perm32(R & 31)) : R;
        voffA[i] = (unsigned)(R * K + C) * 2u; voffB[i] = (unsigned)(Rb * K + C) * 2u; }
    const size_t kstep = (size_t)(BK * 2);
    const size_t hstep = (size_t)HALF * K * 2;
    const size_t tstep = 2 * hstep;
    const unsigned ldsw = (unsigned)wid * 1024u;
    const int aoff = lds_byte(wr * 64 + fr, fq * 8), boff = lds_byte(wc * 32 + fr, fq * 8);
#define PG8_SA(b, h) (((b) * 2 + (h)) * HTB)
#define PG8_SB(b, h) ((4 + (b) * 2 + (h)) * HTB)
#define PG8_STAGE(bufoff, gbase, voff) do { _Pragma("unroll") for (int _i = 0; _i < 2; ++_i) \
        __builtin_amdgcn_global_load_lds((const unsigned*)((const char*)(gbase) + (voff)[_i]), (PG8_LAS unsigned*)(lds + (bufoff) + ldsw + _i * 8192), 16, 0, 0); } while (0)
#define PG8_LDA(dst, b, h) do { _Pragma("unroll") for (int m = 0; m < 4; ++m) _Pragma("unroll") for (int k = 0; k < 2; ++k) dst[m][k] = *(const PG8_LAS bf16x8*)(lds + PG8_SA(b, h) + aoff + m * 2048 + k * 1024); } while (0)
#define PG8_LDB(dst, b, h) do { _Pragma("unroll") for (int n = 0; n < 2; ++n) _Pragma("unroll") for (int k = 0; k < 2; ++k) dst[n][k] = *(const PG8_LAS bf16x8*)(lds + PG8_SB(b, h) + boff + n * 2048 + k * 1024); } while (0)
#define PG8_MMA(ai, bj, At, Bt) do { __builtin_amdgcn_s_setprio(1); _Pragma("unroll") for (int m = 0; m < 4; ++m) _Pragma("unroll") for (int n = 0; n < 2; ++n) _Pragma("unroll") for (int k = 0; k < 2; ++k) \
        acc[ai][bj][m][n] = __builtin_amdgcn_mfma_f32_16x16x32_bf16(Bt[n][k], At[m][k], acc[ai][bj][m][n], 0, 0, 0); __builtin_amdgcn_s_setprio(0); } while (0)
#define PG8_WAIT_V(n) asm volatile("s_waitcnt vmcnt(" #n ")" ::: "memory")
#define PG8_WAIT_L(n) asm volatile("s_waitcnt lgkmcnt(" #n ")" ::: "memory")
#define PG8_BAR __builtin_amdgcn_s_barrier()
#define PG8_SCHED __builtin_amdgcn_sched_barrier(0)
    Unit cur, nxt; int ui = 0;
    if (!S.next(0, cur)) return;
    f32x4 acc[2][2][4][2];
#pragma unroll
    for (int a = 0; a < 2; ++a)
#pragma unroll
        for (int b = 0; b < 2; ++b)
#pragma unroll
            for (int m = 0; m < 4; ++m)
#pragma unroll
                for (int n = 0; n < 2; ++n) acc[a][b][m][n] = (f32x4){0.f, 0.f, 0.f, 0.f};
    bf16x8 At[4][2], B0[2][2], B1[2][2];
    const char* cA = (const char*)g.A + (size_t)cur.pm * tstep; const char* cB = (const char*)g.Bt + (size_t)cur.pn * tstep;
    S.a_ready(cur);
    if constexpr (SP2) {
        PG8_STAGE(PG8_SB(0, 0), cB, voffB); PG8_STAGE(PG8_SB(0, 1), cB + hstep, voffB); PG8_STAGE(PG8_SA(0, 0), cA, voffA); PG8_STAGE(PG8_SA(0, 1), cA + hstep, voffA);
        if (wr == 1) PG8_BAR;
        PG8_WAIT_V(2); PG8_BAR;
        PG8_STAGE(PG8_SB(1, 0), cB + kstep, voffB); PG8_STAGE(PG8_SA(1, 0), cA + kstep, voffA); PG8_STAGE(PG8_SB(1, 1), cB + hstep + kstep, voffB);
        PG8_WAIT_V(6); PG8_BAR;
    } else {
        PG8_STAGE(PG8_SB(0, 0), cB, voffB); PG8_STAGE(PG8_SA(0, 0), cA, voffA); PG8_STAGE(PG8_SB(0, 1), cB + hstep, voffB); PG8_STAGE(PG8_SA(0, 1), cA + hstep, voffA);
        if (wr == 1) PG8_BAR;
        PG8_WAIT_V(4); PG8_BAR;
        PG8_STAGE(PG8_SB(1, 0), cB + kstep, voffB); PG8_STAGE(PG8_SA(1, 0), cA + kstep, voffA); PG8_STAGE(PG8_SB(1, 1), cB + hstep + kstep, voffB);
        PG8_WAIT_V(6); PG8_BAR;
    }
    for (;;) {
        const bool has_next = S.next(ui + 1, nxt);
        const char* nA = has_next ? (const char*)g.A + (size_t)nxt.pm * tstep : cA; const char* nB = has_next ? (const char*)g.Bt + (size_t)nxt.pn * tstep : cB;
        for (int t = 0; t < nt; t += 2) {
            const bool last = (t == nt - 2);
            const char* a1 = cA + (size_t)(t + 1) * kstep;
            const char* a2 = last ? nA : cA + (size_t)(t + 2) * kstep; const char* b2 = last ? nB : cB + (size_t)(t + 2) * kstep;
            const char* a3 = a2 + kstep; const char* b3 = b2 + kstep;
            if (last && has_next) S.a_ready(nxt);
            if constexpr (SP2) {
            PG8_LDB(B0, 0, 0); PG8_LDB(B1, 0, 1); PG8_SCHED; PG8_LDA(At, 0, 0); PG8_STAGE(PG8_SA(1, 1), a1 + hstep, voffA);
            PG8_WAIT_V(8); PG8_WAIT_L(0); PG8_BAR; PG8_MMA(0, 0, At, B0); PG8_MMA(0, 1, At, B1); PG8_BAR; PG8_SCHED;
            PG8_LDA(At, 0, 1); PG8_STAGE(PG8_SB(0, 0), b2, voffB); PG8_STAGE(PG8_SB(0, 1), b2 + hstep, voffB); PG8_STAGE(PG8_SA(0, 0), a2, voffA);
            PG8_WAIT_V(8); PG8_WAIT_L(0); PG8_BAR; PG8_MMA(1, 0, At, B0); PG8_MMA(1, 1, At, B1); PG8_BAR; PG8_SCHED;
            PG8_LDB(B0, 1, 0); PG8_LDB(B1, 1, 1); PG8_SCHED; PG8_LDA(At, 1, 0); PG8_STAGE(PG8_SA(0, 1), a2 + hstep, voffA);
            PG8_WAIT_V(8); PG8_WAIT_L(0); PG8_BAR; PG8_MMA(0, 0, At, B0); PG8_MMA(0, 1, At, B1); PG8_BAR; PG8_SCHED;
            PG8_LDA(At, 1, 1); PG8_STAGE(PG8_SB(1, 0), b3, voffB); PG8_STAGE(PG8_SB(1, 1), b3 + hstep, voffB); PG8_STAGE(PG8_SA(1, 0), a3, voffA);
            PG8_WAIT_V(8); PG8_WAIT_L(0); PG8_BAR; PG8_MMA(1, 0, At, B0); PG8_MMA(1, 1, At, B1); PG8_BAR; PG8_SCHED;
            } else {
            PG8_LDB(B0, 0, 0); PG8_SCHED; PG8_LDA(At, 0, 0); PG8_STAGE(PG8_SA(1, 1), a1 + hstep, voffA);
            PG8_WAIT_L(8); PG8_BAR; PG8_WAIT_L(0); PG8_MMA(0, 0, At, B0); PG8_BAR; PG8_SCHED;
            PG8_LDB(B1, 0, 1); PG8_STAGE(PG8_SB(0, 0), b2, voffB);
            PG8_BAR; PG8_WAIT_L(0); PG8_MMA(0, 1, At, B1); PG8_BAR;
            PG8_LDA(At, 0, 1); PG8_STAGE(PG8_SA(0, 0), a2, voffA);
            PG8_BAR; PG8_WAIT_L(0); PG8_MMA(1, 0, At, B0); PG8_BAR; PG8_SCHED;
            PG8_STAGE(PG8_SB(0, 1), b2 + hstep, voffB);
            PG8_WAIT_V(6); PG8_BAR; PG8_MMA(1, 1, At, B1); PG8_BAR;
            PG8_LDB(B0, 1, 0); PG8_SCHED; PG8_LDA(At, 1, 0); PG8_STAGE(PG8_SA(0, 1), a2 + hstep, voffA);
            PG8_WAIT_L(8); PG8_BAR; PG8_WAIT_L(0); PG8_MMA(0, 0, At, B0); PG8_BAR; PG8_SCHED;
            PG8_LDB(B1, 1, 1); PG8_STAGE(PG8_SB(1, 0), b3, voffB);
            PG8_BAR; PG8_WAIT_L(0); PG8_MMA(0, 1, At, B1); PG8_BAR;
            PG8_LDA(At, 1, 1); PG8_STAGE(PG8_SA(1, 0), a3, voffA);
            PG8_BAR; PG8_WAIT_L(0); PG8_MMA(1, 0, At, B0); PG8_BAR; PG8_SCHED;
            PG8_STAGE(PG8_SB(1, 1), b3 + hstep, voffB);
            PG8_WAIT_V(6); PG8_BAR; PG8_MMA(1, 1, At, B1); PG8_BAR;
            }
        }
        if constexpr (ALIGN_EPI) { if (wr == 0) PG8_BAR; }
        if constexpr (!Epi::AFTER_DRAIN) { E(acc, cur, wr, wc, fr, fq); S.done(cur); }
        if (!has_next) break;
#pragma unroll
        for (int a = 0; a < 2; ++a)
#pragma unroll
            for (int b = 0; b < 2; ++b)
#pragma unroll
                for (int m = 0; m < 4; ++m)
#pragma unroll
                    for (int n = 0; n < 2; ++n) acc[a][b][m][n] = (f32x4){0.f, 0.f, 0.f, 0.f};
        cur = nxt; cA = nA; cB = nB; ++ui;
        if constexpr (ALIGN_EPI) { if (wr == 1) PG8_BAR; }
    }
    PG8_WAIT_V(0);
    if constexpr (!ALIGN_EPI) { if (wr == 0) PG8_BAR; }
    PG8_BAR;
    if constexpr (Epi::AFTER_DRAIN) { E.fused(acc, cur, wr, wc, fr, fq, lds, wid, lane); S.done(cur); }
#undef PG8_SA
#undef PG8_SB
#undef PG8_STAGE
#undef PG8_LDA
#undef PG8_LDB
#undef PG8_MMA
#undef PG8_WAIT_V
#undef PG8_WAIT_L
#undef PG8_BAR
#undef PG8_SCHED
}
}

constexpr int NWAVES = 8;
#ifndef MK_PER_PHASE
#define MK_PER_PHASE 0
#endif
constexpr int N_PHASES = 10;

constexpr int DM = 1024, NB = 8, SEQ = 2048, MP = NB * SEQ  , DEC = 128, MV = MP + DEC  , MR = 16640  ;
constexpr int CC = 512, CW = 31, NH = 4, DKV = 128, QKVN = 1536, NMEM = 256, MHD = 256, DFF = 2816, INC = 3080;
constexpr int PBLD = pg8::PBLD;
constexpr int NCHUNK = NB * NH * 32;
constexpr float RMS_EPS = 1e-6f;
constexpr float ATT_C2 = 0.0625f * 1.4426950408889634f;

constexpr size_t OUT_YP = 0, OUT_YS = 16777216, OUT_CONVP = 16908288, OUT_SCP = 17031168, OUT_DLP = 17068032, OUT_MKP = 17592320, OUT_MVP = 19689472,
                 OUT_CONVS = 21786624, OUT_SCS = 23752704, OUT_DLS = 24342528, OUT_END = 32731136;

constexpr size_t MiB = 1u << 20;
constexpr size_t WS_CTL = 0, CTL_ZERO_BYTES = 1 * MiB;
constexpr size_t WS_WIN = 1 * MiB, WS_WOUT = 7 * MiB, WS_WMQ = 9 * MiB, WS_WMKV = 11 * MiB, WS_WMO = 15 * MiB, WS_WGU = 17 * MiB, WS_WDN = 28 * MiB;
constexpr size_t WS_BG = 34 * MiB, WS_MEMN = 35 * MiB, WS_KB = 39 * MiB, WS_VT = 43 * MiB, WS_GL = 47 * MiB, WS_X1S = 47 * MiB + 65536, WS_XBUF = 47 * MiB + 655360;
constexpr size_t WS_RA = 48 * MiB;
constexpr size_t WS_RB = 138 * MiB;
constexpr size_t WS_RC = 171 * MiB;
constexpr size_t WS_RD = 220 * MiB;
constexpr size_t WS_U = WS_RD, WS_W = 252 * MiB, WS_QG = 268 * MiB, WS_KDT = 284 * MiB, WS_QK = 300 * MiB;
constexpr size_t WS_RE = 308 * MiB;
constexpr size_t WS_RF = 341 * MiB;
constexpr size_t WS_END = 406 * MiB;
constexpr int CW_TMO = 0, CW_CODE = 1, CW_BAR = 4096, CW_SS1 = 65536, CW_SS2 = 98304, CW_SS3 = 131072, CW_PANEL = 200000;

constexpr int RING_OFF = 0, RING_BYTES = 143360;
constexpr int LDSCTL_OFF = RING_BYTES, MISC_OFF = LDSCTL_OFF + 320;
constexpr int LDS_BYTES = 147456;

#define GAS __attribute__((address_space(1)))
#define LAS __attribute__((address_space(3)))
typedef unsigned short bf16;
typedef unsigned v4u __attribute__((ext_vector_type(4)));
typedef unsigned v2u __attribute__((ext_vector_type(2)));
typedef float f32x4 __attribute__((ext_vector_type(4)));
typedef float f32x16 __attribute__((ext_vector_type(16)));
typedef short bf16x8 __attribute__((ext_vector_type(8)));
typedef GAS unsigned gu32;
#define RLX_AGENT __ATOMIC_RELAXED, __HIP_MEMORY_SCOPE_AGENT
#define LDS_WAIT() asm volatile("s_waitcnt lgkmcnt(0)" ::: "memory")
#define VM_WAIT() asm volatile("s_waitcnt vmcnt(0)" ::: "memory")
using pg8::pk2; using pg8::silu; using pg8::sigm;
__device__ __forceinline__ float bf2f(unsigned b) { return __uint_as_float(b << 16); }
__device__ __forceinline__ float bflo(unsigned w) { return __uint_as_float(w << 16); }
__device__ __forceinline__ float bfhi(unsigned w) { return __uint_as_float(w & 0xffff0000u); }
__device__ __forceinline__ void unpack8(const v4u& w, float (&f)[8]) { f[0] = bflo(w.x); f[1] = bfhi(w.x); f[2] = bflo(w.y); f[3] = bfhi(w.y); f[4] = bflo(w.z); f[5] = bfhi(w.z); f[6] = bflo(w.w); f[7] = bfhi(w.w); }
__device__ __forceinline__ v4u pack8(const float (&f)[8]) { v4u w; w.x = pk2(f[0], f[1]); w.y = pk2(f[2], f[3]); w.z = pk2(f[4], f[5]); w.w = pk2(f[6], f[7]); return w; }
template <int CTRL> __device__ __forceinline__ float dppf(float v) { return __int_as_float(__builtin_amdgcn_update_dpp(0, __float_as_int(v), CTRL, 0xf, 0xf, true)); }
__device__ __forceinline__ float row16_sum(float v) { v += dppf<0xB1>(v); v += dppf<0x4E>(v); v += dppf<0x141>(v); v += dppf<0x140>(v); return v; }
__device__ __forceinline__ float row16_max(float v) { v = fmaxf(v, dppf<0xB1>(v)); v = fmaxf(v, dppf<0x4E>(v)); v = fmaxf(v, dppf<0x141>(v)); v = fmaxf(v, dppf<0x140>(v)); return v; }
__device__ __forceinline__ float rdl(float v, int l) { return __int_as_float(__builtin_amdgcn_readlane(__float_as_int(v), l)); }
__device__ __forceinline__ float wave_sum(float v) { v = row16_sum(v); return (rdl(v, 0) + rdl(v, 16)) + (rdl(v, 32) + rdl(v, 48)); }
__device__ __forceinline__ float wave_max(float v) { v = row16_max(v); return fmaxf(fmaxf(rdl(v, 0), rdl(v, 16)), fmaxf(rdl(v, 32), rdl(v, 48))); }

#define XB_TMO      128
#define XB_XCNT(j)  (256  + 64 * (j))
#define XB_XSUB(j)  (1280 + 64 * (j))
#define XB_XGEN(j)  (2304 + 64 * (j))
#define XB_TOP      3328
#define XB_TOPGEN   3392
#define XCD_BAR_WORDS 3456
#define XB_SPIN_CAP (1u << 18)

__device__ __forceinline__ unsigned xb_ld(unsigned* p)              { return __hip_atomic_load(p, __ATOMIC_RELAXED, __HIP_MEMORY_SCOPE_AGENT); }
__device__ __forceinline__ unsigned xb_add(unsigned* p, unsigned v) { return __hip_atomic_fetch_add(p, v, __ATOMIC_RELAXED, __HIP_MEMORY_SCOPE_AGENT); }
__device__ __forceinline__ unsigned xb_xcc_id() { return (unsigned)__builtin_amdgcn_s_getreg((3 << 11) | 20) & 0xFu; }
#define XB_SPIN(cond, bar) do { unsigned _sp = 0; while (cond) { __builtin_amdgcn_s_sleep(1); \
    if ((++_sp & 255u) == 0u) { if (xb_ld(&(bar)[XB_TMO])) break; if (_sp > XB_SPIN_CAP) { atomicAdd(&(bar)[XB_TMO], 1u); break; } } } } while (0)

struct XcdBarrier {
    unsigned* bar; unsigned x;
    volatile LAS unsigned* st;
};

__device__ __forceinline__ XcdBarrier xcd_barrier_post(unsigned* bar, volatile LAS unsigned* st) {
    XcdBarrier b; b.bar = bar; b.x = xb_xcc_id(); b.st = st;
    if (threadIdx.x == 0) (void)xb_add(&bar[XB_XCNT(b.x)], 1u);
    return b;
}
__device__ __forceinline__ void xcd_barrier_complete(unsigned* bar, unsigned x, unsigned& nloc, unsigned& nx) {
    const unsigned G = gridDim.x * gridDim.y * gridDim.z;
    unsigned sum, cnt, mine, sp = 0u;
    for (;;) {
        sum = 0u; cnt = 0u; mine = 0u;
#pragma unroll
        for (unsigned j = 0; j < 16; ++j) { const unsigned c = xb_ld(&bar[XB_XCNT(j)]); sum += c; cnt += (c > 0u) ? 1u : 0u; mine = (j == x) ? c : mine; }
        if (sum == G) break;
        __builtin_amdgcn_s_sleep(1);
        if ((++sp & 255u) == 0u) { if (xb_ld(&bar[XB_TMO])) break; if (sp > XB_SPIN_CAP) { atomicAdd(&bar[XB_TMO], 1u); break; } }
    }
    nloc = mine > 0u ? mine : 1u; nx = cnt > 0u ? cnt : 1u;
}

__device__ __forceinline__ void xcd_barrier(const XcdBarrier& b) {
    asm volatile("s_waitcnt vmcnt(0)" ::: "memory");
    __syncthreads();
    if (threadIdx.x == 0) {
        unsigned* bar = b.bar;
        __builtin_amdgcn_s_waitcnt(0);
        unsigned nloc = b.st[0], nx = b.st[1];
        if (nloc == 0u) { xcd_barrier_complete(bar, b.x, nloc, nx); b.st[0] = nloc; b.st[1] = nx; }
        const unsigned old = xb_add(&bar[XB_XSUB(b.x)], 1u);
        const unsigned gen = old / nloc;
        if (old + 1u == (gen + 1u) * nloc) {
            __builtin_amdgcn_fence(__ATOMIC_RELEASE, "agent");
            asm volatile("s_waitcnt vmcnt(0)" ::: "memory");
            const unsigned og = xb_add(&bar[XB_TOP], 1u);
            const unsigned tg = og / nx;
            if (og + 1u == (tg + 1u) * nx) xb_add(&bar[XB_TOPGEN], 1u);
            else XB_SPIN(xb_ld(&bar[XB_TOPGEN]) == tg, bar);
            __builtin_amdgcn_fence(__ATOMIC_ACQUIRE, "agent");
            xb_add(&bar[XB_XGEN(b.x)], 1u);
            asm volatile("s_waitcnt vmcnt(0)" ::: "memory");
        } else {
            XB_SPIN(xb_ld(&bar[XB_XGEN(b.x)]) == gen, bar);
            __builtin_amdgcn_fence(__ATOMIC_ACQUIRE, "agent");
            asm volatile("s_waitcnt vmcnt(0)" ::: "memory");
        }
    }
    __syncthreads();
}

struct Args { const float* in[30]; float* out; unsigned char* ws; int ph_lo, ph_hi, li, pad; };
struct Frame {
    LAS unsigned char* lds;
    volatile LAS unsigned* MISC;
    gu32* ctl;
    int tid, lane, wave;
    int vcu, G;
};
enum { I_XP = 0, I_XS, I_MEM, I_CCONV, I_SSC, I_SDELTA, I_CMK, I_CMV, I_NMIX, I_WIN, I_CONVW, I_CONVB, I_LNG, I_LNB, I_SCW, I_ALOG, I_DTB, I_DNN, I_WOUT,
       I_NMQ, I_NMKV, I_WMQ, I_WMK, I_WMV, I_WMO, I_NFFN, I_WG, I_WU, I_WD, I_NF };

struct TrJob { const float* W; const float* gain; bf16* WT; int ldw, k0, c0, K, r0; };
__device__ __forceinline__ void tr_load(const TrJob& j, int lane, f32x4 (&v)[8]) {
    const float* p = j.W + (size_t)(j.k0 + (lane >> 3)) * j.ldw + j.c0 + (lane & 7) * 4;
#pragma unroll
    for (int i = 0; i < 8; ++i) v[i] = *(const GAS f32x4*)(p + (size_t)(8 * i) * j.ldw);
}
__device__ __forceinline__ void tr_finish(const TrJob& j, const f32x4 (&v)[8], LAS float* scr, int lane) {
#pragma unroll
    for (int i = 0; i < 8; ++i) { LAS float* d = scr + (8 * i + (lane >> 3)) * 33 + (lane & 7) * 4; d[0] = v[i][0]; d[1] = v[i][1]; d[2] = v[i][2]; d[3] = v[i][3]; }
    LDS_WAIT(); asm volatile("" ::: "memory");
    const int c = lane & 7;
    float gv[8];
#pragma unroll
    for (int i = 0; i < 8; ++i) gv[i] = j.gain ? j.gain[j.k0 + 8 * c + i] : 1.f;
#pragma unroll
    for (int q = 0; q < 4; ++q) { const int n = (lane >> 3) + 8 * q; const LAS float* s = scr + (8 * c) * 33 + n;
        v4u o; o.x = pk2(s[0 * 33] * gv[0], s[1 * 33] * gv[1]); o.y = pk2(s[2 * 33] * gv[2], s[3 * 33] * gv[3]); o.z = pk2(s[4 * 33] * gv[4], s[5 * 33] * gv[5]); o.w = pk2(s[6 * 33] * gv[6], s[7 * 33] * gv[7]);
        *(GAS v4u*)(j.WT + (size_t)(j.r0 + n) * j.K + j.k0 + 8 * c) = o; }
    LDS_WAIT(); asm volatile("" ::: "memory");
}
__device__ __forceinline__ float softplusf_(float x) { return x > 20.f ? x : log1pf(__expf(x)); }

__device__ __forceinline__ void p0_prologue(const Args& A, Frame& F) {
    LAS float* scr = (LAS float*)(F.lds + RING_OFF + F.wave * 8448);
    const int gw = F.vcu * NWAVES + F.wave, NGW = F.G * NWAVES;
    unsigned char* ws = A.ws;
    const float* const pWMK = A.in[I_WMK]; const float* const pWMV = A.in[I_WMV]; const float* const pWG = A.in[I_WG]; const float* const pWU = A.in[I_WU];
    const float* const pXP = A.in[I_XP]; const float* const pXS = A.in[I_XS];
    constexpr int I_A = 96 * 16, I_B = 32 * 16, I_D = 64 * 16, I_F = 176 * 16, I_G = 32 * 44;
    constexpr int NITEMS = I_A + I_B + I_B + I_D + I_B + I_F + I_G;
    const float* const pWIN = A.in[I_WIN]; const float* const pWOUT = A.in[I_WOUT]; const float* const pWMQ = A.in[I_WMQ]; const float* const pWMO = A.in[I_WMO]; const float* const pWD = A.in[I_WD];
    const float* const pNMQ = A.in[I_NMQ]; const float* const pNFFN = A.in[I_NFFN];
#define TR_DECODE(J, IT) do { int r = (IT); \
        if (r < I_A) { const int nb = r % 96, kb = r / 96, j0 = 32 * nb; int src = j0; \
            if (j0 < 1024) { const int tile = j0 >> 8, local = j0 & 255; src = local < 128 ? 128 * tile + local : 512 + 128 * tile + (local - 128); } \
            J = TrJob{pWIN, nullptr, (bf16*)(ws + WS_WIN), INC, 64 * kb, src, DM, j0}; break; } r -= I_A; \
        if (r < I_B) { const int nb = r % 32, kb = r / 32; J = TrJob{pWOUT, nullptr, (bf16*)(ws + WS_WOUT), DM, 64 * kb, 32 * nb, DM, 32 * nb}; break; } r -= I_B; \
        if (r < I_B) { const int nb = r % 32, kb = r / 32; J = TrJob{pWMQ, pNMQ, (bf16*)(ws + WS_WMQ), DM, 64 * kb, 32 * nb, DM, 32 * nb}; break; } r -= I_B; \
        if (r < I_D) { const int nb = r % 64, kb = r / 64, j0 = 32 * nb; const bool isv = j0 >= 1024; \
            J = TrJob{isv ? pWMV : pWMK, nullptr, (bf16*)(ws + WS_WMKV), DM, 64 * kb, isv ? j0 - 1024 : j0, DM, j0}; break; } r -= I_D; \
        if (r < I_B) { const int nb = r % 32, kb = r / 32; J = TrJob{pWMO, nullptr, (bf16*)(ws + WS_WMO), DM, 64 * kb, 32 * nb, DM, 32 * nb}; break; } r -= I_B; \
        if (r < I_F) { const int nb = r % 176, kb = r / 176, j0 = 32 * nb, tile = j0 >> 8, local = j0 & 255; const bool up = local >= 128; \
            J = TrJob{up ? pWU : pWG, pNFFN, (bf16*)(ws + WS_WGU), DFF, 64 * kb, 128 * tile + (up ? local - 128 : local), DM, j0}; break; } r -= I_F; \
        { const int nb = r % 32, kb = r / 32; J = TrJob{pWD, nullptr, (bf16*)(ws + WS_WDN), DM, 64 * kb, 32 * nb, DFF, 32 * nb}; } } while (0)
    {
        TrJob jc, jn; f32x4 vc[8], vn[8];
        int it = gw;
        if (it < NITEMS) { TR_DECODE(jc, it); tr_load(jc, F.lane, vc); }
#pragma unroll 1
        for (; it < NITEMS; it += NGW) {
            const int itn = it + NGW;
            if (itn < NITEMS) { TR_DECODE(jn, itn); tr_load(jn, F.lane, vn); }
            tr_finish(jc, vc, scr, F.lane);
            jc = jn;
#pragma unroll
            for (int i = 0; i < 8; ++i) vc[i] = vn[i];
        }
    }
#undef TR_DECODE
    {
        bf16* H = (bf16*)(ws + WS_RB); float* BG = (float*)(ws + WS_BG);
        const float* win = A.in[I_WIN]; const float* gain = A.in[I_NMIX];
        float w8[4][4][8];
#pragma unroll
        for (int j = 0; j < 4; ++j)
#pragma unroll
            for (int i = 0; i < 4; ++i) { const int k = 256 * j + 4 * F.lane + i; const f32x4 a = *(const f32x4*)(win + (size_t)k * INC + 3072), b = *(const f32x4*)(win + (size_t)k * INC + 3076);
                w8[j][i][0] = a[0]; w8[j][i][1] = a[1]; w8[j][i][2] = a[2]; w8[j][i][3] = a[3]; w8[j][i][4] = b[0]; w8[j][i][5] = b[1]; w8[j][i][6] = b[2]; w8[j][i][7] = b[3]; }
        f32x4 gn[4];
#pragma unroll
        for (int j = 0; j < 4; ++j) gn[j] = *(const f32x4*)(gain + 256 * j + 4 * F.lane);
        const f32x4 alog4 = *(const f32x4*)A.in[I_ALOG], dtb4 = *(const f32x4*)A.in[I_DTB];
        const bool hi5 = (F.lane & 32) != 0, b4 = (F.lane & 16) != 0, b3 = (F.lane & 8) != 0; const int cidx = (hi5 ? 4 : 0) + (b4 ? 2 : 0) + (b3 ? 1 : 0), c3 = cidx & 3;
        const float myea = expf(c3 == 0 ? alog4[0] : c3 == 1 ? alog4[1] : c3 == 2 ? alog4[2] : alog4[3]);
        const float mydtb = (cidx < 4) ? 0.f : (c3 == 0 ? dtb4[0] : c3 == 1 ? dtb4[1] : c3 == 2 ? dtb4[2] : dtb4[3]);
        f32x4 v[4], nv[4];
        { const int m0 = gw; if (m0 < MV) { const GAS f32x4* xr = (const GAS f32x4*)((m0 < MP) ? pXP + (size_t)m0 * DM : pXS + (size_t)(m0 - MP) * DM) + F.lane;
#pragma unroll
            for (int j = 0; j < 4; ++j) v[j] = xr[64 * j]; } }
#pragma unroll 1
        for (int m = gw; m < MR; m += NGW) {
            GAS unsigned long long* o8 = (GAS unsigned long long*)(H + (size_t)m * DM) + F.lane;
            { const int mn = m + NGW; if (mn < MV) { const GAS f32x4* xr = (const GAS f32x4*)((mn < MP) ? pXP + (size_t)mn * DM : pXS + (size_t)(mn - MP) * DM) + F.lane;
#pragma unroll
                for (int j = 0; j < 4; ++j) nv[j] = xr[64 * j]; } }
            if (m >= MV) {
#pragma unroll
                for (int j = 0; j < 4; ++j) o8[64 * j] = 0ull;
                if (F.lane < 8) BG[(size_t)m * 8 + F.lane] = 0.f;
                continue;
            }
            float s2 = 0.f;
#pragma unroll
            for (int j = 0; j < 4; ++j) s2 += (v[j][0] * v[j][0] + v[j][1] * v[j][1]) + (v[j][2] * v[j][2] + v[j][3] * v[j][3]);
            const float rstd = 1.f / sqrtf(wave_sum(s2) * (1.f / DM) + RMS_EPS);
            float p8[8];
#pragma unroll
            for (int c = 0; c < 8; ++c) p8[c] = 0.f;
#pragma unroll
            for (int j = 0; j < 4; ++j) { v[j] = v[j] * rstd * gn[j];
#pragma unroll
                for (int i = 0; i < 4; ++i)
#pragma unroll
                    for (int c = 0; c < 8; ++c) p8[c] += v[j][i] * w8[j][i][c];
                o8[64 * j] = (unsigned long long)pk2(v[j][0], v[j][1]) | ((unsigned long long)pk2(v[j][2], v[j][3]) << 32); }
            float z;
            { float r4[4], q2[2];
#pragma unroll
              for (int i = 0; i < 4; ++i) { const float send = hi5 ? p8[i] : p8[4 + i], keep = hi5 ? p8[4 + i] : p8[i]; r4[i] = keep + __shfl_xor(send, 32); }
#pragma unroll
              for (int i = 0; i < 2; ++i) { const float send = b4 ? r4[i] : r4[2 + i], keep = b4 ? r4[2 + i] : r4[i]; q2[i] = keep + __shfl_xor(send, 16); }
              { const float send = b3 ? q2[0] : q2[1], keep = b3 ? q2[1] : q2[0]; z = keep + __shfl_xor(send, 8); }
              z += dppf<0xB1>(z); z += dppf<0x4E>(z); z += dppf<0x141>(z); }
            { const float xs = z + mydtb;
              const float sp = xs > 20.f ? xs : (xs < -15.f ? __expf(xs) : __logf(1.f + __expf(xs)));
              const float val = (cidx < 4) ? __builtin_amdgcn_rcpf(1.f + __expf(-z)) : -myea * sp;
              if ((F.lane & 7) == 0) BG[(size_t)m * 8 + cidx] = val; }
#pragma unroll
            for (int j = 0; j < 4; ++j) v[j] = nv[j];
        }
    }
    {
        bf16* MN = (bf16*)(ws + WS_MEMN); const float* gain = A.in[I_NMKV];
        f32x4 gn[4];
#pragma unroll
        for (int j = 0; j < 4; ++j) gn[j] = *(const f32x4*)(gain + 256 * j + 4 * F.lane);
        for (int m = gw; m < NB * NMEM; m += NGW) {
            const GAS f32x4* xr = (const GAS f32x4*)(A.in[I_MEM] + (size_t)m * DM) + F.lane;
            f32x4 v[4]; float s2 = 0.f;
#pragma unroll
            for (int j = 0; j < 4; ++j) { v[j] = xr[64 * j]; s2 += (v[j][0] * v[j][0] + v[j][1] * v[j][1]) + (v[j][2] * v[j][2] + v[j][3] * v[j][3]); }
            const float rstd = 1.f / sqrtf(wave_sum(s2) * (1.f / DM) + RMS_EPS);
            GAS unsigned long long* o8 = (GAS unsigned long long*)(MN + (size_t)m * DM) + F.lane;
#pragma unroll
            for (int j = 0; j < 4; ++j) { v[j] = v[j] * rstd * gn[j]; o8[64 * j] = (unsigned long long)pk2(v[j][0], v[j][1]) | ((unsigned long long)pk2(v[j][2], v[j][3]) << 32); }
        }
    }
}

typedef float f32x2v __attribute__((ext_vector_type(2)));
__device__ __forceinline__ void short_conv_part(const Args& A, Frame& F, int b, int t0, int p, int oz) {
    const bf16* PB = (const bf16*)(A.ws + WS_RA); bf16* QC = (bf16*)(A.ws + WS_RC);
    __builtin_amdgcn_sched_barrier(0);
    const int ch0 = 512 * p + 8 * F.lane + oz;
    float wsc[4][8];
#pragma unroll
    for (int j = 0; j < 4; ++j) { const f32x4 a = *(const f32x4*)(A.in[I_SCW] + j * QKVN + ch0), bb = *(const f32x4*)(A.in[I_SCW] + j * QKVN + ch0 + 4);
#pragma unroll
        for (int i = 0; i < 4; ++i) { wsc[j][i] = a[i]; wsc[j][4 + i] = bb[i]; } }
    float win[3][8];
#pragma unroll
    for (int j = 0; j < 3; ++j) { const int tk = t0 - 3 + j; const int tkc = tk < 0 ? 0 : tk;
        const v4u x = *(const GAS v4u*)(PB + (size_t)(b * SEQ + tkc) * PBLD + 512 + ch0); unpack8(x, win[j]);
#pragma unroll
        for (int i = 0; i < 8; ++i) win[j][i] = (tk >= 0) ? win[j][i] : 0.f; }
#pragma unroll
    for (int tt = 0; tt < 8; ++tt) {
        float cur[8]; { const v4u x = *(const GAS v4u*)(PB + (size_t)(b * SEQ + t0 + tt) * PBLD + 512 + ch0); unpack8(x, cur); }
        float y[8]; float ss = 0.f;
#pragma unroll
        for (int i = 0; i < 8; ++i) { const float a = wsc[0][i] * win[0][i] + wsc[1][i] * win[1][i] + wsc[2][i] * win[2][i] + wsc[3][i] * cur[i]; y[i] = silu(a); ss += y[i] * y[i]; }
        if (p < 2) { ss = row16_sum(ss);
            const float sc = __builtin_amdgcn_rsqf(ss + 1e-6f) * (p == 0 ? 0.08838834764831845f : 1.f);
#pragma unroll
            for (int i = 0; i < 8; ++i) y[i] *= sc; }
        *(GAS v4u*)(QC + (size_t)(b * SEQ + t0 + tt) * QKVN + ch0) = pack8(y);
#pragma unroll
        for (int i = 0; i < 8; ++i) { win[0][i] = win[1][i]; win[1][i] = win[2][i]; win[2][i] = cur[i]; }
    }
}
__device__ __forceinline__ void conv_tile(const Args& A, Frame& F, int b, int tile) {
    const bf16* PB = (const bf16*)(A.ws + WS_RA); bf16* CD = (bf16*)(A.ws + WS_RB);
    int oz; asm volatile("v_mov_b32 %0, 0" : "=v"(oz));
    const int row0 = b * SEQ + tile * 64;
    LAS float* Y = (LAS float*)(F.lds + RING_OFF);
    if (F.wave < 4) {
        const unsigned rb = (unsigned)(b * SEQ + tile * 64);
#pragma unroll 1
        for (int pass = (A.pad & 8) ? 2 : 0; pass < 2; ++pass) {
            const int c = F.tid + 256 * pass + oz;
            float w[CW];
#pragma unroll
            for (int j = 0; j < CW; ++j) w[j] = A.in[I_CONVW][j * CC + c];
            const float bias = A.in[I_CONVB][c];
            float u[38]; float nx[8];
#pragma unroll
            for (int i = 0; i < 30; ++i) { const int tk = tile * 64 - 30 + i; const unsigned tkc = tk < 0 ? 0u : (unsigned)tk; const float vv = bf2f(PB[(unsigned)(b * SEQ + tkc) * (unsigned)PBLD + (unsigned)c]); u[i] = (tk >= 0) ? vv : 0.f; }
#pragma unroll
            for (int i = 0; i < 8; ++i) nx[i] = bf2f(PB[(rb + (unsigned)i) * (unsigned)PBLD + (unsigned)c]);
#pragma unroll 1
            for (int seg = 0; seg < 8; ++seg) {
#pragma unroll
                for (int i = 0; i < 8; ++i) u[30 + i] = nx[i];
                if (seg < 7) {
#pragma unroll
                    for (int i = 0; i < 8; ++i) nx[i] = bf2f(PB[(rb + (unsigned)(seg * 8 + 8 + i)) * (unsigned)PBLD + (unsigned)c]); }
#pragma unroll
                for (int t = 0; t < 8; ++t) { float a = bias;
#pragma unroll
                    for (int j = 0; j < CW; ++j) a += w[j] * u[t + j];
                    Y[(seg * 8 + t) * CC + c] = a; }
#pragma unroll
                for (int i = 0; i < 30; ++i) u[i] = u[i + 8];
            }
        }
    } else {
        const int t0 = tile * 64 + 16 * (F.wave - 4);
        _Pragma("unroll 1") for (int q = (A.pad & 32) ? 4 : 0; q < 4; ++q) short_conv_part(A, F, b, t0 + 8 * (q & 1), q >> 1, oz);
    }
    __syncthreads();
    if (F.wave < 4) {
        const int ch0 = 8 * F.lane + oz;
        const f32x4 g0 = *(const f32x4*)(A.in[I_LNG] + ch0), g1 = *(const f32x4*)(A.in[I_LNG] + ch0 + 4), b0 = *(const f32x4*)(A.in[I_LNB] + ch0), b1 = *(const f32x4*)(A.in[I_LNB] + ch0 + 4);
#pragma unroll 2
        for (int tt = (A.pad & 16) ? 16 : 0; tt < 16; ++tt) { const int t = 16 * F.wave + tt;
            f32x4 y0 = *(const LAS f32x4*)(Y + t * CC + ch0), y1 = *(const LAS f32x4*)(Y + t * CC + ch0 + 4);
            const float mean = wave_sum((y0[0] + y0[1]) + (y0[2] + y0[3]) + (y1[0] + y1[1]) + (y1[2] + y1[3])) * (1.f / CC);
            y0 = y0 - mean; y1 = y1 - mean;
            const float var = wave_sum((y0[0] * y0[0] + y0[1] * y0[1]) + (y0[2] * y0[2] + y0[3] * y0[3]) + (y1[0] * y1[0] + y1[1] * y1[1]) + (y1[2] * y1[2] + y1[3] * y1[3])) * (1.f / CC);
            const float rstd = __builtin_amdgcn_rsqf(var + 1e-5f);
            y0 = y0 * rstd * g0 + b0; y1 = y1 * rstd * g1 + b1;
            float o[8];
#pragma unroll
            for (int i = 0; i < 4; ++i) { o[i] = silu(y0[i]); o[4 + i] = silu(y1[i]); }
            *(GAS v4u*)(CD + (size_t)(row0 + t) * DM + ch0) = pack8(o); }
        if (tile == 31) {
            const int c = 2 * F.tid;
            float* oc = A.out + OUT_CONVP + (size_t)b * 30 * CC;
            unsigned tv[30];
#pragma unroll
            for (int j = 0; j < 30; ++j) tv[j] = *(const GAS unsigned*)(PB + (size_t)(b * SEQ + SEQ - 30 + j) * PBLD + c);
            __builtin_amdgcn_sched_barrier(0);
#pragma unroll
            for (int j = 0; j < 30; ++j) *(f32x2v*)(oc + j * CC + c) = (f32x2v){bflo(tv[j]), bfhi(tv[j])};
            float* os = A.out + OUT_SCP + (size_t)b * 3 * QKVN;
            unsigned sv[9];
#pragma unroll
            for (int q = 0; q < 9; ++q) { const int e = 2 * (F.tid + q * 256); const int j = e / QKVN, ch = e % QKVN; sv[q] = *(const GAS unsigned*)(PB + (size_t)(b * SEQ + SEQ - 3 + j) * PBLD + 512 + ch); }
            __builtin_amdgcn_sched_barrier(0);
#pragma unroll
            for (int q = 0; q < 9; ++q) *(f32x2v*)(os + 2 * (F.tid + q * 256)) = (f32x2v){bflo(sv[q]), bfhi(sv[q])};
        }
    } else {
        _Pragma("unroll 1") for (int q = (A.pad & 32) ? 2 : 0; q < 2; ++q) short_conv_part(A, F, b, tile * 64 + 16 * (F.wave - 4) + 8 * q, 2, oz);
    }
    __syncthreads();
}
__device__ __forceinline__ void conv_sample(const Args& A, Frame& F, int s) {
    const bf16* PB = (const bf16*)(A.ws + WS_RA); bf16* CD = (bf16*)(A.ws + WS_RB); bf16* QC = (bf16*)(A.ws + WS_RC);
    const int c = F.tid; const size_t row = (size_t)MP + s;
    LAS float* Y = (LAS float*)(F.lds + RING_OFF);
    {
        const float* cache = A.in[I_CCONV] + (size_t)s * 30 * CC; float* oc = A.out + OUT_CONVS + (size_t)s * 30 * CC;
        const float us = bf2f(PB[row * PBLD + c]);
        float a = A.in[I_CONVB][c];
        float cv[30], wv[31];
#pragma unroll
        for (int j = 0; j < 30; ++j) { cv[j] = cache[j * CC + c]; wv[j] = A.in[I_CONVW][j * CC + c]; }
        wv[30] = A.in[I_CONVW][30 * CC + c];
        __builtin_amdgcn_sched_barrier(0);
#pragma unroll
        for (int j = 0; j < 30; ++j) { a += wv[j] * cv[j]; oc[j * CC + c] = (j < 29) ? cv[j + 1] : us; }
        a += wv[30] * us;
        Y[c] = a;
    }
    __syncthreads();
    if (F.wave == 7) {
        const int ch0 = 8 * F.lane;
        const f32x4 g0 = *(const f32x4*)(A.in[I_LNG] + ch0), g1 = *(const f32x4*)(A.in[I_LNG] + ch0 + 4), b0 = *(const f32x4*)(A.in[I_LNB] + ch0), b1 = *(const f32x4*)(A.in[I_LNB] + ch0 + 4);
        f32x4 y0 = *(const LAS f32x4*)(Y + ch0), y1 = *(const LAS f32x4*)(Y + ch0 + 4);
        const float mean = wave_sum((y0[0] + y0[1]) + (y0[2] + y0[3]) + (y1[0] + y1[1]) + (y1[2] + y1[3])) * (1.f / CC);
        y0 = y0 - mean; y1 = y1 - mean;
        const float var = wave_sum((y0[0] * y0[0] + y0[1] * y0[1]) + (y0[2] * y0[2] + y0[3] * y0[3]) + (y1[0] * y1[0] + y1[1] * y1[1]) + (y1[2] * y1[2] + y1[3] * y1[3])) * (1.f / CC);
        const float rstd = 1.f / sqrtf(var + 1e-5f);
        y0 = y0 * rstd * g0 + b0; y1 = y1 * rstd * g1 + b1;
        float o[8];
#pragma unroll
        for (int i = 0; i < 4; ++i) { o[i] = silu(y0[i]); o[4 + i] = silu(y1[i]); }
        *(GAS v4u*)(CD + row * DM + ch0) = pack8(o);
    }
    if (F.wave < 3) {
        const int p = F.wave; const int ch0 = 512 * p + 8 * F.lane;
        const float* st = A.in[I_SSC] + (size_t)s * 3 * QKVN; float* os = A.out + OUT_SCS + (size_t)s * 3 * QKVN;
        float win[3][8], cur[8], y[8];
#pragma unroll
        for (int j = 0; j < 3; ++j) { const f32x4 a = *(const f32x4*)(st + j * QKVN + ch0), bb = *(const f32x4*)(st + j * QKVN + ch0 + 4);
#pragma unroll
            for (int i = 0; i < 4; ++i) { win[j][i] = a[i]; win[j][4 + i] = bb[i]; } }
        { const v4u x = *(const GAS v4u*)(PB + row * PBLD + 512 + ch0); unpack8(x, cur); }
        float ss = 0.f;
#pragma unroll
        for (int i = 0; i < 8; ++i) { float a = 0.f;
#pragma unroll
            for (int j = 0; j < 3; ++j) a += A.in[I_SCW][j * QKVN + ch0 + i] * win[j][i];
            a += A.in[I_SCW][3 * QKVN + ch0 + i] * cur[i]; y[i] = silu(a); ss += y[i] * y[i]; }
        if (p < 2) { ss = row16_sum(ss);
            const float sc = (1.f / sqrtf(ss + 1e-6f)) * (p == 0 ? 0.08838834764831845f : 1.f);
#pragma unroll
            for (int i = 0; i < 8; ++i) y[i] *= sc; }
        *(GAS v4u*)(QC + row * QKVN + ch0) = pack8(y);
#pragma unroll
        for (int j = 0; j < 3; ++j) { f32x4 a, bb;
#pragma unroll
            for (int i = 0; i < 4; ++i) { a[i] = (j < 2) ? win[j + 1][i] : cur[i]; bb[i] = (j < 2) ? win[j + 1][4 + i] : cur[4 + i]; }
            *(f32x4*)(os + j * QKVN + ch0) = a; *(f32x4*)(os + j * QKVN + ch0 + 4) = bb; }
    }
    __syncthreads();
}

__device__ __forceinline__ bf16x8 lds_frag16(const LAS unsigned char* p) { return *(const LAS bf16x8*)p; }
__device__ __forceinline__ void d1_chunk(const Args& A, Frame& F, int ci) {
    using pg8::f32x4;
    const int b = ci >> 7, h = (ci >> 5) & 3, n = ci & 31; const int row0 = b * SEQ + n * 64;
    const bf16* QC = (const bf16*)(A.ws + WS_RC); const float* BG = (const float*)(A.ws + WS_BG);
    float* Ug = (float*)(A.ws + WS_U) + (size_t)ci * 8192; bf16* Wg = (bf16*)(A.ws + WS_W) + (size_t)ci * 8192; bf16* QGg = (bf16*)(A.ws + WS_QG) + (size_t)ci * 8192;
    bf16* KDTg = (bf16*)(A.ws + WS_KDT) + (size_t)ci * 8192; bf16* QKg = (bf16*)(A.ws + WS_QK) + (size_t)ci * 4096; float* GLg = (float*)(A.ws + WS_GL);
    constexpr int OFF_K = 0, OFF_Q = 17408, OFF_VBT = 34816, OFF_KBGT = 53248, OFF_L = 71680, OFF_T = 89088, OFF_GC = 98304, OFF_BETA = 98560, OFF_EG = 98816, OFF_TM = 99072, OFF_X = 116480, LS = 68;
    LAS unsigned char* L = F.lds + RING_OFF;
    LAS float* gcs = (LAS float*)(L + OFF_GC); LAS float* betas = (LAS float*)(L + OFF_BETA); LAS float* egs = (LAS float*)(L + OFF_EG); LAS float* Lm = (LAS float*)(L + OFF_L); LAS float* Tm = (LAS float*)(L + OFF_TM); LAS float* Xm = (LAS float*)(L + OFF_X);
    const int fr = F.lane & 15, fq = F.lane >> 4;
    if (F.wave == 0) {
        float g = BG[(size_t)(row0 + F.lane) * 8 + 4 + h]; const float be = BG[(size_t)(row0 + F.lane) * 8 + h];
#pragma unroll
        for (int o = 1; o < 64; o <<= 1) { const float v = __shfl_up(g, o); if (F.lane >= o) g += v; }
        gcs[F.lane] = g; betas[F.lane] = be; egs[F.lane] = __expf(g);
    }
    __syncthreads();
    {
        const int t = F.tid >> 3, part = F.tid & 7;
        const bf16* rp = QC + (size_t)(row0 + t) * QKVN + h * 128 + part * 16;
        const v4u q0 = *(const GAS v4u*)(rp), q1 = *(const GAS v4u*)(rp + 8), k0 = *(const GAS v4u*)(rp + 512), k1 = *(const GAS v4u*)(rp + 520), v0 = *(const GAS v4u*)(rp + 1024), v1 = *(const GAS v4u*)(rp + 1032);
        *(LAS v4u*)(L + OFF_K + t * 272 + part * 32) = k0; *(LAS v4u*)(L + OFF_K + t * 272 + part * 32 + 16) = k1;
        *(LAS v4u*)(L + OFF_Q + t * 272 + part * 32) = q0; *(LAS v4u*)(L + OFF_Q + t * 272 + part * 32 + 16) = q1;
        const float be = betas[t], beg = be * egs[t];
        float kf[16], vf[16];
        { float tmp[8]; unpack8(k0, tmp);
#pragma unroll
          for (int i = 0; i < 8; ++i) kf[i] = tmp[i]; unpack8(k1, tmp);
#pragma unroll
          for (int i = 0; i < 8; ++i) kf[8 + i] = tmp[i]; unpack8(v0, tmp);
#pragma unroll
          for (int i = 0; i < 8; ++i) vf[i] = tmp[i]; unpack8(v1, tmp);
#pragma unroll
          for (int i = 0; i < 8; ++i) vf[8 + i] = tmp[i]; }
#pragma unroll
        for (int i = 0; i < 16; ++i) { const int d = part * 16 + i;
            *(LAS unsigned short*)(L + OFF_VBT + d * 144 + t * 2) = (unsigned short)(pk2(vf[i] * be, 0.f) & 0xffffu);
            *(LAS unsigned short*)(L + OFF_KBGT + d * 144 + t * 2) = (unsigned short)(pk2(kf[i] * beg, 0.f) & 0xffffu); }
    }
    __syncthreads();
#pragma unroll 1
    for (int x = 0; x < 4; ++x) {
        const int tile = F.wave * 4 + x, which = tile >> 4, ti = (tile >> 2) & 3, tj = tile & 3;
        f32x4 acc = (f32x4){0.f, 0.f, 0.f, 0.f};
        if (ti >= tj) {
            const LAS unsigned char* ap = L + (which ? OFF_Q : OFF_K) + (ti * 16 + fr) * 272 + fq * 16; const LAS unsigned char* bp = L + OFF_K + (tj * 16 + fr) * 272 + fq * 16;
#pragma unroll
            for (int kk = 0; kk < 4; ++kk) acc = __builtin_amdgcn_mfma_f32_16x16x32_bf16(lds_frag16(ap + kk * 64), lds_frag16(bp + kk * 64), acc, 0, 0, 0);
        }
        const int j = tj * 16 + fr; const float gj = gcs[j];
#pragma unroll
        for (int r = 0; r < 4; ++r) { const int i = ti * 16 + 4 * fq + r; const float dec = __expf(gcs[i] - gj);
            if (which == 0) Lm[i * LS + j] = (i > j) ? betas[i] * acc[r] * dec : 0.f;
            else QKg[i * 64 + j] = (bf16)(pk2((i >= j) ? acc[r] * dec : 0.f, 0.f) & 0xffffu); }
    }
    __syncthreads();
    for (int e = F.tid; e < 64 * LS; e += NWAVES * 64) Tm[e] = 0.f;
    __syncthreads();
    if (F.wave == 0) {
        const LAS float* Lb = Lm + (16 * fq) * LS + 16 * fq;
        float t[16];
#pragma unroll
        for (int i = 0; i < 16; ++i) {
            float a0 = 0.f, a1 = 0.f, a2 = 0.f, a3 = 0.f;
#pragma unroll
            for (int j4 = 0; j4 < (i + 3) / 4; ++j4) { const f32x4 lv = *(const LAS f32x4*)(Lb + i * LS + 4 * j4);
                if (4 * j4 + 0 < i) a0 += lv[0] * t[4 * j4 + 0]; if (4 * j4 + 1 < i) a1 += lv[1] * t[4 * j4 + 1]; if (4 * j4 + 2 < i) a2 += lv[2] * t[4 * j4 + 2]; if (4 * j4 + 3 < i) a3 += lv[3] * t[4 * j4 + 3]; }
            t[i] = ((fr == i) ? 1.f : 0.f) - ((a0 + a1) + (a2 + a3));
        }
#pragma unroll
        for (int i = 0; i < 16; ++i) Tm[(16 * fq + i) * LS + 16 * fq + fr] = t[i];
    } else {
        const int lt = F.tid - 64; const float gl = gcs[63];
        for (int cix = lt; cix < 1024; cix += 448) {
            const int t = cix >> 4, cc = cix & 15; const v4u x = *(const LAS v4u*)(L + OFF_Q + t * 272 + cc * 16); float f[8]; unpack8(x, f); const float e = egs[t];
#pragma unroll
            for (int i = 0; i < 8; ++i) f[i] *= e;
            *(GAS v4u*)(QGg + t * 128 + cc * 8) = pack8(f); }
        for (int cix = lt; cix < 1024; cix += 448) {
            const int dk = cix >> 3, t0 = (cix & 7) * 8; float f[8];
#pragma unroll
            for (int i = 0; i < 8; ++i) f[i] = bf2f(*(const LAS unsigned short*)(L + OFF_K + (t0 + i) * 272 + dk * 2)) * __expf(gl - gcs[t0 + i]);
            *(GAS v4u*)(KDTg + dk * 64 + t0) = pack8(f); }
        if (lt == 0) GLg[ci] = __expf(gl);
    }
    __syncthreads();
    if (F.wave < 2) {
        const int pp = F.wave, rb = 16 * (2 * pp + 1), cb = 16 * (2 * pp); f32x4 acc = (f32x4){0.f, 0.f, 0.f, 0.f};
#pragma unroll
        for (int kk = 0; kk < 4; ++kk) acc = __builtin_amdgcn_mfma_f32_16x16x4f32(Lm[(rb + fr) * LS + cb + 4 * kk + fq], Tm[(cb + 4 * kk + fq) * LS + cb + fr], acc, 0, 0, 0);
#pragma unroll
        for (int r = 0; r < 4; ++r) Xm[pp * 576 + (4 * fq + r) * 36 + fr] = acc[r];
    }
    __syncthreads();
    if (F.wave < 2) {
        const int pp = F.wave, rb = 16 * (2 * pp + 1), cb = 16 * (2 * pp); f32x4 acc = (f32x4){0.f, 0.f, 0.f, 0.f};
#pragma unroll
        for (int kk = 0; kk < 4; ++kk) acc = __builtin_amdgcn_mfma_f32_16x16x4f32(Tm[(rb + fr) * LS + rb + 4 * kk + fq], Xm[pp * 576 + (4 * kk + fq) * 36 + fr], acc, 0, 0, 0);
#pragma unroll
        for (int r = 0; r < 4; ++r) Tm[(rb + 4 * fq + r) * LS + cb + fr] = -acc[r];
    }
    __syncthreads();
    if (F.wave < 4) {
        const int bi = F.wave >> 1, bj = F.wave & 1; f32x4 acc = (f32x4){0.f, 0.f, 0.f, 0.f};
#pragma unroll
        for (int kk = 0; kk < 8; ++kk) acc = __builtin_amdgcn_mfma_f32_16x16x4f32(Lm[(32 + 16 * bi + fr) * LS + 4 * kk + fq], Tm[(4 * kk + fq) * LS + 16 * bj + fr], acc, 0, 0, 0);
#pragma unroll
        for (int r = 0; r < 4; ++r) Xm[(16 * bi + 4 * fq + r) * 36 + 16 * bj + fr] = acc[r];
    }
    __syncthreads();
    if (F.wave < 4) {
        const int bi = F.wave >> 1, bj = F.wave & 1; f32x4 acc = (f32x4){0.f, 0.f, 0.f, 0.f};
#pragma unroll
        for (int kk = 0; kk < 8; ++kk) acc = __builtin_amdgcn_mfma_f32_16x16x4f32(Tm[(32 + 16 * bi + fr) * LS + 32 + 4 * kk + fq], Xm[(4 * kk + fq) * 36 + 16 * bj + fr], acc, 0, 0, 0);
#pragma unroll
        for (int r = 0; r < 4; ++r) Tm[(32 + 16 * bi + 4 * fq + r) * LS + 16 * bj + fr] = -acc[r];
    }
    __syncthreads();
    {
        const int i = F.tid >> 3, j0 = (F.tid & 7) * 8; const f32x4 a = *(const LAS f32x4*)(Tm + i * LS + j0), bq = *(const LAS f32x4*)(Tm + i * LS + j0 + 4);
        v4u w; w.x = pk2(a[0], a[1]); w.y = pk2(a[2], a[3]); w.z = pk2(bq[0], bq[1]); w.w = pk2(bq[2], bq[3]);
        *(LAS v4u*)(L + OFF_T + i * 144 + j0 * 2) = w;
    }
    __syncthreads();
#pragma unroll 1
    for (int x = 0; x < 8; ++x) {
        const int tile = F.wave * 8 + x, which = tile >> 5, ti = (tile >> 3) & 3, td = tile & 7;
        const LAS unsigned char* ap = L + OFF_T + (ti * 16 + fr) * 144 + fq * 16; const LAS unsigned char* bp = L + (which ? OFF_KBGT : OFF_VBT) + (td * 16 + fr) * 144 + fq * 16;
        f32x4 acc = (f32x4){0.f, 0.f, 0.f, 0.f};
#pragma unroll
        for (int kk = 0; kk < 2; ++kk) acc = __builtin_amdgcn_mfma_f32_16x16x32_bf16(lds_frag16(ap + kk * 64), lds_frag16(bp + kk * 64), acc, 0, 0, 0);
        const int d = td * 16 + fr;
#pragma unroll
        for (int r = 0; r < 4; ++r) { const int i = ti * 16 + 4 * fq + r;
            if (which == 0) Ug[i * 128 + d] = acc[r]; else Wg[i * 128 + d] = (bf16)(pk2(acc[r], 0.f) & 0xffffu); }
    }
    __syncthreads();
}

constexpr int SC_OW = 0, SC_OQG = 16384, SC_OKDT = 32768, SC_OQK = 49152, SC_OU = 57344, SC_BUF = 65536, SC_NS = 2;
__device__ __forceinline__ void scan_issue(const Args& A, Frame& F, int ci, int sl0, LAS unsigned char* dst) {
    const unsigned char* Wg = A.ws + WS_W + (size_t)ci * 16384; const unsigned char* QGg = A.ws + WS_QG + (size_t)ci * 16384;
    const unsigned char* KDTg = A.ws + WS_KDT + (size_t)ci * 16384; const unsigned char* QKg = A.ws + WS_QK + (size_t)ci * 8192; const unsigned char* Ug = A.ws + WS_U + (size_t)ci * 32768 + sl0 * 64;
#pragma unroll
    for (int j = 0; j < 11; ++j) {
        const int pi = (F.wave - SC_NS) + (NWAVES - SC_NS) * j;
        if (pi < 56 + 4 * SC_NS) {
            const unsigned char* src;
            if (pi < 32) { const int i = (pi & 15) * 64 + F.lane, r = i >> 4, c = (i & 15) ^ (r & 15); src = (pi < 16 ? Wg : QGg) + r * 256 + c * 16; }
            else if (pi < 56) { const int i = (pi < 48 ? pi - 32 : pi - 48) * 64 + F.lane, r = i >> 3, c = (i & 7) ^ ((r >> 1) & 7); src = (pi < 48 ? KDTg : QKg) + r * 128 + c * 16; }
            else { const int i = ((pi - 56) & 3) * 64 + F.lane, r = i >> 2, c = i & 3; src = Ug + ((pi - 56) >> 2) * 64 + r * 512 + c * 16; }
            __builtin_amdgcn_global_load_lds((const unsigned*)src, (LAS unsigned*)(dst + pi * 1024), 16, 0, 0);
        }
    }
}
__device__ __forceinline__ bf16x8 frag2(const LAS unsigned char* p0, const LAS unsigned char* p1) { const v2u lo = *(const LAS v2u*)p0, hi = *(const LAS v2u*)p1; v4u w; w.x = lo.x; w.y = lo.y; w.z = hi.x; w.w = hi.y; return __builtin_bit_cast(bf16x8, w); }
__device__ __forceinline__ bf16x8 frag256(const LAS unsigned char* tile, int row, int kstep, int fq) { const int c = 4 * kstep + (fq >> 1), sw = row & 15; const LAS unsigned char* rp = tile + row * 256 + 8 * (fq & 1); return frag2(rp + ((c ^ sw) << 4), rp + (((c + 2) ^ sw) << 4)); }
__device__ __forceinline__ bf16x8 frag128(const LAS unsigned char* tile, int row, int kstep, int fq) { const int c = 4 * kstep + (fq >> 1), sw = (row >> 1) & 7; const LAS unsigned char* rp = tile + row * 128 + 8 * (fq & 1); return frag2(rp + ((c ^ sw) << 4), rp + (((c + 2) ^ sw) << 4)); }
__device__ __forceinline__ bf16x8 pack_pair(const pg8::f32x4& a, const pg8::f32x4& b) { v4u w; w.x = pk2(a[0], a[1]); w.y = pk2(a[2], a[3]); w.z = pk2(b[0], b[1]); w.w = pk2(b[2], b[3]); return __builtin_bit_cast(bf16x8, w); }
__device__ __forceinline__ void scan_unit(const Args& A, Frame& F, int b, int h, int sl0) {
    using pg8::f32x4;
    LAS unsigned char* L = F.lds + RING_OFF;
    const int ci0 = (b * NH + h) * 32; const int fr = F.lane & 15, fq = F.lane >> 4;
    float* Og = (float*)(A.ws + WS_RE); const float* GLg = (const float*)(A.ws + WS_GL);
    const int sl = sl0 + F.wave;
    if (F.wave >= SC_NS) { scan_issue(A, F, ci0, sl0, L); scan_issue(A, F, ci0 + 1, sl0, L + SC_BUF); asm volatile("s_waitcnt vmcnt(10)" ::: "memory"); }
    __builtin_amdgcn_s_barrier(); asm volatile("" ::: "memory");
    f32x4 S[8];
#pragma unroll
    for (int i = 0; i < 8; ++i) S[i] = (f32x4){0.f, 0.f, 0.f, 0.f};
    float gl = GLg[ci0];
#pragma unroll 1
    for (int n = 0; n < 32; ++n) {
        if (F.wave < SC_NS) {
            const LAS unsigned char* B = L + (n & 1) * SC_BUF; const LAS unsigned char* Ub = B + SC_OU + F.wave * 4096;
            const float gln = GLg[ci0 + (n < 31 ? n + 1 : n)];
            bf16x8 Sb[4];
#pragma unroll
            for (int kk = 0; kk < 4; ++kk) Sb[kk] = pack_pair(S[2 * kk], S[2 * kk + 1]);
            f32x4 vn[4];
#pragma unroll
            for (int tb = 0; tb < 4; ++tb) { f32x4 p1 = (f32x4){0.f, 0.f, 0.f, 0.f};
#pragma unroll
                for (int kk = 0; kk < 4; ++kk) p1 = __builtin_amdgcn_mfma_f32_16x16x32_bf16(frag256(B + SC_OW, 16 * tb + fr, kk, fq), Sb[kk], p1, 0, 0, 0);
#pragma unroll
                for (int r = 0; r < 4; ++r) vn[tb][r] = *(const LAS float*)(Ub + (16 * tb + 4 * fq + r) * 64 + fr * 4) - p1[r]; }
            bf16x8 Vb[2]; Vb[0] = pack_pair(vn[0], vn[1]); Vb[1] = pack_pair(vn[2], vn[3]);
            const size_t orow = (size_t)(b * SEQ + n * 64);
#pragma unroll
            for (int blk = 0; blk < 8; ++blk) { f32x4 s = S[blk] * gl;
#pragma unroll
                for (int kt = 0; kt < 2; ++kt) s = __builtin_amdgcn_mfma_f32_16x16x32_bf16(frag128(B + SC_OKDT, 16 * blk + fr, kt, fq), Vb[kt], s, 0, 0, 0);
                S[blk] = s; }
#pragma unroll
            for (int tb = 0; tb < 4; ++tb) { f32x4 o = (f32x4){0.f, 0.f, 0.f, 0.f};
#pragma unroll
                for (int kk = 0; kk < 4; ++kk) o = __builtin_amdgcn_mfma_f32_16x16x32_bf16(frag256(B + SC_OQG, 16 * tb + fr, kk, fq), Sb[kk], o, 0, 0, 0);
#pragma unroll
                for (int kt = 0; kt < 2; ++kt) o = __builtin_amdgcn_mfma_f32_16x16x32_bf16(frag128(B + SC_OQK, 16 * tb + fr, kt, fq), Vb[kt], o, 0, 0, 0);
#pragma unroll
                for (int r = 0; r < 4; ++r) Og[(orow + 16 * tb + 4 * fq + r) * 512 + h * 128 + sl * 16 + fr] = o[r]; }
            gl = gln;
            asm volatile("s_waitcnt lgkmcnt(0)" ::: "memory");
        } else {
            asm volatile("s_waitcnt vmcnt(0)" ::: "memory");
        }
        __builtin_amdgcn_s_barrier(); asm volatile("" ::: "memory");
        if (F.wave >= SC_NS && n + 2 < 32) scan_issue(A, F, ci0 + n + 2, sl0, L + (n & 1) * SC_BUF);
    }
    if (F.wave < SC_NS) {
        float* od = A.out + OUT_DLP + (size_t)(b * NH + h) * DKV * DKV;
#pragma unroll
        for (int blk = 0; blk < 8; ++blk)
#pragma unroll
            for (int r = 0; r < 4; ++r) od[(16 * blk + 4 * fq + r) * DKV + sl * 16 + fr] = S[blk][r];
    }
    asm volatile("s_waitcnt vmcnt(0) lgkmcnt(0)" ::: "memory"); __builtin_amdgcn_s_barrier(); asm volatile("" ::: "memory");
}
__device__ __forceinline__ void delta_sample_seq(const Args& A, Frame& F, int s) {
    const bf16* QC = (const bf16*)(A.ws + WS_RC); const float* BG = (const float*)(A.ws + WS_BG); float* Og = (float*)(A.ws + WS_RE);
    const size_t row = (size_t)MP + s;
    LAS float* qs = (LAS float*)(F.lds + RING_OFF); LAS float* ks = qs + 128; LAS float* red = qs + 256;
    const int dv = F.tid & 127, grp = F.tid >> 7;
    const float* S0b = A.in[I_SDELTA] + (size_t)s * NH * DKV * DKV + (size_t)(grp * 32) * DKV + dv; float* Sob = A.out + OUT_DLS + (size_t)s * NH * DKV * DKV + (size_t)(grp * 32) * DKV + dv;
    float s0[32], s1[32];
#pragma unroll
    for (int i = 0; i < 32; ++i) s0[i] = S0b[(size_t)i * DKV];
#pragma unroll 1
    for (int h = 0; h < NH; ++h) {
        if (h + 1 < NH) {
#pragma unroll
            for (int i = 0; i < 32; ++i) s1[i] = S0b[(size_t)(h + 1) * DKV * DKV + (size_t)i * DKV]; }
        if (F.tid < 128) { qs[F.tid] = bf2f(QC[row * QKVN + h * 128 + F.tid]); ks[F.tid] = bf2f(QC[row * QKVN + 512 + h * 128 + F.tid]); }
        const float v = bf2f(QC[row * QKVN + 1024 + h * 128 + dv]);
        const float beta = BG[row * 8 + h], eg = __expf(BG[row * 8 + 4 + h]);
        __syncthreads();
        float part = 0.f;
#pragma unroll
        for (int i = 0; i < 32; ++i) part += ks[grp * 32 + i] * s0[i];
        red[grp * 128 + dv] = part;
        __syncthreads();
        const float kS = (red[dv] + red[128 + dv]) + (red[256 + dv] + red[384 + dv]);
        const float vnew = beta * (v - eg * kS);
        __syncthreads();
        float po = 0.f;
#pragma unroll
        for (int i = 0; i < 32; ++i) { const float sn = eg * s0[i] + ks[grp * 32 + i] * vnew; Sob[(size_t)h * DKV * DKV + (size_t)i * DKV] = sn; po += qs[grp * 32 + i] * sn; }
        red[grp * 128 + dv] = po;
        __syncthreads();
        if (F.tid < 128) Og[row * 512 + h * 128 + dv] = (red[dv] + red[128 + dv]) + (red[256 + dv] + red[384 + dv]);
        __syncthreads();
#pragma unroll
        for (int i = 0; i < 32; ++i) s0[i] = s1[i];
    }
}

__device__ __forceinline__ void ogate_row(const Args& A, Frame& F, int m, const pg8::f32x4& n0, const pg8::f32x4& n1) {
    const bf16* PB = (const bf16*)(A.ws + WS_RA); bf16* CD = (bf16*)(A.ws + WS_RB); const float* Og = (const float*)(A.ws + WS_RE); const int ch0 = 8 * F.lane;
    const f32x4 o0 = *(const GAS f32x4*)(Og + (size_t)m * 512 + ch0), o1 = *(const GAS f32x4*)(Og + (size_t)m * 512 + ch0 + 4);
    const v4u zz = *(const GAS v4u*)(PB + (size_t)m * PBLD + 2048 + ch0); float z[8]; unpack8(zz, z);
    float ss = (o0[0] * o0[0] + o0[1] * o0[1]) + (o0[2] * o0[2] + o0[3] * o0[3]) + (o1[0] * o1[0] + o1[1] * o1[1]) + (o1[2] * o1[2] + o1[3] * o1[3]);
    ss = row16_sum(ss);
    const float rstd = 1.f / sqrtf(ss * (1.f / 128.f) + RMS_EPS);
    float d[8];
#pragma unroll
    for (int i = 0; i < 4; ++i) { d[i] = o0[i] * rstd * n0[i] * silu(z[i]); d[4 + i] = o1[i] * rstd * n1[i] * silu(z[4 + i]); }
    *(GAS v4u*)(CD + (size_t)m * DM + 512 + ch0) = pack8(d);
}
__device__ __forceinline__ void ogate_phase(const Args& A, Frame& F, int blk, int nblk) {
    const int gw = blk * NWAVES + F.wave, NGW = nblk * NWAVES; const int ch0 = 8 * F.lane;
    const f32x4 n0 = *(const f32x4*)(A.in[I_DNN] + (ch0 & 127)), n1 = *(const f32x4*)(A.in[I_DNN] + (ch0 & 127) + 4);
    for (int m = gw; m < MP; m += NGW) ogate_row(A, F, m, n0, n1);
}
__device__ __forceinline__ void sample_mixer(const Args& A, Frame& F, int s) {
    conv_sample(A, F, s);
    VM_WAIT(); __syncthreads();
    delta_sample_seq(A, F, s);
    VM_WAIT(); __syncthreads();
    if (F.wave == 0) { const int ch0 = 8 * F.lane; const f32x4 n0 = *(const f32x4*)(A.in[I_DNN] + (ch0 & 127)), n1 = *(const f32x4*)(A.in[I_DNN] + (ch0 & 127) + 4); ogate_row(A, F, MP + s, n0, n1); }
}

__device__ __forceinline__ void attn_issue(const Args& A, Frame& F, int st, int b, int h, LAS unsigned char* slot) {
    const bf16* KB = (const bf16*)(A.ws + WS_KB); const bf16* VT = (const bf16*)(A.ws + WS_VT);
#pragma unroll
    for (int it = 0; it < 4; ++it) {
        const int idx = it * 512 + F.tid; const bf16* src;
        if (st < 4) { const int r = idx >> 5, p = idx & 31, c = p ^ (r & 15); src = KB + (size_t)(b * NMEM + 64 * st + r) * DM + h * MHD + 8 * c; }
        else { const int r = idx >> 3, p = idx & 7, c = p ^ ((r >> 1) & 7); src = VT + (size_t)(h * MHD + r) * (NB * NMEM) + b * NMEM + 64 * (st - 4) + 8 * c; }
        __builtin_amdgcn_global_load_lds((const unsigned*)src, (LAS unsigned*)(slot + it * 8192 + F.wave * 1024), 16, 0, 0);
    }
}
__device__ __forceinline__ void attn_unit(const Args& A, Frame& F, int rt, int h) {
    using pg8::f32x4;
    const int b = rt >> 4; const int fr = F.lane & 15, fq = F.lane >> 4;
    const bf16* Q = (const bf16*)(A.ws + WS_RB); bf16* AO = (bf16*)(A.ws + WS_RD);
    const size_t qoff = (size_t)(rt * 128 + F.wave * 16 + fr) * DM + h * MHD;
    const bf16* qrow = Q + qoff; bf16* orow = AO + qoff;
    LAS unsigned char* L = F.lds + RING_OFF;
    bf16x8 qf[8];
#pragma unroll
    for (int ks = 0; ks < 8; ++ks) qf[ks] = *(const GAS bf16x8*)(qrow + 32 * ks + 8 * fq);
    attn_issue(A, F, 0, b, h, L); attn_issue(A, F, 1, b, h, L + 32768);
    f32x4 sacc[16];
#pragma unroll
    for (int st = 0; st < 4; ++st) {
        asm volatile("s_waitcnt vmcnt(4)" ::: "memory");
        __builtin_amdgcn_s_barrier(); asm volatile("" ::: "memory");
        attn_issue(A, F, st + 2, b, h, L + ((st + 2) & 3) * 32768);
        const LAS unsigned char* slot = L + (st & 3) * 32768;
#pragma unroll
        for (int kbl = 0; kbl < 4; ++kbl) { f32x4 acc = (f32x4){0.f, 0.f, 0.f, 0.f}; const int row = 16 * kbl + fr;
#pragma unroll
            for (int ks = 0; ks < 8; ++ks) { const bf16x8 a = *(const LAS bf16x8*)(slot + row * 512 + (((4 * ks + fq) ^ (row & 15)) << 4)); acc = __builtin_amdgcn_mfma_f32_16x16x32_bf16(a, qf[ks], acc, 0, 0, 0); }
            sacc[4 * st + kbl] = acc; }
    }
    float mx = -3.0e38f;
#pragma unroll
    for (int kb = 0; kb < 16; ++kb)
#pragma unroll
        for (int i = 0; i < 4; ++i) mx = fmaxf(mx, sacc[kb][i]);
    mx = fmaxf(mx, __shfl_xor(mx, 16)); mx = fmaxf(mx, __shfl_xor(mx, 32));
    float lsum = 0.f; bf16x8 pb[8];
#pragma unroll
    for (int kb = 0; kb < 16; ++kb)
#pragma unroll
        for (int i = 0; i < 4; ++i) { const float p = __builtin_amdgcn_exp2f(sacc[kb][i] - mx); sacc[kb][i] = p; lsum += p; }
#pragma unroll
    for (int s = 0; s < 8; ++s) pb[s] = pack_pair(sacc[2 * s], sacc[2 * s + 1]);
    lsum += __shfl_xor(lsum, 16); lsum += __shfl_xor(lsum, 32);
    f32x4 oacc[16];
#pragma unroll
    for (int db = 0; db < 16; ++db) oacc[db] = (f32x4){0.f, 0.f, 0.f, 0.f};
#pragma unroll
    for (int st = 4; st < 8; ++st) {
        if (st + 1 < 8) asm volatile("s_waitcnt vmcnt(4)" ::: "memory"); else asm volatile("s_waitcnt vmcnt(0)" ::: "memory");
        __builtin_amdgcn_s_barrier(); asm volatile("" ::: "memory");
        if (st + 2 < 8) attn_issue(A, F, st + 2, b, h, L + ((st + 2) & 3) * 32768);
        const LAS unsigned char* slot = L + (st & 3) * 32768; const int t = st - 4;
#pragma unroll
        for (int db = 0; db < 16; ++db) { const int row = 16 * db + fr; const int sw = (row >> 1) & 7;
#pragma unroll
            for (int s2 = 0; s2 < 2; ++s2) { const int c = 4 * s2 + (fq >> 1);
                const v2u lo = *(const LAS v2u*)(slot + row * 128 + ((c ^ sw) << 4) + 8 * (fq & 1)), hi = *(const LAS v2u*)(slot + row * 128 + (((c + 2) ^ sw) << 4) + 8 * (fq & 1));
                v4u aw; aw.x = lo.x; aw.y = lo.y; aw.z = hi.x; aw.w = hi.y;
                oacc[db] = __builtin_amdgcn_mfma_f32_16x16x32_bf16(__builtin_bit_cast(bf16x8, aw), pb[2 * t + s2], oacc[db], 0, 0, 0); } }
    }
    const float inv = 1.f / lsum;
#pragma unroll
    for (int db = 0; db < 16; ++db) { v2u w; w.x = pk2(oacc[db][0] * inv, oacc[db][1] * inv); w.y = pk2(oacc[db][2] * inv, oacc[db][3] * inv); *(GAS v2u*)(orow + 16 * db + 4 * fq) = w; }
    LDS_WAIT(); __builtin_amdgcn_s_barrier(); asm volatile("" ::: "memory");
}
__device__ __forceinline__ void attn_sample(const Args& A, Frame& F, int s, int h) {
    const bf16* qrow = (const bf16*)(A.ws + WS_RB) + (size_t)(MP + s) * DM + h * MHD; bf16* orow = (bf16*)(A.ws + WS_RD) + (size_t)(MP + s) * DM + h * MHD;
    const int g = F.lane >> 4, dl = F.lane & 15;
    const float* Kc = A.in[I_CMK] + (size_t)s * NMEM * DM + h * MHD + (size_t)(32 * F.wave + g) * DM + 4 * dl;
    const float* Vc = A.in[I_CMV] + (size_t)s * NMEM * DM + h * MHD + (size_t)(32 * F.wave + g) * DM + 4 * dl;
    LAS float* pl = (LAS float*)(F.lds + RING_OFF); LAS float* wred = pl + 256; LAS float* ored = pl + 512;
    f32x4 kv[8][4];
#pragma unroll
    for (int it = 0; it < 8; ++it)
#pragma unroll
        for (int i = 0; i < 4; ++i) kv[it][i] = *(const GAS f32x4*)(Kc + (size_t)(4 * it) * DM + 64 * i);
    f32x4 q[4];
#pragma unroll
    for (int i = 0; i < 4; ++i) { const v2u x = *(const GAS v2u*)(qrow + 64 * i + 4 * dl); q[i] = (f32x4){bflo(x.x), bfhi(x.x), bflo(x.y), bfhi(x.y)}; }
    __builtin_amdgcn_sched_barrier(0);
    float myscore = -3.0e38f;
#pragma unroll
    for (int it = 0; it < 8; ++it) { float d = 0.f;
#pragma unroll
        for (int i = 0; i < 4; ++i) d += (kv[it][i][0] * q[i][0] + kv[it][i][1] * q[i][1]) + (kv[it][i][2] * q[i][2] + kv[it][i][3] * q[i][3]);
        d = row16_sum(d);
        if (dl == it) myscore = d; }
#pragma unroll
    for (int it = 0; it < 8; ++it)
#pragma unroll
        for (int i = 0; i < 4; ++i) kv[it][i] = *(const GAS f32x4*)(Vc + (size_t)(4 * it) * DM + 64 * i);
    const float m = wave_max(myscore);
    if (F.lane == 0) wred[F.wave] = m;
    __syncthreads();
    float gm = wred[0];
#pragma unroll
    for (int i = 1; i < 8; ++i) gm = fmaxf(gm, wred[i]);
    const float p = (dl < 8) ? __builtin_amdgcn_exp2f(myscore - gm) : 0.f;
    if (dl < 8) pl[32 * F.wave + 4 * dl + g] = p;
    const float ws_ = wave_sum(p);
    if (F.lane == 0) wred[8 + F.wave] = ws_;
    __syncthreads();
    float tot = 0.f;
#pragma unroll
    for (int i = 0; i < 8; ++i) tot += wred[8 + i];
    f32x4 acc[4];
#pragma unroll
    for (int i = 0; i < 4; ++i) acc[i] = (f32x4){0.f, 0.f, 0.f, 0.f};
#pragma unroll
    for (int it = 0; it < 8; ++it) { const float pi = pl[32 * F.wave + 4 * it + g];
#pragma unroll
        for (int i = 0; i < 4; ++i) acc[i] = acc[i] + kv[it][i] * pi; }
#pragma unroll
    for (int i = 0; i < 4; ++i)
#pragma unroll
        for (int e = 0; e < 4; ++e) { float v = acc[i][e]; v += __shfl_xor(v, 16); v += __shfl_xor(v, 32); acc[i][e] = v; }
    if (g == 0) {
#pragma unroll
        for (int i = 0; i < 4; ++i) *(LAS f32x4*)(ored + F.wave * 256 + 64 * i + 4 * dl) = acc[i]; }
    __syncthreads();
    if (F.tid < 256) { float o = 0.f;
#pragma unroll
        for (int w = 0; w < 8; ++w) o += ored[w * 256 + F.tid];
        orow[F.tid] = (bf16)(pk2(o / tot, 0.f) & 0xffffu); }
    __syncthreads();
}

typedef unsigned v2u_ __attribute__((ext_vector_type(2)));
template <int NKS, class Epi>
__device__ __forceinline__ void small_gemm_item(const Frame& F, const bf16* Arow0, const bf16* Bt, int pn, int j, int rq, const Epi& E) {
    using pg8::f32x4;
    constexpr int K = NKS * 256;
    const int fr = F.lane & 15, fq = F.lane >> 4;
    const bf16* ap = Arow0 + (size_t)(32 * rq + fr) * K + F.wave * (K / 8) + 8 * fq;
    const bf16* b0 = Bt + (size_t)(256 * pn + 16 * j + fr) * K + F.wave * (K / 8) + 8 * fq; const bf16* b1 = b0 + (size_t)128 * K;
    bf16x8 a0[NKS], a1[NKS], x0[NKS], x1[NKS];
#pragma unroll
    for (int u = 0; u < NKS; ++u) { a0[u] = *(const GAS bf16x8*)(ap + 32 * u); a1[u] = *(const GAS bf16x8*)(ap + (size_t)16 * K + 32 * u); x0[u] = *(const GAS bf16x8*)(b0 + 32 * u); x1[u] = *(const GAS bf16x8*)(b1 + 32 * u); }
    __builtin_amdgcn_sched_barrier(0);
    f32x4 c00 = (f32x4){0.f, 0.f, 0.f, 0.f}, c01 = c00, c10 = c00, c11 = c00;
#pragma unroll
    for (int u = 0; u < NKS; ++u) {
        c00 = __builtin_amdgcn_mfma_f32_16x16x32_bf16(x0[u], a0[u], c00, 0, 0, 0); c01 = __builtin_amdgcn_mfma_f32_16x16x32_bf16(x1[u], a0[u], c01, 0, 0, 0);
        c10 = __builtin_amdgcn_mfma_f32_16x16x32_bf16(x0[u], a1[u], c10, 0, 0, 0); c11 = __builtin_amdgcn_mfma_f32_16x16x32_bf16(x1[u], a1[u], c11, 0, 0, 0);
    }
    LAS f32x4* red = (LAS f32x4*)(F.lds + RING_OFF);
    red[(F.wave * 4 + 0) * 64 + F.lane] = c00; red[(F.wave * 4 + 1) * 64 + F.lane] = c01; red[(F.wave * 4 + 2) * 64 + F.lane] = c10; red[(F.wave * 4 + 3) * 64 + F.lane] = c11;
    __syncthreads();
    if (F.wave < 2) {
        f32x4 sA = (f32x4){0.f, 0.f, 0.f, 0.f}, sB = sA;
#pragma unroll
        for (int w = 0; w < 8; ++w) { sA = sA + red[(w * 4 + 2 * F.wave) * 64 + F.lane]; sB = sB + red[(w * 4 + 2 * F.wave + 1) * 64 + F.lane]; }
        E(32 * rq + 16 * F.wave + fr, pn, j, fq, sA, sB);
    }
    __syncthreads();
}
__device__ __forceinline__ v2u_ pk4(const pg8::f32x4& a) { v2u_ w; w.x = pk2(a[0], a[1]); w.y = pk2(a[2], a[3]); return w; }
struct SEpiIn { bf16* PBs;
    __device__ __forceinline__ void operator()(int m, int pn, int j, int fq, const pg8::f32x4& a, const pg8::f32x4& b) const {
        if (pn < 4) { pg8::f32x4 v;
#pragma unroll
            for (int i = 0; i < 4; ++i) v[i] = a[i] * sigm(b[i]);
            *(GAS v2u_*)(PBs + (size_t)m * PBLD + 128 * pn + 16 * j + 4 * fq) = pk4(v); }
        else { bf16* rp = PBs + (size_t)m * PBLD + 256 * pn - 512 + 16 * j + 4 * fq; *(GAS v2u_*)rp = pk4(a); *(GAS v2u_*)(rp + 128) = pk4(b); }
    } };
template <int MODE> struct SEpiRes { const float* basef; const bf16* baseb; float* outf; bf16* outb; float* ss;
    __device__ __forceinline__ void operator()(int m, int pn, int j, int fq, const pg8::f32x4& a, const pg8::f32x4& b) const {
        const size_t off = (size_t)m * DM + 256 * pn + 16 * j + 4 * fq;
        pg8::f32x4 b0, b1;
        if (MODE == 0) { b0 = *(const GAS pg8::f32x4*)(basef + off); b1 = *(const GAS pg8::f32x4*)(basef + off + 128); }
        else { const v2u_ w0 = *(const GAS v2u_*)(baseb + off), w1 = *(const GAS v2u_*)(baseb + off + 128); b0 = pg8::bf4lo(w0.x, w0.y); b1 = pg8::bf4lo(w1.x, w1.y); }
        const pg8::f32x4 v0 = a + b0, v1 = b + b1;
        if (MODE == 2) { *(GAS pg8::f32x4*)(outf + off) = v0; *(GAS pg8::f32x4*)(outf + off + 128) = v1; }
        else { *(GAS v2u_*)(outb + off) = pk4(v0); *(GAS v2u_*)(outb + off + 128) = pk4(v1); }
        float s = (v0[0] * v0[0] + v0[1] * v0[1]) + (v0[2] * v0[2] + v0[3] * v0[3]) + (v1[0] * v1[0] + v1[1] * v1[1]) + (v1[2] * v1[2] + v1[3] * v1[3]);
        s += __shfl_xor(s, 16); s += __shfl_xor(s, 32);
        if (fq == 0) atomicAdd(ss + m, s);
    } };
struct SEpiQ { bf16* Qs; const float* ss; float c2;
    __device__ __forceinline__ void operator()(int m, int pn, int j, int fq, const pg8::f32x4& a, const pg8::f32x4& b) const {
        const float rs = __builtin_amdgcn_rsqf(ss[m] * (1.f / 1024.f) + RMS_EPS) * c2; bf16* rp = Qs + (size_t)m * DM + 256 * pn + 16 * j + 4 * fq;
        *(GAS v2u_*)rp = pk4(a * rs); *(GAS v2u_*)(rp + 128) = pk4(b * rs);
    } };
struct SEpiGU { bf16* Ts; const float* ss;
    __device__ __forceinline__ void operator()(int m, int pn, int j, int fq, const pg8::f32x4& a, const pg8::f32x4& b) const {
        const float rs = __builtin_amdgcn_rsqf(ss[m] * (1.f / 1024.f) + RMS_EPS); pg8::f32x4 v;
#pragma unroll
        for (int i = 0; i < 4; ++i) v[i] = silu(a[i] * rs) * (b[i] * rs);
        *(GAS v2u_*)(Ts + (size_t)m * DFF + 128 * pn + 16 * j + 4 * fq) = pk4(v);
    } };

__device__ __forceinline__ void final_norm_phase(const Args& A, Frame& F) {
    const int gw = F.vcu * NWAVES + F.wave, NGW = F.G * NWAVES; const float* ss = (const float*)(F.ctl + CW_SS3); const float* X3S = (const float*)(A.ws + WS_X1S);
    f32x4 gn[4];
#pragma unroll
    for (int j = 0; j < 4; ++j) gn[j] = *(const f32x4*)(A.in[I_NF] + 256 * j + 4 * F.lane);
    for (int m = gw; m < DEC; m += NGW) {
        const GAS f32x4* xr = (const GAS f32x4*)(X3S + (size_t)m * DM) + F.lane; GAS f32x4* yr = (GAS f32x4*)(A.out + (size_t)(MP + m) * DM) + F.lane;
        const float rstd = 1.f / sqrtf(ss[MP + m] * (1.f / DM) + RMS_EPS);
#pragma unroll
        for (int j = 0; j < 4; ++j) yr[64 * j] = xr[64 * j] * rstd * gn[j];
    }
}

__global__ void __launch_bounds__(NWAVES * 64, 2) hymba_fwd(Args args) {
    extern __shared__ __attribute__((aligned(16))) unsigned char lds[];
    Frame F;
    F.lds = (LAS unsigned char*)lds;
    F.MISC = (volatile LAS unsigned*)(F.lds + MISC_OFF);
    F.tid = threadIdx.x; F.lane = F.tid & 63; F.wave = __builtin_amdgcn_readfirstlane(F.tid >> 6);
    F.G = gridDim.x; { const int bx = blockIdx.x; F.vcu = (F.G % 8 == 0) ? (bx % 8) * (F.G / 8) + bx / 8 : bx; }
    F.ctl = (gu32*)(args.ws + WS_CTL);
    const Args& A = args;
    for (int u = F.tid; u < (LDS_BYTES - LDSCTL_OFF) / 4; u += NWAVES * 64) ((LAS unsigned*)(F.lds + LDSCTL_OFF))[u] = 0u;
    __syncthreads();
#if MK_PER_PHASE
#define GRID_BAR() do { } while (0)
#else
    XcdBarrier bar = xcd_barrier_post((unsigned*)(F.ctl + CW_BAR) + args.li * XCD_BAR_WORDS, F.MISC + 8);
#define GRID_BAR() xcd_barrier(bar)
#endif
#if 1
    const int lo = args.ph_lo, hi = args.ph_hi;
    const bool rep = (args.li != 0);
#define REPK(k) (rep && lo == (k))
#ifdef ONLY_PH
#define IN(k) ((k) == ONLY_PH && lo <= (k) && (k) < hi)
#else
#define IN(k) (lo <= (k) && (k) < hi)
#endif
#else
#define REPK(k) false
#define IN(k) true
#endif
#define BOTH(k) (IN(k) && IN((k) + 1))
#define PH_PTRS unsigned char* const ws = args.ws; bf16* const RA = (bf16*)(ws + WS_RA); bf16* const RB = (bf16*)(ws + WS_RB); bf16* const RC = (bf16*)(ws + WS_RC); \
    bf16* const AO = (bf16*)(ws + WS_RD); bf16* const X1B = (bf16*)(ws + WS_RE); \
    float* const SS1 = (float*)(ws + WS_CTL) + CW_SS1; float* const SS2 = (float*)(ws + WS_CTL) + CW_SS2; float* const SS3 = (float*)(ws + WS_CTL) + CW_SS3; float* const SSD = (float*)(ws + WS_CTL) + 163840; \
    (void)RA; (void)RB; (void)RC; (void)AO; (void)X1B; (void)SS1; (void)SS2; (void)SS3; (void)SSD;

    if (IN(0)) { p0_prologue(A, F); if (BOTH(0)) GRID_BAR(); }
    if (IN(1)) { PH_PTRS
        { pg8::Gemm g{RB, (const bf16*)(ws + WS_WIN), MP, 3072, DM}; pg8::StaticOrder S; S.init(MP, 3072, F.G, (int)blockIdx.x);
          pg8::EpiIn E{RA};
          pg8::gemm_phase<pg8::EpiIn, pg8::StaticOrder, true, true>(F.lds + RING_OFF, g, S, E); }
        { const SEpiIn E{RA + (size_t)MP * PBLD};
          for (int i = F.G - 1 - (int)blockIdx.x; i < 96 * 4; i += F.G) small_gemm_item<4>(F, RB + (size_t)MP * DM, (const bf16*)(ws + WS_WIN), i >> 5, (i >> 2) & 7, i & 3, E); }
        if (BOTH(1)) GRID_BAR();
    }
    if (IN(2)) {
        for (int it = F.vcu; it < 256; it += F.G) { const int b = it >> 5, tile = it & 31;
#ifdef PROBE_PH
            if (!(args.pad & 1))
#endif
            conv_tile(A, F, b, tile);
            VM_WAIT(); __syncthreads();
#ifdef PROBE_PH
            if (!(args.pad & 2))
#endif
            _Pragma("unroll 1") for (int h = 0; h < NH; ++h) d1_chunk(A, F, (b * NH + h) * 32 + tile); }
#ifdef PROBE_PH
        if (!(args.pad & 4))
#endif
        for (int s = F.G - 1 - F.vcu; s < DEC; s += F.G) sample_mixer(A, F, s);
        if (BOTH(2)) GRID_BAR();
    }
    if (IN(3)) { PH_PTRS
        if ((int)blockIdx.x < 128) {
            const int u = ((int)blockIdx.x & 7) * 16 + ((int)blockIdx.x >> 3);
            scan_unit(A, F, u >> 4, (u >> 2) & 3, 2 * (u & 3));
        } else if ((int)blockIdx.x < 192) {
            pg8::Gemm g{(const bf16*)(ws + WS_MEMN), (const bf16*)(ws + WS_WMKV), NB * NMEM, 2048, DM}; pg8::StaticOrder S; S.init(NB * NMEM, 2048, 64, (int)blockIdx.x - 128);
            pg8::EpiKV E{A.out + OUT_MKP, A.out + OUT_MVP, (bf16*)(ws + WS_KB), (bf16*)(ws + WS_VT)};
            pg8::gemm_phase<pg8::EpiKV, pg8::StaticOrder, true, true>(F.lds + RING_OFF, g, S, E);
        }
        { const SEpiRes<0> SE{A.in[I_XS], nullptr, nullptr, X1B + (size_t)MP * DM, (REPK(3) ? SSD : SS1) + MP};
          for (int i = F.G - 1 - (int)blockIdx.x; i < 32 * 4; i += F.G) small_gemm_item<4>(F, RB + (size_t)MP * DM, (const bf16*)(ws + WS_WOUT), i >> 5, (i >> 2) & 7, i & 3, SE); }
        if (BOTH(3)) GRID_BAR();
    }
    if (IN(4)) { PH_PTRS
        ogate_phase(A, F, F.vcu, F.G);
        { const SEpiQ SE{RB + (size_t)MP * DM, SS1 + MP, ATT_C2};
          for (int i = F.G - 1 - (int)blockIdx.x; i < 32 * 4; i += F.G) small_gemm_item<4>(F, X1B + (size_t)MP * DM, (const bf16*)(ws + WS_WMQ), i >> 5, (i >> 2) & 7, i & 3, SE); }
        if (BOTH(4)) GRID_BAR();
    }
    if (IN(5)) { PH_PTRS
        const bool stream_first = (((int)blockIdx.x >> 3) & 1) != 0;
        if (stream_first) { _Pragma("unroll 1") for (int it = F.vcu; it < DEC * NH; it += F.G) attn_sample(A, F, it >> 2, it & 3); }
        { pg8::Gemm g{RB, (const bf16*)(ws + WS_WOUT), MP, DM, DM}; pg8::StaticOrder S; S.init(MP, DM, F.G, (int)blockIdx.x);
          pg8::EpiRes<true> E{A.in[I_XP], nullptr, X1B, REPK(5) ? SSD : SS1};
          pg8::gemm_phase<pg8::EpiRes<true>, pg8::StaticOrder, true, true>(F.lds + RING_OFF, g, S, E); }
        if (!stream_first) { _Pragma("unroll 1") for (int it = F.vcu; it < DEC * NH; it += F.G) attn_sample(A, F, it >> 2, it & 3); }
        if (BOTH(5)) GRID_BAR();
    }
    if (IN(6)) { PH_PTRS
        pg8::Gemm g{X1B, (const bf16*)(ws + WS_WMQ), MP, DM, DM}; pg8::StaticOrder S; S.init(MP, DM, F.G, (int)blockIdx.x);
        pg8::EpiQ E{RB, SS1, ATT_C2};
        pg8::gemm_phase<pg8::EpiQ, pg8::StaticOrder, true, true>(F.lds + RING_OFF, g, S, E);
        { pg8::Unit u; _Pragma("unroll 1") for (int i = 0; i < 2 * 64; ++i) { if (!S.next(i >> 1, u)) break; attn_unit(A, F, 2 * u.pm + (i & 1), u.pn); } }
        { const SEpiRes<1> SE{nullptr, X1B + (size_t)MP * DM, nullptr, RC + (size_t)MP * DM, (REPK(6) ? SSD : SS2) + MP};
          for (int i = F.G - 1 - (int)blockIdx.x; i < 32 * 4; i += F.G) small_gemm_item<4>(F, AO + (size_t)MP * DM, (const bf16*)(ws + WS_WMO), i >> 5, (i >> 2) & 7, i & 3, SE); }
        if (BOTH(6)) GRID_BAR();
    }
    if (IN(7)) { PH_PTRS
        pg8::Gemm g{AO, (const bf16*)(ws + WS_WMO), MP, DM, DM}; pg8::StaticOrder S; S.init(MP, DM, F.G, (int)blockIdx.x);
        pg8::EpiRes<false> E{nullptr, X1B, RC, REPK(7) ? SSD : SS2};
        pg8::gemm_phase<pg8::EpiRes<false>, pg8::StaticOrder, true, true>(F.lds + RING_OFF, g, S, E);
        { const SEpiGU SE{RA + (size_t)MP * DFF, SS2 + MP};
          for (int i = F.G - 1 - (int)blockIdx.x; i < 176 * 4; i += F.G) small_gemm_item<4>(F, RC + (size_t)MP * DM, (const bf16*)(ws + WS_WGU), i >> 5, (i >> 2) & 7, i & 3, SE); }
        if (BOTH(7)) GRID_BAR();
    }
    if (IN(8)) { PH_PTRS
        pg8::Gemm g{RC, (const bf16*)(ws + WS_WGU), MP, 2 * DFF, DM}; pg8::StaticOrder S; S.init(MP, 2 * DFF, F.G, (int)blockIdx.x);
        pg8::EpiGU E{RA, SS2};
        pg8::gemm_phase<pg8::EpiGU, pg8::StaticOrder, true, true>(F.lds + RING_OFF, g, S, E);
        { const SEpiRes<2> SE{nullptr, RC + (size_t)MP * DM, (float*)(ws + WS_X1S), nullptr, (REPK(8) ? SSD : SS3) + MP};
          for (int i = F.G - 1 - (int)blockIdx.x; i < 32 * 4; i += F.G) small_gemm_item<11>(F, RA + (size_t)MP * DFF, (const bf16*)(ws + WS_WDN), i >> 5, (i >> 2) & 7, i & 3, SE); }
        if (BOTH(8)) GRID_BAR();
    }
    if (IN(9)) { PH_PTRS
        final_norm_phase(A, F);
        pg8::Gemm g{RA, (const bf16*)(ws + WS_WDN), MP, DM, DFF}; pg8::StaticOrder S; S.init(MP, DM, F.G, (int)blockIdx.x);
        pg8::EpiResNorm E{RC, A.out, A.in[I_NF], (float*)(ws + WS_XBUF), (unsigned*)(ws + WS_CTL) + CW_PANEL, (unsigned*)(ws + WS_CTL) + CW_TMO};
        pg8::gemm_phase<pg8::EpiResNorm, pg8::StaticOrder, false, true>(F.lds + RING_OFF, g, S, E);
    }
#undef IN
#undef BOTH
}

extern "C" void kernel_launch(void* const* d_in, const int* in_sizes, int n_in, void* d_out, int out_size, void* d_ws, size_t ws_size, hipStream_t stream) {
    static int grid = 0;
    if (grid == 0) {
        if (n_in != 30 || in_sizes[0] != MP * DM || (size_t)out_size != OUT_END || ws_size < WS_END) {
            fprintf(stderr, "kernel_launch: unexpected shapes: n_in %d, in0 %d, out %d, ws %zu (need >= %zu); nothing launched\n", n_in, n_in > 0 ? in_sizes[0] : -1, out_size, ws_size, (size_t)WS_END); grid = -1; return; }
        int dev = 0, cus = 0, per_cu = 0;
        if (hipGetDevice(&dev) != hipSuccess || hipDeviceGetAttribute(&cus, hipDeviceAttributeMultiprocessorCount, dev) != hipSuccess) { fprintf(stderr, "kernel_launch: device query failed\n"); grid = -1; return; }
        if (hipFuncSetAttribute((const void*)hymba_fwd, hipFuncAttributeMaxDynamicSharedMemorySize, LDS_BYTES) != hipSuccess) { fprintf(stderr, "kernel_launch: hipFuncSetAttribute failed\n"); grid = -1; return; }
        if (hipOccupancyMaxActiveBlocksPerMultiprocessor(&per_cu, (const void*)hymba_fwd, NWAVES * 64, LDS_BYTES) != hipSuccess || per_cu < 1)
            fprintf(stderr, "kernel_launch: note: occupancy query reports %d workgroups per CU\n", per_cu);
        (void)hipGetLastError();
        grid = cus;
        if (grid != 256) { fprintf(stderr, "kernel_launch: built for 256 CUs (one 256x256 unit per workgroup in the fused final-norm phase); found %d; nothing launched\n", grid); grid = -1; return; }
    }
    if (grid < 0) return;
    if (hipMemsetAsync((char*)d_ws + WS_CTL, 0, CTL_ZERO_BYTES, stream) != hipSuccess) { fprintf(stderr, "kernel_launch: hipMemsetAsync failed\n"); return; }
    Args a{};
    for (int i = 0; i < 30; ++i) a.in[i] = (const float*)d_in[i];
    a.out = (float*)d_out; a.ws = (unsigned char*)d_ws;
#if MK_PER_PHASE
    for (int ph = 0; ph < N_PHASES; ++ph) { a.ph_lo = ph; a.ph_hi = ph + 1; a.li = 0;
        hipLaunchKernelGGL(hymba_fwd, dim3(grid), dim3(NWAVES * 64), LDS_BYTES, stream, a); }
#else
#ifdef PROBE_PH
    a.ph_lo = 0; a.ph_hi = PROBE_PH + 1; a.li = 0;
    hipLaunchKernelGGL(hymba_fwd, dim3(grid), dim3(NWAVES * 64), LDS_BYTES, stream, a);
#ifdef PROBE_REPS
    for (int r_ = 0; r_ < PROBE_REPS; ++r_) { a.ph_lo = PROBE_PH; a.ph_hi = PROBE_PH + 1; a.li = 2 + r_; a.pad = PROBE_MODE; hipLaunchKernelGGL(hymba_fwd, dim3(grid), dim3(NWAVES * 64), LDS_BYTES, stream, a); }
#endif
    a.ph_lo = PROBE_PH; a.ph_hi = N_PHASES; a.li = 1; a.pad = 0;
    hipLaunchKernelGGL(hymba_fwd, dim3(grid), dim3(NWAVES * 64), LDS_BYTES, stream, a);
#else
    a.ph_lo = 0; a.ph_hi = N_PHASES; a.li = 0;
    hipLaunchKernelGGL(hymba_fwd, dim3(grid), dim3(NWAVES * 64), LDS_BYTES, stream, a);
#endif
#endif
    const hipError_t le = hipPeekAtLastError();
    if (le != hipSuccess) fprintf(stderr, "kernel_launch: launch failed: %s\n", hipGetErrorName(le));
}
```

```cpp
#include <hip/hip_runtime.h>
#include <cstdio>
#include <cstdint>
#define MK_PER_PHASE 0
namespace pg8 {
#define PG8_LAS __attribute__((address_space(3)))
typedef unsigned short bf16_t;
typedef short bf16x8 __attribute__((ext_vector_type(8)));
typedef float f32x4 __attribute__((ext_vector_type(4)));
typedef unsigned u32x4 __attribute__((ext_vector_type(4)));
constexpr int BM = 256, BK = 64, HALF = 128, HTB = HALF * BK * 2  , STAGE_BYTES = 8 * HTB, NXCD = 8, WGM = 8;

__host__ __device__ __forceinline__ int lds_byte(int r, int c) { const int st = (r >> 4) * 2 + (c >> 5), rr = r & 15, cc = c & 31, ob = rr * 64 + cc * 2; return st * 1024 + (ob ^ (((ob >> 9) & 1) << 5)); }
__host__ __device__ __forceinline__ void stage_rc(int b, int& R, int& C) { const int st = b / 1024, sb = b % 1024, swz = sb ^ (((sb >> 9) & 1) << 5); R = (st >> 1) * 16 + swz / 64; C = (st & 1) * 32 + (swz % 64) / 2; }
__host__ __device__ __forceinline__ int perm32(int rho) { const int n = rho >> 4, i = rho & 15; return 8 * (i >> 2) + 4 * n + (i & 3); }

struct Unit { int pm, pn; };
struct Gemm { const bf16_t* A; const bf16_t* Bt; int M, N, K; };

struct StaticOrder {
    int nM, nN, nwg, G, c;
    __host__ __device__ __forceinline__ void init(int M, int N, int G_, int c_) { nM = M / BM; nN = N / BM; nwg = nM * nN; G = G_; c = c_; }
    __host__ __device__ __forceinline__ bool next(int i, Unit& u) const {
        const long L = (long)i * G + c; if (L >= nwg) return false;
        int wgid = (int)L; { const int q = nwg / NXCD, r = nwg % NXCD, xcd = wgid % NXCD, off = wgid / NXCD; wgid = (xcd < r ? xcd * (q + 1) : r * (q + 1) + (xcd - r) * q) + off; }
        const int nig = WGM * nN, gid = wgid / nig, fm = gid * WGM, gsz = (nM - fm) < WGM ? (nM - fm) : WGM;
        u.pm = fm + ((wgid % nig) % gsz); u.pn = (wgid % nig) / gsz; return true;
    }
    __device__ __forceinline__ void a_ready(const Unit&) const {}
    __device__ __forceinline__ void done(const Unit&) const {}
};

__device__ __forceinline__ unsigned cvt_pk_bf16(float lo, float hi) { unsigned r; asm volatile("v_cvt_pk_bf16_f32 %0, %1, %2" : "=v"(r) : "v"(lo), "v"(hi)); return r; }
typedef float f32x2_t __attribute__((ext_vector_type(2))); typedef __bf16 bf16x2_t __attribute__((ext_vector_type(2)));
__device__ __forceinline__ unsigned pk2(float lo, float hi) { f32x2_t v = {lo, hi}; bf16x2_t b = __builtin_convertvector(v, bf16x2_t); return __builtin_bit_cast(unsigned, b); }
__device__ __forceinline__ float sigm(float x) { return __builtin_amdgcn_rcpf(1.f + __expf(-x)); }
__device__ __forceinline__ float silu(float x) { return x * __builtin_amdgcn_rcpf(1.f + __expf(-x)); }
__device__ __forceinline__ u32x4 pk8(const f32x4& a, const f32x4& b) { u32x4 w; w.x = pk2(a[0], a[1]); w.y = pk2(a[2], a[3]); w.z = pk2(b[0], b[1]); w.w = pk2(b[2], b[3]); return w; }
constexpr int PBLD = 2560;
constexpr int MPROMPT = 16384;
constexpr float RMS_EPS = 1e-6f;

struct EpiIn {
    static constexpr bool PERM = true, AFTER_DRAIN = false;
    bf16_t* PB;
    __device__ __forceinline__ void operator()(const f32x4 (&acc)[2][2][4][2], const Unit& u, int wr, int wc, int fr, int fq) const {
        const int row0 = u.pm * BM + wr * 64 + fr;
        if (u.pn < 4) {
            const int ch0 = u.pn * 128 + wc * 32 + 8 * fq;
#pragma unroll
            for (int ai = 0; ai < 2; ++ai)
#pragma unroll
                for (int m = 0; m < 4; ++m) {
                    bf16_t* rowp = PB + (size_t)(row0 + ai * HALF + m * 16) * PBLD + ch0;
                    f32x4 v0, v1;
#pragma unroll
                    for (int i = 0; i < 4; ++i) { v0[i] = acc[ai][0][m][0][i] * sigm(acc[ai][1][m][0][i]); v1[i] = acc[ai][0][m][1][i] * sigm(acc[ai][1][m][1][i]); }
                    *(u32x4*)rowp = pk8(v0, v1);
                }
        } else {
            const int col0 = u.pn * BM - 512 + wc * 32 + 8 * fq;
#pragma unroll
            for (int ai = 0; ai < 2; ++ai)
#pragma unroll
                for (int m = 0; m < 4; ++m) {
                    bf16_t* rowp = PB + (size_t)(row0 + ai * HALF + m * 16) * PBLD + col0;
#pragma unroll
                    for (int bj = 0; bj < 2; ++bj) *(u32x4*)(rowp + bj * HALF) = pk8(acc[ai][bj][m][0], acc[ai][bj][m][1]);
                }
        }
    }
};

struct EpiKV {
    static constexpr bool PERM = true, AFTER_DRAIN = false;
    float* outK; float* outV; bf16_t* KB; bf16_t* VT;
    __device__ __forceinline__ void operator()(const f32x4 (&acc)[2][2][4][2], const Unit& u, int wr, int wc, int fr, int fq) const {
        const int row0 = u.pm * BM + wr * 64 + fr;
        const bool isv = u.pn >= 4;
        const int c0 = (isv ? u.pn - 4 : u.pn) * BM + wc * 32 + 8 * fq;
        float* outp = isv ? outV : outK;
#pragma unroll
        for (int ai = 0; ai < 2; ++ai)
#pragma unroll
            for (int m = 0; m < 4; ++m) {
                const int row = row0 + ai * HALF + m * 16;
#pragma unroll
                for (int bj = 0; bj < 2; ++bj) {
                    const int col = c0 + bj * HALF;
                    const f32x4 a = acc[ai][bj][m][0], b = acc[ai][bj][m][1];
                    *(f32x4*)(outp + (size_t)row * 1024 + col) = a; *(f32x4*)(outp + (size_t)row * 1024 + col + 4) = b;
                    const u32x4 w = pk8(a, b);
                    if (!isv) *(u32x4*)(KB + (size_t)row * 1024 + col) = w;
                    else {
                        bf16_t* vp = VT + (size_t)col * 2048 + row;
                        vp[0 * 2048] = (bf16_t)(w.x & 0xffffu); vp[1 * 2048] = (bf16_t)(w.x >> 16); vp[2 * 2048] = (bf16_t)(w.y & 0xffffu); vp[3 * 2048] = (bf16_t)(w.y >> 16);
                        vp[4 * 2048] = (bf16_t)(w.z & 0xffffu); vp[5 * 2048] = (bf16_t)(w.z >> 16); vp[6 * 2048] = (bf16_t)(w.w & 0xffffu); vp[7 * 2048] = (bf16_t)(w.w >> 16);
                    }
                }
            }
    }
};

__device__ __forceinline__ f32x4 bf4lo(unsigned a, unsigned b) { return (f32x4){__uint_as_float(a << 16), __uint_as_float(a & 0xffff0000u), __uint_as_float(b << 16), __uint_as_float(b & 0xffff0000u)}; }
template <bool BASE_F32> struct EpiRes {
    static constexpr bool PERM = true, AFTER_DRAIN = false;
    const float* basef; const bf16_t* baseb; bf16_t* outb; float* ss;
    __device__ __forceinline__ void operator()(const f32x4 (&acc)[2][2][4][2], const Unit& u, int wr, int wc, int fr, int fq) const {
        const int row0 = u.pm * BM + wr * 64 + fr; const int col0 = u.pn * BM + wc * 32 + 8 * fq;
#pragma unroll
        for (int ai = 0; ai < 2; ++ai) {
            f32x4 pre[4][2][2];
#pragma unroll
            for (int m = 0; m < 4; ++m)
#pragma unroll
                for (int bj = 0; bj < 2; ++bj) { const size_t off = (size_t)(row0 + ai * HALF + m * 16) * 1024 + col0 + bj * HALF;
                    if (BASE_F32) { pre[m][bj][0] = *(const f32x4*)(basef + off); pre[m][bj][1] = *(const f32x4*)(basef + off + 4); }
                    else { const u32x4 w = *(const u32x4*)(baseb + off); pre[m][bj][0] = bf4lo(w.x, w.y); pre[m][bj][1] = bf4lo(w.z, w.w); } }
            __builtin_amdgcn_sched_barrier(0);
#pragma unroll
            for (int m = 0; m < 4; ++m) {
                const int row = row0 + ai * HALF + m * 16; const size_t off = (size_t)row * 1024 + col0;
                float s = 0.f;
#pragma unroll
                for (int bj = 0; bj < 2; ++bj) {
                    const f32x4 v0 = acc[ai][bj][m][0] + pre[m][bj][0], v1 = acc[ai][bj][m][1] + pre[m][bj][1];
                    s += (v0[0] * v0[0] + v0[1] * v0[1]) + (v0[2] * v0[2] + v0[3] * v0[3]) + (v1[0] * v1[0] + v1[1] * v1[1]) + (v1[2] * v1[2] + v1[3] * v1[3]);
                    *(u32x4*)(outb + off + bj * HALF) = pk8(v0, v1);
                }
                s += __shfl_xor(s, 16); s += __shfl_xor(s, 32);
                if (fq == 0) atomicAdd(ss + row, s);
            }
        }
    }
};

struct EpiQ {
    static constexpr bool PERM = true, AFTER_DRAIN = false;
    bf16_t* Q; const float* ss; float c2;
    __device__ __forceinline__ void operator()(const f32x4 (&acc)[2][2][4][2], const Unit& u, int wr, int wc, int fr, int fq) const {
        const int row0 = u.pm * BM + wr * 64 + fr; const int col0 = u.pn * BM + wc * 32 + 8 * fq;
#pragma unroll
        for (int ai = 0; ai < 2; ++ai)
#pragma unroll
            for (int m = 0; m < 4; ++m) {
                const int row = row0 + ai * HALF + m * 16;
                const float rs = __builtin_amdgcn_rsqf(ss[row] * (1.f / 1024.f) + RMS_EPS) * c2;
#pragma unroll
                for (int bj = 0; bj < 2; ++bj) *(u32x4*)(Q + (size_t)row * 1024 + col0 + bj * HALF) = pk8(acc[ai][bj][m][0] * rs, acc[ai][bj][m][1] * rs);
            }
    }
};

struct EpiGU {
    static constexpr bool PERM = true, AFTER_DRAIN = false;
    bf16_t* T; const float* ss;
    __device__ __forceinline__ void operator()(const f32x4 (&acc)[2][2][4][2], const Unit& u, int wr, int wc, int fr, int fq) const {
        const int row0 = u.pm * BM + wr * 64 + fr; const int ch0 = u.pn * 128 + wc * 32 + 8 * fq;
#pragma unroll
        for (int ai = 0; ai < 2; ++ai)
#pragma unroll
            for (int m = 0; m < 4; ++m) {
                const int row = row0 + ai * HALF + m * 16;
                const float rs = __builtin_amdgcn_rsqf(ss[row] * (1.f / 1024.f) + RMS_EPS);
                f32x4 v0, v1;
#pragma unroll
                for (int i = 0; i < 4; ++i) { v0[i] = silu(acc[ai][0][m][0][i] * rs) * (acc[ai][1][m][0][i] * rs); v1[i] = silu(acc[ai][0][m][1][i] * rs) * (acc[ai][1][m][1][i] * rs); }
                *(u32x4*)(T + (size_t)row * 2816 + ch0) = pk8(v0, v1);
            }
    }
};


struct EpiResNorm {
    static constexpr bool PERM = true, AFTER_DRAIN = true;
    const bf16_t* base; float* out; const float* gain; float* xbuf; unsigned* cnt; unsigned* tmo;
    __device__ __forceinline__ void fused(f32x4 (&acc)[2][2][4][2], const Unit& u, int wr, int wc, int fr, int fq, PG8_LAS unsigned char* lds, int wid, int lane) const {
        PG8_LAS float* P = (PG8_LAS float*)lds;
        PG8_LAS float* S = (PG8_LAS float*)(lds + 4096);
        PG8_LAS unsigned* flag = (PG8_LAS unsigned*)(lds + 4096 + 1024);
        const int row0 = u.pm * BM + wr * 64 + fr; const int col0 = u.pn * BM + wc * 32 + 8 * fq;
#pragma unroll
        for (int ai = 0; ai < 2; ++ai) {
            f32x4 pre[4][2][2];
#pragma unroll
            for (int m = 0; m < 4; ++m)
#pragma unroll
                for (int bj = 0; bj < 2; ++bj) { const size_t off = (size_t)(row0 + ai * HALF + m * 16) * 1024 + col0 + bj * HALF; const u32x4 w = *(const u32x4*)(base + off); pre[m][bj][0] = bf4lo(w.x, w.y); pre[m][bj][1] = bf4lo(w.z, w.w); }
            __builtin_amdgcn_sched_barrier(0);
#pragma unroll
            for (int m = 0; m < 4; ++m) {
                float s = 0.f;
#pragma unroll
                for (int bj = 0; bj < 2; ++bj) {
                    const f32x4 v0 = acc[ai][bj][m][0] + pre[m][bj][0], v1 = acc[ai][bj][m][1] + pre[m][bj][1];
                    acc[ai][bj][m][0] = v0; acc[ai][bj][m][1] = v1;
                    s += (v0[0] * v0[0] + v0[1] * v0[1]) + (v0[2] * v0[2] + v0[3] * v0[3]) + (v1[0] * v1[0] + v1[1] * v1[1]) + (v1[2] * v1[2] + v1[3] * v1[3]);
                }
                s += __shfl_xor(s, 16); s += __shfl_xor(s, 32);
                if (fq == 0) P[(ai * HALF + wr * 64 + m * 16 + fr) * 4 + wc] = s;
            }
        }
        asm volatile("s_waitcnt lgkmcnt(0)" ::: "memory"); __builtin_amdgcn_s_barrier(); asm volatile("" ::: "memory");
        const int row = wid * 64 + lane;
        if (wid < 4) {
            const float t = (P[row * 4 + 0] + P[row * 4 + 1]) + (P[row * 4 + 2] + P[row * 4 + 3]);
            __hip_atomic_store(xbuf + (size_t)(u.pm * BM + row) * 4 + u.pn, t, __ATOMIC_RELAXED, __HIP_MEMORY_SCOPE_AGENT);
            asm volatile("s_waitcnt vmcnt(0)" ::: "memory");
            if (lane == 0) __hip_atomic_fetch_add(cnt + 64 * u.pm, 1u, __ATOMIC_RELAXED, __HIP_MEMORY_SCOPE_AGENT);
        }
        if (wid == 0) {
            unsigned spins = 0; bool dead = false;
            while ((unsigned)__builtin_amdgcn_readfirstlane(__hip_atomic_load(cnt + 64 * u.pm, __ATOMIC_RELAXED, __HIP_MEMORY_SCOPE_AGENT)) < 16u) {
                __builtin_amdgcn_s_sleep(2);
                if (++spins > (1u << 22)) { dead = true; if (lane == 0) __hip_atomic_store(tmo, 1u, __ATOMIC_RELAXED, __HIP_MEMORY_SCOPE_AGENT); break; }
            }
            __builtin_amdgcn_fence(__ATOMIC_ACQUIRE, "agent");
            if (lane == 0) flag[0] = dead ? 1u : 0u;
        }
        asm volatile("s_waitcnt vmcnt(0) lgkmcnt(0)" ::: "memory"); __builtin_amdgcn_s_barrier(); asm volatile("" ::: "memory");
        if (wid < 4) {
            const float* sl = xbuf + (size_t)(u.pm * BM + row) * 4; float t = 0.f;
#pragma unroll
            for (int q = 0; q < 4; ++q) t += __hip_atomic_load(sl + q, __ATOMIC_RELAXED, __HIP_MEMORY_SCOPE_AGENT);
            S[row] = __builtin_amdgcn_rsqf(t * (1.f / 1024.f) + RMS_EPS);
        }
        asm volatile("s_waitcnt vmcnt(0) lgkmcnt(0)" ::: "memory"); __builtin_amdgcn_s_barrier(); asm volatile("" ::: "memory");
        f32x4 gv[2][2];
#pragma unroll
        for (int bj = 0; bj < 2; ++bj) { gv[bj][0] = *(const f32x4*)(gain + col0 + bj * HALF); gv[bj][1] = *(const f32x4*)(gain + col0 + bj * HALF + 4); }
#pragma unroll
        for (int ai = 0; ai < 2; ++ai)
#pragma unroll
            for (int m = 0; m < 4; ++m) {
                const int rl = ai * HALF + wr * 64 + m * 16 + fr; const float rs = S[rl]; const size_t off = (size_t)(u.pm * BM + rl) * 1024 + col0;
#pragma unroll
                for (int bj = 0; bj < 2; ++bj) { *(f32x4*)(out + off + bj * HALF) = acc[ai][bj][m][0] * rs * gv[bj][0]; *(f32x4*)(out + off + bj * HALF + 4) = acc[ai][bj][m][1] * rs * gv[bj][1]; }
            }
    }
};

template <class Epi, class Sched, bool ALIGN_EPI = false, bool SP2 = false>
__device__ __forceinline__ void gemm_phase(PG8_LAS unsigned char* lds, const Gemm g, const Sched& S, const Epi& E) {
    const int tid = threadIdx.x, wid = __builtin_amdgcn_readfirstlane(tid >> 6), lane = tid & 63, wr = wid >> 2, wc = wid & 3, fr = lane & 15, fq = lane >> 4;
    const int K = g.K, nt = K / BK;
    unsigned voffA[2], voffB[2];
#pragma unroll
    for (int i = 0; i < 2; ++i) { int R, C; stage_rc(tid * 16 + i * 8192, R, C); const int Rb = Epi::PERM ? ((R & ~31) + perm32(R & 31)) : R;
        voffA[i] = (unsigned)(R * K + C) * 2u; voffB[i] = (unsigned)(Rb * K + C) * 2u; }
    const size_t kstep = (size_t)(BK * 2);
    const size_t hstep = (size_t)HALF * K * 2;
    const size_t tstep = 2 * hstep;
    const unsigned ldsw = (unsigned)wid * 1024u;
    const int aoff = lds_byte(wr * 64 + fr, fq * 8), boff = lds_byte(wc * 32 + fr, fq * 8);
#define PG8_SA(b, h) (((b) * 2 + (h)) * HTB)
#define PG8_SB(b, h) ((4 + (b) * 2 + (h)) * HTB)
#define PG8_STAGE(bufoff, gbase, voff) do { _Pragma("unroll") for (int _i = 0; _i < 2; ++_i) \
        __builtin_amdgcn_global_load_lds((const unsigned*)((const char*)(gbase) + (voff)[_i]), (PG8_LAS unsigned*)(lds + (bufoff) + ldsw + _i * 8192), 16, 0, 0); } while (0)
#define PG8_LDA(dst, b, h) do { _Pragma("unroll") for (int m = 0; m < 4; ++m) _Pragma("unroll") for (int k = 0; k < 2; ++k) dst[m][k] = *(const PG8_LAS bf16x8*)(lds + PG8_SA(b, h) + aoff + m * 2048 + k * 1024); } while (0)
#define PG8_LDB(dst, b, h) do { _Pragma("unroll") for (int n = 0; n < 2; ++n) _Pragma("unroll") for (int k = 0; k < 2; ++k) dst[n][k] = *(const PG8_LAS bf16x8*)(lds + PG8_SB(b, h) + boff + n * 2048 + k * 1024); } while (0)
#define PG8_MMA(ai, bj, At, Bt) do { __builtin_amdgcn_s_setprio(1); _Pragma("unroll") for (int m = 0; m < 4; ++m) _Pragma("unroll") for (int n = 0; n < 2; ++n) _Pragma("unroll") for (int k = 0; k < 2; ++k) \
        acc[ai][bj][m][n] = __builtin_amdgcn_mfma_f32_16x16x32_bf16(Bt[n][k], At[m][k], acc[ai][bj][m][n], 0, 0, 0); __builtin_amdgcn_s_setprio(0); } while (0)
#define PG8_WAIT_V(n) asm volatile("s_waitcnt vmcnt(" #n ")" ::: "memory")
#define PG8_WAIT_L(n) asm volatile("s_waitcnt lgkmcnt(" #n ")" ::: "memory")
#define PG8_BAR __builtin_amdgcn_s_barrier()
#define PG8_SCHED __builtin_amdgcn_sched_barrier(0)
    Unit cur, nxt; int ui = 0;
    if (!S.next(0, cur)) return;
    f32x4 acc[2][2][4][2];
#pragma unroll
    for (int a = 0; a < 2; ++a)
#pragma unroll
        for (int b = 0; b < 2; ++b)
#pragma unroll
            for (int m = 0; m < 4; ++m)
#pragma unroll
                for (int n = 0; n < 2; ++n) acc[a][b][m][n] = (f32x4){0.f, 0.f, 0.f, 0.f};
    bf16x8 At[4][2], B0[2][2], B1[2][2];
    const char* cA = (const char*)g.A + (size_t)cur.pm * tstep; const char* cB = (const char*)g.Bt + (size_t)cur.pn * tstep;
    S.a_ready(cur);
    if constexpr (SP2) {
        PG8_STAGE(PG8_SB(0, 0), cB, voffB); PG8_STAGE(PG8_SB(0, 1), cB + hstep, voffB); PG8_STAGE(PG8_SA(0, 0), cA, voffA); PG8_STAGE(PG8_SA(0, 1), cA + hstep, voffA);
        if (wr == 1) PG8_BAR;
        PG8_WAIT_V(2); PG8_BAR;
        PG8_STAGE(PG8_SB(1, 0), cB + kstep, voffB); PG8_STAGE(PG8_SA(1, 0), cA + kstep, voffA); PG8_STAGE(PG8_SB(1, 1), cB + hstep + kstep, voffB);
        PG8_WAIT_V(6); PG8_BAR;
    } else {
        PG8_STAGE(PG8_SB(0, 0), cB, voffB); PG8_STAGE(PG8_SA(0, 0), cA, voffA); PG8_STAGE(PG8_SB(0, 1), cB + hstep, voffB); PG8_STAGE(PG8_SA(0, 1), cA + hstep, voffA);
        if (wr == 1) PG8_BAR;
        PG8_WAIT_V(4); PG8_BAR;
        PG8_STAGE(PG8_SB(1, 0), cB + kstep, voffB); PG8_STAGE(PG8_SA(1, 0), cA + kstep, voffA); PG8_STAGE(PG8_SB(1, 1), cB + hstep + kstep, voffB);
        PG8_WAIT_V(6); PG8_BAR;
    }
    for (;;) {
        const bool has_next = S.next(ui + 1, nxt);
        const char* nA = has_next ? (const char*)g.A + (size_t)nxt.pm * tstep : cA; const char* nB = has_next ? (const char*)g.Bt + (size_t)nxt.pn * tstep : cB;
        for (int t = 0; t < nt; t += 2) {
            const bool last = (t == nt - 2);
            const char* a1 = cA + (size_t)(t + 1) * kstep;
            const char* a2 = last ? nA : cA + (size_t)(t + 2) * kstep; const char* b2 = last ? nB : cB + (size_t)(t + 2) * kstep;
            const char* a3 = a2 + kstep; const char* b3 = b2 + kstep;
            if (last && has_next) S.a_ready(nxt);
            if constexpr (SP2) {
            PG8_LDB(B0, 0, 0); PG8_LDB(B1, 0, 1); PG8_SCHED; PG8_LDA(At, 0, 0); PG8_STAGE(PG8_SA(1, 1), a1 + hstep, voffA);
            PG8_WAIT_V(8); PG8_WAIT_L(0); PG8_BAR; PG8_MMA(0, 0, At, B0); PG8_MMA(0, 1, At, B1); PG8_BAR; PG8_SCHED;
            PG8_LDA(At, 0, 1); PG8_STAGE(PG8_SB(0, 0), b2, voffB); PG8_STAGE(PG8_SB(0, 1), b2 + hstep, voffB); PG8_STAGE(PG8_SA(0, 0), a2, voffA);
            PG8_WAIT_V(8); PG8_WAIT_L(0); PG8_BAR; PG8_MMA(1, 0, At, B0); PG8_MMA(1, 1, At, B1); PG8_BAR; PG8_SCHED;
            PG8_LDB(B0, 1, 0); PG8_LDB(B1, 1, 1); PG8_SCHED; PG8_LDA(At, 1, 0); PG8_STAGE(PG8_SA(0, 1), a2 + hstep, voffA);
            PG8_WAIT_V(8); PG8_WAIT_L(0); PG8_BAR; PG8_MMA(0, 0, At, B0); PG8_MMA(0, 1, At, B1); PG8_BAR; PG8_SCHED;
            PG8_LDA(At, 1, 1); PG8_STAGE(PG8_SB(1, 0), b3, voffB); PG8_STAGE(PG8_SB(1, 1), b3 + hstep, voffB); PG8_STAGE(PG8_SA(1, 0), a3, voffA);
            PG8_WAIT_V(8); PG8_WAIT_L(0); PG8_BAR; PG8_MMA(1, 0, At, B0); PG8_MMA(1, 1, At, B1); PG8_BAR; PG8_SCHED;
            } else {
            PG8_LDB(B0, 0, 0); PG8_SCHED; PG8_LDA(At, 0, 0); PG8_STAGE(PG8_SA(1, 1), a1 + hstep, voffA);
            PG8_WAIT_L(8); PG8_BAR; PG8_WAIT_L(0); PG8_MMA(0, 0, At, B0); PG8_BAR; PG8_SCHED;
            PG8_LDB(B1, 0, 1); PG8_STAGE(PG8_SB(0, 0), b2, voffB);
            PG8_BAR; PG8_WAIT_L(0); PG8_MMA(0, 1, At, B1); PG8_BAR;
            PG8_LDA(At, 0, 1); PG8_STAGE(PG8_SA(0, 0), a2, voffA);
            PG8_BAR; PG8_WAIT_L(0); PG8_MMA(1, 0, At, B0); PG8_BAR; PG8_SCHED;
            PG8_STAGE(PG8_SB(0, 1), b2 + hstep, voffB);
            PG8_WAIT_V(6); PG8_BAR; PG8_MMA(1, 1, At, B1); PG8_BAR;
            PG8_LDB(B0, 1, 0); PG8_SCHED; PG8_LDA(At, 1, 0); PG8_STAGE(PG8_SA(0, 1), a2 + hstep, voffA);
            PG8_WAIT_L(8); PG8_BAR; PG8_WAIT_L(0); PG8_MMA(0, 0, At, B0); PG8_BAR; PG8_SCHED;
            PG8_LDB(B1, 1, 1); PG8_STAGE(PG8_SB(1, 0), b3, voffB);
            PG8_BAR; PG8_WAIT_L(0); PG8_MMA(0, 1, At, B1); PG8_BAR;
            PG8_LDA(At, 1, 1); PG8_STAGE(PG8_SA(1, 0), a3, voffA);
            PG8_BAR; PG8_WAIT_L(0); PG8_MMA(1, 0, At, B0); PG8_BAR; PG8_SCHED;
            PG8_STAGE(PG8_SB(1, 1), b3 + hstep, voffB);
            PG8_WAIT_V(6); PG8_BAR; PG8_MMA(1, 1, At, B1); PG8_BAR;
            }
        }
        if constexpr (ALIGN_EPI) { if (wr == 0) PG8_BAR; }
        if constexpr (!Epi::AFTER_DRAIN) { E(acc, cur, wr, wc, fr, fq); S.done(cur); }
        if (!has_next) break;
#pragma unroll
        for (int a = 0; a < 2; ++a)
#pragma unroll
            for (int b = 0; b < 2; ++b)
#pragma unroll
                for (int m = 0; m < 4; ++m)
#pragma unroll
                    for (int n = 0; n < 2; ++n) acc[a][b][m][n] = (f32x4){0.f, 0.f, 0.f, 0.f};
        cur = nxt; cA = nA; cB = nB; ++ui;
        if constexpr (ALIGN_EPI) { if (wr == 1) PG8_BAR; }
    }
    PG8_WAIT_V(0);
    if constexpr (!ALIGN_EPI) { if (wr == 0) PG8_BAR; }
    PG8_BAR;
    if constexpr (Epi::AFTER_DRAIN) { E.fused(acc, cur, wr, wc, fr, fq, lds, wid, lane); S.done(cur); }
#undef PG8_SA
#undef PG8_SB
#undef PG8_STAGE
#undef PG8_LDA
#undef PG8_LDB
#undef PG8_MMA
#undef PG8_WAIT_V
#undef PG8_WAIT_L
#undef PG8_BAR
#undef PG8_SCHED
}
}

constexpr int NWAVES = 8;
#ifndef MK_PER_PHASE
#define MK_PER_PHASE 0
#endif
constexpr int N_PHASES = 10;

constexpr int DM = 1024, NB = 8, SEQ = 2048, MP = NB * SEQ  , DEC = 128, MV = MP + DEC  , MR = 16640  ;
constexpr int CC = 512, CW = 31, NH = 4, DKV = 128, QKVN = 1536, NMEM = 256, MHD = 256, DFF = 2816, INC = 3080;
constexpr int PBLD = pg8::PBLD;
constexpr int NCHUNK = NB * NH * 32;
constexpr float RMS_EPS = 1e-6f;
constexpr float ATT_C2 = 0.0625f * 1.4426950408889634f;

constexpr size_t OUT_YP = 0, OUT_YS = 16777216, OUT_CONVP = 16908288, OUT_SCP = 17031168, OUT_DLP = 17068032, OUT_MKP = 17592320, OUT_MVP = 19689472,
                 OUT_CONVS = 21786624, OUT_SCS = 23752704, OUT_DLS = 24342528, OUT_END = 32731136;

constexpr size_t MiB = 1u << 20;
constexpr size_t WS_CTL = 0, CTL_ZERO_BYTES = 1 * MiB;
constexpr size_t WS_WIN = 1 * MiB, WS_WOUT = 7 * MiB, WS_WMQ = 9 * MiB, WS_WMKV = 11 * MiB, WS_WMO = 15 * MiB, WS_WGU = 17 * MiB, WS_WDN = 28 * MiB;
constexpr size_t WS_BG = 34 * MiB, WS_MEMN = 35 * MiB, WS_KB = 39 * MiB, WS_VT = 43 * MiB, WS_GL = 47 * MiB, WS_X1S = 47 * MiB + 65536, WS_XBUF = 47 * MiB + 655360;
constexpr size_t WS_RA = 48 * MiB;
constexpr size_t WS_RB = 138 * MiB;
constexpr size_t WS_RC = 171 * MiB;
constexpr size_t WS_RD = 220 * MiB;
constexpr size_t WS_U = WS_RD, WS_W = 252 * MiB, WS_QG = 268 * MiB, WS_KDT = 284 * MiB, WS_QK = 300 * MiB;
constexpr size_t WS_RE = 308 * MiB;
constexpr size_t WS_RF = 341 * MiB;
constexpr size_t WS_END = 406 * MiB;
constexpr int CW_TMO = 0, CW_CODE = 1, CW_BAR = 4096, CW_SS1 = 65536, CW_SS2 = 98304, CW_SS3 = 131072, CW_PANEL = 200000;

constexpr int RING_OFF = 0, RING_BYTES = 143360;
constexpr int LDSCTL_OFF = RING_BYTES, MISC_OFF = LDSCTL_OFF + 320;
constexpr int LDS_BYTES = 147456;

#define GAS __attribute__((address_space(1)))
#define LAS __attribute__((address_space(3)))
typedef unsigned short bf16;
typedef unsigned v4u __attribute__((ext_vector_type(4)));
typedef unsigned v2u __attribute__((ext_vector_type(2)));
typedef float f32x4 __attribute__((ext_vector_type(4)));
typedef float f32x16 __attribute__((ext_vector_type(16)));
typedef short bf16x8 __attribute__((ext_vector_type(8)));
typedef GAS unsigned gu32;
#define RLX_AGENT __ATOMIC_RELAXED, __HIP_MEMORY_SCOPE_AGENT
#define LDS_WAIT() asm volatile("s_waitcnt lgkmcnt(0)" ::: "memory")
#define VM_WAIT() asm volatile("s_waitcnt vmcnt(0)" ::: "memory")
using pg8::pk2; using pg8::silu; using pg8::sigm;
__device__ __forceinline__ float bf2f(unsigned b) { return __uint_as_float(b << 16); }
__device__ __forceinline__ float bflo(unsigned w) { return __uint_as_float(w << 16); }
__device__ __forceinline__ float bfhi(unsigned w) { return __uint_as_float(w & 0xffff0000u); }
__device__ __forceinline__ void unpack8(const v4u& w, float (&f)[8]) { f[0] = bflo(w.x); f[1] = bfhi(w.x); f[2] = bflo(w.y); f[3] = bfhi(w.y); f[4] = bflo(w.z); f[5] = bfhi(w.z); f[6] = bflo(w.w); f[7] = bfhi(w.w); }
__device__ __forceinline__ v4u pack8(const float (&f)[8]) { v4u w; w.x = pk2(f[0], f[1]); w.y = pk2(f[2], f[3]); w.z = pk2(f[4], f[5]); w.w = pk2(f[6], f[7]); return w; }
template <int CTRL> __device__ __forceinline__ float dppf(float v) { return __int_as_float(__builtin_amdgcn_update_dpp(0, __float_as_int(v), CTRL, 0xf, 0xf, true)); }
__device__ __forceinline__ float row16_sum(float v) { v += dppf<0xB1>(v); v += dppf<0x4E>(v); v += dppf<0x141>(v); v += dppf<0x140>(v); return v; }
__device__ __forceinline__ float row16_max(float v) { v = fmaxf(v, dppf<0xB1>(v)); v = fmaxf(v, dppf<0x4E>(v)); v = fmaxf(v, dppf<0x141>(v)); v = fmaxf(v, dppf<0x140>(v)); return v; }
__device__ __forceinline__ float rdl(float v, int l) { return __int_as_float(__builtin_amdgcn_readlane(__float_as_int(v), l)); }
__device__ __forceinline__ float wave_sum(float v) { v = row16_sum(v); return (rdl(v, 0) + rdl(v, 16)) + (rdl(v, 32) + rdl(v, 48)); }
__device__ __forceinline__ float wave_max(float v) { v = row16_max(v); return fmaxf(fmaxf(rdl(v, 0), rdl(v, 16)), fmaxf(rdl(v, 32), rdl(v, 48))); }

#define XB_TMO      128
#define XB_XCNT(j)  (256  + 64 * (j))
#define XB_XSUB(j)  (1280 + 64 * (j))
#define XB_XGEN(j)  (2304 + 64 * (j))
#define XB_TOP      3328
#define XB_TOPGEN   3392
#define XCD_BAR_WORDS 3456
#define XB_SPIN_CAP (1u << 18)

__device__ __forceinline__ unsigned xb_ld(unsigned* p)              { return __hip_atomic_load(p, __ATOMIC_RELAXED, __HIP_MEMORY_SCOPE_AGENT); }
__device__ __forceinline__ unsigned xb_add(unsigned* p, unsigned v) { return __hip_atomic_fetch_add(p, v, __ATOMIC_RELAXED, __HIP_MEMORY_SCOPE_AGENT); }
__device__ __forceinline__ unsigned xb_xcc_id() { return (unsigned)__builtin_amdgcn_s_getreg((3 << 11) | 20) & 0xFu; }
#define XB_SPIN(cond, bar) do { unsigned _sp = 0; while (cond) { __builtin_amdgcn_s_sleep(1); \
    if ((++_sp & 255u) == 0u) { if (xb_ld(&(bar)[XB_TMO])) break; if (_sp > XB_SPIN_CAP) { atomicAdd(&(bar)[XB_TMO], 1u); break; } } } } while (0)

struct XcdBarrier {
    unsigned* bar; unsigned x;
    volatile LAS unsigned* st;
};

__device__ __forceinline__ XcdBarrier xcd_barrier_post(unsigned* bar, volatile LAS unsigned* st) {
    XcdBarrier b; b.bar = bar; b.x = xb_xcc_id(); b.st = st;
    if (threadIdx.x == 0) (void)xb_add(&bar[XB_XCNT(b.x)], 1u);
    return b;
}
__device__ __forceinline__ void xcd_barrier_complete(unsigned* bar, unsigned x, unsigned& nloc, unsigned& nx) {
    const unsigned G = gridDim.x * gridDim.y * gridDim.z;
    unsigned sum, cnt, mine, sp = 0u;
    for (;;) {
        sum = 0u; cnt = 0u; mine = 0u;
#pragma unroll
        for (unsigned j = 0; j < 16; ++j) { const unsigned c = xb_ld(&bar[XB_XCNT(j)]); sum += c; cnt += (c > 0u) ? 1u : 0u; mine = (j == x) ? c : mine; }
        if (sum == G) break;
        __builtin_amdgcn_s_sleep(1);
        if ((++sp & 255u) == 0u) { if (xb_ld(&bar[XB_TMO])) break; if (sp > XB_SPIN_CAP) { atomicAdd(&bar[XB_TMO], 1u); break; } }
    }
    nloc = mine > 0u ? mine : 1u; nx = cnt > 0u ? cnt : 1u;
}

__device__ __forceinline__ void xcd_barrier(const XcdBarrier& b) {
    asm volatile("s_waitcnt vmcnt(0)" ::: "memory");
    __syncthreads();
    if (threadIdx.x == 0) {
        unsigned* bar = b.bar;
        __builtin_amdgcn_s_waitcnt(0);
        unsigned nloc = b.st[0], nx = b.st[1];
        if (nloc == 0u) { xcd_barrier_complete(bar, b.x, nloc, nx); b.st[0] = nloc; b.st[1] = nx; }
        const unsigned old = xb_add(&bar[XB_XSUB(b.x)], 1u);
        const unsigned gen = old / nloc;
        if (old + 1u == (gen + 1u) * nloc) {
            __builtin_amdgcn_fence(__ATOMIC_RELEASE, "agent");
            asm volatile("s_waitcnt vmcnt(0)" ::: "memory");
            const unsigned og = xb_add(&bar[XB_TOP], 1u);
            const unsigned tg = og / nx;
            if (og + 1u == (tg + 1u) * nx) xb_add(&bar[XB_TOPGEN], 1u);
            else XB_SPIN(xb_ld(&bar[XB_TOPGEN]) == tg, bar);
            __builtin_amdgcn_fence(__ATOMIC_ACQUIRE, "agent");
            xb_add(&bar[XB_XGEN(b.x)], 1u);
            asm volatile("s_waitcnt vmcnt(0)" ::: "memory");
        } else {
            XB_SPIN(xb_ld(&bar[XB_XGEN(b.x)]) == gen, bar);
            __builtin_amdgcn_fence(__ATOMIC_ACQUIRE, "agent");
            asm volatile("s_waitcnt vmcnt(0)" ::: "memory");
        }
    }
    __syncthreads();
}

struct Args { const float* in[30]; float* out; unsigned char* ws; int ph_lo, ph_hi, li, pad; };
struct Frame {
    LAS unsigned char* lds;
    volatile LAS unsigned* MISC;
    gu32* ctl;
    int tid, lane, wave;
    int vcu, G;
};
enum { I_XP = 0, I_XS, I_MEM, I_CCONV, I_SSC, I_SDELTA, I_CMK, I_CMV, I_NMIX, I_WIN, I_CONVW, I_CONVB, I_LNG, I_LNB, I_SCW, I_ALOG, I_DTB, I_DNN, I_WOUT,
       I_NMQ, I_NMKV, I_WMQ, I_WMK, I_WMV, I_WMO, I_NFFN, I_WG, I_WU, I_WD, I_NF };

struct TrJob { const float* W; const float* gain; bf16* WT; int ldw, k0, c0, K, r0; };
__device__ __forceinline__ void tr_load(const TrJob& j, int lane, f32x4 (&v)[8]) {
    const float* p = j.W + (size_t)(j.k0 + (lane >> 3)) * j.ldw + j.c0 + (lane & 7) * 4;
#pragma unroll
    for (int i = 0; i < 8; ++i) v[i] = *(const GAS f32x4*)(p + (size_t)(8 * i) * j.ldw);
}
__device__ __forceinline__ void tr_finish(const TrJob& j, const f32x4 (&v)[8], LAS float* scr, int lane) {
#pragma unroll
    for (int i = 0; i < 8; ++i) { LAS float* d = scr + (8 * i + (lane >> 3)) * 33 + (lane & 7) * 4; d[0] = v[i][0]; d[1] = v[i][1]; d[2] = v[i][2]; d[3] = v[i][3]; }
    LDS_WAIT(); asm volatile("" ::: "memory");
    const int c = lane & 7;
    float gv[8];
#pragma unroll
    for (int i = 0; i < 8; ++i) gv[i] = j.gain ? j.gain[j.k0 + 8 * c + i] : 1.f;
#pragma unroll
    for (int q = 0; q < 4; ++q) { const int n = (lane >> 3) + 8 * q; const LAS float* s = scr + (8 * c) * 33 + n;
        v4u o; o.x = pk2(s[0 * 33] * gv[0], s[1 * 33] * gv[1]); o.y = pk2(s[2 * 33] * gv[2], s[3 * 33] * gv[3]); o.z = pk2(s[4 * 33] * gv[4], s[5 * 33] * gv[5]); o.w = pk2(s[6 * 33] * gv[6], s[7 * 33] * gv[7]);
        *(GAS v4u*)(j.WT + (size_t)(j.r0 + n) * j.K + j.k0 + 8 * c) = o; }
    LDS_WAIT(); asm volatile("" ::: "memory");
}
__device__ __forceinline__ float softplusf_(float x) { return x > 20.f ? x : log1pf(__expf(x)); }

constexpr int TR_IA = 96 * 16, TR_IB = 32 * 16, TR_ID = 64 * 16, TR_IF = 176 * 16, TR_IG = 32 * 44, TR_N1 = TR_IA + TR_IB + TR_ID, TR_N = TR_N1 + TR_IB + TR_IB + TR_IF + TR_IG;
__device__ __forceinline__ void weights_phase(const Args& A, Frame& F, int first, int last, int w, int nw) {
    LAS float* scr = (LAS float*)(F.lds + RING_OFF + F.wave * 8448);
    unsigned char* ws = A.ws;
    const float* const pWMK = A.in[I_WMK]; const float* const pWMV = A.in[I_WMV]; const float* const pWG = A.in[I_WG]; const float* const pWU = A.in[I_WU];
    const float* const pWIN = A.in[I_WIN]; const float* const pWOUT = A.in[I_WOUT]; const float* const pWMQ = A.in[I_WMQ]; const float* const pWMO = A.in[I_WMO]; const float* const pWD = A.in[I_WD];
    const float* const pNMQ = A.in[I_NMQ]; const float* const pNFFN = A.in[I_NFFN];
#define TR_DECODE(J, IT) do { int r = (IT); \
        if (r < TR_IA) { const int nb = r % 96, kb = r / 96, j0 = 32 * nb; int src = j0; \
            if (j0 < 1024) { const int tile = j0 >> 8, local = j0 & 255; src = local < 128 ? 128 * tile + local : 512 + 128 * tile + (local - 128); } \
            J = TrJob{pWIN, nullptr, (bf16*)(ws + WS_WIN), INC, 64 * kb, src, DM, j0}; break; } r -= TR_IA; \
        if (r < TR_IB) { const int nb = r % 32, kb = r / 32; J = TrJob{pWOUT, nullptr, (bf16*)(ws + WS_WOUT), DM, 64 * kb, 32 * nb, DM, 32 * nb}; break; } r -= TR_IB; \
        if (r < TR_ID) { const int nb = r % 64, kb = r / 64, j0 = 32 * nb; const bool isv = j0 >= 1024; \
            J = TrJob{isv ? pWMV : pWMK, nullptr, (bf16*)(ws + WS_WMKV), DM, 64 * kb, isv ? j0 - 1024 : j0, DM, j0}; break; } r -= TR_ID; \
        if (r < TR_IB) { const int nb = r % 32, kb = r / 32; J = TrJob{pWMQ, pNMQ, (bf16*)(ws + WS_WMQ), DM, 64 * kb, 32 * nb, DM, 32 * nb}; break; } r -= TR_IB; \
        if (r < TR_IB) { const int nb = r % 32, kb = r / 32; J = TrJob{pWMO, nullptr, (bf16*)(ws + WS_WMO), DM, 64 * kb, 32 * nb, DM, 32 * nb}; break; } r -= TR_IB; \
        if (r < TR_IF) { const int nb = r % 176, kb = r / 176, j0 = 32 * nb, tile = j0 >> 8, local = j0 & 255; const bool up = local >= 128; \
            J = TrJob{up ? pWU : pWG, pNFFN, (bf16*)(ws + WS_WGU), DFF, 64 * kb, 128 * tile + (up ? local - 128 : local), DM, j0}; break; } r -= TR_IF; \
        { const int nb = r % 32, kb = r / 32; J = TrJob{pWD, nullptr, (bf16*)(ws + WS_WDN), DM, 64 * kb, 32 * nb, DFF, 32 * nb}; } } while (0)
    TrJob jc, jn; f32x4 vc[8], vn[8];
    int it = first + w;
    if (it < last) { TR_DECODE(jc, it); tr_load(jc, F.lane, vc); }
#pragma unroll 1
    for (; it < last; it += nw) {
        const int itn = it + nw;
        if (itn < last) { TR_DECODE(jn, itn); tr_load(jn, F.lane, vn); }
        tr_finish(jc, vc, scr, F.lane);
        jc = jn;
#pragma unroll
        for (int i = 0; i < 8; ++i) vc[i] = vn[i];
    }
#undef TR_DECODE
}
__device__ __forceinline__ void p0_prologue(const Args& A, Frame& F) {
    const int gw = F.vcu * NWAVES + F.wave, NGW = F.G * NWAVES;
    unsigned char* ws = A.ws;
    const float* const pXP = A.in[I_XP]; const float* const pXS = A.in[I_XS];
    weights_phase(A, F, 0, TR_N1, gw, NGW);
    {
        bf16* H = (bf16*)(ws + WS_RB); float* BG = (float*)(ws + WS_BG);
        const float* win = A.in[I_WIN]; const float* gain = A.in[I_NMIX];
        float w8[4][4][8];
#pragma unroll
        for (int j = 0; j < 4; ++j)
#pragma unroll
            for (int i = 0; i < 4; ++i) { const int k = 256 * j + 4 * F.lane + i; const f32x4 a = *(const f32x4*)(win + (size_t)k * INC + 3072), b = *(const f32x4*)(win + (size_t)k * INC + 3076);
                w8[j][i][0] = a[0]; w8[j][i][1] = a[1]; w8[j][i][2] = a[2]; w8[j][i][3] = a[3]; w8[j][i][4] = b[0]; w8[j][i][5] = b[1]; w8[j][i][6] = b[2]; w8[j][i][7] = b[3]; }
        f32x4 gn[4];
#pragma unroll
        for (int j = 0; j < 4; ++j) gn[j] = *(const f32x4*)(gain + 256 * j + 4 * F.lane);
        const f32x4 alog4 = *(const f32x4*)A.in[I_ALOG], dtb4 = *(const f32x4*)A.in[I_DTB];
        const bool hi5 = (F.lane & 32) != 0, b4 = (F.lane & 16) != 0, b3 = (F.lane & 8) != 0; const int cidx = (hi5 ? 4 : 0) + (b4 ? 2 : 0) + (b3 ? 1 : 0), c3 = cidx & 3;
        const float myea = expf(c3 == 0 ? alog4[0] : c3 == 1 ? alog4[1] : c3 == 2 ? alog4[2] : alog4[3]);
        const float mydtb = (cidx < 4) ? 0.f : (c3 == 0 ? dtb4[0] : c3 == 1 ? dtb4[1] : c3 == 2 ? dtb4[2] : dtb4[3]);
        f32x4 v[4], nv[4];
        { const int m0 = gw; if (m0 < MV) { const GAS f32x4* xr = (const GAS f32x4*)((m0 < MP) ? pXP + (size_t)m0 * DM : pXS + (size_t)(m0 - MP) * DM) + F.lane;
#pragma unroll
            for (int j = 0; j < 4; ++j) v[j] = xr[64 * j]; } }
#pragma unroll 1
        for (int m = gw; m < MR; m += NGW) {
            GAS unsigned long long* o8 = (GAS unsigned long long*)(H + (size_t)m * DM) + F.lane;
            { const int mn = m + NGW; if (mn < MV) { const GAS f32x4* xr = (const GAS f32x4*)((mn < MP) ? pXP + (size_t)mn * DM : pXS + (size_t)(mn - MP) * DM) + F.lane;
#pragma unroll
                for (int j = 0; j < 4; ++j) nv[j] = xr[64 * j]; } }
            if (m >= MV) {
#pragma unroll
                for (int j = 0; j < 4; ++j) o8[64 * j] = 0ull;
                if (F.lane < 8) BG[(size_t)m * 8 + F.lane] = 0.f;
                continue;
            }
            float s2 = 0.f;
#pragma unroll
            for (int j = 0; j < 4; ++j) s2 += (v[j][0] * v[j][0] + v[j][1] * v[j][1]) + (v[j][2] * v[j][2] + v[j][3] * v[j][3]);
            const float rstd = 1.f / sqrtf(wave_sum(s2) * (1.f / DM) + RMS_EPS);
            float p8[8];
#pragma unroll
            for (int c = 0; c < 8; ++c) p8[c] = 0.f;
#pragma unroll
            for (int j = 0; j < 4; ++j) { v[j] = v[j] * rstd * gn[j];
#pragma unroll
                for (int i = 0; i < 4; ++i)
#pragma unroll
                    for (int c = 0; c < 8; ++c) p8[c] += v[j][i] * w8[j][i][c];
                o8[64 * j] = (unsigned long long)pk2(v[j][0], v[j][1]) | ((unsigned long long)pk2(v[j][2], v[j][3]) << 32); }
            float z;
            { float r4[4], q2[2];
#pragma unroll
              for (int i = 0; i < 4; ++i) { const float send = hi5 ? p8[i] : p8[4 + i], keep = hi5 ? p8[4 + i] : p8[i]; r4[i] = keep + __shfl_xor(send, 32); }
#pragma unroll
              for (int i = 0; i < 2; ++i) { const float send = b4 ? r4[i] : r4[2 + i], keep = b4 ? r4[2 + i] : r4[i]; q2[i] = keep + __shfl_xor(send, 16); }
              { const float send = b3 ? q2[0] : q2[1], keep = b3 ? q2[1] : q2[0]; z = keep + __shfl_xor(send, 8); }
              z += dppf<0xB1>(z); z += dppf<0x4E>(z); z += dppf<0x141>(z); }
            { const float xs = z + mydtb;
              const float sp = xs > 20.f ? xs : (xs < -15.f ? __expf(xs) : __logf(1.f + __expf(xs)));
              const float val = (cidx < 4) ? __builtin_amdgcn_rcpf(1.f + __expf(-z)) : -myea * sp;
              if ((F.lane & 7) == 0) BG[(size_t)m * 8 + cidx] = val; }
#pragma unroll
            for (int j = 0; j < 4; ++j) v[j] = nv[j];
        }
    }
    {
        bf16* MN = (bf16*)(ws + WS_MEMN); const float* gain = A.in[I_NMKV];
        f32x4 gn[4];
#pragma unroll
        for (int j = 0; j < 4; ++j) gn[j] = *(const f32x4*)(gain + 256 * j + 4 * F.lane);
        for (int m = gw; m < NB * NMEM; m += NGW) {
            const GAS f32x4* xr = (const GAS f32x4*)(A.in[I_MEM] + (size_t)m * DM) + F.lane;
            f32x4 v[4]; float s2 = 0.f;
#pragma unroll
            for (int j = 0; j < 4; ++j) { v[j] = xr[64 * j]; s2 += (v[j][0] * v[j][0] + v[j][1] * v[j][1]) + (v[j][2] * v[j][2] + v[j][3] * v[j][3]); }
            const float rstd = 1.f / sqrtf(wave_sum(s2) * (1.f / DM) + RMS_EPS);
            GAS unsigned long long* o8 = (GAS unsigned long long*)(MN + (size_t)m * DM) + F.lane;
#pragma unroll
            for (int j = 0; j < 4; ++j) { v[j] = v[j] * rstd * gn[j]; o8[64 * j] = (unsigned long long)pk2(v[j][0], v[j][1]) | ((unsigned long long)pk2(v[j][2], v[j][3]) << 32); }
        }
    }
}

typedef float f32x2v __attribute__((ext_vector_type(2)));
__device__ __forceinline__ void short_conv_part(const Args& A, Frame& F, int b, int t0, int p, int oz) {
    const bf16* PB = (const bf16*)(A.ws + WS_RA); bf16* QC = (bf16*)(A.ws + WS_RC);
    __builtin_amdgcn_sched_barrier(0);
    const int ch0 = 512 * p + 8 * F.lane + oz;
    float wsc[4][8];
#pragma unroll
    for (int j = 0; j < 4; ++j) { const f32x4 a = *(const f32x4*)(A.in[I_SCW] + j * QKVN + ch0), bb = *(const f32x4*)(A.in[I_SCW] + j * QKVN + ch0 + 4);
#pragma unroll
        for (int i = 0; i < 4; ++i) { wsc[j][i] = a[i]; wsc[j][4 + i] = bb[i]; } }
    float win[3][8];
#pragma unroll
    for (int j = 0; j < 3; ++j) { const int tk = t0 - 3 + j; const int tkc = tk < 0 ? 0 : tk;
        const v4u x = *(const GAS v4u*)(PB + (size_t)(b * SEQ + tkc) * PBLD + 512 + ch0); unpack8(x, win[j]);
#pragma unroll
        for (int i = 0; i < 8; ++i) win[j][i] = (tk >= 0) ? win[j][i] : 0.f; }
#pragma unroll
    for (int tt = 0; tt < 8; ++tt) {
        float cur[8]; { const v4u x = *(const GAS v4u*)(PB + (size_t)(b * SEQ + t0 + tt) * PBLD + 512 + ch0); unpack8(x, cur); }
        float y[8]; float ss = 0.f;
#pragma unroll
        for (int i = 0; i < 8; ++i) { const float a = wsc[0][i] * win[0][i] + wsc[1][i] * win[1][i] + wsc[2][i] * win[2][i] + wsc[3][i] * cur[i]; y[i] = silu(a); ss += y[i] * y[i]; }
        if (p < 2) { ss = row16_sum(ss);
            const float sc = __builtin_amdgcn_rsqf(ss + 1e-6f) * (p == 0 ? 0.08838834764831845f : 1.f);
#pragma unroll
            for (int i = 0; i < 8; ++i) y[i] *= sc; }
        *(GAS v4u*)(QC + (size_t)(b * SEQ + t0 + tt) * QKVN + ch0) = pack8(y);
#pragma unroll
        for (int i = 0; i < 8; ++i) { win[0][i] = win[1][i]; win[1][i] = win[2][i]; win[2][i] = cur[i]; }
    }
}
__device__ __forceinline__ void short_conv_tile(const Args& A, Frame& F, int b, int tile) {
    const bf16* PB = (const bf16*)(A.ws + WS_RA);
    int oz; asm volatile("v_mov_b32 %0, 0" : "=v"(oz));
#pragma unroll 1
    for (int p = 0; p < 3; ++p) short_conv_part(A, F, b, tile * 64 + 8 * F.wave, p, oz);
    if (tile == 31) {
        float* os = A.out + OUT_SCP + (size_t)b * 3 * QKVN;
        float sv[9];
#pragma unroll
        for (int q = 0; q < 9; ++q) { const int e = F.tid + q * (NWAVES * 64); const int j = e / QKVN, ch = e % QKVN; sv[q] = bf2f(PB[(size_t)(b * SEQ + SEQ - 3 + j) * PBLD + 512 + ch]); }
        __builtin_amdgcn_sched_barrier(0);
#pragma unroll
        for (int q = 0; q < 9; ++q) os[F.tid + q * (NWAVES * 64)] = sv[q];
    }
}
__device__ __forceinline__ void conv31_tile(const Args& A, Frame& F, int b, int tile) {
    const bf16* PB = (const bf16*)(A.ws + WS_RA); bf16* CD = (bf16*)(A.ws + WS_RB);
    int oz; asm volatile("v_mov_b32 %0, 0" : "=v"(oz));
    const int row0 = b * SEQ + tile * 64;
    LAS float* Y = (LAS float*)(F.lds + RING_OFF);
    {
        const unsigned rb = (unsigned)(b * SEQ + tile * 64);
        const int c = F.tid + oz;
        float w[CW];
#pragma unroll
        for (int j = 0; j < CW; ++j) w[j] = A.in[I_CONVW][j * CC + c];
        const float bias = A.in[I_CONVB][c];
        float u[38]; float nx[8];
#pragma unroll
        for (int i = 0; i < 30; ++i) { const int tk = tile * 64 - 30 + i; const unsigned tkc = tk < 0 ? 0u : (unsigned)tk; const float vv = bf2f(PB[(unsigned)(b * SEQ + tkc) * (unsigned)PBLD + (unsigned)c]); u[i] = (tk >= 0) ? vv : 0.f; }
#pragma unroll
        for (int i = 0; i < 8; ++i) nx[i] = bf2f(PB[(rb + (unsigned)i) * (unsigned)PBLD + (unsigned)c]);
#pragma unroll 1
        for (int seg = 0; seg < 8; ++seg) {
#pragma unroll
            for (int i = 0; i < 8; ++i) u[30 + i] = nx[i];
            if (seg < 7) {
#pragma unroll
                for (int i = 0; i < 8; ++i) nx[i] = bf2f(PB[(rb + (unsigned)(seg * 8 + 8 + i)) * (unsigned)PBLD + (unsigned)c]); }
#pragma unroll
            for (int t = 0; t < 8; ++t) { float a = bias;
#pragma unroll
                for (int j = 0; j < CW; ++j) a += w[j] * u[t + j];
                Y[(seg * 8 + t) * CC + c] = a; }
#pragma unroll
            for (int i = 0; i < 30; ++i) u[i] = u[i + 8];
        }
    }
    __syncthreads();
    {
        const int ch0 = 8 * F.lane + oz;
        const f32x4 g0 = *(const f32x4*)(A.in[I_LNG] + ch0), g1 = *(const f32x4*)(A.in[I_LNG] + ch0 + 4), b0 = *(const f32x4*)(A.in[I_LNB] + ch0), b1 = *(const f32x4*)(A.in[I_LNB] + ch0 + 4);
#pragma unroll 2
        for (int tt = 0; tt < 8; ++tt) { const int t = 8 * F.wave + tt;
            f32x4 y0 = *(const LAS f32x4*)(Y + t * CC + ch0), y1 = *(const LAS f32x4*)(Y + t * CC + ch0 + 4);
            const float mean = wave_sum((y0[0] + y0[1]) + (y0[2] + y0[3]) + (y1[0] + y1[1]) + (y1[2] + y1[3])) * (1.f / CC);
            y0 = y0 - mean; y1 = y1 - mean;
            const float var = wave_sum((y0[0] * y0[0] + y0[1] * y0[1]) + (y0[2] * y0[2] + y0[3] * y0[3]) + (y1[0] * y1[0] + y1[1] * y1[1]) + (y1[2] * y1[2] + y1[3] * y1[3])) * (1.f / CC);
            const float rstd = __builtin_amdgcn_rsqf(var + 1e-5f);
            y0 = y0 * rstd * g0 + b0; y1 = y1 * rstd * g1 + b1;
            float o[8];
#pragma unroll
            for (int i = 0; i < 4; ++i) { o[i] = silu(y0[i]); o[4 + i] = silu(y1[i]); }
            *(GAS v4u*)(CD + (size_t)(row0 + t) * DM + ch0) = pack8(o); }
    }
    if (tile == 31) {
        const int c = F.tid;
        float* oc = A.out + OUT_CONVP + (size_t)b * 30 * CC;
        float tv[30];
#pragma unroll
        for (int j = 0; j < 30; ++j) tv[j] = bf2f(PB[(size_t)(b * SEQ + SEQ - 30 + j) * PBLD + c]);
        __builtin_amdgcn_sched_barrier(0);
#pragma unroll
        for (int j = 0; j < 30; ++j) oc[j * CC + c] = tv[j];
    }
    __syncthreads();
}
__device__ __forceinline__ void conv31_sample(const Args& A, Frame& F, int s) {
    const bf16* PB = (const bf16*)(A.ws + WS_RA); bf16* CD = (bf16*)(A.ws + WS_RB);
    const int c = F.tid; const size_t row = (size_t)MP + s;
    LAS float* Y = (LAS float*)(F.lds + RING_OFF);
    {
        const float* cache = A.in[I_CCONV] + (size_t)s * 30 * CC; float* oc = A.out + OUT_CONVS + (size_t)s * 30 * CC;
        const float us = bf2f(PB[row * PBLD + c]);
        float a = A.in[I_CONVB][c];
        float cv[30], wv[31];
#pragma unroll
        for (int j = 0; j < 30; ++j) { cv[j] = cache[j * CC + c]; wv[j] = A.in[I_CONVW][j * CC + c]; }
        wv[30] = A.in[I_CONVW][30 * CC + c];
        __builtin_amdgcn_sched_barrier(0);
#pragma unroll
        for (int j = 0; j < 30; ++j) { a += wv[j] * cv[j]; oc[j * CC + c] = (j < 29) ? cv[j + 1] : us; }
        a += wv[30] * us;
        Y[c] = a;
    }
    __syncthreads();
    if (F.wave == 7) {
        const int ch0 = 8 * F.lane;
        const f32x4 g0 = *(const f32x4*)(A.in[I_LNG] + ch0), g1 = *(const f32x4*)(A.in[I_LNG] + ch0 + 4), b0 = *(const f32x4*)(A.in[I_LNB] + ch0), b1 = *(const f32x4*)(A.in[I_LNB] + ch0 + 4);
        f32x4 y0 = *(const LAS f32x4*)(Y + ch0), y1 = *(const LAS f32x4*)(Y + ch0 + 4);
        const float mean = wave_sum((y0[0] + y0[1]) + (y0[2] + y0[3]) + (y1[0] + y1[1]) + (y1[2] + y1[3])) * (1.f / CC);
        y0 = y0 - mean; y1 = y1 - mean;
        const float var = wave_sum((y0[0] * y0[0] + y0[1] * y0[1]) + (y0[2] * y0[2] + y0[3] * y0[3]) + (y1[0] * y1[0] + y1[1] * y1[1]) + (y1[2] * y1[2] + y1[3] * y1[3])) * (1.f / CC);
        const float rstd = 1.f / sqrtf(var + 1e-5f);
        y0 = y0 * rstd * g0 + b0; y1 = y1 * rstd * g1 + b1;
        float o[8];
#pragma unroll
        for (int i = 0; i < 4; ++i) { o[i] = silu(y0[i]); o[4 + i] = silu(y1[i]); }
        *(GAS v4u*)(CD + row * DM + ch0) = pack8(o);
    }
    __syncthreads();
}
__device__ __forceinline__ void shortconv_sample(const Args& A, Frame& F, int s) {
    const bf16* PB = (const bf16*)(A.ws + WS_RA); bf16* QC = (bf16*)(A.ws + WS_RC);
    const size_t row = (size_t)MP + s;
    if (F.wave < 3) {
        const int p = F.wave; const int ch0 = 512 * p + 8 * F.lane;
        const float* st = A.in[I_SSC] + (size_t)s * 3 * QKVN; float* os = A.out + OUT_SCS + (size_t)s * 3 * QKVN;
        float win[3][8], cur[8], y[8];
#pragma unroll
        for (int j = 0; j < 3; ++j) { const f32x4 a = *(const f32x4*)(st + j * QKVN + ch0), bb = *(const f32x4*)(st + j * QKVN + ch0 + 4);
#pragma unroll
            for (int i = 0; i < 4; ++i) { win[j][i] = a[i]; win[j][4 + i] = bb[i]; } }
        { const v4u x = *(const GAS v4u*)(PB + row * PBLD + 512 + ch0); unpack8(x, cur); }
        float ss = 0.f;
#pragma unroll
        for (int i = 0; i < 8; ++i) { float a = 0.f;
#pragma unroll
            for (int j = 0; j < 3; ++j) a += A.in[I_SCW][j * QKVN + ch0 + i] * win[j][i];
            a += A.in[I_SCW][3 * QKVN + ch0 + i] * cur[i]; y[i] = silu(a); ss += y[i] * y[i]; }
        if (p < 2) { ss = row16_sum(ss);
            const float sc = (1.f / sqrtf(ss + 1e-6f)) * (p == 0 ? 0.08838834764831845f : 1.f);
#pragma unroll
            for (int i = 0; i < 8; ++i) y[i] *= sc; }
        *(GAS v4u*)(QC + row * QKVN + ch0) = pack8(y);
#pragma unroll
        for (int j = 0; j < 3; ++j) { f32x4 a, bb;
#pragma unroll
            for (int i = 0; i < 4; ++i) { a[i] = (j < 2) ? win[j + 1][i] : cur[i]; bb[i] = (j < 2) ? win[j + 1][4 + i] : cur[4 + i]; }
            *(f32x4*)(os + j * QKVN + ch0) = a; *(f32x4*)(os + j * QKVN + ch0 + 4) = bb; }
    }
    __syncthreads();
}

__device__ __forceinline__ bf16x8 lds_frag16(const LAS unsigned char* p) { return *(const LAS bf16x8*)p; }
struct D1In { float g, be; v4u q0, q1, k0, k1, v0, v1; };
__device__ __forceinline__ void d1_load(const Args& A, Frame& F, int ci, D1In& I) {
    const int b = ci >> 7, h = (ci >> 5) & 3, n = ci & 31; const int row0 = b * SEQ + n * 64;
    const bf16* QC = (const bf16*)(A.ws + WS_RC); const float* BG = (const float*)(A.ws + WS_BG);
    I.g = 0.f; I.be = 0.f;
    if (F.wave == 0) { I.g = BG[(size_t)(row0 + F.lane) * 8 + 4 + h]; I.be = BG[(size_t)(row0 + F.lane) * 8 + h]; }
    const int t = F.tid >> 3, part = F.tid & 7;
    const bf16* rp = QC + (size_t)(row0 + t) * QKVN + h * 128 + part * 16;
    I.q0 = *(const GAS v4u*)(rp); I.q1 = *(const GAS v4u*)(rp + 8); I.k0 = *(const GAS v4u*)(rp + 512); I.k1 = *(const GAS v4u*)(rp + 520); I.v0 = *(const GAS v4u*)(rp + 1024); I.v1 = *(const GAS v4u*)(rp + 1032);
}
__device__ __forceinline__ void d1_chunk(const Args& A, Frame& F, int ci, const D1In& I) {
    using pg8::f32x4;
    const int b = ci >> 7, h = (ci >> 5) & 3, n = ci & 31; const int row0 = b * SEQ + n * 64;
    const bf16* QC = (const bf16*)(A.ws + WS_RC); const float* BG = (const float*)(A.ws + WS_BG);
    float* Ug = (float*)(A.ws + WS_U) + (size_t)ci * 8192; bf16* Wg = (bf16*)(A.ws + WS_W) + (size_t)ci * 8192; bf16* QGg = (bf16*)(A.ws + WS_QG) + (size_t)ci * 8192;
    bf16* KDTg = (bf16*)(A.ws + WS_KDT) + (size_t)ci * 8192; bf16* QKg = (bf16*)(A.ws + WS_QK) + (size_t)ci * 4096; float* GLg = (float*)(A.ws + WS_GL);
    constexpr int OFF_K = 0, OFF_Q = 17408, OFF_VBT = 34816, OFF_KBGT = 53248, OFF_L = 71680, OFF_T = 89088, OFF_GC = 98304, OFF_BETA = 98560, OFF_EG = 98816, OFF_TM = 99072, OFF_X = 116480, LS = 68;
    LAS unsigned char* L = F.lds + RING_OFF;
    LAS float* gcs = (LAS float*)(L + OFF_GC); LAS float* betas = (LAS float*)(L + OFF_BETA); LAS float* egs = (LAS float*)(L + OFF_EG); LAS float* Lm = (LAS float*)(L + OFF_L); LAS float* Tm = (LAS float*)(L + OFF_TM); LAS float* Xm = (LAS float*)(L + OFF_X);
    const int fr = F.lane & 15, fq = F.lane >> 4;
    if (F.wave == 0) {
        float g = I.g; const float be = I.be;
#pragma unroll
        for (int o = 1; o < 64; o <<= 1) { const float v = __shfl_up(g, o); if (F.lane >= o) g += v; }
        gcs[F.lane] = g; betas[F.lane] = be; egs[F.lane] = __expf(g);
    }
    __syncthreads();
    {
        const int t = F.tid >> 3, part = F.tid & 7;
        const v4u q0 = I.q0, q1 = I.q1, k0 = I.k0, k1 = I.k1, v0 = I.v0, v1 = I.v1;
        *(LAS v4u*)(L + OFF_K + t * 272 + part * 32) = k0; *(LAS v4u*)(L + OFF_K + t * 272 + part * 32 + 16) = k1;
        *(LAS v4u*)(L + OFF_Q + t * 272 + part * 32) = q0; *(LAS v4u*)(L + OFF_Q + t * 272 + part * 32 + 16) = q1;
        const float be = betas[t], beg = be * egs[t];
        float kf[16], vf[16];
        { float tmp[8]; unpack8(k0, tmp);
#pragma unroll
          for (int i = 0; i < 8; ++i) kf[i] = tmp[i]; unpack8(k1, tmp);
#pragma unroll
          for (int i = 0; i < 8; ++i) kf[8 + i] = tmp[i]; unpack8(v0, tmp);
#pragma unroll
          for (int i = 0; i < 8; ++i) vf[i] = tmp[i]; unpack8(v1, tmp);
#pragma unroll
          for (int i = 0; i < 8; ++i) vf[8 + i] = tmp[i]; }
#pragma unroll
        for (int i = 0; i < 16; ++i) { const int d = part * 16 + i;
            *(LAS unsigned short*)(L + OFF_VBT + d * 144 + t * 2) = (unsigned short)(pk2(vf[i] * be, 0.f) & 0xffffu);
            *(LAS unsigned short*)(L + OFF_KBGT + d * 144 + t * 2) = (unsigned short)(pk2(kf[i] * beg, 0.f) & 0xffffu); }
    }
    __syncthreads();
#pragma unroll 1
    for (int x = 0; x < 4; ++x) {
        const int tile = F.wave * 4 + x, which = tile >> 4, ti = (tile >> 2) & 3, tj = tile & 3;
        f32x4 acc = (f32x4){0.f, 0.f, 0.f, 0.f};
        if (ti >= tj) {
            const LAS unsigned char* ap = L + (which ? OFF_Q : OFF_K) + (ti * 16 + fr) * 272 + fq * 16; const LAS unsigned char* bp = L + OFF_K + (tj * 16 + fr) * 272 + fq * 16;
#pragma unroll
            for (int kk = 0; kk < 4; ++kk) acc = __builtin_amdgcn_mfma_f32_16x16x32_bf16(lds_frag16(ap + kk * 64), lds_frag16(bp + kk * 64), acc, 0, 0, 0);
        }
        const int j = tj * 16 + fr; const float gj = gcs[j];
#pragma unroll
        for (int r = 0; r < 4; ++r) { const int i = ti * 16 + 4 * fq + r; const float dec = __expf(gcs[i] - gj);
            if (which == 0) Lm[i * LS + j] = (i > j) ? betas[i] * acc[r] * dec : 0.f;
            else QKg[i * 64 + j] = (bf16)(pk2((i >= j) ? acc[r] * dec : 0.f, 0.f) & 0xffffu); }
    }
    __syncthreads();
    for (int e = F.tid; e < 64 * LS; e += NWAVES * 64) Tm[e] = 0.f;
    __syncthreads();
    if (F.wave == 0) {
        const LAS float* Lb = Lm + (16 * fq) * LS + 16 * fq;
        float t[16];
#pragma unroll
        for (int i = 0; i < 16; ++i) {
            float a0 = 0.f, a1 = 0.f, a2 = 0.f, a3 = 0.f;
#pragma unroll
            for (int j4 = 0; j4 < (i + 3) / 4; ++j4) { const f32x4 lv = *(const LAS f32x4*)(Lb + i * LS + 4 * j4);
                if (4 * j4 + 0 < i) a0 += lv[0] * t[4 * j4 + 0]; if (4 * j4 + 1 < i) a1 += lv[1] * t[4 * j4 + 1]; if (4 * j4 + 2 < i) a2 += lv[2] * t[4 * j4 + 2]; if (4 * j4 + 3 < i) a3 += lv[3] * t[4 * j4 + 3]; }
            t[i] = ((fr == i) ? 1.f : 0.f) - ((a0 + a1) + (a2 + a3));
        }
#pragma unroll
        for (int i = 0; i < 16; ++i) Tm[(16 * fq + i) * LS + 16 * fq + fr] = t[i];
    } else {
        const int lt = F.tid - 64; const float gl = gcs[63];
        for (int cix = lt; cix < 1024; cix += 448) {
            const int t = cix >> 4, cc = cix & 15; const v4u x = *(const LAS v4u*)(L + OFF_Q + t * 272 + cc * 16); float f[8]; unpack8(x, f); const float e = egs[t];
#pragma unroll
            for (int i = 0; i < 8; ++i) f[i] *= e;
            *(GAS v4u*)(QGg + t * 128 + cc * 8) = pack8(f); }
        for (int cix = lt; cix < 1024; cix += 448) {
            const int dk = cix >> 3, t0 = (cix & 7) * 8; float f[8];
#pragma unroll
            for (int i = 0; i < 8; ++i) f[i] = bf2f(*(const LAS unsigned short*)(L + OFF_K + (t0 + i) * 272 + dk * 2)) * __expf(gl - gcs[t0 + i]);
            *(GAS v4u*)(KDTg + dk * 64 + t0) = pack8(f); }
        if (lt == 0) GLg[ci] = __expf(gl);
    }
    __syncthreads();
    if (F.wave < 2) {
        const int pp = F.wave, rb = 16 * (2 * pp + 1), cb = 16 * (2 * pp); f32x4 acc = (f32x4){0.f, 0.f, 0.f, 0.f};
#pragma unroll
        for (int kk = 0; kk < 4; ++kk) acc = __builtin_amdgcn_mfma_f32_16x16x4f32(Lm[(rb + fr) * LS + cb + 4 * kk + fq], Tm[(cb + 4 * kk + fq) * LS + cb + fr], acc, 0, 0, 0);
#pragma unroll
        for (int r = 0; r < 4; ++r) Xm[pp * 576 + (4 * fq + r) * 36 + fr] = acc[r];
    }
    __syncthreads();
    if (F.wave < 2) {
        const int pp = F.wave, rb = 16 * (2 * pp + 1), cb = 16 * (2 * pp); f32x4 acc = (f32x4){0.f, 0.f, 0.f, 0.f};
#pragma unroll
        for (int kk = 0; kk < 4; ++kk) acc = __builtin_amdgcn_mfma_f32_16x16x4f32(Tm[(rb + fr) * LS + rb + 4 * kk + fq], Xm[pp * 576 + (4 * kk + fq) * 36 + fr], acc, 0, 0, 0);
#pragma unroll
        for (int r = 0; r < 4; ++r) Tm[(rb + 4 * fq + r) * LS + cb + fr] = -acc[r];
    }
    __syncthreads();
    if (F.wave < 4) {
        const int bi = F.wave >> 1, bj = F.wave & 1; f32x4 acc = (f32x4){0.f, 0.f, 0.f, 0.f};
#pragma unroll
        for (int kk = 0; kk < 8; ++kk) acc = __builtin_amdgcn_mfma_f32_16x16x4f32(Lm[(32 + 16 * bi + fr) * LS + 4 * kk + fq], Tm[(4 * kk + fq) * LS + 16 * bj + fr], acc, 0, 0, 0);
#pragma unroll
        for (int r = 0; r < 4; ++r) Xm[(16 * bi + 4 * fq + r) * 36 + 16 * bj + fr] = acc[r];
    }
    __syncthreads();
    if (F.wave < 4) {
        const int bi = F.wave >> 1, bj = F.wave & 1; f32x4 acc = (f32x4){0.f, 0.f, 0.f, 0.f};
#pragma unroll
        for (int kk = 0; kk < 8; ++kk) acc = __builtin_amdgcn_mfma_f32_16x16x4f32(Tm[(32 + 16 * bi + fr) * LS + 32 + 4 * kk + fq], Xm[(4 * kk + fq) * 36 + 16 * bj + fr], acc, 0, 0, 0);
#pragma unroll
        for (int r = 0; r < 4; ++r) Tm[(32 + 16 * bi + 4 * fq + r) * LS + 16 * bj + fr] = -acc[r];
    }
    __syncthreads();
    {
        const int i = F.tid >> 3, j0 = (F.tid & 7) * 8; const f32x4 a = *(const LAS f32x4*)(Tm + i * LS + j0), bq = *(const LAS f32x4*)(Tm + i * LS + j0 + 4);
        v4u w; w.x = pk2(a[0], a[1]); w.y = pk2(a[2], a[3]); w.z = pk2(bq[0], bq[1]); w.w = pk2(bq[2], bq[3]);
        *(LAS v4u*)(L + OFF_T + i * 144 + j0 * 2) = w;
    }
    __syncthreads();
#pragma unroll 1
    for (int x = 0; x < 8; ++x) {
        const int tile = F.wave * 8 + x, which = tile >> 5, ti = (tile >> 3) & 3, td = tile & 7;
        const LAS unsigned char* ap = L + OFF_T + (ti * 16 + fr) * 144 + fq * 16; const LAS unsigned char* bp = L + (which ? OFF_KBGT : OFF_VBT) + (td * 16 + fr) * 144 + fq * 16;
        f32x4 acc = (f32x4){0.f, 0.f, 0.f, 0.f};
#pragma unroll
        for (int kk = 0; kk < 2; ++kk) acc = __builtin_amdgcn_mfma_f32_16x16x32_bf16(lds_frag16(ap + kk * 64), lds_frag16(bp + kk * 64), acc, 0, 0, 0);
        const int d = td * 16 + fr;
#pragma unroll
        for (int r = 0; r < 4; ++r) { const int i = ti * 16 + 4 * fq + r;
            if (which == 0) Ug[i * 128 + d] = acc[r]; else Wg[i * 128 + d] = (bf16)(pk2(acc[r], 0.f) & 0xffffu); }
    }
    __syncthreads();
}

constexpr int SC_OW = 0, SC_OQG = 16384, SC_OKDT = 32768, SC_OQK = 49152, SC_OU = 57344, SC_BUF = 65536, SC_NS = 2;
__device__ __forceinline__ void scan_issue(const Args& A, Frame& F, int ci, int sl0, LAS unsigned char* dst) {
    const unsigned char* Wg = A.ws + WS_W + (size_t)ci * 16384; const unsigned char* QGg = A.ws + WS_QG + (size_t)ci * 16384;
    const unsigned char* KDTg = A.ws + WS_KDT + (size_t)ci * 16384; const unsigned char* QKg = A.ws + WS_QK + (size_t)ci * 8192; const unsigned char* Ug = A.ws + WS_U + (size_t)ci * 32768 + sl0 * 64;
#pragma unroll
    for (int j = 0; j < 11; ++j) {
        const int pi = (F.wave - SC_NS) + (NWAVES - SC_NS) * j;
        if (pi < 56 + 4 * SC_NS) {
            const unsigned char* src;
            if (pi < 32) { const int i = (pi & 15) * 64 + F.lane, r = i >> 4, c = (i & 15) ^ (r & 15); src = (pi < 16 ? Wg : QGg) + r * 256 + c * 16; }
            else if (pi < 56) { const int i = (pi < 48 ? pi - 32 : pi - 48) * 64 + F.lane, r = i >> 3, c = (i & 7) ^ ((r >> 1) & 7); src = (pi < 48 ? KDTg : QKg) + r * 128 + c * 16; }
            else { const int i = ((pi - 56) & 3) * 64 + F.lane, r = i >> 2, c = i & 3; src = Ug + ((pi - 56) >> 2) * 64 + r * 512 + c * 16; }
            __builtin_amdgcn_global_load_lds((const unsigned*)src, (LAS unsigned*)(dst + pi * 1024), 16, 0, 0);
        }
    }
}
__device__ __forceinline__ bf16x8 frag2(const LAS unsigned char* p0, const LAS unsigned char* p1) { const v2u lo = *(const LAS v2u*)p0, hi = *(const LAS v2u*)p1; v4u w; w.x = lo.x; w.y = lo.y; w.z = hi.x; w.w = hi.y; return __builtin_bit_cast(bf16x8, w); }
__device__ __forceinline__ bf16x8 frag256(const LAS unsigned char* tile, int row, int kstep, int fq) { const int c = 4 * kstep + (fq >> 1), sw = row & 15; const LAS unsigned char* rp = tile + row * 256 + 8 * (fq & 1); return frag2(rp + ((c ^ sw) << 4), rp + (((c + 2) ^ sw) << 4)); }
__device__ __forceinline__ bf16x8 frag128(const LAS unsigned char* tile, int row, int kstep, int fq) { const int c = 4 * kstep + (fq >> 1), sw = (row >> 1) & 7; const LAS unsigned char* rp = tile + row * 128 + 8 * (fq & 1); return frag2(rp + ((c ^ sw) << 4), rp + (((c + 2) ^ sw) << 4)); }
__device__ __forceinline__ bf16x8 pack_pair(const pg8::f32x4& a, const pg8::f32x4& b) { v4u w; w.x = pk2(a[0], a[1]); w.y = pk2(a[2], a[3]); w.z = pk2(b[0], b[1]); w.w = pk2(b[2], b[3]); return __builtin_bit_cast(bf16x8, w); }
__device__ __forceinline__ void scan_unit(const Args& A, Frame& F, int b, int h, int sl0) {
    using pg8::f32x4;
    LAS unsigned char* L = F.lds + RING_OFF;
    const int ci0 = (b * NH + h) * 32; const int fr = F.lane & 15, fq = F.lane >> 4;
    float* Og = (float*)(A.ws + WS_RE); const float* GLg = (const float*)(A.ws + WS_GL);
    const int sl = sl0 + F.wave;
    if (F.wave >= SC_NS) { scan_issue(A, F, ci0, sl0, L); scan_issue(A, F, ci0 + 1, sl0, L + SC_BUF); asm volatile("s_waitcnt vmcnt(10)" ::: "memory"); }
    __builtin_amdgcn_s_barrier(); asm volatile("" ::: "memory");
    f32x4 S[8];
#pragma unroll
    for (int i = 0; i < 8; ++i) S[i] = (f32x4){0.f, 0.f, 0.f, 0.f};
    float gl = GLg[ci0];
#pragma unroll 1
    for (int n = 0; n < 32; ++n) {
        if (F.wave < SC_NS) {
            const LAS unsigned char* B = L + (n & 1) * SC_BUF; const LAS unsigned char* Ub = B + SC_OU + F.wave * 4096;
            const float gln = GLg[ci0 + (n < 31 ? n + 1 : n)];
            bf16x8 Sb[4];
#pragma unroll
            for (int kk = 0; kk < 4; ++kk) Sb[kk] = pack_pair(S[2 * kk], S[2 * kk + 1]);
            f32x4 vn[4];
#pragma unroll
            for (int tb = 0; tb < 4; ++tb) { f32x4 p1 = (f32x4){0.f, 0.f, 0.f, 0.f};
#pragma unroll
                for (int kk = 0; kk < 4; ++kk) p1 = __builtin_amdgcn_mfma_f32_16x16x32_bf16(frag256(B + SC_OW, 16 * tb + fr, kk, fq), Sb[kk], p1, 0, 0, 0);
#pragma unroll
                for (int r = 0; r < 4; ++r) vn[tb][r] = *(const LAS float*)(Ub + (16 * tb + 4 * fq + r) * 64 + fr * 4) - p1[r]; }
            bf16x8 Vb[2]; Vb[0] = pack_pair(vn[0], vn[1]); Vb[1] = pack_pair(vn[2], vn[3]);
            const size_t orow = (size_t)(b * SEQ + n * 64);
#pragma unroll
            for (int blk = 0; blk < 8; ++blk) { f32x4 s = S[blk] * gl;
#pragma unroll
                for (int kt = 0; kt < 2; ++kt) s = __builtin_amdgcn_mfma_f32_16x16x32_bf16(frag128(B + SC_OKDT, 16 * blk + fr, kt, fq), Vb[kt], s, 0, 0, 0);
                S[blk] = s; }
#pragma unroll
            for (int tb = 0; tb < 4; ++tb) { f32x4 o = (f32x4){0.f, 0.f, 0.f, 0.f};
#pragma unroll
                for (int kk = 0; kk < 4; ++kk) o = __builtin_amdgcn_mfma_f32_16x16x32_bf16(frag256(B + SC_OQG, 16 * tb + fr, kk, fq), Sb[kk], o, 0, 0, 0);
#pragma unroll
                for (int kt = 0; kt < 2; ++kt) o = __builtin_amdgcn_mfma_f32_16x16x32_bf16(frag128(B + SC_OQK, 16 * tb + fr, kt, fq), Vb[kt], o, 0, 0, 0);
#pragma unroll
                for (int r = 0; r < 4; ++r) Og[(orow + 16 * tb + 4 * fq + r) * 512 + h * 128 + sl * 16 + fr] = o[r]; }
            gl = gln;
            asm volatile("s_waitcnt lgkmcnt(0)" ::: "memory");
        } else {
            asm volatile("s_waitcnt vmcnt(0)" ::: "memory");
        }
        __builtin_amdgcn_s_barrier(); asm volatile("" ::: "memory");
        if (F.wave >= SC_NS && n + 2 < 32) scan_issue(A, F, ci0 + n + 2, sl0, L + (n & 1) * SC_BUF);
    }
    if (F.wave < SC_NS) {
        float* od = A.out + OUT_DLP + (size_t)(b * NH + h) * DKV * DKV;
#pragma unroll
        for (int blk = 0; blk < 8; ++blk)
#pragma unroll
            for (int r = 0; r < 4; ++r) od[(16 * blk + 4 * fq + r) * DKV + sl * 16 + fr] = S[blk][r];
    }
    asm volatile("s_waitcnt vmcnt(0) lgkmcnt(0)" ::: "memory"); __builtin_amdgcn_s_barrier(); asm volatile("" ::: "memory");
}
__device__ __forceinline__ void delta_sample_seq(const Args& A, Frame& F, int s) {
    const bf16* QC = (const bf16*)(A.ws + WS_RC); const float* BG = (const float*)(A.ws + WS_BG); float* Og = (float*)(A.ws + WS_RE);
    const size_t row = (size_t)MP + s;
    LAS float* qs = (LAS float*)(F.lds + RING_OFF); LAS float* ks = qs + 128; LAS float* red = qs + 256;
    const int dv = F.tid & 127, grp = F.tid >> 7;
    const float* S0b = A.in[I_SDELTA] + (size_t)s * NH * DKV * DKV + (size_t)(grp * 32) * DKV + dv; float* Sob = A.out + OUT_DLS + (size_t)s * NH * DKV * DKV + (size_t)(grp * 32) * DKV + dv;
    float s0[32], s1[32];
#pragma unroll
    for (int i = 0; i < 32; ++i) s0[i] = S0b[(size_t)i * DKV];
#pragma unroll 1
    for (int h = 0; h < NH; ++h) {
        if (h + 1 < NH) {
#pragma unroll
            for (int i = 0; i < 32; ++i) s1[i] = S0b[(size_t)(h + 1) * DKV * DKV + (size_t)i * DKV]; }
        if (F.tid < 128) { qs[F.tid] = bf2f(QC[row * QKVN + h * 128 + F.tid]); ks[F.tid] = bf2f(QC[row * QKVN + 512 + h * 128 + F.tid]); }
        const float v = bf2f(QC[row * QKVN + 1024 + h * 128 + dv]);
        const float beta = BG[row * 8 + h], eg = __expf(BG[row * 8 + 4 + h]);
        __syncthreads();
        float part = 0.f;
#pragma unroll
        for (int i = 0; i < 32; ++i) part += ks[grp * 32 + i] * s0[i];
        red[grp * 128 + dv] = part;
        __syncthreads();
        const float kS = (red[dv] + red[128 + dv]) + (red[256 + dv] + red[384 + dv]);
        const float vnew = beta * (v - eg * kS);
        __syncthreads();
        float po = 0.f;
#pragma unroll
        for (int i = 0; i < 32; ++i) { const float sn = eg * s0[i] + ks[grp * 32 + i] * vnew; Sob[(size_t)h * DKV * DKV + (size_t)i * DKV] = sn; po += qs[grp * 32 + i] * sn; }
        red[grp * 128 + dv] = po;
        __syncthreads();
        if (F.tid < 128) Og[row * 512 + h * 128 + dv] = (red[dv] + red[128 + dv]) + (red[256 + dv] + red[384 + dv]);
        __syncthreads();
#pragma unroll
        for (int i = 0; i < 32; ++i) s0[i] = s1[i];
    }
}

__device__ __forceinline__ void ogate_row(const Args& A, Frame& F, int m, const pg8::f32x4& n0, const pg8::f32x4& n1) {
    const bf16* PB = (const bf16*)(A.ws + WS_RA); bf16* CD = (bf16*)(A.ws + WS_RB); const float* Og = (const float*)(A.ws + WS_RE); const int ch0 = 8 * F.lane;
    const f32x4 o0 = *(const GAS f32x4*)(Og + (size_t)m * 512 + ch0), o1 = *(const GAS f32x4*)(Og + (size_t)m * 512 + ch0 + 4);
    const v4u zz = *(const GAS v4u*)(PB + (size_t)m * PBLD + 2048 + ch0); float z[8]; unpack8(zz, z);
    float ss = (o0[0] * o0[0] + o0[1] * o0[1]) + (o0[2] * o0[2] + o0[3] * o0[3]) + (o1[0] * o1[0] + o1[1] * o1[1]) + (o1[2] * o1[2] + o1[3] * o1[3]);
    ss = row16_sum(ss);
    const float rstd = 1.f / sqrtf(ss * (1.f / 128.f) + RMS_EPS);
    float d[8];
#pragma unroll
    for (int i = 0; i < 4; ++i) { d[i] = o0[i] * rstd * n0[i] * silu(z[i]); d[4 + i] = o1[i] * rstd * n1[i] * silu(z[4 + i]); }
    *(GAS v4u*)(CD + (size_t)m * DM + 512 + ch0) = pack8(d);
}
__device__ __forceinline__ void ogate_phase(const Args& A, Frame& F, int blk, int nblk) {
    const int gw = blk * NWAVES + F.wave, NGW = nblk * NWAVES; const int ch0 = 8 * F.lane;
    const f32x4 n0 = *(const f32x4*)(A.in[I_DNN] + (ch0 & 127)), n1 = *(const f32x4*)(A.in[I_DNN] + (ch0 & 127) + 4);
    for (int m = gw; m < MP; m += NGW) ogate_row(A, F, m, n0, n1);
}
__device__ __forceinline__ void sample_mixer(const Args& A, Frame& F, int s) {
    shortconv_sample(A, F, s);
    VM_WAIT(); __syncthreads();
    delta_sample_seq(A, F, s);
    VM_WAIT(); __syncthreads();
    if (F.wave == 0) { const int ch0 = 8 * F.lane; const f32x4 n0 = *(const f32x4*)(A.in[I_DNN] + (ch0 & 127)), n1 = *(const f32x4*)(A.in[I_DNN] + (ch0 & 127) + 4); ogate_row(A, F, MP + s, n0, n1); }
}

__device__ __forceinline__ void attn_issue(const Args& A, Frame& F, int st, int b, int h, LAS unsigned char* slot) {
    const bf16* KB = (const bf16*)(A.ws + WS_KB); const bf16* VT = (const bf16*)(A.ws + WS_VT);
#pragma unroll
    for (int it = 0; it < 4; ++it) {
        const int idx = it * 512 + F.tid; const bf16* src;
        if (st < 4) { const int r = idx >> 5, p = idx & 31, c = p ^ (r & 15); src = KB + (size_t)(b * NMEM + 64 * st + r) * DM + h * MHD + 8 * c; }
        else { const int r = idx >> 3, p = idx & 7, c = p ^ ((r >> 1) & 7); src = VT + (size_t)(h * MHD + r) * (NB * NMEM) + b * NMEM + 64 * (st - 4) + 8 * c; }
        __builtin_amdgcn_global_load_lds((const unsigned*)src, (LAS unsigned*)(slot + it * 8192 + F.wave * 1024), 16, 0, 0);
    }
}
__device__ __forceinline__ void attn_unit(const Args& A, Frame& F, int rt, int h) {
    using pg8::f32x4;
    const int b = rt >> 4; const int fr = F.lane & 15, fq = F.lane >> 4;
    const bf16* Q = (const bf16*)(A.ws + WS_RB); bf16* AO = (bf16*)(A.ws + WS_RD);
    const size_t qoff = (size_t)(rt * 128 + F.wave * 16 + fr) * DM + h * MHD;
    const bf16* qrow = Q + qoff; bf16* orow = AO + qoff;
    LAS unsigned char* L = F.lds + RING_OFF;
    bf16x8 qf[8];
#pragma unroll
    for (int ks = 0; ks < 8; ++ks) qf[ks] = *(const GAS bf16x8*)(qrow + 32 * ks + 8 * fq);
    attn_issue(A, F, 0, b, h, L); attn_issue(A, F, 1, b, h, L + 32768);
    f32x4 sacc[16];
#pragma unroll
    for (int st = 0; st < 4; ++st) {
        asm volatile("s_waitcnt vmcnt(4)" ::: "memory");
        __builtin_amdgcn_s_barrier(); asm volatile("" ::: "memory");
        attn_issue(A, F, st + 2, b, h, L + ((st + 2) & 3) * 32768);
        const LAS unsigned char* slot = L + (st & 3) * 32768;
#pragma unroll
        for (int kbl = 0; kbl < 4; ++kbl) { f32x4 acc = (f32x4){0.f, 0.f, 0.f, 0.f}; const int row = 16 * kbl + fr;
#pragma unroll
            for (int ks = 0; ks < 8; ++ks) { const bf16x8 a = *(const LAS bf16x8*)(slot + row * 512 + (((4 * ks + fq) ^ (row & 15)) << 4)); acc = __builtin_amdgcn_mfma_f32_16x16x32_bf16(a, qf[ks], acc, 0, 0, 0); }
            sacc[4 * st + kbl] = acc; }
    }
    float mx = -3.0e38f;
#pragma unroll
    for (int kb = 0; kb < 16; ++kb)
#pragma unroll
        for (int i = 0; i < 4; ++i) mx = fmaxf(mx, sacc[kb][i]);
    mx = fmaxf(mx, __shfl_xor(mx, 16)); mx = fmaxf(mx, __shfl_xor(mx, 32));
    float lsum = 0.f; bf16x8 pb[8];
#pragma unroll
    for (int kb = 0; kb < 16; ++kb)
#pragma unroll
        for (int i = 0; i < 4; ++i) { const float p = __builtin_amdgcn_exp2f(sacc[kb][i] - mx); sacc[kb][i] = p; lsum += p; }
#pragma unroll
    for (int s = 0; s < 8; ++s) pb[s] = pack_pair(sacc[2 * s], sacc[2 * s + 1]);
    lsum += __shfl_xor(lsum, 16); lsum += __shfl_xor(lsum, 32);
    f32x4 oacc[16];
#pragma unroll
    for (int db = 0; db < 16; ++db) oacc[db] = (f32x4){0.f, 0.f, 0.f, 0.f};
#pragma unroll
    for (int st = 4; st < 8; ++st) {
        if (st + 1 < 8) asm volatile("s_waitcnt vmcnt(4)" ::: "memory"); else asm volatile("s_waitcnt vmcnt(0)" ::: "memory");
        __builtin_amdgcn_s_barrier(); asm volatile("" ::: "memory");
        if (st + 2 < 8) attn_issue(A, F, st + 2, b, h, L + ((st + 2) & 3) * 32768);
        const LAS unsigned char* slot = L + (st & 3) * 32768; const int t = st - 4;
#pragma unroll
        for (int db = 0; db < 16; ++db) { const int row = 16 * db + fr; const int sw = (row >> 1) & 7;
#pragma unroll
            for (int s2 = 0; s2 < 2; ++s2) { const int c = 4 * s2 + (fq >> 1);
                const v2u lo = *(const LAS v2u*)(slot + row * 128 + ((c ^ sw) << 4) + 8 * (fq & 1)), hi = *(const LAS v2u*)(slot + row * 128 + (((c + 2) ^ sw) << 4) + 8 * (fq & 1));
                v4u aw; aw.x = lo.x; aw.y = lo.y; aw.z = hi.x; aw.w = hi.y;
                oacc[db] = __builtin_amdgcn_mfma_f32_16x16x32_bf16(__builtin_bit_cast(bf16x8, aw), pb[2 * t + s2], oacc[db], 0, 0, 0); } }
    }
    const float inv = 1.f / lsum;
#pragma unroll
    for (int db = 0; db < 16; ++db) { v2u w; w.x = pk2(oacc[db][0] * inv, oacc[db][1] * inv); w.y = pk2(oacc[db][2] * inv, oacc[db][3] * inv); *(GAS v2u*)(orow + 16 * db + 4 * fq) = w; }
    LDS_WAIT(); __builtin_amdgcn_s_barrier(); asm volatile("" ::: "memory");
}
__device__ __forceinline__ void attn_sample(const Args& A, Frame& F, int s, int h) {
    const bf16* qrow = (const bf16*)(A.ws + WS_RB) + (size_t)(MP + s) * DM + h * MHD; bf16* orow = (bf16*)(A.ws + WS_RD) + (size_t)(MP + s) * DM + h * MHD;
    const int g = F.lane >> 4, dl = F.lane & 15;
    const float* Kc = A.in[I_CMK] + (size_t)s * NMEM * DM + h * MHD + (size_t)(32 * F.wave + g) * DM + 4 * dl;
    const float* Vc = A.in[I_CMV] + (size_t)s * NMEM * DM + h * MHD + (size_t)(32 * F.wave + g) * DM + 4 * dl;
    LAS float* pl = (LAS float*)(F.lds + RING_OFF); LAS float* wred = pl + 256; LAS float* ored = pl + 512;
    f32x4 kv[8][4];
#pragma unroll
    for (int it = 0; it < 8; ++it)
#pragma unroll
        for (int i = 0; i < 4; ++i) kv[it][i] = *(const GAS f32x4*)(Kc + (size_t)(4 * it) * DM + 64 * i);
    f32x4 q[4];
#pragma unroll
    for (int i = 0; i < 4; ++i) { const v2u x = *(const GAS v2u*)(qrow + 64 * i + 4 * dl); q[i] = (f32x4){bflo(x.x), bfhi(x.x), bflo(x.y), bfhi(x.y)}; }
    __builtin_amdgcn_sched_barrier(0);
    float myscore = -3.0e38f;
#pragma unroll
    for (int it = 0; it < 8; ++it) { float d = 0.f;
#pragma unroll
        for (int i = 0; i < 4; ++i) d += (kv[it][i][0] * q[i][0] + kv[it][i][1] * q[i][1]) + (kv[it][i][2] * q[i][2] + kv[it][i][3] * q[i][3]);
        d = row16_sum(d);
        if (dl == it) myscore = d; }
#pragma unroll
    for (int it = 0; it < 8; ++it)
#pragma unroll
        for (int i = 0; i < 4; ++i) kv[it][i] = *(const GAS f32x4*)(Vc + (size_t)(4 * it) * DM + 64 * i);
    const float m = wave_max(myscore);
    if (F.lane == 0) wred[F.wave] = m;
    __syncthreads();
    float gm = wred[0];
#pragma unroll
    for (int i = 1; i < 8; ++i) gm = fmaxf(gm, wred[i]);
    const float p = (dl < 8) ? __builtin_amdgcn_exp2f(myscore - gm) : 0.f;
    if (dl < 8) pl[32 * F.wave + 4 * dl + g] = p;
    const float ws_ = wave_sum(p);
    if (F.lane == 0) wred[8 + F.wave] = ws_;
    __syncthreads();
    float tot = 0.f;
#pragma unroll
    for (int i = 0; i < 8; ++i) tot += wred[8 + i];
    f32x4 acc[4];
#pragma unroll
    for (int i = 0; i < 4; ++i) acc[i] = (f32x4){0.f, 0.f, 0.f, 0.f};
#pragma unroll
    for (int it = 0; it < 8; ++it) { const float pi = pl[32 * F.wave + 4 * it + g];
#pragma unroll
        for (int i = 0; i < 4; ++i) acc[i] = acc[i] + kv[it][i] * pi; }
#pragma unroll
    for (int i = 0; i < 4; ++i)
#pragma unroll
        for (int e = 0; e < 4; ++e) { float v = acc[i][e]; v += __shfl_xor(v, 16); v += __shfl_xor(v, 32); acc[i][e] = v; }
    if (g == 0) {
#pragma unroll
        for (int i = 0; i < 4; ++i) *(LAS f32x4*)(ored + F.wave * 256 + 64 * i + 4 * dl) = acc[i]; }
    __syncthreads();
    if (F.tid < 256) { float o = 0.f;
#pragma unroll
        for (int w = 0; w < 8; ++w) o += ored[w * 256 + F.tid];
        orow[F.tid] = (bf16)(pk2(o / tot, 0.f) & 0xffffu); }
    __syncthreads();
}

typedef unsigned v2u_ __attribute__((ext_vector_type(2)));
template <int NKS, class Epi>
__device__ __forceinline__ void small_gemm_item(const Frame& F, const bf16* Arow0, const bf16* Bt, int pn, int j, int rq, const Epi& E) {
    using pg8::f32x4;
    constexpr int K = NKS * 256;
    const int fr = F.lane & 15, fq = F.lane >> 4;
    const bf16* ap = Arow0 + (size_t)(32 * rq + fr) * K + F.wave * (K / 8) + 8 * fq;
    const bf16* b0 = Bt + (size_t)(256 * pn + 16 * j + fr) * K + F.wave * (K / 8) + 8 * fq; const bf16* b1 = b0 + (size_t)128 * K;
    bf16x8 a0[NKS], a1[NKS], x0[NKS], x1[NKS];
#pragma unroll
    for (int u = 0; u < NKS; ++u) { a0[u] = *(const GAS bf16x8*)(ap + 32 * u); a1[u] = *(const GAS bf16x8*)(ap + (size_t)16 * K + 32 * u); x0[u] = *(const GAS bf16x8*)(b0 + 32 * u); x1[u] = *(const GAS bf16x8*)(b1 + 32 * u); }
    __builtin_amdgcn_sched_barrier(0);
    f32x4 c00 = (f32x4){0.f, 0.f, 0.f, 0.f}, c01 = c00, c10 = c00, c11 = c00;
#pragma unroll
    for (int u = 0; u < NKS; ++u) {
        c00 = __builtin_amdgcn_mfma_f32_16x16x32_bf16(x0[u], a0[u], c00, 0, 0, 0); c01 = __builtin_amdgcn_mfma_f32_16x16x32_bf16(x1[u], a0[u], c01, 0, 0, 0);
        c10 = __builtin_amdgcn_mfma_f32_16x16x32_bf16(x0[u], a1[u], c10, 0, 0, 0); c11 = __builtin_amdgcn_mfma_f32_16x16x32_bf16(x1[u], a1[u], c11, 0, 0, 0);
    }
    LAS f32x4* red = (LAS f32x4*)(F.lds + RING_OFF);
    red[(F.wave * 4 + 0) * 64 + F.lane] = c00; red[(F.wave * 4 + 1) * 64 + F.lane] = c01; red[(F.wave * 4 + 2) * 64 + F.lane] = c10; red[(F.wave * 4 + 3) * 64 + F.lane] = c11;
    __syncthreads();
    if (F.wave < 2) {
        f32x4 sA = (f32x4){0.f, 0.f, 0.f, 0.f}, sB = sA;
#pragma unroll
        for (int w = 0; w < 8; ++w) { sA = sA + red[(w * 4 + 2 * F.wave) * 64 + F.lane]; sB = sB + red[(w * 4 + 2 * F.wave + 1) * 64 + F.lane]; }
        E(32 * rq + 16 * F.wave + fr, pn, j, fq, sA, sB);
    }
    __syncthreads();
}
__device__ __forceinline__ v2u_ pk4(const pg8::f32x4& a) { v2u_ w; w.x = pk2(a[0], a[1]); w.y = pk2(a[2], a[3]); return w; }
struct SEpiIn { bf16* PBs;
    __device__ __forceinline__ void operator()(int m, int pn, int j, int fq, const pg8::f32x4& a, const pg8::f32x4& b) const {
        if (pn < 4) { pg8::f32x4 v;
#pragma unroll
            for (int i = 0; i < 4; ++i) v[i] = a[i] * sigm(b[i]);
            *(GAS v2u_*)(PBs + (size_t)m * PBLD + 128 * pn + 16 * j + 4 * fq) = pk4(v); }
        else { bf16* rp = PBs + (size_t)m * PBLD + 256 * pn - 512 + 16 * j + 4 * fq; *(GAS v2u_*)rp = pk4(a); *(GAS v2u_*)(rp + 128) = pk4(b); }
    } };
template <int MODE> struct SEpiRes { const float* basef; const bf16* baseb; float* outf; bf16* outb; float* ss;
    __device__ __forceinline__ void operator()(int m, int pn, int j, int fq, const pg8::f32x4& a, const pg8::f32x4& b) const {
        const size_t off = (size_t)m * DM + 256 * pn + 16 * j + 4 * fq;
        pg8::f32x4 b0, b1;
        if (MODE == 0) { b0 = *(const GAS pg8::f32x4*)(basef + off); b1 = *(const GAS pg8::f32x4*)(basef + off + 128); }
        else { const v2u_ w0 = *(const GAS v2u_*)(baseb + off), w1 = *(const GAS v2u_*)(baseb + off + 128); b0 = pg8::bf4lo(w0.x, w0.y); b1 = pg8::bf4lo(w1.x, w1.y); }
        const pg8::f32x4 v0 = a + b0, v1 = b + b1;
        if (MODE == 2) { *(GAS pg8::f32x4*)(outf + off) = v0; *(GAS pg8::f32x4*)(outf + off + 128) = v1; }
        else { *(GAS v2u_*)(outb + off) = pk4(v0); *(GAS v2u_*)(outb + off + 128) = pk4(v1); }
        float s = (v0[0] * v0[0] + v0[1] * v0[1]) + (v0[2] * v0[2] + v0[3] * v0[3]) + (v1[0] * v1[0] + v1[1] * v1[1]) + (v1[2] * v1[2] + v1[3] * v1[3]);
        s += __shfl_xor(s, 16); s += __shfl_xor(s, 32);
        if (fq == 0) atomicAdd(ss + m, s);
    } };
struct SEpiQ { bf16* Qs; const float* ss; float c2;
    __device__ __forceinline__ void operator()(int m, int pn, int j, int fq, const pg8::f32x4& a, const pg8::f32x4& b) const {
        const float rs = __builtin_amdgcn_rsqf(ss[m] * (1.f / 1024.f) + RMS_EPS) * c2; bf16* rp = Qs + (size_t)m * DM + 256 * pn + 16 * j + 4 * fq;
        *(GAS v2u_*)rp = pk4(a * rs); *(GAS v2u_*)(rp + 128) = pk4(b * rs);
    } };
struct SEpiGU { bf16* Ts; const float* ss;
    __device__ __forceinline__ void operator()(int m, int pn, int j, int fq, const pg8::f32x4& a, const pg8::f32x4& b) const {
        const float rs = __builtin_amdgcn_rsqf(ss[m] * (1.f / 1024.f) + RMS_EPS); pg8::f32x4 v;
#pragma unroll
        for (int i = 0; i < 4; ++i) v[i] = silu(a[i] * rs) * (b[i] * rs);
        *(GAS v2u_*)(Ts + (size_t)m * DFF + 128 * pn + 16 * j + 4 * fq) = pk4(v);
    } };

__device__ __forceinline__ void final_norm_phase(const Args& A, Frame& F) {
    const int gw = F.vcu * NWAVES + F.wave, NGW = F.G * NWAVES; const float* ss = (const float*)(F.ctl + CW_SS3); const float* X3S = (const float*)(A.ws + WS_X1S);
    f32x4 gn[4];
#pragma unroll
    for (int j = 0; j < 4; ++j) gn[j] = *(const f32x4*)(A.in[I_NF] + 256 * j + 4 * F.lane);
    for (int m = gw; m < DEC; m += NGW) {
        const GAS f32x4* xr = (const GAS f32x4*)(X3S + (size_t)m * DM) + F.lane; GAS f32x4* yr = (GAS f32x4*)(A.out + (size_t)(MP + m) * DM) + F.lane;
        const float rstd = 1.f / sqrtf(ss[MP + m] * (1.f / DM) + RMS_EPS);
#pragma unroll
        for (int j = 0; j < 4; ++j) yr[64 * j] = xr[64 * j] * rstd * gn[j];
    }
}

__global__ void __launch_bounds__(NWAVES * 64, 2) hymba_fwd(Args args) {
    extern __shared__ __attribute__((aligned(16))) unsigned char lds[];
    Frame F;
    F.lds = (LAS unsigned char*)lds;
    F.MISC = (volatile LAS unsigned*)(F.lds + MISC_OFF);
    F.tid = threadIdx.x; F.lane = F.tid & 63; F.wave = __builtin_amdgcn_readfirstlane(F.tid >> 6);
    F.G = gridDim.x; { const int bx = blockIdx.x; F.vcu = (F.G % 8 == 0) ? (bx % 8) * (F.G / 8) + bx / 8 : bx; }
    F.ctl = (gu32*)(args.ws + WS_CTL);
    const Args& A = args;
    for (int u = F.tid; u < (LDS_BYTES - LDSCTL_OFF) / 4; u += NWAVES * 64) ((LAS unsigned*)(F.lds + LDSCTL_OFF))[u] = 0u;
    __syncthreads();
#if MK_PER_PHASE
#define GRID_BAR() do { } while (0)
#else
    XcdBarrier bar = xcd_barrier_post((unsigned*)(F.ctl + CW_BAR) + args.li * XCD_BAR_WORDS, F.MISC + 8);
#define GRID_BAR() xcd_barrier(bar)
#endif
#if 1
    const int lo = args.ph_lo, hi = args.ph_hi;
    const bool rep = (args.li != 0);
#define REPK(k) (rep && lo == (k))
#ifdef ONLY_PH
#define IN(k) ((k) == ONLY_PH && lo <= (k) && (k) < hi)
#else
#define IN(k) (lo <= (k) && (k) < hi)
#endif
#else
#define REPK(k) false
#define IN(k) true
#endif
#define BOTH(k) (IN(k) && IN((k) + 1))
#define PH_PTRS unsigned char* const ws = args.ws; bf16* const RA = (bf16*)(ws + WS_RA); bf16* const RB = (bf16*)(ws + WS_RB); bf16* const RC = (bf16*)(ws + WS_RC); \
    bf16* const AO = (bf16*)(ws + WS_RD); bf16* const X1B = (bf16*)(ws + WS_RE); \
    float* const SS1 = (float*)(ws + WS_CTL) + CW_SS1; float* const SS2 = (float*)(ws + WS_CTL) + CW_SS2; float* const SS3 = (float*)(ws + WS_CTL) + CW_SS3; float* const SSD = (float*)(ws + WS_CTL) + 163840; \
    (void)RA; (void)RB; (void)RC; (void)AO; (void)X1B; (void)SS1; (void)SS2; (void)SS3; (void)SSD;

    if (IN(0)) { p0_prologue(A, F); if (BOTH(0)) GRID_BAR(); }
    if (IN(1)) { PH_PTRS
        { pg8::Gemm g{RB, (const bf16*)(ws + WS_WIN), MP, 3072, DM}; pg8::StaticOrder S; S.init(MP, 3072, F.G, (int)blockIdx.x);
          pg8::EpiIn E{RA};
          pg8::gemm_phase<pg8::EpiIn, pg8::StaticOrder, true, true>(F.lds + RING_OFF, g, S, E); }
        { const SEpiIn E{RA + (size_t)MP * PBLD};
          for (int i = F.G - 1 - (int)blockIdx.x; i < 96 * 4; i += F.G) small_gemm_item<4>(F, RB + (size_t)MP * DM, (const bf16*)(ws + WS_WIN), i >> 5, (i >> 2) & 7, i & 3, E); }
        if (BOTH(1)) GRID_BAR();
    }
    if (IN(2)) {
        for (int it = F.vcu; it < 256; it += F.G) { const int b = it >> 5, tile = it & 31;
            short_conv_tile(A, F, b, tile);
            VM_WAIT(); __syncthreads();
            { D1In cur, nxt; d1_load(A, F, (b * NH) * 32 + tile, cur);
              _Pragma("unroll 1") for (int h = 0; h < NH; ++h) { const int hn = h + 1 < NH ? h + 1 : h; d1_load(A, F, (b * NH + hn) * 32 + tile, nxt); d1_chunk(A, F, (b * NH + h) * 32 + tile, cur); cur = nxt; } } }
#ifdef PROBE_PH
        if (!(args.pad & 4))
#endif
        for (int s = F.G - 1 - F.vcu; s < DEC; s += F.G) sample_mixer(A, F, s);
        for (int s = F.vcu; s < DEC; s += F.G) conv31_sample(A, F, s);
        if (BOTH(2)) GRID_BAR();
    }
    if (IN(3)) { PH_PTRS
        if ((int)blockIdx.x < 128) {
            const int u = ((int)blockIdx.x & 7) * 16 + ((int)blockIdx.x >> 3);
            scan_unit(A, F, u >> 4, (u >> 2) & 3, 2 * (u & 3));
        } else if ((int)blockIdx.x < 192) {
            pg8::Gemm g{(const bf16*)(ws + WS_MEMN), (const bf16*)(ws + WS_WMKV), NB * NMEM, 2048, DM}; pg8::StaticOrder S; S.init(NB * NMEM, 2048, 64, (int)blockIdx.x - 128);
            pg8::EpiKV E{A.out + OUT_MKP, A.out + OUT_MVP, (bf16*)(ws + WS_KB), (bf16*)(ws + WS_VT)};
            pg8::gemm_phase<pg8::EpiKV, pg8::StaticOrder, true, true>(F.lds + RING_OFF, g, S, E);
        } else {
            weights_phase(A, F, TR_N1, TR_N, ((int)blockIdx.x - 192) * NWAVES + F.wave, (F.G - 192) * NWAVES);
            __syncthreads();
        }
        if ((int)blockIdx.x >= 128) {
            _Pragma("unroll 1") for (int it = (int)blockIdx.x - 128; it < 256; it += F.G - 128) conv31_tile(A, F, it >> 5, it & 31);
        }
        { const SEpiRes<0> SE{A.in[I_XS], nullptr, nullptr, X1B + (size_t)MP * DM, (REPK(3) ? SSD : SS1) + MP};
          for (int i = F.G - 1 - (int)blockIdx.x; i < 32 * 4; i += F.G) small_gemm_item<4>(F, RB + (size_t)MP * DM, (const bf16*)(ws + WS_WOUT), i >> 5, (i >> 2) & 7, i & 3, SE); }
        if (BOTH(3)) GRID_BAR();
    }
    if (IN(4)) { PH_PTRS
        ogate_phase(A, F, F.vcu, F.G);
        { const SEpiQ SE{RB + (size_t)MP * DM, SS1 + MP, ATT_C2};
          for (int i = F.G - 1 - (int)blockIdx.x; i < 32 * 4; i += F.G) small_gemm_item<4>(F, X1B + (size_t)MP * DM, (const bf16*)(ws + WS_WMQ), i >> 5, (i >> 2) & 7, i & 3, SE); }
        if (BOTH(4)) GRID_BAR();
    }
    if (IN(5)) { PH_PTRS
        const bool stream_first = (((int)blockIdx.x >> 3) & 1) != 0;
        if (stream_first) { _Pragma("unroll 1") for (int it = F.vcu; it < DEC * NH; it += F.G) attn_sample(A, F, it >> 2, it & 3); }
        { pg8::Gemm g{RB, (const bf16*)(ws + WS_WOUT), MP, DM, DM}; pg8::StaticOrder S; S.init(MP, DM, F.G, (int)blockIdx.x);
          pg8::EpiRes<true> E{A.in[I_XP], nullptr, X1B, REPK(5) ? SSD : SS1};
          pg8::gemm_phase<pg8::EpiRes<true>, pg8::StaticOrder, true, true>(F.lds + RING_OFF, g, S, E); }
        if (!stream_first) { _Pragma("unroll 1") for (int it = F.vcu; it < DEC * NH; it += F.G) attn_sample(A, F, it >> 2, it & 3); }
        if (BOTH(5)) GRID_BAR();
    }
    if (IN(6)) { PH_PTRS
        pg8::Gemm g{X1B, (const bf16*)(ws + WS_WMQ), MP, DM, DM}; pg8::StaticOrder S; S.init(MP, DM, F.G, (int)blockIdx.x);
        pg8::EpiQ E{RB, SS1, ATT_C2};
        pg8::gemm_phase<pg8::EpiQ, pg8::StaticOrder, true, true>(F.lds + RING_OFF, g, S, E);
        { pg8::Unit u; _Pragma("unroll 1") for (int i = 0; i < 2 * 64; ++i) { if (!S.next(i >> 1, u)) break; attn_unit(A, F, 2 * u.pm + (i & 1), u.pn); } }
        { const SEpiRes<1> SE{nullptr, X1B + (size_t)MP * DM, nullptr, RC + (size_t)MP * DM, (REPK(6) ? SSD : SS2) + MP};
          for (int i = F.G - 1 - (int)blockIdx.x; i < 32 * 4; i += F.G) small_gemm_item<4>(F, AO + (size_t)MP * DM, (const bf16*)(ws + WS_WMO), i >> 5, (i >> 2) & 7, i & 3, SE); }
        if (BOTH(6)) GRID_BAR();
    }
    if (IN(7)) { PH_PTRS
        pg8::Gemm g{AO, (const bf16*)(ws + WS_WMO), MP, DM, DM}; pg8::StaticOrder S; S.init(MP, DM, F.G, (int)blockIdx.x);
        pg8::EpiRes<false> E{nullptr, X1B, RC, REPK(7) ? SSD : SS2};
        pg8::gemm_phase<pg8::EpiRes<false>, pg8::StaticOrder, true, true>(F.lds + RING_OFF, g, S, E);
        { const SEpiGU SE{RA + (size_t)MP * DFF, SS2 + MP};
          for (int i = F.G - 1 - (int)blockIdx.x; i < 176 * 4; i += F.G) small_gemm_item<4>(F, RC + (size_t)MP * DM, (const bf16*)(ws + WS_WGU), i >> 5, (i >> 2) & 7, i & 3, SE); }
        if (BOTH(7)) GRID_BAR();
    }
    if (IN(8)) { PH_PTRS
        pg8::Gemm g{RC, (const bf16*)(ws + WS_WGU), MP, 2 * DFF, DM}; pg8::StaticOrder S; S.init(MP, 2 * DFF, F.G, (int)blockIdx.x);
        pg8::EpiGU E{RA, SS2};
        pg8::gemm_phase<pg8::EpiGU, pg8::StaticOrder, true, true>(F.lds + RING_OFF, g, S, E);
        { const SEpiRes<2> SE{nullptr, RC + (size_t)MP * DM, (float*)(ws + WS_X1S), nullptr, (REPK(8) ? SSD : SS3) + MP};
          for (int i = F.G - 1 - (int)blockIdx.x; i < 32 * 4; i += F.G) small_gemm_item<11>(F, RA + (size_t)MP * DFF, (const bf16*)(ws + WS_WDN), i >> 5, (i >> 2) & 7, i & 3, SE); }
        if (BOTH(8)) GRID_BAR();
    }
    if (IN(9)) { PH_PTRS
        final_norm_phase(A, F);
        pg8::Gemm g{RA, (const bf16*)(ws + WS_WDN), MP, DM, DFF}; pg8::StaticOrder S; S.init(MP, DM, F.G, (int)blockIdx.x);
        pg8::EpiResNorm E{RC, A.out, A.in[I_NF], (float*)(ws + WS_XBUF), (unsigned*)(ws + WS_CTL) + CW_PANEL, (unsigned*)(ws + WS_CTL) + CW_TMO};
        pg8::gemm_phase<pg8::EpiResNorm, pg8::StaticOrder, false, true>(F.lds + RING_OFF, g, S, E);
    }
#undef IN
#undef BOTH
}

extern "C" void kernel_launch(void* const* d_in, const int* in_sizes, int n_in, void* d_out, int out_size, void* d_ws, size_t ws_size, hipStream_t stream) {
    static int grid = 0;
    if (grid == 0) {
        if (n_in != 30 || in_sizes[0] != MP * DM || (size_t)out_size != OUT_END || ws_size < WS_END) {
            fprintf(stderr, "kernel_launch: unexpected shapes: n_in %d, in0 %d, out %d, ws %zu (need >= %zu); nothing launched\n", n_in, n_in > 0 ? in_sizes[0] : -1, out_size, ws_size, (size_t)WS_END); grid = -1; return; }
        int dev = 0, cus = 0, per_cu = 0;
        if (hipGetDevice(&dev) != hipSuccess || hipDeviceGetAttribute(&cus, hipDeviceAttributeMultiprocessorCount, dev) != hipSuccess) { fprintf(stderr, "kernel_launch: device query failed\n"); grid = -1; return; }
        if (hipFuncSetAttribute((const void*)hymba_fwd, hipFuncAttributeMaxDynamicSharedMemorySize, LDS_BYTES) != hipSuccess) { fprintf(stderr, "kernel_launch: hipFuncSetAttribute failed\n"); grid = -1; return; }
        if (hipOccupancyMaxActiveBlocksPerMultiprocessor(&per_cu, (const void*)hymba_fwd, NWAVES * 64, LDS_BYTES) != hipSuccess || per_cu < 1)
            fprintf(stderr, "kernel_launch: note: occupancy query reports %d workgroups per CU\n", per_cu);
        (void)hipGetLastError();
        grid = cus;
        if (grid != 256) { fprintf(stderr, "kernel_launch: built for 256 CUs (one 256x256 unit per workgroup in the fused final-norm phase); found %d; nothing launched\n", grid); grid = -1; return; }
    }
    if (grid < 0) return;
    if (hipMemsetAsync((char*)d_ws + WS_CTL, 0, CTL_ZERO_BYTES, stream) != hipSuccess) { fprintf(stderr, "kernel_launch: hipMemsetAsync failed\n"); return; }
    Args a{};
    for (int i = 0; i < 30; ++i) a.in[i] = (const float*)d_in[i];
    a.out = (float*)d_out; a.ws = (unsigned char*)d_ws;
#if MK_PER_PHASE
    for (int ph = 0; ph < N_PHASES; ++ph) { a.ph_lo = ph; a.ph_hi = ph + 1; a.li = 0;
        hipLaunchKernelGGL(hymba_fwd, dim3(grid), dim3(NWAVES * 64), LDS_BYTES, stream, a); }
#else
#ifdef PROBE_PH
    a.ph_lo = 0; a.ph_hi = PROBE_PH + 1; a.li = 0;
    hipLaunchKernelGGL(hymba_fwd, dim3(grid), dim3(NWAVES * 64), LDS_BYTES, stream, a);
#ifdef PROBE_REPS
    for (int r_ = 0; r_ < PROBE_REPS; ++r_) { a.ph_lo = PROBE_PH; a.ph_hi = PROBE_PH + 1; a.li = 2 + r_; a.pad = PROBE_MODE; hipLaunchKernelGGL(hymba_fwd, dim3(grid), dim3(NWAVES * 64), LDS_BYTES, stream, a); }
#endif
    a.ph_lo = PROBE_PH; a.ph_hi = N_PHASES; a.li = 1; a.pad = 0;
    hipLaunchKernelGGL(hymba_fwd, dim3(grid), dim3(NWAVES * 64), LDS_BYTES, stream, a);
#else
    a.ph_lo = 0; a.ph_hi = N_PHASES; a.li = 0;
    hipLaunchKernelGGL(hymba_fwd, dim3(grid), dim3(NWAVES * 64), LDS_BYTES, stream, a);
#endif
#endif
    const hipError_t le = hipPeekAtLastError();
    if (le != hipSuccess) fprintf(stderr, "kernel_launch: launch failed: %s\n", hipGetErrorName(le));
}
```

```cpp
#include <hip/hip_runtime.h>
#include <cstdio>
#include <cstdint>
#define MK_PER_PHASE 0
namespace pg8 {
#define PG8_LAS __attribute__((address_space(3)))
typedef unsigned short bf16_t;
typedef short bf16x8 __attribute__((ext_vector_type(8)));
typedef float f32x4 __attribute__((ext_vector_type(4)));
typedef unsigned u32x4 __attribute__((ext_vector_type(4)));
constexpr int BM = 256, BK = 64, HALF = 128, HTB = HALF * BK * 2  , STAGE_BYTES = 8 * HTB, NXCD = 8, WGM = 8;

__host__ __device__ __forceinline__ int lds_byte(int r, int c) { const int st = (r >> 4) * 2 + (c >> 5), rr = r & 15, cc = c & 31, ob = rr * 64 + cc * 2; return st * 1024 + (ob ^ (((ob >> 9) & 1) << 5)); }
__host__ __device__ __forceinline__ void stage_rc(int b, int& R, int& C) { const int st = b / 1024, sb = b % 1024, swz = sb ^ (((sb >> 9) & 1) << 5); R = (st >> 1) * 16 + swz / 64; C = (st & 1) * 32 + (swz % 64) / 2; }
__host__ __device__ __forceinline__ int perm32(int rho) { const int n = rho >> 4, i = rho & 15; return 8 * (i >> 2) + 4 * n + (i & 3); }

struct Unit { int pm, pn; };
struct Gemm { const bf16_t* A; const bf16_t* Bt; int M, N, K; };

struct StaticOrder {
    int nM, nN, nwg, G, c;
    __host__ __device__ __forceinline__ void init(int M, int N, int G_, int c_) { nM = M / BM; nN = N / BM; nwg = nM * nN; G = G_; c = c_; }
    __host__ __device__ __forceinline__ bool next(int i, Unit& u) const {
        const long L = (long)i * G + c; if (L >= nwg) return false;
        int wgid = (int)L; { const int q = nwg / NXCD, r = nwg % NXCD, xcd = wgid % NXCD, off = wgid / NXCD; wgid = (xcd < r ? xcd * (q + 1) : r * (q + 1) + (xcd - r) * q) + off; }
        const int nig = WGM * nN, gid = wgid / nig, fm = gid * WGM, gsz = (nM - fm) < WGM ? (nM - fm) : WGM;
        u.pm = fm + ((wgid % nig) % gsz); u.pn = (wgid % nig) / gsz; return true;
    }
    __device__ __forceinline__ void a_ready(const Unit&) const {}
    __device__ __forceinline__ void done(const Unit&) const {}
};

__device__ __forceinline__ unsigned cvt_pk_bf16(float lo, float hi) { unsigned r; asm volatile("v_cvt_pk_bf16_f32 %0, %1, %2" : "=v"(r) : "v"(lo), "v"(hi)); return r; }
typedef float f32x2_t __attribute__((ext_vector_type(2))); typedef __bf16 bf16x2_t __attribute__((ext_vector_type(2)));
__device__ __forceinline__ unsigned pk2(float lo, float hi) { f32x2_t v = {lo, hi}; bf16x2_t b = __builtin_convertvector(v, bf16x2_t); return __builtin_bit_cast(unsigned, b); }
__device__ __forceinline__ float sigm(float x) { return __builtin_amdgcn_rcpf(1.f + __expf(-x)); }
__device__ __forceinline__ float silu(float x) { return x * __builtin_amdgcn_rcpf(1.f + __expf(-x)); }
__device__ __forceinline__ u32x4 pk8(const f32x4& a, const f32x4& b) { u32x4 w; w.x = pk2(a[0], a[1]); w.y = pk2(a[2], a[3]); w.z = pk2(b[0], b[1]); w.w = pk2(b[2], b[3]); return w; }
constexpr int PBLD = 2560;
constexpr int MPROMPT = 16384;
constexpr float RMS_EPS = 1e-6f;

struct EpiIn {
    static constexpr bool PERM = true, AFTER_DRAIN = false;
    bf16_t* PB;
    __device__ __forceinline__ void operator()(const f32x4 (&acc)[2][2][4][2], const Unit& u, int wr, int wc, int fr, int fq) const {
        const int row0 = u.pm * BM + wr * 64 + fr;
        if (u.pn < 4) {
            const int ch0 = u.pn * 128 + wc * 32 + 8 * fq;
#pragma unroll
            for (int ai = 0; ai < 2; ++ai)
#pragma unroll
                for (int m = 0; m < 4; ++m) {
                    bf16_t* rowp = PB + (size_t)(row0 + ai * HALF + m * 16) * PBLD + ch0;
                    f32x4 v0, v1;
#pragma unroll
                    for (int i = 0; i < 4; ++i) { v0[i] = acc[ai][0][m][0][i] * sigm(acc[ai][1][m][0][i]); v1[i] = acc[ai][0][m][1][i] * sigm(acc[ai][1][m][1][i]); }
                    *(u32x4*)rowp = pk8(v0, v1);
                }
        } else {
            const int col0 = u.pn * BM - 512 + wc * 32 + 8 * fq;
#pragma unroll
            for (int ai = 0; ai < 2; ++ai)
#pragma unroll
                for (int m = 0; m < 4; ++m) {
                    bf16_t* rowp = PB + (size_t)(row0 + ai * HALF + m * 16) * PBLD + col0;
#pragma unroll
                    for (int bj = 0; bj < 2; ++bj) *(u32x4*)(rowp + bj * HALF) = pk8(acc[ai][bj][m][0], acc[ai][bj][m][1]);
                }
        }
    }
};

struct EpiKV {
    static constexpr bool PERM = true, AFTER_DRAIN = false;
    float* outK; float* outV; bf16_t* KB; bf16_t* VT;
    __device__ __forceinline__ void operator()(const f32x4 (&acc)[2][2][4][2], const Unit& u, int wr, int wc, int fr, int fq) const {
        const int row0 = u.pm * BM + wr * 64 + fr;
        const bool isv = u.pn >= 4;
        const int c0 = (isv ? u.pn - 4 : u.pn) * BM + wc * 32 + 8 * fq;
        float* outp = isv ? outV : outK;
#pragma unroll
        for (int ai = 0; ai < 2; ++ai)
#pragma unroll
            for (int m = 0; m < 4; ++m) {
                const int row = row0 + ai * HALF + m * 16;
#pragma unroll
                for (int bj = 0; bj < 2; ++bj) {
                    const int col = c0 + bj * HALF;
                    const f32x4 a = acc[ai][bj][m][0], b = acc[ai][bj][m][1];
                    *(f32x4*)(outp + (size_t)row * 1024 + col) = a; *(f32x4*)(outp + (size_t)row * 1024 + col + 4) = b;
                    const u32x4 w = pk8(a, b);
                    if (!isv) *(u32x4*)(KB + (size_t)row * 1024 + col) = w;
                    else {
                        bf16_t* vp = VT + (size_t)col * 2048 + row;
                        vp[0 * 2048] = (bf16_t)(w.x & 0xffffu); vp[1 * 2048] = (bf16_t)(w.x >> 16); vp[2 * 2048] = (bf16_t)(w.y & 0xffffu); vp[3 * 2048] = (bf16_t)(w.y >> 16);
                        vp[4 * 2048] = (bf16_t)(w.z & 0xffffu); vp[5 * 2048] = (bf16_t)(w.z >> 16); vp[6 * 2048] = (bf16_t)(w.w & 0xffffu); vp[7 * 2048] = (bf16_t)(w.w >> 16);
                    }
                }
            }
    }
};

__device__ __forceinline__ f32x4 bf4lo(unsigned a, unsigned b) { return (f32x4){__uint_as_float(a << 16), __uint_as_float(a & 0xffff0000u), __uint_as_float(b << 16), __uint_as_float(b & 0xffff0000u)}; }
template <bool BASE_F32> struct EpiRes {
    static constexpr bool PERM = true, AFTER_DRAIN = false;
    const float* basef; const bf16_t* baseb; bf16_t* outb; float* ss;
    __device__ __forceinline__ void operator()(const f32x4 (&acc)[2][2][4][2], const Unit& u, int wr, int wc, int fr, int fq) const {
        const int row0 = u.pm * BM + wr * 64 + fr; const int col0 = u.pn * BM + wc * 32 + 8 * fq;
#pragma unroll
        for (int ai = 0; ai < 2; ++ai) {
            f32x4 pre[4][2][2];
#pragma unroll
            for (int m = 0; m < 4; ++m)
#pragma unroll
                for (int bj = 0; bj < 2; ++bj) { const size_t off = (size_t)(row0 + ai * HALF + m * 16) * 1024 + col0 + bj * HALF;
                    if (BASE_F32) { pre[m][bj][0] = *(const f32x4*)(basef + off); pre[m][bj][1] = *(const f32x4*)(basef + off + 4); }
                    else { const u32x4 w = *(const u32x4*)(baseb + off); pre[m][bj][0] = bf4lo(w.x, w.y); pre[m][bj][1] = bf4lo(w.z, w.w); } }
            __builtin_amdgcn_sched_barrier(0);
#pragma unroll
            for (int m = 0; m < 4; ++m) {
                const int row = row0 + ai * HALF + m * 16; const size_t off = (size_t)row * 1024 + col0;
                float s = 0.f;
#pragma unroll
                for (int bj = 0; bj < 2; ++bj) {
                    const f32x4 v0 = acc[ai][bj][m][0] + pre[m][bj][0], v1 = acc[ai][bj][m][1] + pre[m][bj][1];
                    s += (v0[0] * v0[0] + v0[1] * v0[1]) + (v0[2] * v0[2] + v0[3] * v0[3]) + (v1[0] * v1[0] + v1[1] * v1[1]) + (v1[2] * v1[2] + v1[3] * v1[3]);
                    *(u32x4*)(outb + off + bj * HALF) = pk8(v0, v1);
                }
                s += __shfl_xor(s, 16); s += __shfl_xor(s, 32);
                if (fq == 0) atomicAdd(ss + row, s);
            }
        }
    }
};

struct EpiQ {
    static constexpr bool PERM = true, AFTER_DRAIN = false;
    bf16_t* Q; const float* ss; float c2;
    __device__ __forceinline__ void operator()(const f32x4 (&acc)[2][2][4][2], const Unit& u, int wr, int wc, int fr, int fq) const {
        const int row0 = u.pm * BM + wr * 64 + fr; const int col0 = u.pn * BM + wc * 32 + 8 * fq;
#pragma unroll
        for (int ai = 0; ai < 2; ++ai)
#pragma unroll
            for (int m = 0; m < 4; ++m) {
                const int row = row0 + ai * HALF + m * 16;
                const float rs = __builtin_amdgcn_rsqf(ss[row] * (1.f / 1024.f) + RMS_EPS) * c2;
#pragma unroll
                for (int bj = 0; bj < 2; ++bj) *(u32x4*)(Q + (size_t)row * 1024 + col0 + bj * HALF) = pk8(acc[ai][bj][m][0] * rs, acc[ai][bj][m][1] * rs);
            }
    }
};

struct EpiGU {
    static constexpr bool PERM = true, AFTER_DRAIN = false;
    bf16_t* T; const float* ss;
    __device__ __forceinline__ void operator()(const f32x4 (&acc)[2][2][4][2], const Unit& u, int wr, int wc, int fr, int fq) const {
        const int row0 = u.pm * BM + wr * 64 + fr; const int ch0 = u.pn * 128 + wc * 32 + 8 * fq;
#pragma unroll
        for (int ai = 0; ai < 2; ++ai)
#pragma unroll
            for (int m = 0; m < 4; ++m) {
                const int row = row0 + ai * HALF + m * 16;
                const float rs = __builtin_amdgcn_rsqf(ss[row] * (1.f / 1024.f) + RMS_EPS);
                f32x4 v0, v1;
#pragma unroll
                for (int i = 0; i < 4; ++i) { v0[i] = silu(acc[ai][0][m][0][i] * rs) * (acc[ai][1][m][0][i] * rs); v1[i] = silu(acc[ai][0][m][1][i] * rs) * (acc[ai][1][m][1][i] * rs); }
                *(u32x4*)(T + (size_t)row * 2816 + ch0) = pk8(v0, v1);
            }
    }
};


struct EpiResNorm {
    static constexpr bool PERM = true, AFTER_DRAIN = true;
    const bf16_t* base; float* out; const float* gain; float* xbuf; unsigned* cnt; unsigned* tmo;
    __device__ __forceinline__ void fused(f32x4 (&acc)[2][2][4][2], const Unit& u, int wr, int wc, int fr, int fq, PG8_LAS unsigned char* lds, int wid, int lane) const {
        PG8_LAS float* P = (PG8_LAS float*)lds;
        PG8_LAS float* S = (PG8_LAS float*)(lds + 4096);
        PG8_LAS unsigned* flag = (PG8_LAS unsigned*)(lds + 4096 + 1024);
        const int row0 = u.pm * BM + wr * 64 + fr; const int col0 = u.pn * BM + wc * 32 + 8 * fq;
#pragma unroll
        for (int ai = 0; ai < 2; ++ai) {
            f32x4 pre[4][2][2];
#pragma unroll
            for (int m = 0; m < 4; ++m)
#pragma unroll
                for (int bj = 0; bj < 2; ++bj) { const size_t off = (size_t)(row0 + ai * HALF + m * 16) * 1024 + col0 + bj * HALF; const u32x4 w = *(const u32x4*)(base + off); pre[m][bj][0] = bf4lo(w.x, w.y); pre[m][bj][1] = bf4lo(w.z, w.w); }
            __builtin_amdgcn_sched_barrier(0);
#pragma unroll
            for (int m = 0; m < 4; ++m) {
                float s = 0.f;
#pragma unroll
                for (int bj = 0; bj < 2; ++bj) {
                    const f32x4 v0 = acc[ai][bj][m][0] + pre[m][bj][0], v1 = acc[ai][bj][m][1] + pre[m][bj][1];
                    acc[ai][bj][m][0] = v0; acc[ai][bj][m][1] = v1;
                    s += (v0[0] * v0[0] + v0[1] * v0[1]) + (v0[2] * v0[2] + v0[3] * v0[3]) + (v1[0] * v1[0] + v1[1] * v1[1]) + (v1[2] * v1[2] + v1[3] * v1[3]);
                }
                s += __shfl_xor(s, 16); s += __shfl_xor(s, 32);
                if (fq == 0) P[(ai * HALF + wr * 64 + m * 16 + fr) * 4 + wc] = s;
            }
        }
        asm volatile("s_waitcnt lgkmcnt(0)" ::: "memory"); __builtin_amdgcn_s_barrier(); asm volatile("" ::: "memory");
        const int row = wid * 64 + lane;
        if (wid < 4) {
            const float t = (P[row * 4 + 0] + P[row * 4 + 1]) + (P[row * 4 + 2] + P[row * 4 + 3]);
            __hip_atomic_store(xbuf + (size_t)(u.pm * BM + row) * 4 + u.pn, t, __ATOMIC_RELAXED, __HIP_MEMORY_SCOPE_AGENT);
            asm volatile("s_waitcnt vmcnt(0)" ::: "memory");
            if (lane == 0) __hip_atomic_fetch_add(cnt + 64 * u.pm, 1u, __ATOMIC_RELAXED, __HIP_MEMORY_SCOPE_AGENT);
        }
        if (wid == 0) {
            unsigned spins = 0; bool dead = false;
            while ((unsigned)__builtin_amdgcn_readfirstlane(__hip_atomic_load(cnt + 64 * u.pm, __ATOMIC_RELAXED, __HIP_MEMORY_SCOPE_AGENT)) < 16u) {
                __builtin_amdgcn_s_sleep(2);
                if (++spins > (1u << 22)) { dead = true; if (lane == 0) __hip_atomic_store(tmo, 1u, __ATOMIC_RELAXED, __HIP_MEMORY_SCOPE_AGENT); break; }
            }
            __builtin_amdgcn_fence(__ATOMIC_ACQUIRE, "agent");
            if (lane == 0) flag[0] = dead ? 1u : 0u;
        }
        asm volatile("s_waitcnt vmcnt(0) lgkmcnt(0)" ::: "memory"); __builtin_amdgcn_s_barrier(); asm volatile("" ::: "memory");
        if (wid < 4) {
            const float* sl = xbuf + (size_t)(u.pm * BM + row) * 4; float t = 0.f;
#pragma unroll
            for (int q = 0; q < 4; ++q) t += __hip_atomic_load(sl + q, __ATOMIC_RELAXED, __HIP_MEMORY_SCOPE_AGENT);
            S[row] = __builtin_amdgcn_rsqf(t * (1.f / 1024.f) + RMS_EPS);
        }
        asm volatile("s_waitcnt vmcnt(0) lgkmcnt(0)" ::: "memory"); __builtin_amdgcn_s_barrier(); asm volatile("" ::: "memory");
        f32x4 gv[2][2];
#pragma unroll
        for (int bj = 0; bj < 2; ++bj) { gv[bj][0] = *(const f32x4*)(gain + col0 + bj * HALF); gv[bj][1] = *(const f32x4*)(gain + col0 + bj * HALF + 4); }
#pragma unroll
        for (int ai = 0; ai < 2; ++ai)
#pragma unroll
            for (int m = 0; m < 4; ++m) {
                const int rl = ai * HALF + wr * 64 + m * 16 + fr; const float rs = S[rl]; const size_t off = (size_t)(u.pm * BM + rl) * 1024 + col0;
#pragma unroll
                for (int bj = 0; bj < 2; ++bj) { *(f32x4*)(out + off + bj * HALF) = acc[ai][bj][m][0] * rs * gv[bj][0]; *(f32x4*)(out + off + bj * HALF + 4) = acc[ai][bj][m][1] * rs * gv[bj][1]; }
            }
    }
};

template <class Epi, class Sched, bool ALIGN_EPI = false, bool SP2 = false>
__device__ __forceinline__ void gemm_phase(PG8_LAS unsigned char* lds, const Gemm g, const Sched& S, const Epi& E) {
    const int tid = threadIdx.x, wid = __builtin_amdgcn_readfirstlane(tid >> 6), lane = tid & 63, wr = wid >> 2, wc = wid & 3, fr = lane & 15, fq = lane >> 4;
    const int K = g.K, nt = K / BK;
    unsigned voffA[2], voffB[2];
#pragma unroll
    for (int i = 0; i < 2; ++i) { int R, C; stage_rc(tid * 16 + i * 8192, R, C); const int Rb = Epi::PERM ? ((R & ~31) + perm32(R & 31)) : R;
        voffA[i] = (unsigned)(R * K + C) * 2u; voffB[i] = (unsigned)(Rb * K + C) * 2u; }
    const size_t kstep = (size_t)(BK * 2);
    const size_t hstep = (size_t)HALF * K * 2;
    const size_t tstep = 2 * hstep;
    const unsigned ldsw = (unsigned)wid * 1024u;
    const int aoff = lds_byte(wr * 64 + fr, fq * 8), boff = lds_byte(wc * 32 + fr, fq * 8);
#define PG8_SA(b, h) (((b) * 2 + (h)) * HTB)
#define PG8_SB(b, h) ((4 + (b) * 2 + (h)) * HTB)
#define PG8_STAGE(bufoff, gbase, voff) do { _Pragma("unroll") for (int _i = 0; _i < 2; ++_i) \
        __builtin_amdgcn_global_load_lds((const unsigned*)((const char*)(gbase) + (voff)[_i]), (PG8_LAS unsigned*)(lds + (bufoff) + ldsw + _i * 8192), 16, 0, 0); } while (0)
#define PG8_LDA(dst, b, h) do { _Pragma("unroll") for (int m = 0; m < 4; ++m) _Pragma("unroll") for (int k = 0; k < 2; ++k) dst[m][k] = *(const PG8_LAS bf16x8*)(lds + PG8_SA(b, h) + aoff + m * 2048 + k * 1024); } while (0)
#define PG8_LDB(dst, b, h) do { _Pragma("unroll") for (int n = 0; n < 2; ++n) _Pragma("unroll") for (int k = 0; k < 2; ++k) dst[n][k] = *(const PG8_LAS bf16x8*)(lds + PG8_SB(b, h) + boff + n * 2048 + k * 1024); } while (0)
#define PG8_MMA(ai, bj, At, Bt) do { __builtin_amdgcn_s_setprio(1); _Pragma("unroll") for (int m = 0; m < 4; ++m) _Pragma("unroll") for (int n = 0; n < 2; ++n) _Pragma("unroll") for (int k = 0; k < 2; ++k) \
        acc[ai][bj][m][n] = __builtin_amdgcn_mfma_f32_16x16x32_bf16(Bt[n][k], At[m][k], acc[ai][bj][m][n], 0, 0, 0); __builtin_amdgcn_s_setprio(0); } while (0)
#define PG8_WAIT_V(n) asm volatile("s_waitcnt vmcnt(" #n ")" ::: "memory")
#define PG8_WAIT_L(n) asm volatile("s_waitcnt lgkmcnt(" #n ")" ::: "memory")
#define PG8_BAR __builtin_amdgcn_s_barrier()
#define PG8_SCHED __builtin_amdgcn_sched_barrier(0)
    Unit cur, nxt; int ui = 0;
    if (!S.next(0, cur)) return;
    f32x4 acc[2][2][4][2];
#pragma unroll
    for (int a = 0; a < 2; ++a)
#pragma unroll
        for (int b = 0; b < 2; ++b)
#pragma unroll
            for (int m = 0; m < 4; ++m)
#pragma unroll
                for (int n = 0; n < 2; ++n) acc[a][b][m][n] = (f32x4){0.f, 0.f, 0.f, 0.f};
    bf16x8 At[4][2], B0[2][2], B1[2][2];
    const char* cA = (const char*)g.A + (size_t)cur.pm * tstep; const char* cB = (const char*)g.Bt + (size_t)cur.pn * tstep;
    S.a_ready(cur);
    if constexpr (SP2) {
        PG8_STAGE(PG8_SB(0, 0), cB, voffB); PG8_STAGE(PG8_SB(0, 1), cB + hstep, voffB); PG8_STAGE(PG8_SA(0, 0), cA, voffA); PG8_STAGE(PG8_SA(0, 1), cA + hstep, voffA);
        if (wr == 1) PG8_BAR;
        PG8_WAIT_V(2); PG8_BAR;
        PG8_STAGE(PG8_SB(1, 0), cB + kstep, voffB); PG8_STAGE(PG8_SA(1, 0), cA + kstep, voffA); PG8_STAGE(PG8_SB(1, 1), cB + hstep + kstep, voffB);
        PG8_WAIT_V(6); PG8_BAR;
    } else {
        PG8_STAGE(PG8_SB(0, 0), cB, voffB); PG8_STAGE(PG8_SA(0, 0), cA, voffA); PG8_STAGE(PG8_SB(0, 1), cB + hstep, voffB); PG8_STAGE(PG8_SA(0, 1), cA + hstep, voffA);
        if (wr == 1) PG8_BAR;
        PG8_WAIT_V(4); PG8_BAR;
        PG8_STAGE(PG8_SB(1, 0), cB + kstep, voffB); PG8_STAGE(PG8_SA(1, 0), cA + kstep, voffA); PG8_STAGE(PG8_SB(1, 1), cB + hstep + kstep, voffB);
        PG8_WAIT_V(6); PG8_BAR;
    }
    for (;;) {
        const bool has_next = S.next(ui + 1, nxt);
        const char* nA = has_next ? (const char*)g.A + (size_t)nxt.pm * tstep : cA; const char* nB = has_next ? (const char*)g.Bt + (size_t)nxt.pn * tstep : cB;
        for (int t = 0; t < nt; t += 2) {
            const bool last = (t == nt - 2);
            const char* a1 = cA + (size_t)(t + 1) * kstep;
            const char* a2 = last ? nA : cA + (size_t)(t + 2) * kstep; const char* b2 = last ? nB : cB + (size_t)(t + 2) * kstep;
            const char* a3 = a2 + kstep; const char* b3 = b2 + kstep;
            if (last && has_next) S.a_ready(nxt);
            if constexpr (SP2) {
            PG8_LDB(B0, 0, 0); PG8_LDB(B1, 0, 1); PG8_SCHED; PG8_LDA(At, 0, 0); PG8_STAGE(PG8_SA(1, 1), a1 + hstep, voffA);
            PG8_WAIT_V(8); PG8_WAIT_L(0); PG8_BAR; PG8_MMA(0, 0, At, B0); PG8_MMA(0, 1, At, B1); PG8_BAR; PG8_SCHED;
            PG8_LDA(At, 0, 1); PG8_STAGE(PG8_SB(0, 0), b2, voffB); PG8_STAGE(PG8_SB(0, 1), b2 + hstep, voffB); PG8_STAGE(PG8_SA(0, 0), a2, voffA);
            PG8_WAIT_V(8); PG8_WAIT_L(0); PG8_BAR; PG8_MMA(1, 0, At, B0); PG8_MMA(1, 1, At, B1); PG8_BAR; PG8_SCHED;
            PG8_LDB(B0, 1, 0); PG8_LDB(B1, 1, 1); PG8_SCHED; PG8_LDA(At, 1, 0); PG8_STAGE(PG8_SA(0, 1), a2 + hstep, voffA);
            PG8_WAIT_V(8); PG8_WAIT_L(0); PG8_BAR; PG8_MMA(0, 0, At, B0); PG8_MMA(0, 1, At, B1); PG8_BAR; PG8_SCHED;
            PG8_LDA(At, 1, 1); PG8_STAGE(PG8_SB(1, 0), b3, voffB); PG8_STAGE(PG8_SB(1, 1), b3 + hstep, voffB); PG8_STAGE(PG8_SA(1, 0), a3, voffA);
            PG8_WAIT_V(8); PG8_WAIT_L(0); PG8_BAR; PG8_MMA(1, 0, At, B0); PG8_MMA(1, 1, At, B1); PG8_BAR; PG8_SCHED;
            } else {
            PG8_LDB(B0, 0, 0); PG8_SCHED; PG8_LDA(At, 0, 0); PG8_STAGE(PG8_SA(1, 1), a1 + hstep, voffA);
            PG8_WAIT_L(8); PG8_BAR; PG8_WAIT_L(0); PG8_MMA(0, 0, At, B0); PG8_BAR; PG8_SCHED;
            PG8_LDB(B1, 0, 1); PG8_STAGE(PG8_SB(0, 0), b2, voffB);
            PG8_BAR; PG8_WAIT_L(0); PG8_MMA(0, 1, At, B1); PG8_BAR;
            PG8_LDA(At, 0, 1); PG8_STAGE(PG8_SA(0, 0), a2, voffA);
            PG8_BAR; PG8_WAIT_L(0); PG8_MMA(1, 0, At, B0); PG8_BAR; PG8_SCHED;
            PG8_STAGE(PG8_SB(0, 1), b2 + hstep, voffB);
            PG8_WAIT_V(6); PG8_BAR; PG8_MMA(1, 1, At, B1); PG8_BAR;
            PG8_LDB(B0, 1, 0); PG8_SCHED; PG8_LDA(At, 1, 0); PG8_STAGE(PG8_SA(0, 1), a2 + hstep, voffA);
            PG8_WAIT_L(8); PG8_BAR; PG8_WAIT_L(0); PG8_MMA(0, 0, At, B0); PG8_BAR; PG8_SCHED;
            PG8_LDB(B1, 1, 1); PG8_STAGE(PG8_SB(1, 0), b3, voffB);
            PG8_BAR; PG8_WAIT_L(0); PG8_MMA(0, 1, At, B1); PG8_BAR;
            PG8_LDA(At, 1, 1); PG8_STAGE(PG8_SA(1, 0), a3, voffA);
            PG8_BAR; PG8_WAIT_L(0); PG8_MMA(1, 0, At, B0); PG8_BAR; PG8_SCHED;
            PG8_STAGE(PG8_SB(1, 1), b3 + hstep, voffB);
            PG8_WAIT_V(6); PG8_BAR; PG8_MMA(1, 1, At, B1); PG8_BAR;
            }
        }
        if constexpr (ALIGN_EPI) { if (wr == 0) PG8_BAR; }
        if constexpr (!Epi::AFTER_DRAIN) { E(acc, cur, wr, wc, fr, fq); S.done(cur); }
        if (!has_next) break;
#pragma unroll
        for (int a = 0; a < 2; ++a)
#pragma unroll
            for (int b = 0; b < 2; ++b)
#pragma unroll
                for (int m = 0; m < 4; ++m)
#pragma unroll
                    for (int n = 0; n < 2; ++n) acc[a][b][m][n] = (f32x4){0.f, 0.f, 0.f, 0.f};
        cur = nxt; cA = nA; cB = nB; ++ui;
        if constexpr (ALIGN_EPI) { if (wr == 1) PG8_BAR; }
    }
    PG8_WAIT_V(0);
    if constexpr (!ALIGN_EPI) { if (wr == 0) PG8_BAR; }
    PG8_BAR;
    if constexpr (Epi::AFTER_DRAIN) { E.fused(acc, cur, wr, wc, fr, fq, lds, wid, lane); S.done(cur); }
#undef PG8_SA
#undef PG8_SB
#undef PG8_STAGE
#undef PG8_LDA
#undef PG8_LDB
#undef PG8_MMA
#undef PG8_WAIT_V
#undef PG8_WAIT_L
#undef PG8_BAR
#undef PG8_SCHED
}
}

constexpr int NWAVES = 8;
#ifndef MK_PER_PHASE
#define MK_PER_PHASE 0
#endif
constexpr int N_PHASES = 10;

constexpr int DM = 1024, NB = 8, SEQ = 2048, MP = NB * SEQ  , DEC = 128, MV = MP + DEC  , MR = 16640  ;
constexpr int CC = 512, CW = 31, NH = 4, DKV = 128, QKVN = 1536, NMEM = 256, MHD = 256, DFF = 2816, INC = 3080;
constexpr int PBLD = pg8::PBLD;
constexpr int NCHUNK = NB * NH * 32;
constexpr float RMS_EPS = 1e-6f;
constexpr float ATT_C2 = 0.0625f * 1.4426950408889634f;

constexpr size_t OUT_YP = 0, OUT_YS = 16777216, OUT_CONVP = 16908288, OUT_SCP = 17031168, OUT_DLP = 17068032, OUT_MKP = 17592320, OUT_MVP = 19689472,
                 OUT_CONVS = 21786624, OUT_SCS = 23752704, OUT_DLS = 24342528, OUT_END = 32731136;

constexpr size_t MiB = 1u << 20;
constexpr size_t WS_CTL = 0, CTL_ZERO_BYTES = 1 * MiB;
constexpr size_t WS_WIN = 1 * MiB, WS_WOUT = 7 * MiB, WS_WMQ = 9 * MiB, WS_WMKV = 11 * MiB, WS_WMO = 15 * MiB, WS_WGU = 17 * MiB, WS_WDN = 28 * MiB;
constexpr size_t WS_BG = 34 * MiB, WS_MEMN = 35 * MiB, WS_KB = 39 * MiB, WS_VT = 43 * MiB, WS_GL = 47 * MiB, WS_X1S = 47 * MiB + 65536, WS_XBUF = 47 * MiB + 655360;
constexpr size_t WS_RA = 48 * MiB;
constexpr size_t WS_RB = 138 * MiB;
constexpr size_t WS_RC = 171 * MiB;
constexpr size_t WS_RD = 220 * MiB;
constexpr size_t WS_U = WS_RD, WS_W = 252 * MiB, WS_QG = 268 * MiB, WS_KDT = 284 * MiB, WS_QK = 300 * MiB;
constexpr size_t WS_RE = 308 * MiB;
constexpr size_t WS_RF = 341 * MiB;
constexpr size_t WS_END = 406 * MiB;
constexpr int CW_TMO = 0, CW_CODE = 1, CW_BAR = 4096, CW_SS1 = 65536, CW_SS2 = 98304, CW_SS3 = 131072, CW_PANEL = 200000;

constexpr int RING_OFF = 0, RING_BYTES = 143360;
constexpr int LDSCTL_OFF = RING_BYTES, MISC_OFF = LDSCTL_OFF + 320;
constexpr int LDS_BYTES = 147456;

#define GAS __attribute__((address_space(1)))
#define LAS __attribute__((address_space(3)))
typedef unsigned short bf16;
typedef unsigned v4u __attribute__((ext_vector_type(4)));
typedef unsigned v2u __attribute__((ext_vector_type(2)));
typedef float f32x4 __attribute__((ext_vector_type(4)));
typedef float f32x16 __attribute__((ext_vector_type(16)));
typedef short bf16x8 __attribute__((ext_vector_type(8)));
typedef GAS unsigned gu32;
#define RLX_AGENT __ATOMIC_RELAXED, __HIP_MEMORY_SCOPE_AGENT
#define LDS_WAIT() asm volatile("s_waitcnt lgkmcnt(0)" ::: "memory")
#define VM_WAIT() asm volatile("s_waitcnt vmcnt(0)" ::: "memory")
using pg8::pk2; using pg8::silu; using pg8::sigm;
__device__ __forceinline__ float bf2f(unsigned b) { return __uint_as_float(b << 16); }
__device__ __forceinline__ float bflo(unsigned w) { return __uint_as_float(w << 16); }
__device__ __forceinline__ float bfhi(unsigned w) { return __uint_as_float(w & 0xffff0000u); }
__device__ __forceinline__ void unpack8(const v4u& w, float (&f)[8]) { f[0] = bflo(w.x); f[1] = bfhi(w.x); f[2] = bflo(w.y); f[3] = bfhi(w.y); f[4] = bflo(w.z); f[5] = bfhi(w.z); f[6] = bflo(w.w); f[7] = bfhi(w.w); }
__device__ __forceinline__ v4u pack8(const float (&f)[8]) { v4u w; w.x = pk2(f[0], f[1]); w.y = pk2(f[2], f[3]); w.z = pk2(f[4], f[5]); w.w = pk2(f[6], f[7]); return w; }
template <int CTRL> __device__ __forceinline__ float dppf(float v) { return __int_as_float(__builtin_amdgcn_update_dpp(0, __float_as_int(v), CTRL, 0xf, 0xf, true)); }
__device__ __forceinline__ float row16_sum(float v) { v += dppf<0xB1>(v); v += dppf<0x4E>(v); v += dppf<0x141>(v); v += dppf<0x140>(v); return v; }
__device__ __forceinline__ float row16_max(float v) { v = fmaxf(v, dppf<0xB1>(v)); v = fmaxf(v, dppf<0x4E>(v)); v = fmaxf(v, dppf<0x141>(v)); v = fmaxf(v, dppf<0x140>(v)); return v; }
__device__ __forceinline__ float rdl(float v, int l) { return __int_as_float(__builtin_amdgcn_readlane(__float_as_int(v), l)); }
__device__ __forceinline__ float wave_sum(float v) { v = row16_sum(v); return (rdl(v, 0) + rdl(v, 16)) + (rdl(v, 32) + rdl(v, 48)); }
__device__ __forceinline__ float wave_max(float v) { v = row16_max(v); return fmaxf(fmaxf(rdl(v, 0), rdl(v, 16)), fmaxf(rdl(v, 32), rdl(v, 48))); }

#define XB_TMO      128
#define XB_XCNT(j)  (256  + 64 * (j))
#define XB_XSUB(j)  (1280 + 64 * (j))
#define XB_XGEN(j)  (2304 + 64 * (j))
#define XB_TOP      3328
#define XB_TOPGEN   3392
#define XCD_BAR_WORDS 3456
#define XB_SPIN_CAP (1u << 18)

__device__ __forceinline__ unsigned xb_ld(unsigned* p)              { return __hip_atomic_load(p, __ATOMIC_RELAXED, __HIP_MEMORY_SCOPE_AGENT); }
__device__ __forceinline__ unsigned xb_add(unsigned* p, unsigned v) { return __hip_atomic_fetch_add(p, v, __ATOMIC_RELAXED, __HIP_MEMORY_SCOPE_AGENT); }
__device__ __forceinline__ unsigned xb_xcc_id() { return (unsigned)__builtin_amdgcn_s_getreg((3 << 11) | 20) & 0xFu; }
#define XB_SPIN(cond, bar) do { unsigned _sp = 0; while (cond) { __builtin_amdgcn_s_sleep(1); \
    if ((++_sp & 255u) == 0u) { if (xb_ld(&(bar)[XB_TMO])) break; if (_sp > XB_SPIN_CAP) { atomicAdd(&(bar)[XB_TMO], 1u); break; } } } } while (0)

struct XcdBarrier {
    unsigned* bar; unsigned x;
    volatile LAS unsigned* st;
};

__device__ __forceinline__ XcdBarrier xcd_barrier_post(unsigned* bar, volatile LAS unsigned* st) {
    XcdBarrier b; b.bar = bar; b.x = xb_xcc_id(); b.st = st;
    if (threadIdx.x == 0) (void)xb_add(&bar[XB_XCNT(b.x)], 1u);
    return b;
}
__device__ __forceinline__ void xcd_barrier_complete(unsigned* bar, unsigned x, unsigned& nloc, unsigned& nx) {
    const unsigned G = gridDim.x * gridDim.y * gridDim.z;
    unsigned sum, cnt, mine, sp = 0u;
    for (;;) {
        sum = 0u; cnt = 0u; mine = 0u;
#pragma unroll
        for (unsigned j = 0; j < 16; ++j) { const unsigned c = xb_ld(&bar[XB_XCNT(j)]); sum += c; cnt += (c > 0u) ? 1u : 0u; mine = (j == x) ? c : mine; }
        if (sum == G) break;
        __builtin_amdgcn_s_sleep(1);
        if ((++sp & 255u) == 0u) { if (xb_ld(&bar[XB_TMO])) break; if (sp > XB_SPIN_CAP) { atomicAdd(&bar[XB_TMO], 1u); break; } }
    }
    nloc = mine > 0u ? mine : 1u; nx = cnt > 0u ? cnt : 1u;
}

__device__ __forceinline__ void xcd_barrier(const XcdBarrier& b) {
    asm volatile("s_waitcnt vmcnt(0)" ::: "memory");
    __syncthreads();
    if (threadIdx.x == 0) {
        unsigned* bar = b.bar;
        __builtin_amdgcn_s_waitcnt(0);
        unsigned nloc = b.st[0], nx = b.st[1];
        if (nloc == 0u) { xcd_barrier_complete(bar, b.x, nloc, nx); b.st[0] = nloc; b.st[1] = nx; }
        const unsigned old = xb_add(&bar[XB_XSUB(b.x)], 1u);
        const unsigned gen = old / nloc;
        if (old + 1u == (gen + 1u) * nloc) {
            __builtin_amdgcn_fence(__ATOMIC_RELEASE, "agent");
            asm volatile("s_waitcnt vmcnt(0)" ::: "memory");
            const unsigned og = xb_add(&bar[XB_TOP], 1u);
            const unsigned tg = og / nx;
            if (og + 1u == (tg + 1u) * nx) xb_add(&bar[XB_TOPGEN], 1u);
            else XB_SPIN(xb_ld(&bar[XB_TOPGEN]) == tg, bar);
            __builtin_amdgcn_fence(__ATOMIC_ACQUIRE, "agent");
            xb_add(&bar[XB_XGEN(b.x)], 1u);
            asm volatile("s_waitcnt vmcnt(0)" ::: "memory");
        } else {
            XB_SPIN(xb_ld(&bar[XB_XGEN(b.x)]) == gen, bar);
            __builtin_amdgcn_fence(__ATOMIC_ACQUIRE, "agent");
            asm volatile("s_waitcnt vmcnt(0)" ::: "memory");
        }
    }
    __syncthreads();
}

struct Args { const float* in[30]; float* out; unsigned char* ws; int ph_lo, ph_hi, li, pad; };
struct Frame {
    LAS unsigned char* lds;
    volatile LAS unsigned* MISC;
    gu32* ctl;
    int tid, lane, wave;
    int vcu, G;
};
enum { I_XP = 0, I_XS, I_MEM, I_CCONV, I_SSC, I_SDELTA, I_CMK, I_CMV, I_NMIX, I_WIN, I_CONVW, I_CONVB, I_LNG, I_LNB, I_SCW, I_ALOG, I_DTB, I_DNN, I_WOUT,
       I_NMQ, I_NMKV, I_WMQ, I_WMK, I_WMV, I_WMO, I_NFFN, I_WG, I_WU, I_WD, I_NF };

struct TrJob { const float* W; const float* gain; bf16* WT; int ldw, k0, c0, K, r0; };
__device__ __forceinline__ void tr_load(const TrJob& j, int lane, f32x4 (&v)[8]) {
    const float* p = j.W + (size_t)(j.k0 + (lane >> 3)) * j.ldw + j.c0 + (lane & 7) * 4;
#pragma unroll
    for (int i = 0; i < 8; ++i) v[i] = *(const GAS f32x4*)(p + (size_t)(8 * i) * j.ldw);
}
__device__ __forceinline__ void tr_finish(const TrJob& j, const f32x4 (&v)[8], LAS float* scr, int lane) {
#pragma unroll
    for (int i = 0; i < 8; ++i) { LAS float* d = scr + (8 * i + (lane >> 3)) * 33 + (lane & 7) * 4; d[0] = v[i][0]; d[1] = v[i][1]; d[2] = v[i][2]; d[3] = v[i][3]; }
    LDS_WAIT(); asm volatile("" ::: "memory");
    const int c = lane & 7;
    float gv[8];
#pragma unroll
    for (int i = 0; i < 8; ++i) gv[i] = j.gain ? j.gain[j.k0 + 8 * c + i] : 1.f;
#pragma unroll
    for (int q = 0; q < 4; ++q) { const int n = (lane >> 3) + 8 * q; const LAS float* s = scr + (8 * c) * 33 + n;
        v4u o; o.x = pk2(s[0 * 33] * gv[0], s[1 * 33] * gv[1]); o.y = pk2(s[2 * 33] * gv[2], s[3 * 33] * gv[3]); o.z = pk2(s[4 * 33] * gv[4], s[5 * 33] * gv[5]); o.w = pk2(s[6 * 33] * gv[6], s[7 * 33] * gv[7]);
        *(GAS v4u*)(j.WT + (size_t)(j.r0 + n) * j.K + j.k0 + 8 * c) = o; }
    LDS_WAIT(); asm volatile("" ::: "memory");
}
__device__ __forceinline__ float softplusf_(float x) { return x > 20.f ? x : log1pf(__expf(x)); }

constexpr int TR_IA = 96 * 16, TR_IB = 32 * 16, TR_ID = 64 * 16, TR_IF = 176 * 16, TR_IG = 32 * 44, TR_N1 = TR_IA + TR_IB + TR_ID, TR_N = TR_N1 + TR_IB + TR_IB + TR_IF + TR_IG;
__device__ __forceinline__ void weights_phase(const Args& A, Frame& F, int first, int last, int w, int nw) {
    LAS float* scr = (LAS float*)(F.lds + RING_OFF + F.wave * 8448);
    unsigned char* ws = A.ws;
    const float* const pWMK = A.in[I_WMK]; const float* const pWMV = A.in[I_WMV]; const float* const pWG = A.in[I_WG]; const float* const pWU = A.in[I_WU];
    const float* const pWIN = A.in[I_WIN]; const float* const pWOUT = A.in[I_WOUT]; const float* const pWMQ = A.in[I_WMQ]; const float* const pWMO = A.in[I_WMO]; const float* const pWD = A.in[I_WD];
    const float* const pNMQ = A.in[I_NMQ]; const float* const pNFFN = A.in[I_NFFN];
#define TR_DECODE(J, IT) do { int r = (IT); \
        if (r < TR_IA) { const int nb = r % 96, kb = r / 96, j0 = 32 * nb; int src = j0; \
            if (j0 < 1024) { const int tile = j0 >> 8, local = j0 & 255; src = local < 128 ? 128 * tile + local : 512 + 128 * tile + (local - 128); } \
            J = TrJob{pWIN, nullptr, (bf16*)(ws + WS_WIN), INC, 64 * kb, src, DM, j0}; break; } r -= TR_IA; \
        if (r < TR_IB) { const int nb = r % 32, kb = r / 32; J = TrJob{pWOUT, nullptr, (bf16*)(ws + WS_WOUT), DM, 64 * kb, 32 * nb, DM, 32 * nb}; break; } r -= TR_IB; \
        if (r < TR_ID) { const int nb = r % 64, kb = r / 64, j0 = 32 * nb; const bool isv = j0 >= 1024; \
            J = TrJob{isv ? pWMV : pWMK, nullptr, (bf16*)(ws + WS_WMKV), DM, 64 * kb, isv ? j0 - 1024 : j0, DM, j0}; break; } r -= TR_ID; \
        if (r < TR_IB) { const int nb = r % 32, kb = r / 32; J = TrJob{pWMQ, pNMQ, (bf16*)(ws + WS_WMQ), DM, 64 * kb, 32 * nb, DM, 32 * nb}; break; } r -= TR_IB; \
        if (r < TR_IB) { const int nb = r % 32, kb = r / 32; J = TrJob{pWMO, nullptr, (bf16*)(ws + WS_WMO), DM, 64 * kb, 32 * nb, DM, 32 * nb}; break; } r -= TR_IB; \
        if (r < TR_IF) { const int nb = r % 176, kb = r / 176, j0 = 32 * nb, tile = j0 >> 8, local = j0 & 255; const bool up = local >= 128; \
            J = TrJob{up ? pWU : pWG, pNFFN, (bf16*)(ws + WS_WGU), DFF, 64 * kb, 128 * tile + (up ? local - 128 : local), DM, j0}; break; } r -= TR_IF; \
        { const int nb = r % 32, kb = r / 32; J = TrJob{pWD, nullptr, (bf16*)(ws + WS_WDN), DM, 64 * kb, 32 * nb, DFF, 32 * nb}; } } while (0)
    TrJob jc, jn; f32x4 vc[8], vn[8];
    int it = first + w;
    if (it < last) { TR_DECODE(jc, it); tr_load(jc, F.lane, vc); }
#pragma unroll 1
    for (; it < last; it += nw) {
        const int itn = it + nw;
        if (itn < last) { TR_DECODE(jn, itn); tr_load(jn, F.lane, vn); }
        tr_finish(jc, vc, scr, F.lane);
        jc = jn;
#pragma unroll
        for (int i = 0; i < 8; ++i) vc[i] = vn[i];
    }
#undef TR_DECODE
}
__device__ __forceinline__ void p0_prologue(const Args& A, Frame& F) {
    const int gw = F.vcu * NWAVES + F.wave, NGW = F.G * NWAVES;
    unsigned char* ws = A.ws;
    const float* const pXP = A.in[I_XP]; const float* const pXS = A.in[I_XS];
    weights_phase(A, F, 0, TR_N1, gw, NGW);
    {
        bf16* H = (bf16*)(ws + WS_RB); float* BG = (float*)(ws + WS_BG);
        const float* win = A.in[I_WIN]; const float* gain = A.in[I_NMIX];
        float w8[4][4][8];
#pragma unroll
        for (int j = 0; j < 4; ++j)
#pragma unroll
            for (int i = 0; i < 4; ++i) { const int k = 256 * j + 4 * F.lane + i; const f32x4 a = *(const f32x4*)(win + (size_t)k * INC + 3072), b = *(const f32x4*)(win + (size_t)k * INC + 3076);
                w8[j][i][0] = a[0]; w8[j][i][1] = a[1]; w8[j][i][2] = a[2]; w8[j][i][3] = a[3]; w8[j][i][4] = b[0]; w8[j][i][5] = b[1]; w8[j][i][6] = b[2]; w8[j][i][7] = b[3]; }
        f32x4 gn[4];
#pragma unroll
        for (int j = 0; j < 4; ++j) gn[j] = *(const f32x4*)(gain + 256 * j + 4 * F.lane);
        const f32x4 alog4 = *(const f32x4*)A.in[I_ALOG], dtb4 = *(const f32x4*)A.in[I_DTB];
        const bool hi5 = (F.lane & 32) != 0, b4 = (F.lane & 16) != 0, b3 = (F.lane & 8) != 0; const int cidx = (hi5 ? 4 : 0) + (b4 ? 2 : 0) + (b3 ? 1 : 0), c3 = cidx & 3;
        const float myea = expf(c3 == 0 ? alog4[0] : c3 == 1 ? alog4[1] : c3 == 2 ? alog4[2] : alog4[3]);
        const float mydtb = (cidx < 4) ? 0.f : (c3 == 0 ? dtb4[0] : c3 == 1 ? dtb4[1] : c3 == 2 ? dtb4[2] : dtb4[3]);
        f32x4 v[4], nv[4];
        { const int m0 = gw; if (m0 < MV) { const GAS f32x4* xr = (const GAS f32x4*)((m0 < MP) ? pXP + (size_t)m0 * DM : pXS + (size_t)(m0 - MP) * DM) + F.lane;
#pragma unroll
            for (int j = 0; j < 4; ++j) v[j] = xr[64 * j]; } }
#pragma unroll 1
        for (int m = gw; m < MR; m += NGW) {
            GAS unsigned long long* o8 = (GAS unsigned long long*)(H + (size_t)m * DM) + F.lane;
            { const int mn = m + NGW; if (mn < MV) { const GAS f32x4* xr = (const GAS f32x4*)((mn < MP) ? pXP + (size_t)mn * DM : pXS + (size_t)(mn - MP) * DM) + F.lane;
#pragma unroll
                for (int j = 0; j < 4; ++j) nv[j] = xr[64 * j]; } }
            if (m >= MV) {
#pragma unroll
                for (int j = 0; j < 4; ++j) o8[64 * j] = 0ull;
                if (F.lane < 8) BG[(size_t)m * 8 + F.lane] = 0.f;
                continue;
            }
            float s2 = 0.f;
#pragma unroll
            for (int j = 0; j < 4; ++j) s2 += (v[j][0] * v[j][0] + v[j][1] * v[j][1]) + (v[j][2] * v[j][2] + v[j][3] * v[j][3]);
            const float rstd = 1.f / sqrtf(wave_sum(s2) * (1.f / DM) + RMS_EPS);
            float p8[8];
#pragma unroll
            for (int c = 0; c < 8; ++c) p8[c] = 0.f;
#pragma unroll
            for (int j = 0; j < 4; ++j) { v[j] = v[j] * rstd * gn[j];
#pragma unroll
                for (int i = 0; i < 4; ++i)
#pragma unroll
                    for (int c = 0; c < 8; ++c) p8[c] += v[j][i] * w8[j][i][c];
                o8[64 * j] = (unsigned long long)pk2(v[j][0], v[j][1]) | ((unsigned long long)pk2(v[j][2], v[j][3]) << 32); }
            float z;
            { float r4[4], q2[2];
#pragma unroll
              for (int i = 0; i < 4; ++i) { const float send = hi5 ? p8[i] : p8[4 + i], keep = hi5 ? p8[4 + i] : p8[i]; r4[i] = keep + __shfl_xor(send, 32); }
#pragma unroll
              for (int i = 0; i < 2; ++i) { const float send = b4 ? r4[i] : r4[2 + i], keep = b4 ? r4[2 + i] : r4[i]; q2[i] = keep + __shfl_xor(send, 16); }
              { const float send = b3 ? q2[0] : q2[1], keep = b3 ? q2[1] : q2[0]; z = keep + __shfl_xor(send, 8); }
              z += dppf<0xB1>(z); z += dppf<0x4E>(z); z += dppf<0x141>(z); }
            { const float xs = z + mydtb;
              const float sp = xs > 20.f ? xs : (xs < -15.f ? __expf(xs) : __logf(1.f + __expf(xs)));
              const float val = (cidx < 4) ? __builtin_amdgcn_rcpf(1.f + __expf(-z)) : -myea * sp;
              if ((F.lane & 7) == 0) BG[(size_t)m * 8 + cidx] = val; }
#pragma unroll
            for (int j = 0; j < 4; ++j) v[j] = nv[j];
        }
    }
    {
        bf16* MN = (bf16*)(ws + WS_MEMN); const float* gain = A.in[I_NMKV];
        f32x4 gn[4];
#pragma unroll
        for (int j = 0; j < 4; ++j) gn[j] = *(const f32x4*)(gain + 256 * j + 4 * F.lane);
        for (int m = gw; m < NB * NMEM; m += NGW) {
            const GAS f32x4* xr = (const GAS f32x4*)(A.in[I_MEM] + (size_t)m * DM) + F.lane;
            f32x4 v[4]; float s2 = 0.f;
#pragma unroll
            for (int j = 0; j < 4; ++j) { v[j] = xr[64 * j]; s2 += (v[j][0] * v[j][0] + v[j][1] * v[j][1]) + (v[j][2] * v[j][2] + v[j][3] * v[j][3]); }
            const float rstd = 1.f / sqrtf(wave_sum(s2) * (1.f / DM) + RMS_EPS);
            GAS unsigned long long* o8 = (GAS unsigned long long*)(MN + (size_t)m * DM) + F.lane;
#pragma unroll
            for (int j = 0; j < 4; ++j) { v[j] = v[j] * rstd * gn[j]; o8[64 * j] = (unsigned long long)pk2(v[j][0], v[j][1]) | ((unsigned long long)pk2(v[j][2], v[j][3]) << 32); }
        }
    }
}

typedef float f32x2v __attribute__((ext_vector_type(2)));
__device__ __forceinline__ void short_conv_part(const Args& A, Frame& F, int b, int t0, int p, int oz) {
    const bf16* PB = (const bf16*)(A.ws + WS_RA); bf16* QC = (bf16*)(A.ws + WS_RC);
    __builtin_amdgcn_sched_barrier(0);
    const int ch0 = 512 * p + 8 * F.lane + oz;
    float wsc[4][8];
#pragma unroll
    for (int j = 0; j < 4; ++j) { const f32x4 a = *(const f32x4*)(A.in[I_SCW] + j * QKVN + ch0), bb = *(const f32x4*)(A.in[I_SCW] + j * QKVN + ch0 + 4);
#pragma unroll
        for (int i = 0; i < 4; ++i) { wsc[j][i] = a[i]; wsc[j][4 + i] = bb[i]; } }
    float win[3][8];
#pragma unroll
    for (int j = 0; j < 3; ++j) { const int tk = t0 - 3 + j; const int tkc = tk < 0 ? 0 : tk;
        const v4u x = *(const GAS v4u*)(PB + (size_t)(b * SEQ + tkc) * PBLD + 512 + ch0); unpack8(x, win[j]);
#pragma unroll
        for (int i = 0; i < 8; ++i) win[j][i] = (tk >= 0) ? win[j][i] : 0.f; }
#pragma unroll
    for (int tt = 0; tt < 8; ++tt) {
        float cur[8]; { const v4u x = *(const GAS v4u*)(PB + (size_t)(b * SEQ + t0 + tt) * PBLD + 512 + ch0); unpack8(x, cur); }
        float y[8]; float ss = 0.f;
#pragma unroll
        for (int i = 0; i < 8; ++i) { const float a = wsc[0][i] * win[0][i] + wsc[1][i] * win[1][i] + wsc[2][i] * win[2][i] + wsc[3][i] * cur[i]; y[i] = silu(a); ss += y[i] * y[i]; }
        if (p < 2) { ss = row16_sum(ss);
            const float sc = __builtin_amdgcn_rsqf(ss + 1e-6f) * (p == 0 ? 0.08838834764831845f : 1.f);
#pragma unroll
            for (int i = 0; i < 8; ++i) y[i] *= sc; }
        *(GAS v4u*)(QC + (size_t)(b * SEQ + t0 + tt) * QKVN + ch0) = pack8(y);
#pragma unroll
        for (int i = 0; i < 8; ++i) { win[0][i] = win[1][i]; win[1][i] = win[2][i]; win[2][i] = cur[i]; }
    }
}
__device__ __forceinline__ void short_conv_tile(const Args& A, Frame& F, int b, int tile) {
    const bf16* PB = (const bf16*)(A.ws + WS_RA);
    int oz; asm volatile("v_mov_b32 %0, 0" : "=v"(oz));
#pragma unroll 1
    for (int p = 0; p < 3; ++p) short_conv_part(A, F, b, tile * 64 + 8 * F.wave, p, oz);
    if (tile == 31) {
        float* os = A.out + OUT_SCP + (size_t)b * 3 * QKVN;
        float sv[9];
#pragma unroll
        for (int q = 0; q < 9; ++q) { const int e = F.tid + q * (NWAVES * 64); const int j = e / QKVN, ch = e % QKVN; sv[q] = bf2f(PB[(size_t)(b * SEQ + SEQ - 3 + j) * PBLD + 512 + ch]); }
        __builtin_amdgcn_sched_barrier(0);
#pragma unroll
        for (int q = 0; q < 9; ++q) os[F.tid + q * (NWAVES * 64)] = sv[q];
    }
}
__device__ __forceinline__ void conv31_tile(const Args& A, Frame& F, int b, int tile) {
    const bf16* PB = (const bf16*)(A.ws + WS_RA); bf16* CD = (bf16*)(A.ws + WS_RB);
    int oz; asm volatile("v_mov_b32 %0, 0" : "=v"(oz));
    const int row0 = b * SEQ + tile * 64;
    LAS float* Y = (LAS float*)(F.lds + RING_OFF);
    {
        const unsigned rb = (unsigned)(b * SEQ + tile * 64);
        const int c = F.tid + oz;
        float w[CW];
#pragma unroll
        for (int j = 0; j < CW; ++j) w[j] = A.in[I_CONVW][j * CC + c];
        const float bias = A.in[I_CONVB][c];
        float u[38]; float nx[8];
#pragma unroll
        for (int i = 0; i < 30; ++i) { const int tk = tile * 64 - 30 + i; const unsigned tkc = tk < 0 ? 0u : (unsigned)tk; const float vv = bf2f(PB[(unsigned)(b * SEQ + tkc) * (unsigned)PBLD + (unsigned)c]); u[i] = (tk >= 0) ? vv : 0.f; }
#pragma unroll
        for (int i = 0; i < 8; ++i) nx[i] = bf2f(PB[(rb + (unsigned)i) * (unsigned)PBLD + (unsigned)c]);
#pragma unroll 1
        for (int seg = 0; seg < 8; ++seg) {
#pragma unroll
            for (int i = 0; i < 8; ++i) u[30 + i] = nx[i];
            if (seg < 7) {
#pragma unroll
                for (int i = 0; i < 8; ++i) nx[i] = bf2f(PB[(rb + (unsigned)(seg * 8 + 8 + i)) * (unsigned)PBLD + (unsigned)c]); }
#pragma unroll
            for (int t = 0; t < 8; ++t) { float a = bias;
#pragma unroll
                for (int j = 0; j < CW; ++j) a += w[j] * u[t + j];
                Y[(seg * 8 + t) * CC + c] = a; }
#pragma unroll
            for (int i = 0; i < 30; ++i) u[i] = u[i + 8];
        }
    }
    __syncthreads();
    {
        const int ch0 = 8 * F.lane + oz;
        const f32x4 g0 = *(const f32x4*)(A.in[I_LNG] + ch0), g1 = *(const f32x4*)(A.in[I_LNG] + ch0 + 4), b0 = *(const f32x4*)(A.in[I_LNB] + ch0), b1 = *(const f32x4*)(A.in[I_LNB] + ch0 + 4);
#pragma unroll 2
        for (int tt = 0; tt < 8; ++tt) { const int t = 8 * F.wave + tt;
            f32x4 y0 = *(const LAS f32x4*)(Y + t * CC + ch0), y1 = *(const LAS f32x4*)(Y + t * CC + ch0 + 4);
            const float mean = wave_sum((y0[0] + y0[1]) + (y0[2] + y0[3]) + (y1[0] + y1[1]) + (y1[2] + y1[3])) * (1.f / CC);
            y0 = y0 - mean; y1 = y1 - mean;
            const float var = wave_sum((y0[0] * y0[0] + y0[1] * y0[1]) + (y0[2] * y0[2] + y0[3] * y0[3]) + (y1[0] * y1[0] + y1[1] * y1[1]) + (y1[2] * y1[2] + y1[3] * y1[3])) * (1.f / CC);
            const float rstd = __builtin_amdgcn_rsqf(var + 1e-5f);
            y0 = y0 * rstd * g0 + b0; y1 = y1 * rstd * g1 + b1;
            float o[8];
#pragma unroll
            for (int i = 0; i < 4; ++i) { o[i] = silu(y0[i]); o[4 + i] = silu(y1[i]); }
            *(GAS v4u*)(CD + (size_t)(row0 + t) * DM + ch0) = pack8(o); }
    }
    if (tile == 31) {
        const int c = F.tid;
        float* oc = A.out + OUT_CONVP + (size_t)b * 30 * CC;
        float tv[30];
#pragma unroll
        for (int j = 0; j < 30; ++j) tv[j] = bf2f(PB[(size_t)(b * SEQ + SEQ - 30 + j) * PBLD + c]);
        __builtin_amdgcn_sched_barrier(0);
#pragma unroll
        for (int j = 0; j < 30; ++j) oc[j * CC + c] = tv[j];
    }
    __syncthreads();
}
__device__ __forceinline__ void conv31_sample(const Args& A, Frame& F, int s) {
    const bf16* PB = (const bf16*)(A.ws + WS_RA); bf16* CD = (bf16*)(A.ws + WS_RB);
    const int c = F.tid; const size_t row = (size_t)MP + s;
    LAS float* Y = (LAS float*)(F.lds + RING_OFF);
    {
        const float* cache = A.in[I_CCONV] + (size_t)s * 30 * CC; float* oc = A.out + OUT_CONVS + (size_t)s * 30 * CC;
        const float us = bf2f(PB[row * PBLD + c]);
        float a = A.in[I_CONVB][c];
        float cv[30], wv[31];
#pragma unroll
        for (int j = 0; j < 30; ++j) { cv[j] = cache[j * CC + c]; wv[j] = A.in[I_CONVW][j * CC + c]; }
        wv[30] = A.in[I_CONVW][30 * CC + c];
        __builtin_amdgcn_sched_barrier(0);
#pragma unroll
        for (int j = 0; j < 30; ++j) { a += wv[j] * cv[j]; oc[j * CC + c] = (j < 29) ? cv[j + 1] : us; }
        a += wv[30] * us;
        Y[c] = a;
    }
    __syncthreads();
    if (F.wave == 7) {
        const int ch0 = 8 * F.lane;
        const f32x4 g0 = *(const f32x4*)(A.in[I_LNG] + ch0), g1 = *(const f32x4*)(A.in[I_LNG] + ch0 + 4), b0 = *(const f32x4*)(A.in[I_LNB] + ch0), b1 = *(const f32x4*)(A.in[I_LNB] + ch0 + 4);
        f32x4 y0 = *(const LAS f32x4*)(Y + ch0), y1 = *(const LAS f32x4*)(Y + ch0 + 4);
        const float mean = wave_sum((y0[0] + y0[1]) + (y0[2] + y0[3]) + (y1[0] + y1[1]) + (y1[2] + y1[3])) * (1.f / CC);
        y0 = y0 - mean; y1 = y1 - mean;
        const float var = wave_sum((y0[0] * y0[0] + y0[1] * y0[1]) + (y0[2] * y0[2] + y0[3] * y0[3]) + (y1[0] * y1[0] + y1[1] * y1[1]) + (y1[2] * y1[2] + y1[3] * y1[3])) * (1.f / CC);
        const float rstd = 1.f / sqrtf(var + 1e-5f);
        y0 = y0 * rstd * g0 + b0; y1 = y1 * rstd * g1 + b1;
        float o[8];
#pragma unroll
        for (int i = 0; i < 4; ++i) { o[i] = silu(y0[i]); o[4 + i] = silu(y1[i]); }
        *(GAS v4u*)(CD + row * DM + ch0) = pack8(o);
    }
    __syncthreads();
}
__device__ __forceinline__ void shortconv_sample(const Args& A, Frame& F, int s) {
    const bf16* PB = (const bf16*)(A.ws + WS_RA); bf16* QC = (bf16*)(A.ws + WS_RC);
    const size_t row = (size_t)MP + s;
    if (F.wave < 3) {
        const int p = F.wave; const int ch0 = 512 * p + 8 * F.lane;
        const float* st = A.in[I_SSC] + (size_t)s * 3 * QKVN; float* os = A.out + OUT_SCS + (size_t)s * 3 * QKVN;
        float win[3][8], cur[8], y[8];
#pragma unroll
        for (int j = 0; j < 3; ++j) { const f32x4 a = *(const f32x4*)(st + j * QKVN + ch0), bb = *(const f32x4*)(st + j * QKVN + ch0 + 4);
#pragma unroll
            for (int i = 0; i < 4; ++i) { win[j][i] = a[i]; win[j][4 + i] = bb[i]; } }
        { const v4u x = *(const GAS v4u*)(PB + row * PBLD + 512 + ch0); unpack8(x, cur); }
        float ss = 0.f;
#pragma unroll
        for (int i = 0; i < 8; ++i) { float a = 0.f;
#pragma unroll
            for (int j = 0; j < 3; ++j) a += A.in[I_SCW][j * QKVN + ch0 + i] * win[j][i];
            a += A.in[I_SCW][3 * QKVN + ch0 + i] * cur[i]; y[i] = silu(a); ss += y[i] * y[i]; }
        if (p < 2) { ss = row16_sum(ss);
            const float sc = (1.f / sqrtf(ss + 1e-6f)) * (p == 0 ? 0.08838834764831845f : 1.f);
#pragma unroll
            for (int i = 0; i < 8; ++i) y[i] *= sc; }
        *(GAS v4u*)(QC + row * QKVN + ch0) = pack8(y);
#pragma unroll
        for (int j = 0; j < 3; ++j) { f32x4 a, bb;
#pragma unroll
            for (int i = 0; i < 4; ++i) { a[i] = (j < 2) ? win[j + 1][i] : cur[i]; bb[i] = (j < 2) ? win[j + 1][4 + i] : cur[4 + i]; }
            *(f32x4*)(os + j * QKVN + ch0) = a; *(f32x4*)(os + j * QKVN + ch0 + 4) = bb; }
    }
    __syncthreads();
}

__device__ __forceinline__ bf16x8 lds_frag16(const LAS unsigned char* p) { return *(const LAS bf16x8*)p; }
struct D1In { float g, be; v4u q0, q1, k0, k1, v0, v1; };
__device__ __forceinline__ void d1_load(const Args& A, Frame& F, int ci, D1In& I) {
    const int b = ci >> 7, h = (ci >> 5) & 3, n = ci & 31; const int row0 = b * SEQ + n * 64;
    const bf16* QC = (const bf16*)(A.ws + WS_RC); const float* BG = (const float*)(A.ws + WS_BG);
    I.g = 0.f; I.be = 0.f;
    if (F.wave == 0) { I.g = BG[(size_t)(row0 + F.lane) * 8 + 4 + h]; I.be = BG[(size_t)(row0 + F.lane) * 8 + h]; }
    const int t = F.tid >> 3, part = F.tid & 7;
    const bf16* rp = QC + (size_t)(row0 + t) * QKVN + h * 128 + part * 16;
    I.q0 = *(const GAS v4u*)(rp); I.q1 = *(const GAS v4u*)(rp + 8); I.k0 = *(const GAS v4u*)(rp + 512); I.k1 = *(const GAS v4u*)(rp + 520); I.v0 = *(const GAS v4u*)(rp + 1024); I.v1 = *(const GAS v4u*)(rp + 1032);
}
__device__ __forceinline__ void d1_chunk(const Args& A, Frame& F, int ci, const D1In& I) {
    using pg8::f32x4;
    const int b = ci >> 7, h = (ci >> 5) & 3, n = ci & 31; const int row0 = b * SEQ + n * 64;
    const bf16* QC = (const bf16*)(A.ws + WS_RC); const float* BG = (const float*)(A.ws + WS_BG);
    float* Ug = (float*)(A.ws + WS_U) + (size_t)ci * 8192; bf16* Wg = (bf16*)(A.ws + WS_W) + (size_t)ci * 8192; bf16* QGg = (bf16*)(A.ws + WS_QG) + (size_t)ci * 8192;
    bf16* KDTg = (bf16*)(A.ws + WS_KDT) + (size_t)ci * 8192; bf16* QKg = (bf16*)(A.ws + WS_QK) + (size_t)ci * 4096; float* GLg = (float*)(A.ws + WS_GL);
    constexpr int OFF_K = 0, OFF_Q = 17408, OFF_VBT = 34816, OFF_KBGT = 53248, OFF_L = 71680, OFF_T = 89088, OFF_GC = 98304, OFF_BETA = 98560, OFF_EG = 98816, OFF_TM = 99072, OFF_X = 116480, LS = 68;
    LAS unsigned char* L = F.lds + RING_OFF;
    LAS float* gcs = (LAS float*)(L + OFF_GC); LAS float* betas = (LAS float*)(L + OFF_BETA); LAS float* egs = (LAS float*)(L + OFF_EG); LAS float* Lm = (LAS float*)(L + OFF_L); LAS float* Tm = (LAS float*)(L + OFF_TM); LAS float* Xm = (LAS float*)(L + OFF_X);
    const int fr = F.lane & 15, fq = F.lane >> 4;
    if (F.wave == 0) {
        float g = I.g; const float be = I.be;
#pragma unroll
        for (int o = 1; o < 64; o <<= 1) { const float v = __shfl_up(g, o); if (F.lane >= o) g += v; }
        gcs[F.lane] = g; betas[F.lane] = be; egs[F.lane] = __expf(g);
    }
    __syncthreads();
    {
        const int t = F.tid >> 3, part = F.tid & 7;
        const v4u q0 = I.q0, q1 = I.q1, k0 = I.k0, k1 = I.k1, v0 = I.v0, v1 = I.v1;
        *(LAS v4u*)(L + OFF_K + t * 272 + part * 32) = k0; *(LAS v4u*)(L + OFF_K + t * 272 + part * 32 + 16) = k1;
        *(LAS v4u*)(L + OFF_Q + t * 272 + part * 32) = q0; *(LAS v4u*)(L + OFF_Q + t * 272 + part * 32 + 16) = q1;
        const float be = betas[t], beg = be * egs[t];
        float kf[16], vf[16];
        { float tmp[8]; unpack8(k0, tmp);
#pragma unroll
          for (int i = 0; i < 8; ++i) kf[i] = tmp[i]; unpack8(k1, tmp);
#pragma unroll
          for (int i = 0; i < 8; ++i) kf[8 + i] = tmp[i]; unpack8(v0, tmp);
#pragma unroll
          for (int i = 0; i < 8; ++i) vf[i] = tmp[i]; unpack8(v1, tmp);
#pragma unroll
          for (int i = 0; i < 8; ++i) vf[8 + i] = tmp[i]; }
#pragma unroll
        for (int i = 0; i < 16; ++i) { const int d = part * 16 + i;
            *(LAS unsigned short*)(L + OFF_VBT + d * 144 + t * 2) = (unsigned short)(pk2(vf[i] * be, 0.f) & 0xffffu);
            *(LAS unsigned short*)(L + OFF_KBGT + d * 144 + t * 2) = (unsigned short)(pk2(kf[i] * beg, 0.f) & 0xffffu); }
    }
    __syncthreads();
#pragma unroll 1
    for (int x = 0; x < 4; ++x) {
        const int tile = F.wave * 4 + x, which = tile >> 4, ti = (tile >> 2) & 3, tj = tile & 3;
        f32x4 acc = (f32x4){0.f, 0.f, 0.f, 0.f};
        if (ti >= tj) {
            const LAS unsigned char* ap = L + (which ? OFF_Q : OFF_K) + (ti * 16 + fr) * 272 + fq * 16; const LAS unsigned char* bp = L + OFF_K + (tj * 16 + fr) * 272 + fq * 16;
#pragma unroll
            for (int kk = 0; kk < 4; ++kk) acc = __builtin_amdgcn_mfma_f32_16x16x32_bf16(lds_frag16(ap + kk * 64), lds_frag16(bp + kk * 64), acc, 0, 0, 0);
        }
        const int j = tj * 16 + fr; const float gj = gcs[j];
#pragma unroll
        for (int r = 0; r < 4; ++r) { const int i = ti * 16 + 4 * fq + r; const float dec = __expf(gcs[i] - gj);
            if (which == 0) Lm[i * LS + j] = (i > j) ? betas[i] * acc[r] * dec : 0.f;
            else QKg[i * 64 + j] = (bf16)(pk2((i >= j) ? acc[r] * dec : 0.f, 0.f) & 0xffffu); }
    }
    __syncthreads();
    for (int e = F.tid; e < 64 * LS; e += NWAVES * 64) Tm[e] = 0.f;
    __syncthreads();
    if (F.wave == 0) {
        const LAS float* Lb = Lm + (16 * fq) * LS + 16 * fq;
        float t[16];
#pragma unroll
        for (int i = 0; i < 16; ++i) {
            float a0 = 0.f, a1 = 0.f, a2 = 0.f, a3 = 0.f;
#pragma unroll
            for (int j4 = 0; j4 < (i + 3) / 4; ++j4) { const f32x4 lv = *(const LAS f32x4*)(Lb + i * LS + 4 * j4);
                if (4 * j4 + 0 < i) a0 += lv[0] * t[4 * j4 + 0]; if (4 * j4 + 1 < i) a1 += lv[1] * t[4 * j4 + 1]; if (4 * j4 + 2 < i) a2 += lv[2] * t[4 * j4 + 2]; if (4 * j4 + 3 < i) a3 += lv[3] * t[4 * j4 + 3]; }
            t[i] = ((fr == i) ? 1.f : 0.f) - ((a0 + a1) + (a2 + a3));
        }
#pragma unroll
        for (int i = 0; i < 16; ++i) Tm[(16 * fq + i) * LS + 16 * fq + fr] = t[i];
    } else {
        const int lt = F.tid - 64; const float gl = gcs[63];
        for (int cix = lt; cix < 1024; cix += 448) {
            const int t = cix >> 4, cc = cix & 15; const v4u x = *(const LAS v4u*)(L + OFF_Q + t * 272 + cc * 16); float f[8]; unpack8(x, f); const float e = egs[t];
#pragma unroll
            for (int i = 0; i < 8; ++i) f[i] *= e;
            *(GAS v4u*)(QGg + t * 128 + cc * 8) = pack8(f); }
        for (int cix = lt; cix < 1024; cix += 448) {
            const int dk = cix >> 3, t0 = (cix & 7) * 8; float f[8];
#pragma unroll
            for (int i = 0; i < 8; ++i) f[i] = bf2f(*(const LAS unsigned short*)(L + OFF_K + (t0 + i) * 272 + dk * 2)) * __expf(gl - gcs[t0 + i]);
            *(GAS v4u*)(KDTg + dk * 64 + t0) = pack8(f); }
        if (lt == 0) GLg[ci] = __expf(gl);
    }
    __syncthreads();
    if (F.wave < 2) {
        const int pp = F.wave, rb = 16 * (2 * pp + 1), cb = 16 * (2 * pp); f32x4 acc = (f32x4){0.f, 0.f, 0.f, 0.f};
#pragma unroll
        for (int kk = 0; kk < 4; ++kk) acc = __builtin_amdgcn_mfma_f32_16x16x4f32(Lm[(rb + fr) * LS + cb + 4 * kk + fq], Tm[(cb + 4 * kk + fq) * LS + cb + fr], acc, 0, 0, 0);
#pragma unroll
        for (int r = 0; r < 4; ++r) Xm[pp * 576 + (4 * fq + r) * 36 + fr] = acc[r];
    }
    __syncthreads();
    if (F.wave < 2) {
        const int pp = F.wave, rb = 16 * (2 * pp + 1), cb = 16 * (2 * pp); f32x4 acc = (f32x4){0.f, 0.f, 0.f, 0.f};
#pragma unroll
        for (int kk = 0; kk < 4; ++kk) acc = __builtin_amdgcn_mfma_f32_16x16x4f32(Tm[(rb + fr) * LS + rb + 4 * kk + fq], Xm[pp * 576 + (4 * kk + fq) * 36 + fr], acc, 0, 0, 0);
#pragma unroll
        for (int r = 0; r < 4; ++r) Tm[(rb + 4 * fq + r) * LS + cb + fr] = -acc[r];
    }
    __syncthreads();
    if (F.wave < 4) {
        const int bi = F.wave >> 1, bj = F.wave & 1; f32x4 acc = (f32x4){0.f, 0.f, 0.f, 0.f};
#pragma unroll
        for (int kk = 0; kk < 8; ++kk) acc = __builtin_amdgcn_mfma_f32_16x16x4f32(Lm[(32 + 16 * bi + fr) * LS + 4 * kk + fq], Tm[(4 * kk + fq) * LS + 16 * bj + fr], acc, 0, 0, 0);
#pragma unroll
        for (int r = 0; r < 4; ++r) Xm[(16 * bi + 4 * fq + r) * 36 + 16 * bj + fr] = acc[r];
    }
    __syncthreads();
    if (F.wave < 4) {
        const int bi = F.wave >> 1, bj = F.wave & 1; f32x4 acc = (f32x4){0.f, 0.f, 0.f, 0.f};
#pragma unroll
        for (int kk = 0; kk < 8; ++kk) acc = __builtin_amdgcn_mfma_f32_16x16x4f32(Tm[(32 + 16 * bi + fr) * LS + 32 + 4 * kk + fq], Xm[(4 * kk + fq) * 36 + 16 * bj + fr], acc, 0, 0, 0);
#pragma unroll
        for (int r = 0; r < 4; ++r) Tm[(32 + 16 * bi + 4 * fq + r) * LS + 16 * bj + fr] = -acc[r];
    }
    __syncthreads();
    {
        const int i = F.tid >> 3, j0 = (F.tid & 7) * 8; const f32x4 a = *(const LAS f32x4*)(Tm + i * LS + j0), bq = *(const LAS f32x4*)(Tm + i * LS + j0 + 4);
        v4u w; w.x = pk2(a[0], a[1]); w.y = pk2(a[2], a[3]); w.z = pk2(bq[0], bq[1]); w.w = pk2(bq[2], bq[3]);
        *(LAS v4u*)(L + OFF_T + i * 144 + j0 * 2) = w;
    }
    __syncthreads();
#pragma unroll 1
    for (int x = 0; x < 8; ++x) {
        const int tile = F.wave * 8 + x, which = tile >> 5, ti = (tile >> 3) & 3, td = tile & 7;
        const LAS unsigned char* ap = L + OFF_T + (ti * 16 + fr) * 144 + fq * 16; const LAS unsigned char* bp = L + (which ? OFF_KBGT : OFF_VBT) + (td * 16 + fr) * 144 + fq * 16;
        f32x4 acc = (f32x4){0.f, 0.f, 0.f, 0.f};
#pragma unroll
        for (int kk = 0; kk < 2; ++kk) acc = __builtin_amdgcn_mfma_f32_16x16x32_bf16(lds_frag16(ap + kk * 64), lds_frag16(bp + kk * 64), acc, 0, 0, 0);
        const int d = td * 16 + fr;
#pragma unroll
        for (int r = 0; r < 4; ++r) { const int i = ti * 16 + 4 * fq + r;
            if (which == 0) Ug[i * 128 + d] = acc[r]; else Wg[i * 128 + d] = (bf16)(pk2(acc[r], 0.f) & 0xffffu); }
    }
    __syncthreads();
}

constexpr int SC_OW = 0, SC_OQG = 16384, SC_OKDT = 32768, SC_OQK = 49152, SC_OU = 57344, SC_BUF = 65536, SC_NS = 2;
__device__ __forceinline__ void scan_issue(const Args& A, Frame& F, int ci, int sl0, LAS unsigned char* dst) {
    const unsigned char* Wg = A.ws + WS_W + (size_t)ci * 16384; const unsigned char* QGg = A.ws + WS_QG + (size_t)ci * 16384;
    const unsigned char* KDTg = A.ws + WS_KDT + (size_t)ci * 16384; const unsigned char* QKg = A.ws + WS_QK + (size_t)ci * 8192; const unsigned char* Ug = A.ws + WS_U + (size_t)ci * 32768 + sl0 * 64;
#pragma unroll
    for (int j = 0; j < 11; ++j) {
        const int pi = (F.wave - SC_NS) + (NWAVES - SC_NS) * j;
        if (pi < 56 + 4 * SC_NS) {
            const unsigned char* src;
            if (pi < 32) { const int i = (pi & 15) * 64 + F.lane, r = i >> 4, c = (i & 15) ^ (r & 15); src = (pi < 16 ? Wg : QGg) + r * 256 + c * 16; }
            else if (pi < 56) { const int i = (pi < 48 ? pi - 32 : pi - 48) * 64 + F.lane, r = i >> 3, c = (i & 7) ^ ((r >> 1) & 7); src = (pi < 48 ? KDTg : QKg) + r * 128 + c * 16; }
            else { const int i = ((pi - 56) & 3) * 64 + F.lane, r = i >> 2, c = i & 3; src = Ug + ((pi - 56) >> 2) * 64 + r * 512 + c * 16; }
            __builtin_amdgcn_global_load_lds((const unsigned*)src, (LAS unsigned*)(dst + pi * 1024), 16, 0, 0);
        }
    }
}
__device__ __forceinline__ bf16x8 frag2(const LAS unsigned char* p0, const LAS unsigned char* p1) { const v2u lo = *(const LAS v2u*)p0, hi = *(const LAS v2u*)p1; v4u w; w.x = lo.x; w.y = lo.y; w.z = hi.x; w.w = hi.y; return __builtin_bit_cast(bf16x8, w); }
__device__ __forceinline__ bf16x8 frag256(const LAS unsigned char* tile, int row, int kstep, int fq) { const int c = 4 * kstep + (fq >> 1), sw = row & 15; const LAS unsigned char* rp = tile + row * 256 + 8 * (fq & 1); return frag2(rp + ((c ^ sw) << 4), rp + (((c + 2) ^ sw) << 4)); }
__device__ __forceinline__ bf16x8 frag128(const LAS unsigned char* tile, int row, int kstep, int fq) { const int c = 4 * kstep + (fq >> 1), sw = (row >> 1) & 7; const LAS unsigned char* rp = tile + row * 128 + 8 * (fq & 1); return frag2(rp + ((c ^ sw) << 4), rp + (((c + 2) ^ sw) << 4)); }
__device__ __forceinline__ bf16x8 pack_pair(const pg8::f32x4& a, const pg8::f32x4& b) { v4u w; w.x = pk2(a[0], a[1]); w.y = pk2(a[2], a[3]); w.z = pk2(b[0], b[1]); w.w = pk2(b[2], b[3]); return __builtin_bit_cast(bf16x8, w); }
__device__ __forceinline__ void scan_unit(const Args& A, Frame& F, int b, int h, int sl0) {
    using pg8::f32x4;
    LAS unsigned char* L = F.lds + RING_OFF;
    const int ci0 = (b * NH + h) * 32; const int fr = F.lane & 15, fq = F.lane >> 4;
    float* Og = (float*)(A.ws + WS_RE); const float* GLg = (const float*)(A.ws + WS_GL);
    const int sl = sl0 + F.wave;
    if (F.wave >= SC_NS) { scan_issue(A, F, ci0, sl0, L); scan_issue(A, F, ci0 + 1, sl0, L + SC_BUF); asm volatile("s_waitcnt vmcnt(10)" ::: "memory"); }
    __builtin_amdgcn_s_barrier(); asm volatile("" ::: "memory");
    f32x4 S[8];
#pragma unroll
    for (int i = 0; i < 8; ++i) S[i] = (f32x4){0.f, 0.f, 0.f, 0.f};
    float gl = GLg[ci0];
#pragma unroll 1
    for (int n = 0; n < 32; ++n) {
        if (F.wave < SC_NS) {
            const LAS unsigned char* B = L + (n & 1) * SC_BUF; const LAS unsigned char* Ub = B + SC_OU + F.wave * 4096;
            const float gln = GLg[ci0 + (n < 31 ? n + 1 : n)];
            bf16x8 Sb[4];
#pragma unroll
            for (int kk = 0; kk < 4; ++kk) Sb[kk] = pack_pair(S[2 * kk], S[2 * kk + 1]);
            f32x4 vn[4];
#pragma unroll
            for (int tb = 0; tb < 4; ++tb) { f32x4 p1 = (f32x4){0.f, 0.f, 0.f, 0.f};
#pragma unroll
                for (int kk = 0; kk < 4; ++kk) p1 = __builtin_amdgcn_mfma_f32_16x16x32_bf16(frag256(B + SC_OW, 16 * tb + fr, kk, fq), Sb[kk], p1, 0, 0, 0);
#pragma unroll
                for (int r = 0; r < 4; ++r) vn[tb][r] = *(const LAS float*)(Ub + (16 * tb + 4 * fq + r) * 64 + fr * 4) - p1[r]; }
            bf16x8 Vb[2]; Vb[0] = pack_pair(vn[0], vn[1]); Vb[1] = pack_pair(vn[2], vn[3]);
            const size_t orow = (size_t)(b * SEQ + n * 64);
#pragma unroll
            for (int blk = 0; blk < 8; ++blk) { f32x4 s = S[blk] * gl;
#pragma unroll
                for (int kt = 0; kt < 2; ++kt) s = __builtin_amdgcn_mfma_f32_16x16x32_bf16(frag128(B + SC_OKDT, 16 * blk + fr, kt, fq), Vb[kt], s, 0, 0, 0);
                S[blk] = s; }
#pragma unroll
            for (int tb = 0; tb < 4; ++tb) { f32x4 o = (f32x4){0.f, 0.f, 0.f, 0.f};
#pragma unroll
                for (int kk = 0; kk < 4; ++kk) o = __builtin_amdgcn_mfma_f32_16x16x32_bf16(frag256(B + SC_OQG, 16 * tb + fr, kk, fq), Sb[kk], o, 0, 0, 0);
#pragma unroll
                for (int kt = 0; kt < 2; ++kt) o = __builtin_amdgcn_mfma_f32_16x16x32_bf16(frag128(B + SC_OQK, 16 * tb + fr, kt, fq), Vb[kt], o, 0, 0, 0);
#pragma unroll
                for (int r = 0; r < 4; ++r) Og[(orow + 16 * tb + 4 * fq + r) * 512 + h * 128 + sl * 16 + fr] = o[r]; }
            gl = gln;
            asm volatile("s_waitcnt lgkmcnt(0)" ::: "memory");
        } else {
            asm volatile("s_waitcnt vmcnt(0)" ::: "memory");
        }
        __builtin_amdgcn_s_barrier(); asm volatile("" ::: "memory");
        if (F.wave >= SC_NS && n + 2 < 32) scan_issue(A, F, ci0 + n + 2, sl0, L + (n & 1) * SC_BUF);
    }
    if (F.wave < SC_NS) {
        float* od = A.out + OUT_DLP + (size_t)(b * NH + h) * DKV * DKV;
#pragma unroll
        for (int blk = 0; blk < 8; ++blk)
#pragma unroll
            for (int r = 0; r < 4; ++r) od[(16 * blk + 4 * fq + r) * DKV + sl * 16 + fr] = S[blk][r];
    }
    asm volatile("s_waitcnt vmcnt(0) lgkmcnt(0)" ::: "memory"); __builtin_amdgcn_s_barrier(); asm volatile("" ::: "memory");
}
__device__ __forceinline__ void delta_sample_seq(const Args& A, Frame& F, int s, int h0, int nh) {
    using pg8::f32x4;
    const bf16* QC = (const bf16*)(A.ws + WS_RC); const float* BG = (const float*)(A.ws + WS_BG); float* Og = (float*)(A.ws + WS_RE);
    const size_t row = (size_t)MP + s;
    LAS float* qs = (LAS float*)(F.lds + RING_OFF); LAS float* ks = qs + 128; LAS float* red = qs + 256;
    const int dv4 = (F.tid & 31) * 4, grp = F.tid >> 5;
    const float* S0b = A.in[I_SDELTA] + (size_t)s * NH * DKV * DKV + (size_t)(grp * 8) * DKV + dv4; float* Sob = A.out + OUT_DLS + (size_t)s * NH * DKV * DKV + (size_t)(grp * 8) * DKV + dv4;
    f32x4 s0[8], s1[8];
#pragma unroll
    for (int i = 0; i < 8; ++i) s0[i] = *(const GAS f32x4*)(S0b + (size_t)h0 * DKV * DKV + (size_t)i * DKV);
#pragma unroll 1
    for (int h = h0; h < h0 + nh; ++h) {
        if (h + 1 < h0 + nh) {
#pragma unroll
            for (int i = 0; i < 8; ++i) s1[i] = *(const GAS f32x4*)(S0b + (size_t)(h + 1) * DKV * DKV + (size_t)i * DKV); }
        if (F.tid < 128) { qs[F.tid] = bf2f(QC[row * QKVN + h * 128 + F.tid]); ks[F.tid] = bf2f(QC[row * QKVN + 512 + h * 128 + F.tid]); }
        f32x4 v; { const v2u x = *(const GAS v2u*)(QC + row * QKVN + 1024 + h * 128 + dv4); v = (f32x4){bflo(x.x), bfhi(x.x), bflo(x.y), bfhi(x.y)}; }
        const float beta = BG[row * 8 + h], eg = __expf(BG[row * 8 + 4 + h]);
        __syncthreads();
        f32x4 part = (f32x4){0.f, 0.f, 0.f, 0.f};
#pragma unroll
        for (int i = 0; i < 8; ++i) part = part + s0[i] * ks[grp * 8 + i];
        *(LAS f32x4*)(red + grp * 128 + dv4) = part;
        __syncthreads();
        f32x4 kS = (f32x4){0.f, 0.f, 0.f, 0.f};
#pragma unroll
        for (int g = 0; g < 16; ++g) kS = kS + *(const LAS f32x4*)(red + g * 128 + dv4);
        const f32x4 vnew = (v - kS * eg) * beta;
        __syncthreads();
        f32x4 po = (f32x4){0.f, 0.f, 0.f, 0.f};
#pragma unroll
        for (int i = 0; i < 8; ++i) { const f32x4 sn = s0[i] * eg + vnew * ks[grp * 8 + i]; *(GAS f32x4*)(Sob + (size_t)h * DKV * DKV + (size_t)i * DKV) = sn; po = po + sn * qs[grp * 8 + i]; }
        *(LAS f32x4*)(red + grp * 128 + dv4) = po;
        __syncthreads();
        if (F.tid < 32) { f32x4 o = (f32x4){0.f, 0.f, 0.f, 0.f};
#pragma unroll
            for (int g = 0; g < 16; ++g) o = o + *(const LAS f32x4*)(red + g * 128 + dv4);
            *(GAS f32x4*)(Og + row * 512 + h * 128 + dv4) = o; }
        __syncthreads();
#pragma unroll
        for (int i = 0; i < 8; ++i) s0[i] = s1[i];
    }
}

__device__ __forceinline__ void ogate_row(const Args& A, Frame& F, int m, const pg8::f32x4& n0, const pg8::f32x4& n1, int half = -1) {
    const bf16* PB = (const bf16*)(A.ws + WS_RA); bf16* CD = (bf16*)(A.ws + WS_RB); const float* Og = (const float*)(A.ws + WS_RE); const int ch0 = 8 * F.lane;
    const f32x4 o0 = *(const GAS f32x4*)(Og + (size_t)m * 512 + ch0), o1 = *(const GAS f32x4*)(Og + (size_t)m * 512 + ch0 + 4);
    const v4u zz = *(const GAS v4u*)(PB + (size_t)m * PBLD + 2048 + ch0); float z[8]; unpack8(zz, z);
    float ss = (o0[0] * o0[0] + o0[1] * o0[1]) + (o0[2] * o0[2] + o0[3] * o0[3]) + (o1[0] * o1[0] + o1[1] * o1[1]) + (o1[2] * o1[2] + o1[3] * o1[3]);
    ss = row16_sum(ss);
    const float rstd = 1.f / sqrtf(ss * (1.f / 128.f) + RMS_EPS);
    float d[8];
#pragma unroll
    for (int i = 0; i < 4; ++i) { d[i] = o0[i] * rstd * n0[i] * silu(z[i]); d[4 + i] = o1[i] * rstd * n1[i] * silu(z[4 + i]); }
    if (half < 0 || (F.lane >> 5) == half) *(GAS v4u*)(CD + (size_t)m * DM + 512 + ch0) = pack8(d);
}
__device__ __forceinline__ void ogate_phase(const Args& A, Frame& F, int blk, int nblk) {
    const int gw = blk * NWAVES + F.wave, NGW = nblk * NWAVES; const int ch0 = 8 * F.lane;
    const f32x4 n0 = *(const f32x4*)(A.in[I_DNN] + (ch0 & 127)), n1 = *(const f32x4*)(A.in[I_DNN] + (ch0 & 127) + 4);
    for (int m = gw; m < MP; m += NGW) ogate_row(A, F, m, n0, n1);
}
__device__ __forceinline__ void sample_mixer(const Args& A, Frame& F, int s) {
    shortconv_sample(A, F, s);
    VM_WAIT(); __syncthreads();
    delta_sample_seq(A, F, s, 0, NH);
    VM_WAIT(); __syncthreads();
    if (F.wave == 0) { const int ch0 = 8 * F.lane; const f32x4 n0 = *(const f32x4*)(A.in[I_DNN] + (ch0 & 127)), n1 = *(const f32x4*)(A.in[I_DNN] + (ch0 & 127) + 4); ogate_row(A, F, MP + s, n0, n1); }
}

__device__ __forceinline__ void attn_issue(const Args& A, Frame& F, int st, int b, int h, LAS unsigned char* slot) {
    const bf16* KB = (const bf16*)(A.ws + WS_KB); const bf16* VT = (const bf16*)(A.ws + WS_VT);
#pragma unroll
    for (int it = 0; it < 4; ++it) {
        const int idx = it * 512 + F.tid; const bf16* src;
        if (st < 4) { const int r = idx >> 5, p = idx & 31, c = p ^ (r & 15); src = KB + (size_t)(b * NMEM + 64 * st + r) * DM + h * MHD + 8 * c; }
        else { const int r = idx >> 3, p = idx & 7, c = p ^ ((r >> 1) & 7); src = VT + (size_t)(h * MHD + r) * (NB * NMEM) + b * NMEM + 64 * (st - 4) + 8 * c; }
        __builtin_amdgcn_global_load_lds((const unsigned*)src, (LAS unsigned*)(slot + it * 8192 + F.wave * 1024), 16, 0, 0);
    }
}
__device__ __forceinline__ void attn_unit(const Args& A, Frame& F, int rt, int h) {
    using pg8::f32x4;
    const int b = rt >> 4; const int fr = F.lane & 15, fq = F.lane >> 4;
    const bf16* Q = (const bf16*)(A.ws + WS_RB); bf16* AO = (bf16*)(A.ws + WS_RD);
    const size_t qoff = (size_t)(rt * 128 + F.wave * 16 + fr) * DM + h * MHD;
    const bf16* qrow = Q + qoff; bf16* orow = AO + qoff;
    LAS unsigned char* L = F.lds + RING_OFF;
    bf16x8 qf[8];
#pragma unroll
    for (int ks = 0; ks < 8; ++ks) qf[ks] = *(const GAS bf16x8*)(qrow + 32 * ks + 8 * fq);
    attn_issue(A, F, 0, b, h, L); attn_issue(A, F, 1, b, h, L + 32768);
    f32x4 sacc[16];
#pragma unroll
    for (int st = 0; st < 4; ++st) {
        asm volatile("s_waitcnt vmcnt(4)" ::: "memory");
        __builtin_amdgcn_s_barrier(); asm volatile("" ::: "memory");
        attn_issue(A, F, st + 2, b, h, L + ((st + 2) & 3) * 32768);
        const LAS unsigned char* slot = L + (st & 3) * 32768;
#pragma unroll
        for (int kbl = 0; kbl < 4; ++kbl) { f32x4 acc = (f32x4){0.f, 0.f, 0.f, 0.f}; const int row = 16 * kbl + fr;
#pragma unroll
            for (int ks = 0; ks < 8; ++ks) { const bf16x8 a = *(const LAS bf16x8*)(slot + row * 512 + (((4 * ks + fq) ^ (row & 15)) << 4)); acc = __builtin_amdgcn_mfma_f32_16x16x32_bf16(a, qf[ks], acc, 0, 0, 0); }
            sacc[4 * st + kbl] = acc; }
    }
    float mx = -3.0e38f;
#pragma unroll
    for (int kb = 0; kb < 16; ++kb)
#pragma unroll
        for (int i = 0; i < 4; ++i) mx = fmaxf(mx, sacc[kb][i]);
    mx = fmaxf(mx, __shfl_xor(mx, 16)); mx = fmaxf(mx, __shfl_xor(mx, 32));
    float lsum = 0.f; bf16x8 pb[8];
#pragma unroll
    for (int kb = 0; kb < 16; ++kb)
#pragma unroll
        for (int i = 0; i < 4; ++i) { const float p = __builtin_amdgcn_exp2f(sacc[kb][i] - mx); sacc[kb][i] = p; lsum += p; }
#pragma unroll
    for (int s = 0; s < 8; ++s) pb[s] = pack_pair(sacc[2 * s], sacc[2 * s + 1]);
    lsum += __shfl_xor(lsum, 16); lsum += __shfl_xor(lsum, 32);
    f32x4 oacc[16];
#pragma unroll
    for (int db = 0; db < 16; ++db) oacc[db] = (f32x4){0.f, 0.f, 0.f, 0.f};
#pragma unroll
    for (int st = 4; st < 8; ++st) {
        if (st + 1 < 8) asm volatile("s_waitcnt vmcnt(4)" ::: "memory"); else asm volatile("s_waitcnt vmcnt(0)" ::: "memory");
        __builtin_amdgcn_s_barrier(); asm volatile("" ::: "memory");
        if (st + 2 < 8) attn_issue(A, F, st + 2, b, h, L + ((st + 2) & 3) * 32768);
        const LAS unsigned char* slot = L + (st & 3) * 32768; const int t = st - 4;
#pragma unroll
        for (int db = 0; db < 16; ++db) { const int row = 16 * db + fr; const int sw = (row >> 1) & 7;
#pragma unroll
            for (int s2 = 0; s2 < 2; ++s2) { const int c = 4 * s2 + (fq >> 1);
                const v2u lo = *(const LAS v2u*)(slot + row * 128 + ((c ^ sw) << 4) + 8 * (fq & 1)), hi = *(const LAS v2u*)(slot + row * 128 + (((c + 2) ^ sw) << 4) + 8 * (fq & 1));
                v4u aw; aw.x = lo.x; aw.y = lo.y; aw.z = hi.x; aw.w = hi.y;
                oacc[db] = __builtin_amdgcn_mfma_f32_16x16x32_bf16(__builtin_bit_cast(bf16x8, aw), pb[2 * t + s2], oacc[db], 0, 0, 0); } }
    }
    const float inv = 1.f / lsum;
#pragma unroll
    for (int db = 0; db < 16; ++db) { v2u w; w.x = pk2(oacc[db][0] * inv, oacc[db][1] * inv); w.y = pk2(oacc[db][2] * inv, oacc[db][3] * inv); *(GAS v2u*)(orow + 16 * db + 4 * fq) = w; }
    LDS_WAIT(); __builtin_amdgcn_s_barrier(); asm volatile("" ::: "memory");
}
__device__ __forceinline__ void attn_sample(const Args& A, Frame& F, int s, int h) {
    const bf16* qrow = (const bf16*)(A.ws + WS_RB) + (size_t)(MP + s) * DM + h * MHD; bf16* orow = (bf16*)(A.ws + WS_RD) + (size_t)(MP + s) * DM + h * MHD;
    const int g = F.lane >> 4, dl = F.lane & 15;
    const float* Kc = A.in[I_CMK] + (size_t)s * NMEM * DM + h * MHD + (size_t)(32 * F.wave + g) * DM + 4 * dl;
    const float* Vc = A.in[I_CMV] + (size_t)s * NMEM * DM + h * MHD + (size_t)(32 * F.wave + g) * DM + 4 * dl;
    LAS float* pl = (LAS float*)(F.lds + RING_OFF); LAS float* wred = pl + 256; LAS float* ored = pl + 512;
    f32x4 kv[8][4];
#pragma unroll
    for (int it = 0; it < 8; ++it)
#pragma unroll
        for (int i = 0; i < 4; ++i) kv[it][i] = *(const GAS f32x4*)(Kc + (size_t)(4 * it) * DM + 64 * i);
    f32x4 q[4];
#pragma unroll
    for (int i = 0; i < 4; ++i) { const v2u x = *(const GAS v2u*)(qrow + 64 * i + 4 * dl); q[i] = (f32x4){bflo(x.x), bfhi(x.x), bflo(x.y), bfhi(x.y)}; }
    __builtin_amdgcn_sched_barrier(0);
    float myscore = -3.0e38f;
#pragma unroll
    for (int it = 0; it < 8; ++it) { float d = 0.f;
#pragma unroll
        for (int i = 0; i < 4; ++i) d += (kv[it][i][0] * q[i][0] + kv[it][i][1] * q[i][1]) + (kv[it][i][2] * q[i][2] + kv[it][i][3] * q[i][3]);
        d = row16_sum(d);
        if (dl == it) myscore = d; }
#pragma unroll
    for (int it = 0; it < 8; ++it)
#pragma unroll
        for (int i = 0; i < 4; ++i) kv[it][i] = *(const GAS f32x4*)(Vc + (size_t)(4 * it) * DM + 64 * i);
    const float m = wave_max(myscore);
    if (F.lane == 0) wred[F.wave] = m;
    __syncthreads();
    float gm = wred[0];
#pragma unroll
    for (int i = 1; i < 8; ++i) gm = fmaxf(gm, wred[i]);
    const float p = (dl < 8) ? __builtin_amdgcn_exp2f(myscore - gm) : 0.f;
    if (dl < 8) pl[32 * F.wave + 4 * dl + g] = p;
    const float ws_ = wave_sum(p);
    if (F.lane == 0) wred[8 + F.wave] = ws_;
    __syncthreads();
    float tot = 0.f;
#pragma unroll
    for (int i = 0; i < 8; ++i) tot += wred[8 + i];
    f32x4 acc[4];
#pragma unroll
    for (int i = 0; i < 4; ++i) acc[i] = (f32x4){0.f, 0.f, 0.f, 0.f};
#pragma unroll
    for (int it = 0; it < 8; ++it) { const float pi = pl[32 * F.wave + 4 * it + g];
#pragma unroll
        for (int i = 0; i < 4; ++i) acc[i] = acc[i] + kv[it][i] * pi; }
#pragma unroll
    for (int i = 0; i < 4; ++i)
#pragma unroll
        for (int e = 0; e < 4; ++e) { float v = acc[i][e]; v += __shfl_xor(v, 16); v += __shfl_xor(v, 32); acc[i][e] = v; }
    if (g == 0) {
#pragma unroll
        for (int i = 0; i < 4; ++i) *(LAS f32x4*)(ored + F.wave * 256 + 64 * i + 4 * dl) = acc[i]; }
    __syncthreads();
    if (F.tid < 256) { float o = 0.f;
#pragma unroll
        for (int w = 0; w < 8; ++w) o += ored[w * 256 + F.tid];
        orow[F.tid] = (bf16)(pk2(o / tot, 0.f) & 0xffffu); }
    __syncthreads();
}

typedef unsigned v2u_ __attribute__((ext_vector_type(2)));
template <int NKS, class Epi>
__device__ __forceinline__ void small_gemm_item(const Frame& F, const bf16* Arow0, const bf16* Bt, int pn, int j, int rq, const Epi& E) {
    using pg8::f32x4;
    constexpr int K = NKS * 256;
    const int fr = F.lane & 15, fq = F.lane >> 4;
    const bf16* ap = Arow0 + (size_t)(32 * rq + fr) * K + F.wave * (K / 8) + 8 * fq;
    const bf16* b0 = Bt + (size_t)(256 * pn + 16 * j + fr) * K + F.wave * (K / 8) + 8 * fq; const bf16* b1 = b0 + (size_t)128 * K;
    bf16x8 a0[NKS], a1[NKS], x0[NKS], x1[NKS];
#pragma unroll
    for (int u = 0; u < NKS; ++u) { a0[u] = *(const GAS bf16x8*)(ap + 32 * u); a1[u] = *(const GAS bf16x8*)(ap + (size_t)16 * K + 32 * u); x0[u] = *(const GAS bf16x8*)(b0 + 32 * u); x1[u] = *(const GAS bf16x8*)(b1 + 32 * u); }
    __builtin_amdgcn_sched_barrier(0);
    f32x4 c00 = (f32x4){0.f, 0.f, 0.f, 0.f}, c01 = c00, c10 = c00, c11 = c00;
#pragma unroll
    for (int u = 0; u < NKS; ++u) {
        c00 = __builtin_amdgcn_mfma_f32_16x16x32_bf16(x0[u], a0[u], c00, 0, 0, 0); c01 = __builtin_amdgcn_mfma_f32_16x16x32_bf16(x1[u], a0[u], c01, 0, 0, 0);
        c10 = __builtin_amdgcn_mfma_f32_16x16x32_bf16(x0[u], a1[u], c10, 0, 0, 0); c11 = __builtin_amdgcn_mfma_f32_16x16x32_bf16(x1[u], a1[u], c11, 0, 0, 0);
    }
    LAS f32x4* red = (LAS f32x4*)(F.lds + RING_OFF);
    red[(F.wave * 4 + 0) * 64 + F.lane] = c00; red[(F.wave * 4 + 1) * 64 + F.lane] = c01; red[(F.wave * 4 + 2) * 64 + F.lane] = c10; red[(F.wave * 4 + 3) * 64 + F.lane] = c11;
    __syncthreads();
    if (F.wave < 2) {
        f32x4 sA = (f32x4){0.f, 0.f, 0.f, 0.f}, sB = sA;
#pragma unroll
        for (int w = 0; w < 8; ++w) { sA = sA + red[(w * 4 + 2 * F.wave) * 64 + F.lane]; sB = sB + red[(w * 4 + 2 * F.wave + 1) * 64 + F.lane]; }
        E(32 * rq + 16 * F.wave + fr, pn, j, fq, sA, sB);
    }
    __syncthreads();
}
__device__ __forceinline__ v2u_ pk4(const pg8::f32x4& a) { v2u_ w; w.x = pk2(a[0], a[1]); w.y = pk2(a[2], a[3]); return w; }
struct SEpiIn { bf16* PBs;
    __device__ __forceinline__ void operator()(int m, int pn, int j, int fq, const pg8::f32x4& a, const pg8::f32x4& b) const {
        if (pn < 4) { pg8::f32x4 v;
#pragma unroll
            for (int i = 0; i < 4; ++i) v[i] = a[i] * sigm(b[i]);
            *(GAS v2u_*)(PBs + (size_t)m * PBLD + 128 * pn + 16 * j + 4 * fq) = pk4(v); }
        else { bf16* rp = PBs + (size_t)m * PBLD + 256 * pn - 512 + 16 * j + 4 * fq; *(GAS v2u_*)rp = pk4(a); *(GAS v2u_*)(rp + 128) = pk4(b); }
    } };
template <int MODE> struct SEpiRes { const float* basef; const bf16* baseb; float* outf; bf16* outb; float* ss;
    __device__ __forceinline__ void operator()(int m, int pn, int j, int fq, const pg8::f32x4& a, const pg8::f32x4& b) const {
        const size_t off = (size_t)m * DM + 256 * pn + 16 * j + 4 * fq;
        pg8::f32x4 b0, b1;
        if (MODE == 0) { b0 = *(const GAS pg8::f32x4*)(basef + off); b1 = *(const GAS pg8::f32x4*)(basef + off + 128); }
        else { const v2u_ w0 = *(const GAS v2u_*)(baseb + off), w1 = *(const GAS v2u_*)(baseb + off + 128); b0 = pg8::bf4lo(w0.x, w0.y); b1 = pg8::bf4lo(w1.x, w1.y); }
        const pg8::f32x4 v0 = a + b0, v1 = b + b1;
        if (MODE == 2) { *(GAS pg8::f32x4*)(outf + off) = v0; *(GAS pg8::f32x4*)(outf + off + 128) = v1; }
        else { *(GAS v2u_*)(outb + off) = pk4(v0); *(GAS v2u_*)(outb + off + 128) = pk4(v1); }
        float s = (v0[0] * v0[0] + v0[1] * v0[1]) + (v0[2] * v0[2] + v0[3] * v0[3]) + (v1[0] * v1[0] + v1[1] * v1[1]) + (v1[2] * v1[2] + v1[3] * v1[3]);
        s += __shfl_xor(s, 16); s += __shfl_xor(s, 32);
        if (fq == 0) atomicAdd(ss + m, s);
    } };
struct SEpiQ { bf16* Qs; const float* ss; float c2;
    __device__ __forceinline__ void operator()(int m, int pn, int j, int fq, const pg8::f32x4& a, const pg8::f32x4& b) const {
        const float rs = __builtin_amdgcn_rsqf(ss[m] * (1.f / 1024.f) + RMS_EPS) * c2; bf16* rp = Qs + (size_t)m * DM + 256 * pn + 16 * j + 4 * fq;
        *(GAS v2u_*)rp = pk4(a * rs); *(GAS v2u_*)(rp + 128) = pk4(b * rs);
    } };
struct SEpiGU { bf16* Ts; const float* ss;
    __device__ __forceinline__ void operator()(int m, int pn, int j, int fq, const pg8::f32x4& a, const pg8::f32x4& b) const {
        const float rs = __builtin_amdgcn_rsqf(ss[m] * (1.f / 1024.f) + RMS_EPS); pg8::f32x4 v;
#pragma unroll
        for (int i = 0; i < 4; ++i) v[i] = silu(a[i] * rs) * (b[i] * rs);
        *(GAS v2u_*)(Ts + (size_t)m * DFF + 128 * pn + 16 * j + 4 * fq) = pk4(v);
    } };

__device__ __forceinline__ void final_norm_phase(const Args& A, Frame& F) {
    const int gw = F.vcu * NWAVES + F.wave, NGW = F.G * NWAVES; const float* ss = (const float*)(F.ctl + CW_SS3); const float* X3S = (const float*)(A.ws + WS_X1S);
    f32x4 gn[4];
#pragma unroll
    for (int j = 0; j < 4; ++j) gn[j] = *(const f32x4*)(A.in[I_NF] + 256 * j + 4 * F.lane);
    for (int m = gw; m < DEC; m += NGW) {
        const GAS f32x4* xr = (const GAS f32x4*)(X3S + (size_t)m * DM) + F.lane; GAS f32x4* yr = (GAS f32x4*)(A.out + (size_t)(MP + m) * DM) + F.lane;
        const float rstd = 1.f / sqrtf(ss[MP + m] * (1.f / DM) + RMS_EPS);
#pragma unroll
        for (int j = 0; j < 4; ++j) yr[64 * j] = xr[64 * j] * rstd * gn[j];
    }
}

__global__ void __launch_bounds__(NWAVES * 64, 2) hymba_fwd(Args args) {
    extern __shared__ __attribute__((aligned(16))) unsigned char lds[];
    Frame F;
    F.lds = (LAS unsigned char*)lds;
    F.MISC = (volatile LAS unsigned*)(F.lds + MISC_OFF);
    F.tid = threadIdx.x; F.lane = F.tid & 63; F.wave = __builtin_amdgcn_readfirstlane(F.tid >> 6);
    F.G = gridDim.x; { const int bx = blockIdx.x; F.vcu = (F.G % 8 == 0) ? (bx % 8) * (F.G / 8) + bx / 8 : bx; }
    F.ctl = (gu32*)(args.ws + WS_CTL);
    const Args& A = args;
    for (int u = F.tid; u < (LDS_BYTES - LDSCTL_OFF) / 4; u += NWAVES * 64) ((LAS unsigned*)(F.lds + LDSCTL_OFF))[u] = 0u;
    __syncthreads();
#if MK_PER_PHASE
#define GRID_BAR() do { } while (0)
#else
    XcdBarrier bar = xcd_barrier_post((unsigned*)(F.ctl + CW_BAR) + args.li * XCD_BAR_WORDS, F.MISC + 8);
#define GRID_BAR() xcd_barrier(bar)
#endif
#if 1
    const int lo = args.ph_lo, hi = args.ph_hi;
    const bool rep = (args.li != 0);
#define REPK(k) (rep && lo == (k))
#ifdef ONLY_PH
#define IN(k) ((k) == ONLY_PH && lo <= (k) && (k) < hi)
#else
#define IN(k) (lo <= (k) && (k) < hi)
#endif
#else
#define REPK(k) false
#define IN(k) true
#endif
#define BOTH(k) (IN(k) && IN((k) + 1))
#define PH_PTRS unsigned char* const ws = args.ws; bf16* const RA = (bf16*)(ws + WS_RA); bf16* const RB = (bf16*)(ws + WS_RB); bf16* const RC = (bf16*)(ws + WS_RC); \
    bf16* const AO = (bf16*)(ws + WS_RD); bf16* const X1B = (bf16*)(ws + WS_RE); \
    float* const SS1 = (float*)(ws + WS_CTL) + CW_SS1; float* const SS2 = (float*)(ws + WS_CTL) + CW_SS2; float* const SS3 = (float*)(ws + WS_CTL) + CW_SS3; float* const SSD = (float*)(ws + WS_CTL) + 163840; \
    (void)RA; (void)RB; (void)RC; (void)AO; (void)X1B; (void)SS1; (void)SS2; (void)SS3; (void)SSD;

    if (IN(0)) { p0_prologue(A, F); if (BOTH(0)) GRID_BAR(); }
    if (IN(1)) { PH_PTRS
        { pg8::Gemm g{RB, (const bf16*)(ws + WS_WIN), MP, 3072, DM}; pg8::StaticOrder S; S.init(MP, 3072, F.G, (int)blockIdx.x);
          pg8::EpiIn E{RA};
          pg8::gemm_phase<pg8::EpiIn, pg8::StaticOrder, true, true>(F.lds + RING_OFF, g, S, E); }
        { const SEpiIn E{RA + (size_t)MP * PBLD};
          for (int i = F.G - 1 - (int)blockIdx.x; i < 96 * 4; i += F.G) small_gemm_item<4>(F, RB + (size_t)MP * DM, (const bf16*)(ws + WS_WIN), i >> 5, (i >> 2) & 7, i & 3, E); }
        if (BOTH(1)) GRID_BAR();
    }
    if (IN(2)) {
        for (int it = F.vcu; it < 256; it += F.G) { const int b = it >> 5, tile = it & 31;
            short_conv_tile(A, F, b, tile);
            VM_WAIT(); __syncthreads();
            { D1In cur, nxt; d1_load(A, F, (b * NH) * 32 + tile, cur);
              _Pragma("unroll 1") for (int h = 0; h < NH; ++h) { const int hn = h + 1 < NH ? h + 1 : h; d1_load(A, F, (b * NH + hn) * 32 + tile, nxt); d1_chunk(A, F, (b * NH + h) * 32 + tile, cur); cur = nxt; } } }
#ifdef PROBE_PH
        if (!(args.pad & 4))
#endif
        for (int s = F.G - 1 - F.vcu; s < DEC; s += F.G) sample_mixer(A, F, s);
        for (int s = F.vcu; s < DEC; s += F.G) conv31_sample(A, F, s);
        if (BOTH(2)) GRID_BAR();
    }
    if (IN(3)) { PH_PTRS
        if ((int)blockIdx.x < 128) {
            const int u = ((int)blockIdx.x & 7) * 16 + ((int)blockIdx.x >> 3);
            scan_unit(A, F, u >> 4, (u >> 2) & 3, 2 * (u & 3));
        } else if ((int)blockIdx.x < 192) {
            pg8::Gemm g{(const bf16*)(ws + WS_MEMN), (const bf16*)(ws + WS_WMKV), NB * NMEM, 2048, DM}; pg8::StaticOrder S; S.init(NB * NMEM, 2048, 64, (int)blockIdx.x - 128);
            pg8::EpiKV E{A.out + OUT_MKP, A.out + OUT_MVP, (bf16*)(ws + WS_KB), (bf16*)(ws + WS_VT)};
            pg8::gemm_phase<pg8::EpiKV, pg8::StaticOrder, true, true>(F.lds + RING_OFF, g, S, E);
        } else {
            weights_phase(A, F, TR_N1, TR_N, ((int)blockIdx.x - 192) * NWAVES + F.wave, (F.G - 192) * NWAVES);
            __syncthreads();
        }
        if ((int)blockIdx.x >= 128) {
            _Pragma("unroll 1") for (int it = (int)blockIdx.x - 128; it < 256; it += F.G - 128) conv31_tile(A, F, it >> 5, it & 31);
        }
        { const SEpiRes<0> SE{A.in[I_XS], nullptr, nullptr, X1B + (size_t)MP * DM, (REPK(3) ? SSD : SS1) + MP};
          for (int i = F.G - 1 - (int)blockIdx.x; i < 32 * 4; i += F.G) small_gemm_item<4>(F, RB + (size_t)MP * DM, (const bf16*)(ws + WS_WOUT), i >> 5, (i >> 2) & 7, i & 3, SE); }
        if (BOTH(3)) GRID_BAR();
    }
    if (IN(4)) { PH_PTRS
        ogate_phase(A, F, F.vcu, F.G);
        { const SEpiQ SE{RB + (size_t)MP * DM, SS1 + MP, ATT_C2};
          for (int i = F.G - 1 - (int)blockIdx.x; i < 32 * 4; i += F.G) small_gemm_item<4>(F, X1B + (size_t)MP * DM, (const bf16*)(ws + WS_WMQ), i >> 5, (i >> 2) & 7, i & 3, SE); }
        if (BOTH(4)) GRID_BAR();
    }
    if (IN(5)) { PH_PTRS
        const bool stream_first = (((int)blockIdx.x >> 3) & 1) != 0;
        if (stream_first) { _Pragma("unroll 1") for (int it = F.vcu; it < DEC * NH; it += F.G) attn_sample(A, F, it >> 2, it & 3); }
        { pg8::Gemm g{RB, (const bf16*)(ws + WS_WOUT), MP, DM, DM}; pg8::StaticOrder S; S.init(MP, DM, F.G, (int)blockIdx.x);
          pg8::EpiRes<true> E{A.in[I_XP], nullptr, X1B, REPK(5) ? SSD : SS1};
          pg8::gemm_phase<pg8::EpiRes<true>, pg8::StaticOrder, true, true>(F.lds + RING_OFF, g, S, E); }
        if (!stream_first) { _Pragma("unroll 1") for (int it = F.vcu; it < DEC * NH; it += F.G) attn_sample(A, F, it >> 2, it & 3); }
        if (BOTH(5)) GRID_BAR();
    }
    if (IN(6)) { PH_PTRS
        pg8::Gemm g{X1B, (const bf16*)(ws + WS_WMQ), MP, DM, DM}; pg8::StaticOrder S; S.init(MP, DM, F.G, (int)blockIdx.x);
        pg8::EpiQ E{RB, SS1, ATT_C2};
        pg8::gemm_phase<pg8::EpiQ, pg8::StaticOrder, true, true>(F.lds + RING_OFF, g, S, E);
        { pg8::Unit u; _Pragma("unroll 1") for (int i = 0; i < 2 * 64; ++i) { if (!S.next(i >> 1, u)) break; attn_unit(A, F, 2 * u.pm + (i & 1), u.pn); } }
        { const SEpiRes<1> SE{nullptr, X1B + (size_t)MP * DM, nullptr, RC + (size_t)MP * DM, (REPK(6) ? SSD : SS2) + MP};
          for (int i = F.G - 1 - (int)blockIdx.x; i < 32 * 4; i += F.G) small_gemm_item<4>(F, AO + (size_t)MP * DM, (const bf16*)(ws + WS_WMO), i >> 5, (i >> 2) & 7, i & 3, SE); }
        if (BOTH(6)) GRID_BAR();
    }
    if (IN(7)) { PH_PTRS
        pg8::Gemm g{AO, (const bf16*)(ws + WS_WMO), MP, DM, DM}; pg8::StaticOrder S; S.init(MP, DM, F.G, (int)blockIdx.x);
        pg8::EpiRes<false> E{nullptr, X1B, RC, REPK(7) ? SSD : SS2};
        pg8::gemm_phase<pg8::EpiRes<false>, pg8::StaticOrder, true, true>(F.lds + RING_OFF, g, S, E);
        { const SEpiGU SE{RA + (size_t)MP * DFF, SS2 + MP};
          for (int i = F.G - 1 - (int)blockIdx.x; i < 176 * 4; i += F.G) small_gemm_item<4>(F, RC + (size_t)MP * DM, (const bf16*)(ws + WS_WGU), i >> 5, (i >> 2) & 7, i & 3, SE); }
        if (BOTH(7)) GRID_BAR();
    }
    if (IN(8)) { PH_PTRS
        pg8::Gemm g{RC, (const bf16*)(ws + WS_WGU), MP, 2 * DFF, DM}; pg8::StaticOrder S; S.init(MP, 2 * DFF, F.G, (int)blockIdx.x);
        pg8::EpiGU E{RA, SS2};
        pg8::gemm_phase<pg8::EpiGU, pg8::StaticOrder, true, true>(F.lds + RING_OFF, g, S, E);
        { const SEpiRes<2> SE{nullptr, RC + (size_t)MP * DM, (float*)(ws + WS_X1S), nullptr, (REPK(8) ? SSD : SS3) + MP};
          for (int i = F.G - 1 - (int)blockIdx.x; i < 32 * 4; i += F.G) small_gemm_item<11>(F, RA + (size_t)MP * DFF, (const bf16*)(ws + WS_WDN), i >> 5, (i >> 2) & 7, i & 3, SE); }
        if (BOTH(8)) GRID_BAR();
    }
    if (IN(9)) { PH_PTRS
        final_norm_phase(A, F);
        pg8::Gemm g{RA, (const bf16*)(ws + WS_WDN), MP, DM, DFF}; pg8::StaticOrder S; S.init(MP, DM, F.G, (int)blockIdx.x);
        pg8::EpiResNorm E{RC, A.out, A.in[I_NF], (float*)(ws + WS_XBUF), (unsigned*)(ws + WS_CTL) + CW_PANEL, (unsigned*)(ws + WS_CTL) + CW_TMO};
        pg8::gemm_phase<pg8::EpiResNorm, pg8::StaticOrder, false, true>(F.lds + RING_OFF, g, S, E);
    }
#undef IN
#undef BOTH
}

extern "C" void kernel_launch(void* const* d_in, const int* in_sizes, int n_in, void* d_out, int out_size, void* d_ws, size_t ws_size, hipStream_t stream) {
    static int grid = 0;
    if (grid == 0) {
        if (n_in != 30 || in_sizes[0] != MP * DM || (size_t)out_size != OUT_END || ws_size < WS_END) {
            fprintf(stderr, "kernel_launch: unexpected shapes: n_in %d, in0 %d, out %d, ws %zu (need >= %zu); nothing launched\n", n_in, n_in > 0 ? in_sizes[0] : -1, out_size, ws_size, (size_t)WS_END); grid = -1; return; }
        int dev = 0, cus = 0, per_cu = 0;
        if (hipGetDevice(&dev) != hipSuccess || hipDeviceGetAttribute(&cus, hipDeviceAttributeMultiprocessorCount, dev) != hipSuccess) { fprintf(stderr, "kernel_launch: device query failed\n"); grid = -1; return; }
        if (hipFuncSetAttribute((const void*)hymba_fwd, hipFuncAttributeMaxDynamicSharedMemorySize, LDS_BYTES) != hipSuccess) { fprintf(stderr, "kernel_launch: hipFuncSetAttribute failed\n"); grid = -1; return; }
        if (hipOccupancyMaxActiveBlocksPerMultiprocessor(&per_cu, (const void*)hymba_fwd, NWAVES * 64, LDS_BYTES) != hipSuccess || per_cu < 1)
            fprintf(stderr, "kernel_launch: note: occupancy query reports %d workgroups per CU\n", per_cu);
        (void)hipGetLastError();
        grid = cus;
        if (grid != 256) { fprintf(stderr, "kernel_launch: built for 256 CUs (one 256x256 unit per workgroup in the fused final-norm phase); found %d; nothing launched\n", grid); grid = -1; return; }
    }
    if (grid < 0) return;
    if (hipMemsetAsync((char*)d_ws + WS_CTL, 0, CTL_ZERO_BYTES, stream) != hipSuccess) { fprintf(stderr, "kernel_launch: hipMemsetAsync failed\n"); return; }
    Args a{};
    for (int i = 0; i < 30; ++i) a.in[i] = (const float*)d_in[i];
    a.out = (float*)d_out; a.ws = (unsigned char*)d_ws;
#if MK_PER_PHASE
    for (int ph = 0; ph < N_PHASES; ++ph) { a.ph_lo = ph; a.ph_hi = ph + 1; a.li = 0;
        hipLaunchKernelGGL(hymba_fwd, dim3(grid), dim3(NWAVES * 64), LDS_BYTES, stream, a); }
#else
#ifdef PROBE_PH
    a.ph_lo = 0; a.ph_hi = PROBE_PH + 1; a.li = 0;
    hipLaunchKernelGGL(hymba_fwd, dim3(grid), dim3(NWAVES * 64), LDS_BYTES, stream, a);
#ifdef PROBE_REPS
    for (int r_ = 0; r_ < PROBE_REPS; ++r_) { a.ph_lo = PROBE_PH; a.ph_hi = PROBE_PH + 1; a.li = 2 + r_; a.pad = PROBE_MODE; hipLaunchKernelGGL(hymba_fwd, dim3(grid), dim3(NWAVES * 64), LDS_BYTES, stream, a); }
#endif
    a.ph_lo = PROBE_PH; a.ph_hi = N_PHASES; a.li = 1; a.pad = 0;
    hipLaunchKernelGGL(hymba_fwd, dim3(grid), dim3(NWAVES * 64), LDS_BYTES, stream, a);
#else
    a.ph_lo = 0; a.ph_hi = N_PHASES; a.li = 0;
    hipLaunchKernelGGL(hymba_fwd, dim3(grid), dim3(NWAVES * 64), LDS_BYTES, stream, a);
#endif
#endif
    const hipError_t le = hipPeekAtLastError();
    if (le != hipSuccess) fprintf(stderr, "kernel_launch: launch failed: %s\n", hipGetErrorName(le));
}
```

```cpp
#include <hip/hip_runtime.h>
#include <cstdio>
#include <cstdint>
#define MK_PER_PHASE 0
namespace pg8 {
#define PG8_LAS __attribute__((address_space(3)))
typedef unsigned short bf16_t;
typedef short bf16x8 __attribute__((ext_vector_type(8)));
typedef float f32x4 __attribute__((ext_vector_type(4)));
typedef unsigned u32x4 __attribute__((ext_vector_type(4)));
constexpr int BM = 256, BK = 64, HALF = 128, HTB = HALF * BK * 2  , STAGE_BYTES = 8 * HTB, NXCD = 8, WGM = 8;

__host__ __device__ __forceinline__ int lds_byte(int r, int c) { const int st = (r >> 4) * 2 + (c >> 5), rr = r & 15, cc = c & 31, ob = rr * 64 + cc * 2; return st * 1024 + (ob ^ (((ob >> 9) & 1) << 5)); }
__host__ __device__ __forceinline__ void stage_rc(int b, int& R, int& C) { const int st = b / 1024, sb = b % 1024, swz = sb ^ (((sb >> 9) & 1) << 5); R = (st >> 1) * 16 + swz / 64; C = (st & 1) * 32 + (swz % 64) / 2; }
__host__ __device__ __forceinline__ int perm32(int rho) { const int n = rho >> 4, i = rho & 15; return 8 * (i >> 2) + 4 * n + (i & 3); }

struct Unit { int pm, pn; };
struct Gemm { const bf16_t* A; const bf16_t* Bt; int M, N, K; };

struct StaticOrder {
    int nM, nN, nwg, G, c;
    __host__ __device__ __forceinline__ void init(int M, int N, int G_, int c_) { nM = M / BM; nN = N / BM; nwg = nM * nN; G = G_; c = c_; }
    __host__ __device__ __forceinline__ bool next(int i, Unit& u) const {
        const long L = (long)i * G + c; if (L >= nwg) return false;
        int wgid = (int)L; { const int q = nwg / NXCD, r = nwg % NXCD, xcd = wgid % NXCD, off = wgid / NXCD; wgid = (xcd < r ? xcd * (q + 1) : r * (q + 1) + (xcd - r) * q) + off; }
        const int nig = WGM * nN, gid = wgid / nig, fm = gid * WGM, gsz = (nM - fm) < WGM ? (nM - fm) : WGM;
        u.pm = fm + ((wgid % nig) % gsz); u.pn = (wgid % nig) / gsz; return true;
    }
    __device__ __forceinline__ void a_ready(const Unit&) const {}
    __device__ __forceinline__ void done(const Unit&) const {}
};

__device__ __forceinline__ unsigned cvt_pk_bf16(float lo, float hi) { unsigned r; asm volatile("v_cvt_pk_bf16_f32 %0, %1, %2" : "=v"(r) : "v"(lo), "v"(hi)); return r; }
typedef float f32x2_t __attribute__((ext_vector_type(2))); typedef __bf16 bf16x2_t __attribute__((ext_vector_type(2)));
__device__ __forceinline__ unsigned pk2(float lo, float hi) { f32x2_t v = {lo, hi}; bf16x2_t b = __builtin_convertvector(v, bf16x2_t); return __builtin_bit_cast(unsigned, b); }
__device__ __forceinline__ float sigm(float x) { return __builtin_amdgcn_rcpf(1.f + __expf(-x)); }
__device__ __forceinline__ float silu(float x) { return x * __builtin_amdgcn_rcpf(1.f + __expf(-x)); }
__device__ __forceinline__ u32x4 pk8(const f32x4& a, const f32x4& b) { u32x4 w; w.x = pk2(a[0], a[1]); w.y = pk2(a[2], a[3]); w.z = pk2(b[0], b[1]); w.w = pk2(b[2], b[3]); return w; }
constexpr int PBLD = 2560;
constexpr int MPROMPT = 16384;
constexpr float RMS_EPS = 1e-6f;

struct EpiIn {
    static constexpr bool PERM = true, AFTER_DRAIN = false;
    bf16_t* PB;
    __device__ __forceinline__ void operator()(const f32x4 (&acc)[2][2][4][2], const Unit& u, int wr, int wc, int fr, int fq) const {
        const int row0 = u.pm * BM + wr * 64 + fr;
        if (u.pn < 4) {
            const int ch0 = u.pn * 128 + wc * 32 + 8 * fq;
#pragma unroll
            for (int ai = 0; ai < 2; ++ai)
#pragma unroll
                for (int m = 0; m < 4; ++m) {
                    bf16_t* rowp = PB + (size_t)(row0 + ai * HALF + m * 16) * PBLD + ch0;
                    f32x4 v0, v1;
#pragma unroll
                    for (int i = 0; i < 4; ++i) { v0[i] = acc[ai][0][m][0][i] * sigm(acc[ai][1][m][0][i]); v1[i] = acc[ai][0][m][1][i] * sigm(acc[ai][1][m][1][i]); }
                    *(u32x4*)rowp = pk8(v0, v1);
                }
        } else {
            const int col0 = u.pn * BM - 512 + wc * 32 + 8 * fq;
#pragma unroll
            for (int ai = 0; ai < 2; ++ai)
#pragma unroll
                for (int m = 0; m < 4; ++m) {
                    bf16_t* rowp = PB + (size_t)(row0 + ai * HALF + m * 16) * PBLD + col0;
#pragma unroll
                    for (int bj = 0; bj < 2; ++bj) *(u32x4*)(rowp + bj * HALF) = pk8(acc[ai][bj][m][0], acc[ai][bj][m][1]);
                }
        }
    }
};

struct EpiKV {
    static constexpr bool PERM = true, AFTER_DRAIN = false;
    float* outK; float* outV; bf16_t* KB; bf16_t* VT;
    __device__ __forceinline__ void operator()(const f32x4 (&acc)[2][2][4][2], const Unit& u, int wr, int wc, int fr, int fq) const {
        const int row0 = u.pm * BM + wr * 64 + fr;
        const bool isv = u.pn >= 4;
        const int c0 = (isv ? u.pn - 4 : u.pn) * BM + wc * 32 + 8 * fq;
        float* outp = isv ? outV : outK;
#pragma unroll
        for (int ai = 0; ai < 2; ++ai)
#pragma unroll
            for (int m = 0; m < 4; ++m) {
                const int row = row0 + ai * HALF + m * 16;
#pragma unroll
                for (int bj = 0; bj < 2; ++bj) {
                    const int col = c0 + bj * HALF;
                    const f32x4 a = acc[ai][bj][m][0], b = acc[ai][bj][m][1];
                    *(f32x4*)(outp + (size_t)row * 1024 + col) = a; *(f32x4*)(outp + (size_t)row * 1024 + col + 4) = b;
                    const u32x4 w = pk8(a, b);
                    if (!isv) *(u32x4*)(KB + (size_t)row * 1024 + col) = w;
                    else {
                        bf16_t* vp = VT + (size_t)col * 2048 + (row - fr) + (8 * ((fr >> 2) & 1) + 4 * (fr >> 3) + (fr & 3));
                        vp[0 * 2048] = (bf16_t)(w.x & 0xffffu); vp[1 * 2048] = (bf16_t)(w.x >> 16); vp[2 * 2048] = (bf16_t)(w.y & 0xffffu); vp[3 * 2048] = (bf16_t)(w.y >> 16);
                        vp[4 * 2048] = (bf16_t)(w.z & 0xffffu); vp[5 * 2048] = (bf16_t)(w.z >> 16); vp[6 * 2048] = (bf16_t)(w.w & 0xffffu); vp[7 * 2048] = (bf16_t)(w.w >> 16);
                    }
                }
            }
    }
};

struct EpiQL {
    static constexpr bool PERM = true, AFTER_DRAIN = true;
    const float* ss; float c2;
    __device__ __forceinline__ void fused(f32x4 (&acc)[2][2][4][2], const Unit& u, int wr, int wc, int fr, int fq, PG8_LAS unsigned char* lds, int wid, int lane) const {
#pragma unroll
        for (int ai = 0; ai < 2; ++ai)
#pragma unroll
            for (int m = 0; m < 4; ++m) {
                const int rl = wr * 64 + ai * HALF + m * 16 + fr;
                const float rs = __builtin_amdgcn_rsqf(ss[u.pm * BM + rl] * (1.f / 1024.f) + RMS_EPS) * c2;
#pragma unroll
                for (int bj = 0; bj < 2; ++bj) { const int ch = wc * 4 + bj * 16 + fq;
                    *(PG8_LAS u32x4*)(lds + rl * 512 + ((ch ^ (rl & 31)) << 4)) = pk8(acc[ai][bj][m][0] * rs, acc[ai][bj][m][1] * rs); }
            }
    }
};

__device__ __forceinline__ f32x4 bf4lo(unsigned a, unsigned b) { return (f32x4){__uint_as_float(a << 16), __uint_as_float(a & 0xffff0000u), __uint_as_float(b << 16), __uint_as_float(b & 0xffff0000u)}; }
template <bool BASE_F32> struct EpiRes {
    static constexpr bool PERM = true, AFTER_DRAIN = false;
    const float* basef; const bf16_t* baseb; bf16_t* outb; float* ss; const float* rn;
    __device__ __forceinline__ void operator()(const f32x4 (&acc)[2][2][4][2], const Unit& u, int wr, int wc, int fr, int fq) const {
        const int row0 = u.pm * BM + wr * 64 + fr; const int col0 = u.pn * BM + wc * 32 + 8 * fq;
        u32x4 pw[2][4][2]; float rnv[2][4];
#pragma unroll
        for (int ai = 0; ai < 2; ++ai)
#pragma unroll
            for (int m = 0; m < 4; ++m) {
#pragma unroll
                for (int bj = 0; bj < 2; ++bj) pw[ai][m][bj] = __builtin_nontemporal_load((const u32x4*)(baseb + (size_t)(row0 + ai * HALF + m * 16) * 1024 + col0 + bj * HALF));
                rnv[ai][m] = BASE_F32 ? rn[row0 + ai * HALF + m * 16] : 1.f; }
        __builtin_amdgcn_sched_barrier(0);
#pragma unroll
        for (int ai = 0; ai < 2; ++ai) {
#pragma unroll
            for (int m = 0; m < 4; ++m) {
                const int row = row0 + ai * HALF + m * 16; const size_t off = (size_t)row * 1024 + col0;
                float s = 0.f;
#pragma unroll
                for (int bj = 0; bj < 2; ++bj) {
                    const u32x4 w = pw[ai][m][bj]; const f32x4 p0 = bf4lo(w.x, w.y), p1 = bf4lo(w.z, w.w);
                    const f32x4 v0 = BASE_F32 ? acc[ai][bj][m][0] + p0 * rnv[ai][m] : acc[ai][bj][m][0] + p0, v1 = BASE_F32 ? acc[ai][bj][m][1] + p1 * rnv[ai][m] : acc[ai][bj][m][1] + p1;
                    s += (v0[0] * v0[0] + v0[1] * v0[1]) + (v0[2] * v0[2] + v0[3] * v0[3]) + (v1[0] * v1[0] + v1[1] * v1[1]) + (v1[2] * v1[2] + v1[3] * v1[3]);
                    *(u32x4*)(outb + off + bj * HALF) = pk8(v0, v1);
                }
                s += __shfl_xor(s, 16); s += __shfl_xor(s, 32);
                if (fq == 0) atomicAdd(ss + row, s);
            }
        }
    }
};

struct EpiQ {
    static constexpr bool PERM = true, AFTER_DRAIN = false;
    bf16_t* Q; const float* ss; float c2;
    __device__ __forceinline__ void operator()(const f32x4 (&acc)[2][2][4][2], const Unit& u, int wr, int wc, int fr, int fq) const {
        const int row0 = u.pm * BM + wr * 64 + fr; const int col0 = u.pn * BM + wc * 32 + 8 * fq;
#pragma unroll
        for (int ai = 0; ai < 2; ++ai)
#pragma unroll
            for (int m = 0; m < 4; ++m) {
                const int row = row0 + ai * HALF + m * 16;
                const float rs = __builtin_amdgcn_rsqf(ss[row] * (1.f / 1024.f) + RMS_EPS) * c2;
#pragma unroll
                for (int bj = 0; bj < 2; ++bj) *(u32x4*)(Q + (size_t)row * 1024 + col0 + bj * HALF) = pk8(acc[ai][bj][m][0] * rs, acc[ai][bj][m][1] * rs);
            }
    }
};

struct EpiGU {
    static constexpr bool PERM = true, AFTER_DRAIN = false;
    bf16_t* T; const float* ss;
    __device__ __forceinline__ void operator()(const f32x4 (&acc)[2][2][4][2], const Unit& u, int wr, int wc, int fr, int fq) const {
        const int row0 = u.pm * BM + wr * 64 + fr; const int ch0 = u.pn * 128 + wc * 32 + 8 * fq;
#pragma unroll
        for (int ai = 0; ai < 2; ++ai)
#pragma unroll
            for (int m = 0; m < 4; ++m) {
                const int row = row0 + ai * HALF + m * 16;
                const float rs = __builtin_amdgcn_rsqf(ss[row] * (1.f / 1024.f) + RMS_EPS);
                f32x4 v0, v1;
#pragma unroll
                for (int i = 0; i < 4; ++i) { v0[i] = silu(acc[ai][0][m][0][i] * rs) * (acc[ai][1][m][0][i] * rs); v1[i] = silu(acc[ai][0][m][1][i] * rs) * (acc[ai][1][m][1][i] * rs); }
                *(u32x4*)(T + (size_t)row * 2816 + ch0) = pk8(v0, v1);
            }
    }
};


struct EpiResNorm {
    static constexpr bool PERM = true, AFTER_DRAIN = true;
    const bf16_t* base; float* out; const float* gain; float* xbuf; unsigned* cnt; unsigned* tmo;
    __device__ __forceinline__ void fused(f32x4 (&acc)[2][2][4][2], const Unit& u, int wr, int wc, int fr, int fq, PG8_LAS unsigned char* lds, int wid, int lane) const {
        PG8_LAS float* P = (PG8_LAS float*)lds;
        PG8_LAS float* S = (PG8_LAS float*)(lds + 4096);
        PG8_LAS unsigned* flag = (PG8_LAS unsigned*)(lds + 4096 + 1024);
        const int row0 = u.pm * BM + wr * 64 + fr; const int col0 = u.pn * BM + wc * 32 + 8 * fq;
        u32x4 pw[2][4][2];
#pragma unroll
        for (int ai = 0; ai < 2; ++ai)
#pragma unroll
            for (int m = 0; m < 4; ++m)
#pragma unroll
                for (int bj = 0; bj < 2; ++bj) pw[ai][m][bj] = __builtin_nontemporal_load((const u32x4*)(base + (size_t)(row0 + ai * HALF + m * 16) * 1024 + col0 + bj * HALF));
        __builtin_amdgcn_sched_barrier(0);
#pragma unroll
        for (int ai = 0; ai < 2; ++ai) {
#pragma unroll
            for (int m = 0; m < 4; ++m) {
                float s = 0.f;
#pragma unroll
                for (int bj = 0; bj < 2; ++bj) {
                    const u32x4 w = pw[ai][m][bj];
                    const f32x4 v0 = acc[ai][bj][m][0] + bf4lo(w.x, w.y), v1 = acc[ai][bj][m][1] + bf4lo(w.z, w.w);
                    acc[ai][bj][m][0] = v0; acc[ai][bj][m][1] = v1;
                    s += (v0[0] * v0[0] + v0[1] * v0[1]) + (v0[2] * v0[2] + v0[3] * v0[3]) + (v1[0] * v1[0] + v1[1] * v1[1]) + (v1[2] * v1[2] + v1[3] * v1[3]);
                }
                s += __shfl_xor(s, 16); s += __shfl_xor(s, 32);
                if (fq == 0) P[(ai * HALF + wr * 64 + m * 16 + fr) * 4 + wc] = s;
            }
        }
        asm volatile("s_waitcnt lgkmcnt(0)" ::: "memory"); __builtin_amdgcn_s_barrier(); asm volatile("" ::: "memory");
        const int row = wid * 64 + lane;
        if (wid < 4) {
            const float t = (P[row * 4 + 0] + P[row * 4 + 1]) + (P[row * 4 + 2] + P[row * 4 + 3]);
            __hip_atomic_store(xbuf + (size_t)(u.pm * BM + row) * 4 + u.pn, t, __ATOMIC_RELAXED, __HIP_MEMORY_SCOPE_AGENT);
            asm volatile("s_waitcnt vmcnt(0)" ::: "memory");
            if (lane == 0) __hip_atomic_fetch_add(cnt + 64 * u.pm, 1u, __ATOMIC_RELAXED, __HIP_MEMORY_SCOPE_AGENT);
        }
        if (wid == 0) {
            unsigned spins = 0; bool dead = false;
            while ((unsigned)__builtin_amdgcn_readfirstlane(__hip_atomic_load(cnt + 64 * u.pm, __ATOMIC_RELAXED, __HIP_MEMORY_SCOPE_AGENT)) < 16u) {
                __builtin_amdgcn_s_sleep(2);
                if (++spins > (1u << 22)) { dead = true; if (lane == 0) __hip_atomic_store(tmo, 1u, __ATOMIC_RELAXED, __HIP_MEMORY_SCOPE_AGENT); break; }
            }
            __builtin_amdgcn_fence(__ATOMIC_ACQUIRE, "agent");
            if (lane == 0) flag[0] = dead ? 1u : 0u;
        }
        asm volatile("s_waitcnt vmcnt(0) lgkmcnt(0)" ::: "memory"); __builtin_amdgcn_s_barrier(); asm volatile("" ::: "memory");
        if (wid < 4) {
            const float* sl = xbuf + (size_t)(u.pm * BM + row) * 4; float t = 0.f;
#pragma unroll
            for (int q = 0; q < 4; ++q) t += __hip_atomic_load(sl + q, __ATOMIC_RELAXED, __HIP_MEMORY_SCOPE_AGENT);
            S[row] = __builtin_amdgcn_rsqf(t * (1.f / 1024.f) + RMS_EPS);
        }
        asm volatile("s_waitcnt vmcnt(0) lgkmcnt(0)" ::: "memory"); __builtin_amdgcn_s_barrier(); asm volatile("" ::: "memory");
        f32x4 gv[2][2];
#pragma unroll
        for (int bj = 0; bj < 2; ++bj) { gv[bj][0] = *(const f32x4*)(gain + col0 + bj * HALF); gv[bj][1] = *(const f32x4*)(gain + col0 + bj * HALF + 4); }
#pragma unroll
        for (int ai = 0; ai < 2; ++ai)
#pragma unroll
            for (int m = 0; m < 4; ++m) {
                const int rl = ai * HALF + wr * 64 + m * 16 + fr; const float rs = S[rl]; const size_t off = (size_t)(u.pm * BM + rl) * 1024 + col0;
#pragma unroll
                for (int bj = 0; bj < 2; ++bj) { *(f32x4*)(out + off + bj * HALF) = acc[ai][bj][m][0] * rs * gv[bj][0]; *(f32x4*)(out + off + bj * HALF + 4) = acc[ai][bj][m][1] * rs * gv[bj][1]; }
            }
    }
};

template <class Epi, class Sched, bool ALIGN_EPI = false, bool SP2 = false>
__device__ __forceinline__ void gemm_phase(PG8_LAS unsigned char* lds, const Gemm g, const Sched& S, const Epi& E) {
    const int tid = threadIdx.x, wid = __builtin_amdgcn_readfirstlane(tid >> 6), lane = tid & 63, wr = wid >> 2, wc = wid & 3, fr = lane & 15, fq = lane >> 4;
    const int K = g.K, nt = K / BK;
    unsigned voffA[2], voffB[2];
#pragma unroll
    for (int i = 0; i < 2; ++i) { int R, C; stage_rc(tid * 16 + i * 8192, R, C); const int Rb = Epi::PERM ? ((R & ~31) + perm32(R & 31)) : R;
        voffA[i] = (unsigned)(R * K + C) * 2u; voffB[i] = (unsigned)(Rb * K + C) * 2u; }
    const size_t kstep = (size_t)(BK * 2);
    const size_t hstep = (size_t)HALF * K * 2;
    const size_t tstep = 2 * hstep;
    const unsigned ldsw = (unsigned)wid * 1024u;
    const int aoff = lds_byte(wr * 64 + fr, fq * 8), boff = lds_byte(wc * 32 + fr, fq * 8);
#define PG8_SA(b, h) (((b) * 2 + (h)) * HTB)
#define PG8_SB(b, h) ((4 + (b) * 2 + (h)) * HTB)
#define PG8_STAGE(bufoff, gbase, voff) do { _Pragma("unroll") for (int _i = 0; _i < 2; ++_i) \
        __builtin_amdgcn_global_load_lds((const unsigned*)((const char*)(gbase) + (voff)[_i]), (PG8_LAS unsigned*)(lds + (bufoff) + ldsw + _i * 8192), 16, 0, 0); } while (0)
#define PG8_LDA(dst, b, h) do { _Pragma("unroll") for (int m = 0; m < 4; ++m) _Pragma("unroll") for (int k = 0; k < 2; ++k) dst[m][k] = *(const PG8_LAS bf16x8*)(lds + PG8_SA(b, h) + aoff + m * 2048 + k * 1024); } while (0)
#define PG8_LDB(dst, b, h) do { _Pragma("unroll") for (int n = 0; n < 2; ++n) _Pragma("unroll") for (int k = 0; k < 2; ++k) dst[n][k] = *(const PG8_LAS bf16x8*)(lds + PG8_SB(b, h) + boff + n * 2048 + k * 1024); } while (0)
#define PG8_MMA(ai, bj, At, Bt) do { __builtin_amdgcn_s_setprio(1); _Pragma("unroll") for (int m = 0; m < 4; ++m) _Pragma("unroll") for (int n = 0; n < 2; ++n) _Pragma("unroll") for (int k = 0; k < 2; ++k) \
        acc[ai][bj][m][n] = __builtin_amdgcn_mfma_f32_16x16x32_bf16(Bt[n][k], At[m][k], acc[ai][bj][m][n], 0, 0, 0); __builtin_amdgcn_s_setprio(0); } while (0)
#define PG8_WAIT_V(n) asm volatile("s_waitcnt vmcnt(" #n ")" ::: "memory")
#define PG8_WAIT_L(n) asm volatile("s_waitcnt lgkmcnt(" #n ")" ::: "memory")
#define PG8_BAR __builtin_amdgcn_s_barrier()
#define PG8_SCHED __builtin_amdgcn_sched_barrier(0)
    Unit cur, nxt; int ui = 0;
    if (!S.next(0, cur)) return;
    f32x4 acc[2][2][4][2];
#pragma unroll
    for (int a = 0; a < 2; ++a)
#pragma unroll
        for (int b = 0; b < 2; ++b)
#pragma unroll
            for (int m = 0; m < 4; ++m)
#pragma unroll
                for (int n = 0; n < 2; ++n) acc[a][b][m][n] = (f32x4){0.f, 0.f, 0.f, 0.f};
    bf16x8 At[4][2], B0[2][2], B1[2][2];
    const char* cA = (const char*)g.A + (size_t)cur.pm * tstep; const char* cB = (const char*)g.Bt + (size_t)cur.pn * tstep;
    S.a_ready(cur);
    if constexpr (SP2) {
        PG8_STAGE(PG8_SB(0, 0), cB, voffB); PG8_STAGE(PG8_SB(0, 1), cB + hstep, voffB); PG8_STAGE(PG8_SA(0, 0), cA, voffA); PG8_STAGE(PG8_SA(0, 1), cA + hstep, voffA);
        if (wr == 1) PG8_BAR;
        PG8_WAIT_V(2); PG8_BAR;
        PG8_STAGE(PG8_SB(1, 0), cB + kstep, voffB); PG8_STAGE(PG8_SA(1, 0), cA + kstep, voffA); PG8_STAGE(PG8_SB(1, 1), cB + hstep + kstep, voffB);
        PG8_WAIT_V(6); PG8_BAR;
    } else {
        PG8_STAGE(PG8_SB(0, 0), cB, voffB); PG8_STAGE(PG8_SA(0, 0), cA, voffA); PG8_STAGE(PG8_SB(0, 1), cB + hstep, voffB); PG8_STAGE(PG8_SA(0, 1), cA + hstep, voffA);
        if (wr == 1) PG8_BAR;
        PG8_WAIT_V(4); PG8_BAR;
        PG8_STAGE(PG8_SB(1, 0), cB + kstep, voffB); PG8_STAGE(PG8_SA(1, 0), cA + kstep, voffA); PG8_STAGE(PG8_SB(1, 1), cB + hstep + kstep, voffB);
        PG8_WAIT_V(6); PG8_BAR;
    }
    for (;;) {
        const bool has_next = S.next(ui + 1, nxt);
        const char* nA = has_next ? (const char*)g.A + (size_t)nxt.pm * tstep : cA; const char* nB = has_next ? (const char*)g.Bt + (size_t)nxt.pn * tstep : cB;
        for (int t = 0; t < nt; t += 2) {
            const bool last = (t == nt - 2);
            const char* a1 = cA + (size_t)(t + 1) * kstep;
            const char* a2 = last ? nA : cA + (size_t)(t + 2) * kstep; const char* b2 = last ? nB : cB + (size_t)(t + 2) * kstep;
            const char* a3 = a2 + kstep; const char* b3 = b2 + kstep;
            if (last && has_next) S.a_ready(nxt);
            if constexpr (SP2) {
            PG8_LDB(B0, 0, 0); PG8_LDB(B1, 0, 1); PG8_SCHED; PG8_LDA(At, 0, 0); PG8_STAGE(PG8_SA(1, 1), a1 + hstep, voffA);
            PG8_WAIT_V(8); PG8_WAIT_L(0); PG8_BAR; PG8_MMA(0, 0, At, B0); PG8_MMA(0, 1, At, B1); PG8_BAR; PG8_SCHED;
            PG8_LDA(At, 0, 1); PG8_STAGE(PG8_SB(0, 0), b2, voffB); PG8_STAGE(PG8_SB(0, 1), b2 + hstep, voffB); PG8_STAGE(PG8_SA(0, 0), a2, voffA);
            PG8_WAIT_V(8); PG8_WAIT_L(0); PG8_BAR; PG8_MMA(1, 0, At, B0); PG8_MMA(1, 1, At, B1); PG8_BAR; PG8_SCHED;
            PG8_LDB(B0, 1, 0); PG8_LDB(B1, 1, 1); PG8_SCHED; PG8_LDA(At, 1, 0); PG8_STAGE(PG8_SA(0, 1), a2 + hstep, voffA);
            PG8_WAIT_V(8); PG8_WAIT_L(0); PG8_BAR; PG8_MMA(0, 0, At, B0); PG8_MMA(0, 1, At, B1); PG8_BAR; PG8_SCHED;
            PG8_LDA(At, 1, 1); PG8_STAGE(PG8_SB(1, 0), b3, voffB); PG8_STAGE(PG8_SB(1, 1), b3 + hstep, voffB); PG8_STAGE(PG8_SA(1, 0), a3, voffA);
            PG8_WAIT_V(8); PG8_WAIT_L(0); PG8_BAR; PG8_MMA(1, 0, At, B0); PG8_MMA(1, 1, At, B1); PG8_BAR; PG8_SCHED;
            } else {
            PG8_LDB(B0, 0, 0); PG8_SCHED; PG8_LDA(At, 0, 0); PG8_STAGE(PG8_SA(1, 1), a1 + hstep, voffA);
            PG8_WAIT_L(8); PG8_BAR; PG8_WAIT_L(0); PG8_MMA(0, 0, At, B0); PG8_BAR; PG8_SCHED;
            PG8_LDB(B1, 0, 1); PG8_STAGE(PG8_SB(0, 0), b2, voffB);
            PG8_BAR; PG8_WAIT_L(0); PG8_MMA(0, 1, At, B1); PG8_BAR;
            PG8_LDA(At, 0, 1); PG8_STAGE(PG8_SA(0, 0), a2, voffA);
            PG8_BAR; PG8_WAIT_L(0); PG8_MMA(1, 0, At, B0); PG8_BAR; PG8_SCHED;
            PG8_STAGE(PG8_SB(0, 1), b2 + hstep, voffB);
            PG8_WAIT_V(6); PG8_BAR; PG8_MMA(1, 1, At, B1); PG8_BAR;
            PG8_LDB(B0, 1, 0); PG8_SCHED; PG8_LDA(At, 1, 0); PG8_STAGE(PG8_SA(0, 1), a2 + hstep, voffA);
            PG8_WAIT_L(8); PG8_BAR; PG8_WAIT_L(0); PG8_MMA(0, 0, At, B0); PG8_BAR; PG8_SCHED;
            PG8_LDB(B1, 1, 1); PG8_STAGE(PG8_SB(1, 0), b3, voffB);
            PG8_BAR; PG8_WAIT_L(0); PG8_MMA(0, 1, At, B1); PG8_BAR;
            PG8_LDA(At, 1, 1); PG8_STAGE(PG8_SA(1, 0), a3, voffA);
            PG8_BAR; PG8_WAIT_L(0); PG8_MMA(1, 0, At, B0); PG8_BAR; PG8_SCHED;
            PG8_STAGE(PG8_SB(1, 1), b3 + hstep, voffB);
            PG8_WAIT_V(6); PG8_BAR; PG8_MMA(1, 1, At, B1); PG8_BAR;
            }
        }
        if constexpr (ALIGN_EPI) { if (wr == 0) PG8_BAR; }
        if constexpr (!Epi::AFTER_DRAIN) { E(acc, cur, wr, wc, fr, fq); S.done(cur); }
        if (!has_next) break;
#pragma unroll
        for (int a = 0; a < 2; ++a)
#pragma unroll
            for (int b = 0; b < 2; ++b)
#pragma unroll
                for (int m = 0; m < 4; ++m)
#pragma unroll
                    for (int n = 0; n < 2; ++n) acc[a][b][m][n] = (f32x4){0.f, 0.f, 0.f, 0.f};
        cur = nxt; cA = nA; cB = nB; ++ui;
        if constexpr (ALIGN_EPI) { if (wr == 1) PG8_BAR; }
    }
    PG8_WAIT_V(0);
    if constexpr (!ALIGN_EPI) { if (wr == 0) PG8_BAR; }
    PG8_BAR;
    if constexpr (Epi::AFTER_DRAIN) { E.fused(acc, cur, wr, wc, fr, fq, lds, wid, lane); S.done(cur); }
#undef PG8_SA
#undef PG8_SB
#undef PG8_STAGE
#undef PG8_LDA
#undef PG8_LDB
#undef PG8_MMA
#undef PG8_WAIT_V
#undef PG8_WAIT_L
#undef PG8_BAR
#undef PG8_SCHED
}
}

constexpr int NWAVES = 8;
#ifndef MK_PER_PHASE
#define MK_PER_PHASE 0
#endif
constexpr int N_PHASES = 10;

constexpr int DM = 1024, NB = 8, SEQ = 2048, MP = NB * SEQ  , DEC = 128, MV = MP + DEC  , MR = 16640  ;
constexpr int CC = 512, CW = 31, NH = 4, DKV = 128, QKVN = 1536, NMEM = 256, MHD = 256, DFF = 2816, INC = 3080;
constexpr int PBLD = pg8::PBLD;
constexpr int NCHUNK = NB * NH * 32;
constexpr float RMS_EPS = 1e-6f;
constexpr float ATT_C2 = 0.0625f * 1.4426950408889634f;

constexpr size_t OUT_YP = 0, OUT_YS = 16777216, OUT_CONVP = 16908288, OUT_SCP = 17031168, OUT_DLP = 17068032, OUT_MKP = 17592320, OUT_MVP = 19689472,
                 OUT_CONVS = 21786624, OUT_SCS = 23752704, OUT_DLS = 24342528, OUT_END = 32731136;

constexpr size_t MiB = 1u << 20;
constexpr size_t WS_CTL = 0, CTL_ZERO_BYTES = 1 * MiB;
constexpr size_t WS_WIN = 1 * MiB, WS_WOUT = 7 * MiB, WS_WMQ = 9 * MiB, WS_WMKV = 11 * MiB, WS_WMO = 15 * MiB, WS_WGU = 17 * MiB, WS_WDN = 28 * MiB;
constexpr size_t WS_BG = 34 * MiB, WS_MEMN = 35 * MiB, WS_KB = 39 * MiB, WS_VT = 43 * MiB, WS_GL = 47 * MiB, WS_X1S = 47 * MiB + 65536, WS_XBUF = 47 * MiB + 655360, WS_RN = 47 * MiB + 917504;
constexpr size_t WS_RA = 48 * MiB;
constexpr size_t WS_RB = 138 * MiB;
constexpr size_t WS_RC = 171 * MiB;
constexpr size_t WS_RD = 220 * MiB;
constexpr size_t WS_U = WS_RD, WS_W = 252 * MiB, WS_QG = 268 * MiB, WS_KDT = 284 * MiB, WS_QK = 300 * MiB;
constexpr size_t WS_RE = 308 * MiB;
constexpr size_t WS_RF = 341 * MiB;
constexpr size_t WS_END = 406 * MiB;
constexpr int CW_TMO = 0, CW_CODE = 1, CW_BAR = 4096, CW_SS1 = 65536, CW_SS2 = 98304, CW_SS3 = 131072, CW_PANEL = 200000, CW_P5 = 208000;

constexpr int RING_OFF = 0, RING_BYTES = 143360;
constexpr int LDSCTL_OFF = RING_BYTES, MISC_OFF = LDSCTL_OFF + 320;
constexpr int LDS_BYTES = 147456;

#define GAS __attribute__((address_space(1)))
#define LAS __attribute__((address_space(3)))
typedef unsigned short bf16;
typedef unsigned v4u __attribute__((ext_vector_type(4)));
typedef unsigned v2u __attribute__((ext_vector_type(2)));
typedef float f32x4 __attribute__((ext_vector_type(4)));
typedef float f32x16 __attribute__((ext_vector_type(16)));
typedef short bf16x8 __attribute__((ext_vector_type(8)));
typedef GAS unsigned gu32;
#define RLX_AGENT __ATOMIC_RELAXED, __HIP_MEMORY_SCOPE_AGENT
#define LDS_WAIT() asm volatile("s_waitcnt lgkmcnt(0)" ::: "memory")
#define VM_WAIT() asm volatile("s_waitcnt vmcnt(0)" ::: "memory")
using pg8::pk2; using pg8::silu; using pg8::sigm;
__device__ __forceinline__ float bf2f(unsigned b) { return __uint_as_float(b << 16); }
__device__ __forceinline__ float bflo(unsigned w) { return __uint_as_float(w << 16); }
__device__ __forceinline__ float bfhi(unsigned w) { return __uint_as_float(w & 0xffff0000u); }
__device__ __forceinline__ void unpack8(const v4u& w, float (&f)[8]) { f[0] = bflo(w.x); f[1] = bfhi(w.x); f[2] = bflo(w.y); f[3] = bfhi(w.y); f[4] = bflo(w.z); f[5] = bfhi(w.z); f[6] = bflo(w.w); f[7] = bfhi(w.w); }
__device__ __forceinline__ v4u pack8(const float (&f)[8]) { v4u w; w.x = pk2(f[0], f[1]); w.y = pk2(f[2], f[3]); w.z = pk2(f[4], f[5]); w.w = pk2(f[6], f[7]); return w; }
template <int CTRL> __device__ __forceinline__ float dppf(float v) { return __int_as_float(__builtin_amdgcn_update_dpp(0, __float_as_int(v), CTRL, 0xf, 0xf, true)); }
__device__ __forceinline__ float row16_sum(float v) { v += dppf<0xB1>(v); v += dppf<0x4E>(v); v += dppf<0x141>(v); v += dppf<0x140>(v); return v; }
__device__ __forceinline__ float row16_max(float v) { v = fmaxf(v, dppf<0xB1>(v)); v = fmaxf(v, dppf<0x4E>(v)); v = fmaxf(v, dppf<0x141>(v)); v = fmaxf(v, dppf<0x140>(v)); return v; }
__device__ __forceinline__ float rdl(float v, int l) { return __int_as_float(__builtin_amdgcn_readlane(__float_as_int(v), l)); }
__device__ __forceinline__ float wave_sum(float v) { v = row16_sum(v); return (rdl(v, 0) + rdl(v, 16)) + (rdl(v, 32) + rdl(v, 48)); }
__device__ __forceinline__ float wave_max(float v) { v = row16_max(v); return fmaxf(fmaxf(rdl(v, 0), rdl(v, 16)), fmaxf(rdl(v, 32), rdl(v, 48))); }

#define XB_TMO      128
#define XB_XCNT(j)  (256  + 64 * (j))
#define XB_XSUB(j)  (1280 + 64 * (j))
#define XB_XGEN(j)  (2304 + 64 * (j))
#define XB_TOP      3328
#define XB_TOPGEN   3392
#define XCD_BAR_WORDS 3456
#define XB_SPIN_CAP (1u << 18)

__device__ __forceinline__ unsigned xb_ld(unsigned* p)              { return __hip_atomic_load(p, __ATOMIC_RELAXED, __HIP_MEMORY_SCOPE_AGENT); }
__device__ __forceinline__ unsigned xb_add(unsigned* p, unsigned v) { return __hip_atomic_fetch_add(p, v, __ATOMIC_RELAXED, __HIP_MEMORY_SCOPE_AGENT); }
__device__ __forceinline__ unsigned xb_xcc_id() { return (unsigned)__builtin_amdgcn_s_getreg((3 << 11) | 20) & 0xFu; }
#define XB_SPIN(cond, bar) do { unsigned _sp = 0; while (cond) { __builtin_amdgcn_s_sleep(1); \
    if ((++_sp & 255u) == 0u) { if (xb_ld(&(bar)[XB_TMO])) break; if (_sp > XB_SPIN_CAP) { atomicAdd(&(bar)[XB_TMO], 1u); break; } } } } while (0)

struct XcdBarrier {
    unsigned* bar; unsigned x;
    volatile LAS unsigned* st;
};

__device__ __forceinline__ XcdBarrier xcd_barrier_post(unsigned* bar, volatile LAS unsigned* st) {
    XcdBarrier b; b.bar = bar; b.x = xb_xcc_id(); b.st = st;
    if (threadIdx.x == 0) (void)xb_add(&bar[XB_XCNT(b.x)], 1u);
    return b;
}
__device__ __forceinline__ void xcd_barrier_complete(unsigned* bar, unsigned x, unsigned& nloc, unsigned& nx) {
    const unsigned G = gridDim.x * gridDim.y * gridDim.z;
    unsigned sum, cnt, mine, sp = 0u;
    for (;;) {
        sum = 0u; cnt = 0u; mine = 0u;
#pragma unroll
        for (unsigned j = 0; j < 16; ++j) { const unsigned c = xb_ld(&bar[XB_XCNT(j)]); sum += c; cnt += (c > 0u) ? 1u : 0u; mine = (j == x) ? c : mine; }
        if (sum == G) break;
        __builtin_amdgcn_s_sleep(1);
        if ((++sp & 255u) == 0u) { if (xb_ld(&bar[XB_TMO])) break; if (sp > XB_SPIN_CAP) { atomicAdd(&bar[XB_TMO], 1u); break; } }
    }
    nloc = mine > 0u ? mine : 1u; nx = cnt > 0u ? cnt : 1u;
}

__device__ __forceinline__ void xcd_barrier(const XcdBarrier& b) {
    asm volatile("s_waitcnt vmcnt(0)" ::: "memory");
    __syncthreads();
    if (threadIdx.x == 0) {
        unsigned* bar = b.bar;
        __builtin_amdgcn_s_waitcnt(0);
        unsigned nloc = b.st[0], nx = b.st[1];
        if (nloc == 0u) { xcd_barrier_complete(bar, b.x, nloc, nx); b.st[0] = nloc; b.st[1] = nx; }
        const unsigned old = xb_add(&bar[XB_XSUB(b.x)], 1u);
        const unsigned gen = old / nloc;
        if (old + 1u == (gen + 1u) * nloc) {
            __builtin_amdgcn_fence(__ATOMIC_RELEASE, "agent");
            asm volatile("s_waitcnt vmcnt(0)" ::: "memory");
            const unsigned og = xb_add(&bar[XB_TOP], 1u);
            const unsigned tg = og / nx;
            if (og + 1u == (tg + 1u) * nx) xb_add(&bar[XB_TOPGEN], 1u);
            else XB_SPIN(xb_ld(&bar[XB_TOPGEN]) == tg, bar);
            __builtin_amdgcn_fence(__ATOMIC_ACQUIRE, "agent");
            xb_add(&bar[XB_XGEN(b.x)], 1u);
            asm volatile("s_waitcnt vmcnt(0)" ::: "memory");
        } else {
            XB_SPIN(xb_ld(&bar[XB_XGEN(b.x)]) == gen, bar);
            __builtin_amdgcn_fence(__ATOMIC_ACQUIRE, "agent");
            asm volatile("s_waitcnt vmcnt(0)" ::: "memory");
        }
    }
    __syncthreads();
}

struct Args { const float* in[30]; float* out; unsigned char* ws; int ph_lo, ph_hi, li, pad; };
struct Frame {
    LAS unsigned char* lds;
    volatile LAS unsigned* MISC;
    gu32* ctl;
    int tid, lane, wave;
    int vcu, G;
};
enum { I_XP = 0, I_XS, I_MEM, I_CCONV, I_SSC, I_SDELTA, I_CMK, I_CMV, I_NMIX, I_WIN, I_CONVW, I_CONVB, I_LNG, I_LNB, I_SCW, I_ALOG, I_DTB, I_DNN, I_WOUT,
       I_NMQ, I_NMKV, I_WMQ, I_WMK, I_WMV, I_WMO, I_NFFN, I_WG, I_WU, I_WD, I_NF };

struct TrJob { const float* W; const float* gain; bf16* WT; int ldw, k0, c0, K, r0; };
__device__ __forceinline__ void tr_load(const TrJob& j, int lane, f32x4 (&v)[8]) {
    const float* p = j.W + (size_t)(j.k0 + (lane >> 3)) * j.ldw + j.c0 + (lane & 7) * 4;
#pragma unroll
    for (int i = 0; i < 8; ++i) v[i] = __builtin_nontemporal_load((const GAS f32x4*)(p + (size_t)(8 * i) * j.ldw));
}
__device__ __forceinline__ void tr_finish(const TrJob& j, const f32x4 (&v)[8], LAS float* scr, int lane) {
#pragma unroll
    for (int i = 0; i < 8; ++i) { LAS float* d = scr + (8 * i + (lane >> 3)) * 33 + (lane & 7) * 4; d[0] = v[i][0]; d[1] = v[i][1]; d[2] = v[i][2]; d[3] = v[i][3]; }
    LDS_WAIT(); asm volatile("" ::: "memory");
    const int c = lane & 7;
    float gv[8];
#pragma unroll
    for (int i = 0; i < 8; ++i) gv[i] = j.gain ? j.gain[j.k0 + 8 * c + i] : 1.f;
#pragma unroll
    for (int q = 0; q < 4; ++q) { const int n = (lane >> 3) + 8 * q; const LAS float* s = scr + (8 * c) * 33 + n;
        v4u o; o.x = pk2(s[0 * 33] * gv[0], s[1 * 33] * gv[1]); o.y = pk2(s[2 * 33] * gv[2], s[3 * 33] * gv[3]); o.z = pk2(s[4 * 33] * gv[4], s[5 * 33] * gv[5]); o.w = pk2(s[6 * 33] * gv[6], s[7 * 33] * gv[7]);
        *(GAS v4u*)(j.WT + (size_t)(j.r0 + n) * j.K + j.k0 + 8 * c) = o; }
    LDS_WAIT(); asm volatile("" ::: "memory");
}
__device__ __forceinline__ float softplusf_(float x) { return x > 20.f ? x : log1pf(__expf(x)); }

constexpr int TR_IA = 96 * 16, TR_IB = 32 * 16, TR_ID = 64 * 16, TR_IF = 176 * 16, TR_IG = 32 * 44, TR_N1 = TR_IA + TR_IB + TR_ID, TR_N = TR_N1 + TR_IB + TR_IB + TR_IF + TR_IG;
__device__ __forceinline__ void weights_phase(const Args& A, Frame& F, int first, int last, int w, int nw) {
    LAS float* scr = (LAS float*)(F.lds + RING_OFF + F.wave * 8448);
    unsigned char* ws = A.ws;
    const float* const pWMK = A.in[I_WMK]; const float* const pWMV = A.in[I_WMV]; const float* const pWG = A.in[I_WG]; const float* const pWU = A.in[I_WU];
    const float* const pWIN = A.in[I_WIN]; const float* const pWOUT = A.in[I_WOUT]; const float* const pWMQ = A.in[I_WMQ]; const float* const pWMO = A.in[I_WMO]; const float* const pWD = A.in[I_WD];
    const float* const pNMQ = A.in[I_NMQ]; const float* const pNFFN = A.in[I_NFFN]; const float* const pNMIX = A.in[I_NMIX];
#define TR_DECODE(J, IT) do { int r = (IT); \
        if (r < TR_IA) { const int nb = r % 96, kb = r / 96, j0 = 32 * nb; int src = j0; \
            if (j0 < 1024) { const int tile = j0 >> 8, local = j0 & 255; src = local < 128 ? 128 * tile + local : 512 + 128 * tile + (local - 128); } \
            J = TrJob{pWIN, pNMIX, (bf16*)(ws + WS_WIN), INC, 64 * kb, src, DM, j0}; break; } r -= TR_IA; \
        if (r < TR_IB) { const int nb = r % 32, kb = r / 32; J = TrJob{pWOUT, nullptr, (bf16*)(ws + WS_WOUT), DM, 64 * kb, 32 * nb, DM, 32 * nb}; break; } r -= TR_IB; \
        if (r < TR_ID) { const int nb = r % 64, kb = r / 64, j0 = 32 * nb; const bool isv = j0 >= 1024; \
            J = TrJob{isv ? pWMV : pWMK, nullptr, (bf16*)(ws + WS_WMKV), DM, 64 * kb, isv ? j0 - 1024 : j0, DM, j0}; break; } r -= TR_ID; \
        if (r < TR_IB) { const int nb = r % 32, kb = r / 32; J = TrJob{pWMQ, pNMQ, (bf16*)(ws + WS_WMQ), DM, 64 * kb, 32 * nb, DM, 32 * nb}; break; } r -= TR_IB; \
        if (r < TR_IB) { const int nb = r % 32, kb = r / 32; J = TrJob{pWMO, nullptr, (bf16*)(ws + WS_WMO), DM, 64 * kb, 32 * nb, DM, 32 * nb}; break; } r -= TR_IB; \
        if (r < TR_IF) { const int nb = r % 176, kb = r / 176, j0 = 32 * nb, tile = j0 >> 8, local = j0 & 255; const bool up = local >= 128; \
            J = TrJob{up ? pWU : pWG, pNFFN, (bf16*)(ws + WS_WGU), DFF, 64 * kb, 128 * tile + (up ? local - 128 : local), DM, j0}; break; } r -= TR_IF; \
        { const int nb = r % 32, kb = r / 32; J = TrJob{pWD, nullptr, (bf16*)(ws + WS_WDN), DM, 64 * kb, 32 * nb, DFF, 32 * nb}; } } while (0)
    TrJob jc, jn; f32x4 vc[8], vn[8];
    int it = first + w;
    if (it < last) { TR_DECODE(jc, it); tr_load(jc, F.lane, vc); }
#pragma unroll 1
    for (; it < last; it += nw) {
        const int itn = it + nw;
        if (itn < last) { TR_DECODE(jn, itn); tr_load(jn, F.lane, vn); }
        tr_finish(jc, vc, scr, F.lane);
        jc = jn;
#pragma unroll
        for (int i = 0; i < 8; ++i) vc[i] = vn[i];
    }
#undef TR_DECODE
}
__device__ __forceinline__ void p0_prologue(const Args& A, Frame& F) {
    const int gw = F.vcu * NWAVES + F.wave, NGW = F.G * NWAVES;
    unsigned char* ws = A.ws;
    const float* const pXP = A.in[I_XP]; const float* const pXS = A.in[I_XS];
    weights_phase(A, F, 0, TR_N1, gw, NGW);
    {
        bf16* H = (bf16*)(ws + WS_RB); float* BG = (float*)(ws + WS_BG); float* RN = (float*)(ws + WS_RN);
        const float* win = A.in[I_WIN]; const float* gain = A.in[I_NMIX];
        float w8[4][4][8];
#pragma unroll
        for (int j = 0; j < 4; ++j)
#pragma unroll
            for (int i = 0; i < 4; ++i) { const int k = 256 * j + 4 * F.lane + i; const f32x4 a = *(const f32x4*)(win + (size_t)k * INC + 3072), b = *(const f32x4*)(win + (size_t)k * INC + 3076);
                w8[j][i][0] = a[0]; w8[j][i][1] = a[1]; w8[j][i][2] = a[2]; w8[j][i][3] = a[3]; w8[j][i][4] = b[0]; w8[j][i][5] = b[1]; w8[j][i][6] = b[2]; w8[j][i][7] = b[3]; }
        f32x4 gn[4];
#pragma unroll
        for (int j = 0; j < 4; ++j) gn[j] = *(const f32x4*)(gain + 256 * j + 4 * F.lane);
        const f32x4 alog4 = *(const f32x4*)A.in[I_ALOG], dtb4 = *(const f32x4*)A.in[I_DTB];
        const bool hi5 = (F.lane & 32) != 0, b4 = (F.lane & 16) != 0, b3 = (F.lane & 8) != 0; const int cidx = (hi5 ? 4 : 0) + (b4 ? 2 : 0) + (b3 ? 1 : 0), c3 = cidx & 3;
        const float myea = expf(c3 == 0 ? alog4[0] : c3 == 1 ? alog4[1] : c3 == 2 ? alog4[2] : alog4[3]);
        const float mydtb = (cidx < 4) ? 0.f : (c3 == 0 ? dtb4[0] : c3 == 1 ? dtb4[1] : c3 == 2 ? dtb4[2] : dtb4[3]);
        f32x4 v[4], nv[4];
        { const int m0 = gw; if (m0 < MV) { const GAS f32x4* xr = (const GAS f32x4*)((m0 < MP) ? pXP + (size_t)m0 * DM : pXS + (size_t)(m0 - MP) * DM) + F.lane;
#pragma unroll
            for (int j = 0; j < 4; ++j) v[j] = __builtin_nontemporal_load(xr + 64 * j); } }
#pragma unroll 1
        for (int m = gw; m < MR; m += NGW) {
            GAS unsigned long long* o8 = (GAS unsigned long long*)(H + (size_t)m * DM) + F.lane;
            { const int mn = m + NGW; if (mn < MV) { const GAS f32x4* xr = (const GAS f32x4*)((mn < MP) ? pXP + (size_t)mn * DM : pXS + (size_t)(mn - MP) * DM) + F.lane;
#pragma unroll
                for (int j = 0; j < 4; ++j) nv[j] = __builtin_nontemporal_load(xr + 64 * j); } }
            if (m >= MV) {
#pragma unroll
                for (int j = 0; j < 4; ++j) o8[64 * j] = 0ull;
                if (F.lane < 8) BG[(size_t)m * 8 + F.lane] = 0.f;
                continue;
            }
            float s2 = 0.f;
#pragma unroll
            for (int j = 0; j < 4; ++j) s2 += (v[j][0] * v[j][0] + v[j][1] * v[j][1]) + (v[j][2] * v[j][2] + v[j][3] * v[j][3]);
            const float rnorm = sqrtf(wave_sum(s2) * (1.f / DM) + RMS_EPS); const float rstd = 1.f / rnorm;
            if (F.lane == 0 && m < MP) RN[m] = rnorm;
            float p8[8];
#pragma unroll
            for (int c = 0; c < 8; ++c) p8[c] = 0.f;
#pragma unroll
            for (int j = 0; j < 4; ++j) { v[j] = v[j] * rstd;
                o8[64 * j] = (unsigned long long)pk2(v[j][0], v[j][1]) | ((unsigned long long)pk2(v[j][2], v[j][3]) << 32);
                v[j] = v[j] * gn[j];
#pragma unroll
                for (int i = 0; i < 4; ++i)
#pragma unroll
                    for (int c = 0; c < 8; ++c) p8[c] += v[j][i] * w8[j][i][c]; }
            float z;
            { float r4[4], q2[2];
#pragma unroll
              for (int i = 0; i < 4; ++i) { const float send = hi5 ? p8[i] : p8[4 + i], keep = hi5 ? p8[4 + i] : p8[i]; r4[i] = keep + __shfl_xor(send, 32); }
#pragma unroll
              for (int i = 0; i < 2; ++i) { const float send = b4 ? r4[i] : r4[2 + i], keep = b4 ? r4[2 + i] : r4[i]; q2[i] = keep + __shfl_xor(send, 16); }
              { const float send = b3 ? q2[0] : q2[1], keep = b3 ? q2[1] : q2[0]; z = keep + __shfl_xor(send, 8); }
              z += dppf<0xB1>(z); z += dppf<0x4E>(z); z += dppf<0x141>(z); }
            { const float xs = z + mydtb;
              const float sp = xs > 20.f ? xs : (xs < -15.f ? __expf(xs) : __logf(1.f + __expf(xs)));
              const float val = (cidx < 4) ? __builtin_amdgcn_rcpf(1.f + __expf(-z)) : -myea * sp;
              if ((F.lane & 7) == 0) BG[(size_t)m * 8 + cidx] = val; }
#pragma unroll
            for (int j = 0; j < 4; ++j) v[j] = nv[j];
        }
    }
    {
        bf16* MN = (bf16*)(ws + WS_MEMN); const float* gain = A.in[I_NMKV];
        f32x4 gn[4];
#pragma unroll
        for (int j = 0; j < 4; ++j) gn[j] = *(const f32x4*)(gain + 256 * j + 4 * F.lane);
        for (int m = gw; m < NB * NMEM; m += NGW) {
            const GAS f32x4* xr = (const GAS f32x4*)(A.in[I_MEM] + (size_t)m * DM) + F.lane;
            f32x4 v[4]; float s2 = 0.f;
#pragma unroll
            for (int j = 0; j < 4; ++j) { v[j] = __builtin_nontemporal_load(xr + 64 * j); s2 += (v[j][0] * v[j][0] + v[j][1] * v[j][1]) + (v[j][2] * v[j][2] + v[j][3] * v[j][3]); }
            const float rstd = 1.f / sqrtf(wave_sum(s2) * (1.f / DM) + RMS_EPS);
            GAS unsigned long long* o8 = (GAS unsigned long long*)(MN + (size_t)m * DM) + F.lane;
#pragma unroll
            for (int j = 0; j < 4; ++j) { v[j] = v[j] * rstd * gn[j]; o8[64 * j] = (unsigned long long)pk2(v[j][0], v[j][1]) | ((unsigned long long)pk2(v[j][2], v[j][3]) << 32); }
        }
    }
}

typedef float f32x2v __attribute__((ext_vector_type(2)));
__device__ __forceinline__ void short_conv_tail(const Args& A, Frame& F, int b, int tile) {
    const bf16* PB = (const bf16*)(A.ws + WS_RA);
    int oz; asm volatile("v_mov_b32 %0, 0" : "=v"(oz));
    if (tile == 31) {
        float* os = A.out + OUT_SCP + (size_t)b * 3 * QKVN;
        float sv[9];
#pragma unroll
        for (int q = 0; q < 9; ++q) { const int e = F.tid + oz + q * (NWAVES * 64); const int j = e / QKVN, ch = e % QKVN; sv[q] = bf2f(PB[(size_t)(b * SEQ + SEQ - 3 + j) * PBLD + 512 + ch]); }
        __builtin_amdgcn_sched_barrier(0);
#pragma unroll
        for (int q = 0; q < 9; ++q) os[F.tid + q * (NWAVES * 64)] = sv[q];
    }
}
__device__ __forceinline__ void conv31_tile(const Args& A, Frame& F, int b, int tile) {
    const bf16* PB = (const bf16*)(A.ws + WS_RA); bf16* CD = (bf16*)(A.ws + WS_RF);
    int oz; asm volatile("v_mov_b32 %0, 0" : "=v"(oz));
    const int row0 = b * SEQ + tile * 64;
    LAS float* Y = (LAS float*)(F.lds + RING_OFF);
    {
        const unsigned rb = (unsigned)(b * SEQ + tile * 64);
        const int c = F.tid + oz;
        float w[CW];
#pragma unroll
        for (int j = 0; j < CW; ++j) w[j] = A.in[I_CONVW][j * CC + c];
        const float bias = A.in[I_CONVB][c];
        float u[38]; float nx[8];
#pragma unroll
        for (int i = 0; i < 30; ++i) { const int tk = tile * 64 - 30 + i; const unsigned tkc = tk < 0 ? 0u : (unsigned)tk; const float vv = bf2f(PB[(unsigned)(b * SEQ + tkc) * (unsigned)PBLD + (unsigned)c]); u[i] = (tk >= 0) ? vv : 0.f; }
#pragma unroll
        for (int i = 0; i < 8; ++i) nx[i] = bf2f(PB[(rb + (unsigned)i) * (unsigned)PBLD + (unsigned)c]);
#pragma unroll 1
        for (int seg = 0; seg < 8; ++seg) {
#pragma unroll
            for (int i = 0; i < 8; ++i) u[30 + i] = nx[i];
            if (seg < 7) {
#pragma unroll
                for (int i = 0; i < 8; ++i) nx[i] = bf2f(PB[(rb + (unsigned)(seg * 8 + 8 + i)) * (unsigned)PBLD + (unsigned)c]); }
#pragma unroll
            for (int t = 0; t < 8; ++t) { float a = bias;
#pragma unroll
                for (int j = 0; j < CW; ++j) a += w[j] * u[t + j];
                Y[(seg * 8 + t) * CC + c] = a; }
#pragma unroll
            for (int i = 0; i < 30; ++i) u[i] = u[i + 8];
        }
    }
    __syncthreads();
    {
        const int ch0 = 8 * F.lane + oz;
        const f32x4 g0 = *(const f32x4*)(A.in[I_LNG] + ch0), g1 = *(const f32x4*)(A.in[I_LNG] + ch0 + 4), b0 = *(const f32x4*)(A.in[I_LNB] + ch0), b1 = *(const f32x4*)(A.in[I_LNB] + ch0 + 4);
#pragma unroll 2
        for (int tt = 0; tt < 8; ++tt) { const int t = 8 * F.wave + tt;
            f32x4 y0 = *(const LAS f32x4*)(Y + t * CC + ch0), y1 = *(const LAS f32x4*)(Y + t * CC + ch0 + 4);
            const float mean = wave_sum((y0[0] + y0[1]) + (y0[2] + y0[3]) + (y1[0] + y1[1]) + (y1[2] + y1[3])) * (1.f / CC);
            y0 = y0 - mean; y1 = y1 - mean;
            const float var = wave_sum((y0[0] * y0[0] + y0[1] * y0[1]) + (y0[2] * y0[2] + y0[3] * y0[3]) + (y1[0] * y1[0] + y1[1] * y1[1]) + (y1[2] * y1[2] + y1[3] * y1[3])) * (1.f / CC);
            const float rstd = __builtin_amdgcn_rsqf(var + 1e-5f);
            y0 = y0 * rstd * g0 + b0; y1 = y1 * rstd * g1 + b1;
            float o[8];
#pragma unroll
            for (int i = 0; i < 4; ++i) { o[i] = silu(y0[i]); o[4 + i] = silu(y1[i]); }
            *(GAS v4u*)(CD + (size_t)(row0 + t) * DM + ch0) = pack8(o); }
    }
    if (tile == 31) {
        const int c = F.tid;
        float* oc = A.out + OUT_CONVP + (size_t)b * 30 * CC;
        float tv[30];
#pragma unroll
        for (int j = 0; j < 30; ++j) tv[j] = bf2f(PB[(size_t)(b * SEQ + SEQ - 30 + j) * PBLD + c]);
        __builtin_amdgcn_sched_barrier(0);
#pragma unroll
        for (int j = 0; j < 30; ++j) oc[j * CC + c] = tv[j];
    }
    __syncthreads();
}
__device__ __forceinline__ void conv31_sample(const Args& A, Frame& F, int s) {
    const bf16* PB = (const bf16*)(A.ws + WS_RA); bf16* CD = (bf16*)(A.ws + WS_RF);
    const int c = F.tid; const size_t row = (size_t)MP + s;
    LAS float* Y = (LAS float*)(F.lds + RING_OFF);
    {
        const float* cache = A.in[I_CCONV] + (size_t)s * 30 * CC; float* oc = A.out + OUT_CONVS + (size_t)s * 30 * CC;
        const float us = bf2f(PB[row * PBLD + c]);
        float a = A.in[I_CONVB][c];
        float cv[30], wv[31];
#pragma unroll
        for (int j = 0; j < 30; ++j) { cv[j] = __builtin_nontemporal_load(cache + j * CC + c); wv[j] = A.in[I_CONVW][j * CC + c]; }
        wv[30] = A.in[I_CONVW][30 * CC + c];
        __builtin_amdgcn_sched_barrier(0);
#pragma unroll
        for (int j = 0; j < 30; ++j) { a += wv[j] * cv[j]; oc[j * CC + c] = (j < 29) ? cv[j + 1] : us; }
        a += wv[30] * us;
        Y[c] = a;
    }
    __syncthreads();
    if (F.wave == 7) {
        const int ch0 = 8 * F.lane;
        const f32x4 g0 = *(const f32x4*)(A.in[I_LNG] + ch0), g1 = *(const f32x4*)(A.in[I_LNG] + ch0 + 4), b0 = *(const f32x4*)(A.in[I_LNB] + ch0), b1 = *(const f32x4*)(A.in[I_LNB] + ch0 + 4);
        f32x4 y0 = *(const LAS f32x4*)(Y + ch0), y1 = *(const LAS f32x4*)(Y + ch0 + 4);
        const float mean = wave_sum((y0[0] + y0[1]) + (y0[2] + y0[3]) + (y1[0] + y1[1]) + (y1[2] + y1[3])) * (1.f / CC);
        y0 = y0 - mean; y1 = y1 - mean;
        const float var = wave_sum((y0[0] * y0[0] + y0[1] * y0[1]) + (y0[2] * y0[2] + y0[3] * y0[3]) + (y1[0] * y1[0] + y1[1] * y1[1]) + (y1[2] * y1[2] + y1[3] * y1[3])) * (1.f / CC);
        const float rstd = 1.f / sqrtf(var + 1e-5f);
        y0 = y0 * rstd * g0 + b0; y1 = y1 * rstd * g1 + b1;
        float o[8];
#pragma unroll
        for (int i = 0; i < 4; ++i) { o[i] = silu(y0[i]); o[4 + i] = silu(y1[i]); }
        *(GAS v4u*)(CD + row * DM + ch0) = pack8(o);
    }
    __syncthreads();
}
constexpr int SMP_OFF_Q = 32768, SMP_OFF_O = 36864;
__device__ __forceinline__ void shortconv_sample(const Args& A, Frame& F, int s) {
    const bf16* PB = (const bf16*)(A.ws + WS_RA);
    const size_t row = (size_t)MP + s;
    if (F.wave < 3) {
        const int p = F.wave; const int ch0 = 512 * p + 8 * F.lane;
        const float* st = A.in[I_SSC] + (size_t)s * 3 * QKVN; float* os = A.out + OUT_SCS + (size_t)s * 3 * QKVN;
        float win[3][8], cur[8], y[8];
#pragma unroll
        for (int j = 0; j < 3; ++j) { const f32x4 a = *(const f32x4*)(st + j * QKVN + ch0), bb = *(const f32x4*)(st + j * QKVN + ch0 + 4);
#pragma unroll
            for (int i = 0; i < 4; ++i) { win[j][i] = a[i]; win[j][4 + i] = bb[i]; } }
        { const v4u x = *(const GAS v4u*)(PB + row * PBLD + 512 + ch0); unpack8(x, cur); }
        float ss = 0.f;
#pragma unroll
        for (int i = 0; i < 8; ++i) { float a = 0.f;
#pragma unroll
            for (int j = 0; j < 3; ++j) a += A.in[I_SCW][j * QKVN + ch0 + i] * win[j][i];
            a += A.in[I_SCW][3 * QKVN + ch0 + i] * cur[i]; y[i] = silu(a); ss += y[i] * y[i]; }
        if (p < 2) { ss = row16_sum(ss);
            const float sc = (1.f / sqrtf(ss + 1e-6f)) * (p == 0 ? 0.08838834764831845f : 1.f);
#pragma unroll
            for (int i = 0; i < 8; ++i) y[i] *= sc; }
        *(LAS v4u*)((LAS bf16*)(F.lds + RING_OFF + SMP_OFF_Q) + ch0) = pack8(y);
#pragma unroll
        for (int j = 0; j < 3; ++j) { f32x4 a, bb;
#pragma unroll
            for (int i = 0; i < 4; ++i) { a[i] = (j < 2) ? win[j + 1][i] : cur[i]; bb[i] = (j < 2) ? win[j + 1][4 + i] : cur[4 + i]; }
            *(f32x4*)(os + j * QKVN + ch0) = a; *(f32x4*)(os + j * QKVN + ch0 + 4) = bb; }
    }
    __syncthreads();
}

__device__ __forceinline__ bf16x8 lds_frag16(const LAS unsigned char* p) { return *(const LAS bf16x8*)p; }
struct D1In { float g, be; v4u q0, q1, k0, k1, v0, v1; };
constexpr int D1_OFF_WC = 121344;
struct D1Raw { v4u x[4][2]; };
__device__ __forceinline__ void d1_raw_load(const Args& A, Frame& F, int ci, int p, D1Raw& R) {
    const int b = ci >> 7, h = (ci >> 5) & 3, n = ci & 31;
    const bf16* PB = (const bf16*)(A.ws + WS_RA);
    const int t = F.tid >> 3, part = F.tid & 7; const int pos = n * 64 + t;
#pragma unroll
    for (int j = 0; j < 4; ++j) { const int pj = pos - 3 + j; const int pc = pj < 0 ? 0 : pj;
        const bf16* rp = PB + (size_t)(b * SEQ + pc) * PBLD + 512 + 512 * p + h * 128 + part * 16;
        R.x[j][0] = *(const GAS v4u*)rp; R.x[j][1] = *(const GAS v4u*)(rp + 8); }
}
__device__ __forceinline__ void d1_conv_kind(const Args& A, Frame& F, int ci, int p, const D1Raw& R, v4u& o0, v4u& o1) {
    const int h = (ci >> 5) & 3, n = ci & 31; const int t = F.tid >> 3, part = F.tid & 7; const int pos = n * 64 + t;
    const LAS float* W = (const LAS float*)(F.lds + RING_OFF + D1_OFF_WC) + (4 * p) * 128 + part * 16;
    float y[16]; float ss = 0.f;
#pragma unroll
    for (int hf = 0; hf < 2; ++hf) {
        float a[8];
#pragma unroll
        for (int i = 0; i < 8; ++i) a[i] = 0.f;
#pragma unroll
        for (int j = 0; j < 4; ++j) { const pg8::f32x4 w0 = *(const LAS pg8::f32x4*)(W + j * 128 + 8 * hf), w1 = *(const LAS pg8::f32x4*)(W + j * 128 + 8 * hf + 4);
            float x[8]; unpack8(R.x[j][hf], x); const bool ok = pos - 3 + j >= 0;
#pragma unroll
            for (int i = 0; i < 4; ++i) { a[i] += w0[i] * (ok ? x[i] : 0.f); a[4 + i] += w1[i] * (ok ? x[4 + i] : 0.f); } }
#pragma unroll
        for (int i = 0; i < 8; ++i) { const float s = silu(a[i]); y[8 * hf + i] = s; ss += s * s; }
    }
    if (p < 2) { ss += dppf<0xB1>(ss); ss += dppf<0x4E>(ss); ss += dppf<0x141>(ss);
        const float sc = __builtin_amdgcn_rsqf(ss + 1e-6f) * (p == 0 ? 0.08838834764831845f : 1.f);
#pragma unroll
        for (int i = 0; i < 16; ++i) y[i] *= sc; }
    float y0[8], y1[8];
#pragma unroll
    for (int i = 0; i < 8; ++i) { y0[i] = y[i]; y1[i] = y[8 + i]; }
    o0 = pack8(y0); o1 = pack8(y1);
}
struct D1Pre { D1Raw r0; pg8::f32x4 wv; float g, be; };
__device__ __forceinline__ void d1_pre_issue(const Args& A, Frame& F, int ci, D1Pre& P) {
    const int b = ci >> 7, h = (ci >> 5) & 3, n = ci & 31; const int row0 = b * SEQ + n * 64; const float* BG = (const float*)(A.ws + WS_BG);
    P.g = 0.f; P.be = 0.f;
    if (F.wave == 0) { P.g = BG[(size_t)(row0 + F.lane) * 8 + 4 + h]; P.be = BG[(size_t)(row0 + F.lane) * 8 + h]; }
    P.wv = (pg8::f32x4){0.f, 0.f, 0.f, 0.f};
    const int wp = F.tid >> 7, wj = (F.tid >> 5) & 3, wc4 = F.tid & 31;
    if (F.tid < 384) P.wv = *(const GAS pg8::f32x4*)(A.in[I_SCW] + wj * QKVN + 512 * wp + h * 128 + 4 * wc4);
    d1_raw_load(A, F, ci, 0, P.r0);
}
__device__ __forceinline__ void d1_conv_finish(const Args& A, Frame& F, int ci, D1Pre& P, D1In& I) {
    I.g = P.g; I.be = P.be;
    const int wp = F.tid >> 7, wj = (F.tid >> 5) & 3, wc4 = F.tid & 31;
    if (F.tid < 384) *(LAS pg8::f32x4*)((LAS float*)(F.lds + RING_OFF + D1_OFF_WC) + (4 * wp + wj) * 128 + 4 * wc4) = P.wv;
    D1Raw r1; d1_raw_load(A, F, ci, 1, r1);
    LDS_WAIT(); __syncthreads();
    d1_conv_kind(A, F, ci, 0, P.r0, I.q0, I.q1);
    __builtin_amdgcn_sched_barrier(0);
    d1_raw_load(A, F, ci, 2, P.r0);
    __builtin_amdgcn_sched_barrier(0);
    d1_conv_kind(A, F, ci, 1, r1, I.k0, I.k1);
    __builtin_amdgcn_sched_barrier(0);
    d1_conv_kind(A, F, ci, 2, P.r0, I.v0, I.v1);
}
__device__ __forceinline__ void d1_chunk(const Args& A, Frame& F, int ci, const D1In& I, int ci_next, D1Pre& Pn) {
    using pg8::f32x4;
    const int b = ci >> 7, h = (ci >> 5) & 3, n = ci & 31; const int row0 = b * SEQ + n * 64;
    const bf16* QC = (const bf16*)(A.ws + WS_RC); const float* BG = (const float*)(A.ws + WS_BG);
    bf16* Ug = (bf16*)(A.ws + WS_U) + (size_t)ci * 8192; bf16* Wg = (bf16*)(A.ws + WS_W) + (size_t)ci * 8192; bf16* QGg = (bf16*)(A.ws + WS_QG) + (size_t)ci * 8192;
    bf16* KDTg = (bf16*)(A.ws + WS_KDT) + (size_t)ci * 8192; bf16* QKg = (bf16*)(A.ws + WS_QK) + (size_t)ci * 4096; float* GLg = (float*)(A.ws + WS_GL);
    constexpr int OFF_K = 0, OFF_Q = 17408, OFF_VBT = 34816, OFF_KBGT = 53376, OFF_L = 71936, OFF_T = 89344, OFF_GC = 98560, OFF_BETA = 98816, OFF_EG = 99072, OFF_TM = 99328, OFF_X = 116736, LS = 68;
    LAS unsigned char* L = F.lds + RING_OFF;
    LAS float* gcs = (LAS float*)(L + OFF_GC); LAS float* betas = (LAS float*)(L + OFF_BETA); LAS float* egs = (LAS float*)(L + OFF_EG); LAS float* Lm = (LAS float*)(L + OFF_L); LAS float* Tm = (LAS float*)(L + OFF_TM); LAS float* Xm = (LAS float*)(L + OFF_X);
    const int fr = F.lane & 15, fq = F.lane >> 4;
    if (F.wave == 0) {
        float g = I.g; const float be = I.be;
#pragma unroll
        for (int o = 1; o < 64; o <<= 1) { const float v = __shfl_up(g, o); if (F.lane >= o) g += v; }
        gcs[F.lane] = g; betas[F.lane] = be; egs[F.lane] = __expf(g);
    }
    __syncthreads();
    {
        const int t = F.tid >> 3, part = F.tid & 7;
        const v4u q0 = I.q0, q1 = I.q1, k0 = I.k0, k1 = I.k1, v0 = I.v0, v1 = I.v1;
        *(LAS v4u*)(L + OFF_K + t * 272 + part * 32) = k0; *(LAS v4u*)(L + OFF_K + t * 272 + part * 32 + 16) = k1;
        *(LAS v4u*)(L + OFF_Q + t * 272 + part * 32) = q0; *(LAS v4u*)(L + OFF_Q + t * 272 + part * 32 + 16) = q1;
        const float be = betas[t], beg = be * egs[t];
        float kf[16], vf[16];
        { float tmp[8]; unpack8(k0, tmp);
#pragma unroll
          for (int i = 0; i < 8; ++i) kf[i] = tmp[i]; unpack8(k1, tmp);
#pragma unroll
          for (int i = 0; i < 8; ++i) kf[8 + i] = tmp[i]; unpack8(v0, tmp);
#pragma unroll
          for (int i = 0; i < 8; ++i) vf[i] = tmp[i]; unpack8(v1, tmp);
#pragma unroll
          for (int i = 0; i < 8; ++i) vf[8 + i] = tmp[i]; }
#pragma unroll
        for (int i = 0; i < 16; ++i) { const int d = part * 16 + i;
            *(LAS unsigned short*)(L + OFF_VBT + d * 144 + part * 16 + t * 2) = (unsigned short)(pk2(vf[i] * be, 0.f) & 0xffffu);
            *(LAS unsigned short*)(L + OFF_KBGT + d * 144 + part * 16 + t * 2) = (unsigned short)(pk2(kf[i] * beg, 0.f) & 0xffffu); }
    }
    __syncthreads();
#pragma unroll 1
    for (int x = 0; x < 4; ++x) {
        const int tile = F.wave * 4 + x, which = tile >> 4, ti = (tile >> 2) & 3, tj = tile & 3;
        f32x4 acc = (f32x4){0.f, 0.f, 0.f, 0.f};
        if (ti >= tj) {
            const LAS unsigned char* ap = L + (which ? OFF_Q : OFF_K) + (ti * 16 + fr) * 272 + fq * 16; const LAS unsigned char* bp = L + OFF_K + (tj * 16 + fr) * 272 + fq * 16;
#pragma unroll
            for (int kk = 0; kk < 4; ++kk) acc = __builtin_amdgcn_mfma_f32_16x16x32_bf16(lds_frag16(bp + kk * 64), lds_frag16(ap + kk * 64), acc, 0, 0, 0);
        }
        const int i = ti * 16 + fr; const float gi = gcs[i], bi = betas[i];
        f32x4 val;
#pragma unroll
        for (int r = 0; r < 4; ++r) { const int j = tj * 16 + 4 * fq + r; const float dec = __expf(gi - gcs[j]);
            val[r] = (which == 0) ? ((i > j) ? bi * acc[r] * dec : 0.f) : ((i >= j) ? acc[r] * dec : 0.f); }
        if (which == 0) *(LAS f32x4*)(Lm + i * LS + tj * 16 + 4 * fq) = val;
        else { v2u w; w.x = pk2(val[0], val[1]); w.y = pk2(val[2], val[3]); *(GAS v2u*)(QKg + i * 64 + 32 * (tj >> 1) + 8 * fq + 4 * (tj & 1)) = w; }
    }
    __syncthreads();
    for (int e = F.tid; e < 64 * LS; e += NWAVES * 64) Tm[e] = 0.f;
    __syncthreads();
    if (F.wave == 0) {
        const LAS float* Lb = Lm + (16 * fq) * LS + 16 * fq;
        float t[16];
#pragma unroll
        for (int i = 0; i < 16; ++i) {
            float a0 = 0.f, a1 = 0.f, a2 = 0.f, a3 = 0.f;
#pragma unroll
            for (int j4 = 0; j4 < (i + 3) / 4; ++j4) { const f32x4 lv = *(const LAS f32x4*)(Lb + i * LS + 4 * j4);
                if (4 * j4 + 0 < i) a0 += lv[0] * t[4 * j4 + 0]; if (4 * j4 + 1 < i) a1 += lv[1] * t[4 * j4 + 1]; if (4 * j4 + 2 < i) a2 += lv[2] * t[4 * j4 + 2]; if (4 * j4 + 3 < i) a3 += lv[3] * t[4 * j4 + 3]; }
            t[i] = ((fr == i) ? 1.f : 0.f) - ((a0 + a1) + (a2 + a3));
        }
#pragma unroll
        for (int i = 0; i < 16; ++i) Tm[(16 * fq + i) * LS + 16 * fq + fr] = t[i];
    } else {
        const int lt = F.tid - 64; const float gl = gcs[63];
        for (int cix = lt; cix < 1024; cix += 448) {
            const int t = cix >> 4, cc = cix & 15; const v4u x = *(const LAS v4u*)(L + OFF_Q + t * 272 + cc * 16); float f[8]; unpack8(x, f); const float e = egs[t];
#pragma unroll
            for (int i = 0; i < 8; ++i) f[i] *= e;
            const v4u w = pack8(f); const int pc = 32 * (cc >> 2) + 16 * (cc & 1) + 4 * ((cc >> 1) & 1);
            *(GAS v2u*)(QGg + t * 128 + pc) = (v2u){w.x, w.y}; *(GAS v2u*)(QGg + t * 128 + pc + 8) = (v2u){w.z, w.w}; }
        for (int cix = lt; cix < 1024; cix += 448) {
            const int dk = cix >> 3, t0 = (cix & 7) * 8; float f[8];
#pragma unroll
            for (int i = 0; i < 8; ++i) f[i] = bf2f(*(const LAS unsigned short*)(L + OFF_K + (t0 + i) * 272 + dk * 2)) * __expf(gl - gcs[t0 + i]);
            const v4u w = pack8(f); const int cc = cix & 7, pc = 32 * (cc >> 2) + 16 * (cc & 1) + 4 * ((cc >> 1) & 1);
            *(GAS v2u*)(KDTg + dk * 64 + pc) = (v2u){w.x, w.y}; *(GAS v2u*)(KDTg + dk * 64 + pc + 8) = (v2u){w.z, w.w}; }
        if (lt == 0) GLg[ci] = __expf(gl);
    }
    __syncthreads();
    if (F.wave < 2) {
        const int pp = F.wave, rb = 16 * (2 * pp + 1), cb = 16 * (2 * pp); f32x4 acc = (f32x4){0.f, 0.f, 0.f, 0.f};
#pragma unroll
        for (int kk = 0; kk < 4; ++kk) acc = __builtin_amdgcn_mfma_f32_16x16x4f32(Lm[(rb + fr) * LS + cb + 4 * kk + fq], Tm[(cb + 4 * kk + fq) * LS + cb + fr], acc, 0, 0, 0);
#pragma unroll
        for (int r = 0; r < 4; ++r) Xm[pp * 576 + (4 * fq + r) * 36 + fr] = acc[r];
    }
    __syncthreads();
    if (F.wave < 2) {
        const int pp = F.wave, rb = 16 * (2 * pp + 1), cb = 16 * (2 * pp); f32x4 acc = (f32x4){0.f, 0.f, 0.f, 0.f};
#pragma unroll
        for (int kk = 0; kk < 4; ++kk) acc = __builtin_amdgcn_mfma_f32_16x16x4f32(Tm[(rb + fr) * LS + rb + 4 * kk + fq], Xm[pp * 576 + (4 * kk + fq) * 36 + fr], acc, 0, 0, 0);
#pragma unroll
        for (int r = 0; r < 4; ++r) Tm[(rb + 4 * fq + r) * LS + cb + fr] = -acc[r];
    }
    __syncthreads();
    if (F.wave < 4) {
        const int bi = F.wave >> 1, bj = F.wave & 1; f32x4 acc = (f32x4){0.f, 0.f, 0.f, 0.f};
#pragma unroll
        for (int kk = 0; kk < 8; ++kk) acc = __builtin_amdgcn_mfma_f32_16x16x4f32(Lm[(32 + 16 * bi + fr) * LS + 4 * kk + fq], Tm[(4 * kk + fq) * LS + 16 * bj + fr], acc, 0, 0, 0);
#pragma unroll
        for (int r = 0; r < 4; ++r) Xm[(16 * bi + 4 * fq + r) * 36 + 16 * bj + fr] = acc[r];
    }
    __syncthreads();
    if (F.wave < 4) {
        const int bi = F.wave >> 1, bj = F.wave & 1; f32x4 acc = (f32x4){0.f, 0.f, 0.f, 0.f};
#pragma unroll
        for (int kk = 0; kk < 8; ++kk) acc = __builtin_amdgcn_mfma_f32_16x16x4f32(Tm[(32 + 16 * bi + fr) * LS + 32 + 4 * kk + fq], Xm[(4 * kk + fq) * 36 + 16 * bj + fr], acc, 0, 0, 0);
#pragma unroll
        for (int r = 0; r < 4; ++r) Tm[(32 + 16 * bi + 4 * fq + r) * LS + 16 * bj + fr] = -acc[r];
    }
    __syncthreads();
    {
        const int i = F.tid >> 3, j0 = (F.tid & 7) * 8; const f32x4 a = *(const LAS f32x4*)(Tm + i * LS + j0), bq = *(const LAS f32x4*)(Tm + i * LS + j0 + 4);
        v4u w; w.x = pk2(a[0], a[1]); w.y = pk2(a[2], a[3]); w.z = pk2(bq[0], bq[1]); w.w = pk2(bq[2], bq[3]);
        *(LAS v4u*)(L + OFF_T + i * 144 + j0 * 2) = w;
    }
    __syncthreads();
    d1_pre_issue(A, F, ci_next, Pn);
#pragma unroll 1
    for (int x = 0; x < 8; ++x) {
        const int tile = F.wave * 8 + x, which = tile >> 5, ti = (tile >> 3) & 3, td = tile & 7;
        const LAS unsigned char* ap = L + OFF_T + (ti * 16 + fr) * 144 + fq * 16; const LAS unsigned char* bp = L + (which ? OFF_KBGT : OFF_VBT) + (td * 16 + fr) * 144 + td * 16 + fq * 16;
        f32x4 acc = (f32x4){0.f, 0.f, 0.f, 0.f};
#pragma unroll
        for (int kk = 0; kk < 2; ++kk) acc = __builtin_amdgcn_mfma_f32_16x16x32_bf16(lds_frag16(bp + kk * 64), lds_frag16(ap + kk * 64), acc, 0, 0, 0);
        const int i = ti * 16 + fr, d = td * 16 + 4 * fq;
        if (which == 0) { v2u w; w.x = pk2(acc[0], acc[1]); w.y = pk2(acc[2], acc[3]); *(GAS v2u*)(Ug + i * 128 + d) = w; }
        else { v2u w; w.x = pk2(acc[0], acc[1]); w.y = pk2(acc[2], acc[3]); *(GAS v2u*)(Wg + i * 128 + 32 * (td >> 1) + 8 * fq + 4 * (td & 1)) = w; }
    }
    __syncthreads();
}

constexpr int SC_OW = 0, SC_OQG = 16384, SC_OKDT = 32768, SC_OQK = 49152, SC_OU = 57344, SC_BUF = 65536, SC_NS = 2, SC_NP = (56 + 2 * SC_NS + NWAVES - SC_NS - 1) / (NWAVES - SC_NS);
__device__ __forceinline__ void scan_src(const Frame& F, int sl0, int j, unsigned& off, int& sh, unsigned& ldst) {
    int pi = (F.wave - SC_NS) + (NWAVES - SC_NS) * j; if (pi > 55 + 2 * SC_NS) pi = 55 + 2 * SC_NS;
    ldst = pi * 1024 + F.lane * 16;
    if (pi < 32) { const int i = (pi & 15) * 64 + F.lane, r = i >> 4, c = (i & 15) ^ (r & 15); off = (unsigned)(pi < 16 ? WS_W : WS_QG) + r * 256 + c * 16; sh = 14; }
    else if (pi < 56) { const int i = (pi < 48 ? pi - 32 : pi - 48) * 64 + F.lane, r = i >> 3, c = (i & 7) ^ ((r >> 1) & 7); off = (unsigned)(pi < 48 ? WS_KDT : WS_QK) + r * 128 + c * 16; sh = pi < 48 ? 14 : 13; }
    else { const int i = ((pi - 56) & 1) * 64 + F.lane, r = i >> 1, c = i & 1; off = (unsigned)WS_U + sl0 * 32 + ((pi - 56) >> 1) * 32 + r * 256 + c * 16; sh = 14; }
}
#define SCAN_LOAD(R, ci) _Pragma("unroll") for (int j = 0; j < SC_NP; ++j) R[j] = *(const GAS v4u*)(A.ws + (size_t)(off[j] + ((unsigned)(ci) << sh[j])))
#define SCAN_STORE(buf, R) _Pragma("unroll") for (int j = 0; j < SC_NP; ++j) *(LAS v4u*)((buf) + ldst[j]) = R[j]
__device__ __forceinline__ bf16x8 frag256(const LAS unsigned char* tile, int row, int kstep, int fq) { return *(const LAS bf16x8*)(tile + row * 256 + (((4 * kstep + fq) ^ (row & 15)) << 4)); }
__device__ __forceinline__ bf16x8 frag128(const LAS unsigned char* tile, int row, int kstep, int fq) { return *(const LAS bf16x8*)(tile + row * 128 + (((4 * kstep + fq) ^ ((row >> 1) & 7)) << 4)); }
__device__ __forceinline__ bf16x8 pack_pair(const pg8::f32x4& a, const pg8::f32x4& b) { v4u w; w.x = pk2(a[0], a[1]); w.y = pk2(a[2], a[3]); w.z = pk2(b[0], b[1]); w.w = pk2(b[2], b[3]); return __builtin_bit_cast(bf16x8, w); }
__device__ __forceinline__ void scan_unit(const Args& A, Frame& F, int b, int h, int sl0) {
    using pg8::f32x4;
    LAS unsigned char* L = F.lds + RING_OFF;
    const int ci0 = (b * NH + h) * 32;
    if (F.wave >= SC_NS) {
        v4u R0[SC_NP], R1[SC_NP]; unsigned off[SC_NP], ldst[SC_NP]; int sh[SC_NP];
#pragma unroll
        for (int j = 0; j < SC_NP; ++j) scan_src(F, sl0, j, off[j], sh[j], ldst[j]);
        SCAN_LOAD(R0, ci0); SCAN_LOAD(R1, ci0 + 1); SCAN_STORE(L, R0); SCAN_LOAD(R0, ci0 + 2); SCAN_STORE(L + SC_BUF, R1); SCAN_LOAD(R1, ci0 + 3);
        asm volatile("s_waitcnt lgkmcnt(0)" ::: "memory");
        __builtin_amdgcn_s_barrier(); asm volatile("" ::: "memory");
#define SCAN_BAR() do { asm volatile("s_waitcnt lgkmcnt(0)" ::: "memory"); __builtin_amdgcn_s_barrier(); asm volatile("" ::: "memory"); } while (0)
#ifdef PROBE_PH
        if (A.pad & 8) { _Pragma("unroll 1") for (int n = 0; n < 28; n += 2) { SCAN_BAR(); SCAN_BAR(); } } else
#endif
        _Pragma("unroll 1") for (int n = 0; n < 28; n += 2) {
            SCAN_BAR(); SCAN_STORE(L, R0); SCAN_LOAD(R0, ci0 + n + 4);
            SCAN_BAR(); SCAN_STORE(L + SC_BUF, R1); SCAN_LOAD(R1, ci0 + n + 5);
        }
        SCAN_BAR(); SCAN_STORE(L, R0);
        SCAN_BAR(); SCAN_STORE(L + SC_BUF, R1);
        SCAN_BAR(); SCAN_BAR();
    } else {
        const int fr = F.lane & 15, fq = F.lane >> 4;
        float* Og = (float*)(A.ws + WS_RE); const float* GLg = (const float*)(A.ws + WS_GL);
        const int sl = sl0 + F.wave;
        __builtin_amdgcn_s_barrier(); asm volatile("" ::: "memory");
        f32x4 S[8];
#pragma unroll
        for (int i = 0; i < 8; ++i) S[i] = (f32x4){0.f, 0.f, 0.f, 0.f};
        const float glall = GLg[ci0 + (F.lane & 31)];
#pragma unroll 1
        for (int n = 0; n < 32; ++n) {
            const LAS unsigned char* B = L + (n & 1) * SC_BUF; const LAS unsigned char* Ub = B + SC_OU + F.wave * 2048;
            const float gl = rdl(glall, n);
#ifdef PROBE_PH
            if (A.pad & 16) { __builtin_amdgcn_s_barrier(); continue; }
#endif
            bf16x8 wf[16]; float uu[16];
#pragma unroll
            for (int tb = 0; tb < 4; ++tb)
#pragma unroll
                for (int kk = 0; kk < 4; ++kk) wf[4 * tb + kk] = frag256(B + SC_OW, 16 * tb + fr, kk, fq);
#pragma unroll
            for (int tb = 0; tb < 4; ++tb)
#pragma unroll
                for (int r = 0; r < 4; ++r) uu[4 * tb + r] = bf2f(*(const LAS unsigned short*)(Ub + (16 * tb + 4 * fq + r) * 32 + fr * 2));
            bf16x8 Sb[4];
#pragma unroll
            for (int kk = 0; kk < 4; ++kk) Sb[kk] = pack_pair(S[2 * kk], S[2 * kk + 1]);
            __builtin_amdgcn_sched_barrier(0);
            f32x4 vn[4];
#pragma unroll
            for (int tb = 0; tb < 4; ++tb) { f32x4 p1 = (f32x4){0.f, 0.f, 0.f, 0.f};
#pragma unroll
                for (int kk = 0; kk < 4; ++kk) p1 = __builtin_amdgcn_mfma_f32_16x16x32_bf16(wf[4 * tb + kk], Sb[kk], p1, 0, 0, 0);
#pragma unroll
                for (int r = 0; r < 4; ++r) vn[tb][r] = uu[4 * tb + r] - p1[r]; }
            bf16x8 Vb[2]; Vb[0] = pack_pair(vn[0], vn[1]); Vb[1] = pack_pair(vn[2], vn[3]);
            __builtin_amdgcn_sched_barrier(0);
            bf16x8 qg[16], kd[16];
#pragma unroll
            for (int tb = 0; tb < 4; ++tb)
#pragma unroll
                for (int kk = 0; kk < 4; ++kk) qg[4 * tb + kk] = frag256(B + SC_OQG, 16 * tb + fr, kk, fq);
#pragma unroll
            for (int blk = 0; blk < 8; ++blk)
#pragma unroll
                for (int kt = 0; kt < 2; ++kt) kd[2 * blk + kt] = frag128(B + SC_OKDT, 16 * blk + fr, kt, fq);
            __builtin_amdgcn_sched_barrier(0);
            f32x4 o[4];
#pragma unroll
            for (int tb = 0; tb < 4; ++tb) { f32x4 oo = (f32x4){0.f, 0.f, 0.f, 0.f};
#pragma unroll
                for (int kk = 0; kk < 4; ++kk) oo = __builtin_amdgcn_mfma_f32_16x16x32_bf16(qg[4 * tb + kk], Sb[kk], oo, 0, 0, 0);
                o[tb] = oo; }
            __builtin_amdgcn_sched_barrier(0);
            bf16x8 qk[8];
#pragma unroll
            for (int tb = 0; tb < 4; ++tb)
#pragma unroll
                for (int kt = 0; kt < 2; ++kt) qk[2 * tb + kt] = frag128(B + SC_OQK, 16 * tb + fr, kt, fq);
            __builtin_amdgcn_sched_barrier(0);
            const size_t orow = (size_t)(b * SEQ + n * 64);
#pragma unroll
            for (int blk = 0; blk < 8; ++blk) { f32x4 s = S[blk] * gl;
#pragma unroll
                for (int kt = 0; kt < 2; ++kt) s = __builtin_amdgcn_mfma_f32_16x16x32_bf16(kd[2 * blk + kt], Vb[kt], s, 0, 0, 0);
                S[blk] = s; }
#pragma unroll
            for (int tb = 0; tb < 4; ++tb) { f32x4 oo = o[tb];
#pragma unroll
                for (int kt = 0; kt < 2; ++kt) oo = __builtin_amdgcn_mfma_f32_16x16x32_bf16(qk[2 * tb + kt], Vb[kt], oo, 0, 0, 0);
#pragma unroll
                for (int r = 0; r < 4; ++r)
#ifdef PROBE_PH
                    if (!(A.pad & 4))
#endif
                    Og[(orow + 16 * tb + 4 * fq + r) * 512 + h * 128 + sl * 16 + fr] = oo[r]; }
            asm volatile("s_waitcnt lgkmcnt(0)" ::: "memory");
            __builtin_amdgcn_s_barrier(); asm volatile("" ::: "memory");
        }
        float* od = A.out + OUT_DLP + (size_t)(b * NH + h) * DKV * DKV;
#pragma unroll
        for (int blk = 0; blk < 8; ++blk)
#pragma unroll
            for (int r = 0; r < 4; ++r) od[(16 * blk + 4 * fq + r) * DKV + sl * 16 + fr] = S[blk][r];
    }
    asm volatile("s_waitcnt vmcnt(0) lgkmcnt(0)" ::: "memory"); __builtin_amdgcn_s_barrier(); asm volatile("" ::: "memory");
}
__device__ __forceinline__ void delta_sample_par(const Args& A, Frame& F, int s) {
    using pg8::f32x4;
    const LAS bf16* SQ = (const LAS bf16*)(F.lds + RING_OFF + SMP_OFF_Q); const float* BG = (const float*)(A.ws + WS_BG); LAS float* SO = (LAS float*)(F.lds + RING_OFF + SMP_OFF_O);
    const size_t row = (size_t)MP + s;
    const int h = F.tid >> 7, t = F.tid & 127, dv4 = (t & 31) * 4, grp = t >> 5;
    LAS float* qs = (LAS float*)(F.lds + RING_OFF) + h * 128; LAS float* ks = (LAS float*)(F.lds + RING_OFF) + 512 + h * 128; LAS float* red = (LAS float*)(F.lds + RING_OFF) + 1024 + h * 512;
    const float* S0b = A.in[I_SDELTA] + ((size_t)s * NH + h) * DKV * DKV + (size_t)(grp * 32) * DKV + dv4; float* Sob = A.out + OUT_DLS + ((size_t)s * NH + h) * DKV * DKV + (size_t)(grp * 32) * DKV + dv4;
    f32x4 s0[32];
#pragma unroll
    for (int i = 0; i < 32; ++i) s0[i] = __builtin_nontemporal_load((const GAS f32x4*)(S0b + (size_t)i * DKV));
    qs[t] = bf2f(SQ[h * 128 + t]); ks[t] = bf2f(SQ[512 + h * 128 + t]);
    f32x4 v; { const v2u x = *(const LAS v2u*)(SQ + 1024 + h * 128 + dv4); v = (f32x4){bflo(x.x), bfhi(x.x), bflo(x.y), bfhi(x.y)}; }
    const float beta = BG[row * 8 + h], eg = __expf(BG[row * 8 + 4 + h]);
    __builtin_amdgcn_sched_barrier(0);
    __syncthreads();
    f32x4 part = (f32x4){0.f, 0.f, 0.f, 0.f};
#pragma unroll
    for (int i = 0; i < 32; ++i) part = part + s0[i] * ks[grp * 32 + i];
    *(LAS f32x4*)(red + grp * 128 + dv4) = part;
    __syncthreads();
    f32x4 kS = (f32x4){0.f, 0.f, 0.f, 0.f};
#pragma unroll
    for (int g = 0; g < 4; ++g) kS = kS + *(const LAS f32x4*)(red + g * 128 + dv4);
    const f32x4 vnew = (v - kS * eg) * beta;
    __syncthreads();
    f32x4 po = (f32x4){0.f, 0.f, 0.f, 0.f};
#pragma unroll
    for (int i = 0; i < 32; ++i) { const f32x4 sn = s0[i] * eg + vnew * ks[grp * 32 + i]; *(GAS f32x4*)(Sob + (size_t)i * DKV) = sn; po = po + sn * qs[grp * 32 + i]; }
    *(LAS f32x4*)(red + grp * 128 + dv4) = po;
    __syncthreads();
    if (grp == 0) { f32x4 o = (f32x4){0.f, 0.f, 0.f, 0.f};
#pragma unroll
        for (int g = 0; g < 4; ++g) o = o + *(const LAS f32x4*)(red + g * 128 + dv4);
        *(LAS f32x4*)(SO + h * 128 + dv4) = o; }
    __syncthreads();
}

__device__ __forceinline__ void ogate_row(const Args& A, Frame& F, int m, const pg8::f32x4& n0, const pg8::f32x4& n1, int half = -1) {
    const bf16* PB = (const bf16*)(A.ws + WS_RA); bf16* CD = (bf16*)(A.ws + WS_RF); const float* Og = (const float*)(A.ws + WS_RE); const int ch0 = 8 * F.lane;
    const f32x4 o0 = __builtin_nontemporal_load((const GAS f32x4*)(Og + (size_t)m * 512 + ch0)), o1 = __builtin_nontemporal_load((const GAS f32x4*)(Og + (size_t)m * 512 + ch0 + 4));
    const v4u zz = __builtin_nontemporal_load((const GAS v4u*)(PB + (size_t)m * PBLD + 2048 + ch0)); float z[8]; unpack8(zz, z);
    float ss = (o0[0] * o0[0] + o0[1] * o0[1]) + (o0[2] * o0[2] + o0[3] * o0[3]) + (o1[0] * o1[0] + o1[1] * o1[1]) + (o1[2] * o1[2] + o1[3] * o1[3]);
    ss = row16_sum(ss);
    const float rstd = 1.f / sqrtf(ss * (1.f / 128.f) + RMS_EPS);
    float d[8];
#pragma unroll
    for (int i = 0; i < 4; ++i) { d[i] = o0[i] * rstd * n0[i] * silu(z[i]); d[4 + i] = o1[i] * rstd * n1[i] * silu(z[4 + i]); }
    if (half < 0 || (F.lane >> 5) == half) *(GAS v4u*)(CD + (size_t)m * DM + 512 + ch0) = pack8(d);
}
__device__ __forceinline__ void ogate_phase(const Args& A, Frame& F, int blk, int nblk) {
    const int gw = blk * NWAVES + F.wave, NGW = nblk * NWAVES; const int ch0 = 8 * F.lane;
    const f32x4 n0 = *(const f32x4*)(A.in[I_DNN] + (ch0 & 127)), n1 = *(const f32x4*)(A.in[I_DNN] + (ch0 & 127) + 4);
    for (int m = gw; m < MP; m += NGW) ogate_row(A, F, m, n0, n1);
}
__device__ __forceinline__ void sample_mixer(const Args& A, Frame& F, int s) {
    shortconv_sample(A, F, s);
    delta_sample_par(A, F, s);
    if (F.wave == 0) {
        const bf16* PB = (const bf16*)(A.ws + WS_RA); bf16* CD = (bf16*)(A.ws + WS_RF); const LAS float* SO = (const LAS float*)(F.lds + RING_OFF + SMP_OFF_O);
        const int ch0 = 8 * F.lane; const size_t m = (size_t)MP + s;
        const f32x4 n0 = *(const f32x4*)(A.in[I_DNN] + (ch0 & 127)), n1 = *(const f32x4*)(A.in[I_DNN] + (ch0 & 127) + 4);
        const f32x4 o0 = *(const LAS f32x4*)(SO + ch0), o1 = *(const LAS f32x4*)(SO + ch0 + 4);
        const v4u zz = *(const GAS v4u*)(PB + m * PBLD + 2048 + ch0); float z[8]; unpack8(zz, z);
        float ss = (o0[0] * o0[0] + o0[1] * o0[1]) + (o0[2] * o0[2] + o0[3] * o0[3]) + (o1[0] * o1[0] + o1[1] * o1[1]) + (o1[2] * o1[2] + o1[3] * o1[3]);
        ss = row16_sum(ss);
        const float rstd = 1.f / sqrtf(ss * (1.f / 128.f) + RMS_EPS);
        float d[8];
#pragma unroll
        for (int i = 0; i < 4; ++i) { d[i] = o0[i] * rstd * n0[i] * silu(z[i]); d[4 + i] = o1[i] * rstd * n1[i] * silu(z[4 + i]); }
        *(GAS v4u*)(CD + m * DM + 512 + ch0) = pack8(d);
    }
    __syncthreads();
}

__device__ __forceinline__ void attn32_issue(const Args& A, Frame& F, int st, int b, int h, LAS unsigned char* slot) {
    const bf16* KB = (const bf16*)(A.ws + WS_KB); const bf16* VT = (const bf16*)(A.ws + WS_VT);
    if (st < 4) {
#pragma unroll
        for (int it = 0; it < 4; ++it) { const int idx = it * 512 + F.tid; const int r = idx >> 5, pp = idx & 31, c = pp ^ (r & 15);
            const bf16* src = KB + (size_t)(b * NMEM + 64 * st + r) * DM + h * MHD + 8 * c;
            __builtin_amdgcn_global_load_lds((const unsigned*)src, (LAS unsigned*)(slot + it * 8192 + F.wave * 1024), 16, 0, 0); }
    } else {
        const int half = (st - 4) >> 1, kh = (st - 4) & 1;
#pragma unroll
        for (int it = 0; it < 4; ++it) { const int idx = it * 512 + F.tid; const int r = idx >> 4, pp = idx & 15, c = pp ^ (r & 15);
            const bf16* src = VT + (size_t)(h * MHD + 128 * half + r) * (NB * NMEM) + b * NMEM + 128 * kh + 8 * c;
            __builtin_amdgcn_global_load_lds((const unsigned*)src, (LAS unsigned*)(slot + it * 8192 + F.wave * 1024), 16, 0, 0); }
    }
}
__device__ __forceinline__ void attn_unit32(const Args& A, Frame& F, int pm, int h) {
    int oz; asm volatile("v_mov_b32 %0, 0" : "=v"(oz));
    const int b = pm >> 3; const int lane = F.lane + oz; const int r32 = lane & 31, hh = lane >> 5;
    bf16* AO = (bf16*)(A.ws + WS_RD);
    const size_t qoff = (size_t)(pm * 256 + F.wave * 32 + r32) * DM + h * MHD;
    LAS unsigned char* L = F.lds + RING_OFF;
    bf16x8 qf[16];
    {
      asm volatile("s_waitcnt lgkmcnt(0)" ::: "memory"); __builtin_amdgcn_s_barrier(); asm volatile("" ::: "memory");
      const int rl = F.wave * 32 + r32;
#pragma unroll
      for (int ks = 0; ks < 16; ++ks) qf[ks] = *(const LAS bf16x8*)(L + rl * 512 + (((2 * ks + hh) ^ (rl & 31)) << 4));
      asm volatile("s_waitcnt lgkmcnt(0)" ::: "memory"); __builtin_amdgcn_s_barrier(); asm volatile("" ::: "memory"); }
    attn32_issue(A, F, 0, b, h, L); attn32_issue(A, F, 1, b, h, L + 32768); attn32_issue(A, F, 2, b, h, L + 65536);
    f32x16 sacc[8];
#pragma unroll
    for (int st = 0; st < 4; ++st) {
        asm volatile("s_waitcnt vmcnt(8)" ::: "memory");
        __builtin_amdgcn_s_barrier(); asm volatile("" ::: "memory");
        attn32_issue(A, F, st + 3, b, h, L + ((st + 3) & 3) * 32768);
        const LAS unsigned char* slot = L + (st & 3) * 32768;
#pragma unroll
        for (int kbl = 0; kbl < 2; ++kbl) { f32x16 acc;
#pragma unroll
            for (int i = 0; i < 16; ++i) acc[i] = 0.f;
            const int row = 32 * kbl + r32;
            const LAS unsigned char* rowp = slot + row * 512; const int sw = row & 15;
            bf16x8 af[3];
            af[0] = *(const LAS bf16x8*)(rowp + (((0 + hh) ^ sw) << 4)); af[1] = *(const LAS bf16x8*)(rowp + (((2 + hh) ^ sw) << 4));
#pragma unroll
            for (int ks = 0; ks < 16; ++ks) {
                if (ks + 2 < 16) af[(ks + 2) % 3] = *(const LAS bf16x8*)(rowp + (((2 * ks + 4 + hh) ^ sw) << 4));
                acc = __builtin_amdgcn_mfma_f32_32x32x16_bf16(af[ks % 3], qf[ks], acc, 0, 0, 0);
                if ((ks & 3) == 3) __builtin_amdgcn_sched_barrier(0); }
            sacc[2 * st + kbl] = acc; }
    }
    __builtin_amdgcn_sched_barrier(0);
    float mx = -3.0e38f;
#pragma unroll
    for (int kb = 0; kb < 8; ++kb)
#pragma unroll
        for (int i = 0; i < 16; ++i) mx = fmaxf(mx, sacc[kb][i]);
    mx = fmaxf(mx, __shfl_xor(mx, 32));
    float lsum = 0.f; v4u pb[8][2];
#pragma unroll
    for (int kb = 0; kb < 8; ++kb) {
#pragma unroll
        for (int i = 0; i < 16; ++i) { const float pp = __builtin_amdgcn_exp2f(sacc[kb][i] - mx); sacc[kb][i] = pp; lsum += pp; }
#pragma unroll
        for (int s2 = 0; s2 < 2; ++s2) { pb[kb][s2].x = pk2(sacc[kb][8 * s2 + 0], sacc[kb][8 * s2 + 1]); pb[kb][s2].y = pk2(sacc[kb][8 * s2 + 2], sacc[kb][8 * s2 + 3]);
            pb[kb][s2].z = pk2(sacc[kb][8 * s2 + 4], sacc[kb][8 * s2 + 5]); pb[kb][s2].w = pk2(sacc[kb][8 * s2 + 6], sacc[kb][8 * s2 + 7]); }
        __builtin_amdgcn_sched_barrier(0);
    }
    lsum += __shfl_xor(lsum, 32);
    const float inv = 1.f / lsum;
    __builtin_amdgcn_sched_barrier(0);
#pragma unroll 1
    for (int half = 0; half < 2; ++half) {
        f32x16 oacc[4];
#pragma unroll
        for (int db = 0; db < 4; ++db)
#pragma unroll
            for (int i = 0; i < 16; ++i) oacc[db][i] = 0.f;
#pragma unroll
        for (int kh = 0; kh < 2; ++kh) { const int st = 4 + 2 * half + kh;
            if (half == 0) asm volatile("s_waitcnt vmcnt(8)" ::: "memory"); else if (kh == 0) asm volatile("s_waitcnt vmcnt(4)" ::: "memory"); else asm volatile("s_waitcnt vmcnt(0)" ::: "memory");
            __builtin_amdgcn_s_barrier(); asm volatile("" ::: "memory");
            if (st + 3 < 8) attn32_issue(A, F, st + 3, b, h, L + ((st + 3) & 3) * 32768);
            const LAS unsigned char* slot = L + (st & 3) * 32768;
#pragma unroll
            for (int db = 0; db < 4; ++db) { const int row = 32 * db + r32;
#pragma unroll
                for (int k8 = 0; k8 < 8; ++k8) {
                    const bf16x8 aw = *(const LAS bf16x8*)(slot + row * 256 + (((2 * k8 + hh) ^ (row & 15)) << 4));
                    oacc[db] = __builtin_amdgcn_mfma_f32_32x32x16_bf16(aw, __builtin_bit_cast(bf16x8, pb[4 * kh + (k8 >> 1)][k8 & 1]), oacc[db], 0, 0, 0); } }
        }
#pragma unroll
        for (int db = 0; db < 4; ++db)
#pragma unroll
            for (int g = 0; g < 4; ++g) { v2u w; w.x = pk2(oacc[db][4 * g + 0] * inv, oacc[db][4 * g + 1] * inv); w.y = pk2(oacc[db][4 * g + 2] * inv, oacc[db][4 * g + 3] * inv);
                *(GAS v2u*)(AO + qoff + 128 * half + 32 * db + 8 * g + 4 * hh) = w; }
    }
    LDS_WAIT(); asm volatile("s_waitcnt vmcnt(0)" ::: "memory"); __builtin_amdgcn_s_barrier(); asm volatile("" ::: "memory");
}
__device__ __forceinline__ void attn_sample(const Args& A, Frame& F, int s, int h) {
    const bf16* qrow = (const bf16*)(A.ws + WS_RB) + (size_t)(MP + s) * DM + h * MHD; bf16* orow = (bf16*)(A.ws + WS_RD) + (size_t)(MP + s) * DM + h * MHD;
    const int g = F.lane >> 4, dl = F.lane & 15;
    const float* Kc = A.in[I_CMK] + (size_t)s * NMEM * DM + h * MHD + (size_t)(32 * F.wave + g) * DM + 4 * dl;
    const float* Vc = A.in[I_CMV] + (size_t)s * NMEM * DM + h * MHD + (size_t)(32 * F.wave + g) * DM + 4 * dl;
    LAS float* pl = (LAS float*)(F.lds + RING_OFF); LAS float* wred = pl + 256; LAS float* ored = pl + 512;
    f32x4 kv[8][4];
#pragma unroll
    for (int it = 0; it < 8; ++it)
#pragma unroll
        for (int i = 0; i < 4; ++i) kv[it][i] = __builtin_nontemporal_load((const GAS f32x4*)(Kc + (size_t)(4 * it) * DM + 64 * i));
    f32x4 q[4];
#pragma unroll
    for (int i = 0; i < 4; ++i) { const v2u x = *(const GAS v2u*)(qrow + 64 * i + 4 * dl); q[i] = (f32x4){bflo(x.x), bfhi(x.x), bflo(x.y), bfhi(x.y)}; }
    __builtin_amdgcn_sched_barrier(0);
    float myscore = -3.0e38f;
#pragma unroll
    for (int it = 0; it < 8; ++it) { float d = 0.f;
#pragma unroll
        for (int i = 0; i < 4; ++i) d += (kv[it][i][0] * q[i][0] + kv[it][i][1] * q[i][1]) + (kv[it][i][2] * q[i][2] + kv[it][i][3] * q[i][3]);
        d = row16_sum(d);
        if (dl == it) myscore = d; }
#pragma unroll
    for (int it = 0; it < 8; ++it)
#pragma unroll
        for (int i = 0; i < 4; ++i) kv[it][i] = __builtin_nontemporal_load((const GAS f32x4*)(Vc + (size_t)(4 * it) * DM + 64 * i));
    const float m = wave_max(myscore);
    if (F.lane == 0) wred[F.wave] = m;
    __syncthreads();
    float gm = wred[0];
#pragma unroll
    for (int i = 1; i < 8; ++i) gm = fmaxf(gm, wred[i]);
    const float p = (dl < 8) ? __builtin_amdgcn_exp2f(myscore - gm) : 0.f;
    if (dl < 8) pl[32 * F.wave + 4 * dl + g] = p;
    const float ws_ = wave_sum(p);
    if (F.lane == 0) wred[8 + F.wave] = ws_;
    __syncthreads();
    float tot = 0.f;
#pragma unroll
    for (int i = 0; i < 8; ++i) tot += wred[8 + i];
    f32x4 acc[4];
#pragma unroll
    for (int i = 0; i < 4; ++i) acc[i] = (f32x4){0.f, 0.f, 0.f, 0.f};
#pragma unroll
    for (int it = 0; it < 8; ++it) { const float pi = pl[32 * F.wave + 4 * it + g];
#pragma unroll
        for (int i = 0; i < 4; ++i) acc[i] = acc[i] + kv[it][i] * pi; }
#pragma unroll
    for (int i = 0; i < 4; ++i)
#pragma unroll
        for (int e = 0; e < 4; ++e) { float v = acc[i][e]; v += __shfl_xor(v, 16); v += __shfl_xor(v, 32); acc[i][e] = v; }
    if (g == 0) {
#pragma unroll
        for (int i = 0; i < 4; ++i) *(LAS f32x4*)(ored + F.wave * 256 + 64 * i + 4 * dl) = acc[i]; }
    __syncthreads();
    if (F.tid < 256) { float o = 0.f;
#pragma unroll
        for (int w = 0; w < 8; ++w) o += ored[w * 256 + F.tid];
        orow[F.tid] = (bf16)(pk2(o / tot, 0.f) & 0xffffu); }
    __syncthreads();
}

typedef unsigned v2u_ __attribute__((ext_vector_type(2)));
template <int NKS, class Epi>
__device__ __forceinline__ void small_gemm_item(const Frame& F, const bf16* Arow0, const bf16* Bt, int pn, int j, int rq, const Epi& E) {
    using pg8::f32x4;
    constexpr int K = NKS * 256;
    const int fr = F.lane & 15, fq = F.lane >> 4;
    const bf16* ap = Arow0 + (size_t)(32 * rq + fr) * K + F.wave * (K / 8) + 8 * fq;
    const bf16* b0 = Bt + (size_t)(256 * pn + 16 * j + fr) * K + F.wave * (K / 8) + 8 * fq; const bf16* b1 = b0 + (size_t)128 * K;
    bf16x8 a0[NKS], a1[NKS], x0[NKS], x1[NKS];
#pragma unroll
    for (int u = 0; u < NKS; ++u) { a0[u] = *(const GAS bf16x8*)(ap + 32 * u); a1[u] = *(const GAS bf16x8*)(ap + (size_t)16 * K + 32 * u); x0[u] = *(const GAS bf16x8*)(b0 + 32 * u); x1[u] = *(const GAS bf16x8*)(b1 + 32 * u); }
    __builtin_amdgcn_sched_barrier(0);
    f32x4 c00 = (f32x4){0.f, 0.f, 0.f, 0.f}, c01 = c00, c10 = c00, c11 = c00;
#pragma unroll
    for (int u = 0; u < NKS; ++u) {
        c00 = __builtin_amdgcn_mfma_f32_16x16x32_bf16(x0[u], a0[u], c00, 0, 0, 0); c01 = __builtin_amdgcn_mfma_f32_16x16x32_bf16(x1[u], a0[u], c01, 0, 0, 0);
        c10 = __builtin_amdgcn_mfma_f32_16x16x32_bf16(x0[u], a1[u], c10, 0, 0, 0); c11 = __builtin_amdgcn_mfma_f32_16x16x32_bf16(x1[u], a1[u], c11, 0, 0, 0);
    }
    LAS f32x4* red = (LAS f32x4*)(F.lds + RING_OFF);
    red[(F.wave * 4 + 0) * 64 + F.lane] = c00; red[(F.wave * 4 + 1) * 64 + F.lane] = c01; red[(F.wave * 4 + 2) * 64 + F.lane] = c10; red[(F.wave * 4 + 3) * 64 + F.lane] = c11;
    __syncthreads();
    if (F.wave < 2) {
        f32x4 sA = (f32x4){0.f, 0.f, 0.f, 0.f}, sB = sA;
#pragma unroll
        for (int w = 0; w < 8; ++w) { sA = sA + red[(w * 4 + 2 * F.wave) * 64 + F.lane]; sB = sB + red[(w * 4 + 2 * F.wave + 1) * 64 + F.lane]; }
        E(32 * rq + 16 * F.wave + fr, pn, j, fq, sA, sB);
    }
    __syncthreads();
}
__device__ __forceinline__ v2u_ pk4(const pg8::f32x4& a) { v2u_ w; w.x = pk2(a[0], a[1]); w.y = pk2(a[2], a[3]); return w; }
struct SEpiIn { bf16* PBs;
    __device__ __forceinline__ void operator()(int m, int pn, int j, int fq, const pg8::f32x4& a, const pg8::f32x4& b) const {
        if (pn < 4) { pg8::f32x4 v;
#pragma unroll
            for (int i = 0; i < 4; ++i) v[i] = a[i] * sigm(b[i]);
            *(GAS v2u_*)(PBs + (size_t)m * PBLD + 128 * pn + 16 * j + 4 * fq) = pk4(v); }
        else { bf16* rp = PBs + (size_t)m * PBLD + 256 * pn - 512 + 16 * j + 4 * fq; *(GAS v2u_*)rp = pk4(a); *(GAS v2u_*)(rp + 128) = pk4(b); }
    } };
template <int MODE> struct SEpiRes { const float* basef; const bf16* baseb; float* outf; bf16* outb; float* ss;
    __device__ __forceinline__ void operator()(int m, int pn, int j, int fq, const pg8::f32x4& a, const pg8::f32x4& b) const {
        const size_t off = (size_t)m * DM + 256 * pn + 16 * j + 4 * fq;
        pg8::f32x4 b0, b1;
        if (MODE == 0) { b0 = *(const GAS pg8::f32x4*)(basef + off); b1 = *(const GAS pg8::f32x4*)(basef + off + 128); }
        else { const v2u_ w0 = *(const GAS v2u_*)(baseb + off), w1 = *(const GAS v2u_*)(baseb + off + 128); b0 = pg8::bf4lo(w0.x, w0.y); b1 = pg8::bf4lo(w1.x, w1.y); }
        const pg8::f32x4 v0 = a + b0, v1 = b + b1;
        if (MODE == 2) { *(GAS pg8::f32x4*)(outf + off) = v0; *(GAS pg8::f32x4*)(outf + off + 128) = v1; }
        else { *(GAS v2u_*)(outb + off) = pk4(v0); *(GAS v2u_*)(outb + off + 128) = pk4(v1); }
        float s = (v0[0] * v0[0] + v0[1] * v0[1]) + (v0[2] * v0[2] + v0[3] * v0[3]) + (v1[0] * v1[0] + v1[1] * v1[1]) + (v1[2] * v1[2] + v1[3] * v1[3]);
        s += __shfl_xor(s, 16); s += __shfl_xor(s, 32);
        if (fq == 0) atomicAdd(ss + m, s);
    } };
struct SEpiQ { bf16* Qs; const float* ss; float c2;
    __device__ __forceinline__ void operator()(int m, int pn, int j, int fq, const pg8::f32x4& a, const pg8::f32x4& b) const {
        const float rs = __builtin_amdgcn_rsqf(ss[m] * (1.f / 1024.f) + RMS_EPS) * c2; bf16* rp = Qs + (size_t)m * DM + 256 * pn + 16 * j + 4 * fq;
        *(GAS v2u_*)rp = pk4(a * rs); *(GAS v2u_*)(rp + 128) = pk4(b * rs);
    } };
struct SEpiGU { bf16* Ts; const float* ss;
    __device__ __forceinline__ void operator()(int m, int pn, int j, int fq, const pg8::f32x4& a, const pg8::f32x4& b) const {
        const float rs = __builtin_amdgcn_rsqf(ss[m] * (1.f / 1024.f) + RMS_EPS); pg8::f32x4 v;
#pragma unroll
        for (int i = 0; i < 4; ++i) v[i] = silu(a[i] * rs) * (b[i] * rs);
        *(GAS v2u_*)(Ts + (size_t)m * DFF + 128 * pn + 16 * j + 4 * fq) = pk4(v);
    } };

__device__ __forceinline__ void final_norm_phase(const Args& A, Frame& F) {
    const int gw = F.vcu * NWAVES + F.wave, NGW = F.G * NWAVES; const float* ss = (const float*)(F.ctl + CW_SS3); const float* X3S = (const float*)(A.ws + WS_X1S);
    f32x4 gn[4];
#pragma unroll
    for (int j = 0; j < 4; ++j) gn[j] = *(const f32x4*)(A.in[I_NF] + 256 * j + 4 * F.lane);
    for (int m = gw; m < DEC; m += NGW) {
        const GAS f32x4* xr = (const GAS f32x4*)(X3S + (size_t)m * DM) + F.lane; GAS f32x4* yr = (GAS f32x4*)(A.out + (size_t)(MP + m) * DM) + F.lane;
        const float rstd = 1.f / sqrtf(ss[MP + m] * (1.f / DM) + RMS_EPS);
#pragma unroll
        for (int j = 0; j < 4; ++j) yr[64 * j] = xr[64 * j] * rstd * gn[j];
    }
}

__global__ void __launch_bounds__(NWAVES * 64, 2) hymba_fwd(Args args) {
    extern __shared__ __attribute__((aligned(16))) unsigned char lds[];
    Frame F;
    F.lds = (LAS unsigned char*)lds;
    F.MISC = (volatile LAS unsigned*)(F.lds + MISC_OFF);
    F.tid = threadIdx.x; F.lane = F.tid & 63; F.wave = __builtin_amdgcn_readfirstlane(F.tid >> 6);
    F.G = gridDim.x; { const int bx = blockIdx.x; F.vcu = (F.G % 8 == 0) ? (bx % 8) * (F.G / 8) + bx / 8 : bx; }
    F.ctl = (gu32*)(args.ws + WS_CTL);
    const Args& A = args;
    for (int u = F.tid; u < (LDS_BYTES - LDSCTL_OFF) / 4; u += NWAVES * 64) ((LAS unsigned*)(F.lds + LDSCTL_OFF))[u] = 0u;
    __syncthreads();
#if MK_PER_PHASE
#define GRID_BAR() do { } while (0)
#else
    XcdBarrier bar = xcd_barrier_post((unsigned*)(F.ctl + CW_BAR) + args.li * XCD_BAR_WORDS, F.MISC + 8);
#define GRID_BAR() xcd_barrier(bar)
#endif
#if 1
    const int lo = args.ph_lo, hi = args.ph_hi;
    const bool rep = (args.li != 0);
#define REPK(k) (rep && lo == (k))
#ifdef ONLY_PH
#define IN(k) ((k) == ONLY_PH && lo <= (k) && (k) < hi)
#else
#define IN(k) (lo <= (k) && (k) < hi)
#endif
#else
#define REPK(k) false
#define IN(k) true
#endif
#define BOTH(k) (IN(k) && IN((k) + 1))
#define PH_PTRS unsigned char* const ws = args.ws; bf16* const RA = (bf16*)(ws + WS_RA); bf16* const RB = (bf16*)(ws + WS_RB); bf16* const RC = (bf16*)(ws + WS_RC); \
    bf16* const AO = (bf16*)(ws + WS_RD); bf16* const X1B = (bf16*)(ws + WS_RE); \
    float* const SS1 = (float*)(ws + WS_CTL) + CW_SS1; float* const SS2 = (float*)(ws + WS_CTL) + CW_SS2; float* const SS3 = (float*)(ws + WS_CTL) + CW_SS3; float* const SSD = (float*)(ws + WS_CTL) + 163840; \
    (void)RA; (void)RB; (void)RC; (void)AO; (void)X1B; (void)SS1; (void)SS2; (void)SS3; (void)SSD;

    if (IN(0)) { p0_prologue(A, F); if (BOTH(0)) GRID_BAR(); }
    if (IN(1)) { PH_PTRS
        { pg8::Gemm g{RB, (const bf16*)(ws + WS_WIN), MP, 3072, DM}; pg8::StaticOrder S; S.init(MP, 3072, F.G, (int)blockIdx.x);
          pg8::EpiIn E{RA};
          pg8::gemm_phase<pg8::EpiIn, pg8::StaticOrder, true, true>(F.lds + RING_OFF, g, S, E); }
        { const SEpiIn E{RA + (size_t)MP * PBLD};
          for (int i = F.G - 1 - (int)blockIdx.x; i < 96 * 4; i += F.G) small_gemm_item<4>(F, RB + (size_t)MP * DM, (const bf16*)(ws + WS_WIN), i >> 5, (i >> 2) & 7, i & 3, E); }
        if (BOTH(1)) GRID_BAR();
    }
    if (IN(2)) {
        for (int it = F.vcu; it < 256; it += F.G) { const int b = it >> 5, tile = it & 31;
#ifdef PROBE_PH
            if (!(args.pad & 1))
#endif
            short_conv_tail(A, F, b, tile);
#ifdef PROBE_PH
            if (!(args.pad & 2))
#endif
            { D1Pre pre; d1_pre_issue(A, F, (b * NH) * 32 + tile, pre);
              _Pragma("unroll 1") for (int h = 0; h < NH; ++h) { const int ci = (b * NH + h) * 32 + tile, cin = (b * NH + (h + 1 < NH ? h + 1 : h)) * 32 + tile; D1In cur; d1_conv_finish(A, F, ci, pre, cur); d1_chunk(A, F, ci, cur, cin, pre); } } }
#ifdef PROBE_PH
        if (!(args.pad & 4))
#endif
        for (int s = F.G - 1 - F.vcu; s < DEC; s += F.G) sample_mixer(A, F, s);
#ifdef PROBE_PH
        if (!(args.pad & 8))
#endif
        for (int s = F.vcu; s < DEC; s += F.G) conv31_sample(A, F, s);
        if (BOTH(2)) GRID_BAR();
    }
    if (IN(3)) { PH_PTRS
        if ((int)blockIdx.x < 128) {
            const int u = ((int)blockIdx.x & 7) * 16 + ((int)blockIdx.x >> 3);
            scan_unit(A, F, u >> 4, (u >> 2) & 3, 2 * (u & 3));
        } else if ((int)blockIdx.x < 192) {
            pg8::Gemm g{(const bf16*)(ws + WS_MEMN), (const bf16*)(ws + WS_WMKV), NB * NMEM, 2048, DM}; pg8::StaticOrder S; S.init(NB * NMEM, 2048, 64, (int)blockIdx.x - 128);
            pg8::EpiKV E{A.out + OUT_MKP, A.out + OUT_MVP, (bf16*)(ws + WS_KB), (bf16*)(ws + WS_VT)};
            pg8::gemm_phase<pg8::EpiKV, pg8::StaticOrder, true, true>(F.lds + RING_OFF, g, S, E);
        } else {
            weights_phase(A, F, TR_N1, TR_N, ((int)blockIdx.x - 192) * NWAVES + F.wave, (F.G - 192) * NWAVES);
            __syncthreads();
        }
        if ((int)blockIdx.x >= 128) {
            _Pragma("unroll 1") for (int it = (int)blockIdx.x - 128; it < 256; it += F.G - 128) conv31_tile(A, F, it >> 5, it & 31);
        }
        { const SEpiRes<0> SE{A.in[I_XS], nullptr, nullptr, X1B + (size_t)MP * DM, (REPK(3) ? SSD : SS1) + MP};
          for (int i = F.G - 1 - (int)blockIdx.x; i < 32 * 4; i += F.G) small_gemm_item<4>(F, (const bf16*)(ws + WS_RF) + (size_t)MP * DM, (const bf16*)(ws + WS_WOUT), i >> 5, (i >> 2) & 7, i & 3, SE); }
        if (BOTH(3)) GRID_BAR();
    }
    if (IN(4)) { PH_PTRS
        ogate_phase(A, F, F.vcu, F.G);
        { const SEpiQ SE{RB + (size_t)MP * DM, SS1 + MP, ATT_C2};
          for (int i = F.G - 1 - (int)blockIdx.x; i < 32 * 4; i += F.G) small_gemm_item<4>(F, X1B + (size_t)MP * DM, (const bf16*)(ws + WS_WMQ), i >> 5, (i >> 2) & 7, i & 3, SE); }
        if (BOTH(4)) GRID_BAR();
    }
    if (IN(5)) { PH_PTRS
        const bool stream_first = (((int)blockIdx.x >> 3) & 1) != 0;
        if (stream_first) { _Pragma("unroll 1") for (int it = F.vcu; it < DEC * NH; it += F.G) attn_sample(A, F, it >> 2, it & 3); }
        { pg8::Gemm g{(const bf16*)(ws + WS_RF), (const bf16*)(ws + WS_WOUT), MP, DM, DM}; pg8::StaticOrder S; S.init(MP, DM, F.G, (int)blockIdx.x);
          pg8::EpiRes<true> E{nullptr, RB, X1B, REPK(5) ? SSD : SS1, (const float*)(ws + WS_RN)};
          pg8::gemm_phase<pg8::EpiRes<true>, pg8::StaticOrder, true, true>(F.lds + RING_OFF, g, S, E); }
        if (!stream_first) { _Pragma("unroll 1") for (int it = F.vcu; it < DEC * NH; it += F.G) attn_sample(A, F, it >> 2, it & 3); }
        if (BOTH(5)) GRID_BAR();
    }
    if (IN(6)) { PH_PTRS
        pg8::Gemm g{X1B, (const bf16*)(ws + WS_WMQ), MP, DM, DM}; pg8::StaticOrder S; S.init(MP, DM, F.G, (int)blockIdx.x);
        pg8::EpiQL E{SS1, ATT_C2};
        pg8::gemm_phase<pg8::EpiQL, pg8::StaticOrder, false, true>(F.lds + RING_OFF, g, S, E);
        { pg8::Unit u; _Pragma("unroll 1") for (int i = 0; i < 64; ++i) { if (!S.next(i, u)) break; attn_unit32(A, F, u.pm, u.pn); } }
        { const SEpiRes<1> SE{nullptr, X1B + (size_t)MP * DM, nullptr, RC + (size_t)MP * DM, (REPK(6) ? SSD : SS2) + MP};
          for (int i = F.G - 1 - (int)blockIdx.x; i < 32 * 4; i += F.G) small_gemm_item<4>(F, AO + (size_t)MP * DM, (const bf16*)(ws + WS_WMO), i >> 5, (i >> 2) & 7, i & 3, SE); }
        if (BOTH(6)) GRID_BAR();
    }
    if (IN(7)) { PH_PTRS
        pg8::Gemm g{AO, (const bf16*)(ws + WS_WMO), MP, DM, DM}; pg8::StaticOrder S; S.init(MP, DM, F.G, (int)blockIdx.x);
        pg8::EpiRes<false> E{nullptr, X1B, RC, REPK(7) ? SSD : SS2, nullptr};
        pg8::gemm_phase<pg8::EpiRes<false>, pg8::StaticOrder, true, true>(F.lds + RING_OFF, g, S, E);
        { const SEpiGU SE{RA + (size_t)MP * DFF, SS2 + MP};
          for (int i = F.G - 1 - (int)blockIdx.x; i < 176 * 4; i += F.G) small_gemm_item<4>(F, RC + (size_t)MP * DM, (const bf16*)(ws + WS_WGU), i >> 5, (i >> 2) & 7, i & 3, SE); }
        if (BOTH(7)) GRID_BAR();
    }
    if (IN(8)) { PH_PTRS
        pg8::Gemm g{RC, (const bf16*)(ws + WS_WGU), MP, 2 * DFF, DM}; pg8::StaticOrder S; S.init(MP, 2 * DFF, F.G, (int)blockIdx.x);
        pg8::EpiGU E{RA, SS2};
        pg8::gemm_phase<pg8::EpiGU, pg8::StaticOrder, true, true>(F.lds + RING_OFF, g, S, E);
        { const SEpiRes<2> SE{nullptr, RC + (size_t)MP * DM, (float*)(ws + WS_X1S), nullptr, (REPK(8) ? SSD : SS3) + MP};
          for (int i = F.G - 1 - (int)blockIdx.x; i < 32 * 4; i += F.G) small_gemm_item<11>(F, RA + (size_t)MP * DFF, (const bf16*)(ws + WS_WDN), i >> 5, (i >> 2) & 7, i & 3, SE); }
        if (BOTH(8)) GRID_BAR();
    }
    if (IN(9)) { PH_PTRS
        final_norm_phase(A, F);
        pg8::Gemm g{RA, (const bf16*)(ws + WS_WDN), MP, DM, DFF}; pg8::StaticOrder S; S.init(MP, DM, F.G, (int)blockIdx.x);
        pg8::EpiResNorm E{RC, A.out, A.in[I_NF], (float*)(ws + WS_XBUF), (unsigned*)(ws + WS_CTL) + CW_PANEL, (unsigned*)(ws + WS_CTL) + CW_TMO};
        pg8::gemm_phase<pg8::EpiResNorm, pg8::StaticOrder, false, true>(F.lds + RING_OFF, g, S, E);
    }
#undef IN
#undef BOTH
}

extern "C" void kernel_launch(void* const* d_in, const int* in_sizes, int n_in, void* d_out, int out_size, void* d_ws, size_t ws_size, hipStream_t stream) {
    static int grid = 0;
    if (grid == 0) {
        if (n_in != 30 || in_sizes[0] != MP * DM || (size_t)out_size != OUT_END || ws_size < WS_END) {
            fprintf(stderr, "kernel_launch: unexpected shapes: n_in %d, in0 %d, out %d, ws %zu (need >= %zu); nothing launched\n", n_in, n_in > 0 ? in_sizes[0] : -1, out_size, ws_size, (size_t)WS_END); grid = -1; return; }
        int dev = 0, cus = 0, per_cu = 0;
        if (hipGetDevice(&dev) != hipSuccess || hipDeviceGetAttribute(&cus, hipDeviceAttributeMultiprocessorCount, dev) != hipSuccess) { fprintf(stderr, "kernel_launch: device query failed\n"); grid = -1; return; }
        if (hipFuncSetAttribute((const void*)hymba_fwd, hipFuncAttributeMaxDynamicSharedMemorySize, LDS_BYTES) != hipSuccess) { fprintf(stderr, "kernel_launch: hipFuncSetAttribute failed\n"); grid = -1; return; }
        if (hipOccupancyMaxActiveBlocksPerMultiprocessor(&per_cu, (const void*)hymba_fwd, NWAVES * 64, LDS_BYTES) != hipSuccess || per_cu < 1)
            fprintf(stderr, "kernel_launch: note: occupancy query reports %d workgroups per CU\n", per_cu);
        (void)hipGetLastError();
        grid = cus;
        if (grid != 256) { fprintf(stderr, "kernel_launch: built for 256 CUs (one 256x256 unit per workgroup in the fused final-norm phase); found %d; nothing launched\n", grid); grid = -1; return; }
    }
    if (grid < 0) return;
    if (hipMemsetAsync((char*)d_ws + WS_CTL, 0, CTL_ZERO_BYTES, stream) != hipSuccess) { fprintf(stderr, "kernel_launch: hipMemsetAsync failed\n"); return; }
    Args a{};
    for (int i = 0; i < 30; ++i) a.in[i] = (const float*)d_in[i];
    a.out = (float*)d_out; a.ws = (unsigned char*)d_ws;
#if MK_PER_PHASE
    for (int ph = 0; ph < N_PHASES; ++ph) { a.ph_lo = ph; a.ph_hi = ph + 1; a.li = 0;
        hipLaunchKernelGGL(hymba_fwd, dim3(grid), dim3(NWAVES * 64), LDS_BYTES, stream, a); }
#else
#ifdef PROBE_PH
    a.ph_lo = 0; a.ph_hi = PROBE_PH + 1; a.li = 0;
    hipLaunchKernelGGL(hymba_fwd, dim3(grid), dim3(NWAVES * 64), LDS_BYTES, stream, a);
#ifdef PROBE_REPS
    for (int r_ = 0; r_ < PROBE_REPS; ++r_) { a.ph_lo = PROBE_PH; a.ph_hi = PROBE_PH + 1; a.li = 2 + r_; a.pad = PROBE_MODE; hipLaunchKernelGGL(hymba_fwd, dim3(grid), dim3(NWAVES * 64), LDS_BYTES, stream, a); }
#endif
    a.ph_lo = PROBE_PH; a.ph_hi = N_PHASES; a.li = 1; a.pad = 0;
    hipLaunchKernelGGL(hymba_fwd, dim3(grid), dim3(NWAVES * 64), LDS_BYTES, stream, a);
#else
    a.ph_lo = 0; a.ph_hi = N_PHASES; a.li = 0;
    hipLaunchKernelGGL(hymba_fwd, dim3(grid), dim3(NWAVES * 64), LDS_BYTES, stream, a);
#endif
#endif
    const hipError_t le = hipPeekAtLastError();
    if (le != hipSuccess) fprintf(stderr, "kernel_launch: launch failed: %s\n", hipGetErrorName(le));
}
```
